# Optimizing an MI355X kernel written in HIP

```python
import math
import jax
import jax.numpy as jnp
from jax import lax
import numpy as np

D_MODEL = 1024
BATCH = 2
SEQ = 16384
DEPTH = 2

CHUNK = 64
N_BRANCH = 4
MIX_WIDTH = D_MODEL // 4
CONV_W = 4
EPS = 1e-6

GDN_HEADS = 4
GDN_HEAD_DIM = MIX_WIDTH // GDN_HEADS

LRU_BLOCKS = 4
LRU_BLOCK = MIX_WIDTH // LRU_BLOCKS
LRU_C = 8.0

S5_GROUP = 16
S5_GROUPS = MIX_WIDTH // S5_GROUP
S5_STATE = 64

RWKV_HEADS = 4
RWKV_HEAD_DIM = MIX_WIDTH // RWKV_HEADS
DECAY_LORA = 64
AAA_LORA = 64
GATE_LORA = 128
RWKV_LN_EPS = 64e-5

D_FF = 4 * D_MODEL

GDN_COLS = 4 * MIX_WIDTH + 2 * GDN_HEADS
LRU_COLS = 2 * MIX_WIDTH
S5_COLS = MIX_WIDTH
RWKV_COLS = 3 * MIX_WIDTH + DECAY_LORA + AAA_LORA + GATE_LORA
GATE_COLS = N_BRANCH * D_MODEL
D_IN = GDN_COLS + LRU_COLS + S5_COLS + RWKV_COLS + GATE_COLS

kernel_name = "hybrid_gdn_rglru_s5_rwkv7_block"


def _split(t, widths):
    parts, off = [], 0
    for w in widths:
        parts.append(t[..., off:off + w])
        off += w
    return parts


def _rmsnorm(x, g):
    x32 = x.astype(jnp.float32)
    y = x32 * lax.rsqrt(jnp.mean(x32 * x32, axis=-1, keepdims=True) + EPS)
    return (y * g.astype(jnp.float32)).astype(x.dtype)


def _l2norm(t):
    return t * lax.rsqrt(jnp.sum(t * t, axis=-1, keepdims=True) + EPS)


def _causal_dwconv(u, w):
    k, c = w.shape
    return lax.conv_general_dilated(
        u, w[:, None, :].astype(u.dtype), window_strides=(1,), padding=[(k - 1, 0)],
        dimension_numbers=("NWC", "WIO", "NWC"), feature_group_count=c)


def _linear_recurrence(a, b):
    def combine(left, right):
        return left[0] * right[0], right[0] * left[1] + right[1]
    return lax.associative_scan(combine, (a, b), axis=1)[1]


def _chunk_gated_delta(q, k, v, g, beta):
    b, s, h, dk = q.shape
    dv = v.shape[-1]
    n = s // CHUNK

    def to_chunks(t):
        t = t.reshape((b, n, CHUNK, h) + t.shape[3:])
        return jnp.moveaxis(t, 3, 1)

    q, k, v, g, beta = (to_chunks(t) for t in (q, k, v, g, beta))
    gc = jnp.cumsum(g, axis=-1)
    idx = jnp.arange(CHUNK)
    causal = idx[:, None] >= idx[None, :]
    strict = idx[:, None] > idx[None, :]
    diff = gc[..., :, None] - gc[..., None, :]
    decay = jnp.where(causal, jnp.exp(jnp.where(causal, diff, 0.0)), 0.0)
    kb = k * beta[..., None]
    lmat = jnp.where(strict, jnp.einsum("bhnid,bhnjd->bhnij", kb, k) * decay, 0.0)
    eye = jnp.eye(CHUNK, dtype=q.dtype)
    rhs = jnp.concatenate([v * beta[..., None], kb * jnp.exp(gc)[..., None]], axis=-1)
    sol = lax.linalg.triangular_solve(eye + lmat, rhs, left_side=True, lower=True)
    u, w = sol[..., :dv], sol[..., dv:]
    attn = jnp.einsum("bhnid,bhnjd->bhnij", q, k) * decay
    q_dec = q * jnp.exp(gc)[..., None]
    g_last = gc[..., -1]
    k_dec = k * jnp.exp(g_last[..., None] - gc)[..., None]

    def step(state, inp):
        u_i, w_i, q_i, k_i, a_i, gl_i = inp
        v_new = u_i - jnp.einsum("bhck,bhkv->bhcv", w_i, state)
        o = jnp.einsum("bhck,bhkv->bhcv", q_i, state) + jnp.einsum("bhcj,bhjv->bhcv", a_i, v_new)
        state = state * jnp.exp(gl_i)[..., None, None] + jnp.einsum("bhck,bhcv->bhkv", k_i, v_new)
        return state, o

    xs = tuple(jnp.moveaxis(t, 2, 0) for t in (u, w, q_dec, k_dec, attn, g_last))
    state0 = jnp.zeros((b, h, dk, dv), q.dtype)
    _, o = lax.scan(step, state0, xs)
    o = jnp.moveaxis(o, 0, 2)
    return jnp.moveaxis(o, 1, 3).reshape(b, s, h, dv)


def _gdn_mixer(p, conv_w, a_log, dt_bias, norm_g):
    b, s, _ = p.shape
    f32 = jnp.float32
    qkv, z, beta_logit, a_logit = _split(p, (3 * MIX_WIDTH, MIX_WIDTH, GDN_HEADS, GDN_HEADS))
    qkv = jax.nn.silu(_causal_dwconv(qkv, conv_w)).astype(f32)
    q, k, v = (t.reshape(b, s, GDN_HEADS, GDN_HEAD_DIM) for t in _split(qkv, (MIX_WIDTH,) * 3))
    q = _l2norm(q) * (GDN_HEAD_DIM ** -0.5)
    k = _l2norm(k)
    beta = jax.nn.sigmoid(beta_logit.astype(f32))
    g = -jnp.exp(a_log.astype(f32)) * jax.nn.softplus(a_logit.astype(f32) + dt_bias.astype(f32))
    o = _chunk_gated_delta(q, k, v, g, beta)
    o = o * lax.rsqrt(jnp.mean(o * o, axis=-1, keepdims=True) + EPS) * norm_g.astype(f32)
    o = o * jax.nn.silu(z.astype(f32)).reshape(b, s, GDN_HEADS, GDN_HEAD_DIM)
    return o.reshape(b, s, MIX_WIDTH).astype(p.dtype)


def _rglru_mixer(p, conv_w, conv_b, w_a, b_a, w_x, b_x, lam):
    b, s, _ = p.shape
    f32 = jnp.float32
    xb, gate = _split(p, (MIX_WIDTH, MIX_WIDTH))
    u = (_causal_dwconv(xb, conv_w) + conv_b).astype(f32)
    ub = u.reshape(b, s, LRU_BLOCKS, LRU_BLOCK)
    r = jax.nn.sigmoid(jnp.einsum("bsnd,nde->bsne", ub, w_a.astype(f32)).reshape(b, s, MIX_WIDTH) + b_a.astype(f32))
    i = jax.nn.sigmoid(jnp.einsum("bsnd,nde->bsne", ub, w_x.astype(f32)).reshape(b, s, MIX_WIDTH) + b_x.astype(f32))
    log_a = -LRU_C * r * jax.nn.softplus(-lam.astype(f32))
    a = jnp.exp(log_a)
    inp = jnp.sqrt(-jnp.expm1(2.0 * log_a)) * (i * u)
    h = _linear_recurrence(a, inp)
    return (h * jax.nn.gelu(gate.astype(f32))).astype(p.dtype)


def _s5_mixer(u, lam_re, lam_im, b_re, b_im, c_re, c_im, d, log_dt, glu_w, glu_b):
    b, s, _ = u.shape
    f32 = jnp.float32
    ug = u.astype(f32).reshape(b, s, S5_GROUPS, S5_GROUP)
    lam = lax.complex(lam_re.astype(f32), lam_im.astype(f32))
    dt = jnp.exp(log_dt.astype(f32))[:, None]
    lam_bar = jnp.exp(lam * dt)
    b_bar = ((lam_bar - 1.0) / lam)[..., None] * lax.complex(b_re.astype(f32), b_im.astype(f32))
    bu = jnp.einsum("gpc,bsgc->bsgp", b_bar, ug.astype(jnp.complex64))
    h = _linear_recurrence(jnp.broadcast_to(lam_bar, bu.shape), bu)
    c = lax.complex(c_re.astype(f32), c_im.astype(f32))
    y = jnp.einsum("gcp,bsgp->bsgc", c, h).real + d.astype(f32).reshape(S5_GROUPS, S5_GROUP) * ug
    y = jax.nn.gelu(y.reshape(b, s, MIX_WIDTH))
    y = y * jax.nn.sigmoid(y @ glu_w.astype(f32) + glu_b.astype(f32))
    return y.astype(u.dtype)


def _rwkv7_mixer(p, mu, w0, w_up, a0, a_up, g_up, k_k, k_a, r_k, ln_g, ln_b):
    b, s, _ = p.shape
    f32 = jnp.float32
    dtype = p.dtype
    p = p.astype(f32)
    prev = jnp.pad(p, ((0, 0), (1, 0), (0, 0)))[:, :-1]
    p = p + mu.astype(f32) * (prev - p)
    r, k, v, wd, ad, gd = _split(p, (MIX_WIDTH,) * 3 + (DECAY_LORA, AAA_LORA, GATE_LORA))
    logw = -jax.nn.softplus(-(w0.astype(f32) + jnp.tanh(wd) @ w_up.astype(f32))) - 0.5
    decay = jnp.exp(-jnp.exp(logw))
    a = jax.nn.sigmoid(a0.astype(f32) + ad @ a_up.astype(f32))
    g = jax.nn.sigmoid(gd) @ g_up.astype(f32)

    def heads(t):
        return t.reshape(b, s, RWKV_HEADS, RWKV_HEAD_DIM)

    kk = _l2norm(heads(k * k_k.astype(f32)))
    k = k * (1.0 + (a - 1.0) * k_a.astype(f32))
    r, k, v, decay, a = heads(r), heads(k), heads(v), heads(decay), heads(a)

    def step(state, inp):
        r_t, w_t, k_t, v_t, kk_t, a_t = inp
        removed = jnp.einsum("bhvk,bhk->bhv", state, kk_t)
        state = (state * w_t[:, :, None, :]
                 - jnp.einsum("bhv,bhk->bhvk", removed, kk_t * a_t)
                 + jnp.einsum("bhv,bhk->bhvk", v_t, k_t))
        return state, jnp.einsum("bhvk,bhk->bhv", state, r_t)

    xs = tuple(jnp.moveaxis(t, 1, 0) for t in (r, decay, k, v, kk, a))
    state0 = jnp.zeros((b, RWKV_HEADS, RWKV_HEAD_DIM, RWKV_HEAD_DIM), f32)
    _, o = lax.scan(step, state0, xs)
    o = jnp.moveaxis(o, 0, 1)
    mean = jnp.mean(o, axis=-1, keepdims=True)
    var = jnp.mean(jnp.square(o - mean), axis=-1, keepdims=True)
    o = ((o - mean) * lax.rsqrt(var + RWKV_LN_EPS)).reshape(b, s, MIX_WIDTH)
    o = o * ln_g.astype(f32) + ln_b.astype(f32)
    bonus = jnp.sum(r * k * r_k.astype(f32), axis=-1, keepdims=True) * v
    o = (o + bonus.reshape(b, s, MIX_WIDTH)) * g
    return o.astype(dtype)


def _hybrid_layer(x, norm1_g, w_in,
                  gdn_conv_w, gdn_a_log, gdn_dt_bias, gdn_norm_g,
                  lru_conv_w, lru_conv_b, lru_w_a, lru_b_a, lru_w_x, lru_b_x, lru_lambda,
                  s5_lambda_re, s5_lambda_im, s5_b_re, s5_b_im, s5_c_re, s5_c_im,
                  s5_d, s5_log_dt, s5_glu_w, s5_glu_b,
                  rwkv_mu, rwkv_w0, rwkv_w_up, rwkv_a0, rwkv_a_up, rwkv_g_up,
                  rwkv_k_k, rwkv_k_a, rwkv_r_k, rwkv_ln_g, rwkv_ln_b,
                  w_branch, w_out, norm2_g, mlp_w1, mlp_w2):
    b, s, _ = x.shape
    h = _rmsnorm(x, norm1_g)
    proj = h @ w_in
    p_gdn, p_lru, p_s5, p_rwkv, p_gate = _split(proj, (GDN_COLS, LRU_COLS, S5_COLS, RWKV_COLS, GATE_COLS))
    ys = (
        _gdn_mixer(p_gdn, gdn_conv_w, gdn_a_log, gdn_dt_bias, gdn_norm_g),
        _rglru_mixer(p_lru, lru_conv_w, lru_conv_b, lru_w_a, lru_b_a, lru_w_x, lru_b_x, lru_lambda),
        _s5_mixer(p_s5, s5_lambda_re, s5_lambda_im, s5_b_re, s5_b_im, s5_c_re, s5_c_im,
                  s5_d, s5_log_dt, s5_glu_w, s5_glu_b),
        _rwkv7_mixer(p_rwkv, rwkv_mu, rwkv_w0, rwkv_w_up, rwkv_a0, rwkv_a_up, rwkv_g_up,
                     rwkv_k_k, rwkv_k_a, rwkv_r_k, rwkv_ln_g, rwkv_ln_b),
    )
    gate_logits = p_gate.reshape(b, s, N_BRANCH, D_MODEL)
    merged = None
    for i in range(N_BRANCH):
        term = jax.nn.sigmoid(gate_logits[:, :, i]) * (ys[i] @ w_branch[i])
        merged = term if merged is None else merged + term
    x = x + (merged @ w_out).astype(x.dtype)
    h2 = _rmsnorm(x, norm2_g)
    x = x + (jnp.square(jax.nn.relu(h2 @ mlp_w1)) @ mlp_w2).astype(x.dtype)
    return x


def setup_inputs(seed: int = 0) -> dict:
    key = jax.random.key(seed)
    keys = iter(jax.random.split(key, 64))
    f32 = jnp.float32

    def nrm(shape, scale):
        return scale * jax.random.normal(next(keys), shape, f32)

    def uni(shape, lo, hi):
        return jax.random.uniform(next(keys), shape, f32, lo, hi)

    L, W = DEPTH, MIX_WIDTH
    x = nrm((BATCH, SEQ, D_MODEL), 1.0)
    norm1_g = 1.0 + nrm((L, D_MODEL), 0.02)
    w_in = nrm((L, D_MODEL, D_IN), D_MODEL ** -0.5)
    gdn_conv_w = nrm((L, CONV_W, 3 * W), CONV_W ** -0.5)
    gdn_a_log = jnp.log(uni((L, GDN_HEADS), 1.0, 16.0))
    gdn_dt = jnp.exp(uni((L, GDN_HEADS), math.log(1e-3), math.log(1e-1)))
    gdn_dt_bias = gdn_dt + jnp.log(-jnp.expm1(-gdn_dt))
    gdn_norm_g = 1.0 + nrm((L, GDN_HEAD_DIM), 0.02)
    lru_conv_w = nrm((L, CONV_W, W), CONV_W ** -0.5)
    lru_conv_b = nrm((L, W), 0.01)
    lru_w_a = nrm((L, LRU_BLOCKS, LRU_BLOCK, LRU_BLOCK), LRU_BLOCK ** -0.5)
    lru_b_a = nrm((L, W), 0.01)
    lru_w_x = nrm((L, LRU_BLOCKS, LRU_BLOCK, LRU_BLOCK), LRU_BLOCK ** -0.5)
    lru_b_x = nrm((L, W), 0.01)
    a_base = uni((L, W), 0.9, 0.999) ** (1.0 / LRU_C)
    lru_lambda = jnp.log(a_base) - jnp.log1p(-a_base)
    s5_lambda_re = -0.5 + nrm((L, S5_GROUPS, S5_STATE), 0.01)
    s5_lambda_im = jnp.pi * jnp.arange(S5_STATE, dtype=f32) + nrm((L, S5_GROUPS, S5_STATE), 0.01)
    s5_b_re = nrm((L, S5_GROUPS, S5_STATE, S5_GROUP), (2 * S5_GROUP) ** -0.5)
    s5_b_im = nrm((L, S5_GROUPS, S5_STATE, S5_GROUP), (2 * S5_GROUP) ** -0.5)
    s5_c_re = nrm((L, S5_GROUPS, S5_GROUP, S5_STATE), S5_STATE ** -0.5)
    s5_c_im = nrm((L, S5_GROUPS, S5_GROUP, S5_STATE), S5_STATE ** -0.5)
    s5_d = nrm((L, W), 1.0)
    s5_log_dt = uni((L, S5_GROUPS), math.log(1e-3), math.log(1e-1))
    s5_glu_w = nrm((L, W, W), W ** -0.5)
    s5_glu_b = nrm((L, W), 0.01)
    rwkv_mu = uni((L, RWKV_COLS), 0.0, 1.0)
    rwkv_w0 = uni((L, W), -6.0, -1.0)
    rwkv_w_up = nrm((L, DECAY_LORA, W), 0.1)
    rwkv_a0 = nrm((L, W), 0.1)
    rwkv_a_up = nrm((L, AAA_LORA, W), 0.1)
    rwkv_g_up = nrm((L, GATE_LORA, W), GATE_LORA ** -0.5)
    rwkv_k_k = 0.85 + nrm((L, W), 0.02)
    rwkv_k_a = 1.0 + nrm((L, W), 0.02)
    rwkv_r_k = nrm((L, RWKV_HEADS, RWKV_HEAD_DIM), 0.1)
    rwkv_ln_g = 1.0 + nrm((L, W), 0.02)
    rwkv_ln_b = nrm((L, W), 0.01)
    w_branch = nrm((L, N_BRANCH, W, D_MODEL), W ** -0.5)
    w_out = nrm((L, D_MODEL, D_MODEL), D_MODEL ** -0.5)
    norm2_g = 1.0 + nrm((L, D_MODEL), 0.02)
    mlp_w1 = nrm((L, D_MODEL, D_FF), D_MODEL ** -0.5)
    mlp_w2 = nrm((L, D_FF, D_MODEL), D_FF ** -0.5)
    final_norm_g = 1.0 + nrm((D_MODEL,), 0.02)
    return {
        "x": x, "norm1_g": norm1_g, "w_in": w_in,
        "gdn_conv_w": gdn_conv_w, "gdn_a_log": gdn_a_log, "gdn_dt_bias": gdn_dt_bias, "gdn_norm_g": gdn_norm_g,
        "lru_conv_w": lru_conv_w, "lru_conv_b": lru_conv_b, "lru_w_a": lru_w_a, "lru_b_a": lru_b_a,
        "lru_w_x": lru_w_x, "lru_b_x": lru_b_x, "lru_lambda": lru_lambda,
        "s5_lambda_re": s5_lambda_re, "s5_lambda_im": s5_lambda_im, "s5_b_re": s5_b_re, "s5_b_im": s5_b_im,
        "s5_c_re": s5_c_re, "s5_c_im": s5_c_im, "s5_d": s5_d, "s5_log_dt": s5_log_dt,
        "s5_glu_w": s5_glu_w, "s5_glu_b": s5_glu_b,
        "rwkv_mu": rwkv_mu, "rwkv_w0": rwkv_w0, "rwkv_w_up": rwkv_w_up, "rwkv_a0": rwkv_a0,
        "rwkv_a_up": rwkv_a_up, "rwkv_g_up": rwkv_g_up, "rwkv_k_k": rwkv_k_k, "rwkv_k_a": rwkv_k_a,
        "rwkv_r_k": rwkv_r_k, "rwkv_ln_g": rwkv_ln_g, "rwkv_ln_b": rwkv_ln_b,
        "w_branch": w_branch, "w_out": w_out, "norm2_g": norm2_g, "mlp_w1": mlp_w1, "mlp_w2": mlp_w2,
        "final_norm_g": final_norm_g,
    }


def reference(x, norm1_g, w_in,
              gdn_conv_w, gdn_a_log, gdn_dt_bias, gdn_norm_g,
              lru_conv_w, lru_conv_b, lru_w_a, lru_b_a, lru_w_x, lru_b_x, lru_lambda,
              s5_lambda_re, s5_lambda_im, s5_b_re, s5_b_im, s5_c_re, s5_c_im,
              s5_d, s5_log_dt, s5_glu_w, s5_glu_b,
              rwkv_mu, rwkv_w0, rwkv_w_up, rwkv_a0, rwkv_a_up, rwkv_g_up,
              rwkv_k_k, rwkv_k_a, rwkv_r_k, rwkv_ln_g, rwkv_ln_b,
              w_branch, w_out, norm2_g, mlp_w1, mlp_w2, final_norm_g):
    for l in range(DEPTH):
        x = _hybrid_layer(
            x, norm1_g[l], w_in[l],
            gdn_conv_w[l], gdn_a_log[l], gdn_dt_bias[l], gdn_norm_g[l],
            lru_conv_w[l], lru_conv_b[l], lru_w_a[l], lru_b_a[l], lru_w_x[l], lru_b_x[l], lru_lambda[l],
            s5_lambda_re[l], s5_lambda_im[l], s5_b_re[l], s5_b_im[l], s5_c_re[l], s5_c_im[l],
            s5_d[l], s5_log_dt[l], s5_glu_w[l], s5_glu_b[l],
            rwkv_mu[l], rwkv_w0[l], rwkv_w_up[l], rwkv_a0[l], rwkv_a_up[l], rwkv_g_up[l],
            rwkv_k_k[l], rwkv_k_a[l], rwkv_r_k[l], rwkv_ln_g[l], rwkv_ln_b[l],
            w_branch[l], w_out[l], norm2_g[l], mlp_w1[l], mlp_w2[l])
    return _rmsnorm(x, final_norm_g)
```

```cpp
#include <hip/hip_runtime.h>
#include <cstdio>
#include <cstdint>
#ifndef PH
#define PH 31
#endif

constexpr int TB = 16384;
constexpr int D = 1024;
constexpr int DIN = 6920;
constexpr int NMIX = 2824;
constexpr int W = 256;
constexpr int DFF = 4096;
constexpr int NT = 512;

constexpr int C_GDN = 0, C_LRU = 1032, C_S5 = 1544, C_RWKV = 1800, C_GATE = 2824;

struct Params { const float* in[41]; float* out; unsigned char* ws; size_t pad; };

constexpr size_t MiB = 1u << 20;
constexpr size_t WS_XN = 0;
constexpr size_t WS_PM = 64 * MiB;
constexpr size_t WS_Y  = 241 * MiB;
constexpr size_t WS_MG = 305 * MiB;
constexpr size_t WS_HD = 369 * MiB;
constexpr size_t WS_LA = 433 * MiB;
constexpr size_t WS_LI = 449 * MiB;
constexpr size_t WS_S5 = 465 * MiB;
constexpr size_t WS_RW = 305 * MiB;

__device__ __forceinline__ float sigmoidf_(float x) { return 1.f / (1.f + __expf(-x)); }
__device__ __forceinline__ float softplusf_(float x) { return x > 20.f ? x : log1pf(expf(x)); }
__device__ __forceinline__ float siluf_(float x) { return x * sigmoidf_(x); }
__device__ __forceinline__ float geluf_(float x) { return 0.5f * x * (1.f + tanhf(0.7978845608028654f * (x + 0.044715f * x * x * x))); }
__device__ __forceinline__ float rl(float v, int i) { return __int_as_float(__builtin_amdgcn_readlane(__float_as_int(v), i)); }
__device__ __forceinline__ float wave_sum(float v) {
#pragma unroll
    for (int o = 1; o < 64; o <<= 1) v += __shfl_xor(v, o);
    return v;
}

template <class Epi>
__device__ __forceinline__ void gemm_naive(const float* __restrict__ A, int lda, const float* __restrict__ B, int ldb,
                           int M, int N, int K, float* lds, Epi epi) {
    float* As = lds;
    float* Bs = lds + 16 * 132;
    const int tid = threadIdx.x, ty = tid >> 5, tx = tid & 31;
    const int nM = M / 128, nN = (N + 127) / 128;
    for (int tile = blockIdx.x; tile < nM * nN; tile += gridDim.x) {
        const int tm = tile % nM, tn = tile / nM;
        const int m0 = tm * 128, n0 = tn * 128;
        float acc[8][4];
#pragma unroll
        for (int i = 0; i < 8; ++i)
#pragma unroll
            for (int j = 0; j < 4; ++j) acc[i][j] = 0.f;
        for (int k0 = 0; k0 < K; k0 += 16) {
            {
                const int r = tid >> 2, kk = (tid & 3) * 4;
                const float4 a = *(const float4*)(A + (size_t)(m0 + r) * lda + k0 + kk);
                As[(kk + 0) * 132 + r] = a.x; As[(kk + 1) * 132 + r] = a.y; As[(kk + 2) * 132 + r] = a.z; As[(kk + 3) * 132 + r] = a.w;
                const int kr = tid >> 5, c = (tid & 31) * 4;
                float4 b = make_float4(0.f, 0.f, 0.f, 0.f);
                if (n0 + c < N) b = *(const float4*)(B + (size_t)(k0 + kr) * ldb + n0 + c);
                *(float4*)(Bs + kr * 132 + c) = b;
            }
            __syncthreads();
#pragma unroll 2
            for (int k = 0; k < 16; ++k) {
                const float4 a0 = *(const float4*)(As + k * 132 + ty * 8);
                const float4 a1 = *(const float4*)(As + k * 132 + ty * 8 + 4);
                const float4 b = *(const float4*)(Bs + k * 132 + tx * 4);
                const float av[8] = {a0.x, a0.y, a0.z, a0.w, a1.x, a1.y, a1.z, a1.w};
                const float bv[4] = {b.x, b.y, b.z, b.w};
#pragma unroll
                for (int i = 0; i < 8; ++i)
#pragma unroll
                    for (int j = 0; j < 4; ++j) acc[i][j] = fmaf(av[i], bv[j], acc[i][j]);
            }
            __syncthreads();
        }
        if (n0 + tx * 4 < N) {
#pragma unroll
            for (int i = 0; i < 8; ++i) epi(m0 + ty * 8 + i, n0 + tx * 4, acc[i]);
        }
    }
}

__device__ __forceinline__ void gemm_merge_naive(const float* __restrict__ XN, const float* __restrict__ Y, const float* __restrict__ w_in,
                                 const float* __restrict__ w_branch, float* __restrict__ MG, float* lds) {
    float* As = lds;
    float* Bs = lds + 16 * 132;
    const int tid = threadIdx.x, ty = tid >> 5, tx = tid & 31;
    const int nM = TB / 128, nN = D / 128;
    for (int tile = blockIdx.x; tile < nM * nN; tile += gridDim.x) {
        const int tm = tile % nM, tn = tile / nM;
        const int m0 = tm * 128, n0 = tn * 128;
        float mg[8][4];
#pragma unroll
        for (int i = 0; i < 8; ++i)
#pragma unroll
            for (int j = 0; j < 4; ++j) mg[i][j] = 0.f;
        for (int br = 0; br < 4; ++br) {
            float gate[8][4];
            for (int pass = 0; pass < 2; ++pass) {
                const float* A = pass == 0 ? XN : Y + br * W;
                const int lda = D;
                const float* B = pass == 0 ? w_in + C_GATE + br * D : w_branch + (size_t)br * W * D;
                const int ldb = pass == 0 ? DIN : D;
                const int K = pass == 0 ? D : W;
                float acc[8][4];
#pragma unroll
                for (int i = 0; i < 8; ++i)
#pragma unroll
                    for (int j = 0; j < 4; ++j) acc[i][j] = 0.f;
                for (int k0 = 0; k0 < K; k0 += 16) {
                    {
                        const int r = tid >> 2, kk = (tid & 3) * 4;
                        const float4 a = *(const float4*)(A + (size_t)(m0 + r) * lda + k0 + kk);
                        As[(kk + 0) * 132 + r] = a.x; As[(kk + 1) * 132 + r] = a.y; As[(kk + 2) * 132 + r] = a.z; As[(kk + 3) * 132 + r] = a.w;
                        const int kr = tid >> 5, c = (tid & 31) * 4;
                        const float4 b = *(const float4*)(B + (size_t)(k0 + kr) * ldb + n0 + c);
                        *(float4*)(Bs + kr * 132 + c) = b;
                    }
                    __syncthreads();
#pragma unroll 2
                    for (int k = 0; k < 16; ++k) {
                        const float4 a0 = *(const float4*)(As + k * 132 + ty * 8);
                        const float4 a1 = *(const float4*)(As + k * 132 + ty * 8 + 4);
                        const float4 b = *(const float4*)(Bs + k * 132 + tx * 4);
                        const float av[8] = {a0.x, a0.y, a0.z, a0.w, a1.x, a1.y, a1.z, a1.w};
                        const float bv[4] = {b.x, b.y, b.z, b.w};
#pragma unroll
                        for (int i = 0; i < 8; ++i)
#pragma unroll
                            for (int j = 0; j < 4; ++j) acc[i][j] = fmaf(av[i], bv[j], acc[i][j]);
                    }
                    __syncthreads();
                }
                if (pass == 0) {
#pragma unroll
                    for (int i = 0; i < 8; ++i)
#pragma unroll
                        for (int j = 0; j < 4; ++j) gate[i][j] = sigmoidf_(acc[i][j]);
                } else {
#pragma unroll
                    for (int i = 0; i < 8; ++i)
#pragma unroll
                        for (int j = 0; j < 4; ++j) mg[i][j] = fmaf(gate[i][j], acc[i][j], mg[i][j]);
                }
            }
        }
#pragma unroll
        for (int i = 0; i < 8; ++i)
            *(float4*)(MG + (size_t)(m0 + ty * 8 + i) * D + n0 + tx * 4) = make_float4(mg[i][0], mg[i][1], mg[i][2], mg[i][3]);
    }
}

__device__ __forceinline__ void rmsnorm_rows(const float* X, const float* g, float* O, int rows) {
    const int lane = threadIdx.x & 63, wv = threadIdx.x >> 6;
    const int gw = blockIdx.x * (NT / 64) + wv, ngw = gridDim.x * (NT / 64);
    for (int r = gw; r < rows; r += ngw) {
        const float4* xr = (const float4*)(X + (size_t)r * D);
        float4 v[4]; float s = 0.f;
#pragma unroll
        for (int j = 0; j < 4; ++j) { v[j] = xr[lane + 64 * j]; s += v[j].x * v[j].x + v[j].y * v[j].y + v[j].z * v[j].z + v[j].w * v[j].w; }
        s = wave_sum(s);
        const float rs = rsqrtf(s * (1.f / D) + 1e-6f);
        float4* orow = (float4*)(O + (size_t)r * D);
#pragma unroll
        for (int j = 0; j < 4; ++j) {
            const float4 gg = ((const float4*)g)[lane + 64 * j];
            orow[lane + 64 * j] = make_float4(v[j].x * rs * gg.x, v[j].y * rs * gg.y, v[j].z * rs * gg.z, v[j].w * rs * gg.w);
        }
    }
}

struct LayerW {
    const float *gdn_conv_w, *gdn_a_log, *gdn_dt_bias, *gdn_norm_g;
    const float *lru_conv_w, *lru_conv_b, *lru_w_a, *lru_b_a, *lru_w_x, *lru_b_x, *lru_lambda;
    const float *s5_lre, *s5_lim, *s5_bre, *s5_bim, *s5_cre, *s5_cim, *s5_d, *s5_log_dt, *s5_glu_w, *s5_glu_b;
    const float *rw_mu, *rw_w0, *rw_w_up, *rw_a0, *rw_a_up, *rw_g_up, *rw_k_k, *rw_k_a, *rw_r_k, *rw_ln_g, *rw_ln_b;
};

__device__ __forceinline__ LayerW make_layer(const Params& p, int l) {
    LayerW L;
    L.gdn_conv_w = p.in[3] + l * 4 * 768; L.gdn_a_log = p.in[4] + l * 4; L.gdn_dt_bias = p.in[5] + l * 4; L.gdn_norm_g = p.in[6] + l * 64;
    L.lru_conv_w = p.in[7] + l * 4 * W; L.lru_conv_b = p.in[8] + l * W; L.lru_w_a = p.in[9] + l * 4 * 64 * 64; L.lru_b_a = p.in[10] + l * W;
    L.lru_w_x = p.in[11] + l * 4 * 64 * 64; L.lru_b_x = p.in[12] + l * W; L.lru_lambda = p.in[13] + l * W;
    L.s5_lre = p.in[14] + l * 1024; L.s5_lim = p.in[15] + l * 1024; L.s5_bre = p.in[16] + l * 16384; L.s5_bim = p.in[17] + l * 16384;
    L.s5_cre = p.in[18] + l * 16384; L.s5_cim = p.in[19] + l * 16384; L.s5_d = p.in[20] + l * W; L.s5_log_dt = p.in[21] + l * 16;
    L.s5_glu_w = p.in[22] + l * W * W; L.s5_glu_b = p.in[23] + l * W;
    L.rw_mu = p.in[24] + l * 1024; L.rw_w0 = p.in[25] + l * W; L.rw_w_up = p.in[26] + l * 64 * W; L.rw_a0 = p.in[27] + l * W;
    L.rw_a_up = p.in[28] + l * 64 * W; L.rw_g_up = p.in[29] + l * 128 * W; L.rw_k_k = p.in[30] + l * W; L.rw_k_a = p.in[31] + l * W;
    L.rw_r_k = p.in[32] + l * W; L.rw_ln_g = p.in[33] + l * W; L.rw_ln_b = p.in[34] + l * W;
    return L;
}

__device__ __forceinline__ void gdn_naive_head(const float* __restrict__ PM, float* __restrict__ Y, const Params& p, int l, int h) {
    asm volatile("" : "+s"(l));
    const LayerW L = make_layer(p, (long long)l);
    const int lane = threadIdx.x & 63;
    float S[64];
#pragma unroll
    for (int i = 0; i < 64; ++i) S[i] = 0.f;
    const int cq = h * 64 + lane, ck = 256 + h * 64 + lane, cv = 512 + h * 64 + lane;
    float wq[4], wk[4], wv[4];
#pragma unroll
    for (int t = 0; t < 4; ++t) { wq[t] = L.gdn_conv_w[t * 768 + cq]; wk[t] = L.gdn_conv_w[t * 768 + ck]; wv[t] = L.gdn_conv_w[t * 768 + cv]; }
    float hq0 = 0.f, hq1 = 0.f, hq2 = 0.f, hk0 = 0.f, hk1 = 0.f, hk2 = 0.f, hv0 = 0.f, hv1 = 0.f, hv2 = 0.f;
    const float A = -expf(L.gdn_a_log[h]), dtb = L.gdn_dt_bias[h];
    const float ng = L.gdn_norm_g[lane];
    for (int t = 0; t < TB; ++t) {
        const float* row = PM + (size_t)t * NMIX + C_GDN;
        const float pq = row[cq], pk = row[ck], pv = row[cv];
        float q = wq[0] * hq0 + wq[1] * hq1 + wq[2] * hq2 + wq[3] * pq;
        float k = wk[0] * hk0 + wk[1] * hk1 + wk[2] * hk2 + wk[3] * pk;
        float v = wv[0] * hv0 + wv[1] * hv1 + wv[2] * hv2 + wv[3] * pv;
        hq0 = hq1; hq1 = hq2; hq2 = pq; hk0 = hk1; hk1 = hk2; hk2 = pk; hv0 = hv1; hv1 = hv2; hv2 = pv;
        q = siluf_(q); k = siluf_(k); v = siluf_(v);
        const float qn = wave_sum(q * q), kn = wave_sum(k * k);
        q = q * rsqrtf(qn + 1e-6f) * 0.125f;
        k = k * rsqrtf(kn + 1e-6f);
        const float beta = sigmoidf_(row[1024 + h]);
        const float g = A * softplusf_(row[1028 + h] + dtb);
        const float eg = expf(g);
        float kS = 0.f;
#pragma unroll
        for (int i = 0; i < 64; ++i) kS = fmaf(rl(k, i), S[i], kS);
        const float c1 = beta * (v - eg * kS);
        float o = 0.f;
#pragma unroll
        for (int i = 0; i < 64; ++i) { const float ki = rl(k, i); S[i] = fmaf(eg, S[i], ki * c1); o = fmaf(rl(q, i), S[i], o); }
        const float ms = wave_sum(o * o) * (1.f / 64.f);
        const float z = row[768 + h * 64 + lane];
        Y[(size_t)t * D + h * 64 + lane] = o * rsqrtf(ms + 1e-6f) * ng * siluf_(z);
    }
}

__device__ __forceinline__ void rwkv_prep(const float* __restrict__ PM, float* __restrict__ RW, const Params& p, int l) {
    asm volatile("" : "+s"(l));
    const LayerW L = make_layer(p, (long long)l);
    const size_t AS = (size_t)TB * W;
    for (size_t idx = (size_t)blockIdx.x * NT + threadIdx.x; idx < AS; idx += (size_t)gridDim.x * NT) {
        const int t = (int)(idx >> 8), c = (int)(idx & 255);
        const float* row = PM + (size_t)t * NMIX + C_RWKV;
        const float* prow = row - NMIX;
        auto sh = [&](int col) { const float p = row[col]; const float pr = t > 0 ? prow[col] : 0.f; return p + L.rw_mu[col] * (pr - p); };
        const float r = sh(c), k = sh(256 + c), v = sh(512 + c);
        float wl = 0.f, al = 0.f, gl = 0.f;
        for (int j = 0; j < 64; ++j) { wl = fmaf(tanhf(sh(768 + j)), L.rw_w_up[j * W + c], wl); al = fmaf(sh(832 + j), L.rw_a_up[j * W + c], al); }
        for (int j = 0; j < 128; ++j) gl = fmaf(sigmoidf_(sh(896 + j)), L.rw_g_up[j * W + c], gl);
        const float logw = -softplusf_(-(L.rw_w0[c] + wl)) - 0.5f;
        const float dec = expf(-expf(logw));
        const float a = sigmoidf_(L.rw_a0[c] + al);
        RW[0 * AS + idx] = r;
        RW[1 * AS + idx] = dec;
        RW[2 * AS + idx] = k * (1.f + (a - 1.f) * L.rw_k_a[c]);
        RW[3 * AS + idx] = v;
        RW[4 * AS + idx] = k * L.rw_k_k[c];
        RW[5 * AS + idx] = a;
        RW[6 * AS + idx] = gl;
    }
}

__device__ __forceinline__ void rwkv_naive_head(const float* __restrict__ RW, float* __restrict__ Y, const Params& p, int l, int h) {
    asm volatile("" : "+s"(l));
    const LayerW L = make_layer(p, (long long)l);
    const int lane = threadIdx.x & 63;
    const size_t AS = (size_t)TB * W;
    float S[64];
#pragma unroll
    for (int i = 0; i < 64; ++i) S[i] = 0.f;
    const int c = h * 64 + lane;
    const float rk = L.rw_r_k[h * 64 + lane], lg = L.rw_ln_g[c], lb = L.rw_ln_b[c];
    for (int t = 0; t < TB; ++t) {
        const size_t o = (size_t)t * W + c;
        const float r = RW[o], w = RW[AS + o], k = RW[2 * AS + o], v = RW[3 * AS + o], kraw = RW[4 * AS + o], a = RW[5 * AS + o], g = RW[6 * AS + o];
        const float kk = kraw * rsqrtf(wave_sum(kraw * kraw) + 1e-6f);
        const float ka = kk * a;
        float rem = 0.f;
#pragma unroll
        for (int i = 0; i < 64; ++i) rem = fmaf(S[i], rl(kk, i), rem);
        float out = 0.f;
#pragma unroll
        for (int i = 0; i < 64; ++i) {
            S[i] = S[i] * rl(w, i) - rem * rl(ka, i) + v * rl(k, i);
            out = fmaf(S[i], rl(r, i), out);
        }
        const float mean = wave_sum(out) * (1.f / 64.f);
        const float dv = out - mean;
        const float var = wave_sum(dv * dv) * (1.f / 64.f);
        float y = dv * rsqrtf(var + 64e-5f) * lg + lb;
        const float bonus = wave_sum(r * k * rk) * v;
        Y[(size_t)t * D + 768 + c] = (y + bonus) * g;
    }
}

__device__ __forceinline__ void lru_prep(const float* __restrict__ PM, float* __restrict__ LA, float* __restrict__ LI, const Params& p, int l) {
    asm volatile("" : "+s"(l));
    const LayerW L = make_layer(p, (long long)l);
    const size_t AS = (size_t)TB * W;
    for (size_t idx = (size_t)blockIdx.x * NT + threadIdx.x; idx < AS; idx += (size_t)gridDim.x * NT) {
        const int t = (int)(idx >> 8), c = (int)(idx & 255), n = c >> 6, e = c & 63;
        auto conv = [&](int ch) {
            float u = L.lru_conv_b[ch];
#pragma unroll
            for (int j = 0; j < 4; ++j) { const int tt = t - 3 + j; if (tt >= 0) u = fmaf(L.lru_conv_w[j * W + ch], PM[(size_t)tt * NMIX + C_LRU + ch], u); }
            return u;
        };
        float ra = L.lru_b_a[c], ri = L.lru_b_x[c];
        for (int d = 0; d < 64; ++d) {
            const float ud = conv(n * 64 + d);
            ra = fmaf(ud, L.lru_w_a[(n * 64 + d) * 64 + e], ra);
            ri = fmaf(ud, L.lru_w_x[(n * 64 + d) * 64 + e], ri);
        }
        const float u = conv(c);
        const float r = sigmoidf_(ra), i = sigmoidf_(ri);
        const float log_a = -8.f * r * softplusf_(-L.lru_lambda[c]);
        LA[idx] = expf(log_a);
        LI[idx] = sqrtf(-expm1f(2.f * log_a)) * (i * u);
    }
}
__device__ __forceinline__ void lru_scan(const float* __restrict__ PM, const float* __restrict__ LA, const float* __restrict__ LI, float* __restrict__ Y) {
    const int c = threadIdx.x;
    if (c >= W) return;
    float h = 0.f;
    for (int t = 0; t < TB; ++t) {
        const size_t o = (size_t)t * W + c;
        h = fmaf(LA[o], h, LI[o]);
        const float gate = PM[(size_t)t * NMIX + C_LRU + 256 + c];
        Y[(size_t)t * D + 256 + c] = h * geluf_(gate);
    }
}

__device__ __forceinline__ void s5_naive_group(const float* __restrict__ PM, float* __restrict__ S5Y, const Params& p, int l, int g) {
    asm volatile("" : "+s"(l));
    const LayerW L = make_layer(p, (long long)l);
    const int lane = threadIdx.x & 63;
    const float dt = expf(L.s5_log_dt[g]);
    const float lre = L.s5_lre[g * 64 + lane], lim = L.s5_lim[g * 64 + lane];
    const float er = expf(lre * dt);
    const float lbr = er * cosf(lim * dt), lbi = er * sinf(lim * dt);
    const float nr = lbr - 1.f, ni = lbi, den = lre * lre + lim * lim;
    const float fr = (nr * lre + ni * lim) / den, fi = (ni * lre - nr * lim) / den;
    float bbr[16], bbi[16], cr[16], ci[16];
    const float dd = L.s5_d[g * 16 + (lane & 15)];
#pragma unroll
    for (int c = 0; c < 16; ++c) {
        const float br = L.s5_bre[(g * 64 + lane) * 16 + c], bi = L.s5_bim[(g * 64 + lane) * 16 + c];
        bbr[c] = fr * br - fi * bi; bbi[c] = fr * bi + fi * br;
        cr[c] = L.s5_cre[(g * 16 + c) * 64 + lane]; ci[c] = L.s5_cim[(g * 16 + c) * 64 + lane];
    }
    float hr = 0.f, hi = 0.f;
    for (int t = 0; t < TB; ++t) {
        const float* u = PM + (size_t)t * NMIX + C_S5 + g * 16;
        float br = 0.f, bi = 0.f;
        const float umine = u[lane & 15];
#pragma unroll
        for (int c = 0; c < 16; ++c) { const float uc = rl(umine, c); br = fmaf(bbr[c], uc, br); bi = fmaf(bbi[c], uc, bi); }
        const float nhr = lbr * hr - lbi * hi + br, nhi = lbr * hi + lbi * hr + bi;
        hr = nhr; hi = nhi;
        float myy = 0.f;
#pragma unroll
        for (int c = 0; c < 16; ++c) {
            const float s = wave_sum(cr[c] * hr - ci[c] * hi);
            if (lane == c) myy = s + dd * umine;
        }
        if (lane < 16) S5Y[(size_t)t * W + g * 16 + lane] = myy;
    }
}
__device__ __forceinline__ void s5_post(const float* __restrict__ S5Y, float* __restrict__ Y, const Params& p, int l) {
    asm volatile("" : "+s"(l));
    const LayerW L = make_layer(p, (long long)l);
    const size_t AS = (size_t)TB * W;
    for (size_t idx = (size_t)blockIdx.x * NT + threadIdx.x; idx < AS; idx += (size_t)gridDim.x * NT) {
        const int t = (int)(idx >> 8), c = (int)(idx & 255);
        const float* yr = S5Y + (size_t)t * W;
        float acc = L.s5_glu_b[c];
        for (int j = 0; j < W; ++j) acc = fmaf(geluf_(yr[j]), L.s5_glu_w[j * W + c], acc);
        const float y = geluf_(yr[c]);
        Y[(size_t)t * D + 512 + c] = y * sigmoidf_(acc);
    }
}


struct EpiStore { float* O; int ld; int pad; __device__ __forceinline__ void operator()(int r, int c, const float (&a)[4]) const { *(float4*)(O + (size_t)r * ld + c) = make_float4(a[0], a[1], a[2], a[3]); } };
struct EpiResid { const float* Xin; float* Xo; __device__ __forceinline__ void operator()(int r, int c, const float (&a)[4]) const {
    const float4 xi = *(const float4*)(Xin + (size_t)r * D + c); *(float4*)(Xo + (size_t)r * D + c) = make_float4(xi.x + a[0], xi.y + a[1], xi.z + a[2], xi.w + a[3]); } };
struct EpiRelu2 { float* O; __device__ __forceinline__ void operator()(int r, int c, const float (&a)[4]) const {
    float4 o; o.x = fmaxf(a[0], 0.f); o.y = fmaxf(a[1], 0.f); o.z = fmaxf(a[2], 0.f); o.w = fmaxf(a[3], 0.f);
    o.x *= o.x; o.y *= o.y; o.z *= o.z; o.w *= o.w; *(float4*)(O + (size_t)r * 1024 + c) = o; } };

template <class Epi> struct GemmArgs { const float* A; const float* B; int lda, ldb, M, N, K, pad; Epi epi; };
template <class Epi>
__global__ void __launch_bounds__(NT) k_gemm(GemmArgs<Epi> a) {
    __shared__ __attribute__((aligned(16))) float lds[2 * 16 * 132];
    gemm_naive(a.A, a.lda, a.B, a.ldb, a.M, a.N, a.K, lds, a.epi);
}
template <class Epi> static void launch_gemm(hipStream_t st, const float* A, int lda, const float* B, int ldb, int M, int N, int K, Epi e) {
    GemmArgs<Epi> a{}; a.A = A; a.B = B; a.lda = lda; a.ldb = ldb; a.M = M; a.N = N; a.K = K; a.pad = 0; a.epi = e;
    k_gemm<Epi><<<1024, NT, 0, st>>>(a);
}
struct LP { Params p; long long l; };
__global__ void __launch_bounds__(NT) k_merge(const float* XN, const float* Y, const float* w_in, const float* w_branch, float* MG) {
    __shared__ __attribute__((aligned(16))) float lds[2 * 16 * 132];
    gemm_merge_naive(XN, Y, w_in, w_branch, MG, lds);
}
__global__ void __launch_bounds__(NT) k_rmsnorm(const float* X, const float* g, float* O, long long rows) { rmsnorm_rows(X, g, O, (int)rows); }
__global__ void __launch_bounds__(NT) k_rwkv_prep(Params p, long long l_) { rwkv_prep((const float*)(p.ws + WS_PM), (float*)(p.ws + WS_RW), p, (int)l_); }
__global__ void __launch_bounds__(NT) k_lru_prep(Params p, long long l_) { lru_prep((const float*)(p.ws + WS_PM), (float*)(p.ws + WS_LA), (float*)(p.ws + WS_LI), p, (int)l_); }
__global__ void __launch_bounds__(64) k_gdn(Params p, long long l_) { gdn_naive_head((const float*)(p.ws + WS_PM), (float*)(p.ws + WS_Y), p, (int)l_, blockIdx.x); }
__global__ void __launch_bounds__(64) k_rwkv(Params p, long long l_) { rwkv_naive_head((const float*)(p.ws + WS_RW), (float*)(p.ws + WS_Y), p, (int)l_, blockIdx.x); }
__global__ void __launch_bounds__(64) k_s5(Params p, long long l_) { s5_naive_group((const float*)(p.ws + WS_PM), (float*)(p.ws + WS_S5), p, (int)l_, blockIdx.x); }
__global__ void __launch_bounds__(256) k_lru(Params p) { lru_scan((const float*)(p.ws + WS_PM), (const float*)(p.ws + WS_LA), (const float*)(p.ws + WS_LI), (float*)(p.ws + WS_Y)); }
__global__ void __launch_bounds__(NT) k_s5post(Params p, long long l_) { s5_post((const float*)(p.ws + WS_S5), (float*)(p.ws + WS_Y), p, (int)l_); }

extern "C" void kernel_launch(void* const* d_in, const int* in_sizes, int n_in, void* d_out, int out_size, void* d_ws, size_t ws_size, hipStream_t stream) {
    Params p{};
    for (int i = 0; i < 41; ++i) p.in[i] = (const float*)d_in[i];
    p.out = (float*)d_out; p.ws = (unsigned char*)d_ws; p.pad = 0;
    unsigned char* ws = p.ws;
    float* XN = (float*)(ws + WS_XN); float* PM = (float*)(ws + WS_PM); float* Y = (float*)(ws + WS_Y);
    float* MG = (float*)(ws + WS_MG); float* HD = (float*)(ws + WS_HD);
    float* X = p.out;
    const int G = 1024;
    for (int l = 0; l < 2; ++l) {
        const float* norm1_g = p.in[1] + l * D;
        const float* w_in = p.in[2] + (size_t)l * D * DIN;
        const float* w_branch = p.in[35] + (size_t)l * 4 * W * D;
        const float* w_out = p.in[36] + (size_t)l * D * D;
        const float* norm2_g = p.in[37] + l * D;
        const float* w1 = p.in[38] + (size_t)l * D * DFF;
        const float* w2 = p.in[39] + (size_t)l * DFF * D;
        for (int b = 0; b < 2; ++b) {
            const float* Xin = (l == 0 ? p.in[0] : X) + (size_t)b * TB * D;
            float* Xb = X + (size_t)b * TB * D;
            k_rmsnorm<<<G, NT, 0, stream>>>(Xin, norm1_g, XN, (long long)TB);
            launch_gemm(stream, XN, D, w_in, DIN, TB, NMIX, D, EpiStore{PM, NMIX, 0});
            k_rwkv_prep<<<G, NT, 0, stream>>>(p, (long long)l);
            k_lru_prep<<<G, NT, 0, stream>>>(p, (long long)l);
            k_gdn<<<4, 64, 0, stream>>>(p, (long long)l);
            k_rwkv<<<4, 64, 0, stream>>>(p, (long long)l);
            k_s5<<<16, 64, 0, stream>>>(p, (long long)l);
            k_lru<<<1, 256, 0, stream>>>(p);
            k_s5post<<<G, NT, 0, stream>>>(p, (long long)l);
            k_merge<<<G, NT, 0, stream>>>(XN, Y, w_in, w_branch, MG);
            launch_gemm(stream, MG, D, w_out, D, TB, D, D, EpiResid{Xin, Xb});
            k_rmsnorm<<<G, NT, 0, stream>>>(Xb, norm2_g, XN, (long long)TB);
            for (int ch = 0; ch < 4; ++ch) {
                launch_gemm(stream, XN, D, w1 + ch * 1024, DFF, TB, 1024, D, EpiRelu2{HD});
                launch_gemm(stream, HD, 1024, w2 + (size_t)ch * 1024 * D, D, TB, D, 1024, EpiResid{Xb, Xb});
            }
        }
    }
    k_rmsnorm<<<G, NT, 0, stream>>>(X, p.in[40], X, (long long)(2 * TB));
}
```

```cpp
#include <hip/hip_runtime.h>
#include <cstdio>
#include <cstdint>
#ifndef PH
#define PH 31
#endif

constexpr int TB = 16384;
constexpr int D = 1024;
constexpr int DIN = 6920;
constexpr int NMIX = 2824;
constexpr int W = 256;
constexpr int DFF = 4096;
constexpr int NT = 512;

constexpr int C_GDN = 0, C_LRU = 1032, C_S5 = 1544, C_RWKV = 1800, C_GATE = 2824;

struct Params { const float* in[41]; float* out; unsigned char* ws; size_t pad; };

typedef unsigned short bf16_t;
constexpr int PMLD = 3072;
constexpr size_t MiB = 1u << 20;
constexpr size_t WS_W  = 0;
constexpr size_t WS_XN = 36 * MiB;
constexpr size_t WS_PM = 68 * MiB;
constexpr size_t WS_G  = 164 * MiB;
constexpr size_t WS_HD = 164 * MiB;
constexpr size_t WS_Y  = 292 * MiB;
constexpr size_t WS_MG = 324 * MiB;
constexpr size_t WS_LA = 324 * MiB;
constexpr size_t WS_LI = 340 * MiB;
constexpr size_t WS_S5 = 356 * MiB;

__device__ __forceinline__ unsigned f2bf(float f) { unsigned u = __float_as_uint(f); return (u + 0x7fffu + ((u >> 16) & 1u)) >> 16; }
__device__ __forceinline__ float bf2f(bf16_t b) { return __uint_as_float((unsigned)b << 16); }
__device__ __forceinline__ float ldf(const float* p) { return *p; }
__device__ __forceinline__ float ldf(const bf16_t* p) { return bf2f(*p); }
__device__ __forceinline__ float sigmoidf_(float x) { return 1.f / (1.f + __expf(-x)); }
__device__ __forceinline__ float softplusf_(float x) { return x > 20.f ? x : log1pf(expf(x)); }
__device__ __forceinline__ float siluf_(float x) { return x * sigmoidf_(x); }
__device__ __forceinline__ float geluf_(float x) { return 0.5f * x * (1.f + tanhf(0.7978845608028654f * (x + 0.044715f * x * x * x))); }
__device__ __forceinline__ float rl(float v, int i) { return __int_as_float(__builtin_amdgcn_readlane(__float_as_int(v), i)); }
__device__ __forceinline__ float wave_sum(float v) {
#pragma unroll
    for (int o = 1; o < 64; o <<= 1) v += __shfl_xor(v, o);
    return v;
}

template <class AT, class Epi>
__device__ __forceinline__ void gemm_naive(const AT* __restrict__ A, int lda, const float* __restrict__ B, int ldb,
                           int M, int N, int K, float* lds, Epi epi) {
    float* As = lds;
    float* Bs = lds + 16 * 132;
    const int tid = threadIdx.x, ty = tid >> 5, tx = tid & 31;
    const int nM = M / 128, nN = (N + 127) / 128;
    for (int tile = blockIdx.x; tile < nM * nN; tile += gridDim.x) {
        const int tm = tile % nM, tn = tile / nM;
        const int m0 = tm * 128, n0 = tn * 128;
        float acc[8][4];
#pragma unroll
        for (int i = 0; i < 8; ++i)
#pragma unroll
            for (int j = 0; j < 4; ++j) acc[i][j] = 0.f;
        for (int k0 = 0; k0 < K; k0 += 16) {
            {
                const int r = tid >> 2, kk = (tid & 3) * 4;
                const AT* ap = A + (size_t)(m0 + r) * lda + k0 + kk;
                As[(kk + 0) * 132 + r] = ldf(ap); As[(kk + 1) * 132 + r] = ldf(ap + 1); As[(kk + 2) * 132 + r] = ldf(ap + 2); As[(kk + 3) * 132 + r] = ldf(ap + 3);
                const int kr = tid >> 5, c = (tid & 31) * 4;
                float4 b = make_float4(0.f, 0.f, 0.f, 0.f);
                if (n0 + c < N) b = *(const float4*)(B + (size_t)(k0 + kr) * ldb + n0 + c);
                *(float4*)(Bs + kr * 132 + c) = b;
            }
            __syncthreads();
#pragma unroll 2
            for (int k = 0; k < 16; ++k) {
                const float4 a0 = *(const float4*)(As + k * 132 + ty * 8);
                const float4 a1 = *(const float4*)(As + k * 132 + ty * 8 + 4);
                const float4 b = *(const float4*)(Bs + k * 132 + tx * 4);
                const float av[8] = {a0.x, a0.y, a0.z, a0.w, a1.x, a1.y, a1.z, a1.w};
                const float bv[4] = {b.x, b.y, b.z, b.w};
#pragma unroll
                for (int i = 0; i < 8; ++i)
#pragma unroll
                    for (int j = 0; j < 4; ++j) acc[i][j] = fmaf(av[i], bv[j], acc[i][j]);
            }
            __syncthreads();
        }
        if (n0 + tx * 4 < N) {
#pragma unroll
            for (int i = 0; i < 8; ++i) epi(m0 + ty * 8 + i, n0 + tx * 4, acc[i]);
        }
    }
}

__device__ __forceinline__ void gemm_merge_naive(const bf16_t* __restrict__ G, const bf16_t* __restrict__ Y,
                                 const float* __restrict__ w_branch, bf16_t* __restrict__ MG, float* lds) {
    float* As = lds;
    float* Bs = lds + 16 * 132;
    const int tid = threadIdx.x, ty = tid >> 5, tx = tid & 31;
    const int nM = TB / 128, nN = D / 128;
    for (int tile = blockIdx.x; tile < nM * nN; tile += gridDim.x) {
        const int tm = tile % nM, tn = tile / nM;
        const int m0 = tm * 128, n0 = tn * 128;
        float mg[8][4];
#pragma unroll
        for (int i = 0; i < 8; ++i)
#pragma unroll
            for (int j = 0; j < 4; ++j) mg[i][j] = 0.f;
        for (int br = 0; br < 4; ++br) {
            const bf16_t* A = Y + br * W;
            const float* B = w_branch + (size_t)br * W * D;
            float acc[8][4];
#pragma unroll
            for (int i = 0; i < 8; ++i)
#pragma unroll
                for (int j = 0; j < 4; ++j) acc[i][j] = 0.f;
            for (int k0 = 0; k0 < W; k0 += 16) {
                {
                    const int r = tid >> 2, kk = (tid & 3) * 4;
                    const bf16_t* ap = A + (size_t)(m0 + r) * D + k0 + kk;
                    As[(kk + 0) * 132 + r] = bf2f(ap[0]); As[(kk + 1) * 132 + r] = bf2f(ap[1]); As[(kk + 2) * 132 + r] = bf2f(ap[2]); As[(kk + 3) * 132 + r] = bf2f(ap[3]);
                    const int kr = tid >> 5, c = (tid & 31) * 4;
                    const float4 b = *(const float4*)(B + (size_t)(k0 + kr) * D + n0 + c);
                    *(float4*)(Bs + kr * 132 + c) = b;
                }
                __syncthreads();
#pragma unroll 2
                for (int k = 0; k < 16; ++k) {
                    const float4 a0 = *(const float4*)(As + k * 132 + ty * 8);
                    const float4 a1 = *(const float4*)(As + k * 132 + ty * 8 + 4);
                    const float4 b = *(const float4*)(Bs + k * 132 + tx * 4);
                    const float av[8] = {a0.x, a0.y, a0.z, a0.w, a1.x, a1.y, a1.z, a1.w};
                    const float bv[4] = {b.x, b.y, b.z, b.w};
#pragma unroll
                    for (int i = 0; i < 8; ++i)
#pragma unroll
                        for (int j = 0; j < 4; ++j) acc[i][j] = fmaf(av[i], bv[j], acc[i][j]);
                }
                __syncthreads();
            }
#pragma unroll
            for (int i = 0; i < 8; ++i) {
                const bf16_t* gp = G + (size_t)(m0 + ty * 8 + i) * 4096 + br * D + n0 + tx * 4;
#pragma unroll
                for (int j = 0; j < 4; ++j) mg[i][j] = fmaf(bf2f(gp[j]), acc[i][j], mg[i][j]);
            }
        }
#pragma unroll
        for (int i = 0; i < 8; ++i) {
            bf16_t* op = MG + (size_t)(m0 + ty * 8 + i) * D + n0 + tx * 4;
#pragma unroll
            for (int j = 0; j < 4; ++j) op[j] = (bf16_t)f2bf(mg[i][j]);
        }
    }
}

template <class OT>
__device__ __forceinline__ void rmsnorm_rows(const float* X, const float* g, OT* O, int rows) {
    const int lane = threadIdx.x & 63, wv = threadIdx.x >> 6;
    const int gw = blockIdx.x * (NT / 64) + wv, ngw = gridDim.x * (NT / 64);
    for (int r = gw; r < rows; r += ngw) {
        const float4* xr = (const float4*)(X + (size_t)r * D);
        float4 v[4]; float s = 0.f;
#pragma unroll
        for (int j = 0; j < 4; ++j) { v[j] = xr[lane + 64 * j]; s += v[j].x * v[j].x + v[j].y * v[j].y + v[j].z * v[j].z + v[j].w * v[j].w; }
        s = wave_sum(s);
        const float rs = rsqrtf(s * (1.f / D) + 1e-6f);
#pragma unroll
        for (int j = 0; j < 4; ++j) {
            const float4 gg = ((const float4*)g)[lane + 64 * j];
            const float4 o = make_float4(v[j].x * rs * gg.x, v[j].y * rs * gg.y, v[j].z * rs * gg.z, v[j].w * rs * gg.w);
            if constexpr (sizeof(OT) == 4) ((float4*)(O + (size_t)r * D))[lane + 64 * j] = o;
            else ((uint2*)(O + (size_t)r * D))[lane + 64 * j] = make_uint2(f2bf(o.x) | (f2bf(o.y) << 16), f2bf(o.z) | (f2bf(o.w) << 16));
        }
    }
}

struct LayerW {
    const float *gdn_conv_w, *gdn_a_log, *gdn_dt_bias, *gdn_norm_g;
    const float *lru_conv_w, *lru_conv_b, *lru_w_a, *lru_b_a, *lru_w_x, *lru_b_x, *lru_lambda;
    const float *s5_lre, *s5_lim, *s5_bre, *s5_bim, *s5_cre, *s5_cim, *s5_d, *s5_log_dt, *s5_glu_w, *s5_glu_b;
    const float *rw_mu, *rw_w0, *rw_w_up, *rw_a0, *rw_a_up, *rw_g_up, *rw_k_k, *rw_k_a, *rw_r_k, *rw_ln_g, *rw_ln_b;
};

__device__ __forceinline__ LayerW make_layer(const Params& p, int l) {
    LayerW L;
    L.gdn_conv_w = p.in[3] + l * 4 * 768; L.gdn_a_log = p.in[4] + l * 4; L.gdn_dt_bias = p.in[5] + l * 4; L.gdn_norm_g = p.in[6] + l * 64;
    L.lru_conv_w = p.in[7] + l * 4 * W; L.lru_conv_b = p.in[8] + l * W; L.lru_w_a = p.in[9] + l * 4 * 64 * 64; L.lru_b_a = p.in[10] + l * W;
    L.lru_w_x = p.in[11] + l * 4 * 64 * 64; L.lru_b_x = p.in[12] + l * W; L.lru_lambda = p.in[13] + l * W;
    L.s5_lre = p.in[14] + l * 1024; L.s5_lim = p.in[15] + l * 1024; L.s5_bre = p.in[16] + l * 16384; L.s5_bim = p.in[17] + l * 16384;
    L.s5_cre = p.in[18] + l * 16384; L.s5_cim = p.in[19] + l * 16384; L.s5_d = p.in[20] + l * W; L.s5_log_dt = p.in[21] + l * 16;
    L.s5_glu_w = p.in[22] + l * W * W; L.s5_glu_b = p.in[23] + l * W;
    L.rw_mu = p.in[24] + l * 1024; L.rw_w0 = p.in[25] + l * W; L.rw_w_up = p.in[26] + l * 64 * W; L.rw_a0 = p.in[27] + l * W;
    L.rw_a_up = p.in[28] + l * 64 * W; L.rw_g_up = p.in[29] + l * 128 * W; L.rw_k_k = p.in[30] + l * W; L.rw_k_a = p.in[31] + l * W;
    L.rw_r_k = p.in[32] + l * W; L.rw_ln_g = p.in[33] + l * W; L.rw_ln_b = p.in[34] + l * W;
    return L;
}

__device__ __forceinline__ void gdn_naive_head(const bf16_t* __restrict__ PM, bf16_t* __restrict__ Y, const Params& p, int l, int h) {
    asm volatile("" : "+s"(l));
    const LayerW L = make_layer(p, (long long)l);
    const int lane = threadIdx.x & 63;
    float S[64];
#pragma unroll
    for (int i = 0; i < 64; ++i) S[i] = 0.f;
    const int cq = h * 64 + lane, ck = 256 + h * 64 + lane, cv = 512 + h * 64 + lane;
    float wq[4], wk[4], wv[4];
#pragma unroll
    for (int t = 0; t < 4; ++t) { wq[t] = L.gdn_conv_w[t * 768 + cq]; wk[t] = L.gdn_conv_w[t * 768 + ck]; wv[t] = L.gdn_conv_w[t * 768 + cv]; }
    float hq0 = 0.f, hq1 = 0.f, hq2 = 0.f, hk0 = 0.f, hk1 = 0.f, hk2 = 0.f, hv0 = 0.f, hv1 = 0.f, hv2 = 0.f;
    const float A = -expf(L.gdn_a_log[h]), dtb = L.gdn_dt_bias[h];
    const float ng = L.gdn_norm_g[lane];
    for (int t = 0; t < TB; ++t) {
        const bf16_t* row = PM + (size_t)t * PMLD + C_GDN;
        const float pq = bf2f(row[cq]), pk = bf2f(row[ck]), pv = bf2f(row[cv]);
        float q = wq[0] * hq0 + wq[1] * hq1 + wq[2] * hq2 + wq[3] * pq;
        float k = wk[0] * hk0 + wk[1] * hk1 + wk[2] * hk2 + wk[3] * pk;
        float v = wv[0] * hv0 + wv[1] * hv1 + wv[2] * hv2 + wv[3] * pv;
        hq0 = hq1; hq1 = hq2; hq2 = pq; hk0 = hk1; hk1 = hk2; hk2 = pk; hv0 = hv1; hv1 = hv2; hv2 = pv;
        q = siluf_(q); k = siluf_(k); v = siluf_(v);
        const float qn = wave_sum(q * q), kn = wave_sum(k * k);
        q = q * rsqrtf(qn + 1e-6f) * 0.125f;
        k = k * rsqrtf(kn + 1e-6f);
        const float beta = sigmoidf_(bf2f(row[1024 + h]));
        const float g = A * softplusf_(bf2f(row[1028 + h]) + dtb);
        const float eg = expf(g);
        float kS = 0.f;
#pragma unroll
        for (int i = 0; i < 64; ++i) kS = fmaf(rl(k, i), S[i], kS);
        const float c1 = beta * (v - eg * kS);
        float o = 0.f;
#pragma unroll
        for (int i = 0; i < 64; ++i) { const float ki = rl(k, i); S[i] = fmaf(eg, S[i], ki * c1); o = fmaf(rl(q, i), S[i], o); }
        const float ms = wave_sum(o * o) * (1.f / 64.f);
        const float z = bf2f(row[768 + h * 64 + lane]);
        Y[(size_t)t * D + h * 64 + lane] = (bf16_t)f2bf(o * rsqrtf(ms + 1e-6f) * ng * siluf_(z));
    }
}

__device__ __forceinline__ void rwkv_prep(const bf16_t* __restrict__ PM, float* __restrict__ RW, const Params& p, int l) {
    asm volatile("" : "+s"(l));
    const LayerW L = make_layer(p, (long long)l);
    const size_t AS = (size_t)TB * W;
    for (size_t idx = (size_t)blockIdx.x * NT + threadIdx.x; idx < AS; idx += (size_t)gridDim.x * NT) {
        const int t = (int)(idx >> 8), c = (int)(idx & 255);
        const bf16_t* row = PM + (size_t)t * PMLD + C_RWKV;
        const bf16_t* prow = row - PMLD;
        auto sh = [&](int col) { const float p = bf2f(row[col]); const float pr = t > 0 ? bf2f(prow[col]) : 0.f; return p + L.rw_mu[col] * (pr - p); };
        const float r = sh(c), k = sh(256 + c), v = sh(512 + c);
        float wl = 0.f, al = 0.f, gl = 0.f;
        for (int j = 0; j < 64; ++j) { wl = fmaf(tanhf(sh(768 + j)), L.rw_w_up[j * W + c], wl); al = fmaf(sh(832 + j), L.rw_a_up[j * W + c], al); }
        for (int j = 0; j < 128; ++j) gl = fmaf(sigmoidf_(sh(896 + j)), L.rw_g_up[j * W + c], gl);
        const float logw = -softplusf_(-(L.rw_w0[c] + wl)) - 0.5f;
        const float dec = expf(-expf(logw));
        const float a = sigmoidf_(L.rw_a0[c] + al);
        RW[0 * AS + idx] = r;
        RW[1 * AS + idx] = dec;
        RW[2 * AS + idx] = k * (1.f + (a - 1.f) * L.rw_k_a[c]);
        RW[3 * AS + idx] = v;
        RW[4 * AS + idx] = k * L.rw_k_k[c];
        RW[5 * AS + idx] = a;
        RW[6 * AS + idx] = gl;
    }
}

__device__ __forceinline__ void rwkv_naive_head(const float* __restrict__ RW, bf16_t* __restrict__ Y, const Params& p, int l, int h) {
    asm volatile("" : "+s"(l));
    const LayerW L = make_layer(p, (long long)l);
    const int lane = threadIdx.x & 63;
    const size_t AS = (size_t)TB * W;
    float S[64];
#pragma unroll
    for (int i = 0; i < 64; ++i) S[i] = 0.f;
    const int c = h * 64 + lane;
    const float rk = L.rw_r_k[h * 64 + lane], lg = L.rw_ln_g[c], lb = L.rw_ln_b[c];
    for (int t = 0; t < TB; ++t) {
        const size_t o = (size_t)t * W + c;
        const float r = RW[o], w = RW[AS + o], k = RW[2 * AS + o], v = RW[3 * AS + o], kraw = RW[4 * AS + o], a = RW[5 * AS + o], g = RW[6 * AS + o];
        const float kk = kraw * rsqrtf(wave_sum(kraw * kraw) + 1e-6f);
        const float ka = kk * a;
        float rem = 0.f;
#pragma unroll
        for (int i = 0; i < 64; ++i) rem = fmaf(S[i], rl(kk, i), rem);
        float out = 0.f;
#pragma unroll
        for (int i = 0; i < 64; ++i) {
            S[i] = S[i] * rl(w, i) - rem * rl(ka, i) + v * rl(k, i);
            out = fmaf(S[i], rl(r, i), out);
        }
        const float mean = wave_sum(out) * (1.f / 64.f);
        const float dv = out - mean;
        const float var = wave_sum(dv * dv) * (1.f / 64.f);
        float y = dv * rsqrtf(var + 64e-5f) * lg + lb;
        const float bonus = wave_sum(r * k * rk) * v;
        Y[(size_t)t * D + 768 + c] = (bf16_t)f2bf((y + bonus) * g);
    }
}

__device__ __forceinline__ void lru_prep(const bf16_t* __restrict__ PM, float* __restrict__ LA, float* __restrict__ LI, const Params& p, int l) {
    asm volatile("" : "+s"(l));
    const LayerW L = make_layer(p, (long long)l);
    const size_t AS = (size_t)TB * W;
    for (size_t idx = (size_t)blockIdx.x * NT + threadIdx.x; idx < AS; idx += (size_t)gridDim.x * NT) {
        const int t = (int)(idx >> 8), c = (int)(idx & 255), n = c >> 6, e = c & 63;
        auto conv = [&](int ch) {
            float u = L.lru_conv_b[ch];
#pragma unroll
            for (int j = 0; j < 4; ++j) { const int tt = t - 3 + j; if (tt >= 0) u = fmaf(L.lru_conv_w[j * W + ch], bf2f(PM[(size_t)tt * PMLD + C_LRU + ch]), u); }
            return u;
        };
        float ra = L.lru_b_a[c], ri = L.lru_b_x[c];
        for (int d = 0; d < 64; ++d) {
            const float ud = conv(n * 64 + d);
            ra = fmaf(ud, L.lru_w_a[(n * 64 + d) * 64 + e], ra);
            ri = fmaf(ud, L.lru_w_x[(n * 64 + d) * 64 + e], ri);
        }
        const float u = conv(c);
        const float r = sigmoidf_(ra), i = sigmoidf_(ri);
        const float log_a = -8.f * r * softplusf_(-L.lru_lambda[c]);
        LA[idx] = expf(log_a);
        LI[idx] = sqrtf(-expm1f(2.f * log_a)) * (i * u);
    }
}
__device__ __forceinline__ void lru_scan(const bf16_t* __restrict__ PM, const float* __restrict__ LA, const float* __restrict__ LI, bf16_t* __restrict__ Y) {
    const int c = threadIdx.x;
    if (c >= W) return;
    float h = 0.f;
    for (int t = 0; t < TB; ++t) {
        const size_t o = (size_t)t * W + c;
        h = fmaf(LA[o], h, LI[o]);
        const float gate = bf2f(PM[(size_t)t * PMLD + C_LRU + 256 + c]);
        Y[(size_t)t * D + 256 + c] = (bf16_t)f2bf(h * geluf_(gate));
    }
}

__device__ __forceinline__ void s5_naive_group(const bf16_t* __restrict__ PM, float* __restrict__ S5Y, const Params& p, int l, int g) {
    asm volatile("" : "+s"(l));
    const LayerW L = make_layer(p, (long long)l);
    const int lane = threadIdx.x & 63;
    const float dt = expf(L.s5_log_dt[g]);
    const float lre = L.s5_lre[g * 64 + lane], lim = L.s5_lim[g * 64 + lane];
    const float er = expf(lre * dt);
    const float lbr = er * cosf(lim * dt), lbi = er * sinf(lim * dt);
    const float nr = lbr - 1.f, ni = lbi, den = lre * lre + lim * lim;
    const float fr = (nr * lre + ni * lim) / den, fi = (ni * lre - nr * lim) / den;
    float bbr[16], bbi[16], cr[16], ci[16];
    const float dd = L.s5_d[g * 16 + (lane & 15)];
#pragma unroll
    for (int c = 0; c < 16; ++c) {
        const float br = L.s5_bre[(g * 64 + lane) * 16 + c], bi = L.s5_bim[(g * 64 + lane) * 16 + c];
        bbr[c] = fr * br - fi * bi; bbi[c] = fr * bi + fi * br;
        cr[c] = L.s5_cre[(g * 16 + c) * 64 + lane]; ci[c] = L.s5_cim[(g * 16 + c) * 64 + lane];
    }
    float hr = 0.f, hi = 0.f;
    for (int t = 0; t < TB; ++t) {
        const bf16_t* u = PM + (size_t)t * PMLD + C_S5 + g * 16;
        float br = 0.f, bi = 0.f;
        const float umine = bf2f(u[lane & 15]);
#pragma unroll
        for (int c = 0; c < 16; ++c) { const float uc = rl(umine, c); br = fmaf(bbr[c], uc, br); bi = fmaf(bbi[c], uc, bi); }
        const float nhr = lbr * hr - lbi * hi + br, nhi = lbr * hi + lbi * hr + bi;
        hr = nhr; hi = nhi;
        float myy = 0.f;
#pragma unroll
        for (int c = 0; c < 16; ++c) {
            const float s = wave_sum(cr[c] * hr - ci[c] * hi);
            if (lane == c) myy = s + dd * umine;
        }
        if (lane < 16) S5Y[(size_t)t * W + g * 16 + lane] = myy;
    }
}
__device__ __forceinline__ void s5_post(const float* __restrict__ S5Y, bf16_t* __restrict__ Y, const Params& p, int l) {
    asm volatile("" : "+s"(l));
    const LayerW L = make_layer(p, (long long)l);
    const size_t AS = (size_t)TB * W;
    for (size_t idx = (size_t)blockIdx.x * NT + threadIdx.x; idx < AS; idx += (size_t)gridDim.x * NT) {
        const int t = (int)(idx >> 8), c = (int)(idx & 255);
        const float* yr = S5Y + (size_t)t * W;
        float acc = L.s5_glu_b[c];
        for (int j = 0; j < W; ++j) acc = fmaf(geluf_(yr[j]), L.s5_glu_w[j * W + c], acc);
        const float y = geluf_(yr[c]);
        Y[(size_t)t * D + 512 + c] = (bf16_t)f2bf(y * sigmoidf_(acc));
    }
}


namespace pg8 {
#define PG8_LAS __attribute__((address_space(3)))
typedef short bf16x8 __attribute__((ext_vector_type(8)));
typedef float f32x4 __attribute__((ext_vector_type(4)));
typedef unsigned u32x4 __attribute__((ext_vector_type(4)));
constexpr int BM = 256, BK = 64, HALF = 128, HTB = HALF * BK * 2  , STAGE_BYTES = 8 * HTB, NXCD = 8, WGM = 8;

__host__ __device__ __forceinline__ int lds_byte(int r, int c) { const int st = (r >> 4) * 2 + (c >> 5), rr = r & 15, cc = c & 31, ob = rr * 64 + cc * 2; return st * 1024 + (ob ^ (((ob >> 9) & 1) << 5)); }
__host__ __device__ __forceinline__ void stage_rc(int b, int& R, int& C) { const int st = b / 1024, sb = b % 1024, swz = sb ^ (((sb >> 9) & 1) << 5); R = (st >> 1) * 16 + swz / 64; C = (st & 1) * 32 + (swz % 64) / 2; }
__host__ __device__ __forceinline__ int perm32(int rho) { const int n = rho >> 4, i = rho & 15; return 8 * (i >> 2) + 4 * n + (i & 3); }

struct Unit { int pm, pn; };
struct Gemm { const bf16_t* A; const bf16_t* Bt; int M, N, K, lda, ldb, pad; };

struct StaticOrder {
    int nM, nN, nwg, G, c;
    __host__ __device__ void init(int M, int N, int G_, int c_) { nM = M / BM; nN = N / BM; nwg = nM * nN; G = G_; c = c_; }
    __host__ __device__ bool next(int i, Unit& u) const {
        const long L = (long)i * G + c; if (L >= nwg) return false;
        int wgid = (int)L; { const int q = nwg / NXCD, r = nwg % NXCD, xcd = wgid % NXCD, off = wgid / NXCD; wgid = (xcd < r ? xcd * (q + 1) : r * (q + 1) + (xcd - r) * q) + off; }
        const int nig = WGM * nN, gid = wgid / nig, fm = gid * WGM, gsz = (nM - fm) < WGM ? (nM - fm) : WGM;
        u.pm = fm + ((wgid % nig) % gsz); u.pn = (wgid % nig) / gsz; return true;
    }
    __device__ __forceinline__ void a_ready(const Unit&) const {}
    __device__ __forceinline__ void done(const Unit&) const {}
};


__device__ __forceinline__ unsigned cvt_pk_bf16(float lo, float hi) { unsigned r; asm volatile("v_cvt_pk_bf16_f32 %0, %1, %2" : "=v"(r) : "v"(lo), "v"(hi)); return r; }
__device__ __forceinline__ float sigm(float x) { return __builtin_amdgcn_rcpf(1.f + __expf(-x)); }
struct EpiProjP {
    static constexpr bool PERM = true, AFTER_DRAIN = false;
    bf16_t* PM; bf16_t* G;
    __device__ __forceinline__ void operator()(const f32x4 (&acc)[2][2][4][2], const Unit& u, int wr, int wc, int fr, int fq) const {
        const int row0 = u.pm * BM + wr * 64 + fr;
        const bool sg = u.pn >= 12;
        bf16_t* base = sg ? G : PM; const int ld = sg ? 4096 : 3072; const int colt = (sg ? u.pn - 12 : u.pn) * BM;
        const int col0 = colt + wc * 32 + 8 * fq;
#pragma unroll
        for (int ai = 0; ai < 2; ++ai)
#pragma unroll
            for (int m = 0; m < 4; ++m) { bf16_t* rowp = base + (size_t)(row0 + ai * HALF + m * 16) * ld + col0;
#pragma unroll
                for (int bj = 0; bj < 2; ++bj) { f32x4 v0 = acc[ai][bj][m][0], v1 = acc[ai][bj][m][1];
                    if (sg) { v0[0] = sigm(v0[0]); v0[1] = sigm(v0[1]); v0[2] = sigm(v0[2]); v0[3] = sigm(v0[3]); v1[0] = sigm(v1[0]); v1[1] = sigm(v1[1]); v1[2] = sigm(v1[2]); v1[3] = sigm(v1[3]); }
                    u32x4 w; w.x = cvt_pk_bf16(v0[0], v0[1]); w.y = cvt_pk_bf16(v0[2], v0[3]); w.z = cvt_pk_bf16(v1[0], v1[1]); w.w = cvt_pk_bf16(v1[2], v1[3]);
                    *(u32x4*)(rowp + bj * HALF) = w; } }
    }
};
struct EpiRelu2P {
    static constexpr bool PERM = true, AFTER_DRAIN = false;
    bf16_t* O; int ldo; int pad;
    __device__ __forceinline__ void operator()(const f32x4 (&acc)[2][2][4][2], const Unit& u, int wr, int wc, int fr, int fq) const {
        const int row0 = u.pm * BM + wr * 64 + fr, col0 = u.pn * BM + wc * 32 + 8 * fq;
#pragma unroll
        for (int ai = 0; ai < 2; ++ai)
#pragma unroll
            for (int m = 0; m < 4; ++m) { bf16_t* rowp = O + (size_t)(row0 + ai * HALF + m * 16) * ldo + col0;
#pragma unroll
                for (int bj = 0; bj < 2; ++bj) { f32x4 v0 = acc[ai][bj][m][0], v1 = acc[ai][bj][m][1];
#pragma unroll
                    for (int j = 0; j < 4; ++j) { const float a = fmaxf(v0[j], 0.f), b = fmaxf(v1[j], 0.f); v0[j] = a * a; v1[j] = b * b; }
                    u32x4 w; w.x = cvt_pk_bf16(v0[0], v0[1]); w.y = cvt_pk_bf16(v0[2], v0[3]); w.z = cvt_pk_bf16(v1[0], v1[1]); w.w = cvt_pk_bf16(v1[2], v1[3]);
                    *(u32x4*)(rowp + bj * HALF) = w; } }
    }
};
struct EpiResidP {
    static constexpr bool PERM = false, AFTER_DRAIN = false;
    const float* base; float* out;
    __device__ __forceinline__ void operator()(const f32x4 (&acc)[2][2][4][2], const Unit& u, int wr, int wc, int fr, int fq) const {
        const int row0 = u.pm * BM + wr * 64 + fr, col0 = u.pn * BM + wc * 32 + 4 * fq;
#pragma unroll
        for (int ai = 0; ai < 2; ++ai)
#pragma unroll
            for (int m = 0; m < 4; ++m) { const size_t off = (size_t)(row0 + ai * HALF + m * 16) * 1024 + col0;
#pragma unroll
                for (int bj = 0; bj < 2; ++bj)
#pragma unroll
                    for (int n = 0; n < 2; ++n) { const f32x4 b = *(const f32x4*)(base + off + bj * HALF + n * 16); *(f32x4*)(out + off + bj * HALF + n * 16) = b + acc[ai][bj][m][n]; } }
    }
};
template <class Epi, class Sched, bool ALIGN_EPI = false, bool SP2 = false>
__device__ __forceinline__ void gemm_phase(PG8_LAS unsigned char* lds, const Gemm g, const Sched& S, const Epi& E) {
    const int tid = threadIdx.x, wid = __builtin_amdgcn_readfirstlane(tid >> 6), lane = tid & 63, wr = wid >> 2, wc = wid & 3, fr = lane & 15, fq = lane >> 4;
    const int K = g.K, nt = K / BK;
    unsigned voffA[2], voffB[2];
#pragma unroll
    for (int i = 0; i < 2; ++i) { int R, C; stage_rc(tid * 16 + i * 8192, R, C); const int Rb = Epi::PERM ? ((R & ~31) + perm32(R & 31)) : R;
        voffA[i] = (unsigned)(R * g.lda + C) * 2u; voffB[i] = (unsigned)(Rb * g.ldb + C) * 2u; }
    const size_t kstep = (size_t)(BK * 2);
    const size_t hstepA = (size_t)HALF * g.lda * 2, hstepB = (size_t)HALF * g.ldb * 2;
    const size_t tstepA = 2 * hstepA, tstepB = 2 * hstepB;
    const unsigned ldsw = (unsigned)wid * 1024u;
    const int aoff = lds_byte(wr * 64 + fr, fq * 8), boff = lds_byte(wc * 32 + fr, fq * 8);
#define PG8_SA(b, h) (((b) * 2 + (h)) * HTB)
#define PG8_SB(b, h) ((4 + (b) * 2 + (h)) * HTB)
#define PG8_STAGE(bufoff, gbase, voff) do { _Pragma("unroll") for (int _i = 0; _i < 2; ++_i) \
        __builtin_amdgcn_global_load_lds((const unsigned*)((const char*)(gbase) + (voff)[_i]), (PG8_LAS unsigned*)(lds + (bufoff) + ldsw + _i * 8192), 16, 0, 0); } while (0)
#define PG8_LDA(dst, b, h) do { _Pragma("unroll") for (int m = 0; m < 4; ++m) _Pragma("unroll") for (int k = 0; k < 2; ++k) dst[m][k] = *(const PG8_LAS bf16x8*)(lds + PG8_SA(b, h) + aoff + m * 2048 + k * 1024); } while (0)
#define PG8_LDB(dst, b, h) do { _Pragma("unroll") for (int n = 0; n < 2; ++n) _Pragma("unroll") for (int k = 0; k < 2; ++k) dst[n][k] = *(const PG8_LAS bf16x8*)(lds + PG8_SB(b, h) + boff + n * 2048 + k * 1024); } while (0)
#define PG8_MMA(ai, bj, At, Bt) do { __builtin_amdgcn_s_setprio(1); _Pragma("unroll") for (int m = 0; m < 4; ++m) _Pragma("unroll") for (int n = 0; n < 2; ++n) _Pragma("unroll") for (int k = 0; k < 2; ++k) \
        acc[ai][bj][m][n] = __builtin_amdgcn_mfma_f32_16x16x32_bf16(Bt[n][k], At[m][k], acc[ai][bj][m][n], 0, 0, 0); __builtin_amdgcn_s_setprio(0); } while (0)
#define PG8_WAIT_V(n) asm volatile("s_waitcnt vmcnt(" #n ")" ::: "memory")
#define PG8_WAIT_L(n) asm volatile("s_waitcnt lgkmcnt(" #n ")" ::: "memory")
#define PG8_BAR __builtin_amdgcn_s_barrier()
#define PG8_SCHED __builtin_amdgcn_sched_barrier(0)
    Unit cur, nxt; int ui = 0;
    if (!S.next(0, cur)) return;
    f32x4 acc[2][2][4][2];
#pragma unroll
    for (int a = 0; a < 2; ++a)
#pragma unroll
        for (int b = 0; b < 2; ++b)
#pragma unroll
            for (int m = 0; m < 4; ++m)
#pragma unroll
                for (int n = 0; n < 2; ++n) acc[a][b][m][n] = (f32x4){0.f, 0.f, 0.f, 0.f};
    bf16x8 At[4][2], B0[2][2], B1[2][2];
    const char* cA = (const char*)g.A + (size_t)cur.pm * tstepA; const char* cB = (const char*)g.Bt + (size_t)cur.pn * tstepB;
    S.a_ready(cur);
    if constexpr (SP2) {
        PG8_STAGE(PG8_SB(0, 0), cB, voffB); PG8_STAGE(PG8_SB(0, 1), cB + hstepB, voffB); PG8_STAGE(PG8_SA(0, 0), cA, voffA); PG8_STAGE(PG8_SA(0, 1), cA + hstepA, voffA);
        if (wr == 1) PG8_BAR;
        PG8_WAIT_V(2); PG8_BAR;
        PG8_STAGE(PG8_SB(1, 0), cB + kstep, voffB); PG8_STAGE(PG8_SA(1, 0), cA + kstep, voffA); PG8_STAGE(PG8_SB(1, 1), cB + hstepB + kstep, voffB);
        PG8_WAIT_V(6); PG8_BAR;
    } else {
        PG8_STAGE(PG8_SB(0, 0), cB, voffB); PG8_STAGE(PG8_SA(0, 0), cA, voffA); PG8_STAGE(PG8_SB(0, 1), cB + hstepB, voffB); PG8_STAGE(PG8_SA(0, 1), cA + hstepA, voffA);
        if (wr == 1) PG8_BAR;
        PG8_WAIT_V(4); PG8_BAR;
        PG8_STAGE(PG8_SB(1, 0), cB + kstep, voffB); PG8_STAGE(PG8_SA(1, 0), cA + kstep, voffA); PG8_STAGE(PG8_SB(1, 1), cB + hstepB + kstep, voffB);
        PG8_WAIT_V(6); PG8_BAR;
    }
    for (;;) {
        const bool has_next = S.next(ui + 1, nxt);
        const char* nA = has_next ? (const char*)g.A + (size_t)nxt.pm * tstepA : cA; const char* nB = has_next ? (const char*)g.Bt + (size_t)nxt.pn * tstepB : cB;
        for (int t = 0; t < nt; t += 2) {
            const bool last = (t == nt - 2);
            const char* a1 = cA + (size_t)(t + 1) * kstep;
            const char* a2 = last ? nA : cA + (size_t)(t + 2) * kstep; const char* b2 = last ? nB : cB + (size_t)(t + 2) * kstep;
            const char* a3 = a2 + kstep; const char* b3 = b2 + kstep;
            if (last && has_next) S.a_ready(nxt);
            if constexpr (SP2) {
            PG8_LDB(B0, 0, 0); PG8_LDB(B1, 0, 1); PG8_SCHED; PG8_LDA(At, 0, 0); PG8_STAGE(PG8_SA(1, 1), a1 + hstepA, voffA);
            PG8_WAIT_V(8); PG8_WAIT_L(0); PG8_BAR; PG8_MMA(0, 0, At, B0); PG8_MMA(0, 1, At, B1); PG8_BAR; PG8_SCHED;
            PG8_LDA(At, 0, 1); PG8_STAGE(PG8_SB(0, 0), b2, voffB); PG8_STAGE(PG8_SB(0, 1), b2 + hstepB, voffB); PG8_STAGE(PG8_SA(0, 0), a2, voffA);
            PG8_WAIT_V(8); PG8_WAIT_L(0); PG8_BAR; PG8_MMA(1, 0, At, B0); PG8_MMA(1, 1, At, B1); PG8_BAR; PG8_SCHED;
            PG8_LDB(B0, 1, 0); PG8_LDB(B1, 1, 1); PG8_SCHED; PG8_LDA(At, 1, 0); PG8_STAGE(PG8_SA(0, 1), a2 + hstepA, voffA);
            PG8_WAIT_V(8); PG8_WAIT_L(0); PG8_BAR; PG8_MMA(0, 0, At, B0); PG8_MMA(0, 1, At, B1); PG8_BAR; PG8_SCHED;
            PG8_LDA(At, 1, 1); PG8_STAGE(PG8_SB(1, 0), b3, voffB); PG8_STAGE(PG8_SB(1, 1), b3 + hstepB, voffB); PG8_STAGE(PG8_SA(1, 0), a3, voffA);
            PG8_WAIT_V(8); PG8_WAIT_L(0); PG8_BAR; PG8_MMA(1, 0, At, B0); PG8_MMA(1, 1, At, B1); PG8_BAR; PG8_SCHED;
            } else {
            PG8_LDB(B0, 0, 0); PG8_SCHED; PG8_LDA(At, 0, 0); PG8_STAGE(PG8_SA(1, 1), a1 + hstepA, voffA);
            PG8_WAIT_L(8); PG8_BAR; PG8_WAIT_L(0); PG8_MMA(0, 0, At, B0); PG8_BAR; PG8_SCHED;
            PG8_LDB(B1, 0, 1); PG8_STAGE(PG8_SB(0, 0), b2, voffB);
            PG8_BAR; PG8_WAIT_L(0); PG8_MMA(0, 1, At, B1); PG8_BAR;
            PG8_LDA(At, 0, 1); PG8_STAGE(PG8_SA(0, 0), a2, voffA);
            PG8_BAR; PG8_WAIT_L(0); PG8_MMA(1, 0, At, B0); PG8_BAR; PG8_SCHED;
            PG8_STAGE(PG8_SB(0, 1), b2 + hstepB, voffB);
            PG8_WAIT_V(6); PG8_BAR; PG8_MMA(1, 1, At, B1); PG8_BAR;
            PG8_LDB(B0, 1, 0); PG8_SCHED; PG8_LDA(At, 1, 0); PG8_STAGE(PG8_SA(0, 1), a2 + hstepA, voffA);
            PG8_WAIT_L(8); PG8_BAR; PG8_WAIT_L(0); PG8_MMA(0, 0, At, B0); PG8_BAR; PG8_SCHED;
            PG8_LDB(B1, 1, 1); PG8_STAGE(PG8_SB(1, 0), b3, voffB);
            PG8_BAR; PG8_WAIT_L(0); PG8_MMA(0, 1, At, B1); PG8_BAR;
            PG8_LDA(At, 1, 1); PG8_STAGE(PG8_SA(1, 0), a3, voffA);
            PG8_BAR; PG8_WAIT_L(0); PG8_MMA(1, 0, At, B0); PG8_BAR; PG8_SCHED;
            PG8_STAGE(PG8_SB(1, 1), b3 + hstepB, voffB);
            PG8_WAIT_V(6); PG8_BAR; PG8_MMA(1, 1, At, B1); PG8_BAR;
            }
        }
        if constexpr (ALIGN_EPI) { if (wr == 0) PG8_BAR; }
        if constexpr (!Epi::AFTER_DRAIN) { E(acc, cur, wr, wc, fr, fq); S.done(cur); }
        if (!has_next) break;
#pragma unroll
        for (int a = 0; a < 2; ++a)
#pragma unroll
            for (int b = 0; b < 2; ++b)
#pragma unroll
                for (int m = 0; m < 4; ++m)
#pragma unroll
                    for (int n = 0; n < 2; ++n) acc[a][b][m][n] = (f32x4){0.f, 0.f, 0.f, 0.f};
        cur = nxt; cA = nA; cB = nB; ++ui;
        if constexpr (ALIGN_EPI) { if (wr == 1) PG8_BAR; }
    }
    PG8_WAIT_V(0);
    if constexpr (!ALIGN_EPI) { if (wr == 0) PG8_BAR; }
    PG8_BAR;
    if constexpr (Epi::AFTER_DRAIN) { E.fused(acc, cur, wr, wc, fr, fq, lds, wid, lane); S.done(cur); }
#undef PG8_SA
#undef PG8_SB
#undef PG8_STAGE
#undef PG8_LDA
#undef PG8_LDB
#undef PG8_MMA
#undef PG8_WAIT_V
#undef PG8_WAIT_L
#undef PG8_BAR
#undef PG8_SCHED
}
}


#define LAS __attribute__((address_space(3)))
__device__ __forceinline__ unsigned pk2(float lo, float hi) { return f2bf(lo) | (f2bf(hi) << 16); }
template <class CM>
__device__ __forceinline__ void transpose_item(const float* __restrict__ Wsrc, int K, int ldsrc, bf16_t* __restrict__ WT, int nblk, LAS float* scr, int item, int lane, CM colmap) {
    const int kb = item / nblk, nb = item % nblk, k0 = 64 * kb, n0 = 32 * nb;
    const int sc = colmap(n0 + (lane & 31));
#pragma unroll 8
    for (int i = 0; i < 32; ++i) { const int kk = 2 * i + (lane >> 5); scr[kk * 33 + (lane & 31)] = sc >= 0 ? Wsrc[(size_t)(k0 + kk) * ldsrc + sc] : 0.f; }
    asm volatile("s_waitcnt lgkmcnt(0)" ::: "memory");
    const int c = lane & 7;
#pragma unroll
    for (int j = 0; j < 4; ++j) { const int n = (lane >> 3) + 8 * j; const LAS float* s = scr + (8 * c) * 33 + n;
        uint4 o; o.x = pk2(s[0 * 33], s[1 * 33]); o.y = pk2(s[2 * 33], s[3 * 33]); o.z = pk2(s[4 * 33], s[5 * 33]); o.w = pk2(s[6 * 33], s[7 * 33]);
        *(uint4*)(WT + (size_t)(n0 + n) * K + k0 + 8 * c) = o; }
    asm volatile("s_waitcnt lgkmcnt(0)" ::: "memory");
}
constexpr size_t WO_IN = 0;
constexpr size_t WO_BR = WO_IN + (size_t)7168 * 1024;
constexpr size_t WO_OUT = WO_BR + (size_t)4 * 1024 * 256;
constexpr size_t WO_W1 = WO_OUT + (size_t)1024 * 1024;
constexpr size_t WO_W2 = WO_W1 + (size_t)4096 * 1024;
constexpr size_t WO_WUP = WO_W2 + (size_t)4096 * 1024;
constexpr size_t WO_AUP = WO_WUP + 256 * 64;
constexpr size_t WO_GUP = WO_AUP + 256 * 64;
constexpr size_t WO_GLU = WO_GUP + 256 * 128;
constexpr size_t WO_LWT = WO_GLU + 256 * 256;
constexpr size_t WO_LAYER = WO_LWT + 2 * 16384;
__device__ __forceinline__ void convert_weights(const Params& p, int l, LAS float* scr, int gw, int ngw, int lane) {
    bf16_t* WB = (bf16_t*)(p.ws + WS_W);
    constexpr int I_IN = (1024 / 64) * (7168 / 32), I_BR = (256 / 64) * (1024 / 32), I_OUT = (1024 / 64) * (1024 / 32), I_W1 = (1024 / 64) * (4096 / 32), I_W2 = (4096 / 64) * (1024 / 32);
    constexpr int I_UP = 8, I_GUP = 16, I_GLU = 4 * 8, I_LW = 16;
    constexpr int PER_LAYER = I_IN + 4 * I_BR + I_OUT + I_W1 + I_W2 + 2 * I_UP + I_GUP + I_GLU + I_LW;
    for (int it = gw; it < PER_LAYER; it += ngw) {
        int r = it;
        bf16_t* WL = WB;
        if (r < I_IN) { transpose_item(p.in[2] + (size_t)l * D * DIN, 1024, DIN, WL + WO_IN, 7168 / 32, scr, r, lane, [](int j) { return j < NMIX ? j : (j < 3072 ? -1 : j - 248); }); continue; } r -= I_IN;
        if (r < 4 * I_BR) { const int i = r / I_BR; transpose_item(p.in[35] + ((size_t)l * 4 + i) * W * D, 256, D, WL + WO_BR + (size_t)i * 1024 * 256, 1024 / 32, scr, r % I_BR, lane, [](int j) { return j; }); continue; } r -= 4 * I_BR;
        if (r < I_OUT) { transpose_item(p.in[36] + (size_t)l * D * D, 1024, D, WL + WO_OUT, 1024 / 32, scr, r, lane, [](int j) { return j; }); continue; } r -= I_OUT;
        if (r < I_W1) { transpose_item(p.in[38] + (size_t)l * D * DFF, 1024, DFF, WL + WO_W1, 4096 / 32, scr, r, lane, [](int j) { return j; }); continue; } r -= I_W1;
        if (r < I_W2) { transpose_item(p.in[39] + (size_t)l * DFF * D, 4096, D, WL + WO_W2, 1024 / 32, scr, r, lane, [](int j) { return j; }); continue; } r -= I_W2;
        if (r < I_UP) { transpose_item(p.in[26] + (size_t)l * 64 * W, 64, W, WL + WO_WUP, 8, scr, r, lane, [](int j) { return j; }); continue; } r -= I_UP;
        if (r < I_UP) { transpose_item(p.in[28] + (size_t)l * 64 * W, 64, W, WL + WO_AUP, 8, scr, r, lane, [](int j) { return j; }); continue; } r -= I_UP;
        if (r < I_GUP) { transpose_item(p.in[29] + (size_t)l * 128 * W, 128, W, WL + WO_GUP, 8, scr, r, lane, [](int j) { return j; }); continue; } r -= I_GUP;
        if (r < I_GLU) { transpose_item(p.in[22] + (size_t)l * W * W, 256, W, WL + WO_GLU, 8, scr, r, lane, [](int j) { return j; }); continue; } r -= I_GLU;
        { const int gt = r >> 3, nb = (r >> 1) & 3; transpose_item((gt ? p.in[11] : p.in[9]) + (size_t)l * 16384 + nb * 4096, 64, 64, WL + WO_LWT + (size_t)gt * 16384 + nb * 4096, 2, scr, r & 1, lane, [](int j) { return j; }); }
    }
}
typedef short bf16x8_t __attribute__((ext_vector_type(8)));
typedef float f32x4_t __attribute__((ext_vector_type(4)));
constexpr int PT = 68;
constexpr int MS = 64 * PT;
__device__ __forceinline__ unsigned cvtpk(float lo, float hi) { unsigned r; asm volatile("v_cvt_pk_bf16_f32 %0, %1, %2" : "=v"(r) : "v"(lo), "v"(hi)); return r; }
typedef unsigned u32x4_t __attribute__((ext_vector_type(4)));
union U8 { bf16x8_t v; unsigned u[4]; uint4 q; u32x4_t x; };
__device__ __forceinline__ void split8(const float (&x)[8], bf16x8_t& hi, bf16x8_t& lo) {
    U8 H, L;
#pragma unroll
    for (int i = 0; i < 4; ++i) {
        const unsigned pk = cvtpk(x[2 * i], x[2 * i + 1]);
        H.u[i] = pk;
        const float f0 = __uint_as_float(pk << 16), f1 = __uint_as_float(pk & 0xffff0000u);
        L.u[i] = cvtpk(x[2 * i] - f0, x[2 * i + 1] - f1);
    }
    hi = H.v; lo = L.v;
}
__device__ __forceinline__ bf16x8_t hi8(const float (&x)[8]) {
    U8 H;
#pragma unroll
    for (int i = 0; i < 4; ++i) H.u[i] = cvtpk(x[2 * i], x[2 * i + 1]);
    return H.v;
}
template <int NSPLIT>
__device__ __forceinline__ f32x4_t mm_tile(const LAS float* A, const LAS float* Bt, int lane, f32x4_t acc) {
    const LAS float* ap = A + (lane & 15) * PT + 8 * (lane >> 4);
    const LAS float* bp = Bt + (lane & 15) * PT + 8 * (lane >> 4);
#pragma unroll
    for (int ks = 0; ks < 2; ++ks) {
        const f32x4_t a0 = *(const LAS f32x4_t*)(ap + 32 * ks), a1 = *(const LAS f32x4_t*)(ap + 32 * ks + 4);
        const f32x4_t b0 = *(const LAS f32x4_t*)(bp + 32 * ks), b1 = *(const LAS f32x4_t*)(bp + 32 * ks + 4);
        const float av[8] = {a0.x, a0.y, a0.z, a0.w, a1.x, a1.y, a1.z, a1.w};
        const float bv[8] = {b0.x, b0.y, b0.z, b0.w, b1.x, b1.y, b1.z, b1.w};
        if constexpr (NSPLIT == 3) {
            bf16x8_t ah, al, bh, bl; split8(av, ah, al); split8(bv, bh, bl);
            acc = __builtin_amdgcn_mfma_f32_16x16x32_bf16(ah, bh, acc, 0, 0, 0);
            acc = __builtin_amdgcn_mfma_f32_16x16x32_bf16(ah, bl, acc, 0, 0, 0);
            acc = __builtin_amdgcn_mfma_f32_16x16x32_bf16(al, bh, acc, 0, 0, 0);
        } else {
            acc = __builtin_amdgcn_mfma_f32_16x16x32_bf16(hi8(av), hi8(bv), acc, 0, 0, 0);
        }
    }
    return acc;
}
__device__ __forceinline__ int opq_tid() { int t = threadIdx.x; asm volatile("" : "+v"(t)); return t; }
__device__ __forceinline__ void tri_inverse_wave(LAS float* L, int lane) {
    asm volatile("" : "+v"(lane));
    const float lf = (float)lane;
    float x[64];
#pragma unroll
    for (int i = 0; i < 64; ++i) {
        float s0 = 0.f, s1 = 0.f, s2 = 0.f, s3 = 0.f;
#pragma unroll
        for (int g4 = 0; g4 * 4 < i; ++g4) {
            const f32x4_t l = *(const LAS f32x4_t*)(L + i * PT + 4 * g4);
            s0 = fmaf(l.x, x[4 * g4], s0);
            if (4 * g4 + 1 < i) s1 = fmaf(l.y, x[4 * g4 + 1], s1);
            if (4 * g4 + 2 < i) s2 = fmaf(l.z, x[4 * g4 + 2], s2);
            if (4 * g4 + 3 < i) s3 = fmaf(l.w, x[4 * g4 + 3], s3);
        }
        x[i] = fmaxf(1.f - fabsf(lf - (float)i), 0.f) - ((s0 + s1) + (s2 + s3));
        L[i * PT + lane] = x[i];
        if ((i & 3) == 3) __builtin_amdgcn_sched_barrier(0);
    }
}
__device__ __forceinline__ float wave_incl_scan(float v, int lane) {
#pragma unroll
    for (int o = 1; o < 64; o <<= 1) { const float u = __shfl_up(v, o); if (lane >= o) v += u; }
    return v;
}

struct GdnBufs { bf16_t *GQ, *GK, *GV; float *GB, *GC; uint4* MF; float* NF; float* HT; };
__device__ __forceinline__ void gdn_prep_chunk(const bf16_t* __restrict__ PM, int n, const GdnBufs& B, const Params& p, int l, LAS float* lds) {
    const int tid = opq_tid(), w = tid >> 6, lane = tid & 63;
    const float* conv_w = p.in[3] + l * 4 * 768;
    const int t0 = n * 64;
    float wq[4][4], wk[4][4], wv[4][4];
#pragma unroll
    for (int t = 0; t < 4; ++t)
#pragma unroll
        for (int j = 0; j < 4; ++j) { wq[t][j] = conv_w[t * 768 + 4 * lane + j]; wk[t][j] = conv_w[t * 768 + 256 + 4 * lane + j]; wv[t][j] = conv_w[t * 768 + 512 + 4 * lane + j]; }
    float hq[3][4], hk[3][4], hv[3][4];
    auto ld4 = [&](int t, int col, float (&o)[4]) {
        if (t < 0) { o[0] = o[1] = o[2] = o[3] = 0.f; return; }
        const uint2 u = *(const uint2*)(PM + (size_t)t * PMLD + col);
        o[0] = __uint_as_float(u.x << 16); o[1] = __uint_as_float(u.x & 0xffff0000u); o[2] = __uint_as_float(u.y << 16); o[3] = __uint_as_float(u.y & 0xffff0000u);
    };
    const int tw = t0 + 8 * w;
#pragma unroll
    for (int i = 0; i < 3; ++i) { ld4(tw - 3 + i, 4 * lane, hq[i]); ld4(tw - 3 + i, 256 + 4 * lane, hk[i]); ld4(tw - 3 + i, 512 + 4 * lane, hv[i]); }
    for (int i = 0; i < 8; ++i) {
        const int t = tw + i;
        float pq[4], pk[4], pv[4], q[4], k[4], v[4];
        ld4(t, 4 * lane, pq); ld4(t, 256 + 4 * lane, pk); ld4(t, 512 + 4 * lane, pv);
        float sq = 0.f, sk = 0.f;
#pragma unroll
        for (int j = 0; j < 4; ++j) {
            q[j] = siluf_(wq[0][j] * hq[0][j] + wq[1][j] * hq[1][j] + wq[2][j] * hq[2][j] + wq[3][j] * pq[j]);
            k[j] = siluf_(wk[0][j] * hk[0][j] + wk[1][j] * hk[1][j] + wk[2][j] * hk[2][j] + wk[3][j] * pk[j]);
            v[j] = siluf_(wv[0][j] * hv[0][j] + wv[1][j] * hv[1][j] + wv[2][j] * hv[2][j] + wv[3][j] * pv[j]);
            hq[0][j] = hq[1][j]; hq[1][j] = hq[2][j]; hq[2][j] = pq[j];
            hk[0][j] = hk[1][j]; hk[1][j] = hk[2][j]; hk[2][j] = pk[j];
            hv[0][j] = hv[1][j]; hv[1][j] = hv[2][j]; hv[2][j] = pv[j];
            sq = fmaf(q[j], q[j], sq); sk = fmaf(k[j], k[j], sk);
        }
#pragma unroll
        for (int o = 1; o < 16; o <<= 1) { sq += __shfl_xor(sq, o); sk += __shfl_xor(sk, o); }
        const float rq = rsqrtf(sq + 1e-6f) * 0.125f, rk = rsqrtf(sk + 1e-6f);
        uint2 oq, ok, ov;
        oq.x = cvtpk(q[0] * rq, q[1] * rq); oq.y = cvtpk(q[2] * rq, q[3] * rq);
        ok.x = cvtpk(k[0] * rk, k[1] * rk); ok.y = cvtpk(k[2] * rk, k[3] * rk);
        ov.x = cvtpk(v[0], v[1]); ov.y = cvtpk(v[2], v[3]);
        *(uint2*)(B.GQ + (size_t)t * 256 + 4 * lane) = oq;
        *(uint2*)(B.GK + (size_t)t * 256 + 4 * lane) = ok;
        *(uint2*)(B.GV + (size_t)t * 256 + 4 * lane) = ov;
    }
    if (tid < 256) {
        const int t = tid >> 2, h = tid & 3;
        const bf16_t* row = PM + (size_t)(t0 + t) * PMLD;
        B.GB[(size_t)(t0 + t) * 4 + h] = sigmoidf_(bf2f(row[1024 + h]));
        const float g = -expf(p.in[4][l * 4 + h]) * softplusf_(bf2f(row[1028 + h]) + p.in[5][l * 4 + h]);
        lds[h * 64 + t] = g;
    }
    __syncthreads();
    if (w == 0) {
#pragma unroll
        for (int h = 0; h < 4; ++h) B.GC[(size_t)(t0 + lane) * 4 + h] = wave_incl_scan(lds[h * 64 + lane], lane);
    }
    __syncthreads();
}

__device__ __forceinline__ void gdn_g1_unit(int h, int n, const GdnBufs& B, LAS float* lds) {
    const int tid = opq_tid(), w = tid >> 6, lane = tid & 63, q4 = lane >> 4, cc = lane & 15;
    LAS float* Kr = lds; LAS float* KdT = lds + MS; LAS float* KbT = lds + 2 * MS; LAS float* VbT = lds + 3 * MS; LAS float* Lm = lds + 4 * MS; LAS float* WmT = lds + 5 * MS;
    LAS float* U0T = Kr;
    LAS float* sb = lds + 6 * MS; LAS float* sg = sb + 64;
    const int t0 = n * 64, u = h * 256 + n;
    {
        const int c = tid >> 3, d0 = (tid & 7) * 8;
        const float beta = B.GB[(size_t)(t0 + c) * 4 + h], gc = B.GC[(size_t)(t0 + c) * 4 + h], gl = B.GC[(size_t)(t0 + 63) * 4 + h];
        const uint4 k8 = *(const uint4*)(B.GK + (size_t)(t0 + c) * 256 + h * 64 + d0);
        const uint4 v8 = *(const uint4*)(B.GV + (size_t)(t0 + c) * 256 + h * 64 + d0);
        const float e1 = expf(gl - gc), e2 = beta * expf(gc);
        const unsigned ku[4] = {k8.x, k8.y, k8.z, k8.w}, vu[4] = {v8.x, v8.y, v8.z, v8.w};
#pragma unroll
        for (int i = 0; i < 8; ++i) {
            const float kf = __uint_as_float((i & 1) ? (ku[i >> 1] & 0xffff0000u) : (ku[i >> 1] << 16));
            const float vf = __uint_as_float((i & 1) ? (vu[i >> 1] & 0xffff0000u) : (vu[i >> 1] << 16));
            Kr[c * PT + d0 + i] = kf; KdT[(d0 + i) * PT + c] = kf * e1; KbT[(d0 + i) * PT + c] = kf * e2; VbT[(d0 + i) * PT + c] = beta * vf;
        }
        if ((tid & 7) == 0) { sb[c] = beta; sg[c] = gc; }
    }
    __syncthreads();
    const int ti = w >> 1, tj0 = (w & 1) * 2;
    const f32x4_t zero4 = {0.f, 0.f, 0.f, 0.f};
#pragma unroll
    for (int tt = 0; tt < 2; ++tt) {
        const int tj = tj0 + tt;
        if (tj <= ti) {
            const f32x4_t a = mm_tile<3>(Kr + 16 * ti * PT, Kr + 16 * tj * PT, lane, zero4);
            const int j = 16 * tj + cc; const float gj = sg[j];
#pragma unroll
            for (int r = 0; r < 4; ++r) { const int i = 16 * ti + 4 * q4 + r; Lm[i * PT + j] = (i > j) ? sb[i] * a[r] * expf(sg[i] - gj) : 0.f; }
        }
    }
    __syncthreads();
    if (w == 0) tri_inverse_wave(Lm, lane);
    __syncthreads();
#pragma unroll
    for (int tt = 0; tt < 2; ++tt) {
        const int tj = tj0 + tt;
        const f32x4_t a = mm_tile<3>(Lm + 16 * ti * PT, VbT + 16 * tj * PT, lane, zero4);
        *(LAS f32x4_t*)(U0T + (16 * tj + cc) * PT + 16 * ti + 4 * q4) = (f32x4_t){a[0], a[1], a[2], a[3]};
        const f32x4_t b = mm_tile<3>(Lm + 16 * ti * PT, KbT + 16 * tj * PT, lane, zero4);
        *(LAS f32x4_t*)(WmT + (16 * tj + cc) * PT + 16 * ti + 4 * q4) = (f32x4_t){b[0], b[1], b[2], b[3]};
    }
    __syncthreads();
    {
        const float egl = expf(B.GC[(size_t)(t0 + 63) * 4 + h]);
#pragma unroll
        for (int tt = 0; tt < 2; ++tt) {
            const int tj = tj0 + tt;
            const f32x4_t a = mm_tile<3>(KdT + 16 * ti * PT, WmT + 16 * tj * PT, lane, zero4);
#pragma unroll
            for (int r = 0; r < 4; ++r) { const int ar = 16 * ti + 4 * q4 + r, bc = 16 * tj + cc; Lm[ar * PT + bc] = (ar == bc ? egl : 0.f) - a[r]; }
            const f32x4_t nn = mm_tile<3>(KdT + 16 * ti * PT, U0T + 16 * tj * PT, lane, zero4);
            *(float4*)(B.NF + (size_t)u * 4096 + (tj * 64 + lane) * 16 + ti * 4) = make_float4(nn[0], nn[1], nn[2], nn[3]);
        }
    }
    __syncthreads();
    {
        const int combo = tid >> 6, mt = combo >> 1, s = combo & 1, i = lane & 15, qq = lane >> 4;
        const f32x4_t x0 = *(const LAS f32x4_t*)(Lm + (16 * mt + i) * PT + 32 * s + 4 * qq);
        const f32x4_t x1 = *(const LAS f32x4_t*)(Lm + (16 * mt + i) * PT + 32 * s + 16 + 4 * qq);
        const float xv[8] = {x0.x, x0.y, x0.z, x0.w, x1.x, x1.y, x1.z, x1.w};
        U8 H, L; split8(xv, H.v, L.v);
        uint4* mf = B.MF + (size_t)u * 1024 + (size_t)(combo * 2) * 64 + lane;
        mf[0] = H.q; mf[64] = L.q;
    }
    __syncthreads();
}

__device__ __forceinline__ void chain_wave(const uint4* __restrict__ MF, const float* __restrict__ NF, float* __restrict__ HT, int cb, int nchunk, int lane) {
    const int q4 = lane >> 4, cc = lane & 15;
    f32x4_t H[4];
#pragma unroll
    for (int m = 0; m < 4; ++m) H[m] = (f32x4_t){0.f, 0.f, 0.f, 0.f};
    uint4 mcur[16]; float4 ncur[4];
#pragma unroll
    for (int i = 0; i < 16; ++i) mcur[i] = MF[(size_t)i * 64 + lane];
#pragma unroll
    for (int m = 0; m < 4; ++m) ncur[m] = *(const float4*)(NF + (cb * 64 + lane) * 16 + m * 4);
    for (int ch = 0; ch < nchunk; ++ch) {
        uint4 mnx[16]; float4 nnx[4];
        const int chn = ch + 1 < nchunk ? ch + 1 : ch;
#pragma unroll
        for (int i = 0; i < 16; ++i) mnx[i] = MF[(size_t)chn * 1024 + (size_t)i * 64 + lane];
#pragma unroll
        for (int m = 0; m < 4; ++m) nnx[m] = *(const float4*)(NF + (size_t)chn * 4096 + (cb * 64 + lane) * 16 + m * 4);
        float* ht = HT + (size_t)ch * 4096 + (16 * cb + cc) * 64 + 4 * q4;
#pragma unroll
        for (int m = 0; m < 4; ++m) *(float4*)(ht + 16 * m) = make_float4(H[m][0], H[m][1], H[m][2], H[m][3]);
        bf16x8_t bh[2], bl[2];
#pragma unroll
        for (int s = 0; s < 2; ++s) {
            const float xv[8] = {H[2 * s][0], H[2 * s][1], H[2 * s][2], H[2 * s][3], H[2 * s + 1][0], H[2 * s + 1][1], H[2 * s + 1][2], H[2 * s + 1][3]};
            split8(xv, bh[s], bl[s]);
        }
#pragma unroll
        for (int m = 0; m < 4; ++m) {
            f32x4_t acc = {ncur[m].x, ncur[m].y, ncur[m].z, ncur[m].w};
#pragma unroll
            for (int s = 0; s < 2; ++s) {
                U8 ah, al; ah.q = mcur[(m * 2 + s) * 2]; al.q = mcur[(m * 2 + s) * 2 + 1];
                acc = __builtin_amdgcn_mfma_f32_16x16x32_bf16(ah.v, bh[s], acc, 0, 0, 0);
                acc = __builtin_amdgcn_mfma_f32_16x16x32_bf16(ah.v, bl[s], acc, 0, 0, 0);
                acc = __builtin_amdgcn_mfma_f32_16x16x32_bf16(al.v, bh[s], acc, 0, 0, 0);
            }
            H[m] = acc;
        }
#pragma unroll
        for (int i = 0; i < 16; ++i) mcur[i] = mnx[i];
#pragma unroll
        for (int m = 0; m < 4; ++m) ncur[m] = nnx[m];
    }
}

__device__ __forceinline__ void gdn_g3_unit(int h, int n, const GdnBufs& B, const bf16_t* __restrict__ PM, bf16_t* __restrict__ Y, const float* __restrict__ norm_g, LAS float* lds) {
    const int tid = opq_tid(), w = tid >> 6, lane = tid & 63, q4 = lane >> 4, cc = lane & 15;
    LAS float* Qr = lds; LAS float* Kr = lds + MS; LAS float* KbT = lds + 2 * MS; LAS float* VbT = lds + 3 * MS; LAS float* Lm = lds + 4 * MS; LAS float* At = lds + 5 * MS;
    LAS float* Wm = Kr; LAS float* Hs = KbT; LAS float* VnT = VbT; LAS float* Os = Lm;
    LAS float* sb = lds + 6 * MS; LAS float* sg = sb + 64;
    const int t0 = n * 64, u = h * 256 + n;
    const int c = tid >> 3, d0 = (tid & 7) * 8;
    {
        const float beta = B.GB[(size_t)(t0 + c) * 4 + h], gc = B.GC[(size_t)(t0 + c) * 4 + h];
        const uint4 q8 = *(const uint4*)(B.GQ + (size_t)(t0 + c) * 256 + h * 64 + d0);
        const uint4 k8 = *(const uint4*)(B.GK + (size_t)(t0 + c) * 256 + h * 64 + d0);
        const uint4 v8 = *(const uint4*)(B.GV + (size_t)(t0 + c) * 256 + h * 64 + d0);
        const float e2 = beta * expf(gc);
        const unsigned qu[4] = {q8.x, q8.y, q8.z, q8.w}, ku[4] = {k8.x, k8.y, k8.z, k8.w}, vu[4] = {v8.x, v8.y, v8.z, v8.w};
#pragma unroll
        for (int i = 0; i < 8; ++i) {
            const float qf = __uint_as_float((i & 1) ? (qu[i >> 1] & 0xffff0000u) : (qu[i >> 1] << 16));
            const float kf = __uint_as_float((i & 1) ? (ku[i >> 1] & 0xffff0000u) : (ku[i >> 1] << 16));
            const float vf = __uint_as_float((i & 1) ? (vu[i >> 1] & 0xffff0000u) : (vu[i >> 1] << 16));
            Qr[c * PT + d0 + i] = qf; Kr[c * PT + d0 + i] = kf; KbT[(d0 + i) * PT + c] = kf * e2; VbT[(d0 + i) * PT + c] = beta * vf;
        }
        if ((tid & 7) == 0) { sb[c] = beta; sg[c] = gc; }
    }
    __syncthreads();
    const int ti = w >> 1, tj0 = (w & 1) * 2;
    const f32x4_t zero4 = {0.f, 0.f, 0.f, 0.f};
#pragma unroll
    for (int tt = 0; tt < 2; ++tt) {
        const int tj = tj0 + tt;
        if (tj <= ti) {
            const f32x4_t a = mm_tile<3>(Kr + 16 * ti * PT, Kr + 16 * tj * PT, lane, zero4);
            const f32x4_t s = mm_tile<1>(Qr + 16 * ti * PT, Kr + 16 * tj * PT, lane, zero4);
            const int j = 16 * tj + cc; const float gj = sg[j];
#pragma unroll
            for (int r = 0; r < 4; ++r) { const int i = 16 * ti + 4 * q4 + r; const float dec = expf(fminf(sg[i] - gj, 0.f));
                Lm[i * PT + j] = (i > j) ? sb[i] * a[r] * dec : 0.f; At[i * PT + j] = (i >= j) ? s[r] * dec : 0.f; }
        } else {
            const int j = 16 * tj + cc;
#pragma unroll
            for (int r = 0; r < 4; ++r) { const int i = 16 * ti + 4 * q4 + r; At[i * PT + j] = 0.f; }
        }
    }
    __syncthreads();
    if (w == 0) tri_inverse_wave(Lm, lane);
    else {
        for (int e = tid - 64; e < 4096; e += 448) { const int r = e >> 6, col = e & 63; Qr[r * PT + col] *= expf(sg[r]); }
    }
    __syncthreads();
    f32x4_t u0[2];
#pragma unroll
    for (int tt = 0; tt < 2; ++tt) {
        const int tj = tj0 + tt;
        u0[tt] = mm_tile<3>(Lm + 16 * ti * PT, VbT + 16 * tj * PT, lane, zero4);
        const f32x4_t b = mm_tile<3>(Lm + 16 * ti * PT, KbT + 16 * tj * PT, lane, zero4);
#pragma unroll
        for (int r = 0; r < 4; ++r) Wm[(16 * ti + 4 * q4 + r) * PT + 16 * tj + cc] = b[r];
    }
    __syncthreads();
    {
        const float* ht = B.HT + (size_t)u * 4096;
        const float4 x0 = *(const float4*)(ht + c * 64 + d0), x1 = *(const float4*)(ht + c * 64 + d0 + 4);
        *(LAS f32x4_t*)(Hs + c * PT + d0) = (f32x4_t){x0.x, x0.y, x0.z, x0.w}; *(LAS f32x4_t*)(Hs + c * PT + d0 + 4) = (f32x4_t){x1.x, x1.y, x1.z, x1.w};
    }
    __syncthreads();
    f32x4_t o[2];
#pragma unroll
    for (int tt = 0; tt < 2; ++tt) {
        const int tj = tj0 + tt;
        const f32x4_t wh = mm_tile<3>(Wm + 16 * ti * PT, Hs + 16 * tj * PT, lane, zero4);
        o[tt] = mm_tile<3>(Qr + 16 * ti * PT, Hs + 16 * tj * PT, lane, zero4);
        u0[tt] = u0[tt] - wh;
    }
    __syncthreads();
#pragma unroll
    for (int tt = 0; tt < 2; ++tt) { const int tj = tj0 + tt; *(LAS f32x4_t*)(VnT + (16 * tj + cc) * PT + 16 * ti + 4 * q4) = (f32x4_t){u0[tt][0], u0[tt][1], u0[tt][2], u0[tt][3]}; }
    __syncthreads();
#pragma unroll
    for (int tt = 0; tt < 2; ++tt) {
        const int tj = tj0 + tt;
        o[tt] = mm_tile<3>(At + 16 * ti * PT, VnT + 16 * tj * PT, lane, o[tt]);
    }
    __syncthreads();
#pragma unroll
    for (int tt = 0; tt < 2; ++tt) { const int tj = tj0 + tt;
#pragma unroll
        for (int r = 0; r < 4; ++r) Os[(16 * ti + 4 * q4 + r) * PT + 16 * tj + cc] = o[tt][r]; }
    __syncthreads();
    {
        const f32x4_t x0 = *(const LAS f32x4_t*)(Os + c * PT + d0), x1 = *(const LAS f32x4_t*)(Os + c * PT + d0 + 4);
        float xv[8] = {x0.x, x0.y, x0.z, x0.w, x1.x, x1.y, x1.z, x1.w};
        float ss = 0.f;
#pragma unroll
        for (int i = 0; i < 8; ++i) ss = fmaf(xv[i], xv[i], ss);
        ss += __shfl_xor(ss, 1); ss += __shfl_xor(ss, 2); ss += __shfl_xor(ss, 4);
        const float rs = rsqrtf(ss * (1.f / 64.f) + 1e-6f);
        const uint4 z8 = *(const uint4*)(PM + (size_t)(t0 + c) * PMLD + 768 + h * 64 + d0);
        const unsigned zu[4] = {z8.x, z8.y, z8.z, z8.w};
        unsigned ow[4];
#pragma unroll
        for (int i = 0; i < 4; ++i) {
            const float z0 = __uint_as_float(zu[i] << 16), z1 = __uint_as_float(zu[i] & 0xffff0000u);
            ow[i] = cvtpk(xv[2 * i] * rs * norm_g[d0 + 2 * i] * siluf_(z0), xv[2 * i + 1] * rs * norm_g[d0 + 2 * i + 1] * siluf_(z1));
        }
        *(uint4*)(Y + (size_t)(t0 + c) * D + h * 64 + d0) = make_uint4(ow[0], ow[1], ow[2], ow[3]);
    }
    __syncthreads();
}

struct RwkvBufs { bf16_t *RR, *RK, *RV, *RKK, *RA, *RG; float* CW; uint4* MF; float* NF; float* HT; };
__device__ __forceinline__ void unpack8(const uint4 u, float (&o)[8]) {
    const unsigned w[4] = {u.x, u.y, u.z, u.w};
#pragma unroll
    for (int i = 0; i < 4; ++i) { o[2 * i] = __uint_as_float(w[i] << 16); o[2 * i + 1] = __uint_as_float(w[i] & 0xffff0000u); }
}
__device__ __forceinline__ uint4 pack8(const float (&x)[8]) { return make_uint4(cvtpk(x[0], x[1]), cvtpk(x[2], x[3]), cvtpk(x[4], x[5]), cvtpk(x[6], x[7])); }
typedef unsigned short LAS lds_bf16;
__device__ __forceinline__ void rwkv_prep_chunk(const bf16_t* __restrict__ PM, int n, const RwkvBufs& B, const Params& p, int l, const bf16_t* __restrict__ WUPT, const bf16_t* __restrict__ AUPT, const bf16_t* __restrict__ GUPT, LAS unsigned char* lds) {
    const int tid = opq_tid(), w = tid >> 6, lane = tid & 63, q4 = lane >> 4, cc = lane & 15;
    const int t0 = n * 64;
    const float* mu = p.in[24] + l * 1024;
    lds_bf16* Awd = (lds_bf16*)lds; lds_bf16* Aad = Awd + 64 * 72; lds_bf16* Agd = Aad + 64 * 72;
    lds_bf16* La = Agd + 64 * 136; lds_bf16* Lg = La + 64 * 264; lds_bf16* Llw = Lg + 64 * 264;
    {
        const int t = tid >> 3, c0 = (tid & 7) * 32;
        const bf16_t* row = PM + (size_t)(t0 + t) * PMLD + C_RWKV + 768 + c0;
        const bool hasprev = (t0 + t) > 0;
#pragma unroll 1
        for (int g8 = 0; g8 < 4; ++g8) {
            float x[8], xp[8];
            unpack8(*(const uint4*)(row + 8 * g8), x);
            if (hasprev) unpack8(*(const uint4*)(row - PMLD + 8 * g8), xp); else {
#pragma unroll
                for (int i = 0; i < 8; ++i) xp[i] = 0.f; }
            const int col = c0 + 8 * g8;
            float y[8];
#pragma unroll
            for (int i = 0; i < 8; ++i) {
                const float v = x[i] + mu[768 + col + i] * (xp[i] - x[i]);
                y[i] = col < 64 ? tanhf(v) : (col < 128 ? v : sigmoidf_(v));
            }
            const uint4 pk = pack8(y);
            if (col < 64) *(LAS u32x4_t*)(Awd + t * 72 + col) = (u32x4_t){pk.x, pk.y, pk.z, pk.w};
            else if (col < 128) *(LAS u32x4_t*)(Aad + t * 72 + (col - 64)) = (u32x4_t){pk.x, pk.y, pk.z, pk.w};
            else *(LAS u32x4_t*)(Agd + t * 136 + (col - 128)) = (u32x4_t){pk.x, pk.y, pk.z, pk.w};
        }
    }
    __syncthreads();
    const int hh = w >> 1, tt0 = 2 * (w & 1);
    {
        const float* w0 = p.in[25] + l * W; const float* a0 = p.in[27] + l * W;
#pragma unroll 1
        for (int b = 0; b < 4; ++b) {
            const int ncol = 64 * hh + 16 * b + cc;
            f32x4_t accw[2], acca[2], accg[2];
#pragma unroll
            for (int a = 0; a < 2; ++a) { accw[a] = (f32x4_t){0.f, 0.f, 0.f, 0.f}; acca[a] = accw[a]; accg[a] = accw[a]; }
#pragma unroll
            for (int ks = 0; ks < 4; ++ks) {
                U8 bw, ba, bg;
                bg.q = *(const uint4*)(GUPT + (size_t)ncol * 128 + 32 * ks + 8 * q4);
                if (ks < 2) { bw.q = *(const uint4*)(WUPT + (size_t)ncol * 64 + 32 * ks + 8 * q4); ba.q = *(const uint4*)(AUPT + (size_t)ncol * 64 + 32 * ks + 8 * q4); }
#pragma unroll
                for (int a = 0; a < 2; ++a) {
                    const int row = 16 * (tt0 + a) + cc;
                    U8 ag; ag.x = *(const LAS u32x4_t*)(Agd + row * 136 + 32 * ks + 8 * q4);
                    accg[a] = __builtin_amdgcn_mfma_f32_16x16x32_bf16(ag.v, bg.v, accg[a], 0, 0, 0);
                    if (ks < 2) {
                        U8 aw, aa; aw.x = *(const LAS u32x4_t*)(Awd + row * 72 + 32 * ks + 8 * q4); aa.x = *(const LAS u32x4_t*)(Aad + row * 72 + 32 * ks + 8 * q4);
                        accw[a] = __builtin_amdgcn_mfma_f32_16x16x32_bf16(aw.v, bw.v, accw[a], 0, 0, 0);
                        acca[a] = __builtin_amdgcn_mfma_f32_16x16x32_bf16(aa.v, ba.v, acca[a], 0, 0, 0);
                    }
                }
            }
            const float w0n = w0[ncol], a0n = a0[ncol];
#pragma unroll
            for (int a = 0; a < 2; ++a)
#pragma unroll
                for (int r = 0; r < 4; ++r) {
                    const int t = 16 * (tt0 + a) + 4 * q4 + r;
                    const float logw = -softplusf_(-(w0n + accw[a][r])) - 0.5f;
                    Llw[t * 264 + ncol] = (unsigned short)f2bf(-expf(logw));
                    La[t * 264 + ncol] = (unsigned short)f2bf(sigmoidf_(a0n + acca[a][r]));
                    Lg[t * 264 + ncol] = (unsigned short)f2bf(accg[a][r]);
                }
        }
    }
    __syncthreads();
    {
        const int t = tid >> 3, n0 = (tid & 7) * 32;
        const bf16_t* row = PM + (size_t)(t0 + t) * PMLD + C_RWKV;
        const bool hasprev = (t0 + t) > 0;
        const float* k_k = p.in[30] + l * W; const float* k_a = p.in[31] + l * W;
        float ss = 0.f;
#pragma unroll 1
        for (int g8 = 0; g8 < 4; ++g8) {
            const int nn = n0 + 8 * g8;
            float xr[8], xk[8], xv[8], pr[8], pk[8], pv[8], av[8];
            unpack8(*(const uint4*)(row + nn), xr); unpack8(*(const uint4*)(row + 256 + nn), xk); unpack8(*(const uint4*)(row + 512 + nn), xv);
            if (hasprev) { unpack8(*(const uint4*)(row - PMLD + nn), pr); unpack8(*(const uint4*)(row - PMLD + 256 + nn), pk); unpack8(*(const uint4*)(row - PMLD + 512 + nn), pv); }
            else {
#pragma unroll
                for (int i = 0; i < 8; ++i) { pr[i] = 0.f; pk[i] = 0.f; pv[i] = 0.f; } }
            { const u32x4_t t4 = *(const LAS u32x4_t*)(La + t * 264 + nn); unpack8(make_uint4(t4.x, t4.y, t4.z, t4.w), av); }
            float orr[8], okk[8], ovv[8];
#pragma unroll
            for (int i = 0; i < 8; ++i) {
                const float r = xr[i] + mu[nn + i] * (pr[i] - xr[i]);
                const float k = xk[i] + mu[256 + nn + i] * (pk[i] - xk[i]);
                const float v = xv[i] + mu[512 + nn + i] * (pv[i] - xv[i]);
                orr[i] = r; ovv[i] = v; okk[i] = k * (1.f + (av[i] - 1.f) * k_a[nn + i]);
                const float kr = k * k_k[nn + i]; ss = fmaf(kr, kr, ss);
            }
            const size_t o = (size_t)(t0 + t) * 256 + nn;
            *(uint4*)(B.RR + o) = pack8(orr); *(uint4*)(B.RK + o) = pack8(okk); *(uint4*)(B.RV + o) = pack8(ovv);
            { const u32x4_t t4 = *(const LAS u32x4_t*)(La + t * 264 + nn); *(uint4*)(B.RA + o) = make_uint4(t4.x, t4.y, t4.z, t4.w); }
            { const u32x4_t t4 = *(const LAS u32x4_t*)(Lg + t * 264 + nn); *(uint4*)(B.RG + o) = make_uint4(t4.x, t4.y, t4.z, t4.w); }
        }
        ss += __shfl_xor(ss, 1);
        const float rn = rsqrtf(ss + 1e-6f);
#pragma unroll 1
        for (int g8 = 0; g8 < 4; ++g8) {
            const int nn = n0 + 8 * g8;
            float xk[8], pk[8], kk[8];
            unpack8(*(const uint4*)(row + 256 + nn), xk);
            if (hasprev) unpack8(*(const uint4*)(row - PMLD + 256 + nn), pk); else {
#pragma unroll
                for (int i = 0; i < 8; ++i) pk[i] = 0.f; }
#pragma unroll
            for (int i = 0; i < 8; ++i) kk[i] = (xk[i] + mu[256 + nn + i] * (pk[i] - xk[i])) * k_k[nn + i] * rn;
            *(uint4*)(B.RKK + (size_t)(t0 + t) * 256 + nn) = pack8(kk);
        }
    }
    if (tid < 256) {
        float c = 0.f;
        for (int t = 0; t < 64; ++t) { c += bf2f(Llw[t * 264 + tid]); B.CW[(size_t)(t0 + t) * 256 + tid] = c; }
    }
    __syncthreads();
}

struct RwPiece { float kk[8], al[8], kt[8], v[8], cw[8], cwp[8], cwc[8]; };
__device__ __forceinline__ void rwkv_load_piece(const RwkvBufs& B, int h, int t0, int c, int d0, RwPiece& P) {
    const size_t o = (size_t)(t0 + c) * 256 + h * 64 + d0;
    float a[8];
    unpack8(*(const uint4*)(B.RKK + o), P.kk); unpack8(*(const uint4*)(B.RA + o), a); unpack8(*(const uint4*)(B.RK + o), P.kt); unpack8(*(const uint4*)(B.RV + o), P.v);
    const float4 c0 = *(const float4*)(B.CW + o), c1 = *(const float4*)(B.CW + o + 4);
    P.cw[0] = c0.x; P.cw[1] = c0.y; P.cw[2] = c0.z; P.cw[3] = c0.w; P.cw[4] = c1.x; P.cw[5] = c1.y; P.cw[6] = c1.z; P.cw[7] = c1.w;
    if (c > 0) { const float4 p0 = *(const float4*)(B.CW + o - 256), p1 = *(const float4*)(B.CW + o - 256 + 4);
        P.cwp[0] = p0.x; P.cwp[1] = p0.y; P.cwp[2] = p0.z; P.cwp[3] = p0.w; P.cwp[4] = p1.x; P.cwp[5] = p1.y; P.cwp[6] = p1.z; P.cwp[7] = p1.w; }
    else {
#pragma unroll
        for (int i = 0; i < 8; ++i) P.cwp[i] = 0.f; }
    const size_t oc = (size_t)(t0 + 63) * 256 + h * 64 + d0;
    const float4 e0 = *(const float4*)(B.CW + oc), e1 = *(const float4*)(B.CW + oc + 4);
    P.cwc[0] = e0.x; P.cwc[1] = e0.y; P.cwc[2] = e0.z; P.cwc[3] = e0.w; P.cwc[4] = e1.x; P.cwc[5] = e1.y; P.cwc[6] = e1.z; P.cwc[7] = e1.w;
#pragma unroll
    for (int i = 0; i < 8; ++i) P.al[i] = a[i] * P.kk[i];
}

__device__ __forceinline__ void rwkv_g1_unit(int h, int n, const RwkvBufs& B, LAS float* lds) {
    const int tid = opq_tid(), w = tid >> 6, lane = tid & 63, q4 = lane >> 4, cc = lane & 15;
    LAS float* S0 = lds; LAS float* S1 = lds + MS; LAS float* S2 = lds + 2 * MS; LAS float* S3 = lds + 3 * MS; LAS float* Lm = lds + 4 * MS; LAS float* Lk = lds + 5 * MS;
    const int t0 = n * 64, u = (4 + h) * 256 + n;
    const int c = tid >> 3, d0 = (tid & 7) * 8;
    RwPiece P; rwkv_load_piece(B, h, t0, c, d0, P);
#pragma unroll
    for (int i = 0; i < 8; ++i) {
        const float em = expf(-P.cw[i]);
        S0[c * PT + d0 + i] = P.kk[i] * expf(P.cwp[i]); S1[c * PT + d0 + i] = P.al[i] * em; S2[c * PT + d0 + i] = P.kt[i] * em;
    }
    __syncthreads();
    const int ti = w >> 1, tj0 = (w & 1) * 2;
    const f32x4_t zero4 = {0.f, 0.f, 0.f, 0.f};
#pragma unroll
    for (int tt = 0; tt < 2; ++tt) {
        const int tj = tj0 + tt;
        if (tj <= ti) {
            const f32x4_t a = mm_tile<3>(S0 + 16 * ti * PT, S1 + 16 * tj * PT, lane, zero4);
            const f32x4_t b = mm_tile<3>(S0 + 16 * ti * PT, S2 + 16 * tj * PT, lane, zero4);
            const int j = 16 * tj + cc;
#pragma unroll
            for (int r = 0; r < 4; ++r) { const int i = 16 * ti + 4 * q4 + r; Lm[i * PT + j] = (i > j) ? a[r] : 0.f; Lk[i * PT + j] = (i > j) ? b[r] : 0.f; }
        } else {
            const int j = 16 * tj + cc;
#pragma unroll
            for (int r = 0; r < 4; ++r) { const int i = 16 * ti + 4 * q4 + r; Lk[i * PT + j] = 0.f; }
        }
    }
    __syncthreads();
#pragma unroll
    for (int i = 0; i < 8; ++i) {
        const float eb = expf(P.cwc[i] - P.cw[i]);
        S0[(d0 + i) * PT + c] = P.v[i]; S1[(d0 + i) * PT + c] = P.kk[i] * expf(P.cwp[i]); S2[(d0 + i) * PT + c] = P.al[i] * eb; S3[(d0 + i) * PT + c] = P.kt[i] * eb;
    }
    if (w == 0) tri_inverse_wave(Lm, lane);
    __syncthreads();
    f32x4_t pa[2];
#pragma unroll
    for (int tt = 0; tt < 2; ++tt) pa[tt] = mm_tile<3>(Lk + 16 * ti * PT, S0 + 16 * (tj0 + tt) * PT, lane, zero4);
    __syncthreads();
#pragma unroll
    for (int tt = 0; tt < 2; ++tt) *(LAS f32x4_t*)(Lk + (16 * (tj0 + tt) + cc) * PT + 16 * ti + 4 * q4) = pa[tt];
    __syncthreads();
    f32x4_t ua[2], wa[2];
#pragma unroll
    for (int tt = 0; tt < 2; ++tt) {
        ua[tt] = mm_tile<3>(Lm + 16 * ti * PT, Lk + 16 * (tj0 + tt) * PT, lane, zero4);
        wa[tt] = mm_tile<3>(Lm + 16 * ti * PT, S1 + 16 * (tj0 + tt) * PT, lane, zero4);
    }
    __syncthreads();
#pragma unroll
    for (int tt = 0; tt < 2; ++tt) {
        *(LAS f32x4_t*)(Lk + (16 * (tj0 + tt) + cc) * PT + 16 * ti + 4 * q4) = -ua[tt];
        *(LAS f32x4_t*)(S1 + (16 * (tj0 + tt) + cc) * PT + 16 * ti + 4 * q4) = wa[tt];
    }
    __syncthreads();
    {
#pragma unroll
        for (int tt = 0; tt < 2; ++tt) {
            const int tj = tj0 + tt;
            const f32x4_t a = mm_tile<3>(S2 + 16 * ti * PT, S1 + 16 * tj * PT, lane, zero4);
            const float gam = expf(B.CW[(size_t)(t0 + 63) * 256 + h * 64 + 16 * tj + cc]);
#pragma unroll
            for (int r = 0; r < 4; ++r) { const int ar = 16 * ti + 4 * q4 + r, bc = 16 * tj + cc; Lm[ar * PT + bc] = (ar == bc ? gam : 0.f) - a[r]; }
            f32x4_t nn = mm_tile<3>(S2 + 16 * ti * PT, Lk + 16 * tj * PT, lane, zero4);
            nn = mm_tile<3>(S3 + 16 * ti * PT, S0 + 16 * tj * PT, lane, nn);
            *(float4*)(B.NF + (size_t)u * 4096 + (tj * 64 + lane) * 16 + ti * 4) = make_float4(nn[0], nn[1], nn[2], nn[3]);
        }
    }
    __syncthreads();
    {
        const int combo = tid >> 6, mt = combo >> 1, s = combo & 1, i = lane & 15, qq = lane >> 4;
        const f32x4_t x0 = *(const LAS f32x4_t*)(Lm + (16 * mt + i) * PT + 32 * s + 4 * qq);
        const f32x4_t x1 = *(const LAS f32x4_t*)(Lm + (16 * mt + i) * PT + 32 * s + 16 + 4 * qq);
        const float xv[8] = {x0.x, x0.y, x0.z, x0.w, x1.x, x1.y, x1.z, x1.w};
        U8 H, L; split8(xv, H.v, L.v);
        uint4* mf = B.MF + (size_t)u * 1024 + (size_t)(combo * 2) * 64 + lane;
        mf[0] = H.q; mf[64] = L.q;
    }
    __syncthreads();
}

__device__ __forceinline__ void rwkv_g3_unit(int h, int n, const RwkvBufs& B, bf16_t* __restrict__ Y, const Params& p, int l, LAS float* lds) {
    const int tid = opq_tid(), w = tid >> 6, lane = tid & 63, q4 = lane >> 4, cc = lane & 15;
    LAS float* S0 = lds; LAS float* S1 = lds + MS; LAS float* S2 = lds + 2 * MS; LAS float* RH = lds + 3 * MS; LAS float* Lm = lds + 4 * MS; LAS float* Lk = lds + 5 * MS;
    LAS float* Ara = lds + 6 * MS; LAS float* Ark = lds + 7 * MS;
    const int t0 = n * 64, u = (4 + h) * 256 + n;
    const int c = tid >> 3, d0 = (tid & 7) * 8;
    RwPiece P; rwkv_load_piece(B, h, t0, c, d0, P);
    {
        float rr[8]; unpack8(*(const uint4*)(B.RR + (size_t)(t0 + c) * 256 + h * 64 + d0), rr);
#pragma unroll
        for (int i = 0; i < 8; ++i) {
            const float em = expf(-P.cw[i]);
            S0[c * PT + d0 + i] = P.kk[i] * expf(P.cwp[i]); S1[c * PT + d0 + i] = P.al[i] * em; S2[c * PT + d0 + i] = P.kt[i] * em; RH[c * PT + d0 + i] = rr[i] * expf(P.cw[i]);
        }
    }
    __syncthreads();
    const int ti = w >> 1, tj0 = (w & 1) * 2;
    const f32x4_t zero4 = {0.f, 0.f, 0.f, 0.f};
#pragma unroll
    for (int tt = 0; tt < 2; ++tt) {
        const int tj = tj0 + tt; const int j = 16 * tj + cc;
        if (tj <= ti) {
            const f32x4_t a = mm_tile<3>(S0 + 16 * ti * PT, S1 + 16 * tj * PT, lane, zero4);
            const f32x4_t b = mm_tile<3>(S0 + 16 * ti * PT, S2 + 16 * tj * PT, lane, zero4);
            const f32x4_t e = mm_tile<3>(RH + 16 * ti * PT, S1 + 16 * tj * PT, lane, zero4);
            const f32x4_t f = mm_tile<3>(RH + 16 * ti * PT, S2 + 16 * tj * PT, lane, zero4);
#pragma unroll
            for (int r = 0; r < 4; ++r) { const int i = 16 * ti + 4 * q4 + r;
                Lm[i * PT + j] = (i > j) ? a[r] : 0.f; Lk[i * PT + j] = (i > j) ? b[r] : 0.f; Ara[i * PT + j] = (i >= j) ? e[r] : 0.f; Ark[i * PT + j] = (i >= j) ? f[r] : 0.f; }
        } else {
#pragma unroll
            for (int r = 0; r < 4; ++r) { const int i = 16 * ti + 4 * q4 + r; Lk[i * PT + j] = 0.f; Ara[i * PT + j] = 0.f; Ark[i * PT + j] = 0.f; }
        }
    }
    __syncthreads();
#pragma unroll
    for (int i = 0; i < 8; ++i) { S0[(d0 + i) * PT + c] = P.v[i]; S1[(d0 + i) * PT + c] = P.kk[i] * expf(P.cwp[i]); }
    if (w == 0) tri_inverse_wave(Lm, lane);
    __syncthreads();
    f32x4_t pa[2];
#pragma unroll
    for (int tt = 0; tt < 2; ++tt) pa[tt] = mm_tile<3>(Lk + 16 * ti * PT, S0 + 16 * (tj0 + tt) * PT, lane, zero4);
    __syncthreads();
#pragma unroll
    for (int tt = 0; tt < 2; ++tt) *(LAS f32x4_t*)(Lk + (16 * (tj0 + tt) + cc) * PT + 16 * ti + 4 * q4) = pa[tt];
    __syncthreads();
    f32x4_t ua[2], wa[2];
#pragma unroll
    for (int tt = 0; tt < 2; ++tt) {
        ua[tt] = mm_tile<3>(Lm + 16 * ti * PT, Lk + 16 * (tj0 + tt) * PT, lane, zero4);
        wa[tt] = mm_tile<3>(Lm + 16 * ti * PT, S1 + 16 * (tj0 + tt) * PT, lane, zero4);
    }
    __syncthreads();
    {
#pragma unroll
        for (int tt = 0; tt < 2; ++tt)
#pragma unroll
            for (int r = 0; r < 4; ++r) S1[(16 * ti + 4 * q4 + r) * PT + 16 * (tj0 + tt) + cc] = wa[tt][r];
        const float* ht = B.HT + (size_t)u * 4096;
        const float4 x0 = *(const float4*)(ht + c * 64 + d0), x1 = *(const float4*)(ht + c * 64 + d0 + 4);
        *(LAS f32x4_t*)(S2 + c * PT + d0) = (f32x4_t){x0.x, x0.y, x0.z, x0.w}; *(LAS f32x4_t*)(S2 + c * PT + d0 + 4) = (f32x4_t){x1.x, x1.y, x1.z, x1.w};
    }
    __syncthreads();
    f32x4_t o[2];
#pragma unroll
    for (int tt = 0; tt < 2; ++tt) {
        const int tj = tj0 + tt;
        const f32x4_t wh = mm_tile<3>(S1 + 16 * ti * PT, S2 + 16 * tj * PT, lane, zero4);
        ua[tt] = -ua[tt] - wh;
        o[tt] = mm_tile<3>(RH + 16 * ti * PT, S2 + 16 * tj * PT, lane, zero4);
        o[tt] = mm_tile<3>(Ark + 16 * ti * PT, S0 + 16 * tj * PT, lane, o[tt]);
        *(LAS f32x4_t*)(Lm + (16 * tj + cc) * PT + 16 * ti + 4 * q4) = ua[tt];
    }
    __syncthreads();
#pragma unroll
    for (int tt = 0; tt < 2; ++tt) o[tt] = mm_tile<3>(Ara + 16 * ti * PT, Lm + 16 * (tj0 + tt) * PT, lane, o[tt]);
    __syncthreads();
#pragma unroll
    for (int tt = 0; tt < 2; ++tt)
#pragma unroll
        for (int r = 0; r < 4; ++r) Lk[(16 * ti + 4 * q4 + r) * PT + 16 * (tj0 + tt) + cc] = o[tt][r];
    __syncthreads();
    {
        const f32x4_t x0 = *(const LAS f32x4_t*)(Lk + c * PT + d0), x1 = *(const LAS f32x4_t*)(Lk + c * PT + d0 + 4);
        const float xv[8] = {x0.x, x0.y, x0.z, x0.w, x1.x, x1.y, x1.z, x1.w};
        float s1 = 0.f;
#pragma unroll
        for (int i = 0; i < 8; ++i) s1 += xv[i];
        s1 += __shfl_xor(s1, 1); s1 += __shfl_xor(s1, 2); s1 += __shfl_xor(s1, 4);
        const float mean = s1 * (1.f / 64.f);
        float s2 = 0.f;
#pragma unroll
        for (int i = 0; i < 8; ++i) { const float dd = xv[i] - mean; s2 = fmaf(dd, dd, s2); }
        s2 += __shfl_xor(s2, 1); s2 += __shfl_xor(s2, 2); s2 += __shfl_xor(s2, 4);
        const float rs = rsqrtf(s2 * (1.f / 64.f) + 64e-5f);
        const size_t o8 = (size_t)(t0 + c) * 256 + h * 64 + d0;
        float rr[8], gg[8], kt2[8], v2[8];
        unpack8(*(const uint4*)(B.RR + o8), rr); unpack8(*(const uint4*)(B.RG + o8), gg); unpack8(*(const uint4*)(B.RK + o8), kt2); unpack8(*(const uint4*)(B.RV + o8), v2);
        const float* r_k = p.in[32] + l * W + h * 64 + d0; const float* ln_g = p.in[33] + l * W + h * 64 + d0; const float* ln_b = p.in[34] + l * W + h * 64 + d0;
        float bs = 0.f;
#pragma unroll
        for (int i = 0; i < 8; ++i) bs = fmaf(rr[i] * kt2[i], r_k[i], bs);
        bs += __shfl_xor(bs, 1); bs += __shfl_xor(bs, 2); bs += __shfl_xor(bs, 4);
        float y[8];
#pragma unroll
        for (int i = 0; i < 8; ++i) y[i] = ((xv[i] - mean) * rs * ln_g[i] + ln_b[i] + bs * v2[i]) * gg[i];
        *(uint4*)(Y + (size_t)(t0 + c) * D + 768 + h * 64 + d0) = pack8(y);
    }
    __syncthreads();
}
struct LruBufs { float2* AGG; float* CAR; };
template <int PASS>
__device__ __forceinline__ void lru_unit(const bf16_t* __restrict__ PM, int n, const LruBufs& B, bf16_t* __restrict__ Y, const Params& p, int l, const bf16_t* __restrict__ LWT  , LAS float* lds) {
    const int tid = opq_tid(), c = tid & 255, half = tid >> 8, w = tid >> 6, lane = tid & 63, q4 = lane >> 4, cc = lane & 15;
    const int t0 = n * 64, tb = t0 + 32 * half;
    LAS float* U = lds;
    lds_bf16* R = (lds_bf16*)(lds + 64 * 260);
    lds_bf16* I = R + 64 * 264;
    {
        const float* cw = p.in[7] + l * 4 * W; const float cb = p.in[8][l * W + c];
        const float w0 = cw[c], w1 = cw[W + c], w2 = cw[2 * W + c], w3 = cw[3 * W + c];
        const bf16_t* col = PM + C_LRU + c;
        float h0 = tb >= 3 ? bf2f(col[(size_t)(tb - 3) * PMLD]) : 0.f, h1 = tb >= 2 ? bf2f(col[(size_t)(tb - 2) * PMLD]) : 0.f, h2 = tb >= 1 ? bf2f(col[(size_t)(tb - 1) * PMLD]) : 0.f;
#pragma unroll 4
        for (int i = 0; i < 32; ++i) {
            const float x = bf2f(col[(size_t)(tb + i) * PMLD]);
            U[(32 * half + i) * 260 + c] = cb + w0 * h0 + w1 * h1 + w2 * h2 + w3 * x;
            h0 = h1; h1 = h2; h2 = x;
        }
    }
    __syncthreads();
    {
        const int nb = w >> 1, gt = w & 1;
        const bf16_t* wt = LWT + (size_t)gt * 16384 + (size_t)nb * 4096;
        const float* bias = (gt ? p.in[12] : p.in[10]) + l * W + nb * 64;
        const float* lam = p.in[13] + l * W + nb * 64;
#pragma unroll 1
        for (int te = 0; te < 4; ++te) {
            U8 bf[2];
#pragma unroll
            for (int ks = 0; ks < 2; ++ks) bf[ks].q = *(const uint4*)(wt + (size_t)(16 * te + cc) * 64 + 32 * ks + 8 * q4);
            const int ch = nb * 64 + 16 * te + cc;
            const float bv = bias[16 * te + cc];
            const float sp8 = 8.f * softplusf_(-lam[16 * te + cc]);
#pragma unroll
            for (int tt = 0; tt < 4; ++tt) {
                f32x4_t acc = {0.f, 0.f, 0.f, 0.f};
#pragma unroll
                for (int ks = 0; ks < 2; ++ks) {
                    const LAS float* ap = U + (16 * tt + cc) * 260 + nb * 64 + 32 * ks + 8 * q4;
                    const f32x4_t a0 = *(const LAS f32x4_t*)ap, a1 = *(const LAS f32x4_t*)(ap + 4);
                    const float av[8] = {a0.x, a0.y, a0.z, a0.w, a1.x, a1.y, a1.z, a1.w};
                    acc = __builtin_amdgcn_mfma_f32_16x16x32_bf16(hi8(av), bf[ks].v, acc, 0, 0, 0);
                }
#pragma unroll
                for (int r = 0; r < 4; ++r) {
                    const int t = 16 * tt + 4 * q4 + r;
                    const float sg = sigmoidf_(acc[r] + bv);
                    if (gt) I[t * 264 + ch] = (unsigned short)f2bf(sg); else R[t * 264 + ch] = (unsigned short)f2bf(-sp8 * sg);
                }
            }
        }
    }
    __syncthreads();
    float h = 0.f, ap = 1.f;
    const int sc = 2 * n + half;
    if (PASS == 3) h = B.CAR[(size_t)sc * 256 + c];
#pragma unroll 2
    for (int i = 0; i < 32; ++i) {
        const int t = 32 * half + i;
        const float log_a = bf2f(R[t * 264 + c]), ig = bf2f(I[t * 264 + c]);
        const float a = expf(log_a);
        const float inp = sqrtf(-expm1f(2.f * log_a)) * (ig * U[t * 260 + c]);
        h = fmaf(a, h, inp); ap *= a;
        if (PASS == 3) {
            const float gate = bf2f(PM[(size_t)(t0 + t) * PMLD + C_LRU + 256 + c]);
            Y[(size_t)(t0 + t) * D + 256 + c] = (bf16_t)f2bf(h * geluf_(gate));
        }
    }
    if (PASS == 1) B.AGG[(size_t)sc * 256 + c] = make_float2(ap, h);
    __syncthreads();
}
__device__ __forceinline__ void lru_carry(const LruBufs& B, int c) {
    float h = 0.f;
#pragma unroll 8
    for (int s = 0; s < 512; ++s) { const float2 ab = B.AGG[(size_t)s * 256 + c]; B.CAR[(size_t)s * 256 + c] = h; h = fmaf(ab.x, h, ab.y); }
}

struct S5Bufs { float2* E; float2* CIN; };
struct S5Lane { float lbr, lbi; float bbr[16], bbi[16]; };
__device__ __forceinline__ void s5_lane_consts(const Params& p, int l, int g, int lane, S5Lane& K) {
    const float dt = expf(p.in[21][l * 16 + g]);
    const float lre = p.in[14][l * 1024 + g * 64 + lane], lim = p.in[15][l * 1024 + g * 64 + lane];
    const float er = expf(lre * dt);
    K.lbr = er * cosf(lim * dt); K.lbi = er * sinf(lim * dt);
    const float nr = K.lbr - 1.f, ni = K.lbi, den = lre * lre + lim * lim;
    const float fr = (nr * lre + ni * lim) / den, fi = (ni * lre - nr * lim) / den;
    const float* bre = p.in[16] + (size_t)l * 16384 + (g * 64 + lane) * 16; const float* bim = p.in[17] + (size_t)l * 16384 + (g * 64 + lane) * 16;
#pragma unroll
    for (int c = 0; c < 16; ++c) { const float br = bre[c], bi = bim[c]; K.bbr[c] = fr * br - fi * bi; K.bbi[c] = fr * bi + fi * br; }
}
template <int PASS>
__device__ __forceinline__ void s5_unit(const bf16_t* __restrict__ PM, int n, const S5Bufs& B, bf16_t* __restrict__ Y, const Params& p, int l, const bf16_t* __restrict__ GLUT, LAS unsigned char* lds) {
    const int tid = opq_tid(), w = tid >> 6, lane = tid & 63, q4 = lane >> 4, cc = lane & 15;
    const int t0 = n * 64;
    LAS float* us = (LAS float*)lds + w * (64 * 16);
    LAS unsigned char* hs = lds + 32768 + w * (32 * 272);
    lds_bf16* yp = (lds_bf16*)(lds + 32768 + 8 * 32 * 272);
#pragma unroll 1
    for (int gi = 0; gi < 2; ++gi) {
        const int g = 2 * w + gi;
        {
            const bf16_t* src = PM + (size_t)(t0 + lane) * PMLD + C_S5 + g * 16;
            float a[8], b[8]; unpack8(*(const uint4*)src, a); unpack8(*(const uint4*)(src + 8), b);
            *(LAS f32x4_t*)(us + lane * 16) = (f32x4_t){a[0], a[1], a[2], a[3]}; *(LAS f32x4_t*)(us + lane * 16 + 4) = (f32x4_t){a[4], a[5], a[6], a[7]};
            *(LAS f32x4_t*)(us + lane * 16 + 8) = (f32x4_t){b[0], b[1], b[2], b[3]}; *(LAS f32x4_t*)(us + lane * 16 + 12) = (f32x4_t){b[4], b[5], b[6], b[7]};
        }
        S5Lane K; s5_lane_consts(p, l, g, lane, K);
        float hr = 0.f, hi = 0.f;
        if (PASS == 3) { const float2 h0 = B.CIN[((size_t)n * 16 + g) * 64 + lane]; hr = h0.x; hi = h0.y; }
        U8 cf[4];
        float dch = 0.f;
        if (PASS == 3) {
            const float* cre = p.in[18] + (size_t)l * 16384 + (g * 16 + cc) * 64; const float* cim = p.in[19] + (size_t)l * 16384 + (g * 16 + cc) * 64;
#pragma unroll
            for (int ks = 0; ks < 4; ++ks) {
                const float4 r4 = *(const float4*)(cre + 16 * ks + 4 * q4), i4 = *(const float4*)(cim + 16 * ks + 4 * q4);
                cf[ks].u[0] = cvtpk(r4.x, -i4.x); cf[ks].u[1] = cvtpk(r4.y, -i4.y); cf[ks].u[2] = cvtpk(r4.z, -i4.z); cf[ks].u[3] = cvtpk(r4.w, -i4.w);
            }
            dch = p.in[20][l * W + g * 16 + cc];
        }
        asm volatile("s_waitcnt lgkmcnt(0)" ::: "memory");
#pragma unroll 1
        for (int hf = 0; hf < 2; ++hf) {
#pragma unroll 2
            for (int i = 0; i < 32; ++i) {
                const int t = 32 * hf + i;
                const f32x4_t u0 = *(const LAS f32x4_t*)(us + t * 16), u1 = *(const LAS f32x4_t*)(us + t * 16 + 4), u2 = *(const LAS f32x4_t*)(us + t * 16 + 8), u3 = *(const LAS f32x4_t*)(us + t * 16 + 12);
                const float uv[16] = {u0.x, u0.y, u0.z, u0.w, u1.x, u1.y, u1.z, u1.w, u2.x, u2.y, u2.z, u2.w, u3.x, u3.y, u3.z, u3.w};
                float br = 0.f, bi = 0.f;
#pragma unroll
                for (int c = 0; c < 16; ++c) { br = fmaf(K.bbr[c], uv[c], br); bi = fmaf(K.bbi[c], uv[c], bi); }
                const float nhr = K.lbr * hr - K.lbi * hi + br, nhi = K.lbr * hi + K.lbi * hr + bi;
                hr = nhr; hi = nhi;
                if (PASS == 3) *(LAS unsigned*)(hs + i * 272 + 4 * lane) = cvtpk(hr, hi);
            }
            if (PASS == 3) {
                asm volatile("s_waitcnt lgkmcnt(0)" ::: "memory");
#pragma unroll
                for (int tt = 0; tt < 2; ++tt) {
                    f32x4_t acc = {0.f, 0.f, 0.f, 0.f};
#pragma unroll
                    for (int ks = 0; ks < 4; ++ks) {
                        U8 af; af.x = *(const LAS u32x4_t*)(hs + (16 * tt + cc) * 272 + 64 * ks + 16 * q4);
                        acc = __builtin_amdgcn_mfma_f32_16x16x32_bf16(af.v, cf[ks].v, acc, 0, 0, 0);
                    }
#pragma unroll
                    for (int r = 0; r < 4; ++r) {
                        const int t = 32 * hf + 16 * tt + 4 * q4 + r;
                        const float yv = acc[r] + dch * us[t * 16 + cc];
                        yp[t * 264 + g * 16 + cc] = (unsigned short)f2bf(geluf_(yv));
                    }
                }
                asm volatile("s_waitcnt lgkmcnt(0)" ::: "memory");
            }
        }
        if (PASS == 1) B.E[((size_t)n * 16 + g) * 64 + lane] = make_float2(hr, hi);
    }
    if (PASS == 3) {
        __syncthreads();
        const float* gb = p.in[23] + l * W;
#pragma unroll 1
        for (int tn = 2 * w; tn < 2 * w + 2; ++tn) {
            f32x4_t acc[4];
#pragma unroll
            for (int tt = 0; tt < 4; ++tt) acc[tt] = (f32x4_t){0.f, 0.f, 0.f, 0.f};
#pragma unroll
            for (int ks = 0; ks < 8; ++ks) {
                U8 bf; bf.q = *(const uint4*)(GLUT + (size_t)(16 * tn + cc) * 256 + 32 * ks + 8 * q4);
#pragma unroll
                for (int tt = 0; tt < 4; ++tt) {
                    U8 af; af.x = *(const LAS u32x4_t*)(yp + (16 * tt + cc) * 264 + 32 * ks + 8 * q4);
                    acc[tt] = __builtin_amdgcn_mfma_f32_16x16x32_bf16(af.v, bf.v, acc[tt], 0, 0, 0);
                }
            }
            const int ncol = 16 * tn + cc; const float gbn = gb[ncol];
#pragma unroll
            for (int tt = 0; tt < 4; ++tt)
#pragma unroll
                for (int r = 0; r < 4; ++r) {
                    const int t = 16 * tt + 4 * q4 + r;
                    const float yv = bf2f(yp[t * 264 + ncol]);
                    Y[(size_t)(t0 + t) * D + 512 + ncol] = (bf16_t)f2bf(yv * sigmoidf_(acc[tt][r] + gbn));
                }
        }
    }
    __syncthreads();
}
__device__ __forceinline__ void s5_carry(const S5Bufs& B, const Params& p, int l, int gp) {
    const int g = gp >> 6;
    const float dt = expf(p.in[21][l * 16 + g]) * 64.f;
    const float lre = p.in[14][l * 1024 + gp], lim = p.in[15][l * 1024 + gp];
    const float er = expf(lre * dt);
    const float pr = er * cosf(lim * dt), pi = er * sinf(lim * dt);
    float hr = 0.f, hi = 0.f;
#pragma unroll 4
    for (int n = 0; n < 256; ++n) {
        const float2 e = B.E[(size_t)n * 1024 + gp];
        B.CIN[(size_t)n * 1024 + gp] = make_float2(hr, hi);
        const float nhr = pr * hr - pi * hi + e.x, nhi = pr * hi + pi * hr + e.y;
        hr = nhr; hi = nhi;
    }
}
constexpr size_t WS_GQ = 36 * MiB, WS_GK = 44 * MiB, WS_GV = 52 * MiB, WS_GB = 60 * MiB, WS_GC = 61 * MiB;
constexpr size_t WS_MF = 324 * MiB, WS_NF = 356 * MiB, WS_HT = 388 * MiB;
constexpr size_t WS_RR = 420 * MiB, WS_RK = 428 * MiB, WS_RV = 436 * MiB, WS_RKK = 444 * MiB, WS_RA = 452 * MiB, WS_RG = 460 * MiB, WS_CW = 468 * MiB;
constexpr size_t WS_LAGG = 484 * MiB, WS_LCAR = 485 * MiB, WS_S5E = 486 * MiB, WS_S5C = 488 * MiB;
constexpr int MIX_LDS = 8 * MS * 4 + 1024;
__device__ __forceinline__ LruBufs lru_bufs(unsigned char* ws) { LruBufs B; B.AGG = (float2*)(ws + WS_LAGG); B.CAR = (float*)(ws + WS_LCAR); return B; }
__device__ __forceinline__ S5Bufs s5_bufs(unsigned char* ws) { S5Bufs B; B.E = (float2*)(ws + WS_S5E); B.CIN = (float2*)(ws + WS_S5C); return B; }
__device__ __forceinline__ GdnBufs gdn_bufs(unsigned char* ws) {
    GdnBufs B; B.GQ = (bf16_t*)(ws + WS_GQ); B.GK = (bf16_t*)(ws + WS_GK); B.GV = (bf16_t*)(ws + WS_GV); B.GB = (float*)(ws + WS_GB); B.GC = (float*)(ws + WS_GC);
    B.MF = (uint4*)(ws + WS_MF); B.NF = (float*)(ws + WS_NF); B.HT = (float*)(ws + WS_HT); return B;
}
__device__ __forceinline__ RwkvBufs rwkv_bufs(unsigned char* ws) {
    RwkvBufs B; B.RR = (bf16_t*)(ws + WS_RR); B.RK = (bf16_t*)(ws + WS_RK); B.RV = (bf16_t*)(ws + WS_RV); B.RKK = (bf16_t*)(ws + WS_RKK); B.RA = (bf16_t*)(ws + WS_RA); B.RG = (bf16_t*)(ws + WS_RG);
    B.CW = (float*)(ws + WS_CW); B.MF = (uint4*)(ws + WS_MF); B.NF = (float*)(ws + WS_NF); B.HT = (float*)(ws + WS_HT); return B;
}
__device__ __forceinline__ unsigned char* opq(unsigned char* w) { asm volatile("" : "+s"(w)); return w; }
__global__ void __launch_bounds__(NT, 2) k_mix_prep(Params p, long long l_) {
    extern __shared__ __attribute__((aligned(16))) unsigned char dl[];
    for (int n = blockIdx.x; n < 512; n += gridDim.x) {
        unsigned char* ws = opq(p.ws);
        if (n < 256) gdn_prep_chunk((const bf16_t*)(ws + WS_PM), n, gdn_bufs(ws), p, (int)l_, (LAS float*)dl);
        else { const bf16_t* WL = (const bf16_t*)(ws + WS_W); rwkv_prep_chunk((const bf16_t*)(ws + WS_PM), n - 256, rwkv_bufs(ws), p, (int)l_, WL + WO_WUP, WL + WO_AUP, WL + WO_GUP, (LAS unsigned char*)dl); }
    }
}
__global__ void __launch_bounds__(NT, 2) k_mix_g1(Params p, long long l_) {
    extern __shared__ __attribute__((aligned(16))) unsigned char dl[];
    const int l = (int)l_;
    for (int u = blockIdx.x; u < 2560; u += gridDim.x) {
        unsigned char* ws = opq(p.ws);
        if (u < 1024) gdn_g1_unit(u >> 8, u & 255, gdn_bufs(ws), (LAS float*)dl);
        else if (u < 2048) rwkv_g1_unit((u - 1024) >> 8, u & 255, rwkv_bufs(ws), (LAS float*)dl);
        else if (u < 2304) lru_unit<1>((const bf16_t*)(ws + WS_PM), u - 2048, lru_bufs(ws), (bf16_t*)(ws + WS_Y), p, l, (const bf16_t*)(ws + WS_W) + WO_LWT, (LAS float*)dl);
        else s5_unit<1>((const bf16_t*)(ws + WS_PM), u - 2304, s5_bufs(ws), (bf16_t*)(ws + WS_Y), p, l, (const bf16_t*)(ws + WS_W) + WO_GLU, (LAS unsigned char*)dl);
    }
}
__global__ void __launch_bounds__(64) k_mix_chain(Params p, long long l_) {
    const GdnBufs B = gdn_bufs(p.ws);
    const int bx = blockIdx.x, lane = threadIdx.x & 63;
    if (bx < 32) { const int sq = bx >> 2, cb = bx & 3;
        chain_wave(B.MF + (size_t)sq * 256 * 1024, B.NF + (size_t)sq * 256 * 4096, B.HT + (size_t)sq * 256 * 4096, cb, 256, lane); }
    else if (bx < 36) lru_carry(lru_bufs(p.ws), (bx - 32) * 64 + lane);
    else s5_carry(s5_bufs(p.ws), p, (int)l_, (bx - 36) * 64 + lane);
}
__global__ void __launch_bounds__(NT, 2) k_mix_g3(Params p, long long l_) {
    extern __shared__ __attribute__((aligned(16))) unsigned char dl[];
    const int l = (int)l_;
    for (int u = blockIdx.x; u < 2560; u += gridDim.x) {
        unsigned char* ws = opq(p.ws);
        if (u < 1024) gdn_g3_unit(u >> 8, u & 255, gdn_bufs(ws), (const bf16_t*)(ws + WS_PM), (bf16_t*)(ws + WS_Y), p.in[6] + l * 64, (LAS float*)dl);
        else if (u < 2048) rwkv_g3_unit((u - 1024) >> 8, u & 255, rwkv_bufs(ws), (bf16_t*)(ws + WS_Y), p, l, (LAS float*)dl);
        else if (u < 2304) lru_unit<3>((const bf16_t*)(ws + WS_PM), u - 2048, lru_bufs(ws), (bf16_t*)(ws + WS_Y), p, l, (const bf16_t*)(ws + WS_W) + WO_LWT, (LAS float*)dl);
        else s5_unit<3>((const bf16_t*)(ws + WS_PM), u - 2304, s5_bufs(ws), (bf16_t*)(ws + WS_Y), p, l, (const bf16_t*)(ws + WS_W) + WO_GLU, (LAS unsigned char*)dl);
    }
}
struct EpiProj { bf16_t* PM; bf16_t* G; __device__ __forceinline__ void operator()(int r, int c, const float (&a)[4]) const {
    if (c < NMIX) { bf16_t* o = PM + (size_t)r * PMLD + c; for (int j = 0; j < 4; ++j) o[j] = (bf16_t)f2bf(a[j]); }
    else { bf16_t* o = G + (size_t)r * 4096 + (c - NMIX); for (int j = 0; j < 4; ++j) o[j] = (bf16_t)f2bf(sigmoidf_(a[j])); } } };
struct EpiResid { const float* Xin; float* Xo; __device__ __forceinline__ void operator()(int r, int c, const float (&a)[4]) const {
    const float4 xi = *(const float4*)(Xin + (size_t)r * D + c); *(float4*)(Xo + (size_t)r * D + c) = make_float4(xi.x + a[0], xi.y + a[1], xi.z + a[2], xi.w + a[3]); } };
struct EpiRelu2 { bf16_t* O; __device__ __forceinline__ void operator()(int r, int c, const float (&a)[4]) const {
    bf16_t* o = O + (size_t)r * DFF + c; for (int j = 0; j < 4; ++j) { const float v = fmaxf(a[j], 0.f); o[j] = (bf16_t)f2bf(v * v); } } };

template <class Epi> struct GemmArgs { const bf16_t* A; const float* B; int lda, ldb, M, N, K, pad; Epi epi; };
template <class Epi>
__global__ void __launch_bounds__(NT) k_gemm(GemmArgs<Epi> a) {
    __shared__ __attribute__((aligned(16))) float lds[2 * 16 * 132];
    gemm_naive(a.A, a.lda, a.B, a.ldb, a.M, a.N, a.K, lds, a.epi);
}
template <class Epi> static void launch_gemm(hipStream_t st, const bf16_t* A, int lda, const float* B, int ldb, int M, int N, int K, Epi e) {
    GemmArgs<Epi> a{}; a.A = A; a.B = B; a.lda = lda; a.ldb = ldb; a.M = M; a.N = N; a.K = K; a.pad = 0; a.epi = e;
    k_gemm<Epi><<<1024, NT, 0, st>>>(a);
}
__global__ void __launch_bounds__(NT) k_merge(const bf16_t* G, const bf16_t* Y, const float* w_branch, bf16_t* MG) {
    __shared__ __attribute__((aligned(16))) float lds[2 * 16 * 132];
    gemm_merge_naive(G, Y, w_branch, MG, lds);
}
__global__ void __launch_bounds__(NT) k_rmsnorm_bf(const float* X, const float* g, bf16_t* O, long long rows) { rmsnorm_rows(X, g, O, (int)rows); }
__global__ void __launch_bounds__(NT) k_rmsnorm_f(const float* X, const float* g, float* O, long long rows) { rmsnorm_rows(X, g, O, (int)rows); }
__global__ void __launch_bounds__(NT) k_lru_prep(Params p, long long l_) { lru_prep((const bf16_t*)(p.ws + WS_PM), (float*)(p.ws + WS_LA), (float*)(p.ws + WS_LI), p, (int)l_); }
__global__ void __launch_bounds__(64) k_s5(Params p, long long l_) { s5_naive_group((const bf16_t*)(p.ws + WS_PM), (float*)(p.ws + WS_S5), p, (int)l_, blockIdx.x); }
__global__ void __launch_bounds__(256) k_lru(Params p) { lru_scan((const bf16_t*)(p.ws + WS_PM), (const float*)(p.ws + WS_LA), (const float*)(p.ws + WS_LI), (bf16_t*)(p.ws + WS_Y)); }
__global__ void __launch_bounds__(NT) k_s5post(Params p, long long l_) { s5_post((const float*)(p.ws + WS_S5), (bf16_t*)(p.ws + WS_Y), p, (int)l_); }

template <class Epi, bool ALIGN> struct PgArgs { pg8::Gemm g; Epi e; };
template <class Epi, bool ALIGN>
__global__ void __launch_bounds__(NT, 2) k_pg8(PgArgs<Epi, ALIGN> a) {
    extern __shared__ __attribute__((aligned(16))) unsigned char dlds[];
    pg8::StaticOrder S; S.init(a.g.M, a.g.N, (int)gridDim.x, (int)blockIdx.x);
    pg8::gemm_phase<Epi, pg8::StaticOrder, ALIGN, true>((PG8_LAS unsigned char*)dlds, a.g, S, a.e);
}
template <class Epi, bool ALIGN> static void launch_pg8(hipStream_t st, const bf16_t* A, int lda, const bf16_t* Bt, int ldb, int M, int N, int K, Epi e) {
    static bool attr = false;
    if (!attr) { hipFuncSetAttribute((const void*)k_pg8<Epi, ALIGN>, hipFuncAttributeMaxDynamicSharedMemorySize, pg8::STAGE_BYTES); attr = true; }
    PgArgs<Epi, ALIGN> a{}; a.g.A = A; a.g.Bt = Bt; a.g.M = M; a.g.N = N; a.g.K = K; a.g.lda = lda; a.g.ldb = ldb; a.g.pad = 0; a.e = e;
    k_pg8<Epi, ALIGN><<<256, NT, pg8::STAGE_BYTES, st>>>(a);
}
__global__ void __launch_bounds__(NT) k_wconv(Params p, long long l_) {
    __shared__ float scr[8 * 64 * 33];
    const int wv = threadIdx.x >> 6, lane = threadIdx.x & 63;
    convert_weights(p, (int)l_, (LAS float*)scr + wv * 64 * 33, blockIdx.x * 8 + wv, gridDim.x * 8, lane);
}

extern "C" void kernel_launch(void* const* d_in, const int* in_sizes, int n_in, void* d_out, int out_size, void* d_ws, size_t ws_size, hipStream_t stream) {
    Params p{};
    for (int i = 0; i < 41; ++i) p.in[i] = (const float*)d_in[i];
    p.out = (float*)d_out; p.ws = (unsigned char*)d_ws; p.pad = 0;
    unsigned char* ws = p.ws;
    bf16_t* XN = (bf16_t*)(ws + WS_XN); bf16_t* PM = (bf16_t*)(ws + WS_PM); bf16_t* Y = (bf16_t*)(ws + WS_Y);
    bf16_t* MG = (bf16_t*)(ws + WS_MG); bf16_t* HD = (bf16_t*)(ws + WS_HD); bf16_t* G = (bf16_t*)(ws + WS_G);
    float* X = p.out;
    const int GR = 1024;
    { static bool attr = false; if (!attr) { attr = true;
        hipFuncSetAttribute((const void*)k_mix_prep, hipFuncAttributeMaxDynamicSharedMemorySize, MIX_LDS);
        hipFuncSetAttribute((const void*)k_mix_g1, hipFuncAttributeMaxDynamicSharedMemorySize, MIX_LDS);
        hipFuncSetAttribute((const void*)k_mix_g3, hipFuncAttributeMaxDynamicSharedMemorySize, MIX_LDS); } }
    const bf16_t* WL = (const bf16_t*)(ws + WS_W);
    for (int l = 0; l < 2; ++l) {
        const float* norm1_g = p.in[1] + l * D;
        const float* w_branch = p.in[35] + (size_t)l * 4 * W * D;
        const float* norm2_g = p.in[37] + l * D;
        k_wconv<<<GR, NT, 0, stream>>>(p, (long long)l);
        for (int b = 0; b < 2; ++b) {
            const float* Xin = (l == 0 ? p.in[0] : X) + (size_t)b * TB * D;
            float* Xb = X + (size_t)b * TB * D;
            k_rmsnorm_bf<<<GR, NT, 0, stream>>>(Xin, norm1_g, XN, (long long)TB);
            launch_pg8<pg8::EpiProjP, true>(stream, XN, D, WL + WO_IN, D, TB, 7168, D, pg8::EpiProjP{PM, G});
            k_mix_prep<<<256, NT, MIX_LDS, stream>>>(p, (long long)l);
            k_mix_g1<<<256, NT, MIX_LDS, stream>>>(p, (long long)l);
            k_mix_chain<<<52, 64, 0, stream>>>(p, (long long)l);
            k_mix_g3<<<256, NT, MIX_LDS, stream>>>(p, (long long)l);
            k_merge<<<GR, NT, 0, stream>>>(G, Y, w_branch, MG);
            launch_pg8<pg8::EpiResidP, false>(stream, MG, D, WL + WO_OUT, D, TB, D, D, pg8::EpiResidP{Xin, Xb});
            k_rmsnorm_bf<<<GR, NT, 0, stream>>>(Xb, norm2_g, XN, (long long)TB);
            launch_pg8<pg8::EpiRelu2P, true>(stream, XN, D, WL + WO_W1, D, TB, DFF, D, pg8::EpiRelu2P{HD, DFF, 0});
            launch_pg8<pg8::EpiResidP, false>(stream, HD, DFF, WL + WO_W2, DFF, TB, D, DFF, pg8::EpiResidP{Xb, Xb});
        }
    }
    k_rmsnorm_f<<<GR, NT, 0, stream>>>(X, p.in[40], X, (long long)(2 * TB));
}
```

```cpp
#include <hip/hip_runtime.h>
#include <hip/hip_cooperative_groups.h>
#include <cstdio>
#include <cstdint>

constexpr int TB = 16384;
constexpr int D = 1024;
constexpr int DIN = 6920;
constexpr int NMIX = 2824;
constexpr int W = 256;
constexpr int DFF = 4096;
constexpr int NT = 512;

constexpr int C_GDN = 0, C_LRU = 1032, C_S5 = 1544, C_RWKV = 1800, C_GATE = 2824;

struct KParams { const float* in[41]; float* out; unsigned char* ws; size_t pad; };
#define LAS __attribute__((address_space(3)))
struct PIn { LAS const unsigned long long* tab;
    __device__ __forceinline__ const float* operator[](int i) const { LAS const unsigned long long* t = tab; asm volatile("" : "+v"(t)); const unsigned long long v = t[i];
        const unsigned lo = __builtin_amdgcn_readfirstlane((unsigned)v), hi = __builtin_amdgcn_readfirstlane((unsigned)(v >> 32)); return (const float*)(((unsigned long long)hi << 32) | lo); } };
struct Params { PIn in;
    __device__ __forceinline__ float* out() const { return (float*)in[41]; }
    __device__ __forceinline__ unsigned char* ws() const { return (unsigned char*)in[42]; } };

typedef unsigned short bf16_t;
constexpr int PMLD = 3072;
constexpr size_t MiB = 1u << 20;
constexpr size_t WS_W  = 0;
constexpr size_t WS_XN = 36 * MiB;
constexpr size_t WS_PM = 68 * MiB;
constexpr size_t WS_G  = 164 * MiB;
constexpr size_t WS_HD = 164 * MiB;
constexpr size_t WS_Y  = 292 * MiB;
constexpr size_t WS_MG = 324 * MiB;

__device__ __forceinline__ unsigned f2bf(float f) { unsigned u = __float_as_uint(f); return (u + 0x7fffu + ((u >> 16) & 1u)) >> 16; }
__device__ __forceinline__ float bf2f(bf16_t b) { return __uint_as_float((unsigned)b << 16); }
__device__ __forceinline__ float ldf(const float* p) { return *p; }
__device__ __forceinline__ float ldf(const bf16_t* p) { return bf2f(*p); }
__device__ __forceinline__ float sigmoidf_(float x) { return 1.f / (1.f + __expf(-x)); }
__device__ __forceinline__ float softplusf_(float x) { return x > 20.f ? x : log1pf(expf(x)); }
__device__ __forceinline__ float siluf_(float x) { return x * sigmoidf_(x); }
__device__ __forceinline__ float geluf_(float x) { return 0.5f * x * (1.f + tanhf(0.7978845608028654f * (x + 0.044715f * x * x * x))); }
__device__ __forceinline__ float rl(float v, int i) { return __int_as_float(__builtin_amdgcn_readlane(__float_as_int(v), i)); }
__device__ __forceinline__ float wave_sum(float v) {
#pragma unroll
    for (int o = 1; o < 64; o <<= 1) v += __shfl_xor(v, o);
    return v;
}

template <class OT>
__device__ __forceinline__ void rmsnorm_rows(const float* X, const float* g, OT* O, int rows) {
    int tid_ = threadIdx.x; asm volatile("" : "+v"(tid_));
    const int lane = tid_ & 63, wv = tid_ >> 6;
    const int gw = blockIdx.x * (NT / 64) + wv, ngw = gridDim.x * (NT / 64);
    for (int r = gw; r < rows; r += ngw) {
        const float4* xr = (const float4*)(X + (size_t)r * D);
        float4 v[4]; float s = 0.f;
#pragma unroll
        for (int j = 0; j < 4; ++j) { v[j] = xr[lane + 64 * j]; s += v[j].x * v[j].x + v[j].y * v[j].y + v[j].z * v[j].z + v[j].w * v[j].w; }
        s = wave_sum(s);
        const float rs = rsqrtf(s * (1.f / D) + 1e-6f);
#pragma unroll
        for (int j = 0; j < 4; ++j) {
            const float4 gg = ((const float4*)g)[lane + 64 * j];
            const float4 o = make_float4(v[j].x * rs * gg.x, v[j].y * rs * gg.y, v[j].z * rs * gg.z, v[j].w * rs * gg.w);
            if constexpr (sizeof(OT) == 4) ((float4*)(O + (size_t)r * D))[lane + 64 * j] = o;
            else ((uint2*)(O + (size_t)r * D))[lane + 64 * j] = make_uint2(f2bf(o.x) | (f2bf(o.y) << 16), f2bf(o.z) | (f2bf(o.w) << 16));
        }
    }
}

namespace pg8 {
#define PG8_LAS __attribute__((address_space(3)))
typedef short bf16x8 __attribute__((ext_vector_type(8)));
typedef float f32x4 __attribute__((ext_vector_type(4)));
typedef unsigned u32x4 __attribute__((ext_vector_type(4)));
constexpr int BM = 256, BK = 64, HALF = 128, HTB = HALF * BK * 2  , STAGE_BYTES = 8 * HTB, NXCD = 8, WGM = 8;

__host__ __device__ __forceinline__ int lds_byte(int r, int c) { const int st = (r >> 4) * 2 + (c >> 5), rr = r & 15, cc = c & 31, ob = rr * 64 + cc * 2; return st * 1024 + (ob ^ (((ob >> 9) & 1) << 5)); }
__host__ __device__ __forceinline__ void stage_rc(int b, int& R, int& C) { const int st = b / 1024, sb = b % 1024, swz = sb ^ (((sb >> 9) & 1) << 5); R = (st >> 1) * 16 + swz / 64; C = (st & 1) * 32 + (swz % 64) / 2; }
__host__ __device__ __forceinline__ int perm32(int rho) { const int n = rho >> 4, i = rho & 15; return 8 * (i >> 2) + 4 * n + (i & 3); }

struct Unit { int pm, pn; };
struct Gemm { const bf16_t* A; const bf16_t* Bt; int M, N, K, lda, ldb, pad; };

struct StaticOrder {
    int nM, nN, nwg, G, c;
    __host__ __device__ void init(int M, int N, int G_, int c_) { nM = M / BM; nN = N / BM; nwg = nM * nN; G = G_; c = c_; }
    __host__ __device__ bool next(int i, Unit& u) const {
        const long L = (long)i * G + c; if (L >= nwg) return false;
        int wgid = (int)L; { const int q = nwg / NXCD, r = nwg % NXCD, xcd = wgid % NXCD, off = wgid / NXCD; wgid = (xcd < r ? xcd * (q + 1) : r * (q + 1) + (xcd - r) * q) + off; }
        const int nig = WGM * nN, gid = wgid / nig, fm = gid * WGM, gsz = (nM - fm) < WGM ? (nM - fm) : WGM;
        u.pm = fm + ((wgid % nig) % gsz); u.pn = (wgid % nig) / gsz; return true;
    }
    __device__ __forceinline__ void a_ready(const Unit&) const {}
    __device__ __forceinline__ void done(const Unit&) const {}
};


__device__ __forceinline__ unsigned cvt_pk_bf16(float lo, float hi) { unsigned r; asm volatile("v_cvt_pk_bf16_f32 %0, %1, %2" : "=v"(r) : "v"(lo), "v"(hi)); return r; }
__device__ __forceinline__ float sigm(float x) { return __builtin_amdgcn_rcpf(1.f + __expf(-x)); }
struct EpiProjP {
    static constexpr bool PERM = true, AFTER_DRAIN = false;
    bf16_t* PM; bf16_t* G;
    __device__ __forceinline__ void operator()(const f32x4 (&acc)[2][2][4][2], const Unit& u, int wr, int wc, int fr, int fq) const {
        const int row0 = u.pm * BM + wr * 64 + fr;
        const bool sg = u.pn >= 12;
        bf16_t* base = sg ? G : PM; const int ld = sg ? 4096 : 3072; const int colt = (sg ? u.pn - 12 : u.pn) * BM;
        const int col0 = colt + wc * 32 + 8 * fq;
#pragma unroll
        for (int ai = 0; ai < 2; ++ai)
#pragma unroll
            for (int m = 0; m < 4; ++m) { bf16_t* rowp = base + (size_t)(row0 + ai * HALF + m * 16) * ld + col0;
#pragma unroll
                for (int bj = 0; bj < 2; ++bj) { f32x4 v0 = acc[ai][bj][m][0], v1 = acc[ai][bj][m][1];
                    if (sg) { v0[0] = sigm(v0[0]); v0[1] = sigm(v0[1]); v0[2] = sigm(v0[2]); v0[3] = sigm(v0[3]); v1[0] = sigm(v1[0]); v1[1] = sigm(v1[1]); v1[2] = sigm(v1[2]); v1[3] = sigm(v1[3]); }
                    u32x4 w; w.x = cvt_pk_bf16(v0[0], v0[1]); w.y = cvt_pk_bf16(v0[2], v0[3]); w.z = cvt_pk_bf16(v1[0], v1[1]); w.w = cvt_pk_bf16(v1[2], v1[3]);
                    *(u32x4*)(rowp + bj * HALF) = w; } }
    }
};
struct EpiRelu2P {
    static constexpr bool PERM = true, AFTER_DRAIN = false;
    bf16_t* O; int ldo; int pad;
    __device__ __forceinline__ void operator()(const f32x4 (&acc)[2][2][4][2], const Unit& u, int wr, int wc, int fr, int fq) const {
        const int row0 = u.pm * BM + wr * 64 + fr, col0 = u.pn * BM + wc * 32 + 8 * fq;
#pragma unroll
        for (int ai = 0; ai < 2; ++ai)
#pragma unroll
            for (int m = 0; m < 4; ++m) { bf16_t* rowp = O + (size_t)(row0 + ai * HALF + m * 16) * ldo + col0;
#pragma unroll
                for (int bj = 0; bj < 2; ++bj) { f32x4 v0 = acc[ai][bj][m][0], v1 = acc[ai][bj][m][1];
#pragma unroll
                    for (int j = 0; j < 4; ++j) { const float a = fmaxf(v0[j], 0.f), b = fmaxf(v1[j], 0.f); v0[j] = a * a; v1[j] = b * b; }
                    u32x4 w; w.x = cvt_pk_bf16(v0[0], v0[1]); w.y = cvt_pk_bf16(v0[2], v0[3]); w.z = cvt_pk_bf16(v1[0], v1[1]); w.w = cvt_pk_bf16(v1[2], v1[3]);
                    *(u32x4*)(rowp + bj * HALF) = w; } }
    }
};
struct EpiResidP {
    static constexpr bool PERM = false, AFTER_DRAIN = false;
    const float* base; float* out;
    __device__ __forceinline__ void operator()(const f32x4 (&acc)[2][2][4][2], const Unit& u, int wr, int wc, int fr, int fq) const {
        const int row0 = u.pm * BM + wr * 64 + fr, col0 = u.pn * BM + wc * 32 + 4 * fq;
#pragma unroll
        for (int ai = 0; ai < 2; ++ai)
#pragma unroll
            for (int m = 0; m < 4; ++m) { const size_t off = (size_t)(row0 + ai * HALF + m * 16) * 1024 + col0;
#pragma unroll
                for (int bj = 0; bj < 2; ++bj)
#pragma unroll
                    for (int n = 0; n < 2; ++n) { const f32x4 b = *(const f32x4*)(base + off + bj * HALF + n * 16); *(f32x4*)(out + off + bj * HALF + n * 16) = b + acc[ai][bj][m][n]; } }
    }
};
template <class Epi, class Sched, bool ALIGN_EPI = false, bool SP2 = false>
__device__ __forceinline__ void gemm_phase(PG8_LAS unsigned char* lds, const Gemm g, const Sched& S, const Epi& E) {
    int tid = threadIdx.x; asm volatile("" : "+v"(tid));
    const int wid = __builtin_amdgcn_readfirstlane(tid >> 6), lane = tid & 63, wr = wid >> 2, wc = wid & 3, fr = lane & 15, fq = lane >> 4;
    const int K = g.K, nt = K / BK;
    unsigned voffA[2], voffB[2];
#pragma unroll
    for (int i = 0; i < 2; ++i) { int R, C; stage_rc(tid * 16 + i * 8192, R, C); const int Rb = Epi::PERM ? ((R & ~31) + perm32(R & 31)) : R;
        voffA[i] = (unsigned)(R * g.lda + C) * 2u; voffB[i] = (unsigned)(Rb * g.ldb + C) * 2u; }
    const size_t kstep = (size_t)(BK * 2);
    const size_t hstepA = (size_t)HALF * g.lda * 2, hstepB = (size_t)HALF * g.ldb * 2;
    const size_t tstepA = 2 * hstepA, tstepB = 2 * hstepB;
    const unsigned ldsw = (unsigned)wid * 1024u;
    const int aoff = lds_byte(wr * 64 + fr, fq * 8), boff = lds_byte(wc * 32 + fr, fq * 8);
#define PG8_SA(b, h) (((b) * 2 + (h)) * HTB)
#define PG8_SB(b, h) ((4 + (b) * 2 + (h)) * HTB)
#define PG8_STAGE(bufoff, gbase, voff) do { _Pragma("unroll") for (int _i = 0; _i < 2; ++_i) \
        __builtin_amdgcn_global_load_lds((const unsigned*)((const char*)(gbase) + (voff)[_i]), (PG8_LAS unsigned*)(lds + (bufoff) + ldsw + _i * 8192), 16, 0, 0); } while (0)
#define PG8_LDA(dst, b, h) do { _Pragma("unroll") for (int m = 0; m < 4; ++m) _Pragma("unroll") for (int k = 0; k < 2; ++k) dst[m][k] = *(const PG8_LAS bf16x8*)(lds + PG8_SA(b, h) + aoff + m * 2048 + k * 1024); } while (0)
#define PG8_LDB(dst, b, h) do { _Pragma("unroll") for (int n = 0; n < 2; ++n) _Pragma("unroll") for (int k = 0; k < 2; ++k) dst[n][k] = *(const PG8_LAS bf16x8*)(lds + PG8_SB(b, h) + boff + n * 2048 + k * 1024); } while (0)
#define PG8_MMA(ai, bj, At, Bt) do { __builtin_amdgcn_s_setprio(1); _Pragma("unroll") for (int m = 0; m < 4; ++m) _Pragma("unroll") for (int n = 0; n < 2; ++n) _Pragma("unroll") for (int k = 0; k < 2; ++k) \
        acc[ai][bj][m][n] = __builtin_amdgcn_mfma_f32_16x16x32_bf16(Bt[n][k], At[m][k], acc[ai][bj][m][n], 0, 0, 0); __builtin_amdgcn_s_setprio(0); } while (0)
#define PG8_WAIT_V(n) asm volatile("s_waitcnt vmcnt(" #n ")" ::: "memory")
#define PG8_WAIT_L(n) asm volatile("s_waitcnt lgkmcnt(" #n ")" ::: "memory")
#define PG8_BAR __builtin_amdgcn_s_barrier()
#define PG8_SCHED __builtin_amdgcn_sched_barrier(0)
    Unit cur, nxt; int ui = 0;
    if (!S.next(0, cur)) return;
    f32x4 acc[2][2][4][2];
#pragma unroll
    for (int a = 0; a < 2; ++a)
#pragma unroll
        for (int b = 0; b < 2; ++b)
#pragma unroll
            for (int m = 0; m < 4; ++m)
#pragma unroll
                for (int n = 0; n < 2; ++n) acc[a][b][m][n] = (f32x4){0.f, 0.f, 0.f, 0.f};
    bf16x8 At[4][2], B0[2][2], B1[2][2];
    const char* cA = (const char*)g.A + (size_t)cur.pm * tstepA; const char* cB = (const char*)g.Bt + (size_t)cur.pn * tstepB;
    S.a_ready(cur);
    if constexpr (SP2) {
        PG8_STAGE(PG8_SB(0, 0), cB, voffB); PG8_STAGE(PG8_SB(0, 1), cB + hstepB, voffB); PG8_STAGE(PG8_SA(0, 0), cA, voffA); PG8_STAGE(PG8_SA(0, 1), cA + hstepA, voffA);
        if (wr == 1) PG8_BAR;
        PG8_WAIT_V(2); PG8_BAR;
        PG8_STAGE(PG8_SB(1, 0), cB + kstep, voffB); PG8_STAGE(PG8_SA(1, 0), cA + kstep, voffA); PG8_STAGE(PG8_SB(1, 1), cB + hstepB + kstep, voffB);
        PG8_WAIT_V(6); PG8_BAR;
    } else {
        PG8_STAGE(PG8_SB(0, 0), cB, voffB); PG8_STAGE(PG8_SA(0, 0), cA, voffA); PG8_STAGE(PG8_SB(0, 1), cB + hstepB, voffB); PG8_STAGE(PG8_SA(0, 1), cA + hstepA, voffA);
        if (wr == 1) PG8_BAR;
        PG8_WAIT_V(4); PG8_BAR;
        PG8_STAGE(PG8_SB(1, 0), cB + kstep, voffB); PG8_STAGE(PG8_SA(1, 0), cA + kstep, voffA); PG8_STAGE(PG8_SB(1, 1), cB + hstepB + kstep, voffB);
        PG8_WAIT_V(6); PG8_BAR;
    }
    for (;;) {
        const bool has_next = S.next(ui + 1, nxt);
        const char* nA = has_next ? (const char*)g.A + (size_t)nxt.pm * tstepA : cA; const char* nB = has_next ? (const char*)g.Bt + (size_t)nxt.pn * tstepB : cB;
        for (int t = 0; t < nt; t += 2) {
            const bool last = (t == nt - 2);
            const char* a1 = cA + (size_t)(t + 1) * kstep;
            const char* a2 = last ? nA : cA + (size_t)(t + 2) * kstep; const char* b2 = last ? nB : cB + (size_t)(t + 2) * kstep;
            const char* a3 = a2 + kstep; const char* b3 = b2 + kstep;
            if (last && has_next) S.a_ready(nxt);
            if constexpr (SP2) {
            PG8_LDB(B0, 0, 0); PG8_LDB(B1, 0, 1); PG8_SCHED; PG8_LDA(At, 0, 0); PG8_STAGE(PG8_SA(1, 1), a1 + hstepA, voffA);
            PG8_WAIT_V(8); PG8_WAIT_L(0); PG8_BAR; PG8_MMA(0, 0, At, B0); PG8_MMA(0, 1, At, B1); PG8_BAR; PG8_SCHED;
            PG8_LDA(At, 0, 1); PG8_STAGE(PG8_SB(0, 0), b2, voffB); PG8_STAGE(PG8_SB(0, 1), b2 + hstepB, voffB); PG8_STAGE(PG8_SA(0, 0), a2, voffA);
            PG8_WAIT_V(8); PG8_WAIT_L(0); PG8_BAR; PG8_MMA(1, 0, At, B0); PG8_MMA(1, 1, At, B1); PG8_BAR; PG8_SCHED;
            PG8_LDB(B0, 1, 0); PG8_LDB(B1, 1, 1); PG8_SCHED; PG8_LDA(At, 1, 0); PG8_STAGE(PG8_SA(0, 1), a2 + hstepA, voffA);
            PG8_WAIT_V(8); PG8_WAIT_L(0); PG8_BAR; PG8_MMA(0, 0, At, B0); PG8_MMA(0, 1, At, B1); PG8_BAR; PG8_SCHED;
            PG8_LDA(At, 1, 1); PG8_STAGE(PG8_SB(1, 0), b3, voffB); PG8_STAGE(PG8_SB(1, 1), b3 + hstepB, voffB); PG8_STAGE(PG8_SA(1, 0), a3, voffA);
            PG8_WAIT_V(8); PG8_WAIT_L(0); PG8_BAR; PG8_MMA(1, 0, At, B0); PG8_MMA(1, 1, At, B1); PG8_BAR; PG8_SCHED;
            } else {
            PG8_LDB(B0, 0, 0); PG8_SCHED; PG8_LDA(At, 0, 0); PG8_STAGE(PG8_SA(1, 1), a1 + hstepA, voffA);
            PG8_WAIT_L(8); PG8_BAR; PG8_WAIT_L(0); PG8_MMA(0, 0, At, B0); PG8_BAR; PG8_SCHED;
            PG8_LDB(B1, 0, 1); PG8_STAGE(PG8_SB(0, 0), b2, voffB);
            PG8_BAR; PG8_WAIT_L(0); PG8_MMA(0, 1, At, B1); PG8_BAR;
            PG8_LDA(At, 0, 1); PG8_STAGE(PG8_SA(0, 0), a2, voffA);
            PG8_BAR; PG8_WAIT_L(0); PG8_MMA(1, 0, At, B0); PG8_BAR; PG8_SCHED;
            PG8_STAGE(PG8_SB(0, 1), b2 + hstepB, voffB);
            PG8_WAIT_V(6); PG8_BAR; PG8_MMA(1, 1, At, B1); PG8_BAR;
            PG8_LDB(B0, 1, 0); PG8_SCHED; PG8_LDA(At, 1, 0); PG8_STAGE(PG8_SA(0, 1), a2 + hstepA, voffA);
            PG8_WAIT_L(8); PG8_BAR; PG8_WAIT_L(0); PG8_MMA(0, 0, At, B0); PG8_BAR; PG8_SCHED;
            PG8_LDB(B1, 1, 1); PG8_STAGE(PG8_SB(1, 0), b3, voffB);
            PG8_BAR; PG8_WAIT_L(0); PG8_MMA(0, 1, At, B1); PG8_BAR;
            PG8_LDA(At, 1, 1); PG8_STAGE(PG8_SA(1, 0), a3, voffA);
            PG8_BAR; PG8_WAIT_L(0); PG8_MMA(1, 0, At, B0); PG8_BAR; PG8_SCHED;
            PG8_STAGE(PG8_SB(1, 1), b3 + hstepB, voffB);
            PG8_WAIT_V(6); PG8_BAR; PG8_MMA(1, 1, At, B1); PG8_BAR;
            }
        }
        if constexpr (ALIGN_EPI) { if (wr == 0) PG8_BAR; }
        if constexpr (!Epi::AFTER_DRAIN) { E(acc, cur, wr, wc, fr, fq); S.done(cur); }
        if (!has_next) break;
#pragma unroll
        for (int a = 0; a < 2; ++a)
#pragma unroll
            for (int b = 0; b < 2; ++b)
#pragma unroll
                for (int m = 0; m < 4; ++m)
#pragma unroll
                    for (int n = 0; n < 2; ++n) acc[a][b][m][n] = (f32x4){0.f, 0.f, 0.f, 0.f};
        cur = nxt; cA = nA; cB = nB; ++ui;
        if constexpr (ALIGN_EPI) { if (wr == 1) PG8_BAR; }
    }
    PG8_WAIT_V(0);
    if constexpr (!ALIGN_EPI) { if (wr == 0) PG8_BAR; }
    PG8_BAR;
    if constexpr (Epi::AFTER_DRAIN) { E.fused(acc, cur, wr, wc, fr, fq, lds, wid, lane); S.done(cur); }
#undef PG8_SA
#undef PG8_SB
#undef PG8_STAGE
#undef PG8_LDA
#undef PG8_LDB
#undef PG8_MMA
#undef PG8_WAIT_V
#undef PG8_WAIT_L
#undef PG8_BAR
#undef PG8_SCHED
}
}


__device__ __forceinline__ unsigned pk2(float lo, float hi) { return f2bf(lo) | (f2bf(hi) << 16); }
template <class CM>
__device__ __forceinline__ void transpose_item(const float* __restrict__ Wsrc, int K, int ldsrc, bf16_t* __restrict__ WT, int nblk, LAS float* scr, int item, int lane, CM colmap) {
    const int kb = item / nblk, nb = item % nblk, k0 = 64 * kb, n0 = 32 * nb;
    const int sc = colmap(n0 + (lane & 31));
#pragma unroll 8
    for (int i = 0; i < 32; ++i) { const int kk = 2 * i + (lane >> 5); scr[kk * 33 + (lane & 31)] = sc >= 0 ? Wsrc[(size_t)(k0 + kk) * ldsrc + sc] : 0.f; }
    asm volatile("s_waitcnt lgkmcnt(0)" ::: "memory");
    const int c = lane & 7;
#pragma unroll
    for (int j = 0; j < 4; ++j) { const int n = (lane >> 3) + 8 * j; const LAS float* s = scr + (8 * c) * 33 + n;
        uint4 o; o.x = pk2(s[0 * 33], s[1 * 33]); o.y = pk2(s[2 * 33], s[3 * 33]); o.z = pk2(s[4 * 33], s[5 * 33]); o.w = pk2(s[6 * 33], s[7 * 33]);
        *(uint4*)(WT + (size_t)(n0 + n) * K + k0 + 8 * c) = o; }
    asm volatile("s_waitcnt lgkmcnt(0)" ::: "memory");
}
constexpr size_t WO_IN = 0;
constexpr size_t WO_BR = WO_IN + (size_t)7168 * 1024;
constexpr size_t WO_OUT = WO_BR + (size_t)4 * 1024 * 256;
constexpr size_t WO_W1 = WO_OUT + (size_t)1024 * 1024;
constexpr size_t WO_W2 = WO_W1 + (size_t)4096 * 1024;
constexpr size_t WO_WUP = WO_W2 + (size_t)4096 * 1024;
constexpr size_t WO_AUP = WO_WUP + 256 * 64;
constexpr size_t WO_GUP = WO_AUP + 256 * 64;
constexpr size_t WO_GLU = WO_GUP + 256 * 128;
constexpr size_t WO_LWT = WO_GLU + 256 * 256;
constexpr size_t WO_LAYER = WO_LWT + 2 * 16384;
__device__ __forceinline__ void convert_weights(const Params& p, int l, LAS float* scr, int gw, int ngw, int lane) {
    bf16_t* WB = (bf16_t*)(p.ws() + WS_W);
    constexpr int I_IN = (1024 / 64) * (7168 / 32), I_BR = (256 / 64) * (1024 / 32), I_OUT = (1024 / 64) * (1024 / 32), I_W1 = (1024 / 64) * (4096 / 32), I_W2 = (4096 / 64) * (1024 / 32);
    constexpr int I_UP = 8, I_GUP = 16, I_GLU = 4 * 8, I_LW = 16;
    constexpr int PER_LAYER = I_IN + 4 * I_BR + I_OUT + I_W1 + I_W2 + 2 * I_UP + I_GUP + I_GLU + I_LW;
    for (int it = gw; it < PER_LAYER; it += ngw) {
        int r = it;
        bf16_t* WL = WB;
        if (r < I_IN) { transpose_item(p.in[2] + (size_t)l * D * DIN, 1024, DIN, WL + WO_IN, 7168 / 32, scr, r, lane, [](int j) { return j < NMIX ? j : (j < 3072 ? -1 : j - 248); }); continue; } r -= I_IN;
        if (r < 4 * I_BR) { const int i = r / I_BR; transpose_item(p.in[35] + ((size_t)l * 4 + i) * W * D, 256, D, WL + WO_BR + (size_t)i * 1024 * 256, 1024 / 32, scr, r % I_BR, lane, [](int j) { return j; }); continue; } r -= 4 * I_BR;
        if (r < I_OUT) { transpose_item(p.in[36] + (size_t)l * D * D, 1024, D, WL + WO_OUT, 1024 / 32, scr, r, lane, [](int j) { return j; }); continue; } r -= I_OUT;
        if (r < I_W1) { transpose_item(p.in[38] + (size_t)l * D * DFF, 1024, DFF, WL + WO_W1, 4096 / 32, scr, r, lane, [](int j) { return j; }); continue; } r -= I_W1;
        if (r < I_W2) { transpose_item(p.in[39] + (size_t)l * DFF * D, 4096, D, WL + WO_W2, 1024 / 32, scr, r, lane, [](int j) { return j; }); continue; } r -= I_W2;
        if (r < I_UP) { transpose_item(p.in[26] + (size_t)l * 64 * W, 64, W, WL + WO_WUP, 8, scr, r, lane, [](int j) { return j; }); continue; } r -= I_UP;
        if (r < I_UP) { transpose_item(p.in[28] + (size_t)l * 64 * W, 64, W, WL + WO_AUP, 8, scr, r, lane, [](int j) { return j; }); continue; } r -= I_UP;
        if (r < I_GUP) { transpose_item(p.in[29] + (size_t)l * 128 * W, 128, W, WL + WO_GUP, 8, scr, r, lane, [](int j) { return j; }); continue; } r -= I_GUP;
        if (r < I_GLU) { transpose_item(p.in[22] + (size_t)l * W * W, 256, W, WL + WO_GLU, 8, scr, r, lane, [](int j) { return j; }); continue; } r -= I_GLU;
        { const int gt = r >> 3, nb = (r >> 1) & 3; transpose_item((gt ? p.in[11] : p.in[9]) + (size_t)l * 16384 + nb * 4096, 64, 64, WL + WO_LWT + (size_t)gt * 16384 + nb * 4096, 2, scr, r & 1, lane, [](int j) { return j; }); }
    }
}
typedef short bf16x8_t __attribute__((ext_vector_type(8)));
typedef float f32x4_t __attribute__((ext_vector_type(4)));
constexpr int PT = 68;
constexpr int MS = 64 * PT;
__device__ __forceinline__ unsigned cvtpk(float lo, float hi) { unsigned r; asm volatile("v_cvt_pk_bf16_f32 %0, %1, %2" : "=v"(r) : "v"(lo), "v"(hi)); return r; }
typedef unsigned u32x4_t __attribute__((ext_vector_type(4)));
union U8 { bf16x8_t v; unsigned u[4]; uint4 q; u32x4_t x; };
__device__ __forceinline__ void split8(const float (&x)[8], bf16x8_t& hi, bf16x8_t& lo) {
    U8 H, L;
#pragma unroll
    for (int i = 0; i < 4; ++i) {
        const unsigned pk = cvtpk(x[2 * i], x[2 * i + 1]);
        H.u[i] = pk;
        const float f0 = __uint_as_float(pk << 16), f1 = __uint_as_float(pk & 0xffff0000u);
        L.u[i] = cvtpk(x[2 * i] - f0, x[2 * i + 1] - f1);
    }
    hi = H.v; lo = L.v;
}
__device__ __forceinline__ bf16x8_t hi8(const float (&x)[8]) {
    U8 H;
#pragma unroll
    for (int i = 0; i < 4; ++i) H.u[i] = cvtpk(x[2 * i], x[2 * i + 1]);
    return H.v;
}
template <int NSPLIT>
__device__ __forceinline__ f32x4_t mm_tile(const LAS float* A, const LAS float* Bt, int lane, f32x4_t acc) {
    const LAS float* ap = A + (lane & 15) * PT + 8 * (lane >> 4);
    const LAS float* bp = Bt + (lane & 15) * PT + 8 * (lane >> 4);
#pragma unroll
    for (int ks = 0; ks < 2; ++ks) {
        const f32x4_t a0 = *(const LAS f32x4_t*)(ap + 32 * ks), a1 = *(const LAS f32x4_t*)(ap + 32 * ks + 4);
        const f32x4_t b0 = *(const LAS f32x4_t*)(bp + 32 * ks), b1 = *(const LAS f32x4_t*)(bp + 32 * ks + 4);
        const float av[8] = {a0.x, a0.y, a0.z, a0.w, a1.x, a1.y, a1.z, a1.w};
        const float bv[8] = {b0.x, b0.y, b0.z, b0.w, b1.x, b1.y, b1.z, b1.w};
        if constexpr (NSPLIT == 3) {
            bf16x8_t ah, al, bh, bl; split8(av, ah, al); split8(bv, bh, bl);
            acc = __builtin_amdgcn_mfma_f32_16x16x32_bf16(ah, bh, acc, 0, 0, 0);
            acc = __builtin_amdgcn_mfma_f32_16x16x32_bf16(ah, bl, acc, 0, 0, 0);
            acc = __builtin_amdgcn_mfma_f32_16x16x32_bf16(al, bh, acc, 0, 0, 0);
        } else {
            acc = __builtin_amdgcn_mfma_f32_16x16x32_bf16(hi8(av), hi8(bv), acc, 0, 0, 0);
        }
    }
    return acc;
}
__device__ __forceinline__ int opq_tid() { int t = threadIdx.x; asm volatile("" : "+v"(t)); return t; }
__device__ __forceinline__ void tri_inverse_wave(LAS float* L, int lane) {
    asm volatile("" : "+v"(lane));
    asm volatile("" : "+v"(L));
    const float lf = (float)lane;
    float x[64];
#pragma unroll
    for (int i = 0; i < 64; ++i) {
        float s0 = 0.f, s1 = 0.f, s2 = 0.f, s3 = 0.f;
#pragma unroll
        for (int g4 = 0; g4 * 4 < i; ++g4) {
            const f32x4_t l = *(const LAS f32x4_t*)(L + i * PT + 4 * g4);
            s0 = fmaf(l.x, x[4 * g4], s0);
            if (4 * g4 + 1 < i) s1 = fmaf(l.y, x[4 * g4 + 1], s1);
            if (4 * g4 + 2 < i) s2 = fmaf(l.z, x[4 * g4 + 2], s2);
            if (4 * g4 + 3 < i) s3 = fmaf(l.w, x[4 * g4 + 3], s3);
        }
        x[i] = fmaxf(1.f - fabsf(lf - (float)i), 0.f) - ((s0 + s1) + (s2 + s3));
        L[i * PT + lane] = x[i];
        if ((i & 3) == 3) __builtin_amdgcn_sched_barrier(0);
    }
}
__device__ __forceinline__ float wave_incl_scan(float v, int lane) {
#pragma unroll
    for (int o = 1; o < 64; o <<= 1) { const float u = __shfl_up(v, o); if (lane >= o) v += u; }
    return v;
}

__device__ __forceinline__ void merge_phase(const bf16_t* __restrict__ Yb, const bf16_t* __restrict__ WbT, const bf16_t* __restrict__ G, bf16_t* __restrict__ MG, LAS unsigned char* lds) {
    const int tid = opq_tid(), w = __builtin_amdgcn_readfirstlane(tid >> 6), lane = tid & 63, q4 = lane >> 4, cc = lane & 15;
    const int wr = w >> 2, wc = w & 3;
    constexpr int PA = 144;
    constexpr int ABUF = 256 * PA, BBUF = 128 * PA, BUF = ABUF + BBUF;
    const int bid = blockIdx.x, G_ = gridDim.x;
    const int arow = tid >> 1, ahalf = tid & 1;
    const int brow = tid >> 2, bq = tid & 3;
    for (int it = 0; ; ++it) {
        const int U = it * G_ + bid;
        if (U >= 512) break;
        const int Lx = (G_ == 256) ? ((bid & 7) * 64 + it * 32 + (bid >> 3)) : U;
        const int pm = Lx >> 3, pn = Lx & 7;
        const bf16_t* Abase = Yb + (size_t)(pm * 256 + arow) * 1024 + ahalf * 32;
        const bf16_t* Bbase = WbT + (size_t)(pn * 128 + brow) * 256 + bq * 16;
        f32x4_t mg[8][2];
#pragma unroll
        for (int m = 0; m < 8; ++m)
#pragma unroll
            for (int n = 0; n < 2; ++n) mg[m][n] = (f32x4_t){0.f, 0.f, 0.f, 0.f};
        uint4 sa[4], sb[2];
#define MERGE_LOAD(s_) do { const int br_ = (s_) >> 2, kq_ = (s_) & 3; const bf16_t* ap_ = Abase + br_ * 256 + kq_ * 64; const bf16_t* bp_ = Bbase + (size_t)br_ * 1024 * 256 + kq_ * 64; \
            _Pragma("unroll") for (int j = 0; j < 4; ++j) sa[j] = *(const uint4*)(ap_ + 8 * j); \
            _Pragma("unroll") for (int j = 0; j < 2; ++j) sb[j] = *(const uint4*)(bp_ + 8 * j); } while (0)
#define MERGE_STORE(buf_) do { LAS unsigned char* ab_ = lds + (buf_) * BUF + arow * PA + ahalf * 64; LAS unsigned char* bb_ = lds + (buf_) * BUF + ABUF + brow * PA + bq * 32; \
            _Pragma("unroll") for (int j = 0; j < 4; ++j) *(LAS u32x4_t*)(ab_ + 16 * j) = (u32x4_t){sa[j].x, sa[j].y, sa[j].z, sa[j].w}; \
            _Pragma("unroll") for (int j = 0; j < 2; ++j) *(LAS u32x4_t*)(bb_ + 16 * j) = (u32x4_t){sb[j].x, sb[j].y, sb[j].z, sb[j].w}; } while (0)
        MERGE_LOAD(0);
        MERGE_STORE(0);
        __syncthreads();
        f32x4_t acc[8][2];
#pragma unroll 1
        for (int s = 0; s < 16; ++s) {
            const int buf = s & 1;
            if ((s & 3) == 0) {
#pragma unroll
                for (int m = 0; m < 8; ++m)
#pragma unroll
                    for (int n = 0; n < 2; ++n) acc[m][n] = (f32x4_t){0.f, 0.f, 0.f, 0.f};
            }
            if (s + 1 < 16) MERGE_LOAD(s + 1);
            {
                const LAS unsigned char* ab = lds + buf * BUF + (wr * 128 + cc) * PA + 16 * q4;
                const LAS unsigned char* bb = lds + buf * BUF + ABUF + (wc * 32 + cc) * PA + 16 * q4;
#pragma unroll
                for (int ks = 0; ks < 2; ++ks) {
                    U8 bf[2];
#pragma unroll
                    for (int n = 0; n < 2; ++n) bf[n].x = *(const LAS u32x4_t*)(bb + n * 16 * PA + ks * 64);
#pragma unroll
                    for (int m = 0; m < 8; ++m) {
                        U8 af; af.x = *(const LAS u32x4_t*)(ab + m * 16 * PA + ks * 64);
#pragma unroll
                        for (int n = 0; n < 2; ++n) acc[m][n] = __builtin_amdgcn_mfma_f32_16x16x32_bf16(bf[n].v, af.v, acc[m][n], 0, 0, 0);
                    }
                }
            }
            if ((s & 3) == 3) {
                const int br = s >> 2;
                const bf16_t* gp = G + (size_t)(pm * 256 + wr * 128 + cc) * 4096 + br * 1024 + pn * 128 + wc * 32 + 4 * q4;
#pragma unroll
                for (int m = 0; m < 8; ++m)
#pragma unroll
                    for (int n = 0; n < 2; ++n) {
                        const uint2 g2 = *(const uint2*)(gp + (size_t)m * 16 * 4096 + n * 16);
                        mg[m][n][0] = fmaf(__uint_as_float(g2.x << 16), acc[m][n][0], mg[m][n][0]);
                        mg[m][n][1] = fmaf(__uint_as_float(g2.x & 0xffff0000u), acc[m][n][1], mg[m][n][1]);
                        mg[m][n][2] = fmaf(__uint_as_float(g2.y << 16), acc[m][n][2], mg[m][n][2]);
                        mg[m][n][3] = fmaf(__uint_as_float(g2.y & 0xffff0000u), acc[m][n][3], mg[m][n][3]);
                    }
            }
            if (s + 1 < 16) MERGE_STORE(buf ^ 1);
            __syncthreads();
        }
        {
            bf16_t* op = MG + (size_t)(pm * 256 + wr * 128 + cc) * 1024 + pn * 128 + wc * 32 + 4 * q4;
#pragma unroll
            for (int m = 0; m < 8; ++m)
#pragma unroll
                for (int n = 0; n < 2; ++n) *(uint2*)(op + (size_t)m * 16 * 1024 + n * 16) = make_uint2(cvtpk(mg[m][n][0], mg[m][n][1]), cvtpk(mg[m][n][2], mg[m][n][3]));
        }
#undef MERGE_LOAD
#undef MERGE_STORE
    }
}

struct GdnBufs { bf16_t *GQ, *GK, *GV; float *GB, *GC; uint4* MF; float* NF; float* HT; };
__device__ __forceinline__ void gdn_prep_chunk(const bf16_t* __restrict__ PM, int n, const GdnBufs& B, const Params& p, int l, LAS float* lds) {
    const int tid = opq_tid(), w = tid >> 6, lane = tid & 63;
    const float* conv_w = p.in[3] + l * 4 * 768;
    const int t0 = n * 64;
    float wq[4][4], wk[4][4], wv[4][4];
#pragma unroll
    for (int t = 0; t < 4; ++t)
#pragma unroll
        for (int j = 0; j < 4; ++j) { wq[t][j] = conv_w[t * 768 + 4 * lane + j]; wk[t][j] = conv_w[t * 768 + 256 + 4 * lane + j]; wv[t][j] = conv_w[t * 768 + 512 + 4 * lane + j]; }
    float hq[3][4], hk[3][4], hv[3][4];
    auto ld4 = [&](int t, int col, float (&o)[4]) {
        if (t < 0) { o[0] = o[1] = o[2] = o[3] = 0.f; return; }
        const uint2 u = *(const uint2*)(PM + (size_t)t * PMLD + col);
        o[0] = __uint_as_float(u.x << 16); o[1] = __uint_as_float(u.x & 0xffff0000u); o[2] = __uint_as_float(u.y << 16); o[3] = __uint_as_float(u.y & 0xffff0000u);
    };
    const int tw = t0 + 8 * w;
#pragma unroll
    for (int i = 0; i < 3; ++i) { ld4(tw - 3 + i, 4 * lane, hq[i]); ld4(tw - 3 + i, 256 + 4 * lane, hk[i]); ld4(tw - 3 + i, 512 + 4 * lane, hv[i]); }
    for (int i = 0; i < 8; ++i) {
        const int t = tw + i;
        float pq[4], pk[4], pv[4], q[4], k[4], v[4];
        ld4(t, 4 * lane, pq); ld4(t, 256 + 4 * lane, pk); ld4(t, 512 + 4 * lane, pv);
        float sq = 0.f, sk = 0.f;
#pragma unroll
        for (int j = 0; j < 4; ++j) {
            q[j] = siluf_(wq[0][j] * hq[0][j] + wq[1][j] * hq[1][j] + wq[2][j] * hq[2][j] + wq[3][j] * pq[j]);
            k[j] = siluf_(wk[0][j] * hk[0][j] + wk[1][j] * hk[1][j] + wk[2][j] * hk[2][j] + wk[3][j] * pk[j]);
            v[j] = siluf_(wv[0][j] * hv[0][j] + wv[1][j] * hv[1][j] + wv[2][j] * hv[2][j] + wv[3][j] * pv[j]);
            hq[0][j] = hq[1][j]; hq[1][j] = hq[2][j]; hq[2][j] = pq[j];
            hk[0][j] = hk[1][j]; hk[1][j] = hk[2][j]; hk[2][j] = pk[j];
            hv[0][j] = hv[1][j]; hv[1][j] = hv[2][j]; hv[2][j] = pv[j];
            sq = fmaf(q[j], q[j], sq); sk = fmaf(k[j], k[j], sk);
        }
#pragma unroll
        for (int o = 1; o < 16; o <<= 1) { sq += __shfl_xor(sq, o); sk += __shfl_xor(sk, o); }
        const float rq = rsqrtf(sq + 1e-6f) * 0.125f, rk = rsqrtf(sk + 1e-6f);
        uint2 oq, ok, ov;
        oq.x = cvtpk(q[0] * rq, q[1] * rq); oq.y = cvtpk(q[2] * rq, q[3] * rq);
        ok.x = cvtpk(k[0] * rk, k[1] * rk); ok.y = cvtpk(k[2] * rk, k[3] * rk);
        ov.x = cvtpk(v[0], v[1]); ov.y = cvtpk(v[2], v[3]);
        *(uint2*)(B.GQ + (size_t)t * 256 + 4 * lane) = oq;
        *(uint2*)(B.GK + (size_t)t * 256 + 4 * lane) = ok;
        *(uint2*)(B.GV + (size_t)t * 256 + 4 * lane) = ov;
    }
    if (tid < 256) {
        const int t = tid >> 2, h = tid & 3;
        const bf16_t* row = PM + (size_t)(t0 + t) * PMLD;
        B.GB[(size_t)(t0 + t) * 4 + h] = sigmoidf_(bf2f(row[1024 + h]));
        const float g = -expf(p.in[4][l * 4 + h]) * softplusf_(bf2f(row[1028 + h]) + p.in[5][l * 4 + h]);
        lds[h * 64 + t] = g;
    }
    __syncthreads();
    if (w == 0) {
#pragma unroll
        for (int h = 0; h < 4; ++h) B.GC[(size_t)(t0 + lane) * 4 + h] = wave_incl_scan(lds[h * 64 + lane], lane);
    }
    __syncthreads();
}

__device__ __forceinline__ void gdn_g1_unit(int h, int n, const GdnBufs& B, LAS float* lds) {
    const int tid = opq_tid(), w = tid >> 6, lane = tid & 63, q4 = lane >> 4, cc = lane & 15;
    LAS float* Kr = lds; LAS float* KdT = lds + MS; LAS float* KbT = lds + 2 * MS; LAS float* VbT = lds + 3 * MS; LAS float* Lm = lds + 4 * MS; LAS float* WmT = lds + 5 * MS;
    LAS float* U0T = Kr;
    LAS float* sb = lds + 6 * MS; LAS float* sg = sb + 64;
    const int t0 = n * 64, u = h * 256 + n;
    {
        const int c = tid >> 3, d0 = (tid & 7) * 8;
        const float beta = B.GB[(size_t)(t0 + c) * 4 + h], gc = B.GC[(size_t)(t0 + c) * 4 + h], gl = B.GC[(size_t)(t0 + 63) * 4 + h];
        const uint4 k8 = *(const uint4*)(B.GK + (size_t)(t0 + c) * 256 + h * 64 + d0);
        const uint4 v8 = *(const uint4*)(B.GV + (size_t)(t0 + c) * 256 + h * 64 + d0);
        const float e1 = expf(gl - gc), e2 = beta * expf(gc);
        const unsigned ku[4] = {k8.x, k8.y, k8.z, k8.w}, vu[4] = {v8.x, v8.y, v8.z, v8.w};
#pragma unroll
        for (int i = 0; i < 8; ++i) {
            const float kf = __uint_as_float((i & 1) ? (ku[i >> 1] & 0xffff0000u) : (ku[i >> 1] << 16));
            const float vf = __uint_as_float((i & 1) ? (vu[i >> 1] & 0xffff0000u) : (vu[i >> 1] << 16));
            Kr[c * PT + d0 + i] = kf; KdT[(d0 + i) * PT + c] = kf * e1; KbT[(d0 + i) * PT + c] = kf * e2; VbT[(d0 + i) * PT + c] = beta * vf;
        }
        if ((tid & 7) == 0) { sb[c] = beta; sg[c] = gc; }
    }
    __syncthreads();
    const int ti = w >> 1, tj0 = (w & 1) * 2;
    const f32x4_t zero4 = {0.f, 0.f, 0.f, 0.f};
#pragma unroll
    for (int tt = 0; tt < 2; ++tt) {
        const int tj = tj0 + tt;
        if (tj <= ti) {
            const f32x4_t a = mm_tile<3>(Kr + 16 * ti * PT, Kr + 16 * tj * PT, lane, zero4);
            const int j = 16 * tj + cc; const float gj = sg[j];
#pragma unroll
            for (int r = 0; r < 4; ++r) { const int i = 16 * ti + 4 * q4 + r; Lm[i * PT + j] = (i > j) ? sb[i] * a[r] * expf(sg[i] - gj) : 0.f; }
        }
    }
    __syncthreads();
    if (w == 0) tri_inverse_wave(Lm, lane);
    __syncthreads();
#pragma unroll
    for (int tt = 0; tt < 2; ++tt) {
        const int tj = tj0 + tt;
        const f32x4_t a = mm_tile<3>(Lm + 16 * ti * PT, VbT + 16 * tj * PT, lane, zero4);
        *(LAS f32x4_t*)(U0T + (16 * tj + cc) * PT + 16 * ti + 4 * q4) = (f32x4_t){a[0], a[1], a[2], a[3]};
        const f32x4_t b = mm_tile<3>(Lm + 16 * ti * PT, KbT + 16 * tj * PT, lane, zero4);
        *(LAS f32x4_t*)(WmT + (16 * tj + cc) * PT + 16 * ti + 4 * q4) = (f32x4_t){b[0], b[1], b[2], b[3]};
    }
    __syncthreads();
    {
        const float egl = expf(B.GC[(size_t)(t0 + 63) * 4 + h]);
#pragma unroll
        for (int tt = 0; tt < 2; ++tt) {
            const int tj = tj0 + tt;
            const f32x4_t a = mm_tile<3>(KdT + 16 * ti * PT, WmT + 16 * tj * PT, lane, zero4);
#pragma unroll
            for (int r = 0; r < 4; ++r) { const int ar = 16 * ti + 4 * q4 + r, bc = 16 * tj + cc; Lm[ar * PT + bc] = (ar == bc ? egl : 0.f) - a[r]; }
            const f32x4_t nn = mm_tile<3>(KdT + 16 * ti * PT, U0T + 16 * tj * PT, lane, zero4);
            *(float4*)(B.NF + (size_t)u * 4096 + (tj * 64 + lane) * 16 + ti * 4) = make_float4(nn[0], nn[1], nn[2], nn[3]);
        }
    }
    __syncthreads();
    {
        const int combo = tid >> 6, mt = combo >> 1, s = combo & 1, i = lane & 15, qq = lane >> 4;
        const f32x4_t x0 = *(const LAS f32x4_t*)(Lm + (16 * mt + i) * PT + 32 * s + 4 * qq);
        const f32x4_t x1 = *(const LAS f32x4_t*)(Lm + (16 * mt + i) * PT + 32 * s + 16 + 4 * qq);
        const float xv[8] = {x0.x, x0.y, x0.z, x0.w, x1.x, x1.y, x1.z, x1.w};
        U8 H, L; split8(xv, H.v, L.v);
        uint4* mf = B.MF + (size_t)u * 1024 + (size_t)(combo * 2) * 64 + lane;
        mf[0] = H.q; mf[64] = L.q;
    }
    __syncthreads();
}

__device__ __forceinline__ void chain_wave(const uint4* __restrict__ MF, const float* __restrict__ NF, float* __restrict__ HT, int cb, int nchunk, int lane) {
    const int q4 = lane >> 4, cc = lane & 15;
    f32x4_t H[4];
#pragma unroll
    for (int m = 0; m < 4; ++m) H[m] = (f32x4_t){0.f, 0.f, 0.f, 0.f};
    uint4 mcur[16]; float4 ncur[4];
#pragma unroll
    for (int i = 0; i < 16; ++i) mcur[i] = MF[(size_t)i * 64 + lane];
#pragma unroll
    for (int m = 0; m < 4; ++m) ncur[m] = *(const float4*)(NF + (cb * 64 + lane) * 16 + m * 4);
    for (int ch = 0; ch < nchunk; ++ch) {
        uint4 mnx[16]; float4 nnx[4];
        const int chn = ch + 1 < nchunk ? ch + 1 : ch;
#pragma unroll
        for (int i = 0; i < 16; ++i) mnx[i] = MF[(size_t)chn * 1024 + (size_t)i * 64 + lane];
#pragma unroll
        for (int m = 0; m < 4; ++m) nnx[m] = *(const float4*)(NF + (size_t)chn * 4096 + (cb * 64 + lane) * 16 + m * 4);
        float* ht = HT + (size_t)ch * 4096 + (16 * cb + cc) * 64 + 4 * q4;
#pragma unroll
        for (int m = 0; m < 4; ++m) *(float4*)(ht + 16 * m) = make_float4(H[m][0], H[m][1], H[m][2], H[m][3]);
        bf16x8_t bh[2], bl[2];
#pragma unroll
        for (int s = 0; s < 2; ++s) {
            const float xv[8] = {H[2 * s][0], H[2 * s][1], H[2 * s][2], H[2 * s][3], H[2 * s + 1][0], H[2 * s + 1][1], H[2 * s + 1][2], H[2 * s + 1][3]};
            split8(xv, bh[s], bl[s]);
        }
#pragma unroll
        for (int m = 0; m < 4; ++m) {
            f32x4_t acc = {ncur[m].x, ncur[m].y, ncur[m].z, ncur[m].w};
#pragma unroll
            for (int s = 0; s < 2; ++s) {
                U8 ah, al; ah.q = mcur[(m * 2 + s) * 2]; al.q = mcur[(m * 2 + s) * 2 + 1];
                acc = __builtin_amdgcn_mfma_f32_16x16x32_bf16(ah.v, bh[s], acc, 0, 0, 0);
                acc = __builtin_amdgcn_mfma_f32_16x16x32_bf16(ah.v, bl[s], acc, 0, 0, 0);
                acc = __builtin_amdgcn_mfma_f32_16x16x32_bf16(al.v, bh[s], acc, 0, 0, 0);
            }
            H[m] = acc;
        }
#pragma unroll
        for (int i = 0; i < 16; ++i) mcur[i] = mnx[i];
#pragma unroll
        for (int m = 0; m < 4; ++m) ncur[m] = nnx[m];
    }
}

__device__ __forceinline__ void gdn_g3_unit(int h, int n, const GdnBufs& B, const bf16_t* __restrict__ PM, bf16_t* __restrict__ Y, const float* __restrict__ norm_g, LAS float* lds) {
    const int tid = opq_tid(), w = tid >> 6, lane = tid & 63, q4 = lane >> 4, cc = lane & 15;
    LAS float* Qr = lds; LAS float* Kr = lds + MS; LAS float* KbT = lds + 2 * MS; LAS float* VbT = lds + 3 * MS; LAS float* Lm = lds + 4 * MS; LAS float* At = lds + 5 * MS;
    LAS float* Wm = Kr; LAS float* Hs = KbT; LAS float* VnT = VbT; LAS float* Os = Lm;
    LAS float* sb = lds + 6 * MS; LAS float* sg = sb + 64;
    const int t0 = n * 64, u = h * 256 + n;
    const int c = tid >> 3, d0 = (tid & 7) * 8;
    {
        const float beta = B.GB[(size_t)(t0 + c) * 4 + h], gc = B.GC[(size_t)(t0 + c) * 4 + h];
        const uint4 q8 = *(const uint4*)(B.GQ + (size_t)(t0 + c) * 256 + h * 64 + d0);
        const uint4 k8 = *(const uint4*)(B.GK + (size_t)(t0 + c) * 256 + h * 64 + d0);
        const uint4 v8 = *(const uint4*)(B.GV + (size_t)(t0 + c) * 256 + h * 64 + d0);
        const float e2 = beta * expf(gc);
        const unsigned qu[4] = {q8.x, q8.y, q8.z, q8.w}, ku[4] = {k8.x, k8.y, k8.z, k8.w}, vu[4] = {v8.x, v8.y, v8.z, v8.w};
#pragma unroll
        for (int i = 0; i < 8; ++i) {
            const float qf = __uint_as_float((i & 1) ? (qu[i >> 1] & 0xffff0000u) : (qu[i >> 1] << 16));
            const float kf = __uint_as_float((i & 1) ? (ku[i >> 1] & 0xffff0000u) : (ku[i >> 1] << 16));
            const float vf = __uint_as_float((i & 1) ? (vu[i >> 1] & 0xffff0000u) : (vu[i >> 1] << 16));
            Qr[c * PT + d0 + i] = qf; Kr[c * PT + d0 + i] = kf; KbT[(d0 + i) * PT + c] = kf * e2; VbT[(d0 + i) * PT + c] = beta * vf;
        }
        if ((tid & 7) == 0) { sb[c] = beta; sg[c] = gc; }
    }
    __syncthreads();
    const int ti = w >> 1, tj0 = (w & 1) * 2;
    const f32x4_t zero4 = {0.f, 0.f, 0.f, 0.f};
#pragma unroll
    for (int tt = 0; tt < 2; ++tt) {
        const int tj = tj0 + tt;
        if (tj <= ti) {
            const f32x4_t a = mm_tile<3>(Kr + 16 * ti * PT, Kr + 16 * tj * PT, lane, zero4);
            const f32x4_t s = mm_tile<1>(Qr + 16 * ti * PT, Kr + 16 * tj * PT, lane, zero4);
            const int j = 16 * tj + cc; const float gj = sg[j];
#pragma unroll
            for (int r = 0; r < 4; ++r) { const int i = 16 * ti + 4 * q4 + r; const float dec = expf(fminf(sg[i] - gj, 0.f));
                Lm[i * PT + j] = (i > j) ? sb[i] * a[r] * dec : 0.f; At[i * PT + j] = (i >= j) ? s[r] * dec : 0.f; }
        } else {
            const int j = 16 * tj + cc;
#pragma unroll
            for (int r = 0; r < 4; ++r) { const int i = 16 * ti + 4 * q4 + r; At[i * PT + j] = 0.f; }
        }
    }
    __syncthreads();
    if (w == 0) tri_inverse_wave(Lm, lane);
    else {
        for (int e = tid - 64; e < 4096; e += 448) { const int r = e >> 6, col = e & 63; Qr[r * PT + col] *= expf(sg[r]); }
    }
    __syncthreads();
    f32x4_t u0[2];
#pragma unroll
    for (int tt = 0; tt < 2; ++tt) {
        const int tj = tj0 + tt;
        u0[tt] = mm_tile<3>(Lm + 16 * ti * PT, VbT + 16 * tj * PT, lane, zero4);
        const f32x4_t b = mm_tile<3>(Lm + 16 * ti * PT, KbT + 16 * tj * PT, lane, zero4);
#pragma unroll
        for (int r = 0; r < 4; ++r) Wm[(16 * ti + 4 * q4 + r) * PT + 16 * tj + cc] = b[r];
    }
    __syncthreads();
    {
        const float* ht = B.HT + (size_t)u * 4096;
        const float4 x0 = *(const float4*)(ht + c * 64 + d0), x1 = *(const float4*)(ht + c * 64 + d0 + 4);
        *(LAS f32x4_t*)(Hs + c * PT + d0) = (f32x4_t){x0.x, x0.y, x0.z, x0.w}; *(LAS f32x4_t*)(Hs + c * PT + d0 + 4) = (f32x4_t){x1.x, x1.y, x1.z, x1.w};
    }
    __syncthreads();
    f32x4_t o[2];
#pragma unroll
    for (int tt = 0; tt < 2; ++tt) {
        const int tj = tj0 + tt;
        const f32x4_t wh = mm_tile<3>(Wm + 16 * ti * PT, Hs + 16 * tj * PT, lane, zero4);
        o[tt] = mm_tile<3>(Qr + 16 * ti * PT, Hs + 16 * tj * PT, lane, zero4);
        u0[tt] = u0[tt] - wh;
    }
    __syncthreads();
#pragma unroll
    for (int tt = 0; tt < 2; ++tt) { const int tj = tj0 + tt; *(LAS f32x4_t*)(VnT + (16 * tj + cc) * PT + 16 * ti + 4 * q4) = (f32x4_t){u0[tt][0], u0[tt][1], u0[tt][2], u0[tt][3]}; }
    __syncthreads();
#pragma unroll
    for (int tt = 0; tt < 2; ++tt) {
        const int tj = tj0 + tt;
        o[tt] = mm_tile<3>(At + 16 * ti * PT, VnT + 16 * tj * PT, lane, o[tt]);
    }
    __syncthreads();
#pragma unroll
    for (int tt = 0; tt < 2; ++tt) { const int tj = tj0 + tt;
#pragma unroll
        for (int r = 0; r < 4; ++r) Os[(16 * ti + 4 * q4 + r) * PT + 16 * tj + cc] = o[tt][r]; }
    __syncthreads();
    {
        const f32x4_t x0 = *(const LAS f32x4_t*)(Os + c * PT + d0), x1 = *(const LAS f32x4_t*)(Os + c * PT + d0 + 4);
        float xv[8] = {x0.x, x0.y, x0.z, x0.w, x1.x, x1.y, x1.z, x1.w};
        float ss = 0.f;
#pragma unroll
        for (int i = 0; i < 8; ++i) ss = fmaf(xv[i], xv[i], ss);
        ss += __shfl_xor(ss, 1); ss += __shfl_xor(ss, 2); ss += __shfl_xor(ss, 4);
        const float rs = rsqrtf(ss * (1.f / 64.f) + 1e-6f);
        const uint4 z8 = *(const uint4*)(PM + (size_t)(t0 + c) * PMLD + 768 + h * 64 + d0);
        const unsigned zu[4] = {z8.x, z8.y, z8.z, z8.w};
        unsigned ow[4];
#pragma unroll
        for (int i = 0; i < 4; ++i) {
            const float z0 = __uint_as_float(zu[i] << 16), z1 = __uint_as_float(zu[i] & 0xffff0000u);
            ow[i] = cvtpk(xv[2 * i] * rs * norm_g[d0 + 2 * i] * siluf_(z0), xv[2 * i + 1] * rs * norm_g[d0 + 2 * i + 1] * siluf_(z1));
        }
        *(uint4*)(Y + (size_t)(t0 + c) * D + h * 64 + d0) = make_uint4(ow[0], ow[1], ow[2], ow[3]);
    }
    __syncthreads();
}

struct RwkvBufs { bf16_t *RR, *RK, *RV, *RKK, *RA, *RG; float* CW; uint4* MF; float* NF; float* HT; };
__device__ __forceinline__ void unpack8(const uint4 u, float (&o)[8]) {
    const unsigned w[4] = {u.x, u.y, u.z, u.w};
#pragma unroll
    for (int i = 0; i < 4; ++i) { o[2 * i] = __uint_as_float(w[i] << 16); o[2 * i + 1] = __uint_as_float(w[i] & 0xffff0000u); }
}
__device__ __forceinline__ uint4 pack8(const float (&x)[8]) { return make_uint4(cvtpk(x[0], x[1]), cvtpk(x[2], x[3]), cvtpk(x[4], x[5]), cvtpk(x[6], x[7])); }
typedef unsigned short LAS lds_bf16;
__device__ __forceinline__ void rwkv_prep_chunk(const bf16_t* __restrict__ PM, int n, const RwkvBufs& B, const Params& p, int l, const bf16_t* __restrict__ WUPT, const bf16_t* __restrict__ AUPT, const bf16_t* __restrict__ GUPT, LAS unsigned char* lds) {
    const int tid = opq_tid(), w = tid >> 6, lane = tid & 63, q4 = lane >> 4, cc = lane & 15;
    const int t0 = n * 64;
    const float* mu = p.in[24] + l * 1024;
    lds_bf16* Awd = (lds_bf16*)lds; lds_bf16* Aad = Awd + 64 * 72; lds_bf16* Agd = Aad + 64 * 72;
    lds_bf16* La = Agd + 64 * 136; lds_bf16* Lg = La + 64 * 264; lds_bf16* Llw = Lg + 64 * 264;
    {
        const int t = tid >> 3, c0 = (tid & 7) * 32;
        const bf16_t* row = PM + (size_t)(t0 + t) * PMLD + C_RWKV + 768 + c0;
        const bool hasprev = (t0 + t) > 0;
#pragma unroll 1
        for (int g8 = 0; g8 < 4; ++g8) {
            float x[8], xp[8];
            unpack8(*(const uint4*)(row + 8 * g8), x);
            if (hasprev) unpack8(*(const uint4*)(row - PMLD + 8 * g8), xp); else {
#pragma unroll
                for (int i = 0; i < 8; ++i) xp[i] = 0.f; }
            const int col = c0 + 8 * g8;
            float y[8];
#pragma unroll
            for (int i = 0; i < 8; ++i) {
                const float v = x[i] + mu[768 + col + i] * (xp[i] - x[i]);
                y[i] = col < 64 ? tanhf(v) : (col < 128 ? v : sigmoidf_(v));
            }
            const uint4 pk = pack8(y);
            if (col < 64) *(LAS u32x4_t*)(Awd + t * 72 + col) = (u32x4_t){pk.x, pk.y, pk.z, pk.w};
            else if (col < 128) *(LAS u32x4_t*)(Aad + t * 72 + (col - 64)) = (u32x4_t){pk.x, pk.y, pk.z, pk.w};
            else *(LAS u32x4_t*)(Agd + t * 136 + (col - 128)) = (u32x4_t){pk.x, pk.y, pk.z, pk.w};
        }
    }
    __syncthreads();
    const int hh = w >> 1, tt0 = 2 * (w & 1);
    {
        const float* w0 = p.in[25] + l * W; const float* a0 = p.in[27] + l * W;
#pragma unroll 1
        for (int b = 0; b < 4; ++b) {
            const int ncol = 64 * hh + 16 * b + cc;
            f32x4_t accw[2], acca[2], accg[2];
#pragma unroll
            for (int a = 0; a < 2; ++a) { accw[a] = (f32x4_t){0.f, 0.f, 0.f, 0.f}; acca[a] = accw[a]; accg[a] = accw[a]; }
#pragma unroll
            for (int ks = 0; ks < 4; ++ks) {
                U8 bw, ba, bg;
                bg.q = *(const uint4*)(GUPT + (size_t)ncol * 128 + 32 * ks + 8 * q4);
                if (ks < 2) { bw.q = *(const uint4*)(WUPT + (size_t)ncol * 64 + 32 * ks + 8 * q4); ba.q = *(const uint4*)(AUPT + (size_t)ncol * 64 + 32 * ks + 8 * q4); }
#pragma unroll
                for (int a = 0; a < 2; ++a) {
                    const int row = 16 * (tt0 + a) + cc;
                    U8 ag; ag.x = *(const LAS u32x4_t*)(Agd + row * 136 + 32 * ks + 8 * q4);
                    accg[a] = __builtin_amdgcn_mfma_f32_16x16x32_bf16(ag.v, bg.v, accg[a], 0, 0, 0);
                    if (ks < 2) {
                        U8 aw, aa; aw.x = *(const LAS u32x4_t*)(Awd + row * 72 + 32 * ks + 8 * q4); aa.x = *(const LAS u32x4_t*)(Aad + row * 72 + 32 * ks + 8 * q4);
                        accw[a] = __builtin_amdgcn_mfma_f32_16x16x32_bf16(aw.v, bw.v, accw[a], 0, 0, 0);
                        acca[a] = __builtin_amdgcn_mfma_f32_16x16x32_bf16(aa.v, ba.v, acca[a], 0, 0, 0);
                    }
                }
            }
            const float w0n = w0[ncol], a0n = a0[ncol];
#pragma unroll
            for (int a = 0; a < 2; ++a)
#pragma unroll
                for (int r = 0; r < 4; ++r) {
                    const int t = 16 * (tt0 + a) + 4 * q4 + r;
                    const float logw = -softplusf_(-(w0n + accw[a][r])) - 0.5f;
                    Llw[t * 264 + ncol] = (unsigned short)f2bf(-expf(logw));
                    La[t * 264 + ncol] = (unsigned short)f2bf(sigmoidf_(a0n + acca[a][r]));
                    Lg[t * 264 + ncol] = (unsigned short)f2bf(accg[a][r]);
                }
        }
    }
    __syncthreads();
    {
        const int t = tid >> 3, n0 = (tid & 7) * 32;
        const bf16_t* row = PM + (size_t)(t0 + t) * PMLD + C_RWKV;
        const bool hasprev = (t0 + t) > 0;
        const float* k_k = p.in[30] + l * W; const float* k_a = p.in[31] + l * W;
        float ss = 0.f;
#pragma unroll 1
        for (int g8 = 0; g8 < 4; ++g8) {
            const int nn = n0 + 8 * g8;
            float xr[8], xk[8], xv[8], pr[8], pk[8], pv[8], av[8];
            unpack8(*(const uint4*)(row + nn), xr); unpack8(*(const uint4*)(row + 256 + nn), xk); unpack8(*(const uint4*)(row + 512 + nn), xv);
            if (hasprev) { unpack8(*(const uint4*)(row - PMLD + nn), pr); unpack8(*(const uint4*)(row - PMLD + 256 + nn), pk); unpack8(*(const uint4*)(row - PMLD + 512 + nn), pv); }
            else {
#pragma unroll
                for (int i = 0; i < 8; ++i) { pr[i] = 0.f; pk[i] = 0.f; pv[i] = 0.f; } }
            { const u32x4_t t4 = *(const LAS u32x4_t*)(La + t * 264 + nn); unpack8(make_uint4(t4.x, t4.y, t4.z, t4.w), av); }
            float orr[8], okk[8], ovv[8];
#pragma unroll
            for (int i = 0; i < 8; ++i) {
                const float r = xr[i] + mu[nn + i] * (pr[i] - xr[i]);
                const float k = xk[i] + mu[256 + nn + i] * (pk[i] - xk[i]);
                const float v = xv[i] + mu[512 + nn + i] * (pv[i] - xv[i]);
                orr[i] = r; ovv[i] = v; okk[i] = k * (1.f + (av[i] - 1.f) * k_a[nn + i]);
                const float kr = k * k_k[nn + i]; ss = fmaf(kr, kr, ss);
            }
            const size_t o = (size_t)(t0 + t) * 256 + nn;
            *(uint4*)(B.RR + o) = pack8(orr); *(uint4*)(B.RK + o) = pack8(okk); *(uint4*)(B.RV + o) = pack8(ovv);
            { const u32x4_t t4 = *(const LAS u32x4_t*)(La + t * 264 + nn); *(uint4*)(B.RA + o) = make_uint4(t4.x, t4.y, t4.z, t4.w); }
            { const u32x4_t t4 = *(const LAS u32x4_t*)(Lg + t * 264 + nn); *(uint4*)(B.RG + o) = make_uint4(t4.x, t4.y, t4.z, t4.w); }
        }
        ss += __shfl_xor(ss, 1);
        const float rn = rsqrtf(ss + 1e-6f);
#pragma unroll 1
        for (int g8 = 0; g8 < 4; ++g8) {
            const int nn = n0 + 8 * g8;
            float xk[8], pk[8], kk[8];
            unpack8(*(const uint4*)(row + 256 + nn), xk);
            if (hasprev) unpack8(*(const uint4*)(row - PMLD + 256 + nn), pk); else {
#pragma unroll
                for (int i = 0; i < 8; ++i) pk[i] = 0.f; }
#pragma unroll
            for (int i = 0; i < 8; ++i) kk[i] = (xk[i] + mu[256 + nn + i] * (pk[i] - xk[i])) * k_k[nn + i] * rn;
            *(uint4*)(B.RKK + (size_t)(t0 + t) * 256 + nn) = pack8(kk);
        }
    }
    if (tid < 256) {
        float c = 0.f;
        for (int t = 0; t < 64; ++t) { c += bf2f(Llw[t * 264 + tid]); B.CW[(size_t)(t0 + t) * 256 + tid] = c; }
    }
    __syncthreads();
}

struct RwPiece { float kk[8], al[8], kt[8], v[8], cw[8], cwp[8], cwc[8]; };
__device__ __forceinline__ void rwkv_load_piece(const RwkvBufs& B, int h, int t0, int c, int d0, RwPiece& P) {
    const size_t o = (size_t)(t0 + c) * 256 + h * 64 + d0;
    float a[8];
    unpack8(*(const uint4*)(B.RKK + o), P.kk); unpack8(*(const uint4*)(B.RA + o), a); unpack8(*(const uint4*)(B.RK + o), P.kt); unpack8(*(const uint4*)(B.RV + o), P.v);
    const float4 c0 = *(const float4*)(B.CW + o), c1 = *(const float4*)(B.CW + o + 4);
    P.cw[0] = c0.x; P.cw[1] = c0.y; P.cw[2] = c0.z; P.cw[3] = c0.w; P.cw[4] = c1.x; P.cw[5] = c1.y; P.cw[6] = c1.z; P.cw[7] = c1.w;
    if (c > 0) { const float4 p0 = *(const float4*)(B.CW + o - 256), p1 = *(const float4*)(B.CW + o - 256 + 4);
        P.cwp[0] = p0.x; P.cwp[1] = p0.y; P.cwp[2] = p0.z; P.cwp[3] = p0.w; P.cwp[4] = p1.x; P.cwp[5] = p1.y; P.cwp[6] = p1.z; P.cwp[7] = p1.w; }
    else {
#pragma unroll
        for (int i = 0; i < 8; ++i) P.cwp[i] = 0.f; }
    const size_t oc = (size_t)(t0 + 63) * 256 + h * 64 + d0;
    const float4 e0 = *(const float4*)(B.CW + oc), e1 = *(const float4*)(B.CW + oc + 4);
    P.cwc[0] = e0.x; P.cwc[1] = e0.y; P.cwc[2] = e0.z; P.cwc[3] = e0.w; P.cwc[4] = e1.x; P.cwc[5] = e1.y; P.cwc[6] = e1.z; P.cwc[7] = e1.w;
#pragma unroll
    for (int i = 0; i < 8; ++i) P.al[i] = a[i] * P.kk[i];
}

__device__ __forceinline__ void rwkv_g1_unit(int h, int n, const RwkvBufs& B, LAS float* lds) {
    const int tid = opq_tid(), w = tid >> 6, lane = tid & 63, q4 = lane >> 4, cc = lane & 15;
    LAS float* S0 = lds; LAS float* S1 = lds + MS; LAS float* S2 = lds + 2 * MS; LAS float* S3 = lds + 3 * MS; LAS float* Lm = lds + 4 * MS; LAS float* Lk = lds + 5 * MS;
    const int t0 = n * 64, u = (4 + h) * 256 + n;
    const int c = tid >> 3, d0 = (tid & 7) * 8;
    RwPiece P; rwkv_load_piece(B, h, t0, c, d0, P);
#pragma unroll
    for (int i = 0; i < 8; ++i) {
        const float em = expf(-P.cw[i]);
        S0[c * PT + d0 + i] = P.kk[i] * expf(P.cwp[i]); S1[c * PT + d0 + i] = P.al[i] * em; S2[c * PT + d0 + i] = P.kt[i] * em;
    }
    __syncthreads();
    const int ti = w >> 1, tj0 = (w & 1) * 2;
    const f32x4_t zero4 = {0.f, 0.f, 0.f, 0.f};
#pragma unroll
    for (int tt = 0; tt < 2; ++tt) {
        const int tj = tj0 + tt;
        if (tj <= ti) {
            const f32x4_t a = mm_tile<3>(S0 + 16 * ti * PT, S1 + 16 * tj * PT, lane, zero4);
            const f32x4_t b = mm_tile<3>(S0 + 16 * ti * PT, S2 + 16 * tj * PT, lane, zero4);
            const int j = 16 * tj + cc;
#pragma unroll
            for (int r = 0; r < 4; ++r) { const int i = 16 * ti + 4 * q4 + r; Lm[i * PT + j] = (i > j) ? a[r] : 0.f; Lk[i * PT + j] = (i > j) ? b[r] : 0.f; }
        } else {
            const int j = 16 * tj + cc;
#pragma unroll
            for (int r = 0; r < 4; ++r) { const int i = 16 * ti + 4 * q4 + r; Lk[i * PT + j] = 0.f; }
        }
    }
    __syncthreads();
#pragma unroll
    for (int i = 0; i < 8; ++i) {
        const float eb = expf(P.cwc[i] - P.cw[i]);
        S0[(d0 + i) * PT + c] = P.v[i]; S1[(d0 + i) * PT + c] = P.kk[i] * expf(P.cwp[i]); S2[(d0 + i) * PT + c] = P.al[i] * eb; S3[(d0 + i) * PT + c] = P.kt[i] * eb;
    }
    if (w == 0) tri_inverse_wave(Lm, lane);
    __syncthreads();
    f32x4_t pa[2];
#pragma unroll
    for (int tt = 0; tt < 2; ++tt) pa[tt] = mm_tile<3>(Lk + 16 * ti * PT, S0 + 16 * (tj0 + tt) * PT, lane, zero4);
    __syncthreads();
#pragma unroll
    for (int tt = 0; tt < 2; ++tt) *(LAS f32x4_t*)(Lk + (16 * (tj0 + tt) + cc) * PT + 16 * ti + 4 * q4) = pa[tt];
    __syncthreads();
    f32x4_t ua[2], wa[2];
#pragma unroll
    for (int tt = 0; tt < 2; ++tt) {
        ua[tt] = mm_tile<3>(Lm + 16 * ti * PT, Lk + 16 * (tj0 + tt) * PT, lane, zero4);
        wa[tt] = mm_tile<3>(Lm + 16 * ti * PT, S1 + 16 * (tj0 + tt) * PT, lane, zero4);
    }
    __syncthreads();
#pragma unroll
    for (int tt = 0; tt < 2; ++tt) {
        *(LAS f32x4_t*)(Lk + (16 * (tj0 + tt) + cc) * PT + 16 * ti + 4 * q4) = -ua[tt];
        *(LAS f32x4_t*)(S1 + (16 * (tj0 + tt) + cc) * PT + 16 * ti + 4 * q4) = wa[tt];
    }
    __syncthreads();
    {
#pragma unroll
        for (int tt = 0; tt < 2; ++tt) {
            const int tj = tj0 + tt;
            const f32x4_t a = mm_tile<3>(S2 + 16 * ti * PT, S1 + 16 * tj * PT, lane, zero4);
            const float gam = expf(B.CW[(size_t)(t0 + 63) * 256 + h * 64 + 16 * tj + cc]);
#pragma unroll
            for (int r = 0; r < 4; ++r) { const int ar = 16 * ti + 4 * q4 + r, bc = 16 * tj + cc; Lm[ar * PT + bc] = (ar == bc ? gam : 0.f) - a[r]; }
            f32x4_t nn = mm_tile<3>(S2 + 16 * ti * PT, Lk + 16 * tj * PT, lane, zero4);
            nn = mm_tile<3>(S3 + 16 * ti * PT, S0 + 16 * tj * PT, lane, nn);
            *(float4*)(B.NF + (size_t)u * 4096 + (tj * 64 + lane) * 16 + ti * 4) = make_float4(nn[0], nn[1], nn[2], nn[3]);
        }
    }
    __syncthreads();
    {
        const int combo = tid >> 6, mt = combo >> 1, s = combo & 1, i = lane & 15, qq = lane >> 4;
        const f32x4_t x0 = *(const LAS f32x4_t*)(Lm + (16 * mt + i) * PT + 32 * s + 4 * qq);
        const f32x4_t x1 = *(const LAS f32x4_t*)(Lm + (16 * mt + i) * PT + 32 * s + 16 + 4 * qq);
        const float xv[8] = {x0.x, x0.y, x0.z, x0.w, x1.x, x1.y, x1.z, x1.w};
        U8 H, L; split8(xv, H.v, L.v);
        uint4* mf = B.MF + (size_t)u * 1024 + (size_t)(combo * 2) * 64 + lane;
        mf[0] = H.q; mf[64] = L.q;
    }
    __syncthreads();
}

__device__ __forceinline__ void rwkv_g3_unit(int h, int n, const RwkvBufs& B, bf16_t* __restrict__ Y, const Params& p, int l, LAS float* lds) {
    const int tid = opq_tid(), w = tid >> 6, lane = tid & 63, q4 = lane >> 4, cc = lane & 15;
    LAS float* S0 = lds; LAS float* S1 = lds + MS; LAS float* S2 = lds + 2 * MS; LAS float* RH = lds + 3 * MS; LAS float* Lm = lds + 4 * MS; LAS float* Lk = lds + 5 * MS;
    LAS float* Ara = lds + 6 * MS; LAS float* Ark = lds + 7 * MS;
    const int t0 = n * 64, u = (4 + h) * 256 + n;
    const int c = tid >> 3, d0 = (tid & 7) * 8;
    RwPiece P; rwkv_load_piece(B, h, t0, c, d0, P);
    {
        float rr[8]; unpack8(*(const uint4*)(B.RR + (size_t)(t0 + c) * 256 + h * 64 + d0), rr);
#pragma unroll
        for (int i = 0; i < 8; ++i) {
            const float em = expf(-P.cw[i]);
            S0[c * PT + d0 + i] = P.kk[i] * expf(P.cwp[i]); S1[c * PT + d0 + i] = P.al[i] * em; S2[c * PT + d0 + i] = P.kt[i] * em; RH[c * PT + d0 + i] = rr[i] * expf(P.cw[i]);
        }
    }
    __syncthreads();
    const int ti = w >> 1, tj0 = (w & 1) * 2;
    const f32x4_t zero4 = {0.f, 0.f, 0.f, 0.f};
#pragma unroll
    for (int tt = 0; tt < 2; ++tt) {
        const int tj = tj0 + tt; const int j = 16 * tj + cc;
        if (tj <= ti) {
            const f32x4_t a = mm_tile<3>(S0 + 16 * ti * PT, S1 + 16 * tj * PT, lane, zero4);
            const f32x4_t b = mm_tile<3>(S0 + 16 * ti * PT, S2 + 16 * tj * PT, lane, zero4);
            const f32x4_t e = mm_tile<3>(RH + 16 * ti * PT, S1 + 16 * tj * PT, lane, zero4);
            const f32x4_t f = mm_tile<3>(RH + 16 * ti * PT, S2 + 16 * tj * PT, lane, zero4);
#pragma unroll
            for (int r = 0; r < 4; ++r) { const int i = 16 * ti + 4 * q4 + r;
                Lm[i * PT + j] = (i > j) ? a[r] : 0.f; Lk[i * PT + j] = (i > j) ? b[r] : 0.f; Ara[i * PT + j] = (i >= j) ? e[r] : 0.f; Ark[i * PT + j] = (i >= j) ? f[r] : 0.f; }
        } else {
#pragma unroll
            for (int r = 0; r < 4; ++r) { const int i = 16 * ti + 4 * q4 + r; Lk[i * PT + j] = 0.f; Ara[i * PT + j] = 0.f; Ark[i * PT + j] = 0.f; }
        }
    }
    __syncthreads();
#pragma unroll
    for (int i = 0; i < 8; ++i) { S0[(d0 + i) * PT + c] = P.v[i]; S1[(d0 + i) * PT + c] = P.kk[i] * expf(P.cwp[i]); }
    if (w == 0) tri_inverse_wave(Lm, lane);
    __syncthreads();
    f32x4_t pa[2];
#pragma unroll
    for (int tt = 0; tt < 2; ++tt) pa[tt] = mm_tile<3>(Lk + 16 * ti * PT, S0 + 16 * (tj0 + tt) * PT, lane, zero4);
    __syncthreads();
#pragma unroll
    for (int tt = 0; tt < 2; ++tt) *(LAS f32x4_t*)(Lk + (16 * (tj0 + tt) + cc) * PT + 16 * ti + 4 * q4) = pa[tt];
    __syncthreads();
    f32x4_t ua[2], wa[2];
#pragma unroll
    for (int tt = 0; tt < 2; ++tt) {
        ua[tt] = mm_tile<3>(Lm + 16 * ti * PT, Lk + 16 * (tj0 + tt) * PT, lane, zero4);
        wa[tt] = mm_tile<3>(Lm + 16 * ti * PT, S1 + 16 * (tj0 + tt) * PT, lane, zero4);
    }
    __syncthreads();
    {
#pragma unroll
        for (int tt = 0; tt < 2; ++tt)
#pragma unroll
            for (int r = 0; r < 4; ++r) S1[(16 * ti + 4 * q4 + r) * PT + 16 * (tj0 + tt) + cc] = wa[tt][r];
        const float* ht = B.HT + (size_t)u * 4096;
        const float4 x0 = *(const float4*)(ht + c * 64 + d0), x1 = *(const float4*)(ht + c * 64 + d0 + 4);
        *(LAS f32x4_t*)(S2 + c * PT + d0) = (f32x4_t){x0.x, x0.y, x0.z, x0.w}; *(LAS f32x4_t*)(S2 + c * PT + d0 + 4) = (f32x4_t){x1.x, x1.y, x1.z, x1.w};
    }
    __syncthreads();
    f32x4_t o[2];
#pragma unroll
    for (int tt = 0; tt < 2; ++tt) {
        const int tj = tj0 + tt;
        const f32x4_t wh = mm_tile<3>(S1 + 16 * ti * PT, S2 + 16 * tj * PT, lane, zero4);
        ua[tt] = -ua[tt] - wh;
        o[tt] = mm_tile<3>(RH + 16 * ti * PT, S2 + 16 * tj * PT, lane, zero4);
        o[tt] = mm_tile<3>(Ark + 16 * ti * PT, S0 + 16 * tj * PT, lane, o[tt]);
        *(LAS f32x4_t*)(Lm + (16 * tj + cc) * PT + 16 * ti + 4 * q4) = ua[tt];
    }
    __syncthreads();
#pragma unroll
    for (int tt = 0; tt < 2; ++tt) o[tt] = mm_tile<3>(Ara + 16 * ti * PT, Lm + 16 * (tj0 + tt) * PT, lane, o[tt]);
    __syncthreads();
#pragma unroll
    for (int tt = 0; tt < 2; ++tt)
#pragma unroll
        for (int r = 0; r < 4; ++r) Lk[(16 * ti + 4 * q4 + r) * PT + 16 * (tj0 + tt) + cc] = o[tt][r];
    __syncthreads();
    {
        const f32x4_t x0 = *(const LAS f32x4_t*)(Lk + c * PT + d0), x1 = *(const LAS f32x4_t*)(Lk + c * PT + d0 + 4);
        const float xv[8] = {x0.x, x0.y, x0.z, x0.w, x1.x, x1.y, x1.z, x1.w};
        float s1 = 0.f;
#pragma unroll
        for (int i = 0; i < 8; ++i) s1 += xv[i];
        s1 += __shfl_xor(s1, 1); s1 += __shfl_xor(s1, 2); s1 += __shfl_xor(s1, 4);
        const float mean = s1 * (1.f / 64.f);
        float s2 = 0.f;
#pragma unroll
        for (int i = 0; i < 8; ++i) { const float dd = xv[i] - mean; s2 = fmaf(dd, dd, s2); }
        s2 += __shfl_xor(s2, 1); s2 += __shfl_xor(s2, 2); s2 += __shfl_xor(s2, 4);
        const float rs = rsqrtf(s2 * (1.f / 64.f) + 64e-5f);
        const size_t o8 = (size_t)(t0 + c) * 256 + h * 64 + d0;
        float rr[8], gg[8], kt2[8], v2[8];
        unpack8(*(const uint4*)(B.RR + o8), rr); unpack8(*(const uint4*)(B.RG + o8), gg); unpack8(*(const uint4*)(B.RK + o8), kt2); unpack8(*(const uint4*)(B.RV + o8), v2);
        const float* r_k = p.in[32] + l * W + h * 64 + d0; const float* ln_g = p.in[33] + l * W + h * 64 + d0; const float* ln_b = p.in[34] + l * W + h * 64 + d0;
        float bs = 0.f;
#pragma unroll
        for (int i = 0; i < 8; ++i) bs = fmaf(rr[i] * kt2[i], r_k[i], bs);
        bs += __shfl_xor(bs, 1); bs += __shfl_xor(bs, 2); bs += __shfl_xor(bs, 4);
        float y[8];
#pragma unroll
        for (int i = 0; i < 8; ++i) y[i] = ((xv[i] - mean) * rs * ln_g[i] + ln_b[i] + bs * v2[i]) * gg[i];
        *(uint4*)(Y + (size_t)(t0 + c) * D + 768 + h * 64 + d0) = pack8(y);
    }
    __syncthreads();
}
struct LruBufs { float2* AGG; float* CAR; };
template <int PASS>
__device__ __forceinline__ void lru_unit(const bf16_t* __restrict__ PM, int n, const LruBufs& B, bf16_t* __restrict__ Y, const Params& p, int l, const bf16_t* __restrict__ LWT  , LAS float* lds) {
    const int tid = opq_tid(), c = tid & 255, half = tid >> 8, w = tid >> 6, lane = tid & 63, q4 = lane >> 4, cc = lane & 15;
    const int t0 = n * 64, tb = t0 + 32 * half;
    LAS float* U = lds;
    lds_bf16* R = (lds_bf16*)(lds + 64 * 260);
    lds_bf16* I = R + 64 * 264;
    {
        const float* cw = p.in[7] + l * 4 * W; const float cb = p.in[8][l * W + c];
        const float w0 = cw[c], w1 = cw[W + c], w2 = cw[2 * W + c], w3 = cw[3 * W + c];
        const bf16_t* col = PM + C_LRU + c;
        float h0 = tb >= 3 ? bf2f(col[(size_t)(tb - 3) * PMLD]) : 0.f, h1 = tb >= 2 ? bf2f(col[(size_t)(tb - 2) * PMLD]) : 0.f, h2 = tb >= 1 ? bf2f(col[(size_t)(tb - 1) * PMLD]) : 0.f;
#pragma unroll 4
        for (int i = 0; i < 32; ++i) {
            const float x = bf2f(col[(size_t)(tb + i) * PMLD]);
            U[(32 * half + i) * 260 + c] = cb + w0 * h0 + w1 * h1 + w2 * h2 + w3 * x;
            h0 = h1; h1 = h2; h2 = x;
        }
    }
    __syncthreads();
    {
        const int nb = w >> 1, gt = w & 1;
        const bf16_t* wt = LWT + (size_t)gt * 16384 + (size_t)nb * 4096;
        const float* bias = (gt ? p.in[12] : p.in[10]) + l * W + nb * 64;
        const float* lam = p.in[13] + l * W + nb * 64;
#pragma unroll 1
        for (int te = 0; te < 4; ++te) {
            U8 bf[2];
#pragma unroll
            for (int ks = 0; ks < 2; ++ks) bf[ks].q = *(const uint4*)(wt + (size_t)(16 * te + cc) * 64 + 32 * ks + 8 * q4);
            const int ch = nb * 64 + 16 * te + cc;
            const float bv = bias[16 * te + cc];
            const float sp8 = 8.f * softplusf_(-lam[16 * te + cc]);
#pragma unroll
            for (int tt = 0; tt < 4; ++tt) {
                f32x4_t acc = {0.f, 0.f, 0.f, 0.f};
#pragma unroll
                for (int ks = 0; ks < 2; ++ks) {
                    const LAS float* ap = U + (16 * tt + cc) * 260 + nb * 64 + 32 * ks + 8 * q4;
                    const f32x4_t a0 = *(const LAS f32x4_t*)ap, a1 = *(const LAS f32x4_t*)(ap + 4);
                    const float av[8] = {a0.x, a0.y, a0.z, a0.w, a1.x, a1.y, a1.z, a1.w};
                    acc = __builtin_amdgcn_mfma_f32_16x16x32_bf16(hi8(av), bf[ks].v, acc, 0, 0, 0);
                }
#pragma unroll
                for (int r = 0; r < 4; ++r) {
                    const int t = 16 * tt + 4 * q4 + r;
                    const float sg = sigmoidf_(acc[r] + bv);
                    if (gt) I[t * 264 + ch] = (unsigned short)f2bf(sg); else R[t * 264 + ch] = (unsigned short)f2bf(-sp8 * sg);
                }
            }
        }
    }
    __syncthreads();
    float h = 0.f, ap = 1.f;
    const int sc = 2 * n + half;
    if (PASS == 3) h = B.CAR[(size_t)sc * 256 + c];
#pragma unroll 2
    for (int i = 0; i < 32; ++i) {
        const int t = 32 * half + i;
        const float log_a = bf2f(R[t * 264 + c]), ig = bf2f(I[t * 264 + c]);
        const float a = expf(log_a);
        const float inp = sqrtf(-expm1f(2.f * log_a)) * (ig * U[t * 260 + c]);
        h = fmaf(a, h, inp); ap *= a;
        if (PASS == 3) {
            const float gate = bf2f(PM[(size_t)(t0 + t) * PMLD + C_LRU + 256 + c]);
            Y[(size_t)(t0 + t) * D + 256 + c] = (bf16_t)f2bf(h * geluf_(gate));
        }
    }
    if (PASS == 1) B.AGG[(size_t)sc * 256 + c] = make_float2(ap, h);
    __syncthreads();
}
__device__ __forceinline__ void lru_carry(const LruBufs& B, int c) {
    float h = 0.f;
#pragma unroll 8
    for (int s = 0; s < 512; ++s) { const float2 ab = B.AGG[(size_t)s * 256 + c]; B.CAR[(size_t)s * 256 + c] = h; h = fmaf(ab.x, h, ab.y); }
}

struct S5Bufs { float2* E; float2* CIN; };
struct S5Lane { float lbr, lbi; float bbr[16], bbi[16]; };
__device__ __forceinline__ void s5_lane_consts(const Params& p, int l, int g, int lane, S5Lane& K) {
    const float dt = expf(p.in[21][l * 16 + g]);
    const float lre = p.in[14][l * 1024 + g * 64 + lane], lim = p.in[15][l * 1024 + g * 64 + lane];
    const float er = expf(lre * dt);
    K.lbr = er * cosf(lim * dt); K.lbi = er * sinf(lim * dt);
    const float nr = K.lbr - 1.f, ni = K.lbi, den = lre * lre + lim * lim;
    const float fr = (nr * lre + ni * lim) / den, fi = (ni * lre - nr * lim) / den;
    const float* bre = p.in[16] + (size_t)l * 16384 + (g * 64 + lane) * 16; const float* bim = p.in[17] + (size_t)l * 16384 + (g * 64 + lane) * 16;
#pragma unroll
    for (int c = 0; c < 16; ++c) { const float br = bre[c], bi = bim[c]; K.bbr[c] = fr * br - fi * bi; K.bbi[c] = fr * bi + fi * br; }
}
template <int PASS>
__device__ __forceinline__ void s5_unit(const bf16_t* __restrict__ PM, int n, const S5Bufs& B, bf16_t* __restrict__ Y, const Params& p, int l, const bf16_t* __restrict__ GLUT, LAS unsigned char* lds) {
    const int tid = opq_tid(), w = tid >> 6, lane = tid & 63, q4 = lane >> 4, cc = lane & 15;
    const int t0 = n * 64;
    LAS float* us = (LAS float*)lds + w * (64 * 16);
    LAS unsigned char* hs = lds + 32768 + w * (32 * 272);
    lds_bf16* yp = (lds_bf16*)(lds + 32768 + 8 * 32 * 272);
#pragma unroll 1
    for (int gi = 0; gi < 2; ++gi) {
        const int g = 2 * w + gi;
        {
            const bf16_t* src = PM + (size_t)(t0 + lane) * PMLD + C_S5 + g * 16;
            float a[8], b[8]; unpack8(*(const uint4*)src, a); unpack8(*(const uint4*)(src + 8), b);
            *(LAS f32x4_t*)(us + lane * 16) = (f32x4_t){a[0], a[1], a[2], a[3]}; *(LAS f32x4_t*)(us + lane * 16 + 4) = (f32x4_t){a[4], a[5], a[6], a[7]};
            *(LAS f32x4_t*)(us + lane * 16 + 8) = (f32x4_t){b[0], b[1], b[2], b[3]}; *(LAS f32x4_t*)(us + lane * 16 + 12) = (f32x4_t){b[4], b[5], b[6], b[7]};
        }
        S5Lane K; s5_lane_consts(p, l, g, lane, K);
        float hr = 0.f, hi = 0.f;
        if (PASS == 3) { const float2 h0 = B.CIN[((size_t)n * 16 + g) * 64 + lane]; hr = h0.x; hi = h0.y; }
        U8 cf[4];
        float dch = 0.f;
        if (PASS == 3) {
            const float* cre = p.in[18] + (size_t)l * 16384 + (g * 16 + cc) * 64; const float* cim = p.in[19] + (size_t)l * 16384 + (g * 16 + cc) * 64;
#pragma unroll
            for (int ks = 0; ks < 4; ++ks) {
                const float4 r4 = *(const float4*)(cre + 16 * ks + 4 * q4), i4 = *(const float4*)(cim + 16 * ks + 4 * q4);
                cf[ks].u[0] = cvtpk(r4.x, -i4.x); cf[ks].u[1] = cvtpk(r4.y, -i4.y); cf[ks].u[2] = cvtpk(r4.z, -i4.z); cf[ks].u[3] = cvtpk(r4.w, -i4.w);
            }
            dch = p.in[20][l * W + g * 16 + cc];
        }
        asm volatile("s_waitcnt lgkmcnt(0)" ::: "memory");
#pragma unroll 1
        for (int hf = 0; hf < 2; ++hf) {
#pragma unroll 2
            for (int i = 0; i < 32; ++i) {
                const int t = 32 * hf + i;
                const f32x4_t u0 = *(const LAS f32x4_t*)(us + t * 16), u1 = *(const LAS f32x4_t*)(us + t * 16 + 4), u2 = *(const LAS f32x4_t*)(us + t * 16 + 8), u3 = *(const LAS f32x4_t*)(us + t * 16 + 12);
                const float uv[16] = {u0.x, u0.y, u0.z, u0.w, u1.x, u1.y, u1.z, u1.w, u2.x, u2.y, u2.z, u2.w, u3.x, u3.y, u3.z, u3.w};
                float br = 0.f, bi = 0.f;
#pragma unroll
                for (int c = 0; c < 16; ++c) { br = fmaf(K.bbr[c], uv[c], br); bi = fmaf(K.bbi[c], uv[c], bi); }
                const float nhr = K.lbr * hr - K.lbi * hi + br, nhi = K.lbr * hi + K.lbi * hr + bi;
                hr = nhr; hi = nhi;
                if (PASS == 3) *(LAS unsigned*)(hs + i * 272 + 4 * lane) = cvtpk(hr, hi);
            }
            if (PASS == 3) {
                asm volatile("s_waitcnt lgkmcnt(0)" ::: "memory");
#pragma unroll
                for (int tt = 0; tt < 2; ++tt) {
                    f32x4_t acc = {0.f, 0.f, 0.f, 0.f};
#pragma unroll
                    for (int ks = 0; ks < 4; ++ks) {
                        U8 af; af.x = *(const LAS u32x4_t*)(hs + (16 * tt + cc) * 272 + 64 * ks + 16 * q4);
                        acc = __builtin_amdgcn_mfma_f32_16x16x32_bf16(af.v, cf[ks].v, acc, 0, 0, 0);
                    }
#pragma unroll
                    for (int r = 0; r < 4; ++r) {
                        const int t = 32 * hf + 16 * tt + 4 * q4 + r;
                        const float yv = acc[r] + dch * us[t * 16 + cc];
                        yp[t * 264 + g * 16 + cc] = (unsigned short)f2bf(geluf_(yv));
                    }
                }
                asm volatile("s_waitcnt lgkmcnt(0)" ::: "memory");
            }
        }
        if (PASS == 1) B.E[((size_t)n * 16 + g) * 64 + lane] = make_float2(hr, hi);
    }
    if (PASS == 3) {
        __syncthreads();
        const float* gb = p.in[23] + l * W;
#pragma unroll 1
        for (int tn = 2 * w; tn < 2 * w + 2; ++tn) {
            f32x4_t acc[4];
#pragma unroll
            for (int tt = 0; tt < 4; ++tt) acc[tt] = (f32x4_t){0.f, 0.f, 0.f, 0.f};
#pragma unroll
            for (int ks = 0; ks < 8; ++ks) {
                U8 bf; bf.q = *(const uint4*)(GLUT + (size_t)(16 * tn + cc) * 256 + 32 * ks + 8 * q4);
#pragma unroll
                for (int tt = 0; tt < 4; ++tt) {
                    U8 af; af.x = *(const LAS u32x4_t*)(yp + (16 * tt + cc) * 264 + 32 * ks + 8 * q4);
                    acc[tt] = __builtin_amdgcn_mfma_f32_16x16x32_bf16(af.v, bf.v, acc[tt], 0, 0, 0);
                }
            }
            const int ncol = 16 * tn + cc; const float gbn = gb[ncol];
#pragma unroll
            for (int tt = 0; tt < 4; ++tt)
#pragma unroll
                for (int r = 0; r < 4; ++r) {
                    const int t = 16 * tt + 4 * q4 + r;
                    const float yv = bf2f(yp[t * 264 + ncol]);
                    Y[(size_t)(t0 + t) * D + 512 + ncol] = (bf16_t)f2bf(yv * sigmoidf_(acc[tt][r] + gbn));
                }
        }
    }
    __syncthreads();
}
__device__ __forceinline__ void s5_carry(const S5Bufs& B, const Params& p, int l, int gp) {
    const int g = gp >> 6;
    const float dt = expf(p.in[21][l * 16 + g]) * 64.f;
    const float lre = p.in[14][l * 1024 + gp], lim = p.in[15][l * 1024 + gp];
    const float er = expf(lre * dt);
    const float pr = er * cosf(lim * dt), pi = er * sinf(lim * dt);
    float hr = 0.f, hi = 0.f;
#pragma unroll 4
    for (int n = 0; n < 256; ++n) {
        const float2 e = B.E[(size_t)n * 1024 + gp];
        B.CIN[(size_t)n * 1024 + gp] = make_float2(hr, hi);
        const float nhr = pr * hr - pi * hi + e.x, nhi = pr * hi + pi * hr + e.y;
        hr = nhr; hi = nhi;
    }
}
constexpr size_t WS_GQ = 36 * MiB, WS_GK = 44 * MiB, WS_GV = 52 * MiB, WS_GB = 60 * MiB, WS_GC = 61 * MiB;
constexpr size_t WS_MF = 324 * MiB, WS_NF = 356 * MiB, WS_HT = 388 * MiB;
constexpr size_t WS_RR = 420 * MiB, WS_RK = 428 * MiB, WS_RV = 436 * MiB, WS_RKK = 444 * MiB, WS_RA = 452 * MiB, WS_RG = 460 * MiB, WS_CW = 468 * MiB;
constexpr size_t WS_LAGG = 484 * MiB, WS_LCAR = 485 * MiB, WS_S5E = 486 * MiB, WS_S5C = 488 * MiB;
constexpr int MIX_LDS = 8 * MS * 4 + 1024;
__device__ __forceinline__ LruBufs lru_bufs(unsigned char* ws) { LruBufs B; B.AGG = (float2*)(ws + WS_LAGG); B.CAR = (float*)(ws + WS_LCAR); return B; }
__device__ __forceinline__ S5Bufs s5_bufs(unsigned char* ws) { S5Bufs B; B.E = (float2*)(ws + WS_S5E); B.CIN = (float2*)(ws + WS_S5C); return B; }
__device__ __forceinline__ GdnBufs gdn_bufs(unsigned char* ws) {
    GdnBufs B; B.GQ = (bf16_t*)(ws + WS_GQ); B.GK = (bf16_t*)(ws + WS_GK); B.GV = (bf16_t*)(ws + WS_GV); B.GB = (float*)(ws + WS_GB); B.GC = (float*)(ws + WS_GC);
    B.MF = (uint4*)(ws + WS_MF); B.NF = (float*)(ws + WS_NF); B.HT = (float*)(ws + WS_HT); return B;
}
__device__ __forceinline__ RwkvBufs rwkv_bufs(unsigned char* ws) {
    RwkvBufs B; B.RR = (bf16_t*)(ws + WS_RR); B.RK = (bf16_t*)(ws + WS_RK); B.RV = (bf16_t*)(ws + WS_RV); B.RKK = (bf16_t*)(ws + WS_RKK); B.RA = (bf16_t*)(ws + WS_RA); B.RG = (bf16_t*)(ws + WS_RG);
    B.CW = (float*)(ws + WS_CW); B.MF = (uint4*)(ws + WS_MF); B.NF = (float*)(ws + WS_NF); B.HT = (float*)(ws + WS_HT); return B;
}
__device__ __forceinline__ unsigned char* opq(unsigned char* w) { asm volatile("" : "+s"(w)); return w; }
namespace cg = cooperative_groups;
constexpr int FUSED_LDS = MIX_LDS;
static_assert(FUSED_LDS >= pg8::STAGE_BYTES && FUSED_LDS >= 8 * 64 * 33 * 4, "LDS budget");
#define GSYNC() grid.sync()
#ifndef PHM
#define PHM 511
#endif
__global__ void __launch_bounds__(NT, 2) fwd_fused(KParams kp_unused) {
    cg::grid_group grid = cg::this_grid();
    extern __shared__ __attribute__((aligned(16))) unsigned char dl[];
    Params p; p.in.tab = (LAS const unsigned long long*)((LAS unsigned char*)dl + FUSED_LDS);
    {
        const __attribute__((address_space(4))) unsigned long long* ka = (const __attribute__((address_space(4))) unsigned long long*)__builtin_amdgcn_kernarg_segment_ptr();
        if (threadIdx.x < 43) ((LAS unsigned long long*)((LAS unsigned char*)dl + FUSED_LDS))[threadIdx.x] = ka[threadIdx.x];
        __syncthreads();
    }
    float* X = p.out();
#pragma unroll 1
    for (int l = 0; l < 2; ++l) {
        {
            const int tid = opq_tid();
            convert_weights(p, l, (LAS float*)dl + (tid >> 6) * 64 * 33, blockIdx.x * 8 + (tid >> 6), gridDim.x * 8, tid & 63);
        }
#pragma unroll 1
        for (int b = 0; b < 2; ++b) {
            const float* Xin = (l == 0 ? p.in[0] : X) + (size_t)b * TB * D;
            float* Xb = X + (size_t)b * TB * D;
            { unsigned char* ws = opq(p.ws()); rmsnorm_rows(Xin, p.in[1] + l * D, (bf16_t*)(ws + WS_XN), TB); }
            GSYNC();
#if PHM & 1
            {
                unsigned char* ws = opq(p.ws()); const bf16_t* WL = (const bf16_t*)(ws + WS_W);
                pg8::Gemm g{(const bf16_t*)(ws + WS_XN), WL + WO_IN, TB, 7168, D, D, D, 0};
                pg8::StaticOrder S; S.init(g.M, g.N, (int)gridDim.x, (int)blockIdx.x);
                pg8::gemm_phase<pg8::EpiProjP, pg8::StaticOrder, true, true>((PG8_LAS unsigned char*)dl, g, S, pg8::EpiProjP{(bf16_t*)(ws + WS_PM), (bf16_t*)(ws + WS_G)});
            }
#endif
            GSYNC();
#if PHM & 2
            for (int n = blockIdx.x; n < 512; n += gridDim.x) {
                unsigned char* ws = opq(p.ws());
                if (n < 256) gdn_prep_chunk((const bf16_t*)(ws + WS_PM), n, gdn_bufs(ws), p, l, (LAS float*)dl);
                else { const bf16_t* WL = (const bf16_t*)(ws + WS_W); rwkv_prep_chunk((const bf16_t*)(ws + WS_PM), n - 256, rwkv_bufs(ws), p, l, WL + WO_WUP, WL + WO_AUP, WL + WO_GUP, (LAS unsigned char*)dl); }
            }
#endif
            GSYNC();
#if PHM & 4
            for (int u = blockIdx.x; u < 2560; u += gridDim.x) {
                unsigned char* ws = opq(p.ws());
                if (u < 1024) gdn_g1_unit(u >> 8, u & 255, gdn_bufs(ws), (LAS float*)dl);
                else if (u < 2048) rwkv_g1_unit((u - 1024) >> 8, u & 255, rwkv_bufs(ws), (LAS float*)dl);
                else if (u < 2304) lru_unit<1>((const bf16_t*)(ws + WS_PM), u - 2048, lru_bufs(ws), (bf16_t*)(ws + WS_Y), p, l, (const bf16_t*)(ws + WS_W) + WO_LWT, (LAS float*)dl);
                else s5_unit<1>((const bf16_t*)(ws + WS_PM), u - 2304, s5_bufs(ws), (bf16_t*)(ws + WS_Y), p, l, (const bf16_t*)(ws + WS_W) + WO_GLU, (LAS unsigned char*)dl);
            }
#endif
            GSYNC();
#if PHM & 8
            {
                const int tid = opq_tid(), lane = tid & 63;
                const int bx = blockIdx.x;
                if ((tid >> 6) == 0 && bx < 52) {
                    unsigned char* ws = opq(p.ws());
                    if (bx < 32) { const GdnBufs B = gdn_bufs(ws); const int sq = bx >> 2, cb = bx & 3;
                        chain_wave(B.MF + (size_t)sq * 256 * 1024, B.NF + (size_t)sq * 256 * 4096, B.HT + (size_t)sq * 256 * 4096, cb, 256, lane); }
                    else if (bx < 36) lru_carry(lru_bufs(ws), (bx - 32) * 64 + lane);
                    else s5_carry(s5_bufs(ws), p, l, (bx - 36) * 64 + lane);
                }
            }
#endif
            GSYNC();
#if PHM & 16
            for (int u = blockIdx.x; u < 2560; u += gridDim.x) {
                unsigned char* ws = opq(p.ws());
                if (u < 1024) gdn_g3_unit(u >> 8, u & 255, gdn_bufs(ws), (const bf16_t*)(ws + WS_PM), (bf16_t*)(ws + WS_Y), p.in[6] + l * 64, (LAS float*)dl);
                else if (u < 2048) rwkv_g3_unit((u - 1024) >> 8, u & 255, rwkv_bufs(ws), (bf16_t*)(ws + WS_Y), p, l, (LAS float*)dl);
                else if (u < 2304) lru_unit<3>((const bf16_t*)(ws + WS_PM), u - 2048, lru_bufs(ws), (bf16_t*)(ws + WS_Y), p, l, (const bf16_t*)(ws + WS_W) + WO_LWT, (LAS float*)dl);
                else s5_unit<3>((const bf16_t*)(ws + WS_PM), u - 2304, s5_bufs(ws), (bf16_t*)(ws + WS_Y), p, l, (const bf16_t*)(ws + WS_W) + WO_GLU, (LAS unsigned char*)dl);
            }
#endif
            GSYNC();
#if PHM & 32
            { unsigned char* ws = opq(p.ws()); merge_phase((const bf16_t*)(ws + WS_Y), (const bf16_t*)(ws + WS_W) + WO_BR, (const bf16_t*)(ws + WS_G), (bf16_t*)(ws + WS_MG), (LAS unsigned char*)dl); }
#endif
            GSYNC();
#if PHM & 64
            {
                unsigned char* ws = opq(p.ws()); const bf16_t* WL = (const bf16_t*)(ws + WS_W);
                pg8::Gemm g{(const bf16_t*)(ws + WS_MG), WL + WO_OUT, TB, D, D, D, D, 0};
                pg8::StaticOrder S; S.init(g.M, g.N, (int)gridDim.x, (int)blockIdx.x);
                pg8::gemm_phase<pg8::EpiResidP, pg8::StaticOrder, false, true>((PG8_LAS unsigned char*)dl, g, S, pg8::EpiResidP{Xin, Xb});
            }
#endif
            GSYNC();
            { unsigned char* ws = opq(p.ws()); rmsnorm_rows(Xb, p.in[37] + l * D, (bf16_t*)(ws + WS_XN), TB); }
            GSYNC();
#if PHM & 128
            {
                unsigned char* ws = opq(p.ws()); const bf16_t* WL = (const bf16_t*)(ws + WS_W);
                pg8::Gemm g{(const bf16_t*)(ws + WS_XN), WL + WO_W1, TB, DFF, D, D, D, 0};
                pg8::StaticOrder S; S.init(g.M, g.N, (int)gridDim.x, (int)blockIdx.x);
                pg8::gemm_phase<pg8::EpiRelu2P, pg8::StaticOrder, true, true>((PG8_LAS unsigned char*)dl, g, S, pg8::EpiRelu2P{(bf16_t*)(ws + WS_HD), DFF, 0});
            }
#endif
            GSYNC();
#if PHM & 256
            {
                unsigned char* ws = opq(p.ws()); const bf16_t* WL = (const bf16_t*)(ws + WS_W);
                pg8::Gemm g{(const bf16_t*)(ws + WS_HD), WL + WO_W2, TB, D, DFF, DFF, DFF, 0};
                pg8::StaticOrder S; S.init(g.M, g.N, (int)gridDim.x, (int)blockIdx.x);
                pg8::gemm_phase<pg8::EpiResidP, pg8::StaticOrder, false, true>((PG8_LAS unsigned char*)dl, g, S, pg8::EpiResidP{Xb, Xb});
            }
#endif
            GSYNC();
        }
    }
    rmsnorm_rows(X, p.in[40], X, 2 * TB);
}

extern "C" void kernel_launch(void* const* d_in, const int* in_sizes, int n_in, void* d_out, int out_size, void* d_ws, size_t ws_size, hipStream_t stream) {
    KParams p{};
    for (int i = 0; i < 41; ++i) p.in[i] = (const float*)d_in[i];
    p.out = (float*)d_out; p.ws = (unsigned char*)d_ws; p.pad = 0;
    static int grid = 0;
    if (grid == 0) {
        int dev = 0, cus = 0, per_cu = 0;
        hipGetDevice(&dev);
        hipDeviceGetAttribute(&cus, hipDeviceAttributeMultiprocessorCount, dev);
        hipFuncSetAttribute((const void*)fwd_fused, hipFuncAttributeMaxDynamicSharedMemorySize, FUSED_LDS + 1024);
        hipOccupancyMaxActiveBlocksPerMultiprocessor(&per_cu, (const void*)fwd_fused, NT, FUSED_LDS + 1024);
        if (per_cu < 1) per_cu = 1;
        grid = cus * per_cu;
        if (grid > 256) grid = 256;
    }
    void* args[] = {&p};
    hipError_t e = hipLaunchCooperativeKernel((const void*)fwd_fused, dim3(grid), dim3(NT), args, FUSED_LDS + 1024, stream);
    if (e != hipSuccess) fprintf(stderr, "cooperative launch failed: %s (grid %d)\n", hipGetErrorString(e), grid);
}
```

```cpp
#include <hip/hip_runtime.h>
#include <hip/hip_cooperative_groups.h>
#include <cstdio>
#include <cstdint>

constexpr int TB = 16384;
constexpr int D = 1024;
constexpr int DIN = 6920;
constexpr int NMIX = 2824;
constexpr int W = 256;
constexpr int DFF = 4096;
constexpr int NT = 512;

constexpr int C_GDN = 0, C_LRU = 1032, C_S5 = 1544, C_RWKV = 1800, C_GATE = 2824;

struct KParams { const float* in[41]; float* out; unsigned char* ws; size_t pad; };
#define LAS __attribute__((address_space(3)))
#define GAS __attribute__((address_space(1)))
struct PIn { LAS const unsigned long long* tab;
    __device__ __forceinline__ const float* operator[](int i) const { LAS const unsigned long long* t = tab; asm volatile("" : "+v"(t)); const unsigned long long v = t[i];
        const unsigned lo = __builtin_amdgcn_readfirstlane((unsigned)v), hi = __builtin_amdgcn_readfirstlane((unsigned)(v >> 32)); return (const float*)(GAS const float*)(((unsigned long long)hi << 32) | lo); } };
struct Params { PIn in;
    __device__ __forceinline__ float* out() const { return (float*)in[41]; }
    __device__ __forceinline__ unsigned char* ws() const { return (unsigned char*)in[42]; } };

typedef unsigned short bf16_t;
constexpr int PMLD = 3072;
constexpr size_t MiB = 1u << 20;
constexpr size_t WS_W  = 0;
constexpr size_t WS_CTL = 35 * MiB;
constexpr size_t WS_XN = 36 * MiB;
constexpr size_t WS_PM = 68 * MiB;
constexpr size_t WS_G  = 164 * MiB;
constexpr size_t WS_HD = 164 * MiB;
constexpr size_t WS_Y  = 292 * MiB;
constexpr size_t WS_MG = 324 * MiB;

__device__ __forceinline__ unsigned f2bf(float f) { unsigned u = __float_as_uint(f); return (u + 0x7fffu + ((u >> 16) & 1u)) >> 16; }
__device__ __forceinline__ float bf2f(bf16_t b) { return __uint_as_float((unsigned)b << 16); }
__device__ __forceinline__ float ldf(const float* p) { return *p; }
__device__ __forceinline__ float ldf(const bf16_t* p) { return bf2f(*p); }
__device__ __forceinline__ float sigmoidf_(float x) { return 1.f / (1.f + __expf(-x)); }
__device__ __forceinline__ float softplusf_(float x) { return x > 20.f ? x : log1pf(__expf(x)); }
__device__ __forceinline__ float siluf_(float x) { return x * sigmoidf_(x); }
__device__ __forceinline__ float geluf_(float x) { return 0.5f * x * (1.f + tanhf(0.7978845608028654f * (x + 0.044715f * x * x * x))); }
__device__ __forceinline__ float rl(float v, int i) { return __int_as_float(__builtin_amdgcn_readlane(__float_as_int(v), i)); }
__device__ __forceinline__ float wave_sum(float v) {
#pragma unroll
    for (int o = 1; o < 64; o <<= 1) v += __shfl_xor(v, o);
    return v;
}

template <class OT>
__device__ __forceinline__ void rmsnorm_rows(const float* X, const float* g, OT* O, int rows) {
    int tid_ = threadIdx.x; asm volatile("" : "+v"(tid_));
    const int lane = tid_ & 63, wv = tid_ >> 6;
    const int gw = blockIdx.x * (NT / 64) + wv, ngw = gridDim.x * (NT / 64);
    for (int r = gw; r < rows; r += ngw) {
        const float4* xr = (const float4*)(X + (size_t)r * D);
        float4 v[4]; float s = 0.f;
#pragma unroll
        for (int j = 0; j < 4; ++j) { v[j] = xr[lane + 64 * j]; s += v[j].x * v[j].x + v[j].y * v[j].y + v[j].z * v[j].z + v[j].w * v[j].w; }
        s = wave_sum(s);
        const float rs = rsqrtf(s * (1.f / D) + 1e-6f);
#pragma unroll
        for (int j = 0; j < 4; ++j) {
            const float4 gg = ((const float4*)g)[lane + 64 * j];
            const float4 o = make_float4(v[j].x * rs * gg.x, v[j].y * rs * gg.y, v[j].z * rs * gg.z, v[j].w * rs * gg.w);
            if constexpr (sizeof(OT) == 4) ((float4*)(O + (size_t)r * D))[lane + 64 * j] = o;
            else ((uint2*)(O + (size_t)r * D))[lane + 64 * j] = make_uint2(f2bf(o.x) | (f2bf(o.y) << 16), f2bf(o.z) | (f2bf(o.w) << 16));
        }
    }
}

namespace pg8 {
#define PG8_LAS __attribute__((address_space(3)))
typedef short bf16x8 __attribute__((ext_vector_type(8)));
typedef float f32x4 __attribute__((ext_vector_type(4)));
typedef unsigned u32x4 __attribute__((ext_vector_type(4)));
constexpr int BM = 256, BK = 64, HALF = 128, HTB = HALF * BK * 2  , STAGE_BYTES = 8 * HTB, NXCD = 8, WGM = 8;

__host__ __device__ __forceinline__ int lds_byte(int r, int c) { const int st = (r >> 4) * 2 + (c >> 5), rr = r & 15, cc = c & 31, ob = rr * 64 + cc * 2; return st * 1024 + (ob ^ (((ob >> 9) & 1) << 5)); }
__host__ __device__ __forceinline__ void stage_rc(int b, int& R, int& C) { const int st = b / 1024, sb = b % 1024, swz = sb ^ (((sb >> 9) & 1) << 5); R = (st >> 1) * 16 + swz / 64; C = (st & 1) * 32 + (swz % 64) / 2; }
__host__ __device__ __forceinline__ int perm32(int rho) { const int n = rho >> 4, i = rho & 15; return 8 * (i >> 2) + 4 * n + (i & 3); }

struct Unit { int pm, pn; };
struct Gemm { const bf16_t* A; const bf16_t* Bt; int M, N, K, lda, ldb, pad; };

struct StaticOrder {
    int nM, nN, nwg, G, c;
    __host__ __device__ void init(int M, int N, int G_, int c_) { nM = M / BM; nN = N / BM; nwg = nM * nN; G = G_; c = c_; }
    __host__ __device__ bool next(int i, Unit& u) const {
        const long L = (long)i * G + c; if (L >= nwg) return false;
        int wgid = (int)L; { const int q = nwg / NXCD, r = nwg % NXCD, xcd = wgid % NXCD, off = wgid / NXCD; wgid = (xcd < r ? xcd * (q + 1) : r * (q + 1) + (xcd - r) * q) + off; }
        const int nig = WGM * nN, gid = wgid / nig, fm = gid * WGM, gsz = (nM - fm) < WGM ? (nM - fm) : WGM;
        u.pm = fm + ((wgid % nig) % gsz); u.pn = (wgid % nig) / gsz; return true;
    }
    __device__ __forceinline__ void a_ready(const Unit&) const {}
    __device__ __forceinline__ void done(const Unit&) const {}
};


__device__ __forceinline__ unsigned cvt_pk_bf16(float lo, float hi) { unsigned r; asm volatile("v_cvt_pk_bf16_f32 %0, %1, %2" : "=v"(r) : "v"(lo), "v"(hi)); return r; }
__device__ __forceinline__ float sigm(float x) { return __builtin_amdgcn_rcpf(1.f + __expf(-x)); }
struct EpiProjP {
    static constexpr bool PERM = true, AFTER_DRAIN = false;
    bf16_t* PM; bf16_t* G;
    __device__ __forceinline__ void operator()(const f32x4 (&acc)[2][2][4][2], const Unit& u, int wr, int wc, int fr, int fq) const {
        const int row0 = u.pm * BM + wr * 64 + fr;
        const bool sg = u.pn >= 12;
        bf16_t* base = sg ? G : PM; const int ld = sg ? 4096 : 3072; const int colt = (sg ? u.pn - 12 : u.pn) * BM;
        const int col0 = colt + wc * 32 + 8 * fq;
#pragma unroll
        for (int ai = 0; ai < 2; ++ai)
#pragma unroll
            for (int m = 0; m < 4; ++m) { bf16_t* rowp = base + (size_t)(row0 + ai * HALF + m * 16) * ld + col0;
#pragma unroll
                for (int bj = 0; bj < 2; ++bj) { f32x4 v0 = acc[ai][bj][m][0], v1 = acc[ai][bj][m][1];
                    if (sg) { v0[0] = sigm(v0[0]); v0[1] = sigm(v0[1]); v0[2] = sigm(v0[2]); v0[3] = sigm(v0[3]); v1[0] = sigm(v1[0]); v1[1] = sigm(v1[1]); v1[2] = sigm(v1[2]); v1[3] = sigm(v1[3]); }
                    u32x4 w; w.x = cvt_pk_bf16(v0[0], v0[1]); w.y = cvt_pk_bf16(v0[2], v0[3]); w.z = cvt_pk_bf16(v1[0], v1[1]); w.w = cvt_pk_bf16(v1[2], v1[3]);
                    *(u32x4*)(rowp + bj * HALF) = w; } }
    }
};
struct EpiRelu2P {
    static constexpr bool PERM = true, AFTER_DRAIN = false;
    bf16_t* O; int ldo; int pad;
    __device__ __forceinline__ void operator()(const f32x4 (&acc)[2][2][4][2], const Unit& u, int wr, int wc, int fr, int fq) const {
        const int row0 = u.pm * BM + wr * 64 + fr, col0 = u.pn * BM + wc * 32 + 8 * fq;
#pragma unroll
        for (int ai = 0; ai < 2; ++ai)
#pragma unroll
            for (int m = 0; m < 4; ++m) { bf16_t* rowp = O + (size_t)(row0 + ai * HALF + m * 16) * ldo + col0;
#pragma unroll
                for (int bj = 0; bj < 2; ++bj) { f32x4 v0 = acc[ai][bj][m][0], v1 = acc[ai][bj][m][1];
#pragma unroll
                    for (int j = 0; j < 4; ++j) { const float a = fmaxf(v0[j], 0.f), b = fmaxf(v1[j], 0.f); v0[j] = a * a; v1[j] = b * b; }
                    u32x4 w; w.x = cvt_pk_bf16(v0[0], v0[1]); w.y = cvt_pk_bf16(v0[2], v0[3]); w.z = cvt_pk_bf16(v1[0], v1[1]); w.w = cvt_pk_bf16(v1[2], v1[3]);
                    *(u32x4*)(rowp + bj * HALF) = w; } }
    }
};
struct EpiResidP {
    static constexpr bool PERM = false, AFTER_DRAIN = false;
    const float* base; float* out;
    __device__ __forceinline__ void operator()(const f32x4 (&acc)[2][2][4][2], const Unit& u, int wr, int wc, int fr, int fq) const {
        const int row0 = u.pm * BM + wr * 64 + fr, col0 = u.pn * BM + wc * 32 + 4 * fq;
#pragma unroll
        for (int ai = 0; ai < 2; ++ai)
#pragma unroll
            for (int m = 0; m < 4; ++m) { const size_t off = (size_t)(row0 + ai * HALF + m * 16) * 1024 + col0;
#pragma unroll
                for (int bj = 0; bj < 2; ++bj)
#pragma unroll
                    for (int n = 0; n < 2; ++n) { const f32x4 b = *(const f32x4*)(base + off + bj * HALF + n * 16); *(f32x4*)(out + off + bj * HALF + n * 16) = b + acc[ai][bj][m][n]; } }
    }
};
template <class Epi, class Sched, bool ALIGN_EPI = false, bool SP2 = false>
__device__ __forceinline__ void gemm_phase(PG8_LAS unsigned char* lds, const Gemm g, const Sched& S, const Epi& E) {
    int tid = threadIdx.x; asm volatile("" : "+v"(tid));
    const int wid = __builtin_amdgcn_readfirstlane(tid >> 6), lane = tid & 63, wr = wid >> 2, wc = wid & 3, fr = lane & 15, fq = lane >> 4;
    const int K = g.K, nt = K / BK;
    unsigned voffA[2], voffB[2];
#pragma unroll
    for (int i = 0; i < 2; ++i) { int R, C; stage_rc(tid * 16 + i * 8192, R, C); const int Rb = Epi::PERM ? ((R & ~31) + perm32(R & 31)) : R;
        voffA[i] = (unsigned)(R * g.lda + C) * 2u; voffB[i] = (unsigned)(Rb * g.ldb + C) * 2u; }
    const size_t kstep = (size_t)(BK * 2);
    const size_t hstepA = (size_t)HALF * g.lda * 2, hstepB = (size_t)HALF * g.ldb * 2;
    const size_t tstepA = 2 * hstepA, tstepB = 2 * hstepB;
    const unsigned ldsw = (unsigned)wid * 1024u;
    const int aoff = lds_byte(wr * 64 + fr, fq * 8), boff = lds_byte(wc * 32 + fr, fq * 8);
#define PG8_SA(b, h) (((b) * 2 + (h)) * HTB)
#define PG8_SB(b, h) ((4 + (b) * 2 + (h)) * HTB)
#define PG8_STAGE(bufoff, gbase, voff) do { _Pragma("unroll") for (int _i = 0; _i < 2; ++_i) \
        __builtin_amdgcn_global_load_lds((const unsigned*)((const char*)(gbase) + (voff)[_i]), (PG8_LAS unsigned*)(lds + (bufoff) + ldsw + _i * 8192), 16, 0, 0); } while (0)
#define PG8_LDA(dst, b, h) do { _Pragma("unroll") for (int m = 0; m < 4; ++m) _Pragma("unroll") for (int k = 0; k < 2; ++k) dst[m][k] = *(const PG8_LAS bf16x8*)(lds + PG8_SA(b, h) + aoff + m * 2048 + k * 1024); } while (0)
#define PG8_LDB(dst, b, h) do { _Pragma("unroll") for (int n = 0; n < 2; ++n) _Pragma("unroll") for (int k = 0; k < 2; ++k) dst[n][k] = *(const PG8_LAS bf16x8*)(lds + PG8_SB(b, h) + boff + n * 2048 + k * 1024); } while (0)
#define PG8_MMA(ai, bj, At, Bt) do { __builtin_amdgcn_s_setprio(1); _Pragma("unroll") for (int m = 0; m < 4; ++m) _Pragma("unroll") for (int n = 0; n < 2; ++n) _Pragma("unroll") for (int k = 0; k < 2; ++k) \
        acc[ai][bj][m][n] = __builtin_amdgcn_mfma_f32_16x16x32_bf16(Bt[n][k], At[m][k], acc[ai][bj][m][n], 0, 0, 0); __builtin_amdgcn_s_setprio(0); } while (0)
#define PG8_WAIT_V(n) asm volatile("s_waitcnt vmcnt(" #n ")" ::: "memory")
#define PG8_WAIT_L(n) asm volatile("s_waitcnt lgkmcnt(" #n ")" ::: "memory")
#define PG8_BAR __builtin_amdgcn_s_barrier()
#define PG8_SCHED __builtin_amdgcn_sched_barrier(0)
    Unit cur, nxt; int ui = 0;
    if (!S.next(0, cur)) return;
    f32x4 acc[2][2][4][2];
#pragma unroll
    for (int a = 0; a < 2; ++a)
#pragma unroll
        for (int b = 0; b < 2; ++b)
#pragma unroll
            for (int m = 0; m < 4; ++m)
#pragma unroll
                for (int n = 0; n < 2; ++n) acc[a][b][m][n] = (f32x4){0.f, 0.f, 0.f, 0.f};
    bf16x8 At[4][2], B0[2][2], B1[2][2];
    const char* cA = (const char*)g.A + (size_t)cur.pm * tstepA; const char* cB = (const char*)g.Bt + (size_t)cur.pn * tstepB;
    S.a_ready(cur);
    if constexpr (SP2) {
        PG8_STAGE(PG8_SB(0, 0), cB, voffB); PG8_STAGE(PG8_SB(0, 1), cB + hstepB, voffB); PG8_STAGE(PG8_SA(0, 0), cA, voffA); PG8_STAGE(PG8_SA(0, 1), cA + hstepA, voffA);
        if (wr == 1) PG8_BAR;
        PG8_WAIT_V(2); PG8_BAR;
        PG8_STAGE(PG8_SB(1, 0), cB + kstep, voffB); PG8_STAGE(PG8_SA(1, 0), cA + kstep, voffA); PG8_STAGE(PG8_SB(1, 1), cB + hstepB + kstep, voffB);
        PG8_WAIT_V(6); PG8_BAR;
    } else {
        PG8_STAGE(PG8_SB(0, 0), cB, voffB); PG8_STAGE(PG8_SA(0, 0), cA, voffA); PG8_STAGE(PG8_SB(0, 1), cB + hstepB, voffB); PG8_STAGE(PG8_SA(0, 1), cA + hstepA, voffA);
        if (wr == 1) PG8_BAR;
        PG8_WAIT_V(4); PG8_BAR;
        PG8_STAGE(PG8_SB(1, 0), cB + kstep, voffB); PG8_STAGE(PG8_SA(1, 0), cA + kstep, voffA); PG8_STAGE(PG8_SB(1, 1), cB + hstepB + kstep, voffB);
        PG8_WAIT_V(6); PG8_BAR;
    }
    for (;;) {
        const bool has_next = S.next(ui + 1, nxt);
        const char* nA = has_next ? (const char*)g.A + (size_t)nxt.pm * tstepA : cA; const char* nB = has_next ? (const char*)g.Bt + (size_t)nxt.pn * tstepB : cB;
        for (int t = 0; t < nt; t += 2) {
            const bool last = (t == nt - 2);
            const char* a1 = cA + (size_t)(t + 1) * kstep;
            const char* a2 = last ? nA : cA + (size_t)(t + 2) * kstep; const char* b2 = last ? nB : cB + (size_t)(t + 2) * kstep;
            const char* a3 = a2 + kstep; const char* b3 = b2 + kstep;
            if (last && has_next) S.a_ready(nxt);
            if constexpr (SP2) {
            PG8_LDB(B0, 0, 0); PG8_LDB(B1, 0, 1); PG8_SCHED; PG8_LDA(At, 0, 0); PG8_STAGE(PG8_SA(1, 1), a1 + hstepA, voffA);
            PG8_WAIT_V(8); PG8_WAIT_L(0); PG8_BAR; PG8_MMA(0, 0, At, B0); PG8_MMA(0, 1, At, B1); PG8_BAR; PG8_SCHED;
            PG8_LDA(At, 0, 1); PG8_STAGE(PG8_SB(0, 0), b2, voffB); PG8_STAGE(PG8_SB(0, 1), b2 + hstepB, voffB); PG8_STAGE(PG8_SA(0, 0), a2, voffA);
            PG8_WAIT_V(8); PG8_WAIT_L(0); PG8_BAR; PG8_MMA(1, 0, At, B0); PG8_MMA(1, 1, At, B1); PG8_BAR; PG8_SCHED;
            PG8_LDB(B0, 1, 0); PG8_LDB(B1, 1, 1); PG8_SCHED; PG8_LDA(At, 1, 0); PG8_STAGE(PG8_SA(0, 1), a2 + hstepA, voffA);
            PG8_WAIT_V(8); PG8_WAIT_L(0); PG8_BAR; PG8_MMA(0, 0, At, B0); PG8_MMA(0, 1, At, B1); PG8_BAR; PG8_SCHED;
            PG8_LDA(At, 1, 1); PG8_STAGE(PG8_SB(1, 0), b3, voffB); PG8_STAGE(PG8_SB(1, 1), b3 + hstepB, voffB); PG8_STAGE(PG8_SA(1, 0), a3, voffA);
            PG8_WAIT_V(8); PG8_WAIT_L(0); PG8_BAR; PG8_MMA(1, 0, At, B0); PG8_MMA(1, 1, At, B1); PG8_BAR; PG8_SCHED;
            } else {
            PG8_LDB(B0, 0, 0); PG8_SCHED; PG8_LDA(At, 0, 0); PG8_STAGE(PG8_SA(1, 1), a1 + hstepA, voffA);
            PG8_WAIT_L(8); PG8_BAR; PG8_WAIT_L(0); PG8_MMA(0, 0, At, B0); PG8_BAR; PG8_SCHED;
            PG8_LDB(B1, 0, 1); PG8_STAGE(PG8_SB(0, 0), b2, voffB);
            PG8_BAR; PG8_WAIT_L(0); PG8_MMA(0, 1, At, B1); PG8_BAR;
            PG8_LDA(At, 0, 1); PG8_STAGE(PG8_SA(0, 0), a2, voffA);
            PG8_BAR; PG8_WAIT_L(0); PG8_MMA(1, 0, At, B0); PG8_BAR; PG8_SCHED;
            PG8_STAGE(PG8_SB(0, 1), b2 + hstepB, voffB);
            PG8_WAIT_V(6); PG8_BAR; PG8_MMA(1, 1, At, B1); PG8_BAR;
            PG8_LDB(B0, 1, 0); PG8_SCHED; PG8_LDA(At, 1, 0); PG8_STAGE(PG8_SA(0, 1), a2 + hstepA, voffA);
            PG8_WAIT_L(8); PG8_BAR; PG8_WAIT_L(0); PG8_MMA(0, 0, At, B0); PG8_BAR; PG8_SCHED;
            PG8_LDB(B1, 1, 1); PG8_STAGE(PG8_SB(1, 0), b3, voffB);
            PG8_BAR; PG8_WAIT_L(0); PG8_MMA(0, 1, At, B1); PG8_BAR;
            PG8_LDA(At, 1, 1); PG8_STAGE(PG8_SA(1, 0), a3, voffA);
            PG8_BAR; PG8_WAIT_L(0); PG8_MMA(1, 0, At, B0); PG8_BAR; PG8_SCHED;
            PG8_STAGE(PG8_SB(1, 1), b3 + hstepB, voffB);
            PG8_WAIT_V(6); PG8_BAR; PG8_MMA(1, 1, At, B1); PG8_BAR;
            }
        }
        if constexpr (ALIGN_EPI) { if (wr == 0) PG8_BAR; }
        if constexpr (!Epi::AFTER_DRAIN) { E(acc, cur, wr, wc, fr, fq); S.done(cur); }
        if (!has_next) break;
#pragma unroll
        for (int a = 0; a < 2; ++a)
#pragma unroll
            for (int b = 0; b < 2; ++b)
#pragma unroll
                for (int m = 0; m < 4; ++m)
#pragma unroll
                    for (int n = 0; n < 2; ++n) acc[a][b][m][n] = (f32x4){0.f, 0.f, 0.f, 0.f};
        cur = nxt; cA = nA; cB = nB; ++ui;
        if constexpr (ALIGN_EPI) { if (wr == 1) PG8_BAR; }
    }
    PG8_WAIT_V(0);
    if constexpr (!ALIGN_EPI) { if (wr == 0) PG8_BAR; }
    PG8_BAR;
    if constexpr (Epi::AFTER_DRAIN) { E.fused(acc, cur, wr, wc, fr, fq, lds, wid, lane); S.done(cur); }
#undef PG8_SA
#undef PG8_SB
#undef PG8_STAGE
#undef PG8_LDA
#undef PG8_LDB
#undef PG8_MMA
#undef PG8_WAIT_V
#undef PG8_WAIT_L
#undef PG8_BAR
#undef PG8_SCHED
}
}


__device__ __forceinline__ unsigned pk2(float lo, float hi) { return f2bf(lo) | (f2bf(hi) << 16); }
template <class CM>
__device__ __forceinline__ void transpose_item(const float* __restrict__ Wsrc, int K, int ldsrc, bf16_t* __restrict__ WT, int nblk, LAS float* scr, int item, int lane, CM colmap) {
    const int kb = item / nblk, nb = item % nblk, k0 = 64 * kb, n0 = 32 * nb;
    const int sc = colmap(n0 + (lane & 31));
#pragma unroll 8
    for (int i = 0; i < 32; ++i) { const int kk = 2 * i + (lane >> 5); scr[kk * 33 + (lane & 31)] = sc >= 0 ? Wsrc[(size_t)(k0 + kk) * ldsrc + sc] : 0.f; }
    asm volatile("s_waitcnt lgkmcnt(0)" ::: "memory");
    const int c = lane & 7;
#pragma unroll
    for (int j = 0; j < 4; ++j) { const int n = (lane >> 3) + 8 * j; const LAS float* s = scr + (8 * c) * 33 + n;
        uint4 o; o.x = pk2(s[0 * 33], s[1 * 33]); o.y = pk2(s[2 * 33], s[3 * 33]); o.z = pk2(s[4 * 33], s[5 * 33]); o.w = pk2(s[6 * 33], s[7 * 33]);
        *(uint4*)(WT + (size_t)(n0 + n) * K + k0 + 8 * c) = o; }
    asm volatile("s_waitcnt lgkmcnt(0)" ::: "memory");
}
constexpr size_t WO_IN = 0;
constexpr size_t WO_BR = WO_IN + (size_t)7168 * 1024;
constexpr size_t WO_OUT = WO_BR + (size_t)4 * 1024 * 256;
constexpr size_t WO_W1 = WO_OUT + (size_t)1024 * 1024;
constexpr size_t WO_W2 = WO_W1 + (size_t)4096 * 1024;
constexpr size_t WO_WUP = WO_W2 + (size_t)4096 * 1024;
constexpr size_t WO_AUP = WO_WUP + 256 * 64;
constexpr size_t WO_GUP = WO_AUP + 256 * 64;
constexpr size_t WO_GLU = WO_GUP + 256 * 128;
constexpr size_t WO_LWT = WO_GLU + 256 * 256;
constexpr size_t WO_LAYER = WO_LWT + 2 * 16384;
__device__ __forceinline__ void convert_weights(const Params& p, int l, LAS float* scr, int gw, int ngw, int lane) {
    bf16_t* WB = (bf16_t*)(p.ws() + WS_W);
    constexpr int I_IN = (1024 / 64) * (7168 / 32), I_BR = (256 / 64) * (1024 / 32), I_OUT = (1024 / 64) * (1024 / 32), I_W1 = (1024 / 64) * (4096 / 32), I_W2 = (4096 / 64) * (1024 / 32);
    constexpr int I_UP = 8, I_GUP = 16, I_GLU = 4 * 8, I_LW = 16;
    constexpr int PER_LAYER = I_IN + 4 * I_BR + I_OUT + I_W1 + I_W2 + 2 * I_UP + I_GUP + I_GLU + I_LW;
    for (int it = gw; it < PER_LAYER; it += ngw) {
        int r = it;
        bf16_t* WL = WB;
        if (r < I_IN) { transpose_item(p.in[2] + (size_t)l * D * DIN, 1024, DIN, WL + WO_IN, 7168 / 32, scr, r, lane, [](int j) { return j < NMIX ? j : (j < 3072 ? -1 : j - 248); }); continue; } r -= I_IN;
        if (r < 4 * I_BR) { const int i = r / I_BR; transpose_item(p.in[35] + ((size_t)l * 4 + i) * W * D, 256, D, WL + WO_BR + (size_t)i * 1024 * 256, 1024 / 32, scr, r % I_BR, lane, [](int j) { return j; }); continue; } r -= 4 * I_BR;
        if (r < I_OUT) { transpose_item(p.in[36] + (size_t)l * D * D, 1024, D, WL + WO_OUT, 1024 / 32, scr, r, lane, [](int j) { return j; }); continue; } r -= I_OUT;
        if (r < I_W1) { transpose_item(p.in[38] + (size_t)l * D * DFF, 1024, DFF, WL + WO_W1, 4096 / 32, scr, r, lane, [](int j) { return j; }); continue; } r -= I_W1;
        if (r < I_W2) { transpose_item(p.in[39] + (size_t)l * DFF * D, 4096, D, WL + WO_W2, 1024 / 32, scr, r, lane, [](int j) { return j; }); continue; } r -= I_W2;
        if (r < I_UP) { transpose_item(p.in[26] + (size_t)l * 64 * W, 64, W, WL + WO_WUP, 8, scr, r, lane, [](int j) { return j; }); continue; } r -= I_UP;
        if (r < I_UP) { transpose_item(p.in[28] + (size_t)l * 64 * W, 64, W, WL + WO_AUP, 8, scr, r, lane, [](int j) { return j; }); continue; } r -= I_UP;
        if (r < I_GUP) { transpose_item(p.in[29] + (size_t)l * 128 * W, 128, W, WL + WO_GUP, 8, scr, r, lane, [](int j) { return j; }); continue; } r -= I_GUP;
        if (r < I_GLU) { transpose_item(p.in[22] + (size_t)l * W * W, 256, W, WL + WO_GLU, 8, scr, r, lane, [](int j) { return j; }); continue; } r -= I_GLU;
        { const int gt = r >> 3, nb = (r >> 1) & 3; transpose_item((gt ? p.in[11] : p.in[9]) + (size_t)l * 16384 + nb * 4096, 64, 64, WL + WO_LWT + (size_t)gt * 16384 + nb * 4096, 2, scr, r & 1, lane, [](int j) { return j; }); }
    }
}
typedef short bf16x8_t __attribute__((ext_vector_type(8)));
typedef float f32x4_t __attribute__((ext_vector_type(4)));
constexpr int PT = 68;
constexpr int MS = 64 * PT;
__device__ __forceinline__ unsigned cvtpk(float lo, float hi) { unsigned r; asm volatile("v_cvt_pk_bf16_f32 %0, %1, %2" : "=v"(r) : "v"(lo), "v"(hi)); return r; }
typedef unsigned u32x4_t __attribute__((ext_vector_type(4)));
union U8 { bf16x8_t v; unsigned u[4]; uint4 q; u32x4_t x; };
__device__ __forceinline__ void split8(const float (&x)[8], bf16x8_t& hi, bf16x8_t& lo) {
    U8 H, L;
#pragma unroll
    for (int i = 0; i < 4; ++i) {
        const unsigned pk = cvtpk(x[2 * i], x[2 * i + 1]);
        H.u[i] = pk;
        const float f0 = __uint_as_float(pk << 16), f1 = __uint_as_float(pk & 0xffff0000u);
        L.u[i] = cvtpk(x[2 * i] - f0, x[2 * i + 1] - f1);
    }
    hi = H.v; lo = L.v;
}
__device__ __forceinline__ bf16x8_t hi8(const float (&x)[8]) {
    U8 H;
#pragma unroll
    for (int i = 0; i < 4; ++i) H.u[i] = cvtpk(x[2 * i], x[2 * i + 1]);
    return H.v;
}
template <int NSPLIT>
__device__ __forceinline__ f32x4_t mm_tile(const LAS float* A, const LAS float* Bt, int lane, f32x4_t acc) {
    const LAS float* ap = A + (lane & 15) * PT + 8 * (lane >> 4);
    const LAS float* bp = Bt + (lane & 15) * PT + 8 * (lane >> 4);
#pragma unroll
    for (int ks = 0; ks < 2; ++ks) {
        const f32x4_t a0 = *(const LAS f32x4_t*)(ap + 32 * ks), a1 = *(const LAS f32x4_t*)(ap + 32 * ks + 4);
        const f32x4_t b0 = *(const LAS f32x4_t*)(bp + 32 * ks), b1 = *(const LAS f32x4_t*)(bp + 32 * ks + 4);
        const float av[8] = {a0.x, a0.y, a0.z, a0.w, a1.x, a1.y, a1.z, a1.w};
        const float bv[8] = {b0.x, b0.y, b0.z, b0.w, b1.x, b1.y, b1.z, b1.w};
        if constexpr (NSPLIT == 3) {
            bf16x8_t ah, al, bh, bl; split8(av, ah, al); split8(bv, bh, bl);
            acc = __builtin_amdgcn_mfma_f32_16x16x32_bf16(ah, bh, acc, 0, 0, 0);
            acc = __builtin_amdgcn_mfma_f32_16x16x32_bf16(ah, bl, acc, 0, 0, 0);
            acc = __builtin_amdgcn_mfma_f32_16x16x32_bf16(al, bh, acc, 0, 0, 0);
        } else {
            acc = __builtin_amdgcn_mfma_f32_16x16x32_bf16(hi8(av), hi8(bv), acc, 0, 0, 0);
        }
    }
    return acc;
}
__device__ __forceinline__ int opq_tid() { int t = threadIdx.x; asm volatile("" : "+v"(t)); return t; }
__device__ __forceinline__ void tri_inverse_wave(LAS float* L, int lane) {
    asm volatile("" : "+v"(lane));
    asm volatile("" : "+v"(L));
    const float lf = (float)lane;
    float x[64];
#pragma unroll
    for (int i = 0; i < 64; ++i) {
        float s0 = 0.f, s1 = 0.f, s2 = 0.f, s3 = 0.f;
#pragma unroll
        for (int g4 = 0; g4 * 4 < i; ++g4) {
            const f32x4_t l = *(const LAS f32x4_t*)(L + i * PT + 4 * g4);
            s0 = fmaf(l.x, x[4 * g4], s0);
            if (4 * g4 + 1 < i) s1 = fmaf(l.y, x[4 * g4 + 1], s1);
            if (4 * g4 + 2 < i) s2 = fmaf(l.z, x[4 * g4 + 2], s2);
            if (4 * g4 + 3 < i) s3 = fmaf(l.w, x[4 * g4 + 3], s3);
        }
        x[i] = fmaxf(1.f - fabsf(lf - (float)i), 0.f) - ((s0 + s1) + (s2 + s3));
        L[i * PT + lane] = x[i];
        if ((i & 3) == 3) __builtin_amdgcn_sched_barrier(0);
    }
}
__device__ __forceinline__ float wave_incl_scan(float v, int lane) {
#pragma unroll
    for (int o = 1; o < 64; o <<= 1) { const float u = __shfl_up(v, o); if (lane >= o) v += u; }
    return v;
}

__device__ __forceinline__ void merge_phase(const bf16_t* __restrict__ Yb, const bf16_t* __restrict__ WbT, const bf16_t* __restrict__ G, bf16_t* __restrict__ MG, LAS unsigned char* lds) {
    const int tid = opq_tid(), w = __builtin_amdgcn_readfirstlane(tid >> 6), lane = tid & 63, q4 = lane >> 4, cc = lane & 15;
    const int wr = w >> 2, wc = w & 3;
    constexpr int PA = 144;
    constexpr int ABUF = 256 * PA, BBUF = 128 * PA, BUF = ABUF + BBUF;
    const int bid = blockIdx.x, G_ = gridDim.x;
    const int arow = tid >> 1, ahalf = tid & 1;
    const int brow = tid >> 2, bq = tid & 3;
    for (int it = 0; ; ++it) {
        const int U = it * G_ + bid;
        if (U >= 512) break;
        const int Lx = (G_ == 256) ? ((bid & 7) * 64 + it * 32 + (bid >> 3)) : U;
        const int pm = Lx >> 3, pn = Lx & 7;
        const bf16_t* Abase = Yb + (size_t)(pm * 256 + arow) * 1024 + ahalf * 32;
        const bf16_t* Bbase = WbT + (size_t)(pn * 128 + brow) * 256 + bq * 16;
        f32x4_t mg[8][2];
#pragma unroll
        for (int m = 0; m < 8; ++m)
#pragma unroll
            for (int n = 0; n < 2; ++n) mg[m][n] = (f32x4_t){0.f, 0.f, 0.f, 0.f};
        uint4 sa[4], sb[2];
#define MERGE_LOAD(s_) do { const int br_ = (s_) >> 2, kq_ = (s_) & 3; const bf16_t* ap_ = Abase + br_ * 256 + kq_ * 64; const bf16_t* bp_ = Bbase + (size_t)br_ * 1024 * 256 + kq_ * 64; \
            _Pragma("unroll") for (int j = 0; j < 4; ++j) sa[j] = *(const uint4*)(ap_ + 8 * j); \
            _Pragma("unroll") for (int j = 0; j < 2; ++j) sb[j] = *(const uint4*)(bp_ + 8 * j); } while (0)
#define MERGE_STORE(buf_) do { LAS unsigned char* ab_ = lds + (buf_) * BUF + arow * PA + ahalf * 64; LAS unsigned char* bb_ = lds + (buf_) * BUF + ABUF + brow * PA + bq * 32; \
            _Pragma("unroll") for (int j = 0; j < 4; ++j) *(LAS u32x4_t*)(ab_ + 16 * j) = (u32x4_t){sa[j].x, sa[j].y, sa[j].z, sa[j].w}; \
            _Pragma("unroll") for (int j = 0; j < 2; ++j) *(LAS u32x4_t*)(bb_ + 16 * j) = (u32x4_t){sb[j].x, sb[j].y, sb[j].z, sb[j].w}; } while (0)
        MERGE_LOAD(0);
        MERGE_STORE(0);
        __syncthreads();
        f32x4_t acc[8][2];
#pragma unroll 1
        for (int s = 0; s < 16; ++s) {
            const int buf = s & 1;
            if ((s & 3) == 0) {
#pragma unroll
                for (int m = 0; m < 8; ++m)
#pragma unroll
                    for (int n = 0; n < 2; ++n) acc[m][n] = (f32x4_t){0.f, 0.f, 0.f, 0.f};
            }
            if (s + 1 < 16) MERGE_LOAD(s + 1);
            {
                const LAS unsigned char* ab = lds + buf * BUF + (wr * 128 + cc) * PA + 16 * q4;
                const LAS unsigned char* bb = lds + buf * BUF + ABUF + (wc * 32 + cc) * PA + 16 * q4;
#pragma unroll
                for (int ks = 0; ks < 2; ++ks) {
                    U8 bf[2];
#pragma unroll
                    for (int n = 0; n < 2; ++n) bf[n].x = *(const LAS u32x4_t*)(bb + n * 16 * PA + ks * 64);
#pragma unroll
                    for (int m = 0; m < 8; ++m) {
                        U8 af; af.x = *(const LAS u32x4_t*)(ab + m * 16 * PA + ks * 64);
#pragma unroll
                        for (int n = 0; n < 2; ++n) acc[m][n] = __builtin_amdgcn_mfma_f32_16x16x32_bf16(bf[n].v, af.v, acc[m][n], 0, 0, 0);
                    }
                }
            }
            if ((s & 3) == 3) {
                const int br = s >> 2;
                const bf16_t* gp = G + (size_t)(pm * 256 + wr * 128 + cc) * 4096 + br * 1024 + pn * 128 + wc * 32 + 4 * q4;
#pragma unroll
                for (int m = 0; m < 8; ++m)
#pragma unroll
                    for (int n = 0; n < 2; ++n) {
                        const uint2 g2 = *(const uint2*)(gp + (size_t)m * 16 * 4096 + n * 16);
                        mg[m][n][0] = fmaf(__uint_as_float(g2.x << 16), acc[m][n][0], mg[m][n][0]);
                        mg[m][n][1] = fmaf(__uint_as_float(g2.x & 0xffff0000u), acc[m][n][1], mg[m][n][1]);
                        mg[m][n][2] = fmaf(__uint_as_float(g2.y << 16), acc[m][n][2], mg[m][n][2]);
                        mg[m][n][3] = fmaf(__uint_as_float(g2.y & 0xffff0000u), acc[m][n][3], mg[m][n][3]);
                    }
            }
            if (s + 1 < 16) MERGE_STORE(buf ^ 1);
            __syncthreads();
        }
        {
            bf16_t* op = MG + (size_t)(pm * 256 + wr * 128 + cc) * 1024 + pn * 128 + wc * 32 + 4 * q4;
#pragma unroll
            for (int m = 0; m < 8; ++m)
#pragma unroll
                for (int n = 0; n < 2; ++n) *(uint2*)(op + (size_t)m * 16 * 1024 + n * 16) = make_uint2(cvtpk(mg[m][n][0], mg[m][n][1]), cvtpk(mg[m][n][2], mg[m][n][3]));
        }
#undef MERGE_LOAD
#undef MERGE_STORE
    }
}

struct GdnBufs { bf16_t *GQ, *GK, *GV; float *GB, *GC; uint4* MF; float* NF; float* HT; };
__device__ __forceinline__ void gdn_prep_chunk(const bf16_t* __restrict__ PM, int n, const GdnBufs& B, const Params& p, int l, LAS float* lds) {
    const int tid = opq_tid(), w = tid >> 6, lane = tid & 63;
    const float* conv_w = p.in[3] + l * 4 * 768;
    const int t0 = n * 64;
    float wq[4][4], wk[4][4], wv[4][4];
#pragma unroll
    for (int t = 0; t < 4; ++t)
#pragma unroll
        for (int j = 0; j < 4; ++j) { wq[t][j] = conv_w[t * 768 + 4 * lane + j]; wk[t][j] = conv_w[t * 768 + 256 + 4 * lane + j]; wv[t][j] = conv_w[t * 768 + 512 + 4 * lane + j]; }
    float hq[3][4], hk[3][4], hv[3][4];
    auto ld4 = [&](int t, int col, float (&o)[4]) {
        if (t < 0) { o[0] = o[1] = o[2] = o[3] = 0.f; return; }
        const uint2 u = *(const uint2*)(PM + (size_t)t * PMLD + col);
        o[0] = __uint_as_float(u.x << 16); o[1] = __uint_as_float(u.x & 0xffff0000u); o[2] = __uint_as_float(u.y << 16); o[3] = __uint_as_float(u.y & 0xffff0000u);
    };
    const int tw = t0 + 8 * w;
#pragma unroll
    for (int i = 0; i < 3; ++i) { ld4(tw - 3 + i, 4 * lane, hq[i]); ld4(tw - 3 + i, 256 + 4 * lane, hk[i]); ld4(tw - 3 + i, 512 + 4 * lane, hv[i]); }
#pragma unroll
    for (int i = 0; i < 8; ++i) {
        const int t = tw + i;
        float pq[4], pk[4], pv[4], q[4], k[4], v[4];
        ld4(t, 4 * lane, pq); ld4(t, 256 + 4 * lane, pk); ld4(t, 512 + 4 * lane, pv);
        float sq = 0.f, sk = 0.f;
#pragma unroll
        for (int j = 0; j < 4; ++j) {
            q[j] = siluf_(wq[0][j] * hq[0][j] + wq[1][j] * hq[1][j] + wq[2][j] * hq[2][j] + wq[3][j] * pq[j]);
            k[j] = siluf_(wk[0][j] * hk[0][j] + wk[1][j] * hk[1][j] + wk[2][j] * hk[2][j] + wk[3][j] * pk[j]);
            v[j] = siluf_(wv[0][j] * hv[0][j] + wv[1][j] * hv[1][j] + wv[2][j] * hv[2][j] + wv[3][j] * pv[j]);
            hq[0][j] = hq[1][j]; hq[1][j] = hq[2][j]; hq[2][j] = pq[j];
            hk[0][j] = hk[1][j]; hk[1][j] = hk[2][j]; hk[2][j] = pk[j];
            hv[0][j] = hv[1][j]; hv[1][j] = hv[2][j]; hv[2][j] = pv[j];
            sq = fmaf(q[j], q[j], sq); sk = fmaf(k[j], k[j], sk);
        }
#pragma unroll
        for (int o = 1; o < 16; o <<= 1) { sq += __shfl_xor(sq, o); sk += __shfl_xor(sk, o); }
        const float rq = rsqrtf(sq + 1e-6f) * 0.125f, rk = rsqrtf(sk + 1e-6f);
        uint2 oq, ok, ov;
        oq.x = cvtpk(q[0] * rq, q[1] * rq); oq.y = cvtpk(q[2] * rq, q[3] * rq);
        ok.x = cvtpk(k[0] * rk, k[1] * rk); ok.y = cvtpk(k[2] * rk, k[3] * rk);
        ov.x = cvtpk(v[0], v[1]); ov.y = cvtpk(v[2], v[3]);
        *(uint2*)(B.GQ + (size_t)t * 256 + 4 * lane) = oq;
        *(uint2*)(B.GK + (size_t)t * 256 + 4 * lane) = ok;
        *(uint2*)(B.GV + (size_t)t * 256 + 4 * lane) = ov;
    }
    if (tid < 256) {
        const int t = tid >> 2, h = tid & 3;
        const bf16_t* row = PM + (size_t)(t0 + t) * PMLD;
        B.GB[(size_t)(t0 + t) * 4 + h] = sigmoidf_(bf2f(row[1024 + h]));
        const float g = -__expf(p.in[4][l * 4 + h]) * softplusf_(bf2f(row[1028 + h]) + p.in[5][l * 4 + h]);
        lds[h * 64 + t] = g;
    }
    __syncthreads();
    if (w == 0) {
#pragma unroll
        for (int h = 0; h < 4; ++h) B.GC[(size_t)(t0 + lane) * 4 + h] = wave_incl_scan(lds[h * 64 + lane], lane);
    }
    __syncthreads();
}

__device__ __forceinline__ void gdn_g1_unit(int h, int n, const GdnBufs& B, LAS float* lds) {
    const int tid = opq_tid(), w = tid >> 6, lane = tid & 63, q4 = lane >> 4, cc = lane & 15;
    LAS float* Kr = lds; LAS float* KdT = lds + MS; LAS float* KbT = lds + 2 * MS; LAS float* VbT = lds + 3 * MS; LAS float* Lm = lds + 4 * MS; LAS float* WmT = lds + 5 * MS;
    LAS float* U0T = Kr;
    LAS float* sb = lds + 6 * MS; LAS float* sg = sb + 64;
    const int t0 = n * 64, u = h * 256 + n;
    {
        const int c = tid >> 3, d0 = (tid & 7) * 8;
        const float beta = B.GB[(size_t)(t0 + c) * 4 + h], gc = B.GC[(size_t)(t0 + c) * 4 + h], gl = B.GC[(size_t)(t0 + 63) * 4 + h];
        const uint4 k8 = *(const uint4*)(B.GK + (size_t)(t0 + c) * 256 + h * 64 + d0);
        const uint4 v8 = *(const uint4*)(B.GV + (size_t)(t0 + c) * 256 + h * 64 + d0);
        const float e1 = __expf(gl - gc), e2 = beta * __expf(gc);
        const unsigned ku[4] = {k8.x, k8.y, k8.z, k8.w}, vu[4] = {v8.x, v8.y, v8.z, v8.w};
#pragma unroll
        for (int i = 0; i < 8; ++i) {
            const float kf = __uint_as_float((i & 1) ? (ku[i >> 1] & 0xffff0000u) : (ku[i >> 1] << 16));
            const float vf = __uint_as_float((i & 1) ? (vu[i >> 1] & 0xffff0000u) : (vu[i >> 1] << 16));
            Kr[c * PT + d0 + i] = kf; KdT[(d0 + i) * PT + c] = kf * e1; KbT[(d0 + i) * PT + c] = kf * e2; VbT[(d0 + i) * PT + c] = beta * vf;
        }
        if ((tid & 7) == 0) { sb[c] = beta; sg[c] = gc; }
    }
    __syncthreads();
    const int ti = w >> 1, tj0 = (w & 1) * 2;
    const f32x4_t zero4 = {0.f, 0.f, 0.f, 0.f};
#pragma unroll
    for (int tt = 0; tt < 2; ++tt) {
        const int tj = tj0 + tt;
        if (tj <= ti) {
            const f32x4_t a = mm_tile<3>(Kr + 16 * ti * PT, Kr + 16 * tj * PT, lane, zero4);
            const int j = 16 * tj + cc; const float gj = sg[j];
#pragma unroll
            for (int r = 0; r < 4; ++r) { const int i = 16 * ti + 4 * q4 + r; Lm[i * PT + j] = (i > j) ? sb[i] * a[r] * __expf(sg[i] - gj) : 0.f; }
        }
    }
    __syncthreads();
    if (w == 0) tri_inverse_wave(Lm, lane);
    __syncthreads();
#pragma unroll
    for (int tt = 0; tt < 2; ++tt) {
        const int tj = tj0 + tt;
        const f32x4_t a = mm_tile<3>(Lm + 16 * ti * PT, VbT + 16 * tj * PT, lane, zero4);
        *(LAS f32x4_t*)(U0T + (16 * tj + cc) * PT + 16 * ti + 4 * q4) = (f32x4_t){a[0], a[1], a[2], a[3]};
        const f32x4_t b = mm_tile<3>(Lm + 16 * ti * PT, KbT + 16 * tj * PT, lane, zero4);
        *(LAS f32x4_t*)(WmT + (16 * tj + cc) * PT + 16 * ti + 4 * q4) = (f32x4_t){b[0], b[1], b[2], b[3]};
    }
    __syncthreads();
    {
        const float egl = __expf(B.GC[(size_t)(t0 + 63) * 4 + h]);
#pragma unroll
        for (int tt = 0; tt < 2; ++tt) {
            const int tj = tj0 + tt;
            const f32x4_t a = mm_tile<3>(KdT + 16 * ti * PT, WmT + 16 * tj * PT, lane, zero4);
#pragma unroll
            for (int r = 0; r < 4; ++r) { const int ar = 16 * ti + 4 * q4 + r, bc = 16 * tj + cc; Lm[ar * PT + bc] = (ar == bc ? egl : 0.f) - a[r]; }
            const f32x4_t nn = mm_tile<3>(KdT + 16 * ti * PT, U0T + 16 * tj * PT, lane, zero4);
            *(float4*)(B.NF + (size_t)u * 4096 + (tj * 64 + lane) * 16 + ti * 4) = make_float4(nn[0], nn[1], nn[2], nn[3]);
        }
    }
    __syncthreads();
    {
        const int combo = tid >> 6, mt = combo >> 1, s = combo & 1, i = lane & 15, qq = lane >> 4;
        const f32x4_t x0 = *(const LAS f32x4_t*)(Lm + (16 * mt + i) * PT + 32 * s + 4 * qq);
        const f32x4_t x1 = *(const LAS f32x4_t*)(Lm + (16 * mt + i) * PT + 32 * s + 16 + 4 * qq);
        const float xv[8] = {x0.x, x0.y, x0.z, x0.w, x1.x, x1.y, x1.z, x1.w};
        U8 H, L; split8(xv, H.v, L.v);
        uint4* mf = B.MF + (size_t)u * 1024 + (size_t)(combo * 2) * 64 + lane;
        mf[0] = H.q; mf[64] = L.q;
    }
    __syncthreads();
}

constexpr int CH_SLOT = 20480, CH_RING = 6;
__device__ __forceinline__ void chain_wave(float* __restrict__ HT, int cb, int nchunk, int lane, LAS unsigned char* ring, volatile LAS unsigned* flags  ) {
    const int q4 = lane >> 4, cc = lane & 15;
    f32x4_t H[4];
#pragma unroll
    for (int m = 0; m < 4; ++m) H[m] = (f32x4_t){0.f, 0.f, 0.f, 0.f};
    for (int ch = 0; ch < nchunk; ++ch) {
        const int slot = ch % CH_RING;
        float* ht = HT + (size_t)ch * 4096 + (16 * cb + cc) * 64 + 4 * q4;
#pragma unroll
        for (int m = 0; m < 4; ++m) *(float4*)(ht + 16 * m) = make_float4(H[m][0], H[m][1], H[m][2], H[m][3]);
        bf16x8_t bh[2], bl[2];
#pragma unroll
        for (int s = 0; s < 2; ++s) {
            const float xv[8] = {H[2 * s][0], H[2 * s][1], H[2 * s][2], H[2 * s][3], H[2 * s + 1][0], H[2 * s + 1][1], H[2 * s + 1][2], H[2 * s + 1][3]};
            split8(xv, bh[s], bl[s]);
        }
        while (flags[slot] != (unsigned)(ch + 1)) __builtin_amdgcn_s_sleep(1);
        asm volatile("" ::: "memory");
        const LAS unsigned char* sp = ring + slot * CH_SLOT + lane * 16;
        U8 mf[16]; f32x4_t nf[4];
#pragma unroll
        for (int i = 0; i < 16; ++i) mf[i].x = *(const LAS u32x4_t*)(sp + i * 1024);
#pragma unroll
        for (int m = 0; m < 4; ++m) nf[m] = *(const LAS f32x4_t*)(sp + (16 + m) * 1024);
        asm volatile("s_waitcnt lgkmcnt(0)" ::: "memory");
        if (lane == 0) flags[8] = (unsigned)(ch + 1);
#pragma unroll
        for (int m = 0; m < 4; ++m) {
            f32x4_t acc = nf[m];
#pragma unroll
            for (int s = 0; s < 2; ++s) {
                acc = __builtin_amdgcn_mfma_f32_16x16x32_bf16(mf[(m * 2 + s) * 2].v, bh[s], acc, 0, 0, 0);
                acc = __builtin_amdgcn_mfma_f32_16x16x32_bf16(mf[(m * 2 + s) * 2].v, bl[s], acc, 0, 0, 0);
                acc = __builtin_amdgcn_mfma_f32_16x16x32_bf16(mf[(m * 2 + s) * 2 + 1].v, bh[s], acc, 0, 0, 0);
            }
            H[m] = acc;
        }
    }
}
__device__ __forceinline__ void chain_loader(const uint4* __restrict__ MF, const float* __restrict__ NF, int cb, int nchunk, int lane, int lw, LAS unsigned char* ring, volatile LAS unsigned* flags) {
    for (int ch = lw; ch < nchunk; ch += 7) {
        uint4 m[16]; float4 nn[4];
#pragma unroll
        for (int i = 0; i < 16; ++i) m[i] = MF[(size_t)ch * 1024 + (size_t)i * 64 + lane];
#pragma unroll
        for (int k = 0; k < 4; ++k) nn[k] = *(const float4*)(NF + (size_t)ch * 4096 + (cb * 64 + lane) * 16 + k * 4);
        while ((int)flags[8] + CH_RING <= ch) __builtin_amdgcn_s_sleep(2);
        asm volatile("" ::: "memory");
        LAS unsigned char* sp = ring + (ch % CH_RING) * CH_SLOT + lane * 16;
#pragma unroll
        for (int i = 0; i < 16; ++i) *(LAS u32x4_t*)(sp + i * 1024) = (u32x4_t){m[i].x, m[i].y, m[i].z, m[i].w};
#pragma unroll
        for (int k = 0; k < 4; ++k) *(LAS f32x4_t*)(sp + (16 + k) * 1024) = (f32x4_t){nn[k].x, nn[k].y, nn[k].z, nn[k].w};
        asm volatile("s_waitcnt lgkmcnt(0)" ::: "memory");
        if (lane == 0) flags[ch % CH_RING] = (unsigned)(ch + 1);
    }
}

__device__ __forceinline__ void gdn_g3_unit(int h, int n, const GdnBufs& B, const bf16_t* __restrict__ PM, bf16_t* __restrict__ Y, const float* __restrict__ norm_g, LAS float* lds) {
    const int tid = opq_tid(), w = tid >> 6, lane = tid & 63, q4 = lane >> 4, cc = lane & 15;
    LAS float* Qr = lds; LAS float* Kr = lds + MS; LAS float* KbT = lds + 2 * MS; LAS float* VbT = lds + 3 * MS; LAS float* Lm = lds + 4 * MS; LAS float* At = lds + 5 * MS;
    LAS float* Wm = Kr; LAS float* Hs = KbT; LAS float* VnT = VbT; LAS float* Os = Lm;
    LAS float* sb = lds + 6 * MS; LAS float* sg = sb + 64;
    const int t0 = n * 64, u = h * 256 + n;
    const int c = tid >> 3, d0 = (tid & 7) * 8;
    {
        const float beta = B.GB[(size_t)(t0 + c) * 4 + h], gc = B.GC[(size_t)(t0 + c) * 4 + h];
        const uint4 q8 = *(const uint4*)(B.GQ + (size_t)(t0 + c) * 256 + h * 64 + d0);
        const uint4 k8 = *(const uint4*)(B.GK + (size_t)(t0 + c) * 256 + h * 64 + d0);
        const uint4 v8 = *(const uint4*)(B.GV + (size_t)(t0 + c) * 256 + h * 64 + d0);
        const float e2 = beta * __expf(gc);
        const unsigned qu[4] = {q8.x, q8.y, q8.z, q8.w}, ku[4] = {k8.x, k8.y, k8.z, k8.w}, vu[4] = {v8.x, v8.y, v8.z, v8.w};
#pragma unroll
        for (int i = 0; i < 8; ++i) {
            const float qf = __uint_as_float((i & 1) ? (qu[i >> 1] & 0xffff0000u) : (qu[i >> 1] << 16));
            const float kf = __uint_as_float((i & 1) ? (ku[i >> 1] & 0xffff0000u) : (ku[i >> 1] << 16));
            const float vf = __uint_as_float((i & 1) ? (vu[i >> 1] & 0xffff0000u) : (vu[i >> 1] << 16));
            Qr[c * PT + d0 + i] = qf; Kr[c * PT + d0 + i] = kf; KbT[(d0 + i) * PT + c] = kf * e2; VbT[(d0 + i) * PT + c] = beta * vf;
        }
        if ((tid & 7) == 0) { sb[c] = beta; sg[c] = gc; }
    }
    __syncthreads();
    const int ti = w >> 1, tj0 = (w & 1) * 2;
    const f32x4_t zero4 = {0.f, 0.f, 0.f, 0.f};
#pragma unroll
    for (int tt = 0; tt < 2; ++tt) {
        const int tj = tj0 + tt;
        if (tj <= ti) {
            const f32x4_t a = mm_tile<3>(Kr + 16 * ti * PT, Kr + 16 * tj * PT, lane, zero4);
            const f32x4_t s = mm_tile<1>(Qr + 16 * ti * PT, Kr + 16 * tj * PT, lane, zero4);
            const int j = 16 * tj + cc; const float gj = sg[j];
#pragma unroll
            for (int r = 0; r < 4; ++r) { const int i = 16 * ti + 4 * q4 + r; const float dec = __expf(fminf(sg[i] - gj, 0.f));
                Lm[i * PT + j] = (i > j) ? sb[i] * a[r] * dec : 0.f; At[i * PT + j] = (i >= j) ? s[r] * dec : 0.f; }
        } else {
            const int j = 16 * tj + cc;
#pragma unroll
            for (int r = 0; r < 4; ++r) { const int i = 16 * ti + 4 * q4 + r; At[i * PT + j] = 0.f; }
        }
    }
    __syncthreads();
    if (w == 0) tri_inverse_wave(Lm, lane);
    else {
        for (int e = tid - 64; e < 4096; e += 448) { const int r = e >> 6, col = e & 63; Qr[r * PT + col] *= __expf(sg[r]); }
    }
    __syncthreads();
    f32x4_t u0[2];
#pragma unroll
    for (int tt = 0; tt < 2; ++tt) {
        const int tj = tj0 + tt;
        u0[tt] = mm_tile<3>(Lm + 16 * ti * PT, VbT + 16 * tj * PT, lane, zero4);
        const f32x4_t b = mm_tile<3>(Lm + 16 * ti * PT, KbT + 16 * tj * PT, lane, zero4);
#pragma unroll
        for (int r = 0; r < 4; ++r) Wm[(16 * ti + 4 * q4 + r) * PT + 16 * tj + cc] = b[r];
    }
    __syncthreads();
    {
        const float* ht = B.HT + (size_t)u * 4096;
        const float4 x0 = *(const float4*)(ht + c * 64 + d0), x1 = *(const float4*)(ht + c * 64 + d0 + 4);
        *(LAS f32x4_t*)(Hs + c * PT + d0) = (f32x4_t){x0.x, x0.y, x0.z, x0.w}; *(LAS f32x4_t*)(Hs + c * PT + d0 + 4) = (f32x4_t){x1.x, x1.y, x1.z, x1.w};
    }
    __syncthreads();
    f32x4_t o[2];
#pragma unroll
    for (int tt = 0; tt < 2; ++tt) {
        const int tj = tj0 + tt;
        const f32x4_t wh = mm_tile<3>(Wm + 16 * ti * PT, Hs + 16 * tj * PT, lane, zero4);
        o[tt] = mm_tile<3>(Qr + 16 * ti * PT, Hs + 16 * tj * PT, lane, zero4);
        u0[tt] = u0[tt] - wh;
    }
    __syncthreads();
#pragma unroll
    for (int tt = 0; tt < 2; ++tt) { const int tj = tj0 + tt; *(LAS f32x4_t*)(VnT + (16 * tj + cc) * PT + 16 * ti + 4 * q4) = (f32x4_t){u0[tt][0], u0[tt][1], u0[tt][2], u0[tt][3]}; }
    __syncthreads();
#pragma unroll
    for (int tt = 0; tt < 2; ++tt) {
        const int tj = tj0 + tt;
        o[tt] = mm_tile<3>(At + 16 * ti * PT, VnT + 16 * tj * PT, lane, o[tt]);
    }
    __syncthreads();
#pragma unroll
    for (int tt = 0; tt < 2; ++tt) { const int tj = tj0 + tt;
#pragma unroll
        for (int r = 0; r < 4; ++r) Os[(16 * ti + 4 * q4 + r) * PT + 16 * tj + cc] = o[tt][r]; }
    __syncthreads();
    {
        const f32x4_t x0 = *(const LAS f32x4_t*)(Os + c * PT + d0), x1 = *(const LAS f32x4_t*)(Os + c * PT + d0 + 4);
        float xv[8] = {x0.x, x0.y, x0.z, x0.w, x1.x, x1.y, x1.z, x1.w};
        float ss = 0.f;
#pragma unroll
        for (int i = 0; i < 8; ++i) ss = fmaf(xv[i], xv[i], ss);
        ss += __shfl_xor(ss, 1); ss += __shfl_xor(ss, 2); ss += __shfl_xor(ss, 4);
        const float rs = rsqrtf(ss * (1.f / 64.f) + 1e-6f);
        const uint4 z8 = *(const uint4*)(PM + (size_t)(t0 + c) * PMLD + 768 + h * 64 + d0);
        const unsigned zu[4] = {z8.x, z8.y, z8.z, z8.w};
        unsigned ow[4];
#pragma unroll
        for (int i = 0; i < 4; ++i) {
            const float z0 = __uint_as_float(zu[i] << 16), z1 = __uint_as_float(zu[i] & 0xffff0000u);
            ow[i] = cvtpk(xv[2 * i] * rs * norm_g[d0 + 2 * i] * siluf_(z0), xv[2 * i + 1] * rs * norm_g[d0 + 2 * i + 1] * siluf_(z1));
        }
        *(uint4*)(Y + (size_t)(t0 + c) * D + h * 64 + d0) = make_uint4(ow[0], ow[1], ow[2], ow[3]);
    }
    __syncthreads();
}

struct RwkvBufs { bf16_t *RR, *RK, *RV, *RKK, *RA, *RG; float* CW; uint4* MF; float* NF; float* HT; };
__device__ __forceinline__ void unpack8(const uint4 u, float (&o)[8]) {
    const unsigned w[4] = {u.x, u.y, u.z, u.w};
#pragma unroll
    for (int i = 0; i < 4; ++i) { o[2 * i] = __uint_as_float(w[i] << 16); o[2 * i + 1] = __uint_as_float(w[i] & 0xffff0000u); }
}
__device__ __forceinline__ uint4 pack8(const float (&x)[8]) { return make_uint4(cvtpk(x[0], x[1]), cvtpk(x[2], x[3]), cvtpk(x[4], x[5]), cvtpk(x[6], x[7])); }
typedef unsigned short LAS lds_bf16;
__device__ __forceinline__ void rwkv_prep_chunk(const bf16_t* __restrict__ PM, int n, const RwkvBufs& B, const Params& p, int l, const bf16_t* __restrict__ WUPT, const bf16_t* __restrict__ AUPT, const bf16_t* __restrict__ GUPT, LAS unsigned char* lds) {
    const int tid = opq_tid(), w = tid >> 6, lane = tid & 63, q4 = lane >> 4, cc = lane & 15;
    const int t0 = n * 64;
    const float* mu = p.in[24] + l * 1024;
    lds_bf16* Awd = (lds_bf16*)lds; lds_bf16* Aad = Awd + 64 * 72; lds_bf16* Agd = Aad + 64 * 72;
    lds_bf16* La = Agd + 64 * 136; lds_bf16* Lg = La + 64 * 264; lds_bf16* Llw = Lg + 64 * 264;
    {
        const int t = tid >> 3, c0 = (tid & 7) * 32;
        const bf16_t* row = PM + (size_t)(t0 + t) * PMLD + C_RWKV + 768 + c0;
        const bool hasprev = (t0 + t) > 0;
#pragma unroll
        for (int g8 = 0; g8 < 4; ++g8) {
            float x[8], xp[8];
            unpack8(*(const uint4*)(row + 8 * g8), x);
            if (hasprev) unpack8(*(const uint4*)(row - PMLD + 8 * g8), xp); else {
#pragma unroll
                for (int i = 0; i < 8; ++i) xp[i] = 0.f; }
            const int col = c0 + 8 * g8;
            float y[8];
#pragma unroll
            for (int i = 0; i < 8; ++i) {
                const float v = x[i] + mu[768 + col + i] * (xp[i] - x[i]);
                y[i] = col < 64 ? tanhf(v) : (col < 128 ? v : sigmoidf_(v));
            }
            const uint4 pk = pack8(y);
            if (col < 64) *(LAS u32x4_t*)(Awd + t * 72 + col) = (u32x4_t){pk.x, pk.y, pk.z, pk.w};
            else if (col < 128) *(LAS u32x4_t*)(Aad + t * 72 + (col - 64)) = (u32x4_t){pk.x, pk.y, pk.z, pk.w};
            else *(LAS u32x4_t*)(Agd + t * 136 + (col - 128)) = (u32x4_t){pk.x, pk.y, pk.z, pk.w};
        }
    }
    __syncthreads();
    const int hh = w >> 1, tt0 = 2 * (w & 1);
    {
        const float* w0 = p.in[25] + l * W; const float* a0 = p.in[27] + l * W;
#pragma unroll 2
        for (int b = 0; b < 4; ++b) {
            const int ncol = 64 * hh + 16 * b + cc;
            f32x4_t accw[2], acca[2], accg[2];
#pragma unroll
            for (int a = 0; a < 2; ++a) { accw[a] = (f32x4_t){0.f, 0.f, 0.f, 0.f}; acca[a] = accw[a]; accg[a] = accw[a]; }
#pragma unroll
            for (int ks = 0; ks < 4; ++ks) {
                U8 bw, ba, bg;
                bg.q = *(const uint4*)(GUPT + (size_t)ncol * 128 + 32 * ks + 8 * q4);
                if (ks < 2) { bw.q = *(const uint4*)(WUPT + (size_t)ncol * 64 + 32 * ks + 8 * q4); ba.q = *(const uint4*)(AUPT + (size_t)ncol * 64 + 32 * ks + 8 * q4); }
#pragma unroll
                for (int a = 0; a < 2; ++a) {
                    const int row = 16 * (tt0 + a) + cc;
                    U8 ag; ag.x = *(const LAS u32x4_t*)(Agd + row * 136 + 32 * ks + 8 * q4);
                    accg[a] = __builtin_amdgcn_mfma_f32_16x16x32_bf16(ag.v, bg.v, accg[a], 0, 0, 0);
                    if (ks < 2) {
                        U8 aw, aa; aw.x = *(const LAS u32x4_t*)(Awd + row * 72 + 32 * ks + 8 * q4); aa.x = *(const LAS u32x4_t*)(Aad + row * 72 + 32 * ks + 8 * q4);
                        accw[a] = __builtin_amdgcn_mfma_f32_16x16x32_bf16(aw.v, bw.v, accw[a], 0, 0, 0);
                        acca[a] = __builtin_amdgcn_mfma_f32_16x16x32_bf16(aa.v, ba.v, acca[a], 0, 0, 0);
                    }
                }
            }
            const float w0n = w0[ncol], a0n = a0[ncol];
#pragma unroll
            for (int a = 0; a < 2; ++a)
#pragma unroll
                for (int r = 0; r < 4; ++r) {
                    const int t = 16 * (tt0 + a) + 4 * q4 + r;
                    const float logw = -softplusf_(-(w0n + accw[a][r])) - 0.5f;
                    Llw[t * 264 + ncol] = (unsigned short)f2bf(-__expf(logw));
                    La[t * 264 + ncol] = (unsigned short)f2bf(sigmoidf_(a0n + acca[a][r]));
                    Lg[t * 264 + ncol] = (unsigned short)f2bf(accg[a][r]);
                }
        }
    }
    __syncthreads();
    {
        const int t = tid >> 3, n0 = (tid & 7) * 32;
        const bf16_t* row = PM + (size_t)(t0 + t) * PMLD + C_RWKV;
        const bool hasprev = (t0 + t) > 0;
        const float* k_k = p.in[30] + l * W; const float* k_a = p.in[31] + l * W;
        float ss = 0.f;
#pragma unroll 2
        for (int g8 = 0; g8 < 4; ++g8) {
            const int nn = n0 + 8 * g8;
            float xr[8], xk[8], xv[8], pr[8], pk[8], pv[8], av[8];
            unpack8(*(const uint4*)(row + nn), xr); unpack8(*(const uint4*)(row + 256 + nn), xk); unpack8(*(const uint4*)(row + 512 + nn), xv);
            if (hasprev) { unpack8(*(const uint4*)(row - PMLD + nn), pr); unpack8(*(const uint4*)(row - PMLD + 256 + nn), pk); unpack8(*(const uint4*)(row - PMLD + 512 + nn), pv); }
            else {
#pragma unroll
                for (int i = 0; i < 8; ++i) { pr[i] = 0.f; pk[i] = 0.f; pv[i] = 0.f; } }
            { const u32x4_t t4 = *(const LAS u32x4_t*)(La + t * 264 + nn); unpack8(make_uint4(t4.x, t4.y, t4.z, t4.w), av); }
            float orr[8], okk[8], ovv[8];
#pragma unroll
            for (int i = 0; i < 8; ++i) {
                const float r = xr[i] + mu[nn + i] * (pr[i] - xr[i]);
                const float k = xk[i] + mu[256 + nn + i] * (pk[i] - xk[i]);
                const float v = xv[i] + mu[512 + nn + i] * (pv[i] - xv[i]);
                orr[i] = r; ovv[i] = v; okk[i] = k * (1.f + (av[i] - 1.f) * k_a[nn + i]);
                const float kr = k * k_k[nn + i]; ss = fmaf(kr, kr, ss);
            }
            const size_t o = (size_t)(t0 + t) * 256 + nn;
            *(uint4*)(B.RR + o) = pack8(orr); *(uint4*)(B.RK + o) = pack8(okk); *(uint4*)(B.RV + o) = pack8(ovv);
            { const u32x4_t t4 = *(const LAS u32x4_t*)(La + t * 264 + nn); *(uint4*)(B.RA + o) = make_uint4(t4.x, t4.y, t4.z, t4.w); }
            { const u32x4_t t4 = *(const LAS u32x4_t*)(Lg + t * 264 + nn); *(uint4*)(B.RG + o) = make_uint4(t4.x, t4.y, t4.z, t4.w); }
        }
        ss += __shfl_xor(ss, 1);
        const float rn = rsqrtf(ss + 1e-6f);
#pragma unroll
        for (int g8 = 0; g8 < 4; ++g8) {
            const int nn = n0 + 8 * g8;
            float xk[8], pk[8], kk[8];
            unpack8(*(const uint4*)(row + 256 + nn), xk);
            if (hasprev) unpack8(*(const uint4*)(row - PMLD + 256 + nn), pk); else {
#pragma unroll
                for (int i = 0; i < 8; ++i) pk[i] = 0.f; }
#pragma unroll
            for (int i = 0; i < 8; ++i) kk[i] = (xk[i] + mu[256 + nn + i] * (pk[i] - xk[i])) * k_k[nn + i] * rn;
            *(uint4*)(B.RKK + (size_t)(t0 + t) * 256 + nn) = pack8(kk);
        }
    }
    if (tid < 256) {
        float c = 0.f;
#pragma unroll 16
        for (int t = 0; t < 64; ++t) { c += bf2f(Llw[t * 264 + tid]); B.CW[(size_t)(t0 + t) * 256 + tid] = c; }
    }
    __syncthreads();
}

struct RwPiece { float kk[8], al[8], kt[8], v[8], cw[8], cwp[8], cwc[8]; };
__device__ __forceinline__ void rwkv_load_piece(const RwkvBufs& B, int h, int t0, int c, int d0, RwPiece& P) {
    const size_t o = (size_t)(t0 + c) * 256 + h * 64 + d0;
    float a[8];
    unpack8(*(const uint4*)(B.RKK + o), P.kk); unpack8(*(const uint4*)(B.RA + o), a); unpack8(*(const uint4*)(B.RK + o), P.kt); unpack8(*(const uint4*)(B.RV + o), P.v);
    const float4 c0 = *(const float4*)(B.CW + o), c1 = *(const float4*)(B.CW + o + 4);
    P.cw[0] = c0.x; P.cw[1] = c0.y; P.cw[2] = c0.z; P.cw[3] = c0.w; P.cw[4] = c1.x; P.cw[5] = c1.y; P.cw[6] = c1.z; P.cw[7] = c1.w;
    if (c > 0) { const float4 p0 = *(const float4*)(B.CW + o - 256), p1 = *(const float4*)(B.CW + o - 256 + 4);
        P.cwp[0] = p0.x; P.cwp[1] = p0.y; P.cwp[2] = p0.z; P.cwp[3] = p0.w; P.cwp[4] = p1.x; P.cwp[5] = p1.y; P.cwp[6] = p1.z; P.cwp[7] = p1.w; }
    else {
#pragma unroll
        for (int i = 0; i < 8; ++i) P.cwp[i] = 0.f; }
    const size_t oc = (size_t)(t0 + 63) * 256 + h * 64 + d0;
    const float4 e0 = *(const float4*)(B.CW + oc), e1 = *(const float4*)(B.CW + oc + 4);
    P.cwc[0] = e0.x; P.cwc[1] = e0.y; P.cwc[2] = e0.z; P.cwc[3] = e0.w; P.cwc[4] = e1.x; P.cwc[5] = e1.y; P.cwc[6] = e1.z; P.cwc[7] = e1.w;
#pragma unroll
    for (int i = 0; i < 8; ++i) P.al[i] = a[i] * P.kk[i];
}

__device__ __forceinline__ void rwkv_g1_unit(int h, int n, const RwkvBufs& B, LAS float* lds) {
    const int tid = opq_tid(), w = tid >> 6, lane = tid & 63, q4 = lane >> 4, cc = lane & 15;
    LAS float* S0 = lds; LAS float* S1 = lds + MS; LAS float* S2 = lds + 2 * MS; LAS float* S3 = lds + 3 * MS; LAS float* Lm = lds + 4 * MS; LAS float* Lk = lds + 5 * MS;
    const int t0 = n * 64, u = (4 + h) * 256 + n;
    const int c = tid >> 3, d0 = (tid & 7) * 8;
    RwPiece P; rwkv_load_piece(B, h, t0, c, d0, P);
#pragma unroll
    for (int i = 0; i < 8; ++i) {
        const float em = __expf(-P.cw[i]);
        S0[c * PT + d0 + i] = P.kk[i] * __expf(P.cwp[i]); S1[c * PT + d0 + i] = P.al[i] * em; S2[c * PT + d0 + i] = P.kt[i] * em;
    }
    __syncthreads();
    const int ti = w >> 1, tj0 = (w & 1) * 2;
    const f32x4_t zero4 = {0.f, 0.f, 0.f, 0.f};
#pragma unroll
    for (int tt = 0; tt < 2; ++tt) {
        const int tj = tj0 + tt;
        if (tj <= ti) {
            const f32x4_t a = mm_tile<3>(S0 + 16 * ti * PT, S1 + 16 * tj * PT, lane, zero4);
            const f32x4_t b = mm_tile<3>(S0 + 16 * ti * PT, S2 + 16 * tj * PT, lane, zero4);
            const int j = 16 * tj + cc;
#pragma unroll
            for (int r = 0; r < 4; ++r) { const int i = 16 * ti + 4 * q4 + r; Lm[i * PT + j] = (i > j) ? a[r] : 0.f; Lk[i * PT + j] = (i > j) ? b[r] : 0.f; }
        } else {
            const int j = 16 * tj + cc;
#pragma unroll
            for (int r = 0; r < 4; ++r) { const int i = 16 * ti + 4 * q4 + r; Lk[i * PT + j] = 0.f; }
        }
    }
    __syncthreads();
#pragma unroll
    for (int i = 0; i < 8; ++i) {
        const float eb = __expf(P.cwc[i] - P.cw[i]);
        S0[(d0 + i) * PT + c] = P.v[i]; S1[(d0 + i) * PT + c] = P.kk[i] * __expf(P.cwp[i]); S2[(d0 + i) * PT + c] = P.al[i] * eb; S3[(d0 + i) * PT + c] = P.kt[i] * eb;
    }
    if (w == 0) tri_inverse_wave(Lm, lane);
    __syncthreads();
    f32x4_t pa[2];
#pragma unroll
    for (int tt = 0; tt < 2; ++tt) pa[tt] = mm_tile<3>(Lk + 16 * ti * PT, S0 + 16 * (tj0 + tt) * PT, lane, zero4);
    __syncthreads();
#pragma unroll
    for (int tt = 0; tt < 2; ++tt) *(LAS f32x4_t*)(Lk + (16 * (tj0 + tt) + cc) * PT + 16 * ti + 4 * q4) = pa[tt];
    __syncthreads();
    f32x4_t ua[2], wa[2];
#pragma unroll
    for (int tt = 0; tt < 2; ++tt) {
        ua[tt] = mm_tile<3>(Lm + 16 * ti * PT, Lk + 16 * (tj0 + tt) * PT, lane, zero4);
        wa[tt] = mm_tile<3>(Lm + 16 * ti * PT, S1 + 16 * (tj0 + tt) * PT, lane, zero4);
    }
    __syncthreads();
#pragma unroll
    for (int tt = 0; tt < 2; ++tt) {
        *(LAS f32x4_t*)(Lk + (16 * (tj0 + tt) + cc) * PT + 16 * ti + 4 * q4) = -ua[tt];
        *(LAS f32x4_t*)(S1 + (16 * (tj0 + tt) + cc) * PT + 16 * ti + 4 * q4) = wa[tt];
    }
    __syncthreads();
    {
#pragma unroll
        for (int tt = 0; tt < 2; ++tt) {
            const int tj = tj0 + tt;
            const f32x4_t a = mm_tile<3>(S2 + 16 * ti * PT, S1 + 16 * tj * PT, lane, zero4);
            const float gam = __expf(B.CW[(size_t)(t0 + 63) * 256 + h * 64 + 16 * tj + cc]);
#pragma unroll
            for (int r = 0; r < 4; ++r) { const int ar = 16 * ti + 4 * q4 + r, bc = 16 * tj + cc; Lm[ar * PT + bc] = (ar == bc ? gam : 0.f) - a[r]; }
            f32x4_t nn = mm_tile<3>(S2 + 16 * ti * PT, Lk + 16 * tj * PT, lane, zero4);
            nn = mm_tile<3>(S3 + 16 * ti * PT, S0 + 16 * tj * PT, lane, nn);
            *(float4*)(B.NF + (size_t)u * 4096 + (tj * 64 + lane) * 16 + ti * 4) = make_float4(nn[0], nn[1], nn[2], nn[3]);
        }
    }
    __syncthreads();
    {
        const int combo = tid >> 6, mt = combo >> 1, s = combo & 1, i = lane & 15, qq = lane >> 4;
        const f32x4_t x0 = *(const LAS f32x4_t*)(Lm + (16 * mt + i) * PT + 32 * s + 4 * qq);
        const f32x4_t x1 = *(const LAS f32x4_t*)(Lm + (16 * mt + i) * PT + 32 * s + 16 + 4 * qq);
        const float xv[8] = {x0.x, x0.y, x0.z, x0.w, x1.x, x1.y, x1.z, x1.w};
        U8 H, L; split8(xv, H.v, L.v);
        uint4* mf = B.MF + (size_t)u * 1024 + (size_t)(combo * 2) * 64 + lane;
        mf[0] = H.q; mf[64] = L.q;
    }
    __syncthreads();
}

__device__ __forceinline__ void rwkv_g3_unit(int h, int n, const RwkvBufs& B, bf16_t* __restrict__ Y, const Params& p, int l, LAS float* lds) {
    const int tid = opq_tid(), w = tid >> 6, lane = tid & 63, q4 = lane >> 4, cc = lane & 15;
    LAS float* S0 = lds; LAS float* S1 = lds + MS; LAS float* S2 = lds + 2 * MS; LAS float* RH = lds + 3 * MS; LAS float* Lm = lds + 4 * MS; LAS float* Lk = lds + 5 * MS;
    LAS float* Ara = lds + 6 * MS; LAS float* Ark = lds + 7 * MS;
    const int t0 = n * 64, u = (4 + h) * 256 + n;
    const int c = tid >> 3, d0 = (tid & 7) * 8;
    RwPiece P; rwkv_load_piece(B, h, t0, c, d0, P);
    {
        float rr[8]; unpack8(*(const uint4*)(B.RR + (size_t)(t0 + c) * 256 + h * 64 + d0), rr);
#pragma unroll
        for (int i = 0; i < 8; ++i) {
            const float em = __expf(-P.cw[i]);
            S0[c * PT + d0 + i] = P.kk[i] * __expf(P.cwp[i]); S1[c * PT + d0 + i] = P.al[i] * em; S2[c * PT + d0 + i] = P.kt[i] * em; RH[c * PT + d0 + i] = rr[i] * __expf(P.cw[i]);
        }
    }
    __syncthreads();
    const int ti = w >> 1, tj0 = (w & 1) * 2;
    const f32x4_t zero4 = {0.f, 0.f, 0.f, 0.f};
#pragma unroll
    for (int tt = 0; tt < 2; ++tt) {
        const int tj = tj0 + tt; const int j = 16 * tj + cc;
        if (tj <= ti) {
            const f32x4_t a = mm_tile<3>(S0 + 16 * ti * PT, S1 + 16 * tj * PT, lane, zero4);
            const f32x4_t b = mm_tile<3>(S0 + 16 * ti * PT, S2 + 16 * tj * PT, lane, zero4);
            const f32x4_t e = mm_tile<3>(RH + 16 * ti * PT, S1 + 16 * tj * PT, lane, zero4);
            const f32x4_t f = mm_tile<3>(RH + 16 * ti * PT, S2 + 16 * tj * PT, lane, zero4);
#pragma unroll
            for (int r = 0; r < 4; ++r) { const int i = 16 * ti + 4 * q4 + r;
                Lm[i * PT + j] = (i > j) ? a[r] : 0.f; Lk[i * PT + j] = (i > j) ? b[r] : 0.f; Ara[i * PT + j] = (i >= j) ? e[r] : 0.f; Ark[i * PT + j] = (i >= j) ? f[r] : 0.f; }
        } else {
#pragma unroll
            for (int r = 0; r < 4; ++r) { const int i = 16 * ti + 4 * q4 + r; Lk[i * PT + j] = 0.f; Ara[i * PT + j] = 0.f; Ark[i * PT + j] = 0.f; }
        }
    }
    __syncthreads();
#pragma unroll
    for (int i = 0; i < 8; ++i) { S0[(d0 + i) * PT + c] = P.v[i]; S1[(d0 + i) * PT + c] = P.kk[i] * __expf(P.cwp[i]); }
    if (w == 0) tri_inverse_wave(Lm, lane);
    __syncthreads();
    f32x4_t pa[2];
#pragma unroll
    for (int tt = 0; tt < 2; ++tt) pa[tt] = mm_tile<3>(Lk + 16 * ti * PT, S0 + 16 * (tj0 + tt) * PT, lane, zero4);
    __syncthreads();
#pragma unroll
    for (int tt = 0; tt < 2; ++tt) *(LAS f32x4_t*)(Lk + (16 * (tj0 + tt) + cc) * PT + 16 * ti + 4 * q4) = pa[tt];
    __syncthreads();
    f32x4_t ua[2], wa[2];
#pragma unroll
    for (int tt = 0; tt < 2; ++tt) {
        ua[tt] = mm_tile<3>(Lm + 16 * ti * PT, Lk + 16 * (tj0 + tt) * PT, lane, zero4);
        wa[tt] = mm_tile<3>(Lm + 16 * ti * PT, S1 + 16 * (tj0 + tt) * PT, lane, zero4);
    }
    __syncthreads();
    {
#pragma unroll
        for (int tt = 0; tt < 2; ++tt)
#pragma unroll
            for (int r = 0; r < 4; ++r) S1[(16 * ti + 4 * q4 + r) * PT + 16 * (tj0 + tt) + cc] = wa[tt][r];
        const float* ht = B.HT + (size_t)u * 4096;
        const float4 x0 = *(const float4*)(ht + c * 64 + d0), x1 = *(const float4*)(ht + c * 64 + d0 + 4);
        *(LAS f32x4_t*)(S2 + c * PT + d0) = (f32x4_t){x0.x, x0.y, x0.z, x0.w}; *(LAS f32x4_t*)(S2 + c * PT + d0 + 4) = (f32x4_t){x1.x, x1.y, x1.z, x1.w};
    }
    __syncthreads();
    f32x4_t o[2];
#pragma unroll
    for (int tt = 0; tt < 2; ++tt) {
        const int tj = tj0 + tt;
        const f32x4_t wh = mm_tile<3>(S1 + 16 * ti * PT, S2 + 16 * tj * PT, lane, zero4);
        ua[tt] = -ua[tt] - wh;
        o[tt] = mm_tile<3>(RH + 16 * ti * PT, S2 + 16 * tj * PT, lane, zero4);
        o[tt] = mm_tile<3>(Ark + 16 * ti * PT, S0 + 16 * tj * PT, lane, o[tt]);
        *(LAS f32x4_t*)(Lm + (16 * tj + cc) * PT + 16 * ti + 4 * q4) = ua[tt];
    }
    __syncthreads();
#pragma unroll
    for (int tt = 0; tt < 2; ++tt) o[tt] = mm_tile<3>(Ara + 16 * ti * PT, Lm + 16 * (tj0 + tt) * PT, lane, o[tt]);
    __syncthreads();
#pragma unroll
    for (int tt = 0; tt < 2; ++tt)
#pragma unroll
        for (int r = 0; r < 4; ++r) Lk[(16 * ti + 4 * q4 + r) * PT + 16 * (tj0 + tt) + cc] = o[tt][r];
    __syncthreads();
    {
        const f32x4_t x0 = *(const LAS f32x4_t*)(Lk + c * PT + d0), x1 = *(const LAS f32x4_t*)(Lk + c * PT + d0 + 4);
        const float xv[8] = {x0.x, x0.y, x0.z, x0.w, x1.x, x1.y, x1.z, x1.w};
        float s1 = 0.f;
#pragma unroll
        for (int i = 0; i < 8; ++i) s1 += xv[i];
        s1 += __shfl_xor(s1, 1); s1 += __shfl_xor(s1, 2); s1 += __shfl_xor(s1, 4);
        const float mean = s1 * (1.f / 64.f);
        float s2 = 0.f;
#pragma unroll
        for (int i = 0; i < 8; ++i) { const float dd = xv[i] - mean; s2 = fmaf(dd, dd, s2); }
        s2 += __shfl_xor(s2, 1); s2 += __shfl_xor(s2, 2); s2 += __shfl_xor(s2, 4);
        const float rs = rsqrtf(s2 * (1.f / 64.f) + 64e-5f);
        const size_t o8 = (size_t)(t0 + c) * 256 + h * 64 + d0;
        float rr[8], gg[8], kt2[8], v2[8];
        unpack8(*(const uint4*)(B.RR + o8), rr); unpack8(*(const uint4*)(B.RG + o8), gg); unpack8(*(const uint4*)(B.RK + o8), kt2); unpack8(*(const uint4*)(B.RV + o8), v2);
        const float* r_k = p.in[32] + l * W + h * 64 + d0; const float* ln_g = p.in[33] + l * W + h * 64 + d0; const float* ln_b = p.in[34] + l * W + h * 64 + d0;
        float bs = 0.f;
#pragma unroll
        for (int i = 0; i < 8; ++i) bs = fmaf(rr[i] * kt2[i], r_k[i], bs);
        bs += __shfl_xor(bs, 1); bs += __shfl_xor(bs, 2); bs += __shfl_xor(bs, 4);
        float y[8];
#pragma unroll
        for (int i = 0; i < 8; ++i) y[i] = ((xv[i] - mean) * rs * ln_g[i] + ln_b[i] + bs * v2[i]) * gg[i];
        *(uint4*)(Y + (size_t)(t0 + c) * D + 768 + h * 64 + d0) = pack8(y);
    }
    __syncthreads();
}
struct LruBufs { float2* AGG; float* CAR; };
template <int PASS>
__device__ __forceinline__ void lru_unit(const bf16_t* __restrict__ PM, int n, const LruBufs& B, bf16_t* __restrict__ Y, const Params& p, int l, const bf16_t* __restrict__ LWT  , LAS float* lds) {
    const int tid = opq_tid(), c = tid & 255, half = tid >> 8, w = tid >> 6, lane = tid & 63, q4 = lane >> 4, cc = lane & 15;
    const int t0 = n * 64, tb = t0 + 32 * half;
    LAS float* U = lds;
    lds_bf16* R = (lds_bf16*)(lds + 64 * 260);
    lds_bf16* I = R + 64 * 264;
    {
        const float* cw = p.in[7] + l * 4 * W; const float cb = p.in[8][l * W + c];
        const float w0 = cw[c], w1 = cw[W + c], w2 = cw[2 * W + c], w3 = cw[3 * W + c];
        const bf16_t* col = PM + C_LRU + c;
        float h0 = tb >= 3 ? bf2f(col[(size_t)(tb - 3) * PMLD]) : 0.f, h1 = tb >= 2 ? bf2f(col[(size_t)(tb - 2) * PMLD]) : 0.f, h2 = tb >= 1 ? bf2f(col[(size_t)(tb - 1) * PMLD]) : 0.f;
#pragma unroll 4
        for (int i = 0; i < 32; ++i) {
            const float x = bf2f(col[(size_t)(tb + i) * PMLD]);
            U[(32 * half + i) * 260 + c] = cb + w0 * h0 + w1 * h1 + w2 * h2 + w3 * x;
            h0 = h1; h1 = h2; h2 = x;
        }
    }
    __syncthreads();
    {
        const int nb = w >> 1, gt = w & 1;
        const bf16_t* wt = LWT + (size_t)gt * 16384 + (size_t)nb * 4096;
        const float* bias = (gt ? p.in[12] : p.in[10]) + l * W + nb * 64;
        const float* lam = p.in[13] + l * W + nb * 64;
#pragma unroll 1
        for (int te = 0; te < 4; ++te) {
            U8 bf[2];
#pragma unroll
            for (int ks = 0; ks < 2; ++ks) bf[ks].q = *(const uint4*)(wt + (size_t)(16 * te + cc) * 64 + 32 * ks + 8 * q4);
            const int ch = nb * 64 + 16 * te + cc;
            const float bv = bias[16 * te + cc];
            const float sp8 = 8.f * softplusf_(-lam[16 * te + cc]);
#pragma unroll
            for (int tt = 0; tt < 4; ++tt) {
                f32x4_t acc = {0.f, 0.f, 0.f, 0.f};
#pragma unroll
                for (int ks = 0; ks < 2; ++ks) {
                    const LAS float* ap = U + (16 * tt + cc) * 260 + nb * 64 + 32 * ks + 8 * q4;
                    const f32x4_t a0 = *(const LAS f32x4_t*)ap, a1 = *(const LAS f32x4_t*)(ap + 4);
                    const float av[8] = {a0.x, a0.y, a0.z, a0.w, a1.x, a1.y, a1.z, a1.w};
                    acc = __builtin_amdgcn_mfma_f32_16x16x32_bf16(hi8(av), bf[ks].v, acc, 0, 0, 0);
                }
#pragma unroll
                for (int r = 0; r < 4; ++r) {
                    const int t = 16 * tt + 4 * q4 + r;
                    const float sg = sigmoidf_(acc[r] + bv);
                    if (gt) I[t * 264 + ch] = (unsigned short)f2bf(sg); else R[t * 264 + ch] = (unsigned short)f2bf(-sp8 * sg);
                }
            }
        }
    }
    __syncthreads();
    float h = 0.f, ap = 1.f;
    const int sc = 2 * n + half;
    if (PASS == 3) h = B.CAR[(size_t)c * 512 + sc];
#pragma unroll 2
    for (int i = 0; i < 32; ++i) {
        const int t = 32 * half + i;
        const float log_a = bf2f(R[t * 264 + c]), ig = bf2f(I[t * 264 + c]);
        const float a = __expf(log_a);
        const float inp = sqrtf(-expm1f(2.f * log_a)) * (ig * U[t * 260 + c]);
        h = fmaf(a, h, inp); ap *= a;
        if (PASS == 3) {
            const float gate = bf2f(PM[(size_t)(t0 + t) * PMLD + C_LRU + 256 + c]);
            Y[(size_t)(t0 + t) * D + 256 + c] = (bf16_t)f2bf(h * geluf_(gate));
        }
    }
    if (PASS == 1) B.AGG[(size_t)c * 512 + sc] = make_float2(ap, h);
    __syncthreads();
}
__device__ __forceinline__ void lru_carry_wave(const LruBufs& B, int c, int lane) {
    float2 ab[8];
    const float4* src = (const float4*)(B.AGG + (size_t)c * 512 + 8 * lane);
#pragma unroll
    for (int k = 0; k < 4; ++k) { const float4 v = src[k]; ab[2 * k] = make_float2(v.x, v.y); ab[2 * k + 1] = make_float2(v.z, v.w); }
    float A = 1.f, Bv = 0.f;
#pragma unroll
    for (int k = 0; k < 8; ++k) { Bv = fmaf(ab[k].x, Bv, ab[k].y); A *= ab[k].x; }
#pragma unroll
    for (int o = 1; o < 64; o <<= 1) { const float Al = __shfl_up(A, o), Bl = __shfl_up(Bv, o); if (lane >= o) { Bv = fmaf(A, Bl, Bv); A *= Al; } }
    float h = __shfl_up(Bv, 1); if (lane == 0) h = 0.f;
    float o8[8];
#pragma unroll
    for (int k = 0; k < 8; ++k) { o8[k] = h; h = fmaf(ab[k].x, h, ab[k].y); }
    float4* dst = (float4*)(B.CAR + (size_t)c * 512 + 8 * lane);
    dst[0] = make_float4(o8[0], o8[1], o8[2], o8[3]); dst[1] = make_float4(o8[4], o8[5], o8[6], o8[7]);
}

struct S5Bufs { float2* E; float2* CIN; };
struct S5Lane { float lbr, lbi; float bbr[16], bbi[16]; };
__device__ __forceinline__ void s5_lane_consts(const Params& p, int l, int g, int lane, S5Lane& K) {
    const float dt = __expf(p.in[21][l * 16 + g]);
    const float lre = p.in[14][l * 1024 + g * 64 + lane], lim = p.in[15][l * 1024 + g * 64 + lane];
    const float er = __expf(lre * dt);
    K.lbr = er * cosf(lim * dt); K.lbi = er * sinf(lim * dt);
    const float nr = K.lbr - 1.f, ni = K.lbi, den = lre * lre + lim * lim;
    const float fr = (nr * lre + ni * lim) / den, fi = (ni * lre - nr * lim) / den;
    const float* bre = p.in[16] + (size_t)l * 16384 + (g * 64 + lane) * 16; const float* bim = p.in[17] + (size_t)l * 16384 + (g * 64 + lane) * 16;
#pragma unroll
    for (int c = 0; c < 16; ++c) { const float br = bre[c], bi = bim[c]; K.bbr[c] = fr * br - fi * bi; K.bbi[c] = fr * bi + fi * br; }
}
template <int PASS>
__device__ __forceinline__ void s5_unit(const bf16_t* __restrict__ PM, int n, const S5Bufs& B, bf16_t* __restrict__ Y, const Params& p, int l, const bf16_t* __restrict__ GLUT, LAS unsigned char* lds) {
    const int tid = opq_tid(), w = tid >> 6, lane = tid & 63, q4 = lane >> 4, cc = lane & 15;
    const int t0 = n * 64;
    LAS float* us = (LAS float*)lds + w * (64 * 16);
    LAS unsigned char* hs = lds + 32768 + w * (32 * 272);
    lds_bf16* yp = (lds_bf16*)(lds + 32768 + 8 * 32 * 272);
#pragma unroll 1
    for (int gi = 0; gi < 2; ++gi) {
        const int g = 2 * w + gi;
        {
            const bf16_t* src = PM + (size_t)(t0 + lane) * PMLD + C_S5 + g * 16;
            float a[8], b[8]; unpack8(*(const uint4*)src, a); unpack8(*(const uint4*)(src + 8), b);
            *(LAS f32x4_t*)(us + lane * 16) = (f32x4_t){a[0], a[1], a[2], a[3]}; *(LAS f32x4_t*)(us + lane * 16 + 4) = (f32x4_t){a[4], a[5], a[6], a[7]};
            *(LAS f32x4_t*)(us + lane * 16 + 8) = (f32x4_t){b[0], b[1], b[2], b[3]}; *(LAS f32x4_t*)(us + lane * 16 + 12) = (f32x4_t){b[4], b[5], b[6], b[7]};
        }
        S5Lane K; s5_lane_consts(p, l, g, lane, K);
        float hr = 0.f, hi = 0.f;
        if (PASS == 3) { const float2 h0 = B.CIN[((size_t)g * 64 + lane) * 256 + n]; hr = h0.x; hi = h0.y; }
        U8 cf[4];
        float dch = 0.f;
        if (PASS == 3) {
            const float* cre = p.in[18] + (size_t)l * 16384 + (g * 16 + cc) * 64; const float* cim = p.in[19] + (size_t)l * 16384 + (g * 16 + cc) * 64;
#pragma unroll
            for (int ks = 0; ks < 4; ++ks) {
                const float4 r4 = *(const float4*)(cre + 16 * ks + 4 * q4), i4 = *(const float4*)(cim + 16 * ks + 4 * q4);
                cf[ks].u[0] = cvtpk(r4.x, -i4.x); cf[ks].u[1] = cvtpk(r4.y, -i4.y); cf[ks].u[2] = cvtpk(r4.z, -i4.z); cf[ks].u[3] = cvtpk(r4.w, -i4.w);
            }
            dch = p.in[20][l * W + g * 16 + cc];
        }
        asm volatile("s_waitcnt lgkmcnt(0)" ::: "memory");
#pragma unroll 1
        for (int hf = 0; hf < 2; ++hf) {
#pragma unroll 2
            for (int i = 0; i < 32; ++i) {
                const int t = 32 * hf + i;
                const f32x4_t u0 = *(const LAS f32x4_t*)(us + t * 16), u1 = *(const LAS f32x4_t*)(us + t * 16 + 4), u2 = *(const LAS f32x4_t*)(us + t * 16 + 8), u3 = *(const LAS f32x4_t*)(us + t * 16 + 12);
                const float uv[16] = {u0.x, u0.y, u0.z, u0.w, u1.x, u1.y, u1.z, u1.w, u2.x, u2.y, u2.z, u2.w, u3.x, u3.y, u3.z, u3.w};
                float br = 0.f, bi = 0.f;
#pragma unroll
                for (int c = 0; c < 16; ++c) { br = fmaf(K.bbr[c], uv[c], br); bi = fmaf(K.bbi[c], uv[c], bi); }
                const float nhr = K.lbr * hr - K.lbi * hi + br, nhi = K.lbr * hi + K.lbi * hr + bi;
                hr = nhr; hi = nhi;
                if (PASS == 3) *(LAS unsigned*)(hs + i * 272 + 4 * lane) = cvtpk(hr, hi);
            }
            if (PASS == 3) {
                asm volatile("s_waitcnt lgkmcnt(0)" ::: "memory");
#pragma unroll
                for (int tt = 0; tt < 2; ++tt) {
                    f32x4_t acc = {0.f, 0.f, 0.f, 0.f};
#pragma unroll
                    for (int ks = 0; ks < 4; ++ks) {
                        U8 af; af.x = *(const LAS u32x4_t*)(hs + (16 * tt + cc) * 272 + 64 * ks + 16 * q4);
                        acc = __builtin_amdgcn_mfma_f32_16x16x32_bf16(af.v, cf[ks].v, acc, 0, 0, 0);
                    }
#pragma unroll
                    for (int r = 0; r < 4; ++r) {
                        const int t = 32 * hf + 16 * tt + 4 * q4 + r;
                        const float yv = acc[r] + dch * us[t * 16 + cc];
                        yp[t * 264 + g * 16 + cc] = (unsigned short)f2bf(geluf_(yv));
                    }
                }
                asm volatile("s_waitcnt lgkmcnt(0)" ::: "memory");
            }
        }
        if (PASS == 1) B.E[((size_t)g * 64 + lane) * 256 + n] = make_float2(hr, hi);
    }
    if (PASS == 3) {
        __syncthreads();
        const float* gb = p.in[23] + l * W;
#pragma unroll 1
        for (int tn = 2 * w; tn < 2 * w + 2; ++tn) {
            f32x4_t acc[4];
#pragma unroll
            for (int tt = 0; tt < 4; ++tt) acc[tt] = (f32x4_t){0.f, 0.f, 0.f, 0.f};
#pragma unroll
            for (int ks = 0; ks < 8; ++ks) {
                U8 bf; bf.q = *(const uint4*)(GLUT + (size_t)(16 * tn + cc) * 256 + 32 * ks + 8 * q4);
#pragma unroll
                for (int tt = 0; tt < 4; ++tt) {
                    U8 af; af.x = *(const LAS u32x4_t*)(yp + (16 * tt + cc) * 264 + 32 * ks + 8 * q4);
                    acc[tt] = __builtin_amdgcn_mfma_f32_16x16x32_bf16(af.v, bf.v, acc[tt], 0, 0, 0);
                }
            }
            const int ncol = 16 * tn + cc; const float gbn = gb[ncol];
#pragma unroll
            for (int tt = 0; tt < 4; ++tt)
#pragma unroll
                for (int r = 0; r < 4; ++r) {
                    const int t = 16 * tt + 4 * q4 + r;
                    const float yv = bf2f(yp[t * 264 + ncol]);
                    Y[(size_t)(t0 + t) * D + 512 + ncol] = (bf16_t)f2bf(yv * sigmoidf_(acc[tt][r] + gbn));
                }
        }
    }
    __syncthreads();
}
__device__ __forceinline__ void s5_carry_wave(const S5Bufs& B, const Params& p, int l, int gp, int lane) {
    const int g = gp >> 6;
    const float dt = __expf(p.in[21][l * 16 + g]) * 64.f;
    const float lre = p.in[14][l * 1024 + gp], lim = p.in[15][l * 1024 + gp];
    const float er = __expf(lre * dt);
    const float pr = er * cosf(lim * dt), pi = er * sinf(lim * dt);
    float2 e[4];
    const float4* src = (const float4*)(B.E + (size_t)gp * 256 + 4 * lane);
    { const float4 v0 = src[0], v1 = src[1]; e[0] = make_float2(v0.x, v0.y); e[1] = make_float2(v0.z, v0.w); e[2] = make_float2(v1.x, v1.y); e[3] = make_float2(v1.z, v1.w); }
    float Ar = 1.f, Ai = 0.f, Br = 0.f, Bi = 0.f;
#pragma unroll
    for (int k = 0; k < 4; ++k) {
        const float nbr = pr * Br - pi * Bi + e[k].x, nbi = pr * Bi + pi * Br + e[k].y; Br = nbr; Bi = nbi;
        const float nar = pr * Ar - pi * Ai, nai = pr * Ai + pi * Ar; Ar = nar; Ai = nai;
    }
#pragma unroll
    for (int o = 1; o < 64; o <<= 1) {
        const float Alr = __shfl_up(Ar, o), Ali = __shfl_up(Ai, o), Blr = __shfl_up(Br, o), Bli = __shfl_up(Bi, o);
        if (lane >= o) {
            const float nbr = Ar * Blr - Ai * Bli + Br, nbi = Ar * Bli + Ai * Blr + Bi; Br = nbr; Bi = nbi;
            const float nar = Ar * Alr - Ai * Ali, nai = Ar * Ali + Ai * Alr; Ar = nar; Ai = nai;
        }
    }
    float hr = __shfl_up(Br, 1), hi = __shfl_up(Bi, 1); if (lane == 0) { hr = 0.f; hi = 0.f; }
    float2 o4[4];
#pragma unroll
    for (int k = 0; k < 4; ++k) { o4[k] = make_float2(hr, hi); const float nhr = pr * hr - pi * hi + e[k].x, nhi = pr * hi + pi * hr + e[k].y; hr = nhr; hi = nhi; }
    float4* dst = (float4*)(B.CIN + (size_t)gp * 256 + 4 * lane);
    dst[0] = make_float4(o4[0].x, o4[0].y, o4[1].x, o4[1].y); dst[1] = make_float4(o4[2].x, o4[2].y, o4[3].x, o4[3].y);
}

constexpr size_t WS_GQ = 36 * MiB, WS_GK = 44 * MiB, WS_GV = 52 * MiB, WS_GB = 60 * MiB, WS_GC = 61 * MiB;
constexpr size_t WS_MF = 324 * MiB, WS_NF = 356 * MiB, WS_HT = 388 * MiB;
constexpr size_t WS_RR = 420 * MiB, WS_RK = 428 * MiB, WS_RV = 436 * MiB, WS_RKK = 444 * MiB, WS_RA = 452 * MiB, WS_RG = 460 * MiB, WS_CW = 468 * MiB;
constexpr size_t WS_LAGG = 484 * MiB, WS_LCAR = 485 * MiB, WS_S5E = 486 * MiB, WS_S5C = 488 * MiB;
constexpr int MIX_LDS = 8 * MS * 4 + 1024;
__device__ __forceinline__ LruBufs lru_bufs(unsigned char* ws) { LruBufs B; B.AGG = (float2*)(ws + WS_LAGG); B.CAR = (float*)(ws + WS_LCAR); return B; }
__device__ __forceinline__ S5Bufs s5_bufs(unsigned char* ws) { S5Bufs B; B.E = (float2*)(ws + WS_S5E); B.CIN = (float2*)(ws + WS_S5C); return B; }
__device__ __forceinline__ GdnBufs gdn_bufs(unsigned char* ws) {
    GdnBufs B; B.GQ = (bf16_t*)(ws + WS_GQ); B.GK = (bf16_t*)(ws + WS_GK); B.GV = (bf16_t*)(ws + WS_GV); B.GB = (float*)(ws + WS_GB); B.GC = (float*)(ws + WS_GC);
    B.MF = (uint4*)(ws + WS_MF); B.NF = (float*)(ws + WS_NF); B.HT = (float*)(ws + WS_HT); return B;
}
__device__ __forceinline__ RwkvBufs rwkv_bufs(unsigned char* ws) {
    RwkvBufs B; B.RR = (bf16_t*)(ws + WS_RR); B.RK = (bf16_t*)(ws + WS_RK); B.RV = (bf16_t*)(ws + WS_RV); B.RKK = (bf16_t*)(ws + WS_RKK); B.RA = (bf16_t*)(ws + WS_RA); B.RG = (bf16_t*)(ws + WS_RG);
    B.CW = (float*)(ws + WS_CW); B.MF = (uint4*)(ws + WS_MF); B.NF = (float*)(ws + WS_NF); B.HT = (float*)(ws + WS_HT); return B;
}
__device__ __forceinline__ unsigned char* opq(unsigned char* w) { unsigned long long v = (unsigned long long)w; asm volatile("" : "+s"(v)); return (unsigned char*)(GAS unsigned char*)v; }
#define XB_TMO      128
#define XB_XCNT(j)  (256  + 64 * (j))
#define XB_XSUB(j)  (1280 + 64 * (j))
#define XB_XGEN(j)  (2304 + 64 * (j))
#define XB_TOP      3328
#define XB_TOPGEN   3392
#define XCD_BAR_WORDS 3456
#define XB_SPIN_CAP (1u << 18)

__device__ __forceinline__ unsigned xb_ld(unsigned* p)              { return __hip_atomic_load(p, __ATOMIC_RELAXED, __HIP_MEMORY_SCOPE_AGENT); }
__device__ __forceinline__ unsigned xb_add(unsigned* p, unsigned v) { return __hip_atomic_fetch_add(p, v, __ATOMIC_RELAXED, __HIP_MEMORY_SCOPE_AGENT); }
__device__ __forceinline__ unsigned xb_xcc_id() { return (unsigned)__builtin_amdgcn_s_getreg((3 << 11) | 20) & 0xFu; }
#define XB_SPIN(cond, bar) do { unsigned _sp = 0; while (cond) { __builtin_amdgcn_s_sleep(1); \
    if ((++_sp & 255u) == 0u) { if (xb_ld(&(bar)[XB_TMO])) break; if (_sp > XB_SPIN_CAP) { atomicAdd(&(bar)[XB_TMO], 1u); break; } } } } while (0)

struct XcdBarrier {
    unsigned* bar; unsigned x;
    volatile LAS unsigned* st;
};

__device__ __forceinline__ XcdBarrier xcd_barrier_post(unsigned* bar, volatile LAS unsigned* st) {
    XcdBarrier b; b.bar = bar; b.x = xb_xcc_id(); b.st = st;
    if (threadIdx.x == 0) (void)xb_add(&bar[XB_XCNT(b.x)], 1u);
    return b;
}
__device__ __forceinline__ void xcd_barrier_complete(unsigned* bar, unsigned x, unsigned& nloc, unsigned& nx) {
    const unsigned G = gridDim.x * gridDim.y * gridDim.z;
    unsigned sum, cnt, mine, sp = 0u;
    for (;;) {
        sum = 0u; cnt = 0u; mine = 0u;
#pragma unroll
        for (unsigned j = 0; j < 16; ++j) { const unsigned c = xb_ld(&bar[XB_XCNT(j)]); sum += c; cnt += (c > 0u) ? 1u : 0u; mine = (j == x) ? c : mine; }
        if (sum == G) break;
        __builtin_amdgcn_s_sleep(1);
        if ((++sp & 255u) == 0u) { if (xb_ld(&bar[XB_TMO])) break; if (sp > XB_SPIN_CAP) { atomicAdd(&bar[XB_TMO], 1u); break; } }
    }
    nloc = mine > 0u ? mine : 1u; nx = cnt > 0u ? cnt : 1u;
}

__device__ __forceinline__ void xcd_barrier(const XcdBarrier& b) {
    asm volatile("s_waitcnt vmcnt(0)" ::: "memory");
    __syncthreads();
    if (threadIdx.x == 0) {
        unsigned* bar = b.bar;
        __builtin_amdgcn_s_waitcnt(0);
        unsigned nloc = b.st[0], nx = b.st[1];
        if (nloc == 0u) { xcd_barrier_complete(bar, b.x, nloc, nx); b.st[0] = nloc; b.st[1] = nx; }
        const unsigned old = xb_add(&bar[XB_XSUB(b.x)], 1u);
        const unsigned gen = old / nloc;
        if (old + 1u == (gen + 1u) * nloc) {
            __builtin_amdgcn_fence(__ATOMIC_RELEASE, "agent");
            asm volatile("s_waitcnt vmcnt(0)" ::: "memory");
            const unsigned og = xb_add(&bar[XB_TOP], 1u);
            const unsigned tg = og / nx;
            if (og + 1u == (tg + 1u) * nx) xb_add(&bar[XB_TOPGEN], 1u);
            else XB_SPIN(xb_ld(&bar[XB_TOPGEN]) == tg, bar);
            __builtin_amdgcn_fence(__ATOMIC_ACQUIRE, "agent");
            xb_add(&bar[XB_XGEN(b.x)], 1u);
            asm volatile("s_waitcnt vmcnt(0)" ::: "memory");
        } else {
            XB_SPIN(xb_ld(&bar[XB_XGEN(b.x)]) == gen, bar);
            __builtin_amdgcn_fence(__ATOMIC_ACQUIRE, "agent");
            asm volatile("s_waitcnt vmcnt(0)" ::: "memory");
        }
    }
    __syncthreads();
}

namespace cg = cooperative_groups;
constexpr int FUSED_LDS = MIX_LDS;
static_assert(FUSED_LDS >= pg8::STAGE_BYTES && FUSED_LDS >= 8 * 64 * 33 * 4, "LDS budget");
#define GSYNC() xcd_barrier(bar)
#ifndef PHM
#define PHM 511
#endif
#ifndef REP
#define REP 0
#endif
__global__ void __launch_bounds__(NT, 2) fwd_fused(KParams kp_unused) {
    cg::grid_group grid = cg::this_grid();
    extern __shared__ __attribute__((aligned(16))) unsigned char dl[];
    Params p; p.in.tab = (LAS const unsigned long long*)((LAS unsigned char*)dl + FUSED_LDS);
    {
        const __attribute__((address_space(4))) unsigned long long* ka = (const __attribute__((address_space(4))) unsigned long long*)__builtin_amdgcn_kernarg_segment_ptr();
        if (threadIdx.x < 43) ((LAS unsigned long long*)((LAS unsigned char*)dl + FUSED_LDS))[threadIdx.x] = ka[threadIdx.x];
        if (threadIdx.x < 4) ((LAS unsigned*)((LAS unsigned char*)dl + FUSED_LDS + 512))[threadIdx.x] = 0u;
        __syncthreads();
    }
    const XcdBarrier bar = xcd_barrier_post((unsigned*)(p.ws() + WS_CTL), (volatile LAS unsigned*)((LAS unsigned char*)dl + FUSED_LDS + 512));
    float* X = p.out();
#pragma unroll 1
    for (int l = 0; l < 2; ++l) {
        {
            const int tid = opq_tid();
            convert_weights(p, l, (LAS float*)dl + (tid >> 6) * 64 * 33, blockIdx.x * 8 + (tid >> 6), gridDim.x * 8, tid & 63);
        }
#pragma unroll 1
        for (int b = 0; b < 2; ++b) {
            const float* Xin = (l == 0 ? p.in[0] : X) + (size_t)b * TB * D;
            float* Xb = X + (size_t)b * TB * D;
            { unsigned char* ws = opq(p.ws()); rmsnorm_rows(Xin, p.in[1] + l * D, (bf16_t*)(ws + WS_XN), TB); }
            if (l == 0 && b == 0) grid.sync(); else GSYNC();
#if PHM & 1
            for (int rep_ = 0; rep_ < ((REP & 1) ? 2 : 1); ++rep_) {
            {
                unsigned char* ws = opq(p.ws()); const bf16_t* WL = (const bf16_t*)(ws + WS_W);
                pg8::Gemm g{(const bf16_t*)(ws + WS_XN), WL + WO_IN, TB, 7168, D, D, D, 0};
                pg8::StaticOrder S; S.init(g.M, g.N, (int)gridDim.x, (int)blockIdx.x);
                pg8::gemm_phase<pg8::EpiProjP, pg8::StaticOrder, true, true>((PG8_LAS unsigned char*)dl, g, S, pg8::EpiProjP{(bf16_t*)(ws + WS_PM), (bf16_t*)(ws + WS_G)});
            }
            }
#endif
            GSYNC();
#if PHM & 2
            for (int rep_ = 0; rep_ < ((REP & 2) ? 2 : 1); ++rep_) {
            for (int n = blockIdx.x; n < 512; n += gridDim.x) {
                unsigned char* ws = opq(p.ws());
                if (n < 256) gdn_prep_chunk((const bf16_t*)(ws + WS_PM), n, gdn_bufs(ws), p, l, (LAS float*)dl);
                else { const bf16_t* WL = (const bf16_t*)(ws + WS_W); rwkv_prep_chunk((const bf16_t*)(ws + WS_PM), n - 256, rwkv_bufs(ws), p, l, WL + WO_WUP, WL + WO_AUP, WL + WO_GUP, (LAS unsigned char*)dl); }
            }
            }
#endif
            GSYNC();
#if PHM & 4
            for (int rep_ = 0; rep_ < ((REP & 4) ? 2 : 1); ++rep_) {
            for (int u = blockIdx.x; u < 2560; u += gridDim.x) {
                unsigned char* ws = opq(p.ws());
                if (u < 1024) gdn_g1_unit(u >> 8, u & 255, gdn_bufs(ws), (LAS float*)dl);
                else if (u < 2048) rwkv_g1_unit((u - 1024) >> 8, u & 255, rwkv_bufs(ws), (LAS float*)dl);
                else if (u < 2304) lru_unit<1>((const bf16_t*)(ws + WS_PM), u - 2048, lru_bufs(ws), (bf16_t*)(ws + WS_Y), p, l, (const bf16_t*)(ws + WS_W) + WO_LWT, (LAS float*)dl);
                else s5_unit<1>((const bf16_t*)(ws + WS_PM), u - 2304, s5_bufs(ws), (bf16_t*)(ws + WS_Y), p, l, (const bf16_t*)(ws + WS_W) + WO_GLU, (LAS unsigned char*)dl);
            }
            }
#endif
            GSYNC();
#if PHM & 8
            for (int rep_ = 0; rep_ < ((REP & 8) ? 2 : 1); ++rep_) {
            {
                const int tid = opq_tid(), lane = tid & 63, wv = tid >> 6;
                const int bx = blockIdx.x;
                volatile LAS unsigned* flags = (volatile LAS unsigned*)((LAS unsigned char*)dl + FUSED_LDS + 768);
                if (tid < 16) flags[tid] = 0u;
                __syncthreads();
                if (bx < 32) {
                    unsigned char* ws = opq(p.ws());
                    const GdnBufs B = gdn_bufs(ws); const int sq = bx >> 2, cb = bx & 3;
                    if (wv == 0) chain_wave(B.HT + (size_t)sq * 256 * 4096, cb, 256, lane, (LAS unsigned char*)dl, flags);
                    else chain_loader(B.MF + (size_t)sq * 256 * 1024, B.NF + (size_t)sq * 256 * 4096, cb, 256, lane, wv - 1, (LAS unsigned char*)dl, flags);
                } else {
                    unsigned char* ws = opq(p.ws());
                    for (int job = (bx - 32) * 8 + wv; job < 1280; job += (int)(gridDim.x - 32) * 8) {
                        if (job < 256) lru_carry_wave(lru_bufs(ws), job, lane);
                        else s5_carry_wave(s5_bufs(ws), p, l, job - 256, lane);
                    }
                }
            }
            }
#endif
            GSYNC();
#if PHM & 16
            for (int rep_ = 0; rep_ < ((REP & 16) ? 2 : 1); ++rep_) {
            for (int u = blockIdx.x; u < 2560; u += gridDim.x) {
                unsigned char* ws = opq(p.ws());
                if (u < 1024) gdn_g3_unit(u >> 8, u & 255, gdn_bufs(ws), (const bf16_t*)(ws + WS_PM), (bf16_t*)(ws + WS_Y), p.in[6] + l * 64, (LAS float*)dl);
                else if (u < 2048) rwkv_g3_unit((u - 1024) >> 8, u & 255, rwkv_bufs(ws), (bf16_t*)(ws + WS_Y), p, l, (LAS float*)dl);
                else if (u < 2304) lru_unit<3>((const bf16_t*)(ws + WS_PM), u - 2048, lru_bufs(ws), (bf16_t*)(ws + WS_Y), p, l, (const bf16_t*)(ws + WS_W) + WO_LWT, (LAS float*)dl);
                else s5_unit<3>((const bf16_t*)(ws + WS_PM), u - 2304, s5_bufs(ws), (bf16_t*)(ws + WS_Y), p, l, (const bf16_t*)(ws + WS_W) + WO_GLU, (LAS unsigned char*)dl);
            }
            }
#endif
            GSYNC();
#if PHM & 32
            for (int rep_ = 0; rep_ < ((REP & 32) ? 2 : 1); ++rep_) {
            { unsigned char* ws = opq(p.ws()); merge_phase((const bf16_t*)(ws + WS_Y), (const bf16_t*)(ws + WS_W) + WO_BR, (const bf16_t*)(ws + WS_G), (bf16_t*)(ws + WS_MG), (LAS unsigned char*)dl); }
            }
#endif
            GSYNC();
#if PHM & 64
            {
                unsigned char* ws = opq(p.ws()); const bf16_t* WL = (const bf16_t*)(ws + WS_W);
                pg8::Gemm g{(const bf16_t*)(ws + WS_MG), WL + WO_OUT, TB, D, D, D, D, 0};
                pg8::StaticOrder S; S.init(g.M, g.N, (int)gridDim.x, (int)blockIdx.x);
                pg8::gemm_phase<pg8::EpiResidP, pg8::StaticOrder, false, true>((PG8_LAS unsigned char*)dl, g, S, pg8::EpiResidP{Xin, Xb});
            }
#endif
            GSYNC();
            { unsigned char* ws = opq(p.ws()); rmsnorm_rows(Xb, p.in[37] + l * D, (bf16_t*)(ws + WS_XN), TB); }
            GSYNC();
#if PHM & 128
            for (int rep_ = 0; rep_ < ((REP & 128) ? 2 : 1); ++rep_) {
            {
                unsigned char* ws = opq(p.ws()); const bf16_t* WL = (const bf16_t*)(ws + WS_W);
                pg8::Gemm g{(const bf16_t*)(ws + WS_XN), WL + WO_W1, TB, DFF, D, D, D, 0};
                pg8::StaticOrder S; S.init(g.M, g.N, (int)gridDim.x, (int)blockIdx.x);
                pg8::gemm_phase<pg8::EpiRelu2P, pg8::StaticOrder, true, true>((PG8_LAS unsigned char*)dl, g, S, pg8::EpiRelu2P{(bf16_t*)(ws + WS_HD), DFF, 0});
            }
            }
#endif
            GSYNC();
#if PHM & 256
            {
                unsigned char* ws = opq(p.ws()); const bf16_t* WL = (const bf16_t*)(ws + WS_W);
                pg8::Gemm g{(const bf16_t*)(ws + WS_HD), WL + WO_W2, TB, D, DFF, DFF, DFF, 0};
                pg8::StaticOrder S; S.init(g.M, g.N, (int)gridDim.x, (int)blockIdx.x);
                pg8::gemm_phase<pg8::EpiResidP, pg8::StaticOrder, false, true>((PG8_LAS unsigned char*)dl, g, S, pg8::EpiResidP{Xb, Xb});
            }
#endif
            GSYNC();
        }
    }
    rmsnorm_rows(X, p.in[40], X, 2 * TB);
}

extern "C" void kernel_launch(void* const* d_in, const int* in_sizes, int n_in, void* d_out, int out_size, void* d_ws, size_t ws_size, hipStream_t stream) {
    KParams p{};
    for (int i = 0; i < 41; ++i) p.in[i] = (const float*)d_in[i];
    p.out = (float*)d_out; p.ws = (unsigned char*)d_ws; p.pad = 0;
    static int grid = 0;
    if (grid == 0) {
        int dev = 0, cus = 0, per_cu = 0;
        hipGetDevice(&dev);
        hipDeviceGetAttribute(&cus, hipDeviceAttributeMultiprocessorCount, dev);
        hipFuncSetAttribute((const void*)fwd_fused, hipFuncAttributeMaxDynamicSharedMemorySize, FUSED_LDS + 1024);
        hipOccupancyMaxActiveBlocksPerMultiprocessor(&per_cu, (const void*)fwd_fused, NT, FUSED_LDS + 1024);
        if (per_cu < 1) per_cu = 1;
        grid = cus * per_cu;
        if (grid > 256) grid = 256;
    }
    hipMemsetAsync((unsigned char*)d_ws + WS_CTL, 0, 16384, stream);
    void* args[] = {&p};
    hipError_t e = hipLaunchCooperativeKernel((const void*)fwd_fused, dim3(grid), dim3(NT), args, FUSED_LDS + 1024, stream);
    if (e != hipSuccess) fprintf(stderr, "cooperative launch failed: %s (grid %d)\n", hipGetErrorString(e), grid);
}
```

```cpp
#include <hip/hip_runtime.h>
#include <hip/hip_cooperative_groups.h>
#include <cstdio>
#include <cstdint>

constexpr int TB = 16384;
constexpr int D = 1024;
constexpr int DIN = 6920;
constexpr int NMIX = 2824;
constexpr int W = 256;
constexpr int DFF = 4096;
constexpr int NT = 512;

constexpr int C_GDN = 0, C_LRU = 1032, C_S5 = 1544, C_RWKV = 1800, C_GATE = 2824;

struct KParams { const float* in[41]; float* out; unsigned char* ws; size_t pad; };
#define LAS __attribute__((address_space(3)))
#define GAS __attribute__((address_space(1)))
struct PIn { LAS const unsigned long long* tab;
    __device__ __forceinline__ const float* operator[](int i) const { LAS const unsigned long long* t = tab; asm volatile("" : "+v"(t)); const unsigned long long v = t[i];
        const unsigned lo = __builtin_amdgcn_readfirstlane((unsigned)v), hi = __builtin_amdgcn_readfirstlane((unsigned)(v >> 32)); return (const float*)(GAS const float*)(((unsigned long long)hi << 32) | lo); } };
struct Params { PIn in;
    __device__ __forceinline__ float* out() const { return (float*)in[41]; }
    __device__ __forceinline__ unsigned char* ws() const { return (unsigned char*)in[42]; } };

typedef unsigned short bf16_t;
constexpr int PMLD = 3072;
constexpr size_t MiB = 1u << 20;
constexpr size_t WS_W  = 0;
constexpr size_t WS_CTL = 35 * MiB;
constexpr size_t WS_XN = 36 * MiB;
constexpr size_t WS_PM = 68 * MiB;
constexpr size_t WS_G  = 164 * MiB;
constexpr size_t WS_HD = 164 * MiB;
constexpr size_t WS_Y  = 292 * MiB;
constexpr size_t WS_MG = 324 * MiB;

__device__ __forceinline__ unsigned f2bf(float f) { unsigned u = __float_as_uint(f); return (u + 0x7fffu + ((u >> 16) & 1u)) >> 16; }
__device__ __forceinline__ float bf2f(bf16_t b) { return __uint_as_float((unsigned)b << 16); }
__device__ __forceinline__ float ldf(const float* p) { return *p; }
__device__ __forceinline__ float ldf(const bf16_t* p) { return bf2f(*p); }
__device__ __forceinline__ float sigmoidf_(float x) { return 1.f / (1.f + __expf(-x)); }
__device__ __forceinline__ float softplusf_(float x) { return x > 20.f ? x : log1pf(__expf(x)); }
__device__ __forceinline__ float siluf_(float x) { return x * sigmoidf_(x); }
__device__ __forceinline__ float geluf_(float x) { return 0.5f * x * (1.f + tanhf(0.7978845608028654f * (x + 0.044715f * x * x * x))); }
__device__ __forceinline__ float rl(float v, int i) { return __int_as_float(__builtin_amdgcn_readlane(__float_as_int(v), i)); }
__device__ __forceinline__ float wave_sum(float v) {
#pragma unroll
    for (int o = 1; o < 64; o <<= 1) v += __shfl_xor(v, o);
    return v;
}

template <class OT>
__device__ __forceinline__ void rmsnorm_rows(const float* X, const float* g, OT* O, int rows) {
    int tid_ = threadIdx.x; asm volatile("" : "+v"(tid_));
    const int lane = tid_ & 63, wv = tid_ >> 6;
    const int gw = blockIdx.x * (NT / 64) + wv, ngw = gridDim.x * (NT / 64);
    for (int r = gw; r < rows; r += ngw) {
        const float4* xr = (const float4*)(X + (size_t)r * D);
        float4 v[4]; float s = 0.f;
#pragma unroll
        for (int j = 0; j < 4; ++j) { v[j] = xr[lane + 64 * j]; s += v[j].x * v[j].x + v[j].y * v[j].y + v[j].z * v[j].z + v[j].w * v[j].w; }
        s = wave_sum(s);
        const float rs = rsqrtf(s * (1.f / D) + 1e-6f);
#pragma unroll
        for (int j = 0; j < 4; ++j) {
            const float4 gg = ((const float4*)g)[lane + 64 * j];
            const float4 o = make_float4(v[j].x * rs * gg.x, v[j].y * rs * gg.y, v[j].z * rs * gg.z, v[j].w * rs * gg.w);
            if constexpr (sizeof(OT) == 4) ((float4*)(O + (size_t)r * D))[lane + 64 * j] = o;
            else ((uint2*)(O + (size_t)r * D))[lane + 64 * j] = make_uint2(f2bf(o.x) | (f2bf(o.y) << 16), f2bf(o.z) | (f2bf(o.w) << 16));
        }
    }
}

namespace pg8 {
#define PG8_LAS __attribute__((address_space(3)))
typedef short bf16x8 __attribute__((ext_vector_type(8)));
typedef float f32x4 __attribute__((ext_vector_type(4)));
typedef unsigned u32x4 __attribute__((ext_vector_type(4)));
constexpr int BM = 256, BK = 64, HALF = 128, HTB = HALF * BK * 2  , STAGE_BYTES = 8 * HTB, NXCD = 8, WGM = 8;

__host__ __device__ __forceinline__ int lds_byte(int r, int c) { const int st = (r >> 4) * 2 + (c >> 5), rr = r & 15, cc = c & 31, ob = rr * 64 + cc * 2; return st * 1024 + (ob ^ (((ob >> 9) & 1) << 5)); }
__host__ __device__ __forceinline__ void stage_rc(int b, int& R, int& C) { const int st = b / 1024, sb = b % 1024, swz = sb ^ (((sb >> 9) & 1) << 5); R = (st >> 1) * 16 + swz / 64; C = (st & 1) * 32 + (swz % 64) / 2; }
__host__ __device__ __forceinline__ int perm32(int rho) { const int n = rho >> 4, i = rho & 15; return 8 * (i >> 2) + 4 * n + (i & 3); }

struct Unit { int pm, pn; };
struct Gemm { const bf16_t* A; const bf16_t* Bt; int M, N, K, lda, ldb, pad; };

struct StaticOrder {
    int nM, nN, nwg, G, c;
    __host__ __device__ void init(int M, int N, int G_, int c_) { nM = M / BM; nN = N / BM; nwg = nM * nN; G = G_; c = c_; }
    __host__ __device__ bool next(int i, Unit& u) const {
        const long L = (long)i * G + c; if (L >= nwg) return false;
        int wgid = (int)L; { const int q = nwg / NXCD, r = nwg % NXCD, xcd = wgid % NXCD, off = wgid / NXCD; wgid = (xcd < r ? xcd * (q + 1) : r * (q + 1) + (xcd - r) * q) + off; }
        const int nig = WGM * nN, gid = wgid / nig, fm = gid * WGM, gsz = (nM - fm) < WGM ? (nM - fm) : WGM;
        u.pm = fm + ((wgid % nig) % gsz); u.pn = (wgid % nig) / gsz; return true;
    }
    __device__ __forceinline__ void a_ready(const Unit&) const {}
    __device__ __forceinline__ void done(const Unit&) const {}
};


typedef __bf16 bf16x2p_t __attribute__((ext_vector_type(2)));
typedef float f32x2p_t __attribute__((ext_vector_type(2)));
__device__ __forceinline__ unsigned cvt_pk_bf16(float lo, float hi) { return __builtin_bit_cast(unsigned, __builtin_convertvector((f32x2p_t){lo, hi}, bf16x2p_t)); }
__device__ __forceinline__ float sigm(float x) { return __builtin_amdgcn_rcpf(1.f + __expf(-x)); }
struct EpiProjP {
    static constexpr bool PERM = true, AFTER_DRAIN = false;
    bf16_t* PM; bf16_t* G;
    __device__ __forceinline__ void operator()(const f32x4 (&acc)[2][2][4][2], const Unit& u, int wr, int wc, int fr, int fq) const {
        const int row0 = u.pm * BM + wr * 64 + fr;
        const bool sg = u.pn >= 12;
        bf16_t* base = sg ? G : PM; const int ld = sg ? 4096 : 3072; const int colt = (sg ? u.pn - 12 : u.pn) * BM;
        const int col0 = colt + wc * 32 + 8 * fq;
#pragma unroll
        for (int ai = 0; ai < 2; ++ai)
#pragma unroll
            for (int m = 0; m < 4; ++m) { bf16_t* rowp = base + (size_t)(row0 + ai * HALF + m * 16) * ld + col0;
#pragma unroll
                for (int bj = 0; bj < 2; ++bj) { f32x4 v0 = acc[ai][bj][m][0], v1 = acc[ai][bj][m][1];
                    if (sg) { v0[0] = sigm(v0[0]); v0[1] = sigm(v0[1]); v0[2] = sigm(v0[2]); v0[3] = sigm(v0[3]); v1[0] = sigm(v1[0]); v1[1] = sigm(v1[1]); v1[2] = sigm(v1[2]); v1[3] = sigm(v1[3]); }
                    u32x4 w; w.x = cvt_pk_bf16(v0[0], v0[1]); w.y = cvt_pk_bf16(v0[2], v0[3]); w.z = cvt_pk_bf16(v1[0], v1[1]); w.w = cvt_pk_bf16(v1[2], v1[3]);
                    *(u32x4*)(rowp + bj * HALF) = w; } }
    }
};
struct EpiRelu2P {
    static constexpr bool PERM = true, AFTER_DRAIN = false;
    bf16_t* O; int ldo; int pad;
    __device__ __forceinline__ void operator()(const f32x4 (&acc)[2][2][4][2], const Unit& u, int wr, int wc, int fr, int fq) const {
        const int row0 = u.pm * BM + wr * 64 + fr, col0 = u.pn * BM + wc * 32 + 8 * fq;
#pragma unroll
        for (int ai = 0; ai < 2; ++ai)
#pragma unroll
            for (int m = 0; m < 4; ++m) { bf16_t* rowp = O + (size_t)(row0 + ai * HALF + m * 16) * ldo + col0;
#pragma unroll
                for (int bj = 0; bj < 2; ++bj) { f32x4 v0 = acc[ai][bj][m][0], v1 = acc[ai][bj][m][1];
#pragma unroll
                    for (int j = 0; j < 4; ++j) { const float a = fmaxf(v0[j], 0.f), b = fmaxf(v1[j], 0.f); v0[j] = a * a; v1[j] = b * b; }
                    u32x4 w; w.x = cvt_pk_bf16(v0[0], v0[1]); w.y = cvt_pk_bf16(v0[2], v0[3]); w.z = cvt_pk_bf16(v1[0], v1[1]); w.w = cvt_pk_bf16(v1[2], v1[3]);
                    *(u32x4*)(rowp + bj * HALF) = w; } }
    }
};
struct EpiResidP {
    static constexpr bool PERM = false, AFTER_DRAIN = false;
    const float* base; float* out;
    __device__ __forceinline__ void operator()(const f32x4 (&acc)[2][2][4][2], const Unit& u, int wr, int wc, int fr, int fq) const {
        const int row0 = u.pm * BM + wr * 64 + fr, col0 = u.pn * BM + wc * 32 + 4 * fq;
#pragma unroll
        for (int ai = 0; ai < 2; ++ai)
#pragma unroll
            for (int m = 0; m < 4; ++m) { const size_t off = (size_t)(row0 + ai * HALF + m * 16) * 1024 + col0;
#pragma unroll
                for (int bj = 0; bj < 2; ++bj)
#pragma unroll
                    for (int n = 0; n < 2; ++n) { const f32x4 b = *(const f32x4*)(base + off + bj * HALF + n * 16); *(f32x4*)(out + off + bj * HALF + n * 16) = b + acc[ai][bj][m][n]; } }
    }
};
template <class Epi, class Sched, bool ALIGN_EPI = false, bool SP2 = false>
__device__ __forceinline__ void gemm_phase(PG8_LAS unsigned char* lds, const Gemm g, const Sched& S, const Epi& E) {
    int tid = threadIdx.x; asm volatile("" : "+v"(tid));
    const int wid = __builtin_amdgcn_readfirstlane(tid >> 6), lane = tid & 63, wr = wid >> 2, wc = wid & 3, fr = lane & 15, fq = lane >> 4;
    const int K = g.K, nt = K / BK;
    unsigned voffA[2], voffB[2];
#pragma unroll
    for (int i = 0; i < 2; ++i) { int R, C; stage_rc(tid * 16 + i * 8192, R, C); const int Rb = Epi::PERM ? ((R & ~31) + perm32(R & 31)) : R;
        voffA[i] = (unsigned)(R * g.lda + C) * 2u; voffB[i] = (unsigned)(Rb * g.ldb + C) * 2u; }
    const size_t kstep = (size_t)(BK * 2);
    const size_t hstepA = (size_t)HALF * g.lda * 2, hstepB = (size_t)HALF * g.ldb * 2;
    const size_t tstepA = 2 * hstepA, tstepB = 2 * hstepB;
    const unsigned ldsw = (unsigned)wid * 1024u;
    const int aoff = lds_byte(wr * 64 + fr, fq * 8), boff = lds_byte(wc * 32 + fr, fq * 8);
#define PG8_SA(b, h) (((b) * 2 + (h)) * HTB)
#define PG8_SB(b, h) ((4 + (b) * 2 + (h)) * HTB)
#define PG8_STAGE(bufoff, gbase, voff) do { _Pragma("unroll") for (int _i = 0; _i < 2; ++_i) \
        __builtin_amdgcn_global_load_lds((const unsigned*)((const char*)(gbase) + (voff)[_i]), (PG8_LAS unsigned*)(lds + (bufoff) + ldsw + _i * 8192), 16, 0, 0); } while (0)
#define PG8_LDA(dst, b, h) do { _Pragma("unroll") for (int m = 0; m < 4; ++m) _Pragma("unroll") for (int k = 0; k < 2; ++k) dst[m][k] = *(const PG8_LAS bf16x8*)(lds + PG8_SA(b, h) + aoff + m * 2048 + k * 1024); } while (0)
#define PG8_LDB(dst, b, h) do { _Pragma("unroll") for (int n = 0; n < 2; ++n) _Pragma("unroll") for (int k = 0; k < 2; ++k) dst[n][k] = *(const PG8_LAS bf16x8*)(lds + PG8_SB(b, h) + boff + n * 2048 + k * 1024); } while (0)
#define PG8_MMA(ai, bj, At, Bt) do { __builtin_amdgcn_s_setprio(1); _Pragma("unroll") for (int m = 0; m < 4; ++m) _Pragma("unroll") for (int n = 0; n < 2; ++n) _Pragma("unroll") for (int k = 0; k < 2; ++k) \
        acc[ai][bj][m][n] = __builtin_amdgcn_mfma_f32_16x16x32_bf16(Bt[n][k], At[m][k], acc[ai][bj][m][n], 0, 0, 0); __builtin_amdgcn_s_setprio(0); } while (0)
#define PG8_WAIT_V(n) asm volatile("s_waitcnt vmcnt(" #n ")" ::: "memory")
#define PG8_WAIT_L(n) asm volatile("s_waitcnt lgkmcnt(" #n ")" ::: "memory")
#define PG8_BAR __builtin_amdgcn_s_barrier()
#define PG8_SCHED __builtin_amdgcn_sched_barrier(0)
    Unit cur, nxt; int ui = 0;
    if (!S.next(0, cur)) return;
    f32x4 acc[2][2][4][2];
#pragma unroll
    for (int a = 0; a < 2; ++a)
#pragma unroll
        for (int b = 0; b < 2; ++b)
#pragma unroll
            for (int m = 0; m < 4; ++m)
#pragma unroll
                for (int n = 0; n < 2; ++n) acc[a][b][m][n] = (f32x4){0.f, 0.f, 0.f, 0.f};
    bf16x8 At[4][2], B0[2][2], B1[2][2];
    const char* cA = (const char*)g.A + (size_t)cur.pm * tstepA; const char* cB = (const char*)g.Bt + (size_t)cur.pn * tstepB;
    S.a_ready(cur);
    if constexpr (SP2) {
        PG8_STAGE(PG8_SB(0, 0), cB, voffB); PG8_STAGE(PG8_SB(0, 1), cB + hstepB, voffB); PG8_STAGE(PG8_SA(0, 0), cA, voffA); PG8_STAGE(PG8_SA(0, 1), cA + hstepA, voffA);
        if (wr == 1) PG8_BAR;
        PG8_WAIT_V(2); PG8_BAR;
        PG8_STAGE(PG8_SB(1, 0), cB + kstep, voffB); PG8_STAGE(PG8_SA(1, 0), cA + kstep, voffA); PG8_STAGE(PG8_SB(1, 1), cB + hstepB + kstep, voffB);
        PG8_WAIT_V(6); PG8_BAR;
    } else {
        PG8_STAGE(PG8_SB(0, 0), cB, voffB); PG8_STAGE(PG8_SA(0, 0), cA, voffA); PG8_STAGE(PG8_SB(0, 1), cB + hstepB, voffB); PG8_STAGE(PG8_SA(0, 1), cA + hstepA, voffA);
        if (wr == 1) PG8_BAR;
        PG8_WAIT_V(4); PG8_BAR;
        PG8_STAGE(PG8_SB(1, 0), cB + kstep, voffB); PG8_STAGE(PG8_SA(1, 0), cA + kstep, voffA); PG8_STAGE(PG8_SB(1, 1), cB + hstepB + kstep, voffB);
        PG8_WAIT_V(6); PG8_BAR;
    }
    for (;;) {
        const bool has_next = S.next(ui + 1, nxt);
        const char* nA = has_next ? (const char*)g.A + (size_t)nxt.pm * tstepA : cA; const char* nB = has_next ? (const char*)g.Bt + (size_t)nxt.pn * tstepB : cB;
        for (int t = 0; t < nt; t += 2) {
            const bool last = (t == nt - 2);
            const char* a1 = cA + (size_t)(t + 1) * kstep;
            const char* a2 = last ? nA : cA + (size_t)(t + 2) * kstep; const char* b2 = last ? nB : cB + (size_t)(t + 2) * kstep;
            const char* a3 = a2 + kstep; const char* b3 = b2 + kstep;
            if (last && has_next) S.a_ready(nxt);
            if constexpr (SP2) {
            PG8_LDB(B0, 0, 0); PG8_LDB(B1, 0, 1); PG8_SCHED; PG8_LDA(At, 0, 0); PG8_STAGE(PG8_SA(1, 1), a1 + hstepA, voffA);
            PG8_WAIT_V(8); PG8_WAIT_L(0); PG8_BAR; PG8_MMA(0, 0, At, B0); PG8_MMA(0, 1, At, B1); PG8_BAR; PG8_SCHED;
            PG8_LDA(At, 0, 1); PG8_STAGE(PG8_SB(0, 0), b2, voffB); PG8_STAGE(PG8_SB(0, 1), b2 + hstepB, voffB); PG8_STAGE(PG8_SA(0, 0), a2, voffA);
            PG8_WAIT_V(8); PG8_WAIT_L(0); PG8_BAR; PG8_MMA(1, 0, At, B0); PG8_MMA(1, 1, At, B1); PG8_BAR; PG8_SCHED;
            PG8_LDB(B0, 1, 0); PG8_LDB(B1, 1, 1); PG8_SCHED; PG8_LDA(At, 1, 0); PG8_STAGE(PG8_SA(0, 1), a2 + hstepA, voffA);
            PG8_WAIT_V(8); PG8_WAIT_L(0); PG8_BAR; PG8_MMA(0, 0, At, B0); PG8_MMA(0, 1, At, B1); PG8_BAR; PG8_SCHED;
            PG8_LDA(At, 1, 1); PG8_STAGE(PG8_SB(1, 0), b3, voffB); PG8_STAGE(PG8_SB(1, 1), b3 + hstepB, voffB); PG8_STAGE(PG8_SA(1, 0), a3, voffA);
            PG8_WAIT_V(8); PG8_WAIT_L(0); PG8_BAR; PG8_MMA(1, 0, At, B0); PG8_MMA(1, 1, At, B1); PG8_BAR; PG8_SCHED;
            } else {
            PG8_LDB(B0, 0, 0); PG8_SCHED; PG8_LDA(At, 0, 0); PG8_STAGE(PG8_SA(1, 1), a1 + hstepA, voffA);
            PG8_WAIT_L(8); PG8_BAR; PG8_WAIT_L(0); PG8_MMA(0, 0, At, B0); PG8_BAR; PG8_SCHED;
            PG8_LDB(B1, 0, 1); PG8_STAGE(PG8_SB(0, 0), b2, voffB);
            PG8_BAR; PG8_WAIT_L(0); PG8_MMA(0, 1, At, B1); PG8_BAR;
            PG8_LDA(At, 0, 1); PG8_STAGE(PG8_SA(0, 0), a2, voffA);
            PG8_BAR; PG8_WAIT_L(0); PG8_MMA(1, 0, At, B0); PG8_BAR; PG8_SCHED;
            PG8_STAGE(PG8_SB(0, 1), b2 + hstepB, voffB);
            PG8_WAIT_V(6); PG8_BAR; PG8_MMA(1, 1, At, B1); PG8_BAR;
            PG8_LDB(B0, 1, 0); PG8_SCHED; PG8_LDA(At, 1, 0); PG8_STAGE(PG8_SA(0, 1), a2 + hstepA, voffA);
            PG8_WAIT_L(8); PG8_BAR; PG8_WAIT_L(0); PG8_MMA(0, 0, At, B0); PG8_BAR; PG8_SCHED;
            PG8_LDB(B1, 1, 1); PG8_STAGE(PG8_SB(1, 0), b3, voffB);
            PG8_BAR; PG8_WAIT_L(0); PG8_MMA(0, 1, At, B1); PG8_BAR;
            PG8_LDA(At, 1, 1); PG8_STAGE(PG8_SA(1, 0), a3, voffA);
            PG8_BAR; PG8_WAIT_L(0); PG8_MMA(1, 0, At, B0); PG8_BAR; PG8_SCHED;
            PG8_STAGE(PG8_SB(1, 1), b3 + hstepB, voffB);
            PG8_WAIT_V(6); PG8_BAR; PG8_MMA(1, 1, At, B1); PG8_BAR;
            }
        }
        if constexpr (ALIGN_EPI) { if (wr == 0) PG8_BAR; }
        if constexpr (!Epi::AFTER_DRAIN) { E(acc, cur, wr, wc, fr, fq); S.done(cur); }
        if (!has_next) break;
#pragma unroll
        for (int a = 0; a < 2; ++a)
#pragma unroll
            for (int b = 0; b < 2; ++b)
#pragma unroll
                for (int m = 0; m < 4; ++m)
#pragma unroll
                    for (int n = 0; n < 2; ++n) acc[a][b][m][n] = (f32x4){0.f, 0.f, 0.f, 0.f};
        cur = nxt; cA = nA; cB = nB; ++ui;
        if constexpr (ALIGN_EPI) { if (wr == 1) PG8_BAR; }
    }
    PG8_WAIT_V(0);
    if constexpr (!ALIGN_EPI) { if (wr == 0) PG8_BAR; }
    PG8_BAR;
    if constexpr (Epi::AFTER_DRAIN) { E.fused(acc, cur, wr, wc, fr, fq, lds, wid, lane); S.done(cur); }
#undef PG8_SA
#undef PG8_SB
#undef PG8_STAGE
#undef PG8_LDA
#undef PG8_LDB
#undef PG8_MMA
#undef PG8_WAIT_V
#undef PG8_WAIT_L
#undef PG8_BAR
#undef PG8_SCHED
}
}


__device__ __forceinline__ unsigned pk2(float lo, float hi) { return f2bf(lo) | (f2bf(hi) << 16); }
template <class CM>
__device__ __forceinline__ void transpose_item(const float* __restrict__ Wsrc, int K, int ldsrc, bf16_t* __restrict__ WT, int nblk, LAS float* scr, int item, int lane, CM colmap) {
    const int kb = item / nblk, nb = item % nblk, k0 = 64 * kb, n0 = 32 * nb;
    const int sc = colmap(n0 + (lane & 31));
#pragma unroll 8
    for (int i = 0; i < 32; ++i) { const int kk = 2 * i + (lane >> 5); scr[kk * 33 + (lane & 31)] = sc >= 0 ? Wsrc[(size_t)(k0 + kk) * ldsrc + sc] : 0.f; }
    asm volatile("s_waitcnt lgkmcnt(0)" ::: "memory");
    const int c = lane & 7;
#pragma unroll
    for (int j = 0; j < 4; ++j) { const int n = (lane >> 3) + 8 * j; const LAS float* s = scr + (8 * c) * 33 + n;
        uint4 o; o.x = pk2(s[0 * 33], s[1 * 33]); o.y = pk2(s[2 * 33], s[3 * 33]); o.z = pk2(s[4 * 33], s[5 * 33]); o.w = pk2(s[6 * 33], s[7 * 33]);
        *(uint4*)(WT + (size_t)(n0 + n) * K + k0 + 8 * c) = o; }
    asm volatile("s_waitcnt lgkmcnt(0)" ::: "memory");
}
constexpr size_t WO_IN = 0;
constexpr size_t WO_BR = WO_IN + (size_t)7168 * 1024;
constexpr size_t WO_OUT = WO_BR + (size_t)4 * 1024 * 256;
constexpr size_t WO_W1 = WO_OUT + (size_t)1024 * 1024;
constexpr size_t WO_W2 = WO_W1 + (size_t)4096 * 1024;
constexpr size_t WO_WUP = WO_W2 + (size_t)4096 * 1024;
constexpr size_t WO_AUP = WO_WUP + 256 * 64;
constexpr size_t WO_GUP = WO_AUP + 256 * 64;
constexpr size_t WO_GLU = WO_GUP + 256 * 128;
constexpr size_t WO_LWT = WO_GLU + 256 * 256;
constexpr size_t WO_LAYER = WO_LWT + 2 * 16384;
__device__ __forceinline__ void convert_weights(const Params& p, int l, LAS float* scr, int gw, int ngw, int lane) {
    bf16_t* WB = (bf16_t*)(p.ws() + WS_W);
    constexpr int I_IN = (1024 / 64) * (7168 / 32), I_BR = (256 / 64) * (1024 / 32), I_OUT = (1024 / 64) * (1024 / 32), I_W1 = (1024 / 64) * (4096 / 32), I_W2 = (4096 / 64) * (1024 / 32);
    constexpr int I_UP = 8, I_GUP = 16, I_GLU = 4 * 8, I_LW = 16;
    constexpr int PER_LAYER = I_IN + 4 * I_BR + I_OUT + I_W1 + I_W2 + 2 * I_UP + I_GUP + I_GLU + I_LW;
    for (int it = gw; it < PER_LAYER; it += ngw) {
        int r = it;
        bf16_t* WL = WB;
        if (r < I_IN) { transpose_item(p.in[2] + (size_t)l * D * DIN, 1024, DIN, WL + WO_IN, 7168 / 32, scr, r, lane, [](int j) { return j < NMIX ? j : (j < 3072 ? -1 : j - 248); }); continue; } r -= I_IN;
        if (r < 4 * I_BR) { const int i = r / I_BR; transpose_item(p.in[35] + ((size_t)l * 4 + i) * W * D, 256, D, WL + WO_BR + (size_t)i * 1024 * 256, 1024 / 32, scr, r % I_BR, lane, [](int j) { return j; }); continue; } r -= 4 * I_BR;
        if (r < I_OUT) { transpose_item(p.in[36] + (size_t)l * D * D, 1024, D, WL + WO_OUT, 1024 / 32, scr, r, lane, [](int j) { return j; }); continue; } r -= I_OUT;
        if (r < I_W1) { transpose_item(p.in[38] + (size_t)l * D * DFF, 1024, DFF, WL + WO_W1, 4096 / 32, scr, r, lane, [](int j) { return j; }); continue; } r -= I_W1;
        if (r < I_W2) { transpose_item(p.in[39] + (size_t)l * DFF * D, 4096, D, WL + WO_W2, 1024 / 32, scr, r, lane, [](int j) { return j; }); continue; } r -= I_W2;
        if (r < I_UP) { transpose_item(p.in[26] + (size_t)l * 64 * W, 64, W, WL + WO_WUP, 8, scr, r, lane, [](int j) { return j; }); continue; } r -= I_UP;
        if (r < I_UP) { transpose_item(p.in[28] + (size_t)l * 64 * W, 64, W, WL + WO_AUP, 8, scr, r, lane, [](int j) { return j; }); continue; } r -= I_UP;
        if (r < I_GUP) { transpose_item(p.in[29] + (size_t)l * 128 * W, 128, W, WL + WO_GUP, 8, scr, r, lane, [](int j) { return j; }); continue; } r -= I_GUP;
        if (r < I_GLU) { transpose_item(p.in[22] + (size_t)l * W * W, 256, W, WL + WO_GLU, 8, scr, r, lane, [](int j) { return j; }); continue; } r -= I_GLU;
        { const int gt = r >> 3, nb = (r >> 1) & 3; transpose_item((gt ? p.in[11] : p.in[9]) + (size_t)l * 16384 + nb * 4096, 64, 64, WL + WO_LWT + (size_t)gt * 16384 + nb * 4096, 2, scr, r & 1, lane, [](int j) { return j; }); }
    }
}
#define BAR() do { asm volatile("s_waitcnt lgkmcnt(0)" ::: "memory"); __syncthreads(); } while (0)
typedef short bf16x8_t __attribute__((ext_vector_type(8)));
typedef float f32x4_t __attribute__((ext_vector_type(4)));
constexpr int PT = 68;
constexpr int MS = 64 * PT;
typedef __bf16 bf16x2v_t __attribute__((ext_vector_type(2)));
typedef float f32x2v_t __attribute__((ext_vector_type(2)));
__device__ __forceinline__ unsigned cvtpk(float lo, float hi) { return __builtin_bit_cast(unsigned, __builtin_convertvector((f32x2v_t){lo, hi}, bf16x2v_t)); }
typedef unsigned u32x4_t __attribute__((ext_vector_type(4)));
union U8 { bf16x8_t v; unsigned u[4]; uint4 q; u32x4_t x; };
__device__ __forceinline__ void split8(const float (&x)[8], bf16x8_t& hi, bf16x8_t& lo) {
    U8 H, L;
#pragma unroll
    for (int i = 0; i < 4; ++i) {
        const unsigned pk = cvtpk(x[2 * i], x[2 * i + 1]);
        H.u[i] = pk;
        const float f0 = __uint_as_float(pk << 16), f1 = __uint_as_float(pk & 0xffff0000u);
        L.u[i] = cvtpk(x[2 * i] - f0, x[2 * i + 1] - f1);
    }
    hi = H.v; lo = L.v;
}
__device__ __forceinline__ bf16x8_t hi8(const float (&x)[8]) {
    U8 H;
#pragma unroll
    for (int i = 0; i < 4; ++i) H.u[i] = cvtpk(x[2 * i], x[2 * i + 1]);
    return H.v;
}
template <int NSPLIT>
__device__ __forceinline__ f32x4_t mm_tile(const LAS float* A, const LAS float* Bt, int lane, f32x4_t acc) {
    const LAS float* ap = A + (lane & 15) * PT + 8 * (lane >> 4);
    const LAS float* bp = Bt + (lane & 15) * PT + 8 * (lane >> 4);
#pragma unroll
    for (int ks = 0; ks < 2; ++ks) {
        const f32x4_t a0 = *(const LAS f32x4_t*)(ap + 32 * ks), a1 = *(const LAS f32x4_t*)(ap + 32 * ks + 4);
        const f32x4_t b0 = *(const LAS f32x4_t*)(bp + 32 * ks), b1 = *(const LAS f32x4_t*)(bp + 32 * ks + 4);
        const float av[8] = {a0.x, a0.y, a0.z, a0.w, a1.x, a1.y, a1.z, a1.w};
        const float bv[8] = {b0.x, b0.y, b0.z, b0.w, b1.x, b1.y, b1.z, b1.w};
        if constexpr (NSPLIT == 3) {
            bf16x8_t ah, al, bh, bl; split8(av, ah, al); split8(bv, bh, bl);
            acc = __builtin_amdgcn_mfma_f32_16x16x32_bf16(ah, bh, acc, 0, 0, 0);
            acc = __builtin_amdgcn_mfma_f32_16x16x32_bf16(ah, bl, acc, 0, 0, 0);
            acc = __builtin_amdgcn_mfma_f32_16x16x32_bf16(al, bh, acc, 0, 0, 0);
        } else {
            acc = __builtin_amdgcn_mfma_f32_16x16x32_bf16(hi8(av), hi8(bv), acc, 0, 0, 0);
        }
    }
    return acc;
}
__device__ __forceinline__ int opq_tid() { int t = threadIdx.x; asm volatile("" : "+v"(t)); return t; }
__device__ __forceinline__ void tri_inverse_wave(LAS float* L, int lane) {
    asm volatile("" : "+v"(lane));
    asm volatile("" : "+v"(L));
    const float lf = (float)lane;
    float x[64];
#pragma unroll
    for (int i = 0; i < 64; ++i) {
        float s0 = 0.f, s1 = 0.f, s2 = 0.f, s3 = 0.f;
#pragma unroll
        for (int g4 = 0; g4 * 4 < i; ++g4) {
            const f32x4_t l = *(const LAS f32x4_t*)(L + i * PT + 4 * g4);
            s0 = fmaf(l.x, x[4 * g4], s0);
            if (4 * g4 + 1 < i) s1 = fmaf(l.y, x[4 * g4 + 1], s1);
            if (4 * g4 + 2 < i) s2 = fmaf(l.z, x[4 * g4 + 2], s2);
            if (4 * g4 + 3 < i) s3 = fmaf(l.w, x[4 * g4 + 3], s3);
        }
        x[i] = fmaxf(1.f - fabsf(lf - (float)i), 0.f) - ((s0 + s1) + (s2 + s3));
        L[i * PT + lane] = x[i];
        if ((i & 3) == 3) __builtin_amdgcn_sched_barrier(0);
    }
}
__device__ __forceinline__ float wave_incl_scan(float v, int lane) {
#pragma unroll
    for (int o = 1; o < 64; o <<= 1) { const float u = __shfl_up(v, o); if (lane >= o) v += u; }
    return v;
}

__device__ __forceinline__ void unpack8(const uint4 u, float (&o)[8]) {
    const unsigned w[4] = {u.x, u.y, u.z, u.w};
#pragma unroll
    for (int i = 0; i < 4; ++i) { o[2 * i] = __uint_as_float(w[i] << 16); o[2 * i + 1] = __uint_as_float(w[i] & 0xffff0000u); }
}
__device__ __forceinline__ uint4 pack8(const float (&x)[8]) { return make_uint4(cvtpk(x[0], x[1]), cvtpk(x[2], x[3]), cvtpk(x[4], x[5]), cvtpk(x[6], x[7])); }
typedef unsigned short LAS lds_bf16;
constexpr int MIX_LDS_C = 8 * MS * 4 + 1024;
__device__ __forceinline__ void merge_phase(const bf16_t* __restrict__ Yb, const bf16_t* __restrict__ WbT, const bf16_t* __restrict__ G, bf16_t* __restrict__ MG, LAS unsigned char* lds) {
    const int tid = opq_tid(), w = __builtin_amdgcn_readfirstlane(tid >> 6), lane = tid & 63, q4 = lane >> 4, cc = lane & 15;
    const int wr = w >> 2, wc = w & 3;
    constexpr int PA = 144;
    constexpr int ABUF = 256 * PA, BBUF = 128 * PA, BUF = ABUF + BBUF;
    const int bid = blockIdx.x, G_ = gridDim.x;
    const int arow = tid >> 1, ahalf = tid & 1;
    const int brow = tid >> 2, bq = tid & 3;
    for (int it = 0; ; ++it) {
        const int U = it * G_ + bid;
        if (U >= 512) break;
        const int Lx = (G_ == 256) ? ((bid & 7) * 64 + it * 32 + (bid >> 3)) : U;
        const int pm = Lx >> 3, pn = Lx & 7;
        const bf16_t* Abase = Yb + (size_t)(pm * 256 + arow) * 1024 + ahalf * 32;
        const bf16_t* Bbase = WbT + (size_t)(pn * 128 + brow) * 256 + bq * 16;
        f32x4_t mg[8][2];
#pragma unroll
        for (int m = 0; m < 8; ++m)
#pragma unroll
            for (int n = 0; n < 2; ++n) mg[m][n] = (f32x4_t){0.f, 0.f, 0.f, 0.f};
        uint4 sa[4], sb[2];
#define MERGE_LOAD(s_) do { const int br_ = (s_) >> 2, kq_ = (s_) & 3; const bf16_t* ap_ = Abase + br_ * 256 + kq_ * 64; const bf16_t* bp_ = Bbase + (size_t)br_ * 1024 * 256 + kq_ * 64; \
            _Pragma("unroll") for (int j = 0; j < 4; ++j) sa[j] = *(const uint4*)(ap_ + 8 * j); \
            _Pragma("unroll") for (int j = 0; j < 2; ++j) sb[j] = *(const uint4*)(bp_ + 8 * j); } while (0)
#define MERGE_STORE(buf_) do { LAS unsigned char* ab_ = lds + (buf_) * BUF + arow * PA + ahalf * 64; LAS unsigned char* bb_ = lds + (buf_) * BUF + ABUF + brow * PA + bq * 32; \
            _Pragma("unroll") for (int j = 0; j < 4; ++j) *(LAS u32x4_t*)(ab_ + 16 * j) = (u32x4_t){sa[j].x, sa[j].y, sa[j].z, sa[j].w}; \
            _Pragma("unroll") for (int j = 0; j < 2; ++j) *(LAS u32x4_t*)(bb_ + 16 * j) = (u32x4_t){sb[j].x, sb[j].y, sb[j].z, sb[j].w}; } while (0)
        MERGE_LOAD(0);
        MERGE_STORE(0);
        BAR();
        f32x4_t acc[8][2];
#pragma unroll 1
        for (int s = 0; s < 16; ++s) {
            const int buf = s & 1;
            if ((s & 3) == 0) {
#pragma unroll
                for (int m = 0; m < 8; ++m)
#pragma unroll
                    for (int n = 0; n < 2; ++n) acc[m][n] = (f32x4_t){0.f, 0.f, 0.f, 0.f};
            }
            if (s + 1 < 16) MERGE_LOAD(s + 1);
            {
                const LAS unsigned char* ab = lds + buf * BUF + (wr * 128 + cc) * PA + 16 * q4;
                const LAS unsigned char* bb = lds + buf * BUF + ABUF + (wc * 32 + cc) * PA + 16 * q4;
#pragma unroll
                for (int ks = 0; ks < 2; ++ks) {
                    U8 bf[2];
#pragma unroll
                    for (int n = 0; n < 2; ++n) bf[n].x = *(const LAS u32x4_t*)(bb + n * 16 * PA + ks * 64);
#pragma unroll
                    for (int m = 0; m < 8; ++m) {
                        U8 af; af.x = *(const LAS u32x4_t*)(ab + m * 16 * PA + ks * 64);
#pragma unroll
                        for (int n = 0; n < 2; ++n) acc[m][n] = __builtin_amdgcn_mfma_f32_16x16x32_bf16(bf[n].v, af.v, acc[m][n], 0, 0, 0);
                    }
                }
            }
            if ((s & 3) == 3) {
                const int br = s >> 2;
                const bf16_t* gp = G + (size_t)(pm * 256 + wr * 128 + cc) * 4096 + br * 1024 + pn * 128 + wc * 32 + 4 * q4;
#pragma unroll
                for (int m = 0; m < 8; ++m)
#pragma unroll
                    for (int n = 0; n < 2; ++n) {
                        const uint2 g2 = *(const uint2*)(gp + (size_t)m * 16 * 4096 + n * 16);
                        mg[m][n][0] = fmaf(__uint_as_float(g2.x << 16), acc[m][n][0], mg[m][n][0]);
                        mg[m][n][1] = fmaf(__uint_as_float(g2.x & 0xffff0000u), acc[m][n][1], mg[m][n][1]);
                        mg[m][n][2] = fmaf(__uint_as_float(g2.y << 16), acc[m][n][2], mg[m][n][2]);
                        mg[m][n][3] = fmaf(__uint_as_float(g2.y & 0xffff0000u), acc[m][n][3], mg[m][n][3]);
                    }
            }
            if (s + 1 < 16) MERGE_STORE(buf ^ 1);
            BAR();
        }
        {
            bf16_t* op = MG + (size_t)(pm * 256 + wr * 128 + cc) * 1024 + pn * 128 + wc * 32 + 4 * q4;
#pragma unroll
            for (int m = 0; m < 8; ++m)
#pragma unroll
                for (int n = 0; n < 2; ++n) *(uint2*)(op + (size_t)m * 16 * 1024 + n * 16) = make_uint2(cvtpk(mg[m][n][0], mg[m][n][1]), cvtpk(mg[m][n][2], mg[m][n][3]));
        }
#undef MERGE_LOAD
#undef MERGE_STORE
    }
}

constexpr int PB = 72;
constexpr int PLBYTES = 64 * PB * 2;
typedef unsigned u32x2_t __attribute__((ext_vector_type(2)));
__device__ __forceinline__ lds_bf16* plane(LAS unsigned char* lds, int i) { return (lds_bf16*)(lds + i * PLBYTES); }
__device__ __forceinline__ void hilo2(float a, float b, unsigned& h, unsigned& l) { h = cvtpk(a, b); l = cvtpk(a - __uint_as_float(h << 16), b - __uint_as_float(h & 0xffff0000u)); }
__device__ __forceinline__ unsigned short bf_hi(float v) { return (unsigned short)(cvtpk(v, 0.f) & 0xffffu); }
template <bool LO>
__device__ __forceinline__ void put8(lds_bf16* Ph, lds_bf16* Pl, int r, int c0, const float (&x)[8]) {
    unsigned h[4], l[4];
#pragma unroll
    for (int i = 0; i < 4; ++i) hilo2(x[2 * i], x[2 * i + 1], h[i], l[i]);
    *(LAS u32x4_t*)(Ph + r * PB + c0) = (u32x4_t){h[0], h[1], h[2], h[3]};
    if (LO) *(LAS u32x4_t*)(Pl + r * PB + c0) = (u32x4_t){l[0], l[1], l[2], l[3]};
}
template <bool LO>
__device__ __forceinline__ void put8T(lds_bf16* Ph, lds_bf16* Pl, int r, int c0, const float (&x)[8]) {
#pragma unroll
    for (int i = 0; i < 4; ++i) {
        unsigned h, l; hilo2(x[2 * i], x[2 * i + 1], h, l);
        Ph[(c0 + 2 * i) * PB + r] = (unsigned short)(h & 0xffffu); Ph[(c0 + 2 * i + 1) * PB + r] = (unsigned short)(h >> 16);
        if (LO) { Pl[(c0 + 2 * i) * PB + r] = (unsigned short)(l & 0xffffu); Pl[(c0 + 2 * i + 1) * PB + r] = (unsigned short)(l >> 16); }
    }
}
__device__ __forceinline__ bf16x8_t frag(const lds_bf16* P, int row, int k) { U8 u; u.x = *(const LAS u32x4_t*)(P + row * PB + k); return u.v; }
template <bool AL, bool BL>
__device__ __forceinline__ f32x4_t mmp(const lds_bf16* Ah, const lds_bf16* Al, const lds_bf16* Bh, const lds_bf16* Bl, int ar0, int br0, int lane, f32x4_t acc) {
    const int r = lane & 15, k0 = 8 * (lane >> 4);
#pragma unroll
    for (int ks = 0; ks < 2; ++ks) {
        const bf16x8_t ah = frag(Ah, ar0 + r, 32 * ks + k0), bh = frag(Bh, br0 + r, 32 * ks + k0);
        acc = __builtin_amdgcn_mfma_f32_16x16x32_bf16(ah, bh, acc, 0, 0, 0);
        if (AL) acc = __builtin_amdgcn_mfma_f32_16x16x32_bf16(frag(Al, ar0 + r, 32 * ks + k0), bh, acc, 0, 0, 0);
        if (BL) acc = __builtin_amdgcn_mfma_f32_16x16x32_bf16(ah, frag(Bl, br0 + r, 32 * ks + k0), acc, 0, 0, 0);
    }
    return acc;
}
template <bool LO>
__device__ __forceinline__ void st_tile_T(lds_bf16* Ph, lds_bf16* Pl, int i0, int j0, int lane, const f32x4_t a) {
    unsigned h0, l0, h1, l1; hilo2(a[0], a[1], h0, l0); hilo2(a[2], a[3], h1, l1);
    const int o = (j0 + (lane & 15)) * PB + i0 + 4 * (lane >> 4);
    *(LAS u32x2_t*)(Ph + o) = (u32x2_t){h0, h1};
    if (LO) *(LAS u32x2_t*)(Pl + o) = (u32x2_t){l0, l1};
}
template <bool LO>
__device__ __forceinline__ void st_tile_R(lds_bf16* Ph, lds_bf16* Pl, int i0, int j0, int lane, const f32x4_t a) {
    unsigned h0, l0, h1, l1; hilo2(a[0], a[1], h0, l0); hilo2(a[2], a[3], h1, l1);
    const int o = (i0 + 4 * (lane >> 4)) * PB + j0 + (lane & 15);
    Ph[o] = (unsigned short)(h0 & 0xffffu); Ph[o + PB] = (unsigned short)(h0 >> 16); Ph[o + 2 * PB] = (unsigned short)(h1 & 0xffffu); Ph[o + 3 * PB] = (unsigned short)(h1 >> 16);
    if (LO) { Pl[o] = (unsigned short)(l0 & 0xffffu); Pl[o + PB] = (unsigned short)(l0 >> 16); Pl[o + 2 * PB] = (unsigned short)(l1 & 0xffffu); Pl[o + 3 * PB] = (unsigned short)(l1 >> 16); }
}
constexpr int LM_OFF = 13 * PLBYTES;
constexpr int VEC_OFF = LM_OFF + MS * 4;
static_assert(VEC_OFF + 1024 <= MIX_LDS_C, "plane LDS map");

struct GdnBufs { bf16_t *GQ, *GK, *GV; float *GB, *GC; uint4* MF; float* NF; float* HT; bf16_t* TG; };
__device__ __forceinline__ void gdn_prep_chunk(const bf16_t* __restrict__ PM, int n, const GdnBufs& B, const Params& p, int l, LAS float* lds) {
    const int tid = opq_tid(), w = tid >> 6, lane = tid & 63;
    const float* conv_w = p.in[3] + l * 4 * 768;
    const int t0 = n * 64;
    float wq[4][4], wk[4][4], wv[4][4];
#pragma unroll
    for (int t = 0; t < 4; ++t)
#pragma unroll
        for (int j = 0; j < 4; ++j) { wq[t][j] = conv_w[t * 768 + 4 * lane + j]; wk[t][j] = conv_w[t * 768 + 256 + 4 * lane + j]; wv[t][j] = conv_w[t * 768 + 512 + 4 * lane + j]; }
    float hq[3][4], hk[3][4], hv[3][4];
    auto ld4 = [&](int t, int col, float (&o)[4]) {
        if (t < 0) { o[0] = o[1] = o[2] = o[3] = 0.f; return; }
        const uint2 u = *(const uint2*)(PM + (size_t)t * PMLD + col);
        o[0] = __uint_as_float(u.x << 16); o[1] = __uint_as_float(u.x & 0xffff0000u); o[2] = __uint_as_float(u.y << 16); o[3] = __uint_as_float(u.y & 0xffff0000u);
    };
    const int tw = t0 + 8 * w;
#pragma unroll
    for (int i = 0; i < 3; ++i) { ld4(tw - 3 + i, 4 * lane, hq[i]); ld4(tw - 3 + i, 256 + 4 * lane, hk[i]); ld4(tw - 3 + i, 512 + 4 * lane, hv[i]); }
#pragma unroll
    for (int i = 0; i < 8; ++i) {
        const int t = tw + i;
        float pq[4], pk[4], pv[4], q[4], k[4], v[4];
        ld4(t, 4 * lane, pq); ld4(t, 256 + 4 * lane, pk); ld4(t, 512 + 4 * lane, pv);
        float sq = 0.f, sk = 0.f;
#pragma unroll
        for (int j = 0; j < 4; ++j) {
            q[j] = siluf_(wq[0][j] * hq[0][j] + wq[1][j] * hq[1][j] + wq[2][j] * hq[2][j] + wq[3][j] * pq[j]);
            k[j] = siluf_(wk[0][j] * hk[0][j] + wk[1][j] * hk[1][j] + wk[2][j] * hk[2][j] + wk[3][j] * pk[j]);
            v[j] = siluf_(wv[0][j] * hv[0][j] + wv[1][j] * hv[1][j] + wv[2][j] * hv[2][j] + wv[3][j] * pv[j]);
            hq[0][j] = hq[1][j]; hq[1][j] = hq[2][j]; hq[2][j] = pq[j];
            hk[0][j] = hk[1][j]; hk[1][j] = hk[2][j]; hk[2][j] = pk[j];
            hv[0][j] = hv[1][j]; hv[1][j] = hv[2][j]; hv[2][j] = pv[j];
            sq = fmaf(q[j], q[j], sq); sk = fmaf(k[j], k[j], sk);
        }
#pragma unroll
        for (int o = 1; o < 16; o <<= 1) { sq += __shfl_xor(sq, o); sk += __shfl_xor(sk, o); }
        const float rq = rsqrtf(sq + 1e-6f) * 0.125f, rk = rsqrtf(sk + 1e-6f);
        uint2 oq, ok, ov;
        oq.x = cvtpk(q[0] * rq, q[1] * rq); oq.y = cvtpk(q[2] * rq, q[3] * rq);
        ok.x = cvtpk(k[0] * rk, k[1] * rk); ok.y = cvtpk(k[2] * rk, k[3] * rk);
        ov.x = cvtpk(v[0], v[1]); ov.y = cvtpk(v[2], v[3]);
        *(uint2*)(B.GQ + (size_t)t * 256 + 4 * lane) = oq;
        *(uint2*)(B.GK + (size_t)t * 256 + 4 * lane) = ok;
        *(uint2*)(B.GV + (size_t)t * 256 + 4 * lane) = ov;
    }
    if (tid < 256) {
        const int t = tid >> 2, h = tid & 3;
        const bf16_t* row = PM + (size_t)(t0 + t) * PMLD;
        B.GB[(size_t)(t0 + t) * 4 + h] = sigmoidf_(bf2f(row[1024 + h]));
        const float g = -__expf(p.in[4][l * 4 + h]) * softplusf_(bf2f(row[1028 + h]) + p.in[5][l * 4 + h]);
        lds[h * 64 + t] = g;
    }
    BAR();
    if (w == 0) {
#pragma unroll
        for (int h = 0; h < 4; ++h) B.GC[(size_t)(t0 + lane) * 4 + h] = wave_incl_scan(lds[h * 64 + lane], lane);
    }
    BAR();
}

__device__ __forceinline__ float dpp_xor1(float v) { return __int_as_float(__builtin_amdgcn_update_dpp(0, __float_as_int(v), 0xB1, 0xF, 0xF, false)); }
__device__ __forceinline__ float dpp_xor2(float v) { return __int_as_float(__builtin_amdgcn_update_dpp(0, __float_as_int(v), 0x4E, 0xF, 0xF, false)); }
__device__ __forceinline__ void tri_inverse_4w(const LAS float* Lp, lds_bf16* Th, lds_bf16* Tl, int wq, int lane) {
    asm volatile("" : "+v"(lane));
    const int g = lane & 3, j = 16 * wq + (lane >> 2);
    const LAS float* base = Lp + g * 16; asm volatile("" : "+v"(base));
    const float jf = (float)j;
    float x[16];
#pragma unroll
    for (int m = 0; m < 16; ++m) x[m] = 0.f;
    f32x4_t cur[4], nxt[4];
#pragma unroll
    for (int q = 0; q < 4; ++q) cur[q] = (f32x4_t){0.f, 0.f, 0.f, 0.f};
#pragma unroll
    for (int i = 0; i < 64; ++i) {
        if (i + 1 < 64) {
#pragma unroll
            for (int q = 0; q < 4; ++q) if (16 * q < i + 1) nxt[q] = *(const LAS f32x4_t*)(base + (i + 1) * PT + 4 * q);
        }
        float s0 = 0.f, s1 = 0.f;
#pragma unroll
        for (int q = 0; q < 4; ++q) if (16 * q < i) {
            s0 = fmaf(cur[q].x, x[4 * q], s0); if (16 * q + 4 < i) s1 = fmaf(cur[q].y, x[4 * q + 1], s1);
            if (16 * q + 8 < i) s0 = fmaf(cur[q].z, x[4 * q + 2], s0); if (16 * q + 12 < i) s1 = fmaf(cur[q].w, x[4 * q + 3], s1);
        }
        float t = s0 + s1;
        t += dpp_xor1(t); t += dpp_xor2(t);
        const float xi = fmaxf(1.f - fabsf(jf - (float)i), 0.f) - t;
        if (g == (i & 3)) x[i >> 2] = xi;
        unsigned hh, ll; hilo2(xi, xi, hh, ll);
        if (g == 0) Th[i * PB + j] = (unsigned short)(hh & 0xffffu);
        if (g == 1) Tl[i * PB + j] = (unsigned short)(ll & 0xffffu);
#pragma unroll
        for (int q = 0; q < 4; ++q) cur[q] = nxt[q];
    }
}
__device__ __forceinline__ void gdn_g1_unit(int h, int n, const GdnBufs& B, bf16_t* __restrict__ Y, LAS unsigned char* lds) {
    const int tid = opq_tid(), w = tid >> 6, lane = tid & 63, q4 = lane >> 4, cc = lane & 15;
    lds_bf16 *Krh = plane(lds, 0), *Krl = plane(lds, 1), *KdTh = plane(lds, 2), *KdTl = plane(lds, 3), *KbTh = plane(lds, 4), *KbTl = plane(lds, 5);
    lds_bf16 *VbTh = plane(lds, 6), *VbTl = plane(lds, 7), *Th = plane(lds, 8), *Tl = plane(lds, 9), *WmTh = plane(lds, 10), *WmTl = plane(lds, 11);
    lds_bf16 *U0Th = Krh, *U0Tl = Krl;
    LAS float* Lm = (LAS float*)(lds + LM_OFF); LAS float* sb = (LAS float*)(lds + VEC_OFF); LAS float* sg = sb + 64;
    const int t0 = n * 64, u = h * 256 + n;
    const int c = tid >> 3, d0 = (tid & 7) * 8;
    {
        const float beta = B.GB[(size_t)(t0 + c) * 4 + h], gc = B.GC[(size_t)(t0 + c) * 4 + h], gl = B.GC[(size_t)(t0 + 63) * 4 + h];
        float kf[8], vf[8], x1[8], x2[8], x3[8];
        unpack8(*(const uint4*)(B.GK + (size_t)(t0 + c) * 256 + h * 64 + d0), kf);
        unpack8(*(const uint4*)(B.GV + (size_t)(t0 + c) * 256 + h * 64 + d0), vf);
        const float e1 = __expf(gl - gc), e2 = beta * __expf(gc);
#pragma unroll
        for (int i = 0; i < 8; ++i) { x1[i] = kf[i] * e1; x2[i] = kf[i] * e2; x3[i] = beta * vf[i]; }
        put8<true>(Krh, Krl, c, d0, kf); put8T<true>(KdTh, KdTl, c, d0, x1); put8T<true>(KbTh, KbTl, c, d0, x2); put8T<true>(VbTh, VbTl, c, d0, x3);
        if ((tid & 7) == 0) { sb[c] = beta; sg[c] = gc; }
    }
    BAR();
    const int ti = w >> 1, tj0 = (w & 1) * 2;
    const f32x4_t zero4 = {0.f, 0.f, 0.f, 0.f};
#pragma unroll
    for (int tt = 0; tt < 2; ++tt) {
        const int tj = tj0 + tt;
        const int j = 16 * tj + cc, jp = (j & 3) * 16 + (j >> 2);
        f32x4_t lv = zero4;
        if (tj <= ti) {
            const f32x4_t a = mmp<true, true>(Krh, Krl, Krh, Krl, 16 * ti, 16 * tj, lane, zero4);
            const float gj = sg[j];
#pragma unroll
            for (int r = 0; r < 4; ++r) { const int i = 16 * ti + 4 * q4 + r; lv[r] = (i > j) ? sb[i] * a[r] * __expf(sg[i] - gj) : 0.f; }
        }
#pragma unroll
        for (int r = 0; r < 4; ++r) Lm[(16 * ti + 4 * q4 + r) * PT + jp] = lv[r];
    }
    BAR();
    if (w < 4) tri_inverse_4w(Lm, Th, Tl, w, lane);
    BAR();
    { const u32x4_t t4 = *(const LAS u32x4_t*)(Th + c * PB + d0); *(uint4*)(B.TG + (size_t)u * 4096 + c * 64 + d0) = make_uint4(t4.x, t4.y, t4.z, t4.w);
      const u32x4_t t5 = *(const LAS u32x4_t*)(Tl + c * PB + d0); *(uint4*)(Y + (size_t)(t0 + c) * D + h * 64 + d0) = make_uint4(t5.x, t5.y, t5.z, t5.w); }
#pragma unroll
    for (int tt = 0; tt < 2; ++tt) {
        const int tj = tj0 + tt;
        st_tile_T<true>(U0Th, U0Tl, 16 * ti, 16 * tj, lane, mmp<true, true>(Th, Tl, VbTh, VbTl, 16 * ti, 16 * tj, lane, zero4));
        st_tile_T<true>(WmTh, WmTl, 16 * ti, 16 * tj, lane, mmp<true, true>(Th, Tl, KbTh, KbTl, 16 * ti, 16 * tj, lane, zero4));
    }
    BAR();
    {
        const float egl = __expf(B.GC[(size_t)(t0 + 63) * 4 + h]);
#pragma unroll
        for (int tt = 0; tt < 2; ++tt) {
            const int tj = tj0 + tt;
            const f32x4_t a = mmp<true, true>(KdTh, KdTl, WmTh, WmTl, 16 * ti, 16 * tj, lane, zero4);
#pragma unroll
            for (int r = 0; r < 4; ++r) { const int ar = 16 * ti + 4 * q4 + r, bc = 16 * tj + cc; Lm[ar * PT + bc] = (ar == bc ? egl : 0.f) - a[r]; }
            const f32x4_t nn = mmp<true, true>(KdTh, KdTl, U0Th, U0Tl, 16 * ti, 16 * tj, lane, zero4);
            *(float4*)(B.NF + (size_t)u * 4096 + (tj * 64 + lane) * 16 + ti * 4) = make_float4(nn[0], nn[1], nn[2], nn[3]);
        }
    }
    BAR();
    {
        const int combo = tid >> 6, mt = combo >> 1, s = combo & 1, i = lane & 15, qq = lane >> 4;
        const f32x4_t x0 = *(const LAS f32x4_t*)(Lm + (16 * mt + i) * PT + 32 * s + 4 * qq);
        const f32x4_t x1 = *(const LAS f32x4_t*)(Lm + (16 * mt + i) * PT + 32 * s + 16 + 4 * qq);
        const float xv[8] = {x0.x, x0.y, x0.z, x0.w, x1.x, x1.y, x1.z, x1.w};
        U8 H, L; split8(xv, H.v, L.v);
        uint4* mf = B.MF + (size_t)u * 1024 + (size_t)(combo * 2) * 64 + lane;
        mf[0] = H.q; mf[64] = L.q;
    }
    BAR();
}

constexpr int CH_SLOT = 20480, CH_RING = 6;
__device__ __forceinline__ void chain_wave(float* __restrict__ HT, int cb, int nchunk, int lane, LAS unsigned char* ring, volatile LAS unsigned* flags  ) {
    const int q4 = lane >> 4, cc = lane & 15;
    f32x4_t H[4];
#pragma unroll
    for (int m = 0; m < 4; ++m) H[m] = (f32x4_t){0.f, 0.f, 0.f, 0.f};
    for (int ch = 0; ch < nchunk; ++ch) {
        const int slot = ch % CH_RING;
        float* ht = HT + (size_t)ch * 4096 + (16 * cb + cc) * 64 + 4 * q4;
#pragma unroll
        for (int m = 0; m < 4; ++m) *(float4*)(ht + 16 * m) = make_float4(H[m][0], H[m][1], H[m][2], H[m][3]);
        bf16x8_t bh[2], bl[2];
#pragma unroll
        for (int s = 0; s < 2; ++s) {
            const float xv[8] = {H[2 * s][0], H[2 * s][1], H[2 * s][2], H[2 * s][3], H[2 * s + 1][0], H[2 * s + 1][1], H[2 * s + 1][2], H[2 * s + 1][3]};
            split8(xv, bh[s], bl[s]);
        }
        while (flags[slot] != (unsigned)(ch + 1)) __builtin_amdgcn_s_sleep(1);
        asm volatile("" ::: "memory");
        const LAS unsigned char* sp = ring + slot * CH_SLOT + lane * 16;
        U8 mf[16]; f32x4_t nf[4];
#pragma unroll
        for (int i = 0; i < 16; ++i) mf[i].x = *(const LAS u32x4_t*)(sp + i * 1024);
#pragma unroll
        for (int m = 0; m < 4; ++m) nf[m] = *(const LAS f32x4_t*)(sp + (16 + m) * 1024);
        asm volatile("s_waitcnt lgkmcnt(0)" ::: "memory");
        if (lane == 0) flags[8] = (unsigned)(ch + 1);
#pragma unroll
        for (int m = 0; m < 4; ++m) {
            f32x4_t acc = nf[m];
#pragma unroll
            for (int s = 0; s < 2; ++s) {
                acc = __builtin_amdgcn_mfma_f32_16x16x32_bf16(mf[(m * 2 + s) * 2].v, bh[s], acc, 0, 0, 0);
                acc = __builtin_amdgcn_mfma_f32_16x16x32_bf16(mf[(m * 2 + s) * 2].v, bl[s], acc, 0, 0, 0);
                acc = __builtin_amdgcn_mfma_f32_16x16x32_bf16(mf[(m * 2 + s) * 2 + 1].v, bh[s], acc, 0, 0, 0);
            }
            H[m] = acc;
        }
    }
}
__device__ __forceinline__ void chain_loader(const uint4* __restrict__ MF, const float* __restrict__ NF, int cb, int nchunk, int lane, int lw, LAS unsigned char* ring, volatile LAS unsigned* flags) {
    for (int ch = lw; ch < nchunk; ch += 7) {
        uint4 m[16]; float4 nn[4];
#pragma unroll
        for (int i = 0; i < 16; ++i) m[i] = MF[(size_t)ch * 1024 + (size_t)i * 64 + lane];
#pragma unroll
        for (int k = 0; k < 4; ++k) nn[k] = *(const float4*)(NF + (size_t)ch * 4096 + (cb * 64 + lane) * 16 + k * 4);
        while ((int)flags[8] + CH_RING <= ch) __builtin_amdgcn_s_sleep(2);
        asm volatile("" ::: "memory");
        LAS unsigned char* sp = ring + (ch % CH_RING) * CH_SLOT + lane * 16;
#pragma unroll
        for (int i = 0; i < 16; ++i) *(LAS u32x4_t*)(sp + i * 1024) = (u32x4_t){m[i].x, m[i].y, m[i].z, m[i].w};
#pragma unroll
        for (int k = 0; k < 4; ++k) *(LAS f32x4_t*)(sp + (16 + k) * 1024) = (f32x4_t){nn[k].x, nn[k].y, nn[k].z, nn[k].w};
        asm volatile("s_waitcnt lgkmcnt(0)" ::: "memory");
        if (lane == 0) flags[ch % CH_RING] = (unsigned)(ch + 1);
    }
}

__device__ __forceinline__ void gdn_g3_unit(int h, int n, const GdnBufs& B, const bf16_t* __restrict__ PM, bf16_t* __restrict__ Y, const float* __restrict__ norm_g, LAS unsigned char* lds) {
    const int tid = opq_tid(), w = tid >> 6, lane = tid & 63, q4 = lane >> 4, cc = lane & 15;
    lds_bf16 *Qr = plane(lds, 0), *Qd = plane(lds, 1), *Kr = plane(lds, 2), *KbT = plane(lds, 3), *VbT = plane(lds, 4), *Tp = plane(lds, 5);
    lds_bf16 *At = plane(lds, 6), *Wm = plane(lds, 7), *HTh = plane(lds, 8), *HTl = plane(lds, 9), *VnT = plane(lds, 10), *Tq = plane(lds, 11);
    LAS float* Os = (LAS float*)(lds + LM_OFF); LAS float* sb = (LAS float*)(lds + VEC_OFF); LAS float* sg = sb + 64;
    const int t0 = n * 64, u = h * 256 + n;
    const int c = tid >> 3, d0 = (tid & 7) * 8;
    {
        const float beta = B.GB[(size_t)(t0 + c) * 4 + h], gc = B.GC[(size_t)(t0 + c) * 4 + h];
        float qf[8], kf[8], vf[8], x1[8], x2[8], x3[8];
        unpack8(*(const uint4*)(B.GQ + (size_t)(t0 + c) * 256 + h * 64 + d0), qf);
        unpack8(*(const uint4*)(B.GK + (size_t)(t0 + c) * 256 + h * 64 + d0), kf);
        unpack8(*(const uint4*)(B.GV + (size_t)(t0 + c) * 256 + h * 64 + d0), vf);
        const uint4 t8 = *(const uint4*)(B.TG + (size_t)u * 4096 + c * 64 + d0);
        const uint4 t9 = *(const uint4*)(Y + (size_t)(t0 + c) * D + h * 64 + d0);
        const float* ht = B.HT + (size_t)u * 4096 + c * 64 + d0;
        const float4 h0 = *(const float4*)ht, h1 = *(const float4*)(ht + 4);
        const float eg = __expf(gc), e2 = beta * eg;
#pragma unroll
        for (int i = 0; i < 8; ++i) { x1[i] = qf[i] * eg; x2[i] = kf[i] * e2; x3[i] = beta * vf[i]; }
        put8<false>(Qr, Qr, c, d0, qf); put8<false>(Qd, Qd, c, d0, x1); put8<false>(Kr, Kr, c, d0, kf);
        put8T<false>(KbT, KbT, c, d0, x2); put8T<false>(VbT, VbT, c, d0, x3);
        *(LAS u32x4_t*)(Tp + c * PB + d0) = (u32x4_t){t8.x, t8.y, t8.z, t8.w};
        *(LAS u32x4_t*)(Tq + c * PB + d0) = (u32x4_t){t9.x, t9.y, t9.z, t9.w};
        const float hv[8] = {h0.x, h0.y, h0.z, h0.w, h1.x, h1.y, h1.z, h1.w};
        put8<true>(HTh, HTl, c, d0, hv);
        if ((tid & 7) == 0) { sb[c] = beta; sg[c] = gc; }
    }
    BAR();
    const int ti = w >> 1, tj0 = (w & 1) * 2;
    const f32x4_t zero4 = {0.f, 0.f, 0.f, 0.f};
    f32x4_t u0[2];
#pragma unroll
    for (int tt = 0; tt < 2; ++tt) {
        const int tj = tj0 + tt;
        f32x4_t at = zero4;
        if (tj <= ti) {
            const f32x4_t s = mmp<false, false>(Qr, Qr, Kr, Kr, 16 * ti, 16 * tj, lane, zero4);
            const int j = 16 * tj + cc; const float gj = sg[j];
#pragma unroll
            for (int r = 0; r < 4; ++r) { const int i = 16 * ti + 4 * q4 + r; at[r] = (i >= j) ? s[r] * __expf(fminf(sg[i] - gj, 0.f)) : 0.f; }
        }
        st_tile_R<false>(At, At, 16 * ti, 16 * tj, lane, at);
        u0[tt] = mmp<true, false>(Tp, Tq, VbT, VbT, 16 * ti, 16 * tj, lane, zero4);
        st_tile_R<false>(Wm, Wm, 16 * ti, 16 * tj, lane, mmp<true, false>(Tp, Tq, KbT, KbT, 16 * ti, 16 * tj, lane, zero4));
    }
    BAR();
    f32x4_t o[2];
#pragma unroll
    for (int tt = 0; tt < 2; ++tt) {
        const int tj = tj0 + tt;
        const f32x4_t wh = mmp<false, true>(Wm, Wm, HTh, HTl, 16 * ti, 16 * tj, lane, zero4);
        o[tt] = mmp<false, true>(Qd, Qd, HTh, HTl, 16 * ti, 16 * tj, lane, zero4);
        st_tile_T<false>(VnT, VnT, 16 * ti, 16 * tj, lane, u0[tt] - wh);
    }
    BAR();
#pragma unroll
    for (int tt = 0; tt < 2; ++tt) {
        const int tj = tj0 + tt;
        o[tt] = mmp<false, false>(At, At, VnT, VnT, 16 * ti, 16 * tj, lane, o[tt]);
#pragma unroll
        for (int r = 0; r < 4; ++r) Os[(16 * ti + 4 * q4 + r) * PT + 16 * tj + cc] = o[tt][r];
    }
    BAR();
    {
        const f32x4_t x0 = *(const LAS f32x4_t*)(Os + c * PT + d0), x1 = *(const LAS f32x4_t*)(Os + c * PT + d0 + 4);
        float xv[8] = {x0.x, x0.y, x0.z, x0.w, x1.x, x1.y, x1.z, x1.w};
        float ss = 0.f;
#pragma unroll
        for (int i = 0; i < 8; ++i) ss = fmaf(xv[i], xv[i], ss);
        ss += __shfl_xor(ss, 1); ss += __shfl_xor(ss, 2); ss += __shfl_xor(ss, 4);
        const float rs = rsqrtf(ss * (1.f / 64.f) + 1e-6f);
        float zf[8]; unpack8(*(const uint4*)(PM + (size_t)(t0 + c) * PMLD + 768 + h * 64 + d0), zf);
        float y[8];
#pragma unroll
        for (int i = 0; i < 8; ++i) y[i] = xv[i] * rs * norm_g[d0 + i] * siluf_(zf[i]);
        *(uint4*)(Y + (size_t)(t0 + c) * D + h * 64 + d0) = pack8(y);
    }
    BAR();
}

struct RwkvBufs { bf16_t *RR, *RK, *RV, *RKK, *RA, *RG; float* CW; uint4* MF; float* NF; float* HT; bf16_t* TG; };
__device__ __forceinline__ void rwkv_prep_chunk(const bf16_t* __restrict__ PM, int n, const RwkvBufs& B, const Params& p, int l, const bf16_t* __restrict__ WUPT, const bf16_t* __restrict__ AUPT, const bf16_t* __restrict__ GUPT, LAS unsigned char* lds) {
    const int tid = opq_tid(), w = tid >> 6, lane = tid & 63, q4 = lane >> 4, cc = lane & 15;
    const int t0 = n * 64;
    const float* mu = p.in[24] + l * 1024;
    lds_bf16* Awd = (lds_bf16*)lds; lds_bf16* Aad = Awd + 64 * 72; lds_bf16* Agd = Aad + 64 * 72;
    lds_bf16* La = Agd + 64 * 136; lds_bf16* Lg = La + 64 * 264; lds_bf16* Llw = Lg + 64 * 264;
    {
        const int t = tid >> 3, c0 = (tid & 7) * 32;
        const bf16_t* row = PM + (size_t)(t0 + t) * PMLD + C_RWKV + 768 + c0;
        const bool hasprev = (t0 + t) > 0;
#pragma unroll
        for (int g8 = 0; g8 < 4; ++g8) {
            float x[8], xp[8];
            unpack8(*(const uint4*)(row + 8 * g8), x);
            if (hasprev) unpack8(*(const uint4*)(row - PMLD + 8 * g8), xp); else {
#pragma unroll
                for (int i = 0; i < 8; ++i) xp[i] = 0.f; }
            const int col = c0 + 8 * g8;
            float y[8];
#pragma unroll
            for (int i = 0; i < 8; ++i) {
                const float v = x[i] + mu[768 + col + i] * (xp[i] - x[i]);
                y[i] = col < 64 ? tanhf(v) : (col < 128 ? v : sigmoidf_(v));
            }
            const uint4 pk = pack8(y);
            if (col < 64) *(LAS u32x4_t*)(Awd + t * 72 + col) = (u32x4_t){pk.x, pk.y, pk.z, pk.w};
            else if (col < 128) *(LAS u32x4_t*)(Aad + t * 72 + (col - 64)) = (u32x4_t){pk.x, pk.y, pk.z, pk.w};
            else *(LAS u32x4_t*)(Agd + t * 136 + (col - 128)) = (u32x4_t){pk.x, pk.y, pk.z, pk.w};
        }
    }
    BAR();
    const int hh = w >> 1, tt0 = 2 * (w & 1);
    {
        const float* w0 = p.in[25] + l * W; const float* a0 = p.in[27] + l * W;
#pragma unroll 2
        for (int b = 0; b < 4; ++b) {
            const int ncol = 64 * hh + 16 * b + cc;
            f32x4_t accw[2], acca[2], accg[2];
#pragma unroll
            for (int a = 0; a < 2; ++a) { accw[a] = (f32x4_t){0.f, 0.f, 0.f, 0.f}; acca[a] = accw[a]; accg[a] = accw[a]; }
#pragma unroll
            for (int ks = 0; ks < 4; ++ks) {
                U8 bw, ba, bg;
                bg.q = *(const uint4*)(GUPT + (size_t)ncol * 128 + 32 * ks + 8 * q4);
                if (ks < 2) { bw.q = *(const uint4*)(WUPT + (size_t)ncol * 64 + 32 * ks + 8 * q4); ba.q = *(const uint4*)(AUPT + (size_t)ncol * 64 + 32 * ks + 8 * q4); }
#pragma unroll
                for (int a = 0; a < 2; ++a) {
                    const int row = 16 * (tt0 + a) + cc;
                    U8 ag; ag.x = *(const LAS u32x4_t*)(Agd + row * 136 + 32 * ks + 8 * q4);
                    accg[a] = __builtin_amdgcn_mfma_f32_16x16x32_bf16(ag.v, bg.v, accg[a], 0, 0, 0);
                    if (ks < 2) {
                        U8 aw, aa; aw.x = *(const LAS u32x4_t*)(Awd + row * 72 + 32 * ks + 8 * q4); aa.x = *(const LAS u32x4_t*)(Aad + row * 72 + 32 * ks + 8 * q4);
                        accw[a] = __builtin_amdgcn_mfma_f32_16x16x32_bf16(aw.v, bw.v, accw[a], 0, 0, 0);
                        acca[a] = __builtin_amdgcn_mfma_f32_16x16x32_bf16(aa.v, ba.v, acca[a], 0, 0, 0);
                    }
                }
            }
            const float w0n = w0[ncol], a0n = a0[ncol];
#pragma unroll
            for (int a = 0; a < 2; ++a)
#pragma unroll
                for (int r = 0; r < 4; ++r) {
                    const int t = 16 * (tt0 + a) + 4 * q4 + r;
                    const float logw = -softplusf_(-(w0n + accw[a][r])) - 0.5f;
                    Llw[t * 264 + ncol] = (unsigned short)f2bf(-__expf(logw));
                    La[t * 264 + ncol] = (unsigned short)f2bf(sigmoidf_(a0n + acca[a][r]));
                    Lg[t * 264 + ncol] = (unsigned short)f2bf(accg[a][r]);
                }
        }
    }
    BAR();
    {
        const int t = tid >> 3, n0 = (tid & 7) * 32;
        const bf16_t* row = PM + (size_t)(t0 + t) * PMLD + C_RWKV;
        const bool hasprev = (t0 + t) > 0;
        const float* k_k = p.in[30] + l * W; const float* k_a = p.in[31] + l * W;
        float ss = 0.f;
#pragma unroll 2
        for (int g8 = 0; g8 < 4; ++g8) {
            const int nn = n0 + 8 * g8;
            float xr[8], xk[8], xv[8], pr[8], pk[8], pv[8], av[8];
            unpack8(*(const uint4*)(row + nn), xr); unpack8(*(const uint4*)(row + 256 + nn), xk); unpack8(*(const uint4*)(row + 512 + nn), xv);
            if (hasprev) { unpack8(*(const uint4*)(row - PMLD + nn), pr); unpack8(*(const uint4*)(row - PMLD + 256 + nn), pk); unpack8(*(const uint4*)(row - PMLD + 512 + nn), pv); }
            else {
#pragma unroll
                for (int i = 0; i < 8; ++i) { pr[i] = 0.f; pk[i] = 0.f; pv[i] = 0.f; } }
            { const u32x4_t t4 = *(const LAS u32x4_t*)(La + t * 264 + nn); unpack8(make_uint4(t4.x, t4.y, t4.z, t4.w), av); }
            float orr[8], okk[8], ovv[8];
#pragma unroll
            for (int i = 0; i < 8; ++i) {
                const float r = xr[i] + mu[nn + i] * (pr[i] - xr[i]);
                const float k = xk[i] + mu[256 + nn + i] * (pk[i] - xk[i]);
                const float v = xv[i] + mu[512 + nn + i] * (pv[i] - xv[i]);
                orr[i] = r; ovv[i] = v; okk[i] = k * (1.f + (av[i] - 1.f) * k_a[nn + i]);
                const float kr = k * k_k[nn + i]; ss = fmaf(kr, kr, ss);
            }
            const size_t o = (size_t)(t0 + t) * 256 + nn;
            *(uint4*)(B.RR + o) = pack8(orr); *(uint4*)(B.RK + o) = pack8(okk); *(uint4*)(B.RV + o) = pack8(ovv);
            { const u32x4_t t4 = *(const LAS u32x4_t*)(La + t * 264 + nn); *(uint4*)(B.RA + o) = make_uint4(t4.x, t4.y, t4.z, t4.w); }
            { const u32x4_t t4 = *(const LAS u32x4_t*)(Lg + t * 264 + nn); *(uint4*)(B.RG + o) = make_uint4(t4.x, t4.y, t4.z, t4.w); }
        }
        ss += __shfl_xor(ss, 1);
        const float rn = rsqrtf(ss + 1e-6f);
#pragma unroll
        for (int g8 = 0; g8 < 4; ++g8) {
            const int nn = n0 + 8 * g8;
            float xk[8], pk[8], kk[8];
            unpack8(*(const uint4*)(row + 256 + nn), xk);
            if (hasprev) unpack8(*(const uint4*)(row - PMLD + 256 + nn), pk); else {
#pragma unroll
                for (int i = 0; i < 8; ++i) pk[i] = 0.f; }
#pragma unroll
            for (int i = 0; i < 8; ++i) kk[i] = (xk[i] + mu[256 + nn + i] * (pk[i] - xk[i])) * k_k[nn + i] * rn;
            *(uint4*)(B.RKK + (size_t)(t0 + t) * 256 + nn) = pack8(kk);
        }
    }
    if (tid < 256) {
        float c = 0.f;
#pragma unroll 16
        for (int t = 0; t < 64; ++t) { c += bf2f(Llw[t * 264 + tid]); B.CW[(size_t)(t0 + t) * 256 + tid] = c; }
    }
    BAR();
}

struct RwPiece { float kk[8], al[8], kt[8], v[8], cw[8], cwp[8], cwc[8]; };
__device__ __forceinline__ void rwkv_load_piece(const RwkvBufs& B, int h, int t0, int c, int d0, RwPiece& P) {
    const size_t o = (size_t)(t0 + c) * 256 + h * 64 + d0;
    float a[8];
    unpack8(*(const uint4*)(B.RKK + o), P.kk); unpack8(*(const uint4*)(B.RA + o), a); unpack8(*(const uint4*)(B.RK + o), P.kt); unpack8(*(const uint4*)(B.RV + o), P.v);
    const float4 c0 = *(const float4*)(B.CW + o), c1 = *(const float4*)(B.CW + o + 4);
    P.cw[0] = c0.x; P.cw[1] = c0.y; P.cw[2] = c0.z; P.cw[3] = c0.w; P.cw[4] = c1.x; P.cw[5] = c1.y; P.cw[6] = c1.z; P.cw[7] = c1.w;
    if (c > 0) { const float4 p0 = *(const float4*)(B.CW + o - 256), p1 = *(const float4*)(B.CW + o - 256 + 4);
        P.cwp[0] = p0.x; P.cwp[1] = p0.y; P.cwp[2] = p0.z; P.cwp[3] = p0.w; P.cwp[4] = p1.x; P.cwp[5] = p1.y; P.cwp[6] = p1.z; P.cwp[7] = p1.w; }
    else {
#pragma unroll
        for (int i = 0; i < 8; ++i) P.cwp[i] = 0.f; }
    const size_t oc = (size_t)(t0 + 63) * 256 + h * 64 + d0;
    const float4 e0 = *(const float4*)(B.CW + oc), e1 = *(const float4*)(B.CW + oc + 4);
    P.cwc[0] = e0.x; P.cwc[1] = e0.y; P.cwc[2] = e0.z; P.cwc[3] = e0.w; P.cwc[4] = e1.x; P.cwc[5] = e1.y; P.cwc[6] = e1.z; P.cwc[7] = e1.w;
#pragma unroll
    for (int i = 0; i < 8; ++i) P.al[i] = a[i] * P.kk[i];
}

__device__ __forceinline__ void rwkv_g1_unit(int h, int n, const RwkvBufs& B, bf16_t* __restrict__ Y, LAS unsigned char* lds) {
    const int tid = opq_tid(), w = tid >> 6, lane = tid & 63, q4 = lane >> 4, cc = lane & 15;
    lds_bf16 *P0h = plane(lds, 0), *P0l = plane(lds, 1), *P1h = plane(lds, 2), *P1l = plane(lds, 3), *P2h = plane(lds, 4), *P2l = plane(lds, 5);
    lds_bf16 *Lkh = plane(lds, 6), *Lkl = plane(lds, 7), *P3h = plane(lds, 8), *P3l = plane(lds, 9), *Th = plane(lds, 10), *Tl = plane(lds, 11);
    LAS float* Lm = (LAS float*)(lds + LM_OFF);
    const int t0 = n * 64, u = (4 + h) * 256 + n;
    const int c = tid >> 3, d0 = (tid & 7) * 8;
    RwPiece P; rwkv_load_piece(B, h, t0, c, d0, P);
    {
        float x0[8], x1[8], x2[8];
#pragma unroll
        for (int i = 0; i < 8; ++i) { const float em = __expf(-P.cw[i]); x0[i] = P.kk[i] * __expf(P.cwp[i]); x1[i] = P.al[i] * em; x2[i] = P.kt[i] * em; }
        put8<true>(P0h, P0l, c, d0, x0); put8<true>(P1h, P1l, c, d0, x1); put8<true>(P2h, P2l, c, d0, x2);
    }
    BAR();
    const int ti = w >> 1, tj0 = (w & 1) * 2;
    const f32x4_t zero4 = {0.f, 0.f, 0.f, 0.f};
#pragma unroll
    for (int tt = 0; tt < 2; ++tt) {
        const int tj = tj0 + tt;
        f32x4_t lk = zero4, la = zero4;
        const int j = 16 * tj + cc, jp = (j & 3) * 16 + (j >> 2);
        if (tj <= ti) {
            const f32x4_t a = mmp<true, true>(P0h, P0l, P1h, P1l, 16 * ti, 16 * tj, lane, zero4);
            const f32x4_t b = mmp<true, true>(P0h, P0l, P2h, P2l, 16 * ti, 16 * tj, lane, zero4);
#pragma unroll
            for (int r = 0; r < 4; ++r) { const int i = 16 * ti + 4 * q4 + r; la[r] = (i > j) ? a[r] : 0.f; lk[r] = (i > j) ? b[r] : 0.f; }
        }
#pragma unroll
        for (int r = 0; r < 4; ++r) Lm[(16 * ti + 4 * q4 + r) * PT + jp] = la[r];
        st_tile_R<true>(Lkh, Lkl, 16 * ti, 16 * tj, lane, lk);
    }
    BAR();
    {
        float x0[8], x1[8], x2[8];
#pragma unroll
        for (int i = 0; i < 8; ++i) { const float eb = __expf(P.cwc[i] - P.cw[i]); x0[i] = P.kk[i] * __expf(P.cwp[i]); x1[i] = P.al[i] * eb; x2[i] = P.kt[i] * eb; }
        put8T<true>(P0h, P0l, c, d0, P.v); put8T<true>(P1h, P1l, c, d0, x0); put8T<true>(P2h, P2l, c, d0, x1); put8T<true>(P3h, P3l, c, d0, x2);
    }
    if (w < 4) tri_inverse_4w(Lm, Th, Tl, w, lane);
    BAR();
    { const u32x4_t t4 = *(const LAS u32x4_t*)(Th + c * PB + d0); *(uint4*)(B.TG + (size_t)u * 4096 + c * 64 + d0) = make_uint4(t4.x, t4.y, t4.z, t4.w);
      const u32x4_t t5 = *(const LAS u32x4_t*)(Tl + c * PB + d0); *(uint4*)(Y + (size_t)(t0 + c) * D + 768 + h * 64 + d0) = make_uint4(t5.x, t5.y, t5.z, t5.w); }
    f32x4_t pa[2];
#pragma unroll
    for (int tt = 0; tt < 2; ++tt) pa[tt] = mmp<true, true>(Lkh, Lkl, P0h, P0l, 16 * ti, 16 * (tj0 + tt), lane, zero4);
    BAR();
#pragma unroll
    for (int tt = 0; tt < 2; ++tt) st_tile_T<true>(Lkh, Lkl, 16 * ti, 16 * (tj0 + tt), lane, pa[tt]);
    BAR();
    f32x4_t ua[2], wa[2];
#pragma unroll
    for (int tt = 0; tt < 2; ++tt) {
        ua[tt] = mmp<true, true>(Th, Tl, Lkh, Lkl, 16 * ti, 16 * (tj0 + tt), lane, zero4);
        wa[tt] = mmp<true, true>(Th, Tl, P1h, P1l, 16 * ti, 16 * (tj0 + tt), lane, zero4);
    }
    BAR();
#pragma unroll
    for (int tt = 0; tt < 2; ++tt) {
        st_tile_T<true>(Lkh, Lkl, 16 * ti, 16 * (tj0 + tt), lane, -ua[tt]);
        st_tile_T<true>(P1h, P1l, 16 * ti, 16 * (tj0 + tt), lane, wa[tt]);
    }
    BAR();
    {
#pragma unroll
        for (int tt = 0; tt < 2; ++tt) {
            const int tj = tj0 + tt;
            const f32x4_t a = mmp<true, true>(P2h, P2l, P1h, P1l, 16 * ti, 16 * tj, lane, zero4);
            const float gam = __expf(B.CW[(size_t)(t0 + 63) * 256 + h * 64 + 16 * tj + cc]);
#pragma unroll
            for (int r = 0; r < 4; ++r) { const int ar = 16 * ti + 4 * q4 + r, bc = 16 * tj + cc; Lm[ar * PT + bc] = (ar == bc ? gam : 0.f) - a[r]; }
            f32x4_t nn = mmp<true, true>(P2h, P2l, Lkh, Lkl, 16 * ti, 16 * tj, lane, zero4);
            nn = mmp<true, true>(P3h, P3l, P0h, P0l, 16 * ti, 16 * tj, lane, nn);
            *(float4*)(B.NF + (size_t)u * 4096 + (tj * 64 + lane) * 16 + ti * 4) = make_float4(nn[0], nn[1], nn[2], nn[3]);
        }
    }
    BAR();
    {
        const int combo = tid >> 6, mt = combo >> 1, s = combo & 1, i = lane & 15, qq = lane >> 4;
        const f32x4_t x0 = *(const LAS f32x4_t*)(Lm + (16 * mt + i) * PT + 32 * s + 4 * qq);
        const f32x4_t x1 = *(const LAS f32x4_t*)(Lm + (16 * mt + i) * PT + 32 * s + 16 + 4 * qq);
        const float xv[8] = {x0.x, x0.y, x0.z, x0.w, x1.x, x1.y, x1.z, x1.w};
        U8 H, L; split8(xv, H.v, L.v);
        uint4* mf = B.MF + (size_t)u * 1024 + (size_t)(combo * 2) * 64 + lane;
        mf[0] = H.q; mf[64] = L.q;
    }
    BAR();
}

__device__ __forceinline__ void rwkv_g3_unit(int h, int n, const RwkvBufs& B, bf16_t* __restrict__ Y, const Params& p, int l, LAS unsigned char* lds) {
    const int tid = opq_tid(), w = tid >> 6, lane = tid & 63, q4 = lane >> 4, cc = lane & 15;
    lds_bf16 *KH = plane(lds, 0), *AC = plane(lds, 1), *KC = plane(lds, 2), *RH = plane(lds, 3), *VT = plane(lds, 4), *KHT = plane(lds, 5), *Tp = plane(lds, 6);
    lds_bf16 *HTh = plane(lds, 7), *HTl = plane(lds, 8), *Lk = plane(lds, 9), *Ara = plane(lds, 10), *Ark = plane(lds, 11), *Tq = plane(lds, 12);
    lds_bf16 *PTp = KH, *Wm = AC, *UT = KC;
    LAS float* Os = (LAS float*)(lds + LM_OFF);
    const int t0 = n * 64, u = (4 + h) * 256 + n;
    const int c = tid >> 3, d0 = (tid & 7) * 8;
    {
        RwPiece P; rwkv_load_piece(B, h, t0, c, d0, P);
        float rr[8]; unpack8(*(const uint4*)(B.RR + (size_t)(t0 + c) * 256 + h * 64 + d0), rr);
        const uint4 t8 = *(const uint4*)(B.TG + (size_t)u * 4096 + c * 64 + d0);
        const uint4 t9 = *(const uint4*)(Y + (size_t)(t0 + c) * D + 768 + h * 64 + d0);
        const float* ht = B.HT + (size_t)u * 4096 + c * 64 + d0;
        const float4 h0 = *(const float4*)ht, h1 = *(const float4*)(ht + 4);
        float x0[8], x1[8], x2[8], x3[8];
#pragma unroll
        for (int i = 0; i < 8; ++i) { const float em = __expf(-P.cw[i]); x0[i] = P.kk[i] * __expf(P.cwp[i]); x1[i] = P.al[i] * em; x2[i] = P.kt[i] * em; x3[i] = rr[i] * __expf(P.cw[i]); }
        put8<false>(KH, KH, c, d0, x0); put8<false>(AC, AC, c, d0, x1); put8<false>(KC, KC, c, d0, x2); put8<false>(RH, RH, c, d0, x3);
        put8T<false>(VT, VT, c, d0, P.v); put8T<false>(KHT, KHT, c, d0, x0);
        *(LAS u32x4_t*)(Tp + c * PB + d0) = (u32x4_t){t8.x, t8.y, t8.z, t8.w};
        *(LAS u32x4_t*)(Tq + c * PB + d0) = (u32x4_t){t9.x, t9.y, t9.z, t9.w};
        const float hv[8] = {h0.x, h0.y, h0.z, h0.w, h1.x, h1.y, h1.z, h1.w};
        put8<true>(HTh, HTl, c, d0, hv);
    }
    BAR();
    const int ti = w >> 1, tj0 = (w & 1) * 2;
    const f32x4_t zero4 = {0.f, 0.f, 0.f, 0.f};
#pragma unroll
    for (int tt = 0; tt < 2; ++tt) {
        const int tj = tj0 + tt; const int j = 16 * tj + cc;
        f32x4_t lk = zero4, ara = zero4, ark = zero4;
        if (tj <= ti) {
            const f32x4_t b = mmp<false, false>(KH, KH, KC, KC, 16 * ti, 16 * tj, lane, zero4);
            const f32x4_t e = mmp<false, false>(RH, RH, AC, AC, 16 * ti, 16 * tj, lane, zero4);
            const f32x4_t f = mmp<false, false>(RH, RH, KC, KC, 16 * ti, 16 * tj, lane, zero4);
#pragma unroll
            for (int r = 0; r < 4; ++r) { const int i = 16 * ti + 4 * q4 + r; lk[r] = (i > j) ? b[r] : 0.f; ara[r] = (i >= j) ? e[r] : 0.f; ark[r] = (i >= j) ? f[r] : 0.f; }
        }
        st_tile_R<false>(Lk, Lk, 16 * ti, 16 * tj, lane, lk); st_tile_R<false>(Ara, Ara, 16 * ti, 16 * tj, lane, ara); st_tile_R<false>(Ark, Ark, 16 * ti, 16 * tj, lane, ark);
    }
    BAR();
#pragma unroll
    for (int tt = 0; tt < 2; ++tt) {
        const int tj = tj0 + tt;
        st_tile_T<false>(PTp, PTp, 16 * ti, 16 * tj, lane, mmp<false, false>(Lk, Lk, VT, VT, 16 * ti, 16 * tj, lane, zero4));
        st_tile_R<false>(Wm, Wm, 16 * ti, 16 * tj, lane, mmp<true, false>(Tp, Tq, KHT, KHT, 16 * ti, 16 * tj, lane, zero4));
    }
    BAR();
    f32x4_t o[2];
#pragma unroll
    for (int tt = 0; tt < 2; ++tt) {
        const int tj = tj0 + tt;
        const f32x4_t ua = mmp<true, false>(Tp, Tq, PTp, PTp, 16 * ti, 16 * tj, lane, zero4);
        const f32x4_t wh = mmp<false, true>(Wm, Wm, HTh, HTl, 16 * ti, 16 * tj, lane, zero4);
        st_tile_T<false>(UT, UT, 16 * ti, 16 * tj, lane, -ua - wh);
        o[tt] = mmp<false, true>(RH, RH, HTh, HTl, 16 * ti, 16 * tj, lane, zero4);
        o[tt] = mmp<false, false>(Ark, Ark, VT, VT, 16 * ti, 16 * tj, lane, o[tt]);
    }
    BAR();
#pragma unroll
    for (int tt = 0; tt < 2; ++tt) {
        const int tj = tj0 + tt;
        o[tt] = mmp<false, false>(Ara, Ara, UT, UT, 16 * ti, 16 * tj, lane, o[tt]);
#pragma unroll
        for (int r = 0; r < 4; ++r) Os[(16 * ti + 4 * q4 + r) * PT + 16 * tj + cc] = o[tt][r];
    }
    BAR();
    {
        const f32x4_t x0 = *(const LAS f32x4_t*)(Os + c * PT + d0), x1 = *(const LAS f32x4_t*)(Os + c * PT + d0 + 4);
        const float xv[8] = {x0.x, x0.y, x0.z, x0.w, x1.x, x1.y, x1.z, x1.w};
        float s1 = 0.f;
#pragma unroll
        for (int i = 0; i < 8; ++i) s1 += xv[i];
        s1 += __shfl_xor(s1, 1); s1 += __shfl_xor(s1, 2); s1 += __shfl_xor(s1, 4);
        const float mean = s1 * (1.f / 64.f);
        float s2 = 0.f;
#pragma unroll
        for (int i = 0; i < 8; ++i) { const float dd = xv[i] - mean; s2 = fmaf(dd, dd, s2); }
        s2 += __shfl_xor(s2, 1); s2 += __shfl_xor(s2, 2); s2 += __shfl_xor(s2, 4);
        const float rs = rsqrtf(s2 * (1.f / 64.f) + 64e-5f);
        const size_t o8 = (size_t)(t0 + c) * 256 + h * 64 + d0;
        float rr[8], gg[8], kt2[8], v2[8];
        unpack8(*(const uint4*)(B.RR + o8), rr); unpack8(*(const uint4*)(B.RG + o8), gg); unpack8(*(const uint4*)(B.RK + o8), kt2); unpack8(*(const uint4*)(B.RV + o8), v2);
        const float* r_k = p.in[32] + l * W + h * 64 + d0; const float* ln_g = p.in[33] + l * W + h * 64 + d0; const float* ln_b = p.in[34] + l * W + h * 64 + d0;
        float bs = 0.f;
#pragma unroll
        for (int i = 0; i < 8; ++i) bs = fmaf(rr[i] * kt2[i], r_k[i], bs);
        bs += __shfl_xor(bs, 1); bs += __shfl_xor(bs, 2); bs += __shfl_xor(bs, 4);
        float y[8];
#pragma unroll
        for (int i = 0; i < 8; ++i) y[i] = ((xv[i] - mean) * rs * ln_g[i] + ln_b[i] + bs * v2[i]) * gg[i];
        *(uint4*)(Y + (size_t)(t0 + c) * D + 768 + h * 64 + d0) = pack8(y);
    }
    BAR();
}

struct LruBufs { float2* AGG; float* CAR; };
template <int PASS>
__device__ __forceinline__ void lru_unit(const bf16_t* __restrict__ PM, int n, const LruBufs& B, bf16_t* __restrict__ Y, const Params& p, int l, const bf16_t* __restrict__ LWT  , LAS float* lds) {
    const int tid = opq_tid(), c = tid & 255, half = tid >> 8, w = tid >> 6, lane = tid & 63, q4 = lane >> 4, cc = lane & 15;
    const int t0 = n * 64, tb = t0 + 32 * half;
    LAS float* U = lds;
    lds_bf16* R = (lds_bf16*)(lds + 64 * 260);
    lds_bf16* I = R + 64 * 264;
    {
        const float* cw = p.in[7] + l * 4 * W; const float cb = p.in[8][l * W + c];
        const float w0 = cw[c], w1 = cw[W + c], w2 = cw[2 * W + c], w3 = cw[3 * W + c];
        const bf16_t* col = PM + C_LRU + c;
        float h0 = tb >= 3 ? bf2f(col[(size_t)(tb - 3) * PMLD]) : 0.f, h1 = tb >= 2 ? bf2f(col[(size_t)(tb - 2) * PMLD]) : 0.f, h2 = tb >= 1 ? bf2f(col[(size_t)(tb - 1) * PMLD]) : 0.f;
#pragma unroll 4
        for (int i = 0; i < 32; ++i) {
            const float x = bf2f(col[(size_t)(tb + i) * PMLD]);
            U[(32 * half + i) * 260 + c] = cb + w0 * h0 + w1 * h1 + w2 * h2 + w3 * x;
            h0 = h1; h1 = h2; h2 = x;
        }
    }
    BAR();
    {
        const int nb = w >> 1, gt = w & 1;
        const bf16_t* wt = LWT + (size_t)gt * 16384 + (size_t)nb * 4096;
        const float* bias = (gt ? p.in[12] : p.in[10]) + l * W + nb * 64;
        const float* lam = p.in[13] + l * W + nb * 64;
#pragma unroll 1
        for (int te = 0; te < 4; ++te) {
            U8 bf[2];
#pragma unroll
            for (int ks = 0; ks < 2; ++ks) bf[ks].q = *(const uint4*)(wt + (size_t)(16 * te + cc) * 64 + 32 * ks + 8 * q4);
            const int ch = nb * 64 + 16 * te + cc;
            const float bv = bias[16 * te + cc];
            const float sp8 = 8.f * softplusf_(-lam[16 * te + cc]);
#pragma unroll
            for (int tt = 0; tt < 4; ++tt) {
                f32x4_t acc = {0.f, 0.f, 0.f, 0.f};
#pragma unroll
                for (int ks = 0; ks < 2; ++ks) {
                    const LAS float* ap = U + (16 * tt + cc) * 260 + nb * 64 + 32 * ks + 8 * q4;
                    const f32x4_t a0 = *(const LAS f32x4_t*)ap, a1 = *(const LAS f32x4_t*)(ap + 4);
                    const float av[8] = {a0.x, a0.y, a0.z, a0.w, a1.x, a1.y, a1.z, a1.w};
                    acc = __builtin_amdgcn_mfma_f32_16x16x32_bf16(hi8(av), bf[ks].v, acc, 0, 0, 0);
                }
#pragma unroll
                for (int r = 0; r < 4; ++r) {
                    const int t = 16 * tt + 4 * q4 + r;
                    const float sg = sigmoidf_(acc[r] + bv);
                    if (gt) I[t * 264 + ch] = (unsigned short)f2bf(sg); else R[t * 264 + ch] = (unsigned short)f2bf(-sp8 * sg);
                }
            }
        }
    }
    BAR();
    float h = 0.f, ap = 1.f;
    const int sc = 2 * n + half;
    if (PASS == 3) h = B.CAR[(size_t)c * 512 + sc];
#pragma unroll 2
    for (int i = 0; i < 32; ++i) {
        const int t = 32 * half + i;
        const float log_a = bf2f(R[t * 264 + c]), ig = bf2f(I[t * 264 + c]);
        const float a = __expf(log_a);
        const float inp = sqrtf(-expm1f(2.f * log_a)) * (ig * U[t * 260 + c]);
        h = fmaf(a, h, inp); ap *= a;
        if (PASS == 3) {
            const float gate = bf2f(PM[(size_t)(t0 + t) * PMLD + C_LRU + 256 + c]);
            Y[(size_t)(t0 + t) * D + 256 + c] = (bf16_t)f2bf(h * geluf_(gate));
        }
    }
    if (PASS == 1) B.AGG[(size_t)c * 512 + sc] = make_float2(ap, h);
    BAR();
}
__device__ __forceinline__ void lru_carry_wave(const LruBufs& B, int c, int lane) {
    float2 ab[8];
    const float4* src = (const float4*)(B.AGG + (size_t)c * 512 + 8 * lane);
#pragma unroll
    for (int k = 0; k < 4; ++k) { const float4 v = src[k]; ab[2 * k] = make_float2(v.x, v.y); ab[2 * k + 1] = make_float2(v.z, v.w); }
    float A = 1.f, Bv = 0.f;
#pragma unroll
    for (int k = 0; k < 8; ++k) { Bv = fmaf(ab[k].x, Bv, ab[k].y); A *= ab[k].x; }
#pragma unroll
    for (int o = 1; o < 64; o <<= 1) { const float Al = __shfl_up(A, o), Bl = __shfl_up(Bv, o); if (lane >= o) { Bv = fmaf(A, Bl, Bv); A *= Al; } }
    float h = __shfl_up(Bv, 1); if (lane == 0) h = 0.f;
    float o8[8];
#pragma unroll
    for (int k = 0; k < 8; ++k) { o8[k] = h; h = fmaf(ab[k].x, h, ab[k].y); }
    float4* dst = (float4*)(B.CAR + (size_t)c * 512 + 8 * lane);
    dst[0] = make_float4(o8[0], o8[1], o8[2], o8[3]); dst[1] = make_float4(o8[4], o8[5], o8[6], o8[7]);
}

struct S5Bufs { float2* E; float2* CIN; };
struct S5Lane { float lbr, lbi; float bbr[16], bbi[16]; };
__device__ __forceinline__ void s5_lane_consts(const Params& p, int l, int g, int lane, S5Lane& K) {
    const float dt = __expf(p.in[21][l * 16 + g]);
    const float lre = p.in[14][l * 1024 + g * 64 + lane], lim = p.in[15][l * 1024 + g * 64 + lane];
    const float er = __expf(lre * dt);
    K.lbr = er * cosf(lim * dt); K.lbi = er * sinf(lim * dt);
    const float nr = K.lbr - 1.f, ni = K.lbi, den = lre * lre + lim * lim;
    const float fr = (nr * lre + ni * lim) / den, fi = (ni * lre - nr * lim) / den;
    const float* bre = p.in[16] + (size_t)l * 16384 + (g * 64 + lane) * 16; const float* bim = p.in[17] + (size_t)l * 16384 + (g * 64 + lane) * 16;
#pragma unroll
    for (int c = 0; c < 16; ++c) { const float br = bre[c], bi = bim[c]; K.bbr[c] = fr * br - fi * bi; K.bbi[c] = fr * bi + fi * br; }
}
template <int PASS>
__device__ __forceinline__ void s5_unit(const bf16_t* __restrict__ PM, int n, const S5Bufs& B, bf16_t* __restrict__ Y, const Params& p, int l, const bf16_t* __restrict__ GLUT, LAS unsigned char* lds) {
    const int tid = opq_tid(), w = tid >> 6, lane = tid & 63, q4 = lane >> 4, cc = lane & 15;
    const int t0 = n * 64;
    LAS float* us = (LAS float*)lds + w * (64 * 16);
    LAS unsigned char* hs = lds + 32768 + w * (32 * 272);
    lds_bf16* yp = (lds_bf16*)(lds + 32768 + 8 * 32 * 272);
#pragma unroll 1
    for (int gi = 0; gi < 2; ++gi) {
        const int g = 2 * w + gi;
        {
            const bf16_t* src = PM + (size_t)(t0 + lane) * PMLD + C_S5 + g * 16;
            float a[8], b[8]; unpack8(*(const uint4*)src, a); unpack8(*(const uint4*)(src + 8), b);
            *(LAS f32x4_t*)(us + lane * 16) = (f32x4_t){a[0], a[1], a[2], a[3]}; *(LAS f32x4_t*)(us + lane * 16 + 4) = (f32x4_t){a[4], a[5], a[6], a[7]};
            *(LAS f32x4_t*)(us + lane * 16 + 8) = (f32x4_t){b[0], b[1], b[2], b[3]}; *(LAS f32x4_t*)(us + lane * 16 + 12) = (f32x4_t){b[4], b[5], b[6], b[7]};
        }
        S5Lane K; s5_lane_consts(p, l, g, lane, K);
        float hr = 0.f, hi = 0.f;
        if (PASS == 3) { const float2 h0 = B.CIN[((size_t)g * 64 + lane) * 256 + n]; hr = h0.x; hi = h0.y; }
        U8 cf[4];
        float dch = 0.f;
        if (PASS == 3) {
            const float* cre = p.in[18] + (size_t)l * 16384 + (g * 16 + cc) * 64; const float* cim = p.in[19] + (size_t)l * 16384 + (g * 16 + cc) * 64;
#pragma unroll
            for (int ks = 0; ks < 4; ++ks) {
                const float4 r4 = *(const float4*)(cre + 16 * ks + 4 * q4), i4 = *(const float4*)(cim + 16 * ks + 4 * q4);
                cf[ks].u[0] = cvtpk(r4.x, -i4.x); cf[ks].u[1] = cvtpk(r4.y, -i4.y); cf[ks].u[2] = cvtpk(r4.z, -i4.z); cf[ks].u[3] = cvtpk(r4.w, -i4.w);
            }
            dch = p.in[20][l * W + g * 16 + cc];
        }
        asm volatile("s_waitcnt lgkmcnt(0)" ::: "memory");
#pragma unroll 1
        for (int hf = 0; hf < 2; ++hf) {
#pragma unroll 2
            for (int i = 0; i < 32; ++i) {
                const int t = 32 * hf + i;
                const f32x4_t u0 = *(const LAS f32x4_t*)(us + t * 16), u1 = *(const LAS f32x4_t*)(us + t * 16 + 4), u2 = *(const LAS f32x4_t*)(us + t * 16 + 8), u3 = *(const LAS f32x4_t*)(us + t * 16 + 12);
                const float uv[16] = {u0.x, u0.y, u0.z, u0.w, u1.x, u1.y, u1.z, u1.w, u2.x, u2.y, u2.z, u2.w, u3.x, u3.y, u3.z, u3.w};
                float br = 0.f, bi = 0.f;
#pragma unroll
                for (int c = 0; c < 16; ++c) { br = fmaf(K.bbr[c], uv[c], br); bi = fmaf(K.bbi[c], uv[c], bi); }
                const float nhr = K.lbr * hr - K.lbi * hi + br, nhi = K.lbr * hi + K.lbi * hr + bi;
                hr = nhr; hi = nhi;
                if (PASS == 3) *(LAS unsigned*)(hs + i * 272 + 4 * lane) = cvtpk(hr, hi);
            }
            if (PASS == 3) {
                asm volatile("s_waitcnt lgkmcnt(0)" ::: "memory");
#pragma unroll
                for (int tt = 0; tt < 2; ++tt) {
                    f32x4_t acc = {0.f, 0.f, 0.f, 0.f};
#pragma unroll
                    for (int ks = 0; ks < 4; ++ks) {
                        U8 af; af.x = *(const LAS u32x4_t*)(hs + (16 * tt + cc) * 272 + 64 * ks + 16 * q4);
                        acc = __builtin_amdgcn_mfma_f32_16x16x32_bf16(af.v, cf[ks].v, acc, 0, 0, 0);
                    }
#pragma unroll
                    for (int r = 0; r < 4; ++r) {
                        const int t = 32 * hf + 16 * tt + 4 * q4 + r;
                        const float yv = acc[r] + dch * us[t * 16 + cc];
                        yp[t * 264 + g * 16 + cc] = (unsigned short)f2bf(geluf_(yv));
                    }
                }
                asm volatile("s_waitcnt lgkmcnt(0)" ::: "memory");
            }
        }
        if (PASS == 1) B.E[((size_t)g * 64 + lane) * 256 + n] = make_float2(hr, hi);
    }
    if (PASS == 3) {
        BAR();
        const float* gb = p.in[23] + l * W;
#pragma unroll 1
        for (int tn = 2 * w; tn < 2 * w + 2; ++tn) {
            f32x4_t acc[4];
#pragma unroll
            for (int tt = 0; tt < 4; ++tt) acc[tt] = (f32x4_t){0.f, 0.f, 0.f, 0.f};
#pragma unroll
            for (int ks = 0; ks < 8; ++ks) {
                U8 bf; bf.q = *(const uint4*)(GLUT + (size_t)(16 * tn + cc) * 256 + 32 * ks + 8 * q4);
#pragma unroll
                for (int tt = 0; tt < 4; ++tt) {
                    U8 af; af.x = *(const LAS u32x4_t*)(yp + (16 * tt + cc) * 264 + 32 * ks + 8 * q4);
                    acc[tt] = __builtin_amdgcn_mfma_f32_16x16x32_bf16(af.v, bf.v, acc[tt], 0, 0, 0);
                }
            }
            const int ncol = 16 * tn + cc; const float gbn = gb[ncol];
#pragma unroll
            for (int tt = 0; tt < 4; ++tt)
#pragma unroll
                for (int r = 0; r < 4; ++r) {
                    const int t = 16 * tt + 4 * q4 + r;
                    const float yv = bf2f(yp[t * 264 + ncol]);
                    Y[(size_t)(t0 + t) * D + 512 + ncol] = (bf16_t)f2bf(yv * sigmoidf_(acc[tt][r] + gbn));
                }
        }
    }
    BAR();
}
__device__ __forceinline__ void s5_carry_wave(const S5Bufs& B, const Params& p, int l, int gp, int lane) {
    const int g = gp >> 6;
    const float dt = __expf(p.in[21][l * 16 + g]) * 64.f;
    const float lre = p.in[14][l * 1024 + gp], lim = p.in[15][l * 1024 + gp];
    const float er = __expf(lre * dt);
    const float pr = er * cosf(lim * dt), pi = er * sinf(lim * dt);
    float2 e[4];
    const float4* src = (const float4*)(B.E + (size_t)gp * 256 + 4 * lane);
    { const float4 v0 = src[0], v1 = src[1]; e[0] = make_float2(v0.x, v0.y); e[1] = make_float2(v0.z, v0.w); e[2] = make_float2(v1.x, v1.y); e[3] = make_float2(v1.z, v1.w); }
    float Ar = 1.f, Ai = 0.f, Br = 0.f, Bi = 0.f;
#pragma unroll
    for (int k = 0; k < 4; ++k) {
        const float nbr = pr * Br - pi * Bi + e[k].x, nbi = pr * Bi + pi * Br + e[k].y; Br = nbr; Bi = nbi;
        const float nar = pr * Ar - pi * Ai, nai = pr * Ai + pi * Ar; Ar = nar; Ai = nai;
    }
#pragma unroll
    for (int o = 1; o < 64; o <<= 1) {
        const float Alr = __shfl_up(Ar, o), Ali = __shfl_up(Ai, o), Blr = __shfl_up(Br, o), Bli = __shfl_up(Bi, o);
        if (lane >= o) {
            const float nbr = Ar * Blr - Ai * Bli + Br, nbi = Ar * Bli + Ai * Blr + Bi; Br = nbr; Bi = nbi;
            const float nar = Ar * Alr - Ai * Ali, nai = Ar * Ali + Ai * Alr; Ar = nar; Ai = nai;
        }
    }
    float hr = __shfl_up(Br, 1), hi = __shfl_up(Bi, 1); if (lane == 0) { hr = 0.f; hi = 0.f; }
    float2 o4[4];
#pragma unroll
    for (int k = 0; k < 4; ++k) { o4[k] = make_float2(hr, hi); const float nhr = pr * hr - pi * hi + e[k].x, nhi = pr * hi + pi * hr + e[k].y; hr = nhr; hi = nhi; }
    float4* dst = (float4*)(B.CIN + (size_t)gp * 256 + 4 * lane);
    dst[0] = make_float4(o4[0].x, o4[0].y, o4[1].x, o4[1].y); dst[1] = make_float4(o4[2].x, o4[2].y, o4[3].x, o4[3].y);
}

constexpr size_t WS_GQ = 36 * MiB, WS_GK = 44 * MiB, WS_GV = 52 * MiB, WS_GB = 60 * MiB, WS_GC = 61 * MiB;
constexpr size_t WS_MF = 324 * MiB, WS_NF = 356 * MiB, WS_HT = 388 * MiB;
constexpr size_t WS_RR = 420 * MiB, WS_RK = 428 * MiB, WS_RV = 436 * MiB, WS_RKK = 444 * MiB, WS_RA = 452 * MiB, WS_RG = 460 * MiB, WS_CW = 468 * MiB;
constexpr size_t WS_LAGG = 484 * MiB, WS_LCAR = 485 * MiB, WS_S5E = 486 * MiB, WS_S5C = 488 * MiB;
constexpr size_t WS_TG = 490 * MiB;
constexpr int MIX_LDS = 8 * MS * 4 + 1024;
__device__ __forceinline__ LruBufs lru_bufs(unsigned char* ws) { LruBufs B; B.AGG = (float2*)(ws + WS_LAGG); B.CAR = (float*)(ws + WS_LCAR); return B; }
__device__ __forceinline__ S5Bufs s5_bufs(unsigned char* ws) { S5Bufs B; B.E = (float2*)(ws + WS_S5E); B.CIN = (float2*)(ws + WS_S5C); return B; }
__device__ __forceinline__ GdnBufs gdn_bufs(unsigned char* ws) {
    GdnBufs B; B.GQ = (bf16_t*)(ws + WS_GQ); B.GK = (bf16_t*)(ws + WS_GK); B.GV = (bf16_t*)(ws + WS_GV); B.GB = (float*)(ws + WS_GB); B.GC = (float*)(ws + WS_GC);
    B.MF = (uint4*)(ws + WS_MF); B.NF = (float*)(ws + WS_NF); B.HT = (float*)(ws + WS_HT); B.TG = (bf16_t*)(ws + WS_TG); return B;
}
__device__ __forceinline__ RwkvBufs rwkv_bufs(unsigned char* ws) {
    RwkvBufs B; B.RR = (bf16_t*)(ws + WS_RR); B.RK = (bf16_t*)(ws + WS_RK); B.RV = (bf16_t*)(ws + WS_RV); B.RKK = (bf16_t*)(ws + WS_RKK); B.RA = (bf16_t*)(ws + WS_RA); B.RG = (bf16_t*)(ws + WS_RG);
    B.CW = (float*)(ws + WS_CW); B.MF = (uint4*)(ws + WS_MF); B.NF = (float*)(ws + WS_NF); B.HT = (float*)(ws + WS_HT); B.TG = (bf16_t*)(ws + WS_TG); return B;
}
__device__ __forceinline__ unsigned char* opq(unsigned char* w) { unsigned long long v = (unsigned long long)w; asm volatile("" : "+s"(v)); return (unsigned char*)(GAS unsigned char*)v; }
#define XB_TMO      128
#define XB_XCNT(j)  (256  + 64 * (j))
#define XB_XSUB(j)  (1280 + 64 * (j))
#define XB_XGEN(j)  (2304 + 64 * (j))
#define XB_TOP      3328
#define XB_TOPGEN   3392
#define XCD_BAR_WORDS 3456
#define XB_SPIN_CAP (1u << 18)

__device__ __forceinline__ unsigned xb_ld(unsigned* p)              { return __hip_atomic_load(p, __ATOMIC_RELAXED, __HIP_MEMORY_SCOPE_AGENT); }
__device__ __forceinline__ unsigned xb_add(unsigned* p, unsigned v) { return __hip_atomic_fetch_add(p, v, __ATOMIC_RELAXED, __HIP_MEMORY_SCOPE_AGENT); }
__device__ __forceinline__ unsigned xb_xcc_id() { return (unsigned)__builtin_amdgcn_s_getreg((3 << 11) | 20) & 0xFu; }
#define XB_SPIN(cond, bar) do { unsigned _sp = 0; while (cond) { __builtin_amdgcn_s_sleep(1); \
    if ((++_sp & 255u) == 0u) { if (xb_ld(&(bar)[XB_TMO])) break; if (_sp > XB_SPIN_CAP) { atomicAdd(&(bar)[XB_TMO], 1u); break; } } } } while (0)

struct XcdBarrier {
    unsigned* bar; unsigned x;
    volatile LAS unsigned* st;
};

__device__ __forceinline__ XcdBarrier xcd_barrier_post(unsigned* bar, volatile LAS unsigned* st) {
    XcdBarrier b; b.bar = bar; b.x = xb_xcc_id(); b.st = st;
    if (threadIdx.x == 0) (void)xb_add(&bar[XB_XCNT(b.x)], 1u);
    return b;
}
__device__ __forceinline__ void xcd_barrier_complete(unsigned* bar, unsigned x, unsigned& nloc, unsigned& nx) {
    const unsigned G = gridDim.x * gridDim.y * gridDim.z;
    unsigned sum, cnt, mine, sp = 0u;
    for (;;) {
        sum = 0u; cnt = 0u; mine = 0u;
#pragma unroll
        for (unsigned j = 0; j < 16; ++j) { const unsigned c = xb_ld(&bar[XB_XCNT(j)]); sum += c; cnt += (c > 0u) ? 1u : 0u; mine = (j == x) ? c : mine; }
        if (sum == G) break;
        __builtin_amdgcn_s_sleep(1);
        if ((++sp & 255u) == 0u) { if (xb_ld(&bar[XB_TMO])) break; if (sp > XB_SPIN_CAP) { atomicAdd(&bar[XB_TMO], 1u); break; } }
    }
    nloc = mine > 0u ? mine : 1u; nx = cnt > 0u ? cnt : 1u;
}

__device__ __forceinline__ void xcd_barrier(const XcdBarrier& b) {
    asm volatile("s_waitcnt vmcnt(0)" ::: "memory");
    __syncthreads();
    if (threadIdx.x == 0) {
        unsigned* bar = b.bar;
        __builtin_amdgcn_s_waitcnt(0);
        unsigned nloc = b.st[0], nx = b.st[1];
        if (nloc == 0u) { xcd_barrier_complete(bar, b.x, nloc, nx); b.st[0] = nloc; b.st[1] = nx; }
        const unsigned old = xb_add(&bar[XB_XSUB(b.x)], 1u);
        const unsigned gen = old / nloc;
        if (old + 1u == (gen + 1u) * nloc) {
            __builtin_amdgcn_fence(__ATOMIC_RELEASE, "agent");
            asm volatile("s_waitcnt vmcnt(0)" ::: "memory");
            const unsigned og = xb_add(&bar[XB_TOP], 1u);
            const unsigned tg = og / nx;
            if (og + 1u == (tg + 1u) * nx) xb_add(&bar[XB_TOPGEN], 1u);
            else XB_SPIN(xb_ld(&bar[XB_TOPGEN]) == tg, bar);
            __builtin_amdgcn_fence(__ATOMIC_ACQUIRE, "agent");
            xb_add(&bar[XB_XGEN(b.x)], 1u);
            asm volatile("s_waitcnt vmcnt(0)" ::: "memory");
        } else {
            XB_SPIN(xb_ld(&bar[XB_XGEN(b.x)]) == gen, bar);
            __builtin_amdgcn_fence(__ATOMIC_ACQUIRE, "agent");
            asm volatile("s_waitcnt vmcnt(0)" ::: "memory");
        }
    }
    __syncthreads();
}

namespace cg = cooperative_groups;
constexpr int FUSED_LDS = MIX_LDS;
static_assert(FUSED_LDS >= pg8::STAGE_BYTES && FUSED_LDS >= 8 * 64 * 33 * 4, "LDS budget");
#define GSYNC() xcd_barrier(bar)
#ifndef PHM
#define PHM 511
#endif
#ifndef REP
#define REP 0
#endif
#ifndef REPU
#define REPU 0
#endif
#ifndef REPP
#define REPP 0
#endif
__global__ void __launch_bounds__(NT, 2) fwd_fused(KParams kp_unused) {
    cg::grid_group grid = cg::this_grid();
    extern __shared__ __attribute__((aligned(16))) unsigned char dl[];
    Params p; p.in.tab = (LAS const unsigned long long*)((LAS unsigned char*)dl + FUSED_LDS);
    {
        const __attribute__((address_space(4))) unsigned long long* ka = (const __attribute__((address_space(4))) unsigned long long*)__builtin_amdgcn_kernarg_segment_ptr();
        if (threadIdx.x < 43) ((LAS unsigned long long*)((LAS unsigned char*)dl + FUSED_LDS))[threadIdx.x] = ka[threadIdx.x];
        if (threadIdx.x < 4) ((LAS unsigned*)((LAS unsigned char*)dl + FUSED_LDS + 512))[threadIdx.x] = 0u;
        __syncthreads();
    }
    const XcdBarrier bar = xcd_barrier_post((unsigned*)(p.ws() + WS_CTL), (volatile LAS unsigned*)((LAS unsigned char*)dl + FUSED_LDS + 512));
    float* X = p.out();
#pragma unroll 1
    for (int l = 0; l < 2; ++l) {
        {
            const int tid = opq_tid();
            convert_weights(p, l, (LAS float*)dl + (tid >> 6) * 64 * 33, blockIdx.x * 8 + (tid >> 6), gridDim.x * 8, tid & 63);
        }
#pragma unroll 1
        for (int b = 0; b < 2; ++b) {
            const float* Xin = (l == 0 ? p.in[0] : X) + (size_t)b * TB * D;
            float* Xb = X + (size_t)b * TB * D;
            { unsigned char* ws = opq(p.ws()); rmsnorm_rows(Xin, p.in[1] + l * D, (bf16_t*)(ws + WS_XN), TB); }
            if (l == 0 && b == 0) grid.sync(); else GSYNC();
#if PHM & 1
            for (int rep_ = 0; rep_ < ((REP & 1) ? 2 : 1); ++rep_) {
            {
                unsigned char* ws = opq(p.ws()); const bf16_t* WL = (const bf16_t*)(ws + WS_W);
                pg8::Gemm g{(const bf16_t*)(ws + WS_XN), WL + WO_IN, TB, 7168, D, D, D, 0};
                pg8::StaticOrder S; S.init(g.M, g.N, (int)gridDim.x, (int)blockIdx.x);
                pg8::gemm_phase<pg8::EpiProjP, pg8::StaticOrder, true, true>((PG8_LAS unsigned char*)dl, g, S, pg8::EpiProjP{(bf16_t*)(ws + WS_PM), (bf16_t*)(ws + WS_G)});
            }
            }
#endif
            GSYNC();
#if PHM & 2
            for (int rep_ = 0; rep_ < ((REP & 2) ? 2 : 1); ++rep_) {
            for (int n = blockIdx.x; n < 512; n += gridDim.x) {
                unsigned char* ws = opq(p.ws());
                if (n < 256) gdn_prep_chunk((const bf16_t*)(ws + WS_PM), n, gdn_bufs(ws), p, l, (LAS float*)dl);
                else { const bf16_t* WL = (const bf16_t*)(ws + WS_W); rwkv_prep_chunk((const bf16_t*)(ws + WS_PM), n - 256, rwkv_bufs(ws), p, l, WL + WO_WUP, WL + WO_AUP, WL + WO_GUP, (LAS unsigned char*)dl); }
            }
            }
#endif
            GSYNC();
#if PHM & 4
            for (int rep_ = 0; rep_ < ((REP & 4) ? 2 : 1); ++rep_) {
            for (int ps_ = 0; ps_ < ((REPP == 4) ? 2 : 1); ++ps_)
            for (int u = blockIdx.x; u < 2560; u += gridDim.x) {
                const int ut_ = u < 1024 ? 1 : (u < 2048 ? 2 : (u < 2304 ? 3 : 4));
                if (ps_ == 1 && ut_ != REPU) continue;
                unsigned char* ws = opq(p.ws());
                if (u < 1024) gdn_g1_unit(u >> 8, u & 255, gdn_bufs(ws), (bf16_t*)(ws + WS_Y), (LAS unsigned char*)dl);
                else if (u < 2048) rwkv_g1_unit((u - 1024) >> 8, u & 255, rwkv_bufs(ws), (bf16_t*)(ws + WS_Y), (LAS unsigned char*)dl);
                else if (u < 2304) lru_unit<1>((const bf16_t*)(ws + WS_PM), u - 2048, lru_bufs(ws), (bf16_t*)(ws + WS_Y), p, l, (const bf16_t*)(ws + WS_W) + WO_LWT, (LAS float*)dl);
                else s5_unit<1>((const bf16_t*)(ws + WS_PM), u - 2304, s5_bufs(ws), (bf16_t*)(ws + WS_Y), p, l, (const bf16_t*)(ws + WS_W) + WO_GLU, (LAS unsigned char*)dl);
            }
            }
#endif
            GSYNC();
#if PHM & 8
            for (int rep_ = 0; rep_ < ((REP & 8) ? 2 : 1); ++rep_) {
            {
                const int tid = opq_tid(), lane = tid & 63, wv = tid >> 6;
                const int bx = blockIdx.x;
                volatile LAS unsigned* flags = (volatile LAS unsigned*)((LAS unsigned char*)dl + FUSED_LDS + 768);
                if (tid < 16) flags[tid] = 0u;
                __syncthreads();
                if (bx < 32) {
                    unsigned char* ws = opq(p.ws());
                    const GdnBufs B = gdn_bufs(ws); const int sq = bx >> 2, cb = bx & 3;
                    if (wv == 0) chain_wave(B.HT + (size_t)sq * 256 * 4096, cb, 256, lane, (LAS unsigned char*)dl, flags);
                    else chain_loader(B.MF + (size_t)sq * 256 * 1024, B.NF + (size_t)sq * 256 * 4096, cb, 256, lane, wv - 1, (LAS unsigned char*)dl, flags);
                } else {
                    unsigned char* ws = opq(p.ws());
                    for (int job = (bx - 32) * 8 + wv; job < 1280; job += (int)(gridDim.x - 32) * 8) {
                        if (job < 256) lru_carry_wave(lru_bufs(ws), job, lane);
                        else s5_carry_wave(s5_bufs(ws), p, l, job - 256, lane);
                    }
                }
            }
            }
#endif
            GSYNC();
#if PHM & 16
            for (int rep_ = 0; rep_ < ((REP & 16) ? 2 : 1); ++rep_) {
            for (int ps_ = 0; ps_ < ((REPP == 16) ? 2 : 1); ++ps_)
            for (int u = blockIdx.x; u < 2560; u += gridDim.x) {
                const int ut_ = u < 1024 ? 1 : (u < 2048 ? 2 : (u < 2304 ? 3 : 4));
                if (ps_ == 1 && ut_ != REPU) continue;
                unsigned char* ws = opq(p.ws());
                if (u < 1024) gdn_g3_unit(u >> 8, u & 255, gdn_bufs(ws), (const bf16_t*)(ws + WS_PM), (bf16_t*)(ws + WS_Y), p.in[6] + l * 64, (LAS unsigned char*)dl);
                else if (u < 2048) rwkv_g3_unit((u - 1024) >> 8, u & 255, rwkv_bufs(ws), (bf16_t*)(ws + WS_Y), p, l, (LAS unsigned char*)dl);
                else if (u < 2304) lru_unit<3>((const bf16_t*)(ws + WS_PM), u - 2048, lru_bufs(ws), (bf16_t*)(ws + WS_Y), p, l, (const bf16_t*)(ws + WS_W) + WO_LWT, (LAS float*)dl);
                else s5_unit<3>((const bf16_t*)(ws + WS_PM), u - 2304, s5_bufs(ws), (bf16_t*)(ws + WS_Y), p, l, (const bf16_t*)(ws + WS_W) + WO_GLU, (LAS unsigned char*)dl);
            }
            }
#endif
            GSYNC();
#if PHM & 32
            for (int rep_ = 0; rep_ < ((REP & 32) ? 2 : 1); ++rep_) {
            { unsigned char* ws = opq(p.ws()); merge_phase((const bf16_t*)(ws + WS_Y), (const bf16_t*)(ws + WS_W) + WO_BR, (const bf16_t*)(ws + WS_G), (bf16_t*)(ws + WS_MG), (LAS unsigned char*)dl); }
            }
#endif
            GSYNC();
#if PHM & 64
            {
                unsigned char* ws = opq(p.ws()); const bf16_t* WL = (const bf16_t*)(ws + WS_W);
                pg8::Gemm g{(const bf16_t*)(ws + WS_MG), WL + WO_OUT, TB, D, D, D, D, 0};
                pg8::StaticOrder S; S.init(g.M, g.N, (int)gridDim.x, (int)blockIdx.x);
                pg8::gemm_phase<pg8::EpiResidP, pg8::StaticOrder, false, true>((PG8_LAS unsigned char*)dl, g, S, pg8::EpiResidP{Xin, Xb});
            }
#endif
            GSYNC();
            { unsigned char* ws = opq(p.ws()); rmsnorm_rows(Xb, p.in[37] + l * D, (bf16_t*)(ws + WS_XN), TB); }
            GSYNC();
#if PHM & 128
            for (int rep_ = 0; rep_ < ((REP & 128) ? 2 : 1); ++rep_) {
            {
                unsigned char* ws = opq(p.ws()); const bf16_t* WL = (const bf16_t*)(ws + WS_W);
                pg8::Gemm g{(const bf16_t*)(ws + WS_XN), WL + WO_W1, TB, DFF, D, D, D, 0};
                pg8::StaticOrder S; S.init(g.M, g.N, (int)gridDim.x, (int)blockIdx.x);
                pg8::gemm_phase<pg8::EpiRelu2P, pg8::StaticOrder, true, true>((PG8_LAS unsigned char*)dl, g, S, pg8::EpiRelu2P{(bf16_t*)(ws + WS_HD), DFF, 0});
            }
            }
#endif
            GSYNC();
#if PHM & 256
            {
                unsigned char* ws = opq(p.ws()); const bf16_t* WL = (const bf16_t*)(ws + WS_W);
                pg8::Gemm g{(const bf16_t*)(ws + WS_HD), WL + WO_W2, TB, D, DFF, DFF, DFF, 0};
                pg8::StaticOrder S; S.init(g.M, g.N, (int)gridDim.x, (int)blockIdx.x);
                pg8::gemm_phase<pg8::EpiResidP, pg8::StaticOrder, false, true>((PG8_LAS unsigned char*)dl, g, S, pg8::EpiResidP{Xb, Xb});
            }
#endif
            GSYNC();
        }
    }
    rmsnorm_rows(X, p.in[40], X, 2 * TB);
}

extern "C" void kernel_launch(void* const* d_in, const int* in_sizes, int n_in, void* d_out, int out_size, void* d_ws, size_t ws_size, hipStream_t stream) {
    KParams p{};
    for (int i = 0; i < 41; ++i) p.in[i] = (const float*)d_in[i];
    p.out = (float*)d_out; p.ws = (unsigned char*)d_ws; p.pad = 0;
    static int grid = 0;
    if (grid == 0) {
        int dev = 0, cus = 0, per_cu = 0;
        hipGetDevice(&dev);
        hipDeviceGetAttribute(&cus, hipDeviceAttributeMultiprocessorCount, dev);
        hipFuncSetAttribute((const void*)fwd_fused, hipFuncAttributeMaxDynamicSharedMemorySize, FUSED_LDS + 1024);
        hipOccupancyMaxActiveBlocksPerMultiprocessor(&per_cu, (const void*)fwd_fused, NT, FUSED_LDS + 1024);
        if (per_cu < 1) per_cu = 1;
        grid = cus * per_cu;
        if (grid > 256) grid = 256;
    }
    hipMemsetAsync((unsigned char*)d_ws + WS_CTL, 0, 16384, stream);
    void* args[] = {&p};
    hipError_t e = hipLaunchCooperativeKernel((const void*)fwd_fused, dim3(grid), dim3(NT), args, FUSED_LDS + 1024, stream);
    if (e != hipSuccess) fprintf(stderr, "cooperative launch failed: %s (grid %d)\n", hipGetErrorString(e), grid);
}
```

```cpp
#include <hip/hip_runtime.h>
#ifndef MEXP
#define MEXP 0
#endif
#ifndef PEXP
#define PEXP 0
#endif
#include <hip/hip_cooperative_groups.h>
#include <cstdio>
#include <cstdint>

constexpr int TB = 16384;
constexpr int D = 1024;
constexpr int DIN = 6920;
constexpr int NMIX = 2824;
constexpr int W = 256;
constexpr int DFF = 4096;
constexpr int NT = 512;

constexpr int C_GDN = 0, C_LRU = 1032, C_S5 = 1544, C_RWKV = 1800, C_GATE = 2824;

struct KParams { const float* in[41]; float* out; unsigned char* ws; size_t pad; };
#define LAS __attribute__((address_space(3)))
#define GAS __attribute__((address_space(1)))
struct PIn { LAS const unsigned long long* tab;
    __device__ __forceinline__ const float* operator[](int i) const { LAS const unsigned long long* t = tab; asm volatile("" : "+v"(t)); const unsigned long long v = t[i];
        const unsigned lo = __builtin_amdgcn_readfirstlane((unsigned)v), hi = __builtin_amdgcn_readfirstlane((unsigned)(v >> 32)); return (const float*)(GAS const float*)(((unsigned long long)hi << 32) | lo); } };
struct Params { PIn in;
    __device__ __forceinline__ float* out() const { return (float*)in[41]; }
    __device__ __forceinline__ unsigned char* ws() const { return (unsigned char*)in[42]; } };

typedef unsigned short bf16_t;
constexpr int PMLD = 3072;
constexpr size_t MiB = 1u << 20;
constexpr size_t WS_W  = 0;
constexpr size_t WS_CTL = 35 * MiB;
constexpr size_t WS_XN = 36 * MiB;
constexpr size_t WS_PM = 68 * MiB;
constexpr size_t WS_G  = 164 * MiB;
constexpr size_t WS_HD = 164 * MiB;
constexpr size_t WS_Y  = 292 * MiB;
constexpr size_t WS_MG = 324 * MiB;

__device__ __forceinline__ unsigned f2bf(float f) { unsigned u = __float_as_uint(f); return (u + 0x7fffu + ((u >> 16) & 1u)) >> 16; }
__device__ __forceinline__ float bf2f(bf16_t b) { return __uint_as_float((unsigned)b << 16); }
__device__ __forceinline__ float ldf(const float* p) { return *p; }
__device__ __forceinline__ float ldf(const bf16_t* p) { return bf2f(*p); }
__device__ __forceinline__ float sigmoidf_(float x) { return __builtin_amdgcn_rcpf(1.f + __expf(-x)); }
__device__ __forceinline__ float softplusf_(float x) { const float e = __expf(x); return x > 20.f ? x : (e < 1e-4f ? e : __logf(1.f + e)); }
__device__ __forceinline__ float siluf_(float x) { return x * sigmoidf_(x); }
__device__ __forceinline__ float tanhf_(float y) { return 1.f - 2.f * __builtin_amdgcn_rcpf(1.f + __expf(2.f * y)); }
__device__ __forceinline__ float geluf_(float x) { return 0.5f * x * (1.f + tanhf_(0.7978845608028654f * (x + 0.044715f * x * x * x))); }
__device__ __forceinline__ float rl(float v, int i) { return __int_as_float(__builtin_amdgcn_readlane(__float_as_int(v), i)); }
__device__ __forceinline__ float wave_sum(float v) {
#pragma unroll
    for (int o = 1; o < 64; o <<= 1) v += __shfl_xor(v, o);
    return v;
}

template <class OT>
__device__ __forceinline__ void rmsnorm_rows(const float* X, const float* g, OT* O, int rows) {
    int tid_ = threadIdx.x; asm volatile("" : "+v"(tid_));
    const int lane = tid_ & 63, wv = tid_ >> 6;
    const int gw = blockIdx.x * (NT / 64) + wv, ngw = gridDim.x * (NT / 64);
    for (int r = gw; r < rows; r += ngw) {
        const float4* xr = (const float4*)(X + (size_t)r * D);
        float4 v[4]; float s = 0.f;
#pragma unroll
        for (int j = 0; j < 4; ++j) { v[j] = xr[lane + 64 * j]; s += v[j].x * v[j].x + v[j].y * v[j].y + v[j].z * v[j].z + v[j].w * v[j].w; }
        s = wave_sum(s);
        const float rs = rsqrtf(s * (1.f / D) + 1e-6f);
#pragma unroll
        for (int j = 0; j < 4; ++j) {
            const float4 gg = ((const float4*)g)[lane + 64 * j];
            const float4 o = make_float4(v[j].x * rs * gg.x, v[j].y * rs * gg.y, v[j].z * rs * gg.z, v[j].w * rs * gg.w);
            if constexpr (sizeof(OT) == 4) ((float4*)(O + (size_t)r * D))[lane + 64 * j] = o;
            else ((uint2*)(O + (size_t)r * D))[lane + 64 * j] = make_uint2(f2bf(o.x) | (f2bf(o.y) << 16), f2bf(o.z) | (f2bf(o.w) << 16));
        }
    }
}

namespace pg8 {
#define PG8_LAS __attribute__((address_space(3)))
typedef short bf16x8 __attribute__((ext_vector_type(8)));
typedef float f32x4 __attribute__((ext_vector_type(4)));
typedef unsigned u32x4 __attribute__((ext_vector_type(4)));
constexpr int BM = 256, BK = 64, HALF = 128, HTB = HALF * BK * 2  , STAGE_BYTES = 8 * HTB, NXCD = 8, WGM = 8;

__host__ __device__ __forceinline__ int lds_byte(int r, int c) { const int st = (r >> 4) * 2 + (c >> 5), rr = r & 15, cc = c & 31, ob = rr * 64 + cc * 2; return st * 1024 + (ob ^ (((ob >> 9) & 1) << 5)); }
__host__ __device__ __forceinline__ void stage_rc(int b, int& R, int& C) { const int st = b / 1024, sb = b % 1024, swz = sb ^ (((sb >> 9) & 1) << 5); R = (st >> 1) * 16 + swz / 64; C = (st & 1) * 32 + (swz % 64) / 2; }
__host__ __device__ __forceinline__ int perm32(int rho) { const int n = rho >> 4, i = rho & 15; return 8 * (i >> 2) + 4 * n + (i & 3); }

struct Unit { int pm, pn; };
struct Gemm { const bf16_t* A; const bf16_t* Bt; int M, N, K, lda, ldb, pad; };

struct StaticOrder {
    int nM, nN, nwg, G, c;
    __host__ __device__ void init(int M, int N, int G_, int c_) { nM = M / BM; nN = N / BM; nwg = nM * nN; G = G_; c = c_; }
    __host__ __device__ bool next(int i, Unit& u) const {
        const long L = (long)i * G + c; if (L >= nwg) return false;
        int wgid = (int)L; { const int q = nwg / NXCD, r = nwg % NXCD, xcd = wgid % NXCD, off = wgid / NXCD; wgid = (xcd < r ? xcd * (q + 1) : r * (q + 1) + (xcd - r) * q) + off; }
        const int nig = WGM * nN, gid = wgid / nig, fm = gid * WGM, gsz = (nM - fm) < WGM ? (nM - fm) : WGM;
        u.pm = fm + ((wgid % nig) % gsz); u.pn = (wgid % nig) / gsz; return true;
    }
    __device__ __forceinline__ void a_ready(const Unit&) const {}
    __device__ __forceinline__ void done(const Unit&) const {}
};


typedef __bf16 bf16x2p_t __attribute__((ext_vector_type(2)));
typedef float f32x2p_t __attribute__((ext_vector_type(2)));
__device__ __forceinline__ unsigned cvt_pk_bf16(float lo, float hi) { return __builtin_bit_cast(unsigned, __builtin_convertvector((f32x2p_t){lo, hi}, bf16x2p_t)); }
__device__ __forceinline__ float sigm(float x) { return __builtin_amdgcn_rcpf(1.f + __expf(-x)); }
struct EpiProjP {
    static constexpr bool PERM = true, AFTER_DRAIN = false;
    bf16_t* PM; bf16_t* G;
    __device__ __forceinline__ void operator()(const f32x4 (&acc)[2][2][4][2], const Unit& u, int wr, int wc, int fr, int fq) const {
        const int row0 = u.pm * BM + wr * 64 + fr;
        const bool sg = u.pn >= 12;
        bf16_t* base = sg ? G : PM; const int ld = sg ? 4096 : 3072; const int colt = (sg ? u.pn - 12 : u.pn) * BM;
        const int col0 = colt + wc * 32 + 8 * fq;
#pragma unroll
        for (int ai = 0; ai < 2; ++ai)
#pragma unroll
            for (int m = 0; m < 4; ++m) { bf16_t* rowp = base + (size_t)(row0 + ai * HALF + m * 16) * ld + col0;
#pragma unroll
                for (int bj = 0; bj < 2; ++bj) { f32x4 v0 = acc[ai][bj][m][0], v1 = acc[ai][bj][m][1];
                    if (sg) { v0[0] = sigm(v0[0]); v0[1] = sigm(v0[1]); v0[2] = sigm(v0[2]); v0[3] = sigm(v0[3]); v1[0] = sigm(v1[0]); v1[1] = sigm(v1[1]); v1[2] = sigm(v1[2]); v1[3] = sigm(v1[3]); }
                    u32x4 w; w.x = cvt_pk_bf16(v0[0], v0[1]); w.y = cvt_pk_bf16(v0[2], v0[3]); w.z = cvt_pk_bf16(v1[0], v1[1]); w.w = cvt_pk_bf16(v1[2], v1[3]);
                    *(u32x4*)(rowp + bj * HALF) = w; } }
    }
};
struct EpiRelu2P {
    static constexpr bool PERM = true, AFTER_DRAIN = false;
    bf16_t* O; int ldo; int pad;
    __device__ __forceinline__ void operator()(const f32x4 (&acc)[2][2][4][2], const Unit& u, int wr, int wc, int fr, int fq) const {
        const int row0 = u.pm * BM + wr * 64 + fr, col0 = u.pn * BM + wc * 32 + 8 * fq;
#pragma unroll
        for (int ai = 0; ai < 2; ++ai)
#pragma unroll
            for (int m = 0; m < 4; ++m) { bf16_t* rowp = O + (size_t)(row0 + ai * HALF + m * 16) * ldo + col0;
#pragma unroll
                for (int bj = 0; bj < 2; ++bj) { f32x4 v0 = acc[ai][bj][m][0], v1 = acc[ai][bj][m][1];
#pragma unroll
                    for (int j = 0; j < 4; ++j) { const float a = fmaxf(v0[j], 0.f), b = fmaxf(v1[j], 0.f); v0[j] = a * a; v1[j] = b * b; }
                    u32x4 w; w.x = cvt_pk_bf16(v0[0], v0[1]); w.y = cvt_pk_bf16(v0[2], v0[3]); w.z = cvt_pk_bf16(v1[0], v1[1]); w.w = cvt_pk_bf16(v1[2], v1[3]);
                    *(u32x4*)(rowp + bj * HALF) = w; } }
    }
};
struct EpiResidP {
    static constexpr bool PERM = false, AFTER_DRAIN = false;
    const float* base; float* out;
    __device__ __forceinline__ void operator()(const f32x4 (&acc)[2][2][4][2], const Unit& u, int wr, int wc, int fr, int fq) const {
        const int row0 = u.pm * BM + wr * 64 + fr, col0 = u.pn * BM + wc * 32 + 4 * fq;
#pragma unroll
        for (int ai = 0; ai < 2; ++ai)
#pragma unroll
            for (int m = 0; m < 4; ++m) { const size_t off = (size_t)(row0 + ai * HALF + m * 16) * 1024 + col0;
#pragma unroll
                for (int bj = 0; bj < 2; ++bj)
#pragma unroll
                    for (int n = 0; n < 2; ++n) { const f32x4 b = *(const f32x4*)(base + off + bj * HALF + n * 16); *(f32x4*)(out + off + bj * HALF + n * 16) = b + acc[ai][bj][m][n]; } }
    }
};
template <class Epi, class Sched, bool ALIGN_EPI = false, bool SP2 = false>
__device__ __forceinline__ void gemm_phase(PG8_LAS unsigned char* lds, const Gemm g, const Sched& S, const Epi& E) {
    int tid = threadIdx.x; asm volatile("" : "+v"(tid));
    const int wid = __builtin_amdgcn_readfirstlane(tid >> 6), lane = tid & 63, wr = wid >> 2, wc = wid & 3, fr = lane & 15, fq = lane >> 4;
    const int K = g.K, nt = K / BK;
    unsigned voffA[2], voffB[2];
#pragma unroll
    for (int i = 0; i < 2; ++i) { int R, C; stage_rc(tid * 16 + i * 8192, R, C); const int Rb = Epi::PERM ? ((R & ~31) + perm32(R & 31)) : R;
        voffA[i] = (unsigned)(R * g.lda + C) * 2u; voffB[i] = (unsigned)(Rb * g.ldb + C) * 2u; }
    const size_t kstep = (size_t)(BK * 2);
    const size_t hstepA = (size_t)HALF * g.lda * 2, hstepB = (size_t)HALF * g.ldb * 2;
    const size_t tstepA = 2 * hstepA, tstepB = 2 * hstepB;
    const unsigned ldsw = (unsigned)wid * 1024u;
    const int aoff = lds_byte(wr * 64 + fr, fq * 8), boff = lds_byte(wc * 32 + fr, fq * 8);
#define PG8_SA(b, h) (((b) * 2 + (h)) * HTB)
#define PG8_SB(b, h) ((4 + (b) * 2 + (h)) * HTB)
#define PG8_STAGE(bufoff, gbase, voff) do { _Pragma("unroll") for (int _i = 0; _i < 2; ++_i) \
        __builtin_amdgcn_global_load_lds((const unsigned*)((const char*)(gbase) + (voff)[_i]), (PG8_LAS unsigned*)(lds + (bufoff) + ldsw + _i * 8192), 16, 0, 0); } while (0)
#define PG8_LDA(dst, b, h) do { _Pragma("unroll") for (int m = 0; m < 4; ++m) _Pragma("unroll") for (int k = 0; k < 2; ++k) dst[m][k] = *(const PG8_LAS bf16x8*)(lds + PG8_SA(b, h) + aoff + m * 2048 + k * 1024); } while (0)
#define PG8_LDB(dst, b, h) do { _Pragma("unroll") for (int n = 0; n < 2; ++n) _Pragma("unroll") for (int k = 0; k < 2; ++k) dst[n][k] = *(const PG8_LAS bf16x8*)(lds + PG8_SB(b, h) + boff + n * 2048 + k * 1024); } while (0)
#define PG8_MMA(ai, bj, At, Bt) do { __builtin_amdgcn_s_setprio(1); _Pragma("unroll") for (int m = 0; m < 4; ++m) _Pragma("unroll") for (int n = 0; n < 2; ++n) _Pragma("unroll") for (int k = 0; k < 2; ++k) \
        acc[ai][bj][m][n] = __builtin_amdgcn_mfma_f32_16x16x32_bf16(Bt[n][k], At[m][k], acc[ai][bj][m][n], 0, 0, 0); __builtin_amdgcn_s_setprio(0); } while (0)
#define PG8_WAIT_V(n) asm volatile("s_waitcnt vmcnt(" #n ")" ::: "memory")
#define PG8_WAIT_L(n) asm volatile("s_waitcnt lgkmcnt(" #n ")" ::: "memory")
#define PG8_BAR __builtin_amdgcn_s_barrier()
#define PG8_SCHED __builtin_amdgcn_sched_barrier(0)
    Unit cur, nxt; int ui = 0;
    if (!S.next(0, cur)) return;
    f32x4 acc[2][2][4][2];
#pragma unroll
    for (int a = 0; a < 2; ++a)
#pragma unroll
        for (int b = 0; b < 2; ++b)
#pragma unroll
            for (int m = 0; m < 4; ++m)
#pragma unroll
                for (int n = 0; n < 2; ++n) acc[a][b][m][n] = (f32x4){0.f, 0.f, 0.f, 0.f};
    bf16x8 At[4][2], B0[2][2], B1[2][2];
    const char* cA = (const char*)g.A + (size_t)cur.pm * tstepA; const char* cB = (const char*)g.Bt + (size_t)cur.pn * tstepB;
    S.a_ready(cur);
    if constexpr (SP2) {
        PG8_STAGE(PG8_SB(0, 0), cB, voffB); PG8_STAGE(PG8_SB(0, 1), cB + hstepB, voffB); PG8_STAGE(PG8_SA(0, 0), cA, voffA); PG8_STAGE(PG8_SA(0, 1), cA + hstepA, voffA);
        if (wr == 1) PG8_BAR;
        PG8_WAIT_V(2); PG8_BAR;
        PG8_STAGE(PG8_SB(1, 0), cB + kstep, voffB); PG8_STAGE(PG8_SA(1, 0), cA + kstep, voffA); PG8_STAGE(PG8_SB(1, 1), cB + hstepB + kstep, voffB);
        PG8_WAIT_V(6); PG8_BAR;
    } else {
        PG8_STAGE(PG8_SB(0, 0), cB, voffB); PG8_STAGE(PG8_SA(0, 0), cA, voffA); PG8_STAGE(PG8_SB(0, 1), cB + hstepB, voffB); PG8_STAGE(PG8_SA(0, 1), cA + hstepA, voffA);
        if (wr == 1) PG8_BAR;
        PG8_WAIT_V(4); PG8_BAR;
        PG8_STAGE(PG8_SB(1, 0), cB + kstep, voffB); PG8_STAGE(PG8_SA(1, 0), cA + kstep, voffA); PG8_STAGE(PG8_SB(1, 1), cB + hstepB + kstep, voffB);
        PG8_WAIT_V(6); PG8_BAR;
    }
    for (;;) {
        const bool has_next = S.next(ui + 1, nxt);
        const char* nA = has_next ? (const char*)g.A + (size_t)nxt.pm * tstepA : cA; const char* nB = has_next ? (const char*)g.Bt + (size_t)nxt.pn * tstepB : cB;
        for (int t = 0; t < nt; t += 2) {
            const bool last = (t == nt - 2);
            const char* a1 = cA + (size_t)(t + 1) * kstep;
            const char* a2 = last ? nA : cA + (size_t)(t + 2) * kstep; const char* b2 = last ? nB : cB + (size_t)(t + 2) * kstep;
            const char* a3 = a2 + kstep; const char* b3 = b2 + kstep;
            if (last && has_next) S.a_ready(nxt);
            if constexpr (SP2) {
            PG8_LDB(B0, 0, 0); PG8_LDB(B1, 0, 1); PG8_SCHED; PG8_LDA(At, 0, 0); PG8_STAGE(PG8_SA(1, 1), a1 + hstepA, voffA);
            PG8_WAIT_V(8); PG8_WAIT_L(0); PG8_BAR; PG8_MMA(0, 0, At, B0); PG8_MMA(0, 1, At, B1); PG8_BAR; PG8_SCHED;
            PG8_LDA(At, 0, 1); PG8_STAGE(PG8_SB(0, 0), b2, voffB); PG8_STAGE(PG8_SB(0, 1), b2 + hstepB, voffB); PG8_STAGE(PG8_SA(0, 0), a2, voffA);
            PG8_WAIT_V(8); PG8_WAIT_L(0); PG8_BAR; PG8_MMA(1, 0, At, B0); PG8_MMA(1, 1, At, B1); PG8_BAR; PG8_SCHED;
            PG8_LDB(B0, 1, 0); PG8_LDB(B1, 1, 1); PG8_SCHED; PG8_LDA(At, 1, 0); PG8_STAGE(PG8_SA(0, 1), a2 + hstepA, voffA);
            PG8_WAIT_V(8); PG8_WAIT_L(0); PG8_BAR; PG8_MMA(0, 0, At, B0); PG8_MMA(0, 1, At, B1); PG8_BAR; PG8_SCHED;
            PG8_LDA(At, 1, 1); PG8_STAGE(PG8_SB(1, 0), b3, voffB); PG8_STAGE(PG8_SB(1, 1), b3 + hstepB, voffB); PG8_STAGE(PG8_SA(1, 0), a3, voffA);
            PG8_WAIT_V(8); PG8_WAIT_L(0); PG8_BAR; PG8_MMA(1, 0, At, B0); PG8_MMA(1, 1, At, B1); PG8_BAR; PG8_SCHED;
            } else {
            PG8_LDB(B0, 0, 0); PG8_SCHED; PG8_LDA(At, 0, 0); PG8_STAGE(PG8_SA(1, 1), a1 + hstepA, voffA);
            PG8_WAIT_L(8); PG8_BAR; PG8_WAIT_L(0); PG8_MMA(0, 0, At, B0); PG8_BAR; PG8_SCHED;
            PG8_LDB(B1, 0, 1); PG8_STAGE(PG8_SB(0, 0), b2, voffB);
            PG8_BAR; PG8_WAIT_L(0); PG8_MMA(0, 1, At, B1); PG8_BAR;
            PG8_LDA(At, 0, 1); PG8_STAGE(PG8_SA(0, 0), a2, voffA);
            PG8_BAR; PG8_WAIT_L(0); PG8_MMA(1, 0, At, B0); PG8_BAR; PG8_SCHED;
            PG8_STAGE(PG8_SB(0, 1), b2 + hstepB, voffB);
            PG8_WAIT_V(6); PG8_BAR; PG8_MMA(1, 1, At, B1); PG8_BAR;
            PG8_LDB(B0, 1, 0); PG8_SCHED; PG8_LDA(At, 1, 0); PG8_STAGE(PG8_SA(0, 1), a2 + hstepA, voffA);
            PG8_WAIT_L(8); PG8_BAR; PG8_WAIT_L(0); PG8_MMA(0, 0, At, B0); PG8_BAR; PG8_SCHED;
            PG8_LDB(B1, 1, 1); PG8_STAGE(PG8_SB(1, 0), b3, voffB);
            PG8_BAR; PG8_WAIT_L(0); PG8_MMA(0, 1, At, B1); PG8_BAR;
            PG8_LDA(At, 1, 1); PG8_STAGE(PG8_SA(1, 0), a3, voffA);
            PG8_BAR; PG8_WAIT_L(0); PG8_MMA(1, 0, At, B0); PG8_BAR; PG8_SCHED;
            PG8_STAGE(PG8_SB(1, 1), b3 + hstepB, voffB);
            PG8_WAIT_V(6); PG8_BAR; PG8_MMA(1, 1, At, B1); PG8_BAR;
            }
        }
        if constexpr (ALIGN_EPI) { if (wr == 0) PG8_BAR; }
        if constexpr (!Epi::AFTER_DRAIN) { E(acc, cur, wr, wc, fr, fq); S.done(cur); }
        if (!has_next) break;
#pragma unroll
        for (int a = 0; a < 2; ++a)
#pragma unroll
            for (int b = 0; b < 2; ++b)
#pragma unroll
                for (int m = 0; m < 4; ++m)
#pragma unroll
                    for (int n = 0; n < 2; ++n) acc[a][b][m][n] = (f32x4){0.f, 0.f, 0.f, 0.f};
        cur = nxt; cA = nA; cB = nB; ++ui;
        if constexpr (ALIGN_EPI) { if (wr == 1) PG8_BAR; }
    }
    PG8_WAIT_V(0);
    if constexpr (!ALIGN_EPI) { if (wr == 0) PG8_BAR; }
    PG8_BAR;
    if constexpr (Epi::AFTER_DRAIN) { E.fused(acc, cur, wr, wc, fr, fq, lds, wid, lane); S.done(cur); }
#undef PG8_SA
#undef PG8_SB
#undef PG8_STAGE
#undef PG8_LDA
#undef PG8_LDB
#undef PG8_MMA
#undef PG8_WAIT_V
#undef PG8_WAIT_L
#undef PG8_BAR
#undef PG8_SCHED
}
}


__device__ __forceinline__ unsigned pk2(float lo, float hi) { return f2bf(lo) | (f2bf(hi) << 16); }
template <class CM>
__device__ __forceinline__ void transpose_item(const float* __restrict__ Wsrc, int K, int ldsrc, bf16_t* __restrict__ WT, int nblk, LAS float* scr, int item, int lane, CM colmap) {
    const int kb = item / nblk, nb = item % nblk, k0 = 64 * kb, n0 = 32 * nb;
    const int sc = colmap(n0 + (lane & 31));
#pragma unroll 8
    for (int i = 0; i < 32; ++i) { const int kk = 2 * i + (lane >> 5); scr[kk * 33 + (lane & 31)] = sc >= 0 ? Wsrc[(size_t)(k0 + kk) * ldsrc + sc] : 0.f; }
    asm volatile("s_waitcnt lgkmcnt(0)" ::: "memory");
    const int c = lane & 7;
#pragma unroll
    for (int j = 0; j < 4; ++j) { const int n = (lane >> 3) + 8 * j; const LAS float* s = scr + (8 * c) * 33 + n;
        uint4 o; o.x = pk2(s[0 * 33], s[1 * 33]); o.y = pk2(s[2 * 33], s[3 * 33]); o.z = pk2(s[4 * 33], s[5 * 33]); o.w = pk2(s[6 * 33], s[7 * 33]);
        *(uint4*)(WT + (size_t)(n0 + n) * K + k0 + 8 * c) = o; }
    asm volatile("s_waitcnt lgkmcnt(0)" ::: "memory");
}
constexpr size_t WO_IN = 0;
constexpr size_t WO_BR = WO_IN + (size_t)7168 * 1024;
constexpr size_t WO_OUT = WO_BR + (size_t)4 * 1024 * 256;
constexpr size_t WO_W1 = WO_OUT + (size_t)1024 * 1024;
constexpr size_t WO_W2 = WO_W1 + (size_t)4096 * 1024;
constexpr size_t WO_WUP = WO_W2 + (size_t)4096 * 1024;
constexpr size_t WO_AUP = WO_WUP + 256 * 64;
constexpr size_t WO_GUP = WO_AUP + 256 * 64;
constexpr size_t WO_GLU = WO_GUP + 256 * 128;
constexpr size_t WO_LWT = WO_GLU + 256 * 256;
constexpr size_t WO_LAYER = WO_LWT + 2 * 16384;
__device__ __forceinline__ void convert_weights(const Params& p, int l, LAS float* scr, int gw, int ngw, int lane) {
    bf16_t* WB = (bf16_t*)(p.ws() + WS_W);
    constexpr int I_IN = (1024 / 64) * (7168 / 32), I_BR = (256 / 64) * (1024 / 32), I_OUT = (1024 / 64) * (1024 / 32), I_W1 = (1024 / 64) * (4096 / 32), I_W2 = (4096 / 64) * (1024 / 32);
    constexpr int I_UP = 8, I_GUP = 16, I_GLU = 4 * 8, I_LW = 16;
    constexpr int PER_LAYER = I_IN + 4 * I_BR + I_OUT + I_W1 + I_W2 + 2 * I_UP + I_GUP + I_GLU + I_LW;
    for (int it = gw; it < PER_LAYER; it += ngw) {
        int r = it;
        bf16_t* WL = WB;
        if (r < I_IN) { transpose_item(p.in[2] + (size_t)l * D * DIN, 1024, DIN, WL + WO_IN, 7168 / 32, scr, r, lane, [](int j) { return j < NMIX ? j : (j < 3072 ? -1 : j - 248); }); continue; } r -= I_IN;
        if (r < 4 * I_BR) { const int i = r / I_BR; transpose_item(p.in[35] + ((size_t)l * 4 + i) * W * D, 256, D, WL + WO_BR + (size_t)i * 1024 * 256, 1024 / 32, scr, r % I_BR, lane, [](int j) { return j; }); continue; } r -= 4 * I_BR;
        if (r < I_OUT) { transpose_item(p.in[36] + (size_t)l * D * D, 1024, D, WL + WO_OUT, 1024 / 32, scr, r, lane, [](int j) { return j; }); continue; } r -= I_OUT;
        if (r < I_W1) { transpose_item(p.in[38] + (size_t)l * D * DFF, 1024, DFF, WL + WO_W1, 4096 / 32, scr, r, lane, [](int j) { return j; }); continue; } r -= I_W1;
        if (r < I_W2) { transpose_item(p.in[39] + (size_t)l * DFF * D, 4096, D, WL + WO_W2, 1024 / 32, scr, r, lane, [](int j) { return j; }); continue; } r -= I_W2;
        if (r < I_UP) { transpose_item(p.in[26] + (size_t)l * 64 * W, 64, W, WL + WO_WUP, 8, scr, r, lane, [](int j) { return j; }); continue; } r -= I_UP;
        if (r < I_UP) { transpose_item(p.in[28] + (size_t)l * 64 * W, 64, W, WL + WO_AUP, 8, scr, r, lane, [](int j) { return j; }); continue; } r -= I_UP;
        if (r < I_GUP) { transpose_item(p.in[29] + (size_t)l * 128 * W, 128, W, WL + WO_GUP, 8, scr, r, lane, [](int j) { return j; }); continue; } r -= I_GUP;
        if (r < I_GLU) { transpose_item(p.in[22] + (size_t)l * W * W, 256, W, WL + WO_GLU, 8, scr, r, lane, [](int j) { return j; }); continue; } r -= I_GLU;
        { const int gt = r >> 3, nb = (r >> 1) & 3; transpose_item((gt ? p.in[11] : p.in[9]) + (size_t)l * 16384 + nb * 4096, 64, 64, WL + WO_LWT + (size_t)gt * 16384 + nb * 4096, 2, scr, r & 1, lane, [](int j) { return j; }); }
    }
}
#define BAR() do { asm volatile("s_waitcnt lgkmcnt(0)" ::: "memory"); __syncthreads(); } while (0)
typedef short bf16x8_t __attribute__((ext_vector_type(8)));
typedef float f32x4_t __attribute__((ext_vector_type(4)));
constexpr int PT = 68;
constexpr int MS = 64 * PT;
typedef __bf16 bf16x2v_t __attribute__((ext_vector_type(2)));
typedef float f32x2v_t __attribute__((ext_vector_type(2)));
__device__ __forceinline__ unsigned cvtpk(float lo, float hi) { return __builtin_bit_cast(unsigned, __builtin_convertvector((f32x2v_t){lo, hi}, bf16x2v_t)); }
typedef unsigned u32x4_t __attribute__((ext_vector_type(4)));
union U8 { bf16x8_t v; unsigned u[4]; uint4 q; u32x4_t x; };
__device__ __forceinline__ void split8(const float (&x)[8], bf16x8_t& hi, bf16x8_t& lo) {
    U8 H, L;
#pragma unroll
    for (int i = 0; i < 4; ++i) {
        const unsigned pk = cvtpk(x[2 * i], x[2 * i + 1]);
        H.u[i] = pk;
        const float f0 = __uint_as_float(pk << 16), f1 = __uint_as_float(pk & 0xffff0000u);
        L.u[i] = cvtpk(x[2 * i] - f0, x[2 * i + 1] - f1);
    }
    hi = H.v; lo = L.v;
}
__device__ __forceinline__ bf16x8_t hi8(const float (&x)[8]) {
    U8 H;
#pragma unroll
    for (int i = 0; i < 4; ++i) H.u[i] = cvtpk(x[2 * i], x[2 * i + 1]);
    return H.v;
}
template <int NSPLIT>
__device__ __forceinline__ f32x4_t mm_tile(const LAS float* A, const LAS float* Bt, int lane, f32x4_t acc) {
    const LAS float* ap = A + (lane & 15) * PT + 8 * (lane >> 4);
    const LAS float* bp = Bt + (lane & 15) * PT + 8 * (lane >> 4);
#pragma unroll
    for (int ks = 0; ks < 2; ++ks) {
        const f32x4_t a0 = *(const LAS f32x4_t*)(ap + 32 * ks), a1 = *(const LAS f32x4_t*)(ap + 32 * ks + 4);
        const f32x4_t b0 = *(const LAS f32x4_t*)(bp + 32 * ks), b1 = *(const LAS f32x4_t*)(bp + 32 * ks + 4);
        const float av[8] = {a0.x, a0.y, a0.z, a0.w, a1.x, a1.y, a1.z, a1.w};
        const float bv[8] = {b0.x, b0.y, b0.z, b0.w, b1.x, b1.y, b1.z, b1.w};
        if constexpr (NSPLIT == 3) {
            bf16x8_t ah, al, bh, bl; split8(av, ah, al); split8(bv, bh, bl);
            acc = __builtin_amdgcn_mfma_f32_16x16x32_bf16(ah, bh, acc, 0, 0, 0);
            acc = __builtin_amdgcn_mfma_f32_16x16x32_bf16(ah, bl, acc, 0, 0, 0);
            acc = __builtin_amdgcn_mfma_f32_16x16x32_bf16(al, bh, acc, 0, 0, 0);
        } else {
            acc = __builtin_amdgcn_mfma_f32_16x16x32_bf16(hi8(av), hi8(bv), acc, 0, 0, 0);
        }
    }
    return acc;
}
__device__ __forceinline__ int opq_tid() { int t = threadIdx.x; asm volatile("" : "+v"(t)); return t; }
__device__ __forceinline__ void tri_inverse_wave(LAS float* L, int lane) {
    asm volatile("" : "+v"(lane));
    asm volatile("" : "+v"(L));
    const float lf = (float)lane;
    float x[64];
#pragma unroll
    for (int i = 0; i < 64; ++i) {
        float s0 = 0.f, s1 = 0.f, s2 = 0.f, s3 = 0.f;
#pragma unroll
        for (int g4 = 0; g4 * 4 < i; ++g4) {
            const f32x4_t l = *(const LAS f32x4_t*)(L + i * PT + 4 * g4);
            s0 = fmaf(l.x, x[4 * g4], s0);
            if (4 * g4 + 1 < i) s1 = fmaf(l.y, x[4 * g4 + 1], s1);
            if (4 * g4 + 2 < i) s2 = fmaf(l.z, x[4 * g4 + 2], s2);
            if (4 * g4 + 3 < i) s3 = fmaf(l.w, x[4 * g4 + 3], s3);
        }
        x[i] = fmaxf(1.f - fabsf(lf - (float)i), 0.f) - ((s0 + s1) + (s2 + s3));
        L[i * PT + lane] = x[i];
        if ((i & 3) == 3) __builtin_amdgcn_sched_barrier(0);
    }
}
__device__ __forceinline__ float wave_incl_scan(float v, int lane) {
#pragma unroll
    for (int o = 1; o < 64; o <<= 1) { const float u = __shfl_up(v, o); if (lane >= o) v += u; }
    return v;
}

__device__ __forceinline__ void unpack8(const uint4 u, float (&o)[8]) {
    const unsigned w[4] = {u.x, u.y, u.z, u.w};
#pragma unroll
    for (int i = 0; i < 4; ++i) { o[2 * i] = __uint_as_float(w[i] << 16); o[2 * i + 1] = __uint_as_float(w[i] & 0xffff0000u); }
}
__device__ __forceinline__ uint4 pack8(const float (&x)[8]) { return make_uint4(cvtpk(x[0], x[1]), cvtpk(x[2], x[3]), cvtpk(x[4], x[5]), cvtpk(x[6], x[7])); }
typedef unsigned short LAS lds_bf16;
constexpr int MIX_LDS_C = 8 * MS * 4 + 1024;
__device__ __forceinline__ void merge_phase(const bf16_t* __restrict__ Yb, const bf16_t* __restrict__ WbT, const bf16_t* __restrict__ G, bf16_t* __restrict__ MG, LAS unsigned char* lds) {
    const int tid = opq_tid(), w = __builtin_amdgcn_readfirstlane(tid >> 6), lane = tid & 63, q4 = lane >> 4, cc = lane & 15;
    const int wr = w >> 2, wc = w & 3;
    constexpr int PA = 144;
    constexpr int ABUF = 128 * PA, BUF = 2 * ABUF;
    const int bid = blockIdx.x, G_ = gridDim.x;
    const int srow = tid >> 2, sk = (tid & 3) * 16;
    for (int it = 0; ; ++it) {
        const int U = it * G_ + bid;
        if (U >= 1024) break;
        const int Lx = (G_ == 256) ? ((bid & 7) * 128 + it * 32 + (bid >> 3)) : U;
        const int pm = Lx >> 3, pn = Lx & 7;
        const bf16_t* Abase = Yb + (size_t)(pm * 128 + srow) * 1024 + sk;
        const bf16_t* Bbase = WbT + (size_t)(pn * 128 + srow) * 256 + sk;
        const bf16_t* gbase = G + (size_t)(pm * 128 + wr * 64 + cc) * 4096 + pn * 128 + wc * 32 + 4 * q4;
        f32x4_t mg[4][2], acc[4][2];
#pragma unroll
        for (int m = 0; m < 4; ++m)
#pragma unroll
            for (int n = 0; n < 2; ++n) mg[m][n] = (f32x4_t){0.f, 0.f, 0.f, 0.f};
        uint4 r0[4], r1[4];
        uint2 gq[4][2];
#define MG_LOAD(R, s_) do { const int br_ = (s_) >> 2, kq_ = (s_) & 3; const bf16_t* ap_ = Abase + br_ * 256 + kq_ * 64; const bf16_t* bp_ = Bbase + (size_t)br_ * 1024 * 256 + kq_ * 64; \
            R[0] = *(const uint4*)ap_; R[1] = *(const uint4*)(ap_ + 8); R[2] = *(const uint4*)bp_; R[3] = *(const uint4*)(bp_ + 8); } while (0)
#define MG_STORE(R, buf_) do { LAS unsigned char* ab_ = lds + (buf_) * BUF + srow * PA + sk * 2; \
            *(LAS u32x4_t*)ab_ = (u32x4_t){R[0].x, R[0].y, R[0].z, R[0].w}; *(LAS u32x4_t*)(ab_ + 16) = (u32x4_t){R[1].x, R[1].y, R[1].z, R[1].w}; \
            *(LAS u32x4_t*)(ab_ + ABUF) = (u32x4_t){R[2].x, R[2].y, R[2].z, R[2].w}; *(LAS u32x4_t*)(ab_ + ABUF + 16) = (u32x4_t){R[3].x, R[3].y, R[3].z, R[3].w}; } while (0)
#define MG_COMPUTE(buf_) do { const LAS unsigned char* ab_ = lds + (buf_) * BUF + (wr * 64 + cc) * PA + 16 * q4; const LAS unsigned char* bb_ = lds + (buf_) * BUF + ABUF + (wc * 32 + cc) * PA + 16 * q4; \
            _Pragma("unroll") for (int ks = 0; ks < 2; ++ks) { U8 bf_[2]; \
                _Pragma("unroll") for (int n = 0; n < 2; ++n) bf_[n].x = *(const LAS u32x4_t*)(bb_ + n * 16 * PA + ks * 64); \
                _Pragma("unroll") for (int m = 0; m < 4; ++m) { U8 af_; af_.x = *(const LAS u32x4_t*)(ab_ + m * 16 * PA + ks * 64); \
                    _Pragma("unroll") for (int n = 0; n < 2; ++n) acc[m][n] = __builtin_amdgcn_mfma_f32_16x16x32_bf16(bf_[n].v, af_.v, acc[m][n], 0, 0, 0); } } } while (0)
#define MG_STEP(s_, RL, RS) do { \
            if (((s_) & 3) == 0) { \
                _Pragma("unroll") for (int m = 0; m < 4; ++m) _Pragma("unroll") for (int n = 0; n < 2; ++n) { acc[m][n] = (f32x4_t){0.f, 0.f, 0.f, 0.f}; \
                    gq[m][n] = *(const uint2*)(gbase + ((s_) >> 2) * 1024 + (size_t)m * 16 * 4096 + n * 16); \
                    if (MEXP == 1) { const uint2 gx_ = *(const uint2*)(gbase + ((((s_) >> 2) + 1) & 3) * 1024 + (size_t)m * 16 * 4096 + n * 16); asm volatile("" :: "v"(gx_.x), "v"(gx_.y)); } } } \
            if ((s_) + 2 < 16) MG_LOAD(RL, (s_) + 2); \
            if (MEXP == 2) { uint4 rx_[4]; MG_LOAD(rx_, ((s_) + 6) & 15); asm volatile("" :: "v"(rx_[0].x), "v"(rx_[1].x), "v"(rx_[2].x), "v"(rx_[3].x)); } \
            MG_COMPUTE((s_) & 1); \
            if (MEXP == 3) { f32x4_t sv_[4][2]; _Pragma("unroll") for (int m = 0; m < 4; ++m) _Pragma("unroll") for (int n = 0; n < 2; ++n) sv_[m][n] = acc[m][n]; MG_COMPUTE((s_) & 1); \
                _Pragma("unroll") for (int m = 0; m < 4; ++m) _Pragma("unroll") for (int n = 0; n < 2; ++n) { asm volatile("" :: "v"(acc[m][n])); acc[m][n] = sv_[m][n]; } } \
            if (((s_) & 3) == 3) { \
                _Pragma("unroll") for (int m = 0; m < 4; ++m) _Pragma("unroll") for (int n = 0; n < 2; ++n) { const uint2 g2_ = gq[m][n]; \
                    mg[m][n][0] = fmaf(__uint_as_float(g2_.x << 16), acc[m][n][0], mg[m][n][0]); mg[m][n][1] = fmaf(__uint_as_float(g2_.x & 0xffff0000u), acc[m][n][1], mg[m][n][1]); \
                    mg[m][n][2] = fmaf(__uint_as_float(g2_.y << 16), acc[m][n][2], mg[m][n][2]); mg[m][n][3] = fmaf(__uint_as_float(g2_.y & 0xffff0000u), acc[m][n][3], mg[m][n][3]); } } \
            if ((s_) + 1 < 16) MG_STORE(RS, ((s_) + 1) & 1); \
            BAR(); } while (0)
        MG_LOAD(r0, 0); MG_LOAD(r1, 1);
        MG_STORE(r0, 0);
        BAR();
#pragma unroll 1
        for (int s2 = 0; s2 < 16; s2 += 2) {
            MG_STEP(s2, r0, r1);
            MG_STEP(s2 + 1, r1, r0);
        }
        {
            bf16_t* op = MG + (size_t)(pm * 128 + wr * 64 + cc) * 1024 + pn * 128 + wc * 32 + 4 * q4;
#pragma unroll
            for (int m = 0; m < 4; ++m)
#pragma unroll
                for (int n = 0; n < 2; ++n) *(uint2*)(op + (size_t)m * 16 * 1024 + n * 16) = make_uint2(cvtpk(mg[m][n][0], mg[m][n][1]), cvtpk(mg[m][n][2], mg[m][n][3]));
        }
#undef MG_LOAD
#undef MG_STORE
#undef MG_COMPUTE
#undef MG_STEP
    }
}

constexpr int PB = 72;
constexpr int PLBYTES = 64 * PB * 2;
typedef unsigned u32x2_t __attribute__((ext_vector_type(2)));
__device__ __forceinline__ lds_bf16* plane(LAS unsigned char* lds, int i) { return (lds_bf16*)(lds + i * PLBYTES); }
__device__ __forceinline__ void hilo2(float a, float b, unsigned& h, unsigned& l) { h = cvtpk(a, b); l = cvtpk(a - __uint_as_float(h << 16), b - __uint_as_float(h & 0xffff0000u)); }
__device__ __forceinline__ unsigned short bf_hi(float v) { return (unsigned short)(cvtpk(v, 0.f) & 0xffffu); }
template <bool LO>
__device__ __forceinline__ void put8(lds_bf16* Ph, lds_bf16* Pl, int r, int c0, const float (&x)[8]) {
    unsigned h[4], l[4];
#pragma unroll
    for (int i = 0; i < 4; ++i) hilo2(x[2 * i], x[2 * i + 1], h[i], l[i]);
    *(LAS u32x4_t*)(Ph + r * PB + c0) = (u32x4_t){h[0], h[1], h[2], h[3]};
    if (LO) *(LAS u32x4_t*)(Pl + r * PB + c0) = (u32x4_t){l[0], l[1], l[2], l[3]};
}
template <bool LO>
__device__ __forceinline__ void put8T(lds_bf16* Ph, lds_bf16* Pl, int r, int c0, const float (&x)[8]) {
#pragma unroll
    for (int i = 0; i < 4; ++i) {
        unsigned h, l; hilo2(x[2 * i], x[2 * i + 1], h, l);
        Ph[(c0 + 2 * i) * PB + r] = (unsigned short)(h & 0xffffu); Ph[(c0 + 2 * i + 1) * PB + r] = (unsigned short)(h >> 16);
        if (LO) { Pl[(c0 + 2 * i) * PB + r] = (unsigned short)(l & 0xffffu); Pl[(c0 + 2 * i + 1) * PB + r] = (unsigned short)(l >> 16); }
    }
}
__device__ __forceinline__ bf16x8_t frag(const lds_bf16* P, int row, int k) { U8 u; u.x = *(const LAS u32x4_t*)(P + row * PB + k); return u.v; }
template <bool AL, bool BL>
__device__ __forceinline__ f32x4_t mmp(const lds_bf16* Ah, const lds_bf16* Al, const lds_bf16* Bh, const lds_bf16* Bl, int ar0, int br0, int lane, f32x4_t acc) {
    const int r = lane & 15, k0 = 8 * (lane >> 4);
#pragma unroll
    for (int ks = 0; ks < 2; ++ks) {
        const bf16x8_t ah = frag(Ah, ar0 + r, 32 * ks + k0), bh = frag(Bh, br0 + r, 32 * ks + k0);
        acc = __builtin_amdgcn_mfma_f32_16x16x32_bf16(ah, bh, acc, 0, 0, 0);
        if (AL) acc = __builtin_amdgcn_mfma_f32_16x16x32_bf16(frag(Al, ar0 + r, 32 * ks + k0), bh, acc, 0, 0, 0);
        if (BL) acc = __builtin_amdgcn_mfma_f32_16x16x32_bf16(ah, frag(Bl, br0 + r, 32 * ks + k0), acc, 0, 0, 0);
    }
    return acc;
}
template <bool LO>
__device__ __forceinline__ void st_tile_T(lds_bf16* Ph, lds_bf16* Pl, int i0, int j0, int lane, const f32x4_t a) {
    unsigned h0, l0, h1, l1; hilo2(a[0], a[1], h0, l0); hilo2(a[2], a[3], h1, l1);
    const int o = (j0 + (lane & 15)) * PB + i0 + 4 * (lane >> 4);
    *(LAS u32x2_t*)(Ph + o) = (u32x2_t){h0, h1};
    if (LO) *(LAS u32x2_t*)(Pl + o) = (u32x2_t){l0, l1};
}
template <bool LO>
__device__ __forceinline__ void st_tile_R(lds_bf16* Ph, lds_bf16* Pl, int i0, int j0, int lane, const f32x4_t a) {
    unsigned h0, l0, h1, l1; hilo2(a[0], a[1], h0, l0); hilo2(a[2], a[3], h1, l1);
    const int o = (i0 + 4 * (lane >> 4)) * PB + j0 + (lane & 15);
    Ph[o] = (unsigned short)(h0 & 0xffffu); Ph[o + PB] = (unsigned short)(h0 >> 16); Ph[o + 2 * PB] = (unsigned short)(h1 & 0xffffu); Ph[o + 3 * PB] = (unsigned short)(h1 >> 16);
    if (LO) { Pl[o] = (unsigned short)(l0 & 0xffffu); Pl[o + PB] = (unsigned short)(l0 >> 16); Pl[o + 2 * PB] = (unsigned short)(l1 & 0xffffu); Pl[o + 3 * PB] = (unsigned short)(l1 >> 16); }
}
constexpr int LM_OFF = 13 * PLBYTES;
constexpr int VEC_OFF = LM_OFF + MS * 4;
static_assert(VEC_OFF + 1024 <= MIX_LDS_C, "plane LDS map");

struct GdnBufs { bf16_t *GQ, *GK, *GV; float *GB, *GC; uint4* MF; float* NF; float* HT; bf16_t* TG; };
__device__ __forceinline__ void gdn_prep_chunk(const bf16_t* __restrict__ PM, int n, const GdnBufs& B, const Params& p, int l, LAS float* lds) {
    const int tid = opq_tid(), w = tid >> 6, lane = tid & 63;
    const float* conv_w = p.in[3] + l * 4 * 768;
    const int t0 = n * 64;
    float wq[4][4], wk[4][4], wv[4][4];
#pragma unroll
    for (int t = 0; t < 4; ++t)
#pragma unroll
        for (int j = 0; j < 4; ++j) { wq[t][j] = conv_w[t * 768 + 4 * lane + j]; wk[t][j] = conv_w[t * 768 + 256 + 4 * lane + j]; wv[t][j] = conv_w[t * 768 + 512 + 4 * lane + j]; }
    float hq[3][4], hk[3][4], hv[3][4];
    auto ld4 = [&](int t, int col, float (&o)[4]) {
        if (t < 0) { o[0] = o[1] = o[2] = o[3] = 0.f; return; }
        const uint2 u = *(const uint2*)(PM + (size_t)t * PMLD + col);
        o[0] = __uint_as_float(u.x << 16); o[1] = __uint_as_float(u.x & 0xffff0000u); o[2] = __uint_as_float(u.y << 16); o[3] = __uint_as_float(u.y & 0xffff0000u);
    };
    const int tw = t0 + 8 * w;
#pragma unroll
    for (int i = 0; i < 3; ++i) { ld4(tw - 3 + i, 4 * lane, hq[i]); ld4(tw - 3 + i, 256 + 4 * lane, hk[i]); ld4(tw - 3 + i, 512 + 4 * lane, hv[i]); }
#pragma unroll
    for (int i = 0; i < 8; ++i) {
        const int t = tw + i;
        float pq[4], pk[4], pv[4], q[4], k[4], v[4];
        ld4(t, 4 * lane, pq); ld4(t, 256 + 4 * lane, pk); ld4(t, 512 + 4 * lane, pv);
        float sq = 0.f, sk = 0.f;
#pragma unroll
        for (int j = 0; j < 4; ++j) {
            q[j] = siluf_(wq[0][j] * hq[0][j] + wq[1][j] * hq[1][j] + wq[2][j] * hq[2][j] + wq[3][j] * pq[j]);
            k[j] = siluf_(wk[0][j] * hk[0][j] + wk[1][j] * hk[1][j] + wk[2][j] * hk[2][j] + wk[3][j] * pk[j]);
            v[j] = siluf_(wv[0][j] * hv[0][j] + wv[1][j] * hv[1][j] + wv[2][j] * hv[2][j] + wv[3][j] * pv[j]);
            hq[0][j] = hq[1][j]; hq[1][j] = hq[2][j]; hq[2][j] = pq[j];
            hk[0][j] = hk[1][j]; hk[1][j] = hk[2][j]; hk[2][j] = pk[j];
            hv[0][j] = hv[1][j]; hv[1][j] = hv[2][j]; hv[2][j] = pv[j];
            sq = fmaf(q[j], q[j], sq); sk = fmaf(k[j], k[j], sk);
        }
#pragma unroll
        for (int o = 1; o < 16; o <<= 1) { sq += __shfl_xor(sq, o); sk += __shfl_xor(sk, o); }
        const float rq = rsqrtf(sq + 1e-6f) * 0.125f, rk = rsqrtf(sk + 1e-6f);
        uint2 oq, ok, ov;
        oq.x = cvtpk(q[0] * rq, q[1] * rq); oq.y = cvtpk(q[2] * rq, q[3] * rq);
        ok.x = cvtpk(k[0] * rk, k[1] * rk); ok.y = cvtpk(k[2] * rk, k[3] * rk);
        ov.x = cvtpk(v[0], v[1]); ov.y = cvtpk(v[2], v[3]);
        *(uint2*)(B.GQ + (size_t)t * 256 + 4 * lane) = oq;
        *(uint2*)(B.GK + (size_t)t * 256 + 4 * lane) = ok;
        *(uint2*)(B.GV + (size_t)t * 256 + 4 * lane) = ov;
    }
    if (tid < 256) {
        const int t = tid >> 2, h = tid & 3;
        const bf16_t* row = PM + (size_t)(t0 + t) * PMLD;
        B.GB[(size_t)(t0 + t) * 4 + h] = sigmoidf_(bf2f(row[1024 + h]));
        const float* alog_ = p.in[4] + l * 4; const float* dtb_ = p.in[5] + l * 4;
        const float g = -__expf(alog_[h]) * softplusf_(bf2f(row[1028 + h]) + dtb_[h]);
        lds[h * 64 + t] = g;
    }
    BAR();
    if (w == 0) {
#pragma unroll
        for (int h = 0; h < 4; ++h) B.GC[(size_t)(t0 + lane) * 4 + h] = wave_incl_scan(lds[h * 64 + lane], lane);
    }
    BAR();
}

__device__ __forceinline__ float dpp_xor1(float v) { return __int_as_float(__builtin_amdgcn_update_dpp(0, __float_as_int(v), 0xB1, 0xF, 0xF, false)); }
__device__ __forceinline__ float dpp_xor2(float v) { return __int_as_float(__builtin_amdgcn_update_dpp(0, __float_as_int(v), 0x4E, 0xF, 0xF, false)); }
__device__ __forceinline__ void tri_inverse_4w(const LAS float* Lp, lds_bf16* Th, lds_bf16* Tl, int wq, int lane) {
    asm volatile("" : "+v"(lane));
    const int g = lane & 3, j = 16 * wq + (lane >> 2);
    const LAS float* base = Lp + g * 16; asm volatile("" : "+v"(base));
    const float jf = (float)j;
    float x[16];
#pragma unroll
    for (int m = 0; m < 16; ++m) x[m] = 0.f;
    f32x4_t cur[4], nxt[4];
#pragma unroll
    for (int q = 0; q < 4; ++q) cur[q] = (f32x4_t){0.f, 0.f, 0.f, 0.f};
#pragma unroll
    for (int i = 0; i < 64; ++i) {
        if (i + 1 < 64) {
#pragma unroll
            for (int q = 0; q < 4; ++q) if (16 * q < i + 1) nxt[q] = *(const LAS f32x4_t*)(base + (i + 1) * PT + 4 * q);
        }
        float s0 = 0.f, s1 = 0.f;
#pragma unroll
        for (int q = 0; q < 4; ++q) if (16 * q < i) {
            s0 = fmaf(cur[q].x, x[4 * q], s0); if (16 * q + 4 < i) s1 = fmaf(cur[q].y, x[4 * q + 1], s1);
            if (16 * q + 8 < i) s0 = fmaf(cur[q].z, x[4 * q + 2], s0); if (16 * q + 12 < i) s1 = fmaf(cur[q].w, x[4 * q + 3], s1);
        }
        float t = s0 + s1;
        t += dpp_xor1(t); t += dpp_xor2(t);
        const float xi = fmaxf(1.f - fabsf(jf - (float)i), 0.f) - t;
        if (g == (i & 3)) x[i >> 2] = xi;
        unsigned hh, ll; hilo2(xi, xi, hh, ll);
        if (g == 0) Th[i * PB + j] = (unsigned short)(hh & 0xffffu);
        if (g == 1) Tl[i * PB + j] = (unsigned short)(ll & 0xffffu);
#pragma unroll
        for (int q = 0; q < 4; ++q) cur[q] = nxt[q];
    }
}
__device__ __forceinline__ void gdn_g1_unit(int h, int n, const GdnBufs& B, bf16_t* __restrict__ Y, LAS unsigned char* lds) {
    const int tid = opq_tid(), w = tid >> 6, lane = tid & 63, q4 = lane >> 4, cc = lane & 15;
    lds_bf16 *Krh = plane(lds, 0), *Krl = plane(lds, 1), *KdTh = plane(lds, 2), *KdTl = plane(lds, 3), *KbTh = plane(lds, 4), *KbTl = plane(lds, 5);
    lds_bf16 *VbTh = plane(lds, 6), *VbTl = plane(lds, 7), *Th = plane(lds, 8), *Tl = plane(lds, 9), *WmTh = plane(lds, 10), *WmTl = plane(lds, 11);
    lds_bf16 *U0Th = Krh, *U0Tl = Krl;
    LAS float* Lm = (LAS float*)(lds + LM_OFF); LAS float* sb = (LAS float*)(lds + VEC_OFF); LAS float* sg = sb + 64;
    const int t0 = n * 64, u = h * 256 + n;
    const int c = tid >> 3, d0 = (tid & 7) * 8;
    {
        const float beta = B.GB[(size_t)(t0 + c) * 4 + h], gc = B.GC[(size_t)(t0 + c) * 4 + h], gl = B.GC[(size_t)(t0 + 63) * 4 + h];
        float kf[8], vf[8], x1[8], x2[8], x3[8];
        unpack8(*(const uint4*)(B.GK + (size_t)(t0 + c) * 256 + h * 64 + d0), kf);
        unpack8(*(const uint4*)(B.GV + (size_t)(t0 + c) * 256 + h * 64 + d0), vf);
        const float e1 = __expf(gl - gc), e2 = beta * __expf(gc);
#pragma unroll
        for (int i = 0; i < 8; ++i) { x1[i] = kf[i] * e1; x2[i] = kf[i] * e2; x3[i] = beta * vf[i]; }
        put8<true>(Krh, Krl, c, d0, kf); put8T<true>(KdTh, KdTl, c, d0, x1); put8T<true>(KbTh, KbTl, c, d0, x2); put8T<true>(VbTh, VbTl, c, d0, x3);
        if ((tid & 7) == 0) { sb[c] = beta; sg[c] = gc; }
    }
    BAR();
    const int ti = w >> 1, tj0 = (w & 1) * 2;
    const f32x4_t zero4 = {0.f, 0.f, 0.f, 0.f};
#pragma unroll
    for (int tt = 0; tt < 2; ++tt) {
        const int tj = tj0 + tt;
        const int j = 16 * tj + cc, jp = (j & 3) * 16 + (j >> 2);
        f32x4_t lv = zero4;
        if (tj <= ti) {
            const f32x4_t a = mmp<true, true>(Krh, Krl, Krh, Krl, 16 * ti, 16 * tj, lane, zero4);
            const float gj = sg[j];
#pragma unroll
            for (int r = 0; r < 4; ++r) { const int i = 16 * ti + 4 * q4 + r; lv[r] = (i > j) ? sb[i] * a[r] * __expf(sg[i] - gj) : 0.f; }
        }
#pragma unroll
        for (int r = 0; r < 4; ++r) Lm[(16 * ti + 4 * q4 + r) * PT + jp] = lv[r];
    }
    BAR();
    if (w < 4) tri_inverse_4w(Lm, Th, Tl, w, lane);
    BAR();
    { const u32x4_t t4 = *(const LAS u32x4_t*)(Th + c * PB + d0); *(uint4*)(B.TG + (size_t)u * 4096 + c * 64 + d0) = make_uint4(t4.x, t4.y, t4.z, t4.w);
      const u32x4_t t5 = *(const LAS u32x4_t*)(Tl + c * PB + d0); *(uint4*)(Y + (size_t)(t0 + c) * D + h * 64 + d0) = make_uint4(t5.x, t5.y, t5.z, t5.w); }
#pragma unroll
    for (int tt = 0; tt < 2; ++tt) {
        const int tj = tj0 + tt;
        st_tile_T<true>(U0Th, U0Tl, 16 * ti, 16 * tj, lane, mmp<true, true>(Th, Tl, VbTh, VbTl, 16 * ti, 16 * tj, lane, zero4));
        st_tile_T<true>(WmTh, WmTl, 16 * ti, 16 * tj, lane, mmp<true, true>(Th, Tl, KbTh, KbTl, 16 * ti, 16 * tj, lane, zero4));
    }
    BAR();
    {
        const float egl = __expf(B.GC[(size_t)(t0 + 63) * 4 + h]);
#pragma unroll
        for (int tt = 0; tt < 2; ++tt) {
            const int tj = tj0 + tt;
            const f32x4_t a = mmp<true, true>(KdTh, KdTl, WmTh, WmTl, 16 * ti, 16 * tj, lane, zero4);
#pragma unroll
            for (int r = 0; r < 4; ++r) { const int ar = 16 * ti + 4 * q4 + r, bc = 16 * tj + cc; Lm[ar * PT + bc] = (ar == bc ? egl : 0.f) - a[r]; }
            const f32x4_t nn = mmp<true, true>(KdTh, KdTl, U0Th, U0Tl, 16 * ti, 16 * tj, lane, zero4);
            *(float4*)(B.NF + (size_t)u * 4096 + (tj * 64 + lane) * 16 + ti * 4) = make_float4(nn[0], nn[1], nn[2], nn[3]);
        }
    }
    BAR();
    {
        const int combo = tid >> 6, mt = combo >> 1, s = combo & 1, i = lane & 15, qq = lane >> 4;
        const f32x4_t x0 = *(const LAS f32x4_t*)(Lm + (16 * mt + i) * PT + 32 * s + 4 * qq);
        const f32x4_t x1 = *(const LAS f32x4_t*)(Lm + (16 * mt + i) * PT + 32 * s + 16 + 4 * qq);
        const float xv[8] = {x0.x, x0.y, x0.z, x0.w, x1.x, x1.y, x1.z, x1.w};
        U8 H, L; split8(xv, H.v, L.v);
        uint4* mf = B.MF + (size_t)u * 1024 + (size_t)(combo * 2) * 64 + lane;
        mf[0] = H.q; mf[64] = L.q;
    }
    BAR();
}

constexpr int CH_SLOT = 20480, CH_RING = 6;
__device__ __forceinline__ void chain_wave(float* __restrict__ HT, int cb, int nchunk, int lane, LAS unsigned char* ring, volatile LAS unsigned* flags  ) {
    const int q4 = lane >> 4, cc = lane & 15;
    f32x4_t H[4];
#pragma unroll
    for (int m = 0; m < 4; ++m) H[m] = (f32x4_t){0.f, 0.f, 0.f, 0.f};
    U8 mf[16]; f32x4_t nf[4];
    {
        while (flags[0] != 1u) __builtin_amdgcn_s_sleep(1);
        asm volatile("" ::: "memory");
        const LAS unsigned char* sp = ring + lane * 16;
#pragma unroll
        for (int i = 0; i < 16; ++i) mf[i].x = *(const LAS u32x4_t*)(sp + i * 1024);
#pragma unroll
        for (int m = 0; m < 4; ++m) nf[m] = *(const LAS f32x4_t*)(sp + (16 + m) * 1024);
        asm volatile("s_waitcnt lgkmcnt(0)" ::: "memory");
        if (lane == 0) flags[8] = 1u;
    }
    for (int ch = 0; ch < nchunk; ++ch) {
        float* ht = HT + (size_t)ch * 4096 + (16 * cb + cc) * 64 + 4 * q4;
#pragma unroll
        for (int m = 0; m < 4; ++m) *(float4*)(ht + 16 * m) = make_float4(H[m][0], H[m][1], H[m][2], H[m][3]);
        bf16x8_t bh[2], bl[2];
#pragma unroll
        for (int s = 0; s < 2; ++s) {
            const float xv[8] = {H[2 * s][0], H[2 * s][1], H[2 * s][2], H[2 * s][3], H[2 * s + 1][0], H[2 * s + 1][1], H[2 * s + 1][2], H[2 * s + 1][3]};
            split8(xv, bh[s], bl[s]);
        }
#pragma unroll
        for (int m = 0; m < 4; ++m) {
            f32x4_t acc = nf[m];
#pragma unroll
            for (int s = 0; s < 2; ++s) {
                acc = __builtin_amdgcn_mfma_f32_16x16x32_bf16(mf[(m * 2 + s) * 2].v, bh[s], acc, 0, 0, 0);
                acc = __builtin_amdgcn_mfma_f32_16x16x32_bf16(mf[(m * 2 + s) * 2].v, bl[s], acc, 0, 0, 0);
                acc = __builtin_amdgcn_mfma_f32_16x16x32_bf16(mf[(m * 2 + s) * 2 + 1].v, bh[s], acc, 0, 0, 0);
            }
            H[m] = acc;
        }
        if (ch + 1 < nchunk) {
            const int slot = (ch + 1) % CH_RING;
            while (flags[slot] != (unsigned)(ch + 2)) __builtin_amdgcn_s_sleep(1);
            asm volatile("" ::: "memory");
            const LAS unsigned char* sp = ring + slot * CH_SLOT + lane * 16;
#pragma unroll
            for (int i = 0; i < 16; ++i) mf[i].x = *(const LAS u32x4_t*)(sp + i * 1024);
#pragma unroll
            for (int m = 0; m < 4; ++m) nf[m] = *(const LAS f32x4_t*)(sp + (16 + m) * 1024);
            asm volatile("s_waitcnt lgkmcnt(0)" ::: "memory");
            if (lane == 0) flags[8] = (unsigned)(ch + 2);
        }
    }
}
__device__ __forceinline__ void chain_loader(const uint4* __restrict__ MF, const float* __restrict__ NF, int cb, int nchunk, int lane, int lw, LAS unsigned char* ring, volatile LAS unsigned* flags) {
    for (int ch = lw; ch < nchunk; ch += 7) {
        uint4 m[16]; float4 nn[4];
#pragma unroll
        for (int i = 0; i < 16; ++i) m[i] = MF[(size_t)ch * 1024 + (size_t)i * 64 + lane];
#pragma unroll
        for (int k = 0; k < 4; ++k) nn[k] = *(const float4*)(NF + (size_t)ch * 4096 + (cb * 64 + lane) * 16 + k * 4);
        while ((int)flags[8] + CH_RING <= ch) __builtin_amdgcn_s_sleep(2);
        asm volatile("" ::: "memory");
        LAS unsigned char* sp = ring + (ch % CH_RING) * CH_SLOT + lane * 16;
#pragma unroll
        for (int i = 0; i < 16; ++i) *(LAS u32x4_t*)(sp + i * 1024) = (u32x4_t){m[i].x, m[i].y, m[i].z, m[i].w};
#pragma unroll
        for (int k = 0; k < 4; ++k) *(LAS f32x4_t*)(sp + (16 + k) * 1024) = (f32x4_t){nn[k].x, nn[k].y, nn[k].z, nn[k].w};
        asm volatile("s_waitcnt lgkmcnt(0)" ::: "memory");
        if (lane == 0) flags[ch % CH_RING] = (unsigned)(ch + 1);
    }
}

__device__ __forceinline__ void gdn_g3_unit(int h, int n, const GdnBufs& B, const bf16_t* __restrict__ PM, bf16_t* __restrict__ Y, const float* __restrict__ norm_g, LAS unsigned char* lds) {
    const int tid = opq_tid(), w = tid >> 6, lane = tid & 63, q4 = lane >> 4, cc = lane & 15;
    lds_bf16 *Qr = plane(lds, 0), *Qd = plane(lds, 1), *Kr = plane(lds, 2), *KbT = plane(lds, 3), *VbT = plane(lds, 4), *Tp = plane(lds, 5);
    lds_bf16 *At = plane(lds, 6), *Wm = plane(lds, 7), *HTh = plane(lds, 8), *HTl = plane(lds, 9), *VnT = plane(lds, 10), *Tq = plane(lds, 11);
    LAS float* Os = (LAS float*)(lds + LM_OFF); LAS float* sb = (LAS float*)(lds + VEC_OFF); LAS float* sg = sb + 64;
    const int t0 = n * 64, u = h * 256 + n;
    const int c = tid >> 3, d0 = (tid & 7) * 8;
    {
        const float beta = B.GB[(size_t)(t0 + c) * 4 + h], gc = B.GC[(size_t)(t0 + c) * 4 + h];
        float qf[8], kf[8], vf[8], x1[8], x2[8], x3[8];
        unpack8(*(const uint4*)(B.GQ + (size_t)(t0 + c) * 256 + h * 64 + d0), qf);
        unpack8(*(const uint4*)(B.GK + (size_t)(t0 + c) * 256 + h * 64 + d0), kf);
        unpack8(*(const uint4*)(B.GV + (size_t)(t0 + c) * 256 + h * 64 + d0), vf);
        const uint4 t8 = *(const uint4*)(B.TG + (size_t)u * 4096 + c * 64 + d0);
        const uint4 t9 = *(const uint4*)(Y + (size_t)(t0 + c) * D + h * 64 + d0);
        const float* ht = B.HT + (size_t)u * 4096 + c * 64 + d0;
        const float4 h0 = *(const float4*)ht, h1 = *(const float4*)(ht + 4);
        const float eg = __expf(gc), e2 = beta * eg;
#pragma unroll
        for (int i = 0; i < 8; ++i) { x1[i] = qf[i] * eg; x2[i] = kf[i] * e2; x3[i] = beta * vf[i]; }
        put8<false>(Qr, Qr, c, d0, qf); put8<false>(Qd, Qd, c, d0, x1); put8<false>(Kr, Kr, c, d0, kf);
        put8T<false>(KbT, KbT, c, d0, x2); put8T<false>(VbT, VbT, c, d0, x3);
        *(LAS u32x4_t*)(Tp + c * PB + d0) = (u32x4_t){t8.x, t8.y, t8.z, t8.w};
        *(LAS u32x4_t*)(Tq + c * PB + d0) = (u32x4_t){t9.x, t9.y, t9.z, t9.w};
        const float hv[8] = {h0.x, h0.y, h0.z, h0.w, h1.x, h1.y, h1.z, h1.w};
        put8<true>(HTh, HTl, c, d0, hv);
        if ((tid & 7) == 0) { sb[c] = beta; sg[c] = gc; }
    }
    BAR();
    const int ti = w >> 1, tj0 = (w & 1) * 2;
    const f32x4_t zero4 = {0.f, 0.f, 0.f, 0.f};
    f32x4_t u0[2];
#pragma unroll
    for (int tt = 0; tt < 2; ++tt) {
        const int tj = tj0 + tt;
        f32x4_t at = zero4;
        if (tj <= ti) {
            const f32x4_t s = mmp<false, false>(Qr, Qr, Kr, Kr, 16 * ti, 16 * tj, lane, zero4);
            const int j = 16 * tj + cc; const float gj = sg[j];
#pragma unroll
            for (int r = 0; r < 4; ++r) { const int i = 16 * ti + 4 * q4 + r; at[r] = (i >= j) ? s[r] * __expf(fminf(sg[i] - gj, 0.f)) : 0.f; }
        }
        st_tile_R<false>(At, At, 16 * ti, 16 * tj, lane, at);
        u0[tt] = mmp<true, false>(Tp, Tq, VbT, VbT, 16 * ti, 16 * tj, lane, zero4);
        st_tile_R<false>(Wm, Wm, 16 * ti, 16 * tj, lane, mmp<true, false>(Tp, Tq, KbT, KbT, 16 * ti, 16 * tj, lane, zero4));
    }
    BAR();
    f32x4_t o[2];
#pragma unroll
    for (int tt = 0; tt < 2; ++tt) {
        const int tj = tj0 + tt;
        const f32x4_t wh = mmp<false, true>(Wm, Wm, HTh, HTl, 16 * ti, 16 * tj, lane, zero4);
        o[tt] = mmp<false, true>(Qd, Qd, HTh, HTl, 16 * ti, 16 * tj, lane, zero4);
        st_tile_T<false>(VnT, VnT, 16 * ti, 16 * tj, lane, u0[tt] - wh);
    }
    BAR();
#pragma unroll
    for (int tt = 0; tt < 2; ++tt) {
        const int tj = tj0 + tt;
        o[tt] = mmp<false, false>(At, At, VnT, VnT, 16 * ti, 16 * tj, lane, o[tt]);
#pragma unroll
        for (int r = 0; r < 4; ++r) Os[(16 * ti + 4 * q4 + r) * PT + 16 * tj + cc] = o[tt][r];
    }
    BAR();
    {
        const f32x4_t x0 = *(const LAS f32x4_t*)(Os + c * PT + d0), x1 = *(const LAS f32x4_t*)(Os + c * PT + d0 + 4);
        float xv[8] = {x0.x, x0.y, x0.z, x0.w, x1.x, x1.y, x1.z, x1.w};
        float ss = 0.f;
#pragma unroll
        for (int i = 0; i < 8; ++i) ss = fmaf(xv[i], xv[i], ss);
        ss += __shfl_xor(ss, 1); ss += __shfl_xor(ss, 2); ss += __shfl_xor(ss, 4);
        const float rs = rsqrtf(ss * (1.f / 64.f) + 1e-6f);
        float zf[8]; unpack8(*(const uint4*)(PM + (size_t)(t0 + c) * PMLD + 768 + h * 64 + d0), zf);
        float y[8];
#pragma unroll
        for (int i = 0; i < 8; ++i) y[i] = xv[i] * rs * norm_g[d0 + i] * siluf_(zf[i]);
        *(uint4*)(Y + (size_t)(t0 + c) * D + h * 64 + d0) = pack8(y);
    }
    BAR();
}

struct RwkvBufs { bf16_t *RR, *RK, *RV, *RKK, *RA, *RG; float* CW; uint4* MF; float* NF; float* HT; bf16_t* TG; };
__device__ __forceinline__ void rwkv_prep_chunk(const bf16_t* __restrict__ PM, int n, const RwkvBufs& B, const Params& p, int l, const bf16_t* __restrict__ WUPT, const bf16_t* __restrict__ AUPT, const bf16_t* __restrict__ GUPT, LAS unsigned char* lds) {
    const int tid = opq_tid(), w = tid >> 6, lane = tid & 63, q4 = lane >> 4, cc = lane & 15;
    const int t0 = n * 64;
    const float* mu = p.in[24] + l * 1024;
    lds_bf16* Awd = (lds_bf16*)lds; lds_bf16* Aad = Awd + 64 * 72; lds_bf16* Agd = Aad + 64 * 72;
    lds_bf16* La = Agd + 64 * 136; lds_bf16* Lg = La + 64 * 264; lds_bf16* Llw = Lg + 64 * 264;
    for (int px1_ = 0; px1_ < ((PEXP == 1) ? 2 : 1); ++px1_)
    {
        const int t = tid >> 3, c0 = (tid & 7) * 8;
        const bf16_t* row = PM + (size_t)(t0 + t) * PMLD + C_RWKV + 768 + c0;
        const bool hasprev = (t0 + t) > 0;
#pragma unroll
        for (int g8 = 0; g8 < 4; ++g8) {
            float x[8], xp[8];
            unpack8(*(const uint4*)(row + 64 * g8), x);
            if (hasprev) unpack8(*(const uint4*)(row - PMLD + 64 * g8), xp); else {
#pragma unroll
                for (int i = 0; i < 8; ++i) xp[i] = 0.f; }
            const int col = c0 + 64 * g8;
            float y[8];
#pragma unroll
            for (int i = 0; i < 8; ++i) {
                const float v = x[i] + mu[768 + col + i] * (xp[i] - x[i]);
                y[i] = col < 64 ? tanhf_(v) : (col < 128 ? v : sigmoidf_(v));
            }
            const uint4 pk = pack8(y);
            if (col < 64) *(LAS u32x4_t*)(Awd + t * 72 + col) = (u32x4_t){pk.x, pk.y, pk.z, pk.w};
            else if (col < 128) *(LAS u32x4_t*)(Aad + t * 72 + (col - 64)) = (u32x4_t){pk.x, pk.y, pk.z, pk.w};
            else *(LAS u32x4_t*)(Agd + t * 136 + (col - 128)) = (u32x4_t){pk.x, pk.y, pk.z, pk.w};
        }
    }
    BAR();
    const int hh = w >> 1, tt0 = 2 * (w & 1);
    for (int px2_ = 0; px2_ < ((PEXP == 2) ? 2 : 1); ++px2_)
    {
        const float* w0 = p.in[25] + l * W; const float* a0 = p.in[27] + l * W;
#pragma unroll 2
        for (int b = 0; b < 4; ++b) {
            const int ncol = 64 * hh + 16 * b + cc;
            f32x4_t accw[2], acca[2], accg[2];
#pragma unroll
            for (int a = 0; a < 2; ++a) { accw[a] = (f32x4_t){0.f, 0.f, 0.f, 0.f}; acca[a] = accw[a]; accg[a] = accw[a]; }
#pragma unroll
            for (int ks = 0; ks < 4; ++ks) {
                U8 bw, ba, bg;
                bg.q = *(const uint4*)(GUPT + (size_t)ncol * 128 + 32 * ks + 8 * q4);
                if (ks < 2) { bw.q = *(const uint4*)(WUPT + (size_t)ncol * 64 + 32 * ks + 8 * q4); ba.q = *(const uint4*)(AUPT + (size_t)ncol * 64 + 32 * ks + 8 * q4); }
#pragma unroll
                for (int a = 0; a < 2; ++a) {
                    const int row = 16 * (tt0 + a) + cc;
                    U8 ag; ag.x = *(const LAS u32x4_t*)(Agd + row * 136 + 32 * ks + 8 * q4);
                    accg[a] = __builtin_amdgcn_mfma_f32_16x16x32_bf16(ag.v, bg.v, accg[a], 0, 0, 0);
                    if (ks < 2) {
                        U8 aw, aa; aw.x = *(const LAS u32x4_t*)(Awd + row * 72 + 32 * ks + 8 * q4); aa.x = *(const LAS u32x4_t*)(Aad + row * 72 + 32 * ks + 8 * q4);
                        accw[a] = __builtin_amdgcn_mfma_f32_16x16x32_bf16(aw.v, bw.v, accw[a], 0, 0, 0);
                        acca[a] = __builtin_amdgcn_mfma_f32_16x16x32_bf16(aa.v, ba.v, acca[a], 0, 0, 0);
                    }
                }
            }
            const float w0n = w0[ncol], a0n = a0[ncol];
#pragma unroll
            for (int a = 0; a < 2; ++a)
#pragma unroll
                for (int r = 0; r < 4; ++r) {
                    const int t = 16 * (tt0 + a) + 4 * q4 + r;
                    const float logw = -softplusf_(-(w0n + accw[a][r])) - 0.5f;
                    Llw[t * 264 + ncol] = (unsigned short)f2bf(-__expf(logw));
                    La[t * 264 + ncol] = (unsigned short)f2bf(sigmoidf_(a0n + acca[a][r]));
                    Lg[t * 264 + ncol] = (unsigned short)f2bf(accg[a][r]);
                }
        }
    }
    BAR();
    {
        const int t = tid >> 3, j8 = (tid & 7) * 8;
        const bf16_t* row = PM + (size_t)(t0 + t) * PMLD + C_RWKV;
        const bool hasprev = (t0 + t) > 0;
        const float* k_k = p.in[30] + l * W; const float* k_a = p.in[31] + l * W;
#pragma unroll 2
        for (int hd = 0; hd < 4; ++hd) {
            const int nn = 64 * hd + j8;
            float xr[8], xk[8], xv[8], pr[8], pk[8], pv[8], av[8];
            unpack8(*(const uint4*)(row + nn), xr); unpack8(*(const uint4*)(row + 256 + nn), xk); unpack8(*(const uint4*)(row + 512 + nn), xv);
            if (hasprev) { unpack8(*(const uint4*)(row - PMLD + nn), pr); unpack8(*(const uint4*)(row - PMLD + 256 + nn), pk); unpack8(*(const uint4*)(row - PMLD + 512 + nn), pv); }
            else {
#pragma unroll
                for (int i = 0; i < 8; ++i) { pr[i] = 0.f; pk[i] = 0.f; pv[i] = 0.f; } }
            { const u32x4_t t4 = *(const LAS u32x4_t*)(La + t * 264 + nn); unpack8(make_uint4(t4.x, t4.y, t4.z, t4.w), av); }
            float orr[8], okk[8], ovv[8], kraw[8];
            float ss = 0.f;
#pragma unroll
            for (int i = 0; i < 8; ++i) {
                const float r = xr[i] + mu[nn + i] * (pr[i] - xr[i]);
                const float k = xk[i] + mu[256 + nn + i] * (pk[i] - xk[i]);
                const float v = xv[i] + mu[512 + nn + i] * (pv[i] - xv[i]);
                orr[i] = r; ovv[i] = v; okk[i] = k * (1.f + (av[i] - 1.f) * k_a[nn + i]);
                kraw[i] = k * k_k[nn + i]; ss = fmaf(kraw[i], kraw[i], ss);
            }
            ss += __shfl_xor(ss, 1); ss += __shfl_xor(ss, 2); ss += __shfl_xor(ss, 4);
            const float rn = rsqrtf(ss + 1e-6f);
#pragma unroll
            for (int i = 0; i < 8; ++i) kraw[i] *= rn;
            const size_t o = (size_t)(t0 + t) * 256 + nn;
            *(uint4*)(B.RR + o) = pack8(orr); *(uint4*)(B.RK + o) = pack8(okk); *(uint4*)(B.RV + o) = pack8(ovv); *(uint4*)(B.RKK + o) = pack8(kraw);
            { const u32x4_t t4 = *(const LAS u32x4_t*)(La + t * 264 + nn); *(uint4*)(B.RA + o) = make_uint4(t4.x, t4.y, t4.z, t4.w); }
            { const u32x4_t t4 = *(const LAS u32x4_t*)(Lg + t * 264 + nn); *(uint4*)(B.RG + o) = make_uint4(t4.x, t4.y, t4.z, t4.w); }
        }
    }
    for (int px4_ = 0; px4_ < ((PEXP == 4) ? 2 : 1); ++px4_)
    if (tid < 256) {
        float c = 0.f;
#pragma unroll 16
        for (int t = 0; t < 64; ++t) { c += bf2f(Llw[t * 264 + tid]); B.CW[(size_t)(t0 + t) * 256 + tid] = c; }
    }
    BAR();
}

struct RwPiece { float kk[8], al[8], kt[8], v[8], cw[8], cwp[8], cwc[8]; };
__device__ __forceinline__ void rwkv_load_piece(const RwkvBufs& B, int h, int t0, int c, int d0, RwPiece& P) {
    const size_t o = (size_t)(t0 + c) * 256 + h * 64 + d0;
    float a[8];
    unpack8(*(const uint4*)(B.RKK + o), P.kk); unpack8(*(const uint4*)(B.RA + o), a); unpack8(*(const uint4*)(B.RK + o), P.kt); unpack8(*(const uint4*)(B.RV + o), P.v);
    const float4 c0 = *(const float4*)(B.CW + o), c1 = *(const float4*)(B.CW + o + 4);
    P.cw[0] = c0.x; P.cw[1] = c0.y; P.cw[2] = c0.z; P.cw[3] = c0.w; P.cw[4] = c1.x; P.cw[5] = c1.y; P.cw[6] = c1.z; P.cw[7] = c1.w;
    if (c > 0) { const float4 p0 = *(const float4*)(B.CW + o - 256), p1 = *(const float4*)(B.CW + o - 256 + 4);
        P.cwp[0] = p0.x; P.cwp[1] = p0.y; P.cwp[2] = p0.z; P.cwp[3] = p0.w; P.cwp[4] = p1.x; P.cwp[5] = p1.y; P.cwp[6] = p1.z; P.cwp[7] = p1.w; }
    else {
#pragma unroll
        for (int i = 0; i < 8; ++i) P.cwp[i] = 0.f; }
    const size_t oc = (size_t)(t0 + 63) * 256 + h * 64 + d0;
    const float4 e0 = *(const float4*)(B.CW + oc), e1 = *(const float4*)(B.CW + oc + 4);
    P.cwc[0] = e0.x; P.cwc[1] = e0.y; P.cwc[2] = e0.z; P.cwc[3] = e0.w; P.cwc[4] = e1.x; P.cwc[5] = e1.y; P.cwc[6] = e1.z; P.cwc[7] = e1.w;
#pragma unroll
    for (int i = 0; i < 8; ++i) P.al[i] = a[i] * P.kk[i];
}

__device__ __forceinline__ void rwkv_g1_unit(int h, int n, const RwkvBufs& B, bf16_t* __restrict__ Y, LAS unsigned char* lds) {
    const int tid = opq_tid(), w = tid >> 6, lane = tid & 63, q4 = lane >> 4, cc = lane & 15;
    lds_bf16 *P0h = plane(lds, 0), *P0l = plane(lds, 1), *P1h = plane(lds, 2), *P1l = plane(lds, 3), *P2h = plane(lds, 4), *P2l = plane(lds, 5);
    lds_bf16 *Lkh = plane(lds, 6), *Lkl = plane(lds, 7), *P3h = plane(lds, 8), *P3l = plane(lds, 9), *Th = plane(lds, 10), *Tl = plane(lds, 11);
    LAS float* Lm = (LAS float*)(lds + LM_OFF);
    const int t0 = n * 64, u = (4 + h) * 256 + n;
    const int c = tid >> 3, d0 = (tid & 7) * 8;
    RwPiece P; rwkv_load_piece(B, h, t0, c, d0, P);
    {
        float x0[8], x1[8], x2[8];
#pragma unroll
        for (int i = 0; i < 8; ++i) { const float em = __expf(-P.cw[i]); x0[i] = P.kk[i] * __expf(P.cwp[i]); x1[i] = P.al[i] * em; x2[i] = P.kt[i] * em; }
        put8<true>(P0h, P0l, c, d0, x0); put8<true>(P1h, P1l, c, d0, x1); put8<true>(P2h, P2l, c, d0, x2);
    }
    BAR();
    const int ti = w >> 1, tj0 = (w & 1) * 2;
    const f32x4_t zero4 = {0.f, 0.f, 0.f, 0.f};
#pragma unroll
    for (int tt = 0; tt < 2; ++tt) {
        const int tj = tj0 + tt;
        f32x4_t lk = zero4, la = zero4;
        const int j = 16 * tj + cc, jp = (j & 3) * 16 + (j >> 2);
        if (tj <= ti) {
            const f32x4_t a = mmp<true, true>(P0h, P0l, P1h, P1l, 16 * ti, 16 * tj, lane, zero4);
            const f32x4_t b = mmp<true, true>(P0h, P0l, P2h, P2l, 16 * ti, 16 * tj, lane, zero4);
#pragma unroll
            for (int r = 0; r < 4; ++r) { const int i = 16 * ti + 4 * q4 + r; la[r] = (i > j) ? a[r] : 0.f; lk[r] = (i > j) ? b[r] : 0.f; }
        }
#pragma unroll
        for (int r = 0; r < 4; ++r) Lm[(16 * ti + 4 * q4 + r) * PT + jp] = la[r];
        st_tile_R<true>(Lkh, Lkl, 16 * ti, 16 * tj, lane, lk);
    }
    BAR();
    {
        float x0[8], x1[8], x2[8];
#pragma unroll
        for (int i = 0; i < 8; ++i) { const float eb = __expf(P.cwc[i] - P.cw[i]); x0[i] = P.kk[i] * __expf(P.cwp[i]); x1[i] = P.al[i] * eb; x2[i] = P.kt[i] * eb; }
        put8T<true>(P0h, P0l, c, d0, P.v); put8T<true>(P1h, P1l, c, d0, x0); put8T<true>(P2h, P2l, c, d0, x1); put8T<true>(P3h, P3l, c, d0, x2);
    }
    if (w < 4) tri_inverse_4w(Lm, Th, Tl, w, lane);
    BAR();
    { const u32x4_t t4 = *(const LAS u32x4_t*)(Th + c * PB + d0); *(uint4*)(B.TG + (size_t)u * 4096 + c * 64 + d0) = make_uint4(t4.x, t4.y, t4.z, t4.w);
      const u32x4_t t5 = *(const LAS u32x4_t*)(Tl + c * PB + d0); *(uint4*)(Y + (size_t)(t0 + c) * D + 768 + h * 64 + d0) = make_uint4(t5.x, t5.y, t5.z, t5.w); }
    f32x4_t pa[2];
#pragma unroll
    for (int tt = 0; tt < 2; ++tt) pa[tt] = mmp<true, true>(Lkh, Lkl, P0h, P0l, 16 * ti, 16 * (tj0 + tt), lane, zero4);
    BAR();
#pragma unroll
    for (int tt = 0; tt < 2; ++tt) st_tile_T<true>(Lkh, Lkl, 16 * ti, 16 * (tj0 + tt), lane, pa[tt]);
    BAR();
    f32x4_t ua[2], wa[2];
#pragma unroll
    for (int tt = 0; tt < 2; ++tt) {
        ua[tt] = mmp<true, true>(Th, Tl, Lkh, Lkl, 16 * ti, 16 * (tj0 + tt), lane, zero4);
        wa[tt] = mmp<true, true>(Th, Tl, P1h, P1l, 16 * ti, 16 * (tj0 + tt), lane, zero4);
    }
    BAR();
#pragma unroll
    for (int tt = 0; tt < 2; ++tt) {
        st_tile_T<true>(Lkh, Lkl, 16 * ti, 16 * (tj0 + tt), lane, -ua[tt]);
        st_tile_T<true>(P1h, P1l, 16 * ti, 16 * (tj0 + tt), lane, wa[tt]);
    }
    BAR();
    {
#pragma unroll
        for (int tt = 0; tt < 2; ++tt) {
            const int tj = tj0 + tt;
            const f32x4_t a = mmp<true, true>(P2h, P2l, P1h, P1l, 16 * ti, 16 * tj, lane, zero4);
            const float gam = __expf(B.CW[(size_t)(t0 + 63) * 256 + h * 64 + 16 * tj + cc]);
#pragma unroll
            for (int r = 0; r < 4; ++r) { const int ar = 16 * ti + 4 * q4 + r, bc = 16 * tj + cc; Lm[ar * PT + bc] = (ar == bc ? gam : 0.f) - a[r]; }
            f32x4_t nn = mmp<true, true>(P2h, P2l, Lkh, Lkl, 16 * ti, 16 * tj, lane, zero4);
            nn = mmp<true, true>(P3h, P3l, P0h, P0l, 16 * ti, 16 * tj, lane, nn);
            *(float4*)(B.NF + (size_t)u * 4096 + (tj * 64 + lane) * 16 + ti * 4) = make_float4(nn[0], nn[1], nn[2], nn[3]);
        }
    }
    BAR();
    {
        const int combo = tid >> 6, mt = combo >> 1, s = combo & 1, i = lane & 15, qq = lane >> 4;
        const f32x4_t x0 = *(const LAS f32x4_t*)(Lm + (16 * mt + i) * PT + 32 * s + 4 * qq);
        const f32x4_t x1 = *(const LAS f32x4_t*)(Lm + (16 * mt + i) * PT + 32 * s + 16 + 4 * qq);
        const float xv[8] = {x0.x, x0.y, x0.z, x0.w, x1.x, x1.y, x1.z, x1.w};
        U8 H, L; split8(xv, H.v, L.v);
        uint4* mf = B.MF + (size_t)u * 1024 + (size_t)(combo * 2) * 64 + lane;
        mf[0] = H.q; mf[64] = L.q;
    }
    BAR();
}

__device__ __forceinline__ void rwkv_g3_unit(int h, int n, const RwkvBufs& B, bf16_t* __restrict__ Y, const Params& p, int l, LAS unsigned char* lds) {
    const int tid = opq_tid(), w = tid >> 6, lane = tid & 63, q4 = lane >> 4, cc = lane & 15;
    lds_bf16 *KH = plane(lds, 0), *AC = plane(lds, 1), *KC = plane(lds, 2), *RH = plane(lds, 3), *VT = plane(lds, 4), *KHT = plane(lds, 5), *Tp = plane(lds, 6);
    lds_bf16 *HTh = plane(lds, 7), *HTl = plane(lds, 8), *Lk = plane(lds, 9), *Ara = plane(lds, 10), *Ark = plane(lds, 11), *Tq = plane(lds, 12);
    lds_bf16 *PTp = KH, *Wm = AC, *UT = KC;
    LAS float* Os = (LAS float*)(lds + LM_OFF);
    const int t0 = n * 64, u = (4 + h) * 256 + n;
    const int c = tid >> 3, d0 = (tid & 7) * 8;
    {
        RwPiece P; rwkv_load_piece(B, h, t0, c, d0, P);
        float rr[8]; unpack8(*(const uint4*)(B.RR + (size_t)(t0 + c) * 256 + h * 64 + d0), rr);
        const uint4 t8 = *(const uint4*)(B.TG + (size_t)u * 4096 + c * 64 + d0);
        const uint4 t9 = *(const uint4*)(Y + (size_t)(t0 + c) * D + 768 + h * 64 + d0);
        const float* ht = B.HT + (size_t)u * 4096 + c * 64 + d0;
        const float4 h0 = *(const float4*)ht, h1 = *(const float4*)(ht + 4);
        float x0[8], x1[8], x2[8], x3[8];
#pragma unroll
        for (int i = 0; i < 8; ++i) { const float em = __expf(-P.cw[i]); x0[i] = P.kk[i] * __expf(P.cwp[i]); x1[i] = P.al[i] * em; x2[i] = P.kt[i] * em; x3[i] = rr[i] * __expf(P.cw[i]); }
        put8<false>(KH, KH, c, d0, x0); put8<false>(AC, AC, c, d0, x1); put8<false>(KC, KC, c, d0, x2); put8<false>(RH, RH, c, d0, x3);
        put8T<false>(VT, VT, c, d0, P.v); put8T<false>(KHT, KHT, c, d0, x0);
        *(LAS u32x4_t*)(Tp + c * PB + d0) = (u32x4_t){t8.x, t8.y, t8.z, t8.w};
        *(LAS u32x4_t*)(Tq + c * PB + d0) = (u32x4_t){t9.x, t9.y, t9.z, t9.w};
        const float hv[8] = {h0.x, h0.y, h0.z, h0.w, h1.x, h1.y, h1.z, h1.w};
        put8<true>(HTh, HTl, c, d0, hv);
    }
    BAR();
    const int ti = w >> 1, tj0 = (w & 1) * 2;
    const f32x4_t zero4 = {0.f, 0.f, 0.f, 0.f};
#pragma unroll
    for (int tt = 0; tt < 2; ++tt) {
        const int tj = tj0 + tt; const int j = 16 * tj + cc;
        f32x4_t lk = zero4, ara = zero4, ark = zero4;
        if (tj <= ti) {
            const f32x4_t b = mmp<false, false>(KH, KH, KC, KC, 16 * ti, 16 * tj, lane, zero4);
            const f32x4_t e = mmp<false, false>(RH, RH, AC, AC, 16 * ti, 16 * tj, lane, zero4);
            const f32x4_t f = mmp<false, false>(RH, RH, KC, KC, 16 * ti, 16 * tj, lane, zero4);
#pragma unroll
            for (int r = 0; r < 4; ++r) { const int i = 16 * ti + 4 * q4 + r; lk[r] = (i > j) ? b[r] : 0.f; ara[r] = (i >= j) ? e[r] : 0.f; ark[r] = (i >= j) ? f[r] : 0.f; }
        }
        st_tile_R<false>(Lk, Lk, 16 * ti, 16 * tj, lane, lk); st_tile_R<false>(Ara, Ara, 16 * ti, 16 * tj, lane, ara); st_tile_R<false>(Ark, Ark, 16 * ti, 16 * tj, lane, ark);
    }
    BAR();
#pragma unroll
    for (int tt = 0; tt < 2; ++tt) {
        const int tj = tj0 + tt;
        st_tile_T<false>(PTp, PTp, 16 * ti, 16 * tj, lane, mmp<false, false>(Lk, Lk, VT, VT, 16 * ti, 16 * tj, lane, zero4));
        st_tile_R<false>(Wm, Wm, 16 * ti, 16 * tj, lane, mmp<true, false>(Tp, Tq, KHT, KHT, 16 * ti, 16 * tj, lane, zero4));
    }
    BAR();
    f32x4_t o[2];
#pragma unroll
    for (int tt = 0; tt < 2; ++tt) {
        const int tj = tj0 + tt;
        const f32x4_t ua = mmp<true, false>(Tp, Tq, PTp, PTp, 16 * ti, 16 * tj, lane, zero4);
        const f32x4_t wh = mmp<false, true>(Wm, Wm, HTh, HTl, 16 * ti, 16 * tj, lane, zero4);
        st_tile_T<false>(UT, UT, 16 * ti, 16 * tj, lane, -ua - wh);
        o[tt] = mmp<false, true>(RH, RH, HTh, HTl, 16 * ti, 16 * tj, lane, zero4);
        o[tt] = mmp<false, false>(Ark, Ark, VT, VT, 16 * ti, 16 * tj, lane, o[tt]);
    }
    BAR();
#pragma unroll
    for (int tt = 0; tt < 2; ++tt) {
        const int tj = tj0 + tt;
        o[tt] = mmp<false, false>(Ara, Ara, UT, UT, 16 * ti, 16 * tj, lane, o[tt]);
#pragma unroll
        for (int r = 0; r < 4; ++r) Os[(16 * ti + 4 * q4 + r) * PT + 16 * tj + cc] = o[tt][r];
    }
    BAR();
    {
        const f32x4_t x0 = *(const LAS f32x4_t*)(Os + c * PT + d0), x1 = *(const LAS f32x4_t*)(Os + c * PT + d0 + 4);
        const float xv[8] = {x0.x, x0.y, x0.z, x0.w, x1.x, x1.y, x1.z, x1.w};
        float s1 = 0.f;
#pragma unroll
        for (int i = 0; i < 8; ++i) s1 += xv[i];
        s1 += __shfl_xor(s1, 1); s1 += __shfl_xor(s1, 2); s1 += __shfl_xor(s1, 4);
        const float mean = s1 * (1.f / 64.f);
        float s2 = 0.f;
#pragma unroll
        for (int i = 0; i < 8; ++i) { const float dd = xv[i] - mean; s2 = fmaf(dd, dd, s2); }
        s2 += __shfl_xor(s2, 1); s2 += __shfl_xor(s2, 2); s2 += __shfl_xor(s2, 4);
        const float rs = rsqrtf(s2 * (1.f / 64.f) + 64e-5f);
        const size_t o8 = (size_t)(t0 + c) * 256 + h * 64 + d0;
        float rr[8], gg[8], kt2[8], v2[8];
        unpack8(*(const uint4*)(B.RR + o8), rr); unpack8(*(const uint4*)(B.RG + o8), gg); unpack8(*(const uint4*)(B.RK + o8), kt2); unpack8(*(const uint4*)(B.RV + o8), v2);
        const float* r_k = p.in[32] + l * W + h * 64 + d0; const float* ln_g = p.in[33] + l * W + h * 64 + d0; const float* ln_b = p.in[34] + l * W + h * 64 + d0;
        float bs = 0.f;
#pragma unroll
        for (int i = 0; i < 8; ++i) bs = fmaf(rr[i] * kt2[i], r_k[i], bs);
        bs += __shfl_xor(bs, 1); bs += __shfl_xor(bs, 2); bs += __shfl_xor(bs, 4);
        float y[8];
#pragma unroll
        for (int i = 0; i < 8; ++i) y[i] = ((xv[i] - mean) * rs * ln_g[i] + ln_b[i] + bs * v2[i]) * gg[i];
        *(uint4*)(Y + (size_t)(t0 + c) * D + 768 + h * 64 + d0) = pack8(y);
    }
    BAR();
}

struct LruBufs { float2* AGG; float* CAR; };
template <int PASS>
__device__ __forceinline__ void lru_unit(const bf16_t* __restrict__ PM, int n, const LruBufs& B, bf16_t* __restrict__ Y, const Params& p, int l, const bf16_t* __restrict__ LWT  , LAS float* lds) {
    const int tid = opq_tid(), c = tid & 255, half = tid >> 8, w = tid >> 6, lane = tid & 63, q4 = lane >> 4, cc = lane & 15;
    const int t0 = n * 64, tb = t0 + 32 * half;
    LAS float* U = lds;
    lds_bf16* R = (lds_bf16*)(lds + 64 * 260);
    lds_bf16* I = R + 64 * 264;
    {
        const float* cw = p.in[7] + l * 4 * W; const float cb = p.in[8][l * W + c];
        const float w0 = cw[c], w1 = cw[W + c], w2 = cw[2 * W + c], w3 = cw[3 * W + c];
        const bf16_t* col = PM + C_LRU + c;
#pragma unroll 1
        for (int hf = 0; hf < 2; ++hf) {
            bf16_t xr[19];
#pragma unroll
            for (int i = 0; i < 19; ++i) xr[i] = (tb + 16 * hf + i - 3 >= 0) ? col[(size_t)(tb + 16 * hf + i - 3) * PMLD] : (bf16_t)0;
#pragma unroll
            for (int i = 0; i < 16; ++i)
                U[(32 * half + 16 * hf + i) * 260 + c] = cb + w0 * bf2f(xr[i]) + w1 * bf2f(xr[i + 1]) + w2 * bf2f(xr[i + 2]) + w3 * bf2f(xr[i + 3]);
        }
    }
    BAR();
    {
        const int nb = w >> 1, gt = w & 1;
        const bf16_t* wt = LWT + (size_t)gt * 16384 + (size_t)nb * 4096;
        const float* bias = (gt ? p.in[12] : p.in[10]) + l * W + nb * 64;
        const float* lam = p.in[13] + l * W + nb * 64;
#pragma unroll 1
        for (int te = 0; te < 4; ++te) {
            U8 bf[2];
#pragma unroll
            for (int ks = 0; ks < 2; ++ks) bf[ks].q = *(const uint4*)(wt + (size_t)(16 * te + cc) * 64 + 32 * ks + 8 * q4);
            const int ch = nb * 64 + 16 * te + cc;
            const float bv = bias[16 * te + cc];
            const float sp8 = 8.f * softplusf_(-lam[16 * te + cc]);
#pragma unroll
            for (int tt = 0; tt < 4; ++tt) {
                f32x4_t acc = {0.f, 0.f, 0.f, 0.f};
#pragma unroll
                for (int ks = 0; ks < 2; ++ks) {
                    const LAS float* ap = U + (16 * tt + cc) * 260 + nb * 64 + 32 * ks + 8 * q4;
                    const f32x4_t a0 = *(const LAS f32x4_t*)ap, a1 = *(const LAS f32x4_t*)(ap + 4);
                    const float av[8] = {a0.x, a0.y, a0.z, a0.w, a1.x, a1.y, a1.z, a1.w};
                    acc = __builtin_amdgcn_mfma_f32_16x16x32_bf16(hi8(av), bf[ks].v, acc, 0, 0, 0);
                }
#pragma unroll
                for (int r = 0; r < 4; ++r) {
                    const int t = 16 * tt + 4 * q4 + r;
                    const float sg = sigmoidf_(acc[r] + bv);
                    if (gt) I[t * 264 + ch] = (unsigned short)f2bf(sg); else R[t * 264 + ch] = (unsigned short)f2bf(-sp8 * sg);
                }
            }
        }
    }
    BAR();
    float h = 0.f, ap = 1.f;
    const int sc = 2 * n + half;
    bf16_t gc_[8], gn_[8];
    if (PASS == 3) {
        h = B.CAR[(size_t)c * 512 + sc];
#pragma unroll
        for (int i = 0; i < 8; ++i) gc_[i] = PM[(size_t)(tb + i) * PMLD + C_LRU + 256 + c];
    }
#pragma unroll 1
    for (int g8 = 0; g8 < 4; ++g8) {
        if (PASS == 3 && g8 < 3) {
#pragma unroll
            for (int i = 0; i < 8; ++i) gn_[i] = PM[(size_t)(tb + 8 * (g8 + 1) + i) * PMLD + C_LRU + 256 + c];
        }
#pragma unroll
        for (int i = 0; i < 8; ++i) {
            const int t = 32 * half + 8 * g8 + i;
            const float log_a = bf2f(R[t * 264 + c]), ig = bf2f(I[t * 264 + c]);
            const float a = __expf(log_a);
            const float inp = __builtin_amdgcn_sqrtf(fmaxf(1.f - a * a, 0.f)) * (ig * U[t * 260 + c]);
            h = fmaf(a, h, inp); ap *= a;
            if (PASS == 3) Y[(size_t)(t0 + t) * D + 256 + c] = (bf16_t)f2bf(h * geluf_(bf2f(gc_[i])));
        }
        if (PASS == 3) {
#pragma unroll
            for (int i = 0; i < 8; ++i) gc_[i] = gn_[i];
        }
    }
    if (PASS == 1) B.AGG[(size_t)c * 512 + sc] = make_float2(ap, h);
    BAR();
}
__device__ __forceinline__ void lru_carry_wave(const LruBufs& B, int c, int lane) {
    float2 ab[8];
    const float4* src = (const float4*)(B.AGG + (size_t)c * 512 + 8 * lane);
#pragma unroll
    for (int k = 0; k < 4; ++k) { const float4 v = src[k]; ab[2 * k] = make_float2(v.x, v.y); ab[2 * k + 1] = make_float2(v.z, v.w); }
    float A = 1.f, Bv = 0.f;
#pragma unroll
    for (int k = 0; k < 8; ++k) { Bv = fmaf(ab[k].x, Bv, ab[k].y); A *= ab[k].x; }
#pragma unroll
    for (int o = 1; o < 64; o <<= 1) { const float Al = __shfl_up(A, o), Bl = __shfl_up(Bv, o); if (lane >= o) { Bv = fmaf(A, Bl, Bv); A *= Al; } }
    float h = __shfl_up(Bv, 1); if (lane == 0) h = 0.f;
    float o8[8];
#pragma unroll
    for (int k = 0; k < 8; ++k) { o8[k] = h; h = fmaf(ab[k].x, h, ab[k].y); }
    float4* dst = (float4*)(B.CAR + (size_t)c * 512 + 8 * lane);
    dst[0] = make_float4(o8[0], o8[1], o8[2], o8[3]); dst[1] = make_float4(o8[4], o8[5], o8[6], o8[7]);
}

struct S5Bufs { float2* E; float2* CIN; };
struct S5Lane { float lbr, lbi; float bbr[16], bbi[16]; };
__device__ __forceinline__ void s5_lane_consts(const Params& p, int l, int g, int lane, S5Lane& K) {
    const float dt = __expf(p.in[21][l * 16 + g]);
    const float lre = p.in[14][l * 1024 + g * 64 + lane], lim = p.in[15][l * 1024 + g * 64 + lane];
    const float er = __expf(lre * dt);
    K.lbr = er * cosf(lim * dt); K.lbi = er * sinf(lim * dt);
    const float nr = K.lbr - 1.f, ni = K.lbi, den = lre * lre + lim * lim;
    const float fr = (nr * lre + ni * lim) / den, fi = (ni * lre - nr * lim) / den;
    const float* bre = p.in[16] + (size_t)l * 16384 + (g * 64 + lane) * 16; const float* bim = p.in[17] + (size_t)l * 16384 + (g * 64 + lane) * 16;
#pragma unroll
    for (int c = 0; c < 16; ++c) { const float br = bre[c], bi = bim[c]; K.bbr[c] = fr * br - fi * bi; K.bbi[c] = fr * bi + fi * br; }
}
template <int PASS>
__device__ __forceinline__ void s5_unit(const bf16_t* __restrict__ PM, int n, const S5Bufs& B, bf16_t* __restrict__ Y, const Params& p, int l, const bf16_t* __restrict__ GLUT, LAS unsigned char* lds) {
    const int tid = opq_tid(), w = tid >> 6, lane = tid & 63, q4 = lane >> 4, cc = lane & 15;
    const int t0 = n * 64;
    LAS float* us = (LAS float*)lds + w * (64 * 16);
    LAS unsigned char* hs = lds + 32768 + w * (32 * 272);
    lds_bf16* yp = (lds_bf16*)(lds + 32768 + 8 * 32 * 272);
#pragma unroll 1
    for (int gi = 0; gi < 2; ++gi) {
        const int g = 2 * w + gi;
        {
            const bf16_t* src = PM + (size_t)(t0 + lane) * PMLD + C_S5 + g * 16;
            float a[8], b[8]; unpack8(*(const uint4*)src, a); unpack8(*(const uint4*)(src + 8), b);
            *(LAS f32x4_t*)(us + lane * 16) = (f32x4_t){a[0], a[1], a[2], a[3]}; *(LAS f32x4_t*)(us + lane * 16 + 4) = (f32x4_t){a[4], a[5], a[6], a[7]};
            *(LAS f32x4_t*)(us + lane * 16 + 8) = (f32x4_t){b[0], b[1], b[2], b[3]}; *(LAS f32x4_t*)(us + lane * 16 + 12) = (f32x4_t){b[4], b[5], b[6], b[7]};
        }
        S5Lane K; s5_lane_consts(p, l, g, lane, K);
        float hr = 0.f, hi = 0.f;
        if (PASS == 3) { const float2 h0 = B.CIN[((size_t)g * 64 + lane) * 256 + n]; hr = h0.x; hi = h0.y; }
        U8 cf[4];
        float dch = 0.f;
        if (PASS == 3) {
            const float* cre = p.in[18] + (size_t)l * 16384 + (g * 16 + cc) * 64; const float* cim = p.in[19] + (size_t)l * 16384 + (g * 16 + cc) * 64;
#pragma unroll
            for (int ks = 0; ks < 4; ++ks) {
                const float4 r4 = *(const float4*)(cre + 16 * ks + 4 * q4), i4 = *(const float4*)(cim + 16 * ks + 4 * q4);
                cf[ks].u[0] = cvtpk(r4.x, -i4.x); cf[ks].u[1] = cvtpk(r4.y, -i4.y); cf[ks].u[2] = cvtpk(r4.z, -i4.z); cf[ks].u[3] = cvtpk(r4.w, -i4.w);
            }
            dch = p.in[20][l * W + g * 16 + cc];
        }
        asm volatile("s_waitcnt lgkmcnt(0)" ::: "memory");
#pragma unroll 1
        for (int hf = 0; hf < 2; ++hf) {
#pragma unroll 2
            for (int i = 0; i < 32; ++i) {
                const int t = 32 * hf + i;
                const f32x4_t u0 = *(const LAS f32x4_t*)(us + t * 16), u1 = *(const LAS f32x4_t*)(us + t * 16 + 4), u2 = *(const LAS f32x4_t*)(us + t * 16 + 8), u3 = *(const LAS f32x4_t*)(us + t * 16 + 12);
                const float uv[16] = {u0.x, u0.y, u0.z, u0.w, u1.x, u1.y, u1.z, u1.w, u2.x, u2.y, u2.z, u2.w, u3.x, u3.y, u3.z, u3.w};
                float br = 0.f, bi = 0.f;
#pragma unroll
                for (int c = 0; c < 16; ++c) { br = fmaf(K.bbr[c], uv[c], br); bi = fmaf(K.bbi[c], uv[c], bi); }
                const float nhr = K.lbr * hr - K.lbi * hi + br, nhi = K.lbr * hi + K.lbi * hr + bi;
                hr = nhr; hi = nhi;
                if (PASS == 3) *(LAS unsigned*)(hs + i * 272 + 4 * lane) = cvtpk(hr, hi);
            }
            if (PASS == 3) {
                asm volatile("s_waitcnt lgkmcnt(0)" ::: "memory");
#pragma unroll
                for (int tt = 0; tt < 2; ++tt) {
                    f32x4_t acc = {0.f, 0.f, 0.f, 0.f};
#pragma unroll
                    for (int ks = 0; ks < 4; ++ks) {
                        U8 af; af.x = *(const LAS u32x4_t*)(hs + (16 * tt + cc) * 272 + 64 * ks + 16 * q4);
                        acc = __builtin_amdgcn_mfma_f32_16x16x32_bf16(af.v, cf[ks].v, acc, 0, 0, 0);
                    }
#pragma unroll
                    for (int r = 0; r < 4; ++r) {
                        const int t = 32 * hf + 16 * tt + 4 * q4 + r;
                        const float yv = acc[r] + dch * us[t * 16 + cc];
                        yp[t * 264 + g * 16 + cc] = (unsigned short)f2bf(geluf_(yv));
                    }
                }
                asm volatile("s_waitcnt lgkmcnt(0)" ::: "memory");
            }
        }
        if (PASS == 1) B.E[((size_t)g * 64 + lane) * 256 + n] = make_float2(hr, hi);
    }
    if (PASS == 3) {
        BAR();
        const float* gb = p.in[23] + l * W;
#pragma unroll 1
        for (int tn = 2 * w; tn < 2 * w + 2; ++tn) {
            f32x4_t acc[4];
#pragma unroll
            for (int tt = 0; tt < 4; ++tt) acc[tt] = (f32x4_t){0.f, 0.f, 0.f, 0.f};
#pragma unroll
            for (int ks = 0; ks < 8; ++ks) {
                U8 bf; bf.q = *(const uint4*)(GLUT + (size_t)(16 * tn + cc) * 256 + 32 * ks + 8 * q4);
#pragma unroll
                for (int tt = 0; tt < 4; ++tt) {
                    U8 af; af.x = *(const LAS u32x4_t*)(yp + (16 * tt + cc) * 264 + 32 * ks + 8 * q4);
                    acc[tt] = __builtin_amdgcn_mfma_f32_16x16x32_bf16(af.v, bf.v, acc[tt], 0, 0, 0);
                }
            }
            const int ncol = 16 * tn + cc; const float gbn = gb[ncol];
#pragma unroll
            for (int tt = 0; tt < 4; ++tt)
#pragma unroll
                for (int r = 0; r < 4; ++r) {
                    const int t = 16 * tt + 4 * q4 + r;
                    const float yv = bf2f(yp[t * 264 + ncol]);
                    Y[(size_t)(t0 + t) * D + 512 + ncol] = (bf16_t)f2bf(yv * sigmoidf_(acc[tt][r] + gbn));
                }
        }
    }
    BAR();
}
__device__ __forceinline__ void s5_carry_wave(const S5Bufs& B, const Params& p, int l, int gp, int lane) {
    const int g = gp >> 6;
    const float dt = __expf(p.in[21][l * 16 + g]) * 64.f;
    const float lre = p.in[14][l * 1024 + gp], lim = p.in[15][l * 1024 + gp];
    const float er = __expf(lre * dt);
    const float pr = er * cosf(lim * dt), pi = er * sinf(lim * dt);
    float2 e[4];
    const float4* src = (const float4*)(B.E + (size_t)gp * 256 + 4 * lane);
    { const float4 v0 = src[0], v1 = src[1]; e[0] = make_float2(v0.x, v0.y); e[1] = make_float2(v0.z, v0.w); e[2] = make_float2(v1.x, v1.y); e[3] = make_float2(v1.z, v1.w); }
    float Ar = 1.f, Ai = 0.f, Br = 0.f, Bi = 0.f;
#pragma unroll
    for (int k = 0; k < 4; ++k) {
        const float nbr = pr * Br - pi * Bi + e[k].x, nbi = pr * Bi + pi * Br + e[k].y; Br = nbr; Bi = nbi;
        const float nar = pr * Ar - pi * Ai, nai = pr * Ai + pi * Ar; Ar = nar; Ai = nai;
    }
#pragma unroll
    for (int o = 1; o < 64; o <<= 1) {
        const float Alr = __shfl_up(Ar, o), Ali = __shfl_up(Ai, o), Blr = __shfl_up(Br, o), Bli = __shfl_up(Bi, o);
        if (lane >= o) {
            const float nbr = Ar * Blr - Ai * Bli + Br, nbi = Ar * Bli + Ai * Blr + Bi; Br = nbr; Bi = nbi;
            const float nar = Ar * Alr - Ai * Ali, nai = Ar * Ali + Ai * Alr; Ar = nar; Ai = nai;
        }
    }
    float hr = __shfl_up(Br, 1), hi = __shfl_up(Bi, 1); if (lane == 0) { hr = 0.f; hi = 0.f; }
    float2 o4[4];
#pragma unroll
    for (int k = 0; k < 4; ++k) { o4[k] = make_float2(hr, hi); const float nhr = pr * hr - pi * hi + e[k].x, nhi = pr * hi + pi * hr + e[k].y; hr = nhr; hi = nhi; }
    float4* dst = (float4*)(B.CIN + (size_t)gp * 256 + 4 * lane);
    dst[0] = make_float4(o4[0].x, o4[0].y, o4[1].x, o4[1].y); dst[1] = make_float4(o4[2].x, o4[2].y, o4[3].x, o4[3].y);
}

constexpr size_t WS_GQ = 36 * MiB, WS_GK = 44 * MiB, WS_GV = 52 * MiB, WS_GB = 60 * MiB, WS_GC = 61 * MiB;
constexpr size_t WS_MF = 324 * MiB, WS_NF = 356 * MiB, WS_HT = 388 * MiB;
constexpr size_t WS_RR = 420 * MiB, WS_RK = 428 * MiB, WS_RV = 436 * MiB, WS_RKK = 444 * MiB, WS_RA = 452 * MiB, WS_RG = 460 * MiB, WS_CW = 468 * MiB;
constexpr size_t WS_LAGG = 484 * MiB, WS_LCAR = 485 * MiB, WS_S5E = 486 * MiB, WS_S5C = 488 * MiB;
constexpr size_t WS_TG = 490 * MiB;
constexpr int MIX_LDS = 8 * MS * 4 + 1024;
__device__ __forceinline__ LruBufs lru_bufs(unsigned char* ws) { LruBufs B; B.AGG = (float2*)(ws + WS_LAGG); B.CAR = (float*)(ws + WS_LCAR); return B; }
__device__ __forceinline__ S5Bufs s5_bufs(unsigned char* ws) { S5Bufs B; B.E = (float2*)(ws + WS_S5E); B.CIN = (float2*)(ws + WS_S5C); return B; }
__device__ __forceinline__ GdnBufs gdn_bufs(unsigned char* ws) {
    GdnBufs B; B.GQ = (bf16_t*)(ws + WS_GQ); B.GK = (bf16_t*)(ws + WS_GK); B.GV = (bf16_t*)(ws + WS_GV); B.GB = (float*)(ws + WS_GB); B.GC = (float*)(ws + WS_GC);
    B.MF = (uint4*)(ws + WS_MF); B.NF = (float*)(ws + WS_NF); B.HT = (float*)(ws + WS_HT); B.TG = (bf16_t*)(ws + WS_TG); return B;
}
__device__ __forceinline__ RwkvBufs rwkv_bufs(unsigned char* ws) {
    RwkvBufs B; B.RR = (bf16_t*)(ws + WS_RR); B.RK = (bf16_t*)(ws + WS_RK); B.RV = (bf16_t*)(ws + WS_RV); B.RKK = (bf16_t*)(ws + WS_RKK); B.RA = (bf16_t*)(ws + WS_RA); B.RG = (bf16_t*)(ws + WS_RG);
    B.CW = (float*)(ws + WS_CW); B.MF = (uint4*)(ws + WS_MF); B.NF = (float*)(ws + WS_NF); B.HT = (float*)(ws + WS_HT); B.TG = (bf16_t*)(ws + WS_TG); return B;
}
__device__ __forceinline__ unsigned char* opq(unsigned char* w) { unsigned long long v = (unsigned long long)w; asm volatile("" : "+s"(v)); return (unsigned char*)(GAS unsigned char*)v; }
#define XB_TMO      128
#define XB_XCNT(j)  (256  + 64 * (j))
#define XB_XSUB(j)  (1280 + 64 * (j))
#define XB_XGEN(j)  (2304 + 64 * (j))
#define XB_TOP      3328
#define XB_TOPGEN   3392
#define XCD_BAR_WORDS 3456
#define XB_SPIN_CAP (1u << 18)

__device__ __forceinline__ unsigned xb_ld(unsigned* p)              { return __hip_atomic_load(p, __ATOMIC_RELAXED, __HIP_MEMORY_SCOPE_AGENT); }
__device__ __forceinline__ unsigned xb_add(unsigned* p, unsigned v) { return __hip_atomic_fetch_add(p, v, __ATOMIC_RELAXED, __HIP_MEMORY_SCOPE_AGENT); }
__device__ __forceinline__ unsigned xb_xcc_id() { return (unsigned)__builtin_amdgcn_s_getreg((3 << 11) | 20) & 0xFu; }
#define XB_SPIN(cond, bar) do { unsigned _sp = 0; while (cond) { __builtin_amdgcn_s_sleep(1); \
    if ((++_sp & 255u) == 0u) { if (xb_ld(&(bar)[XB_TMO])) break; if (_sp > XB_SPIN_CAP) { atomicAdd(&(bar)[XB_TMO], 1u); break; } } } } while (0)

struct XcdBarrier {
    unsigned* bar; unsigned x;
    volatile LAS unsigned* st;
};

__device__ __forceinline__ XcdBarrier xcd_barrier_post(unsigned* bar, volatile LAS unsigned* st) {
    XcdBarrier b; b.bar = bar; b.x = xb_xcc_id(); b.st = st;
    if (threadIdx.x == 0) (void)xb_add(&bar[XB_XCNT(b.x)], 1u);
    return b;
}
__device__ __forceinline__ void xcd_barrier_complete(unsigned* bar, unsigned x, unsigned& nloc, unsigned& nx) {
    const unsigned G = gridDim.x * gridDim.y * gridDim.z;
    unsigned sum, cnt, mine, sp = 0u;
    for (;;) {
        sum = 0u; cnt = 0u; mine = 0u;
#pragma unroll
        for (unsigned j = 0; j < 16; ++j) { const unsigned c = xb_ld(&bar[XB_XCNT(j)]); sum += c; cnt += (c > 0u) ? 1u : 0u; mine = (j == x) ? c : mine; }
        if (sum == G) break;
        __builtin_amdgcn_s_sleep(1);
        if ((++sp & 255u) == 0u) { if (xb_ld(&bar[XB_TMO])) break; if (sp > XB_SPIN_CAP) { atomicAdd(&bar[XB_TMO], 1u); break; } }
    }
    nloc = mine > 0u ? mine : 1u; nx = cnt > 0u ? cnt : 1u;
}

__device__ __forceinline__ void xcd_barrier(const XcdBarrier& b) {
    asm volatile("s_waitcnt vmcnt(0)" ::: "memory");
    __syncthreads();
    if (threadIdx.x == 0) {
        unsigned* bar = b.bar;
        __builtin_amdgcn_s_waitcnt(0);
        unsigned nloc = b.st[0], nx = b.st[1];
        if (nloc == 0u) { xcd_barrier_complete(bar, b.x, nloc, nx); b.st[0] = nloc; b.st[1] = nx; }
        const unsigned old = xb_add(&bar[XB_XSUB(b.x)], 1u);
        const unsigned gen = old / nloc;
        if (old + 1u == (gen + 1u) * nloc) {
            __builtin_amdgcn_fence(__ATOMIC_RELEASE, "agent");
            asm volatile("s_waitcnt vmcnt(0)" ::: "memory");
            const unsigned og = xb_add(&bar[XB_TOP], 1u);
            const unsigned tg = og / nx;
            if (og + 1u == (tg + 1u) * nx) xb_add(&bar[XB_TOPGEN], 1u);
            else XB_SPIN(xb_ld(&bar[XB_TOPGEN]) == tg, bar);
            __builtin_amdgcn_fence(__ATOMIC_ACQUIRE, "agent");
            xb_add(&bar[XB_XGEN(b.x)], 1u);
            asm volatile("s_waitcnt vmcnt(0)" ::: "memory");
        } else {
            XB_SPIN(xb_ld(&bar[XB_XGEN(b.x)]) == gen, bar);
            __builtin_amdgcn_fence(__ATOMIC_ACQUIRE, "agent");
            asm volatile("s_waitcnt vmcnt(0)" ::: "memory");
        }
    }
    __syncthreads();
}

__device__ __forceinline__ void sub_barrier(unsigned* cnt, unsigned target) {
    asm volatile("s_waitcnt vmcnt(0)" ::: "memory"); __syncthreads();
    if (threadIdx.x == 0) {
        __builtin_amdgcn_fence(__ATOMIC_RELEASE, "agent"); asm volatile("s_waitcnt vmcnt(0)" ::: "memory");
        (void)__hip_atomic_fetch_add(cnt, 1u, __ATOMIC_RELAXED, __HIP_MEMORY_SCOPE_AGENT);
        unsigned sp = 0;
        while (__hip_atomic_load(cnt, __ATOMIC_RELAXED, __HIP_MEMORY_SCOPE_AGENT) < target) { __builtin_amdgcn_s_sleep(2); if (++sp > (1u << 22)) break; }
        __builtin_amdgcn_fence(__ATOMIC_ACQUIRE, "agent"); asm volatile("s_waitcnt vmcnt(0)" ::: "memory");
    }
    __syncthreads();
}

namespace cg = cooperative_groups;
constexpr int FUSED_LDS = MIX_LDS;
static_assert(FUSED_LDS >= pg8::STAGE_BYTES && FUSED_LDS >= 8 * 64 * 33 * 4, "LDS budget");
#define GSYNC() xcd_barrier(bar)
#ifndef PHM
#define PHM 511
#endif
#ifndef REP
#define REP 0
#endif
#ifndef REPU
#define REPU 0
#endif
#ifndef REPP
#define REPP 0
#endif
__global__ void __launch_bounds__(NT, 2) fwd_fused(KParams kp_unused) {
    cg::grid_group grid = cg::this_grid();
    extern __shared__ __attribute__((aligned(16))) unsigned char dl[];
    Params p; p.in.tab = (LAS const unsigned long long*)((LAS unsigned char*)dl + FUSED_LDS);
    {
        const __attribute__((address_space(4))) unsigned long long* ka = (const __attribute__((address_space(4))) unsigned long long*)__builtin_amdgcn_kernarg_segment_ptr();
        if (threadIdx.x < 43) ((LAS unsigned long long*)((LAS unsigned char*)dl + FUSED_LDS))[threadIdx.x] = ka[threadIdx.x];
        if (threadIdx.x < 4) ((LAS unsigned*)((LAS unsigned char*)dl + FUSED_LDS + 512))[threadIdx.x] = 0u;
        __syncthreads();
    }
    const XcdBarrier bar = xcd_barrier_post((unsigned*)(p.ws() + WS_CTL), (volatile LAS unsigned*)((LAS unsigned char*)dl + FUSED_LDS + 512));
    float* X = p.out();
#pragma unroll 1
    for (int l = 0; l < 2; ++l) {
        {
            const int tid = opq_tid();
            convert_weights(p, l, (LAS float*)dl + (tid >> 6) * 64 * 33, blockIdx.x * 8 + (tid >> 6), gridDim.x * 8, tid & 63);
        }
#pragma unroll 1
        for (int b = 0; b < 2; ++b) {
            const float* Xin = (l == 0 ? p.in[0] : X) + (size_t)b * TB * D;
            float* Xb = X + (size_t)b * TB * D;
            { unsigned char* ws = opq(p.ws()); rmsnorm_rows(Xin, p.in[1] + l * D, (bf16_t*)(ws + WS_XN), TB); }
            if (l == 0 && b == 0) grid.sync(); else GSYNC();
#if PHM & 1
            for (int rep_ = 0; rep_ < ((REP & 1) ? 2 : 1); ++rep_) {
            {
                unsigned char* ws = opq(p.ws()); const bf16_t* WL = (const bf16_t*)(ws + WS_W);
                pg8::Gemm g{(const bf16_t*)(ws + WS_XN), WL + WO_IN, TB, 7168, D, D, D, 0};
                pg8::StaticOrder S; S.init(g.M, g.N, (int)gridDim.x, (int)blockIdx.x);
                pg8::gemm_phase<pg8::EpiProjP, pg8::StaticOrder, true, true>((PG8_LAS unsigned char*)dl, g, S, pg8::EpiProjP{(bf16_t*)(ws + WS_PM), (bf16_t*)(ws + WS_G)});
            }
            }
#endif
            GSYNC();
#if PHM & 2
            for (int rep_ = 0; rep_ < ((REP & 2) ? 2 : 1); ++rep_) {
            for (int ps_ = 0; ps_ < ((REPP == 2) ? 2 : 1); ++ps_)
            for (int n = blockIdx.x; n < 512; n += gridDim.x) {
                if (ps_ == 1 && ((n < 256) ? 1 : 2) != REPU) continue;
                unsigned char* ws = opq(p.ws());
                if (n < 256) gdn_prep_chunk((const bf16_t*)(ws + WS_PM), n, gdn_bufs(ws), p, l, (LAS float*)dl);
                else { const bf16_t* WL = (const bf16_t*)(ws + WS_W); rwkv_prep_chunk((const bf16_t*)(ws + WS_PM), n - 256, rwkv_bufs(ws), p, l, WL + WO_WUP, WL + WO_AUP, WL + WO_GUP, (LAS unsigned char*)dl); }
            }
            }
#endif
            GSYNC();
#if PHM & 4
            for (int rep_ = 0; rep_ < ((REP & 4) ? 2 : 1); ++rep_) {
            for (int ps_ = 0; ps_ < ((REPP == 4) ? 2 : 1); ++ps_)
            for (int u = blockIdx.x; u < 2560; u += gridDim.x) {
                const int ut_ = u < 1024 ? 1 : (u < 2048 ? 2 : (u < 2304 ? 3 : 4));
                if (ps_ == 1 && ut_ != REPU) continue;
                unsigned char* ws = opq(p.ws());
                if (u < 1024) gdn_g1_unit(u >> 8, u & 255, gdn_bufs(ws), (bf16_t*)(ws + WS_Y), (LAS unsigned char*)dl);
                else if (u < 2048) rwkv_g1_unit((u - 1024) >> 8, u & 255, rwkv_bufs(ws), (bf16_t*)(ws + WS_Y), (LAS unsigned char*)dl);
                else if (u < 2304) lru_unit<1>((const bf16_t*)(ws + WS_PM), u - 2048, lru_bufs(ws), (bf16_t*)(ws + WS_Y), p, l, (const bf16_t*)(ws + WS_W) + WO_LWT, (LAS float*)dl);
                else s5_unit<1>((const bf16_t*)(ws + WS_PM), u - 2304, s5_bufs(ws), (bf16_t*)(ws + WS_Y), p, l, (const bf16_t*)(ws + WS_W) + WO_GLU, (LAS unsigned char*)dl);
            }
            }
#endif
            GSYNC();
#if PHM & 8
            for (int rep_ = 0; rep_ < ((REP & 8) ? 2 : 1); ++rep_) {
            {
                const int tid = opq_tid(), lane = tid & 63, wv = tid >> 6;
                const int bx = blockIdx.x;
                volatile LAS unsigned* flags = (volatile LAS unsigned*)((LAS unsigned char*)dl + FUSED_LDS + 768);
                if (tid < 16) flags[tid] = 0u;
                __syncthreads();
                if (bx < 32) {
                    unsigned char* ws = opq(p.ws());
                    const GdnBufs B = gdn_bufs(ws); const int sq = bx >> 2, cb = bx & 3;
                    if (wv == 0) chain_wave(B.HT + (size_t)sq * 256 * 4096, cb, 256, lane, (LAS unsigned char*)dl, flags);
                    else chain_loader(B.MF + (size_t)sq * 256 * 1024, B.NF + (size_t)sq * 256 * 4096, cb, 256, lane, wv - 1, (LAS unsigned char*)dl, flags);
                } else {
                    {
                        unsigned char* ws = opq(p.ws());
                        for (int job = (bx - 32) * 8 + wv; job < 1280; job += (int)(gridDim.x - 32) * 8) {
                            if (job < 256) lru_carry_wave(lru_bufs(ws), job, lane);
                            else s5_carry_wave(s5_bufs(ws), p, l, job - 256, lane);
                        }
                    }
                    sub_barrier((unsigned*)(p.ws() + WS_CTL + 15360), (unsigned)(gridDim.x - 32) * (unsigned)(l * 2 + b + 1));
                    for (int u = bx - 32; u < 512; u += (int)gridDim.x - 32) {
                        unsigned char* ws = opq(p.ws());
                        if (u < 256) lru_unit<3>((const bf16_t*)(ws + WS_PM), u, lru_bufs(ws), (bf16_t*)(ws + WS_Y), p, l, (const bf16_t*)(ws + WS_W) + WO_LWT, (LAS float*)dl);
                        else s5_unit<3>((const bf16_t*)(ws + WS_PM), u - 256, s5_bufs(ws), (bf16_t*)(ws + WS_Y), p, l, (const bf16_t*)(ws + WS_W) + WO_GLU, (LAS unsigned char*)dl);
                    }
                }
            }
            }
#endif
            GSYNC();
#if PHM & 16
            for (int rep_ = 0; rep_ < ((REP & 16) ? 2 : 1); ++rep_) {
            for (int ps_ = 0; ps_ < ((REPP == 16) ? 2 : 1); ++ps_)
            for (int u = blockIdx.x; u < 2048; u += gridDim.x) {
                const int ut_ = u < 1024 ? 1 : (u < 2048 ? 2 : (u < 2304 ? 3 : 4));
                if (ps_ == 1 && ut_ != REPU) continue;
                unsigned char* ws = opq(p.ws());
                if (u < 1024) gdn_g3_unit(u >> 8, u & 255, gdn_bufs(ws), (const bf16_t*)(ws + WS_PM), (bf16_t*)(ws + WS_Y), p.in[6] + l * 64, (LAS unsigned char*)dl);
                else rwkv_g3_unit((u - 1024) >> 8, u & 255, rwkv_bufs(ws), (bf16_t*)(ws + WS_Y), p, l, (LAS unsigned char*)dl);
            }
            }
#endif
            GSYNC();
#if PHM & 32
            for (int rep_ = 0; rep_ < ((REP & 32) ? 2 : 1); ++rep_) {
            { unsigned char* ws = opq(p.ws()); merge_phase((const bf16_t*)(ws + WS_Y), (const bf16_t*)(ws + WS_W) + WO_BR, (const bf16_t*)(ws + WS_G), (bf16_t*)(ws + WS_MG), (LAS unsigned char*)dl); }
            }
#endif
            GSYNC();
#if PHM & 64
            {
                unsigned char* ws = opq(p.ws()); const bf16_t* WL = (const bf16_t*)(ws + WS_W);
                pg8::Gemm g{(const bf16_t*)(ws + WS_MG), WL + WO_OUT, TB, D, D, D, D, 0};
                pg8::StaticOrder S; S.init(g.M, g.N, (int)gridDim.x, (int)blockIdx.x);
                pg8::gemm_phase<pg8::EpiResidP, pg8::StaticOrder, false, true>((PG8_LAS unsigned char*)dl, g, S, pg8::EpiResidP{Xin, Xb});
            }
#endif
            GSYNC();
            { unsigned char* ws = opq(p.ws()); rmsnorm_rows(Xb, p.in[37] + l * D, (bf16_t*)(ws + WS_XN), TB); }
            GSYNC();
#if PHM & 128
            for (int rep_ = 0; rep_ < ((REP & 128) ? 2 : 1); ++rep_) {
            {
                unsigned char* ws = opq(p.ws()); const bf16_t* WL = (const bf16_t*)(ws + WS_W);
                pg8::Gemm g{(const bf16_t*)(ws + WS_XN), WL + WO_W1, TB, DFF, D, D, D, 0};
                pg8::StaticOrder S; S.init(g.M, g.N, (int)gridDim.x, (int)blockIdx.x);
                pg8::gemm_phase<pg8::EpiRelu2P, pg8::StaticOrder, true, true>((PG8_LAS unsigned char*)dl, g, S, pg8::EpiRelu2P{(bf16_t*)(ws + WS_HD), DFF, 0});
            }
            }
#endif
            GSYNC();
#if PHM & 256
            {
                unsigned char* ws = opq(p.ws()); const bf16_t* WL = (const bf16_t*)(ws + WS_W);
                pg8::Gemm g{(const bf16_t*)(ws + WS_HD), WL + WO_W2, TB, D, DFF, DFF, DFF, 0};
                pg8::StaticOrder S; S.init(g.M, g.N, (int)gridDim.x, (int)blockIdx.x);
                pg8::gemm_phase<pg8::EpiResidP, pg8::StaticOrder, false, true>((PG8_LAS unsigned char*)dl, g, S, pg8::EpiResidP{Xb, Xb});
            }
#endif
            GSYNC();
        }
    }
    rmsnorm_rows(X, p.in[40], X, 2 * TB);
}

extern "C" void kernel_launch(void* const* d_in, const int* in_sizes, int n_in, void* d_out, int out_size, void* d_ws, size_t ws_size, hipStream_t stream) {
    KParams p{};
    for (int i = 0; i < 41; ++i) p.in[i] = (const float*)d_in[i];
    p.out = (float*)d_out; p.ws = (unsigned char*)d_ws; p.pad = 0;
    static int grid = 0;
    if (grid == 0) {
        int dev = 0, cus = 0, per_cu = 0;
        hipGetDevice(&dev);
        hipDeviceGetAttribute(&cus, hipDeviceAttributeMultiprocessorCount, dev);
        hipFuncSetAttribute((const void*)fwd_fused, hipFuncAttributeMaxDynamicSharedMemorySize, FUSED_LDS + 1024);
        hipOccupancyMaxActiveBlocksPerMultiprocessor(&per_cu, (const void*)fwd_fused, NT, FUSED_LDS + 1024);
        if (per_cu < 1) per_cu = 1;
        grid = cus * per_cu;
        if (grid > 256) grid = 256;
    }
    hipMemsetAsync((unsigned char*)d_ws + WS_CTL, 0, 16384, stream);
    void* args[] = {&p};
    hipError_t e = hipLaunchCooperativeKernel((const void*)fwd_fused, dim3(grid), dim3(NT), args, FUSED_LDS + 1024, stream);
    if (e != hipSuccess) fprintf(stderr, "cooperative launch failed: %s (grid %d)\n", hipGetErrorString(e), grid);
}
```

```cpp
#include <hip/hip_runtime.h>
#ifndef MEXP
#define MEXP 0
#endif
#ifndef PEXP
#define PEXP 0
#endif
#include <hip/hip_cooperative_groups.h>
#include <cstdio>
#include <cstdint>

constexpr int TB = 16384;
constexpr int D = 1024;
constexpr int DIN = 6920;
constexpr int NMIX = 2824;
constexpr int W = 256;
constexpr int DFF = 4096;
constexpr int NT = 512;

constexpr int C_GDN = 0, C_LRU = 1032, C_S5 = 1544, C_RWKV = 1800, C_GATE = 2824;

struct KParams { const float* in[41]; float* out; unsigned char* ws; size_t pad; };
#define LAS __attribute__((address_space(3)))
#define GAS __attribute__((address_space(1)))
struct PIn { LAS const unsigned long long* tab;
    __device__ __forceinline__ const float* operator[](int i) const { LAS const unsigned long long* t = tab; asm volatile("" : "+v"(t)); const unsigned long long v = t[i];
        const unsigned lo = __builtin_amdgcn_readfirstlane((unsigned)v), hi = __builtin_amdgcn_readfirstlane((unsigned)(v >> 32)); return (const float*)(GAS const float*)(((unsigned long long)hi << 32) | lo); } };
struct Params { PIn in;
    __device__ __forceinline__ float* out() const { return (float*)in[41]; }
    __device__ __forceinline__ unsigned char* ws() const { return (unsigned char*)in[42]; } };

typedef unsigned short bf16_t;
constexpr int PMLD = 3072;
constexpr size_t MiB = 1u << 20;
constexpr size_t WS_W  = 0;
constexpr size_t WS_CTL = 35 * MiB;
constexpr size_t WS_XN = 36 * MiB;
constexpr size_t WS_PM = 68 * MiB;
constexpr size_t WS_G  = 164 * MiB;
constexpr size_t WS_HD = 164 * MiB;
constexpr size_t WS_Y  = 292 * MiB;
constexpr size_t WS_MG = 324 * MiB;

__device__ __forceinline__ unsigned f2bf(float f) { unsigned u = __float_as_uint(f); return (u + 0x7fffu + ((u >> 16) & 1u)) >> 16; }
__device__ __forceinline__ float bf2f(bf16_t b) { return __uint_as_float((unsigned)b << 16); }
__device__ __forceinline__ float ldf(const float* p) { return *p; }
__device__ __forceinline__ float ldf(const bf16_t* p) { return bf2f(*p); }
__device__ __forceinline__ float sigmoidf_(float x) { return __builtin_amdgcn_rcpf(1.f + __expf(-x)); }
__device__ __forceinline__ float softplusf_(float x) { const float e = __expf(x); return x > 20.f ? x : (e < 1e-4f ? e : __logf(1.f + e)); }
__device__ __forceinline__ float siluf_(float x) { return x * sigmoidf_(x); }
__device__ __forceinline__ float tanhf_(float y) { return 1.f - 2.f * __builtin_amdgcn_rcpf(1.f + __expf(2.f * y)); }
__device__ __forceinline__ float geluf_(float x) { return 0.5f * x * (1.f + tanhf_(0.7978845608028654f * (x + 0.044715f * x * x * x))); }
__device__ __forceinline__ float rl(float v, int i) { return __int_as_float(__builtin_amdgcn_readlane(__float_as_int(v), i)); }
__device__ __forceinline__ float wave_sum(float v) {
#pragma unroll
    for (int o = 1; o < 64; o <<= 1) v += __shfl_xor(v, o);
    return v;
}

template <class OT>
__device__ __forceinline__ void rmsnorm_rows(const float* X, const float* g, OT* O, int rows) {
    int tid_ = threadIdx.x; asm volatile("" : "+v"(tid_));
    const int lane = tid_ & 63, wv = tid_ >> 6;
    const int gw = blockIdx.x * (NT / 64) + wv, ngw = gridDim.x * (NT / 64);
    for (int r = gw; r < rows; r += ngw) {
        const float4* xr = (const float4*)(X + (size_t)r * D);
        float4 v[4]; float s = 0.f;
#pragma unroll
        for (int j = 0; j < 4; ++j) { v[j] = xr[lane + 64 * j]; s += v[j].x * v[j].x + v[j].y * v[j].y + v[j].z * v[j].z + v[j].w * v[j].w; }
        s = wave_sum(s);
        const float rs = rsqrtf(s * (1.f / D) + 1e-6f);
#pragma unroll
        for (int j = 0; j < 4; ++j) {
            const float4 gg = ((const float4*)g)[lane + 64 * j];
            const float4 o = make_float4(v[j].x * rs * gg.x, v[j].y * rs * gg.y, v[j].z * rs * gg.z, v[j].w * rs * gg.w);
            if constexpr (sizeof(OT) == 4) ((float4*)(O + (size_t)r * D))[lane + 64 * j] = o;
            else ((uint2*)(O + (size_t)r * D))[lane + 64 * j] = make_uint2(f2bf(o.x) | (f2bf(o.y) << 16), f2bf(o.z) | (f2bf(o.w) << 16));
        }
    }
}

namespace pg8 {
#define PG8_LAS __attribute__((address_space(3)))
typedef short bf16x8 __attribute__((ext_vector_type(8)));
typedef float f32x4 __attribute__((ext_vector_type(4)));
typedef unsigned u32x4 __attribute__((ext_vector_type(4)));
constexpr int BM = 256, BK = 64, HALF = 128, HTB = HALF * BK * 2  , STAGE_BYTES = 8 * HTB, NXCD = 8, WGM = 8;

__host__ __device__ __forceinline__ int lds_byte(int r, int c) { const int st = (r >> 4) * 2 + (c >> 5), rr = r & 15, cc = c & 31, ob = rr * 64 + cc * 2; return st * 1024 + (ob ^ (((ob >> 9) & 1) << 5)); }
__host__ __device__ __forceinline__ void stage_rc(int b, int& R, int& C) { const int st = b / 1024, sb = b % 1024, swz = sb ^ (((sb >> 9) & 1) << 5); R = (st >> 1) * 16 + swz / 64; C = (st & 1) * 32 + (swz % 64) / 2; }
__host__ __device__ __forceinline__ int perm32(int rho) { const int n = rho >> 4, i = rho & 15; return 8 * (i >> 2) + 4 * n + (i & 3); }

struct Unit { int pm, pn; };
struct Gemm { const bf16_t* A; const bf16_t* Bt; int M, N, K, lda, ldb, pad; };

struct StaticOrder {
    int nM, nN, nwg, G, c;
    __host__ __device__ void init(int M, int N, int G_, int c_) { nM = M / BM; nN = N / BM; nwg = nM * nN; G = G_; c = c_; }
    __host__ __device__ bool next(int i, Unit& u) const {
        const long L = (long)i * G + c; if (L >= nwg) return false;
        int wgid = (int)L; { const int q = nwg / NXCD, r = nwg % NXCD, xcd = wgid % NXCD, off = wgid / NXCD; wgid = (xcd < r ? xcd * (q + 1) : r * (q + 1) + (xcd - r) * q) + off; }
        const int nig = WGM * nN, gid = wgid / nig, fm = gid * WGM, gsz = (nM - fm) < WGM ? (nM - fm) : WGM;
        u.pm = fm + ((wgid % nig) % gsz); u.pn = (wgid % nig) / gsz; return true;
    }
    __device__ __forceinline__ void a_ready(const Unit&) const {}
    __device__ __forceinline__ void done(const Unit&) const {}
};


typedef __bf16 bf16x2p_t __attribute__((ext_vector_type(2)));
typedef float f32x2p_t __attribute__((ext_vector_type(2)));
__device__ __forceinline__ unsigned cvt_pk_bf16(float lo, float hi) { return __builtin_bit_cast(unsigned, __builtin_convertvector((f32x2p_t){lo, hi}, bf16x2p_t)); }
__device__ __forceinline__ float sigm(float x) { return __builtin_amdgcn_rcpf(1.f + __expf(-x)); }
struct EpiProjP {
    static constexpr bool PERM = true, AFTER_DRAIN = false;
    bf16_t* PM; bf16_t* G;
    __device__ __forceinline__ void operator()(const f32x4 (&acc)[2][2][4][2], const Unit& u, int wr, int wc, int fr, int fq) const {
        const int row0 = u.pm * BM + wr * 64 + fr;
        const bool sg = u.pn >= 12;
        bf16_t* base = sg ? G : PM; const int ld = sg ? 4096 : 3072; const int colt = (sg ? u.pn - 12 : u.pn) * BM;
        const int col0 = colt + wc * 32 + 8 * fq;
#pragma unroll
        for (int ai = 0; ai < 2; ++ai)
#pragma unroll
            for (int m = 0; m < 4; ++m) { bf16_t* rowp = base + (size_t)(row0 + ai * HALF + m * 16) * ld + col0;
#pragma unroll
                for (int bj = 0; bj < 2; ++bj) { f32x4 v0 = acc[ai][bj][m][0], v1 = acc[ai][bj][m][1];
                    if (sg) { v0[0] = sigm(v0[0]); v0[1] = sigm(v0[1]); v0[2] = sigm(v0[2]); v0[3] = sigm(v0[3]); v1[0] = sigm(v1[0]); v1[1] = sigm(v1[1]); v1[2] = sigm(v1[2]); v1[3] = sigm(v1[3]); }
                    u32x4 w; w.x = cvt_pk_bf16(v0[0], v0[1]); w.y = cvt_pk_bf16(v0[2], v0[3]); w.z = cvt_pk_bf16(v1[0], v1[1]); w.w = cvt_pk_bf16(v1[2], v1[3]);
                    *(u32x4*)(rowp + bj * HALF) = w; } }
    }
};
struct EpiRelu2P {
    static constexpr bool PERM = true, AFTER_DRAIN = false;
    bf16_t* O; int ldo; int pad;
    __device__ __forceinline__ void operator()(const f32x4 (&acc)[2][2][4][2], const Unit& u, int wr, int wc, int fr, int fq) const {
        const int row0 = u.pm * BM + wr * 64 + fr, col0 = u.pn * BM + wc * 32 + 8 * fq;
#pragma unroll
        for (int ai = 0; ai < 2; ++ai)
#pragma unroll
            for (int m = 0; m < 4; ++m) { bf16_t* rowp = O + (size_t)(row0 + ai * HALF + m * 16) * ldo + col0;
#pragma unroll
                for (int bj = 0; bj < 2; ++bj) { f32x4 v0 = acc[ai][bj][m][0], v1 = acc[ai][bj][m][1];
#pragma unroll
                    for (int j = 0; j < 4; ++j) { const float a = fmaxf(v0[j], 0.f), b = fmaxf(v1[j], 0.f); v0[j] = a * a; v1[j] = b * b; }
                    u32x4 w; w.x = cvt_pk_bf16(v0[0], v0[1]); w.y = cvt_pk_bf16(v0[2], v0[3]); w.z = cvt_pk_bf16(v1[0], v1[1]); w.w = cvt_pk_bf16(v1[2], v1[3]);
                    *(u32x4*)(rowp + bj * HALF) = w; } }
    }
};
struct EpiResidP {
    static constexpr bool PERM = false, AFTER_DRAIN = false;
    const float* base; float* out;
    __device__ __forceinline__ void operator()(const f32x4 (&acc)[2][2][4][2], const Unit& u, int wr, int wc, int fr, int fq) const {
        const int row0 = u.pm * BM + wr * 64 + fr, col0 = u.pn * BM + wc * 32 + 4 * fq;
#pragma unroll
        for (int ai = 0; ai < 2; ++ai)
#pragma unroll
            for (int m = 0; m < 4; ++m) { const size_t off = (size_t)(row0 + ai * HALF + m * 16) * 1024 + col0;
#pragma unroll
                for (int bj = 0; bj < 2; ++bj)
#pragma unroll
                    for (int n = 0; n < 2; ++n) { const f32x4 b = *(const f32x4*)(base + off + bj * HALF + n * 16); *(f32x4*)(out + off + bj * HALF + n * 16) = b + acc[ai][bj][m][n]; } }
    }
};
template <class Epi, class Sched, bool ALIGN_EPI = false, bool SP2 = false>
__device__ __forceinline__ void gemm_phase(PG8_LAS unsigned char* lds, const Gemm g, const Sched& S, const Epi& E) {
    int tid = threadIdx.x; asm volatile("" : "+v"(tid));
    const int wid = __builtin_amdgcn_readfirstlane(tid >> 6), lane = tid & 63, wr = wid >> 2, wc = wid & 3, fr = lane & 15, fq = lane >> 4;
    const int K = g.K, nt = K / BK;
    unsigned voffA[2], voffB[2];
#pragma unroll
    for (int i = 0; i < 2; ++i) { int R, C; stage_rc(tid * 16 + i * 8192, R, C); const int Rb = Epi::PERM ? ((R & ~31) + perm32(R & 31)) : R;
        voffA[i] = (unsigned)(R * g.lda + C) * 2u; voffB[i] = (unsigned)(Rb * g.ldb + C) * 2u; }
    const size_t kstep = (size_t)(BK * 2);
    const size_t hstepA = (size_t)HALF * g.lda * 2, hstepB = (size_t)HALF * g.ldb * 2;
    const size_t tstepA = 2 * hstepA, tstepB = 2 * hstepB;
    const unsigned ldsw = (unsigned)wid * 1024u;
    const int aoff = lds_byte(wr * 64 + fr, fq * 8), boff = lds_byte(wc * 32 + fr, fq * 8);
#define PG8_SA(b, h) (((b) * 2 + (h)) * HTB)
#define PG8_SB(b, h) ((4 + (b) * 2 + (h)) * HTB)
#define PG8_STAGE(bufoff, gbase, voff) do { _Pragma("unroll") for (int _i = 0; _i < 2; ++_i) \
        __builtin_amdgcn_global_load_lds((const unsigned*)((const char*)(gbase) + (voff)[_i]), (PG8_LAS unsigned*)(lds + (bufoff) + ldsw + _i * 8192), 16, 0, 0); } while (0)
#define PG8_LDA(dst, b, h) do { _Pragma("unroll") for (int m = 0; m < 4; ++m) _Pragma("unroll") for (int k = 0; k < 2; ++k) dst[m][k] = *(const PG8_LAS bf16x8*)(lds + PG8_SA(b, h) + aoff + m * 2048 + k * 1024); } while (0)
#define PG8_LDB(dst, b, h) do { _Pragma("unroll") for (int n = 0; n < 2; ++n) _Pragma("unroll") for (int k = 0; k < 2; ++k) dst[n][k] = *(const PG8_LAS bf16x8*)(lds + PG8_SB(b, h) + boff + n * 2048 + k * 1024); } while (0)
#define PG8_MMA(ai, bj, At, Bt) do { __builtin_amdgcn_s_setprio(1); _Pragma("unroll") for (int m = 0; m < 4; ++m) _Pragma("unroll") for (int n = 0; n < 2; ++n) _Pragma("unroll") for (int k = 0; k < 2; ++k) \
        acc[ai][bj][m][n] = __builtin_amdgcn_mfma_f32_16x16x32_bf16(Bt[n][k], At[m][k], acc[ai][bj][m][n], 0, 0, 0); __builtin_amdgcn_s_setprio(0); } while (0)
#define PG8_WAIT_V(n) asm volatile("s_waitcnt vmcnt(" #n ")" ::: "memory")
#define PG8_WAIT_L(n) asm volatile("s_waitcnt lgkmcnt(" #n ")" ::: "memory")
#define PG8_BAR __builtin_amdgcn_s_barrier()
#define PG8_SCHED __builtin_amdgcn_sched_barrier(0)
    Unit cur, nxt; int ui = 0;
    if (!S.next(0, cur)) return;
    f32x4 acc[2][2][4][2];
#pragma unroll
    for (int a = 0; a < 2; ++a)
#pragma unroll
        for (int b = 0; b < 2; ++b)
#pragma unroll
            for (int m = 0; m < 4; ++m)
#pragma unroll
                for (int n = 0; n < 2; ++n) acc[a][b][m][n] = (f32x4){0.f, 0.f, 0.f, 0.f};
    bf16x8 At[4][2], B0[2][2], B1[2][2];
    const char* cA = (const char*)g.A + (size_t)cur.pm * tstepA; const char* cB = (const char*)g.Bt + (size_t)cur.pn * tstepB;
    S.a_ready(cur);
    if constexpr (SP2) {
        PG8_STAGE(PG8_SB(0, 0), cB, voffB); PG8_STAGE(PG8_SB(0, 1), cB + hstepB, voffB); PG8_STAGE(PG8_SA(0, 0), cA, voffA); PG8_STAGE(PG8_SA(0, 1), cA + hstepA, voffA);
        if (wr == 1) PG8_BAR;
        PG8_WAIT_V(2); PG8_BAR;
        PG8_STAGE(PG8_SB(1, 0), cB + kstep, voffB); PG8_STAGE(PG8_SA(1, 0), cA + kstep, voffA); PG8_STAGE(PG8_SB(1, 1), cB + hstepB + kstep, voffB);
        PG8_WAIT_V(6); PG8_BAR;
    } else {
        PG8_STAGE(PG8_SB(0, 0), cB, voffB); PG8_STAGE(PG8_SA(0, 0), cA, voffA); PG8_STAGE(PG8_SB(0, 1), cB + hstepB, voffB); PG8_STAGE(PG8_SA(0, 1), cA + hstepA, voffA);
        if (wr == 1) PG8_BAR;
        PG8_WAIT_V(4); PG8_BAR;
        PG8_STAGE(PG8_SB(1, 0), cB + kstep, voffB); PG8_STAGE(PG8_SA(1, 0), cA + kstep, voffA); PG8_STAGE(PG8_SB(1, 1), cB + hstepB + kstep, voffB);
        PG8_WAIT_V(6); PG8_BAR;
    }
    for (;;) {
        const bool has_next = S.next(ui + 1, nxt);
        const char* nA = has_next ? (const char*)g.A + (size_t)nxt.pm * tstepA : cA; const char* nB = has_next ? (const char*)g.Bt + (size_t)nxt.pn * tstepB : cB;
        for (int t = 0; t < nt; t += 2) {
            const bool last = (t == nt - 2);
            const char* a1 = cA + (size_t)(t + 1) * kstep;
            const char* a2 = last ? nA : cA + (size_t)(t + 2) * kstep; const char* b2 = last ? nB : cB + (size_t)(t + 2) * kstep;
            const char* a3 = a2 + kstep; const char* b3 = b2 + kstep;
            if (last && has_next) S.a_ready(nxt);
            if constexpr (SP2) {
            PG8_LDB(B0, 0, 0); PG8_LDB(B1, 0, 1); PG8_SCHED; PG8_LDA(At, 0, 0); PG8_STAGE(PG8_SA(1, 1), a1 + hstepA, voffA);
            PG8_WAIT_V(8); PG8_WAIT_L(0); PG8_BAR; PG8_MMA(0, 0, At, B0); PG8_MMA(0, 1, At, B1); PG8_BAR; PG8_SCHED;
            PG8_LDA(At, 0, 1); PG8_STAGE(PG8_SB(0, 0), b2, voffB); PG8_STAGE(PG8_SB(0, 1), b2 + hstepB, voffB); PG8_STAGE(PG8_SA(0, 0), a2, voffA);
            PG8_WAIT_V(8); PG8_WAIT_L(0); PG8_BAR; PG8_MMA(1, 0, At, B0); PG8_MMA(1, 1, At, B1); PG8_BAR; PG8_SCHED;
            PG8_LDB(B0, 1, 0); PG8_LDB(B1, 1, 1); PG8_SCHED; PG8_LDA(At, 1, 0); PG8_STAGE(PG8_SA(0, 1), a2 + hstepA, voffA);
            PG8_WAIT_V(8); PG8_WAIT_L(0); PG8_BAR; PG8_MMA(0, 0, At, B0); PG8_MMA(0, 1, At, B1); PG8_BAR; PG8_SCHED;
            PG8_LDA(At, 1, 1); PG8_STAGE(PG8_SB(1, 0), b3, voffB); PG8_STAGE(PG8_SB(1, 1), b3 + hstepB, voffB); PG8_STAGE(PG8_SA(1, 0), a3, voffA);
            PG8_WAIT_V(8); PG8_WAIT_L(0); PG8_BAR; PG8_MMA(1, 0, At, B0); PG8_MMA(1, 1, At, B1); PG8_BAR; PG8_SCHED;
            } else {
            PG8_LDB(B0, 0, 0); PG8_SCHED; PG8_LDA(At, 0, 0); PG8_STAGE(PG8_SA(1, 1), a1 + hstepA, voffA);
            PG8_WAIT_L(8); PG8_BAR; PG8_WAIT_L(0); PG8_MMA(0, 0, At, B0); PG8_BAR; PG8_SCHED;
            PG8_LDB(B1, 0, 1); PG8_STAGE(PG8_SB(0, 0), b2, voffB);
            PG8_BAR; PG8_WAIT_L(0); PG8_MMA(0, 1, At, B1); PG8_BAR;
            PG8_LDA(At, 0, 1); PG8_STAGE(PG8_SA(0, 0), a2, voffA);
            PG8_BAR; PG8_WAIT_L(0); PG8_MMA(1, 0, At, B0); PG8_BAR; PG8_SCHED;
            PG8_STAGE(PG8_SB(0, 1), b2 + hstepB, voffB);
            PG8_WAIT_V(6); PG8_BAR; PG8_MMA(1, 1, At, B1); PG8_BAR;
            PG8_LDB(B0, 1, 0); PG8_SCHED; PG8_LDA(At, 1, 0); PG8_STAGE(PG8_SA(0, 1), a2 + hstepA, voffA);
            PG8_WAIT_L(8); PG8_BAR; PG8_WAIT_L(0); PG8_MMA(0, 0, At, B0); PG8_BAR; PG8_SCHED;
            PG8_LDB(B1, 1, 1); PG8_STAGE(PG8_SB(1, 0), b3, voffB);
            PG8_BAR; PG8_WAIT_L(0); PG8_MMA(0, 1, At, B1); PG8_BAR;
            PG8_LDA(At, 1, 1); PG8_STAGE(PG8_SA(1, 0), a3, voffA);
            PG8_BAR; PG8_WAIT_L(0); PG8_MMA(1, 0, At, B0); PG8_BAR; PG8_SCHED;
            PG8_STAGE(PG8_SB(1, 1), b3 + hstepB, voffB);
            PG8_WAIT_V(6); PG8_BAR; PG8_MMA(1, 1, At, B1); PG8_BAR;
            }
        }
        if constexpr (ALIGN_EPI) { if (wr == 0) PG8_BAR; }
        if constexpr (!Epi::AFTER_DRAIN) { E(acc, cur, wr, wc, fr, fq); S.done(cur); }
        if (!has_next) break;
#pragma unroll
        for (int a = 0; a < 2; ++a)
#pragma unroll
            for (int b = 0; b < 2; ++b)
#pragma unroll
                for (int m = 0; m < 4; ++m)
#pragma unroll
                    for (int n = 0; n < 2; ++n) acc[a][b][m][n] = (f32x4){0.f, 0.f, 0.f, 0.f};
        cur = nxt; cA = nA; cB = nB; ++ui;
        if constexpr (ALIGN_EPI) { if (wr == 1) PG8_BAR; }
    }
    PG8_WAIT_V(0);
    if constexpr (!ALIGN_EPI) { if (wr == 0) PG8_BAR; }
    PG8_BAR;
    if constexpr (Epi::AFTER_DRAIN) { E.fused(acc, cur, wr, wc, fr, fq, lds, wid, lane); S.done(cur); }
#undef PG8_SA
#undef PG8_SB
#undef PG8_STAGE
#undef PG8_LDA
#undef PG8_LDB
#undef PG8_MMA
#undef PG8_WAIT_V
#undef PG8_WAIT_L
#undef PG8_BAR
#undef PG8_SCHED
}
}


__device__ __forceinline__ unsigned pk2(float lo, float hi) { return f2bf(lo) | (f2bf(hi) << 16); }
template <class CM>
__device__ __forceinline__ void transpose_item(const float* __restrict__ Wsrc, int K, int ldsrc, bf16_t* __restrict__ WT, int nblk, LAS float* scr, int item, int lane, CM colmap) {
    const int kb = item / nblk, nb = item % nblk, k0 = 64 * kb, n0 = 32 * nb;
    const int sc = colmap(n0 + (lane & 31));
#pragma unroll 8
    for (int i = 0; i < 32; ++i) { const int kk = 2 * i + (lane >> 5); scr[kk * 33 + (lane & 31)] = sc >= 0 ? Wsrc[(size_t)(k0 + kk) * ldsrc + sc] : 0.f; }
    asm volatile("s_waitcnt lgkmcnt(0)" ::: "memory");
    const int c = lane & 7;
#pragma unroll
    for (int j = 0; j < 4; ++j) { const int n = (lane >> 3) + 8 * j; const LAS float* s = scr + (8 * c) * 33 + n;
        uint4 o; o.x = pk2(s[0 * 33], s[1 * 33]); o.y = pk2(s[2 * 33], s[3 * 33]); o.z = pk2(s[4 * 33], s[5 * 33]); o.w = pk2(s[6 * 33], s[7 * 33]);
        *(uint4*)(WT + (size_t)(n0 + n) * K + k0 + 8 * c) = o; }
    asm volatile("s_waitcnt lgkmcnt(0)" ::: "memory");
}
constexpr size_t WO_IN = 0;
constexpr size_t WO_BR = WO_IN + (size_t)7168 * 1024;
constexpr size_t WO_OUT = WO_BR + (size_t)4 * 1024 * 256;
constexpr size_t WO_W1 = WO_OUT + (size_t)1024 * 1024;
constexpr size_t WO_W2 = WO_W1 + (size_t)4096 * 1024;
constexpr size_t WO_WUP = WO_W2 + (size_t)4096 * 1024;
constexpr size_t WO_AUP = WO_WUP + 256 * 64;
constexpr size_t WO_GUP = WO_AUP + 256 * 64;
constexpr size_t WO_GLU = WO_GUP + 256 * 128;
constexpr size_t WO_LWT = WO_GLU + 256 * 256;
constexpr size_t WO_LAYER = WO_LWT + 2 * 16384;
__device__ __forceinline__ void convert_weights(const Params& p, int l, LAS float* scr, int gw, int ngw, int lane) {
    bf16_t* WB = (bf16_t*)(p.ws() + WS_W);
    constexpr int I_IN = (1024 / 64) * (7168 / 32), I_BR = (256 / 64) * (1024 / 32), I_OUT = (1024 / 64) * (1024 / 32), I_W1 = (1024 / 64) * (4096 / 32), I_W2 = (4096 / 64) * (1024 / 32);
    constexpr int I_UP = 8, I_GUP = 16, I_GLU = 4 * 8, I_LW = 16;
    constexpr int PER_LAYER = I_IN + 4 * I_BR + I_OUT + I_W1 + I_W2 + 2 * I_UP + I_GUP + I_GLU + I_LW;
    for (int it = gw; it < PER_LAYER; it += ngw) {
        int r = it;
        bf16_t* WL = WB;
        if (r < I_IN) { transpose_item(p.in[2] + (size_t)l * D * DIN, 1024, DIN, WL + WO_IN, 7168 / 32, scr, r, lane, [](int j) { return j < NMIX ? j : (j < 3072 ? -1 : j - 248); }); continue; } r -= I_IN;
        if (r < 4 * I_BR) { const int i = r / I_BR; transpose_item(p.in[35] + ((size_t)l * 4 + i) * W * D, 256, D, WL + WO_BR + (size_t)i * 1024 * 256, 1024 / 32, scr, r % I_BR, lane, [](int j) { return j; }); continue; } r -= 4 * I_BR;
        if (r < I_OUT) { transpose_item(p.in[36] + (size_t)l * D * D, 1024, D, WL + WO_OUT, 1024 / 32, scr, r, lane, [](int j) { return j; }); continue; } r -= I_OUT;
        if (r < I_W1) { transpose_item(p.in[38] + (size_t)l * D * DFF, 1024, DFF, WL + WO_W1, 4096 / 32, scr, r, lane, [](int j) { return j; }); continue; } r -= I_W1;
        if (r < I_W2) { transpose_item(p.in[39] + (size_t)l * DFF * D, 4096, D, WL + WO_W2, 1024 / 32, scr, r, lane, [](int j) { return j; }); continue; } r -= I_W2;
        if (r < I_UP) { transpose_item(p.in[26] + (size_t)l * 64 * W, 64, W, WL + WO_WUP, 8, scr, r, lane, [](int j) { return j; }); continue; } r -= I_UP;
        if (r < I_UP) { transpose_item(p.in[28] + (size_t)l * 64 * W, 64, W, WL + WO_AUP, 8, scr, r, lane, [](int j) { return j; }); continue; } r -= I_UP;
        if (r < I_GUP) { transpose_item(p.in[29] + (size_t)l * 128 * W, 128, W, WL + WO_GUP, 8, scr, r, lane, [](int j) { return j; }); continue; } r -= I_GUP;
        if (r < I_GLU) { transpose_item(p.in[22] + (size_t)l * W * W, 256, W, WL + WO_GLU, 8, scr, r, lane, [](int j) { return j; }); continue; } r -= I_GLU;
        { const int gt = r >> 3, nb = (r >> 1) & 3; transpose_item((gt ? p.in[11] : p.in[9]) + (size_t)l * 16384 + nb * 4096, 64, 64, WL + WO_LWT + (size_t)gt * 16384 + nb * 4096, 2, scr, r & 1, lane, [](int j) { return j; }); }
    }
}
#define BAR() do { asm volatile("s_waitcnt lgkmcnt(0)" ::: "memory"); __syncthreads(); } while (0)
typedef short bf16x8_t __attribute__((ext_vector_type(8)));
typedef float f32x4_t __attribute__((ext_vector_type(4)));
constexpr int PT = 68;
constexpr int MS = 64 * PT;
typedef __bf16 bf16x2v_t __attribute__((ext_vector_type(2)));
typedef float f32x2v_t __attribute__((ext_vector_type(2)));
__device__ __forceinline__ unsigned cvtpk(float lo, float hi) { return __builtin_bit_cast(unsigned, __builtin_convertvector((f32x2v_t){lo, hi}, bf16x2v_t)); }
typedef unsigned u32x4_t __attribute__((ext_vector_type(4)));
union U8 { bf16x8_t v; unsigned u[4]; uint4 q; u32x4_t x; };
__device__ __forceinline__ void split8(const float (&x)[8], bf16x8_t& hi, bf16x8_t& lo) {
    U8 H, L;
#pragma unroll
    for (int i = 0; i < 4; ++i) {
        const unsigned pk = cvtpk(x[2 * i], x[2 * i + 1]);
        H.u[i] = pk;
        const float f0 = __uint_as_float(pk << 16), f1 = __uint_as_float(pk & 0xffff0000u);
        L.u[i] = cvtpk(x[2 * i] - f0, x[2 * i + 1] - f1);
    }
    hi = H.v; lo = L.v;
}
__device__ __forceinline__ bf16x8_t hi8(const float (&x)[8]) {
    U8 H;
#pragma unroll
    for (int i = 0; i < 4; ++i) H.u[i] = cvtpk(x[2 * i], x[2 * i + 1]);
    return H.v;
}
template <int NSPLIT>
__device__ __forceinline__ f32x4_t mm_tile(const LAS float* A, const LAS float* Bt, int lane, f32x4_t acc) {
    const LAS float* ap = A + (lane & 15) * PT + 8 * (lane >> 4);
    const LAS float* bp = Bt + (lane & 15) * PT + 8 * (lane >> 4);
#pragma unroll
    for (int ks = 0; ks < 2; ++ks) {
        const f32x4_t a0 = *(const LAS f32x4_t*)(ap + 32 * ks), a1 = *(const LAS f32x4_t*)(ap + 32 * ks + 4);
        const f32x4_t b0 = *(const LAS f32x4_t*)(bp + 32 * ks), b1 = *(const LAS f32x4_t*)(bp + 32 * ks + 4);
        const float av[8] = {a0.x, a0.y, a0.z, a0.w, a1.x, a1.y, a1.z, a1.w};
        const float bv[8] = {b0.x, b0.y, b0.z, b0.w, b1.x, b1.y, b1.z, b1.w};
        if constexpr (NSPLIT == 3) {
            bf16x8_t ah, al, bh, bl; split8(av, ah, al); split8(bv, bh, bl);
            acc = __builtin_amdgcn_mfma_f32_16x16x32_bf16(ah, bh, acc, 0, 0, 0);
            acc = __builtin_amdgcn_mfma_f32_16x16x32_bf16(ah, bl, acc, 0, 0, 0);
            acc = __builtin_amdgcn_mfma_f32_16x16x32_bf16(al, bh, acc, 0, 0, 0);
        } else {
            acc = __builtin_amdgcn_mfma_f32_16x16x32_bf16(hi8(av), hi8(bv), acc, 0, 0, 0);
        }
    }
    return acc;
}
__device__ __forceinline__ int opq_tid() { int t = threadIdx.x; asm volatile("" : "+v"(t)); return t; }
__device__ __forceinline__ void tri_inverse_wave(LAS float* L, int lane) {
    asm volatile("" : "+v"(lane));
    asm volatile("" : "+v"(L));
    const float lf = (float)lane;
    float x[64];
#pragma unroll
    for (int i = 0; i < 64; ++i) {
        float s0 = 0.f, s1 = 0.f, s2 = 0.f, s3 = 0.f;
#pragma unroll
        for (int g4 = 0; g4 * 4 < i; ++g4) {
            const f32x4_t l = *(const LAS f32x4_t*)(L + i * PT + 4 * g4);
            s0 = fmaf(l.x, x[4 * g4], s0);
            if (4 * g4 + 1 < i) s1 = fmaf(l.y, x[4 * g4 + 1], s1);
            if (4 * g4 + 2 < i) s2 = fmaf(l.z, x[4 * g4 + 2], s2);
            if (4 * g4 + 3 < i) s3 = fmaf(l.w, x[4 * g4 + 3], s3);
        }
        x[i] = fmaxf(1.f - fabsf(lf - (float)i), 0.f) - ((s0 + s1) + (s2 + s3));
        L[i * PT + lane] = x[i];
        if ((i & 3) == 3) __builtin_amdgcn_sched_barrier(0);
    }
}
__device__ __forceinline__ float wave_incl_scan(float v, int lane) {
#pragma unroll
    for (int o = 1; o < 64; o <<= 1) { const float u = __shfl_up(v, o); if (lane >= o) v += u; }
    return v;
}

__device__ __forceinline__ void unpack8(const uint4 u, float (&o)[8]) {
    const unsigned w[4] = {u.x, u.y, u.z, u.w};
#pragma unroll
    for (int i = 0; i < 4; ++i) { o[2 * i] = __uint_as_float(w[i] << 16); o[2 * i + 1] = __uint_as_float(w[i] & 0xffff0000u); }
}
__device__ __forceinline__ uint4 pack8(const float (&x)[8]) { return make_uint4(cvtpk(x[0], x[1]), cvtpk(x[2], x[3]), cvtpk(x[4], x[5]), cvtpk(x[6], x[7])); }
typedef unsigned short LAS lds_bf16;
constexpr int MIX_LDS_C = 8 * MS * 4 + 1024;
__device__ __forceinline__ void merge_phase(const bf16_t* __restrict__ Yb, const bf16_t* __restrict__ WbT, const bf16_t* __restrict__ G, bf16_t* __restrict__ MG, LAS unsigned char* lds) {
    const int tid = opq_tid(), w = __builtin_amdgcn_readfirstlane(tid >> 6), lane = tid & 63, q4 = lane >> 4, cc = lane & 15;
    const int wr = w >> 2, wc = w & 3;
    constexpr int PA = 144;
    constexpr int ABUF = 128 * PA, BUF = 2 * ABUF;
    const int bid = blockIdx.x, G_ = gridDim.x;
    const int srow = tid >> 2, sk = (tid & 3) * 16;
    for (int it = 0; ; ++it) {
        const int U = it * G_ + bid;
        if (U >= 1024) break;
        const int Lx = (G_ == 256) ? ((bid & 7) * 128 + it * 32 + (bid >> 3)) : U;
        const int pm = Lx >> 3, pn = Lx & 7;
        const bf16_t* Abase = Yb + (size_t)(pm * 128 + srow) * 1024 + sk;
        const bf16_t* Bbase = WbT + (size_t)(pn * 128 + srow) * 256 + sk;
        const bf16_t* gbase = G + (size_t)(pm * 128 + wr * 64 + cc) * 4096 + pn * 128 + wc * 32 + 4 * q4;
        f32x4_t mg[4][2], acc[4][2];
#pragma unroll
        for (int m = 0; m < 4; ++m)
#pragma unroll
            for (int n = 0; n < 2; ++n) mg[m][n] = (f32x4_t){0.f, 0.f, 0.f, 0.f};
        uint4 r0[4], r1[4];
        uint2 gq[4][2];
#define MG_LOAD(R, s_) do { const int br_ = (s_) >> 2, kq_ = (s_) & 3; const bf16_t* ap_ = Abase + br_ * 256 + kq_ * 64; const bf16_t* bp_ = Bbase + (size_t)br_ * 1024 * 256 + kq_ * 64; \
            R[0] = *(const uint4*)ap_; R[1] = *(const uint4*)(ap_ + 8); R[2] = *(const uint4*)bp_; R[3] = *(const uint4*)(bp_ + 8); } while (0)
#define MG_STORE(R, buf_) do { LAS unsigned char* ab_ = lds + (buf_) * BUF + srow * PA + sk * 2; \
            *(LAS u32x4_t*)ab_ = (u32x4_t){R[0].x, R[0].y, R[0].z, R[0].w}; *(LAS u32x4_t*)(ab_ + 16) = (u32x4_t){R[1].x, R[1].y, R[1].z, R[1].w}; \
            *(LAS u32x4_t*)(ab_ + ABUF) = (u32x4_t){R[2].x, R[2].y, R[2].z, R[2].w}; *(LAS u32x4_t*)(ab_ + ABUF + 16) = (u32x4_t){R[3].x, R[3].y, R[3].z, R[3].w}; } while (0)
#define MG_COMPUTE(buf_) do { const LAS unsigned char* ab_ = lds + (buf_) * BUF + (wr * 64 + cc) * PA + 16 * q4; const LAS unsigned char* bb_ = lds + (buf_) * BUF + ABUF + (wc * 32 + cc) * PA + 16 * q4; \
            _Pragma("unroll") for (int ks = 0; ks < 2; ++ks) { U8 bf_[2]; \
                _Pragma("unroll") for (int n = 0; n < 2; ++n) bf_[n].x = *(const LAS u32x4_t*)(bb_ + n * 16 * PA + ks * 64); \
                _Pragma("unroll") for (int m = 0; m < 4; ++m) { U8 af_; af_.x = *(const LAS u32x4_t*)(ab_ + m * 16 * PA + ks * 64); \
                    _Pragma("unroll") for (int n = 0; n < 2; ++n) acc[m][n] = __builtin_amdgcn_mfma_f32_16x16x32_bf16(bf_[n].v, af_.v, acc[m][n], 0, 0, 0); } } } while (0)
#define MG_STEP(s_, RL, RS) do { \
            if (((s_) & 3) == 0) { \
                _Pragma("unroll") for (int m = 0; m < 4; ++m) _Pragma("unroll") for (int n = 0; n < 2; ++n) { acc[m][n] = (f32x4_t){0.f, 0.f, 0.f, 0.f}; \
                    gq[m][n] = *(const uint2*)(gbase + ((s_) >> 2) * 1024 + (size_t)m * 16 * 4096 + n * 16); \
                    if (MEXP == 1) { const uint2 gx_ = *(const uint2*)(gbase + ((((s_) >> 2) + 1) & 3) * 1024 + (size_t)m * 16 * 4096 + n * 16); asm volatile("" :: "v"(gx_.x), "v"(gx_.y)); } } } \
            if ((s_) + 2 < 16) MG_LOAD(RL, (s_) + 2); \
            if (MEXP == 2) { uint4 rx_[4]; MG_LOAD(rx_, ((s_) + 6) & 15); asm volatile("" :: "v"(rx_[0].x), "v"(rx_[1].x), "v"(rx_[2].x), "v"(rx_[3].x)); } \
            MG_COMPUTE((s_) & 1); \
            if (MEXP == 3) { f32x4_t sv_[4][2]; _Pragma("unroll") for (int m = 0; m < 4; ++m) _Pragma("unroll") for (int n = 0; n < 2; ++n) sv_[m][n] = acc[m][n]; MG_COMPUTE((s_) & 1); \
                _Pragma("unroll") for (int m = 0; m < 4; ++m) _Pragma("unroll") for (int n = 0; n < 2; ++n) { asm volatile("" :: "v"(acc[m][n])); acc[m][n] = sv_[m][n]; } } \
            if (((s_) & 3) == 3) { \
                _Pragma("unroll") for (int m = 0; m < 4; ++m) _Pragma("unroll") for (int n = 0; n < 2; ++n) { const uint2 g2_ = gq[m][n]; \
                    mg[m][n][0] = fmaf(__uint_as_float(g2_.x << 16), acc[m][n][0], mg[m][n][0]); mg[m][n][1] = fmaf(__uint_as_float(g2_.x & 0xffff0000u), acc[m][n][1], mg[m][n][1]); \
                    mg[m][n][2] = fmaf(__uint_as_float(g2_.y << 16), acc[m][n][2], mg[m][n][2]); mg[m][n][3] = fmaf(__uint_as_float(g2_.y & 0xffff0000u), acc[m][n][3], mg[m][n][3]); } } \
            if ((s_) + 1 < 16) MG_STORE(RS, ((s_) + 1) & 1); \
            BAR(); } while (0)
        MG_LOAD(r0, 0); MG_LOAD(r1, 1);
        MG_STORE(r0, 0);
        BAR();
#pragma unroll 1
        for (int s2 = 0; s2 < 16; s2 += 2) {
            MG_STEP(s2, r0, r1);
            MG_STEP(s2 + 1, r1, r0);
        }
        {
            bf16_t* op = MG + (size_t)(pm * 128 + wr * 64 + cc) * 1024 + pn * 128 + wc * 32 + 4 * q4;
#pragma unroll
            for (int m = 0; m < 4; ++m)
#pragma unroll
                for (int n = 0; n < 2; ++n) *(uint2*)(op + (size_t)m * 16 * 1024 + n * 16) = make_uint2(cvtpk(mg[m][n][0], mg[m][n][1]), cvtpk(mg[m][n][2], mg[m][n][3]));
        }
#undef MG_LOAD
#undef MG_STORE
#undef MG_COMPUTE
#undef MG_STEP
    }
}

constexpr int PB = 72;
constexpr int PLBYTES = 64 * PB * 2;
typedef unsigned u32x2_t __attribute__((ext_vector_type(2)));
__device__ __forceinline__ lds_bf16* plane(LAS unsigned char* lds, int i) { return (lds_bf16*)(lds + i * PLBYTES); }
__device__ __forceinline__ void hilo2(float a, float b, unsigned& h, unsigned& l) { h = cvtpk(a, b); l = cvtpk(a - __uint_as_float(h << 16), b - __uint_as_float(h & 0xffff0000u)); }
__device__ __forceinline__ unsigned short bf_hi(float v) { return (unsigned short)(cvtpk(v, 0.f) & 0xffffu); }
template <bool LO>
__device__ __forceinline__ void put8(lds_bf16* Ph, lds_bf16* Pl, int r, int c0, const float (&x)[8]) {
    unsigned h[4], l[4];
#pragma unroll
    for (int i = 0; i < 4; ++i) hilo2(x[2 * i], x[2 * i + 1], h[i], l[i]);
    *(LAS u32x4_t*)(Ph + r * PB + c0) = (u32x4_t){h[0], h[1], h[2], h[3]};
    if (LO) *(LAS u32x4_t*)(Pl + r * PB + c0) = (u32x4_t){l[0], l[1], l[2], l[3]};
}
template <bool LO>
__device__ __forceinline__ void put8T(lds_bf16* Ph, lds_bf16* Pl, int r, int c0, const float (&x)[8]) {
#pragma unroll
    for (int i = 0; i < 4; ++i) {
        unsigned h, l; hilo2(x[2 * i], x[2 * i + 1], h, l);
        Ph[(c0 + 2 * i) * PB + r] = (unsigned short)(h & 0xffffu); Ph[(c0 + 2 * i + 1) * PB + r] = (unsigned short)(h >> 16);
        if (LO) { Pl[(c0 + 2 * i) * PB + r] = (unsigned short)(l & 0xffffu); Pl[(c0 + 2 * i + 1) * PB + r] = (unsigned short)(l >> 16); }
    }
}
__device__ __forceinline__ bf16x8_t frag(const lds_bf16* P, int row, int k) { U8 u; u.x = *(const LAS u32x4_t*)(P + row * PB + k); return u.v; }
template <bool AL, bool BL>
__device__ __forceinline__ f32x4_t mmp(const lds_bf16* Ah, const lds_bf16* Al, const lds_bf16* Bh, const lds_bf16* Bl, int ar0, int br0, int lane, f32x4_t acc) {
    const int r = lane & 15, k0 = 8 * (lane >> 4);
#pragma unroll
    for (int ks = 0; ks < 2; ++ks) {
        const bf16x8_t ah = frag(Ah, ar0 + r, 32 * ks + k0), bh = frag(Bh, br0 + r, 32 * ks + k0);
        acc = __builtin_amdgcn_mfma_f32_16x16x32_bf16(ah, bh, acc, 0, 0, 0);
        if (AL) acc = __builtin_amdgcn_mfma_f32_16x16x32_bf16(frag(Al, ar0 + r, 32 * ks + k0), bh, acc, 0, 0, 0);
        if (BL) acc = __builtin_amdgcn_mfma_f32_16x16x32_bf16(ah, frag(Bl, br0 + r, 32 * ks + k0), acc, 0, 0, 0);
    }
    return acc;
}
template <bool LO>
__device__ __forceinline__ void st_tile_T(lds_bf16* Ph, lds_bf16* Pl, int i0, int j0, int lane, const f32x4_t a) {
    unsigned h0, l0, h1, l1; hilo2(a[0], a[1], h0, l0); hilo2(a[2], a[3], h1, l1);
    const int o = (j0 + (lane & 15)) * PB + i0 + 4 * (lane >> 4);
    *(LAS u32x2_t*)(Ph + o) = (u32x2_t){h0, h1};
    if (LO) *(LAS u32x2_t*)(Pl + o) = (u32x2_t){l0, l1};
}
template <bool LO>
__device__ __forceinline__ void st_tile_R(lds_bf16* Ph, lds_bf16* Pl, int i0, int j0, int lane, const f32x4_t a) {
    unsigned h0, l0, h1, l1; hilo2(a[0], a[1], h0, l0); hilo2(a[2], a[3], h1, l1);
    const int o = (i0 + 4 * (lane >> 4)) * PB + j0 + (lane & 15);
    Ph[o] = (unsigned short)(h0 & 0xffffu); Ph[o + PB] = (unsigned short)(h0 >> 16); Ph[o + 2 * PB] = (unsigned short)(h1 & 0xffffu); Ph[o + 3 * PB] = (unsigned short)(h1 >> 16);
    if (LO) { Pl[o] = (unsigned short)(l0 & 0xffffu); Pl[o + PB] = (unsigned short)(l0 >> 16); Pl[o + 2 * PB] = (unsigned short)(l1 & 0xffffu); Pl[o + 3 * PB] = (unsigned short)(l1 >> 16); }
}
constexpr int LM_OFF = 13 * PLBYTES;
constexpr int VEC_OFF = LM_OFF + MS * 4;
static_assert(VEC_OFF + 1024 <= MIX_LDS_C, "plane LDS map");

struct GdnBufs { bf16_t *GQ, *GK, *GV; float *GB, *GC; uint4* MF; float* NF; float* HT; bf16_t* TG; };
__device__ __forceinline__ void gdn_prep_chunk(const bf16_t* __restrict__ PM, int n, const GdnBufs& B, const Params& p, int l, LAS float* lds) {
    const int tid = opq_tid(), w = tid >> 6, lane = tid & 63;
    const float* conv_w = p.in[3] + l * 4 * 768;
    const int t0 = n * 64;
    float wq[4][4], wk[4][4], wv[4][4];
#pragma unroll
    for (int t = 0; t < 4; ++t)
#pragma unroll
        for (int j = 0; j < 4; ++j) { wq[t][j] = conv_w[t * 768 + 4 * lane + j]; wk[t][j] = conv_w[t * 768 + 256 + 4 * lane + j]; wv[t][j] = conv_w[t * 768 + 512 + 4 * lane + j]; }
    float hq[3][4], hk[3][4], hv[3][4];
    auto ld4 = [&](int t, int col, float (&o)[4]) {
        if (t < 0) { o[0] = o[1] = o[2] = o[3] = 0.f; return; }
        const uint2 u = *(const uint2*)(PM + (size_t)t * PMLD + col);
        o[0] = __uint_as_float(u.x << 16); o[1] = __uint_as_float(u.x & 0xffff0000u); o[2] = __uint_as_float(u.y << 16); o[3] = __uint_as_float(u.y & 0xffff0000u);
    };
    const int tw = t0 + 8 * w;
#pragma unroll
    for (int i = 0; i < 3; ++i) { ld4(tw - 3 + i, 4 * lane, hq[i]); ld4(tw - 3 + i, 256 + 4 * lane, hk[i]); ld4(tw - 3 + i, 512 + 4 * lane, hv[i]); }
#pragma unroll
    for (int i = 0; i < 8; ++i) {
        const int t = tw + i;
        float pq[4], pk[4], pv[4], q[4], k[4], v[4];
        ld4(t, 4 * lane, pq); ld4(t, 256 + 4 * lane, pk); ld4(t, 512 + 4 * lane, pv);
        float sq = 0.f, sk = 0.f;
#pragma unroll
        for (int j = 0; j < 4; ++j) {
            q[j] = siluf_(wq[0][j] * hq[0][j] + wq[1][j] * hq[1][j] + wq[2][j] * hq[2][j] + wq[3][j] * pq[j]);
            k[j] = siluf_(wk[0][j] * hk[0][j] + wk[1][j] * hk[1][j] + wk[2][j] * hk[2][j] + wk[3][j] * pk[j]);
            v[j] = siluf_(wv[0][j] * hv[0][j] + wv[1][j] * hv[1][j] + wv[2][j] * hv[2][j] + wv[3][j] * pv[j]);
            hq[0][j] = hq[1][j]; hq[1][j] = hq[2][j]; hq[2][j] = pq[j];
            hk[0][j] = hk[1][j]; hk[1][j] = hk[2][j]; hk[2][j] = pk[j];
            hv[0][j] = hv[1][j]; hv[1][j] = hv[2][j]; hv[2][j] = pv[j];
            sq = fmaf(q[j], q[j], sq); sk = fmaf(k[j], k[j], sk);
        }
#pragma unroll
        for (int o = 1; o < 16; o <<= 1) { sq += __shfl_xor(sq, o); sk += __shfl_xor(sk, o); }
        const float rq = rsqrtf(sq + 1e-6f) * 0.125f, rk = rsqrtf(sk + 1e-6f);
        uint2 oq, ok, ov;
        oq.x = cvtpk(q[0] * rq, q[1] * rq); oq.y = cvtpk(q[2] * rq, q[3] * rq);
        ok.x = cvtpk(k[0] * rk, k[1] * rk); ok.y = cvtpk(k[2] * rk, k[3] * rk);
        ov.x = cvtpk(v[0], v[1]); ov.y = cvtpk(v[2], v[3]);
        *(uint2*)(B.GQ + (size_t)t * 256 + 4 * lane) = oq;
        *(uint2*)(B.GK + (size_t)t * 256 + 4 * lane) = ok;
        *(uint2*)(B.GV + (size_t)t * 256 + 4 * lane) = ov;
    }
    if (tid < 256) {
        const int t = tid >> 2, h = tid & 3;
        const bf16_t* row = PM + (size_t)(t0 + t) * PMLD;
        B.GB[(size_t)(t0 + t) * 4 + h] = sigmoidf_(bf2f(row[1024 + h]));
        const float* alog_ = p.in[4] + l * 4; const float* dtb_ = p.in[5] + l * 4;
        const float g = -__expf(alog_[h]) * softplusf_(bf2f(row[1028 + h]) + dtb_[h]);
        lds[h * 64 + t] = g;
    }
    BAR();
    if (w == 0) {
#pragma unroll
        for (int h = 0; h < 4; ++h) B.GC[(size_t)(t0 + lane) * 4 + h] = wave_incl_scan(lds[h * 64 + lane], lane);
    }
    BAR();
}

__device__ __forceinline__ float dpp_xor1(float v) { return __int_as_float(__builtin_amdgcn_update_dpp(0, __float_as_int(v), 0xB1, 0xF, 0xF, false)); }
__device__ __forceinline__ float dpp_xor2(float v) { return __int_as_float(__builtin_amdgcn_update_dpp(0, __float_as_int(v), 0x4E, 0xF, 0xF, false)); }
__device__ __forceinline__ void tri_inverse_4w(const LAS float* Lp, lds_bf16* Th, lds_bf16* Tl, int wq, int lane) {
    asm volatile("" : "+v"(lane));
    const int g = lane & 3, j = 16 * wq + (lane >> 2);
    const LAS float* base = Lp + g * 16; asm volatile("" : "+v"(base));
    const float jf = (float)j;
    float x[16];
#pragma unroll
    for (int m = 0; m < 16; ++m) x[m] = 0.f;
    f32x4_t cur[4], nxt[4];
#pragma unroll
    for (int q = 0; q < 4; ++q) cur[q] = (f32x4_t){0.f, 0.f, 0.f, 0.f};
#pragma unroll
    for (int i = 0; i < 64; ++i) {
        if (i + 1 < 64) {
#pragma unroll
            for (int q = 0; q < 4; ++q) if (16 * q < i + 1) nxt[q] = *(const LAS f32x4_t*)(base + (i + 1) * PT + 4 * q);
        }
        float s0 = 0.f, s1 = 0.f;
#pragma unroll
        for (int q = 0; q < 4; ++q) if (16 * q < i) {
            s0 = fmaf(cur[q].x, x[4 * q], s0); if (16 * q + 4 < i) s1 = fmaf(cur[q].y, x[4 * q + 1], s1);
            if (16 * q + 8 < i) s0 = fmaf(cur[q].z, x[4 * q + 2], s0); if (16 * q + 12 < i) s1 = fmaf(cur[q].w, x[4 * q + 3], s1);
        }
        float t = s0 + s1;
        t += dpp_xor1(t); t += dpp_xor2(t);
        const float xi = fmaxf(1.f - fabsf(jf - (float)i), 0.f) - t;
        if (g == (i & 3)) x[i >> 2] = xi;
        unsigned hh, ll; hilo2(xi, xi, hh, ll);
        if (g == 0) Th[i * PB + j] = (unsigned short)(hh & 0xffffu);
        if (g == 1) Tl[i * PB + j] = (unsigned short)(ll & 0xffffu);
#pragma unroll
        for (int q = 0; q < 4; ++q) cur[q] = nxt[q];
    }
}
__device__ __forceinline__ void gdn_g1_unit(int h, int n, const GdnBufs& B, bf16_t* __restrict__ Y, LAS unsigned char* lds) {
    const int tid = opq_tid(), w = tid >> 6, lane = tid & 63, q4 = lane >> 4, cc = lane & 15;
    lds_bf16 *Krh = plane(lds, 0), *Krl = plane(lds, 1), *KdTh = plane(lds, 2), *KdTl = plane(lds, 3), *KbTh = plane(lds, 4), *KbTl = plane(lds, 5);
    lds_bf16 *VbTh = plane(lds, 6), *VbTl = plane(lds, 7), *Th = plane(lds, 8), *Tl = plane(lds, 9), *WmTh = plane(lds, 10), *WmTl = plane(lds, 11);
    lds_bf16 *U0Th = Krh, *U0Tl = Krl;
    LAS float* Lm = (LAS float*)(lds + LM_OFF); LAS float* sb = (LAS float*)(lds + VEC_OFF); LAS float* sg = sb + 64;
    const int t0 = n * 64, u = h * 256 + n;
    const int c = tid >> 3, d0 = (tid & 7) * 8;
    {
        const float beta = B.GB[(size_t)(t0 + c) * 4 + h], gc = B.GC[(size_t)(t0 + c) * 4 + h], gl = B.GC[(size_t)(t0 + 63) * 4 + h];
        float kf[8], vf[8], x1[8], x2[8], x3[8];
        unpack8(*(const uint4*)(B.GK + (size_t)(t0 + c) * 256 + h * 64 + d0), kf);
        unpack8(*(const uint4*)(B.GV + (size_t)(t0 + c) * 256 + h * 64 + d0), vf);
        const float e1 = __expf(gl - gc), e2 = beta * __expf(gc);
#pragma unroll
        for (int i = 0; i < 8; ++i) { x1[i] = kf[i] * e1; x2[i] = kf[i] * e2; x3[i] = beta * vf[i]; }
        put8<true>(Krh, Krl, c, d0, kf); put8T<true>(KdTh, KdTl, c, d0, x1); put8T<true>(KbTh, KbTl, c, d0, x2); put8T<true>(VbTh, VbTl, c, d0, x3);
        if ((tid & 7) == 0) { sb[c] = beta; sg[c] = gc; }
    }
    BAR();
    const int ti = w >> 1, tj0 = (w & 1) * 2;
    const f32x4_t zero4 = {0.f, 0.f, 0.f, 0.f};
#pragma unroll
    for (int tt = 0; tt < 2; ++tt) {
        const int tj = tj0 + tt;
        const int j = 16 * tj + cc, jp = (j & 3) * 16 + (j >> 2);
        f32x4_t lv = zero4;
        if (tj <= ti) {
            const f32x4_t a = mmp<true, true>(Krh, Krl, Krh, Krl, 16 * ti, 16 * tj, lane, zero4);
            const float gj = sg[j];
#pragma unroll
            for (int r = 0; r < 4; ++r) { const int i = 16 * ti + 4 * q4 + r; lv[r] = (i > j) ? sb[i] * a[r] * __expf(sg[i] - gj) : 0.f; }
        }
#pragma unroll
        for (int r = 0; r < 4; ++r) Lm[(16 * ti + 4 * q4 + r) * PT + jp] = lv[r];
    }
    BAR();
    if (w < 4) tri_inverse_4w(Lm, Th, Tl, w, lane);
    BAR();
    { const u32x4_t t4 = *(const LAS u32x4_t*)(Th + c * PB + d0); *(uint4*)(B.TG + (size_t)u * 4096 + c * 64 + d0) = make_uint4(t4.x, t4.y, t4.z, t4.w);
      const u32x4_t t5 = *(const LAS u32x4_t*)(Tl + c * PB + d0); *(uint4*)(Y + (size_t)(t0 + c) * D + h * 64 + d0) = make_uint4(t5.x, t5.y, t5.z, t5.w); }
#pragma unroll
    for (int tt = 0; tt < 2; ++tt) {
        const int tj = tj0 + tt;
        st_tile_T<true>(U0Th, U0Tl, 16 * ti, 16 * tj, lane, mmp<true, true>(Th, Tl, VbTh, VbTl, 16 * ti, 16 * tj, lane, zero4));
        st_tile_T<true>(WmTh, WmTl, 16 * ti, 16 * tj, lane, mmp<true, true>(Th, Tl, KbTh, KbTl, 16 * ti, 16 * tj, lane, zero4));
    }
    BAR();
    {
        const float egl = __expf(B.GC[(size_t)(t0 + 63) * 4 + h]);
#pragma unroll
        for (int tt = 0; tt < 2; ++tt) {
            const int tj = tj0 + tt;
            const f32x4_t a = mmp<true, true>(KdTh, KdTl, WmTh, WmTl, 16 * ti, 16 * tj, lane, zero4);
#pragma unroll
            for (int r = 0; r < 4; ++r) { const int ar = 16 * ti + 4 * q4 + r, bc = 16 * tj + cc; Lm[ar * PT + bc] = (ar == bc ? egl : 0.f) - a[r]; }
            const f32x4_t nn = mmp<true, true>(KdTh, KdTl, U0Th, U0Tl, 16 * ti, 16 * tj, lane, zero4);
            *(float4*)(B.NF + (size_t)u * 4096 + (tj * 64 + lane) * 16 + ti * 4) = make_float4(nn[0], nn[1], nn[2], nn[3]);
        }
    }
    BAR();
    {
        const int combo = tid >> 6, mt = combo >> 1, s = combo & 1, i = lane & 15, qq = lane >> 4;
        const f32x4_t x0 = *(const LAS f32x4_t*)(Lm + (16 * mt + i) * PT + 32 * s + 4 * qq);
        const f32x4_t x1 = *(const LAS f32x4_t*)(Lm + (16 * mt + i) * PT + 32 * s + 16 + 4 * qq);
        const float xv[8] = {x0.x, x0.y, x0.z, x0.w, x1.x, x1.y, x1.z, x1.w};
        U8 H, L; split8(xv, H.v, L.v);
        uint4* mf = B.MF + (size_t)u * 1024 + (size_t)(combo * 2) * 64 + lane;
        mf[0] = H.q; mf[64] = L.q;
    }
    BAR();
}

constexpr int CH_SLOT = 20480, CH_RING = 6;
__device__ __forceinline__ void chain_wave(float* __restrict__ HT, int cb, int nchunk, int lane, LAS unsigned char* ring, volatile LAS unsigned* flags  ) {
    const int q4 = lane >> 4, cc = lane & 15;
    f32x4_t H[4];
#pragma unroll
    for (int m = 0; m < 4; ++m) H[m] = (f32x4_t){0.f, 0.f, 0.f, 0.f};
    U8 mf[16]; f32x4_t nf[4];
    {
        while (flags[0] != 1u) __builtin_amdgcn_s_sleep(1);
        asm volatile("" ::: "memory");
        const LAS unsigned char* sp = ring + lane * 16;
#pragma unroll
        for (int i = 0; i < 16; ++i) mf[i].x = *(const LAS u32x4_t*)(sp + i * 1024);
#pragma unroll
        for (int m = 0; m < 4; ++m) nf[m] = *(const LAS f32x4_t*)(sp + (16 + m) * 1024);
        asm volatile("s_waitcnt lgkmcnt(0)" ::: "memory");
        if (lane == 0) flags[8] = 1u;
    }
    for (int ch = 0; ch < nchunk; ++ch) {
        float* ht = HT + (size_t)ch * 4096 + (16 * cb + cc) * 64 + 4 * q4;
#pragma unroll
        for (int m = 0; m < 4; ++m) *(float4*)(ht + 16 * m) = make_float4(H[m][0], H[m][1], H[m][2], H[m][3]);
        bf16x8_t bh[2], bl[2];
#pragma unroll
        for (int s = 0; s < 2; ++s) {
            const float xv[8] = {H[2 * s][0], H[2 * s][1], H[2 * s][2], H[2 * s][3], H[2 * s + 1][0], H[2 * s + 1][1], H[2 * s + 1][2], H[2 * s + 1][3]};
            split8(xv, bh[s], bl[s]);
        }
#pragma unroll
        for (int m = 0; m < 4; ++m) {
            f32x4_t acc = nf[m];
#pragma unroll
            for (int s = 0; s < 2; ++s) {
                acc = __builtin_amdgcn_mfma_f32_16x16x32_bf16(mf[(m * 2 + s) * 2].v, bh[s], acc, 0, 0, 0);
                acc = __builtin_amdgcn_mfma_f32_16x16x32_bf16(mf[(m * 2 + s) * 2].v, bl[s], acc, 0, 0, 0);
                acc = __builtin_amdgcn_mfma_f32_16x16x32_bf16(mf[(m * 2 + s) * 2 + 1].v, bh[s], acc, 0, 0, 0);
            }
            H[m] = acc;
        }
        if (ch + 1 < nchunk) {
            const int slot = (ch + 1) % CH_RING;
            while (flags[slot] != (unsigned)(ch + 2)) __builtin_amdgcn_s_sleep(1);
            asm volatile("" ::: "memory");
            const LAS unsigned char* sp = ring + slot * CH_SLOT + lane * 16;
#pragma unroll
            for (int i = 0; i < 16; ++i) mf[i].x = *(const LAS u32x4_t*)(sp + i * 1024);
#pragma unroll
            for (int m = 0; m < 4; ++m) nf[m] = *(const LAS f32x4_t*)(sp + (16 + m) * 1024);
            asm volatile("s_waitcnt lgkmcnt(0)" ::: "memory");
            if (lane == 0) flags[8] = (unsigned)(ch + 2);
        }
    }
}
__device__ __forceinline__ void chain_loader(const uint4* __restrict__ MF, const float* __restrict__ NF, int cb, int nchunk, int lane, int lw, LAS unsigned char* ring, volatile LAS unsigned* flags) {
    for (int ch = lw; ch < nchunk; ch += 7) {
        uint4 m[16]; float4 nn[4];
#pragma unroll
        for (int i = 0; i < 16; ++i) m[i] = MF[(size_t)ch * 1024 + (size_t)i * 64 + lane];
#pragma unroll
        for (int k = 0; k < 4; ++k) nn[k] = *(const float4*)(NF + (size_t)ch * 4096 + (cb * 64 + lane) * 16 + k * 4);
        while ((int)flags[8] + CH_RING <= ch) __builtin_amdgcn_s_sleep(2);
        asm volatile("" ::: "memory");
        LAS unsigned char* sp = ring + (ch % CH_RING) * CH_SLOT + lane * 16;
#pragma unroll
        for (int i = 0; i < 16; ++i) *(LAS u32x4_t*)(sp + i * 1024) = (u32x4_t){m[i].x, m[i].y, m[i].z, m[i].w};
#pragma unroll
        for (int k = 0; k < 4; ++k) *(LAS f32x4_t*)(sp + (16 + k) * 1024) = (f32x4_t){nn[k].x, nn[k].y, nn[k].z, nn[k].w};
        asm volatile("s_waitcnt lgkmcnt(0)" ::: "memory");
        if (lane == 0) flags[ch % CH_RING] = (unsigned)(ch + 1);
    }
}

__device__ __forceinline__ void gdn_g3_unit(int h, int n, const GdnBufs& B, const bf16_t* __restrict__ PM, bf16_t* __restrict__ Y, const float* __restrict__ norm_g, LAS unsigned char* lds) {
    const int tid = opq_tid(), w = tid >> 6, lane = tid & 63, q4 = lane >> 4, cc = lane & 15;
    lds_bf16 *Qr = plane(lds, 0), *Qd = plane(lds, 1), *Kr = plane(lds, 2), *KbT = plane(lds, 3), *VbT = plane(lds, 4), *Tp = plane(lds, 5);
    lds_bf16 *At = plane(lds, 6), *Wm = plane(lds, 7), *HTh = plane(lds, 8), *HTl = plane(lds, 9), *VnT = plane(lds, 10), *Tq = plane(lds, 11);
    LAS float* Os = (LAS float*)(lds + LM_OFF); LAS float* sb = (LAS float*)(lds + VEC_OFF); LAS float* sg = sb + 64;
    const int t0 = n * 64, u = h * 256 + n;
    const int c = tid >> 3, d0 = (tid & 7) * 8;
    {
        const float beta = B.GB[(size_t)(t0 + c) * 4 + h], gc = B.GC[(size_t)(t0 + c) * 4 + h];
        float qf[8], kf[8], vf[8], x1[8], x2[8], x3[8];
        unpack8(*(const uint4*)(B.GQ + (size_t)(t0 + c) * 256 + h * 64 + d0), qf);
        unpack8(*(const uint4*)(B.GK + (size_t)(t0 + c) * 256 + h * 64 + d0), kf);
        unpack8(*(const uint4*)(B.GV + (size_t)(t0 + c) * 256 + h * 64 + d0), vf);
        const uint4 t8 = *(const uint4*)(B.TG + (size_t)u * 4096 + c * 64 + d0);
        const uint4 t9 = *(const uint4*)(Y + (size_t)(t0 + c) * D + h * 64 + d0);
        const float* ht = B.HT + (size_t)u * 4096 + c * 64 + d0;
        const float4 h0 = *(const float4*)ht, h1 = *(const float4*)(ht + 4);
        const float eg = __expf(gc), e2 = beta * eg;
#pragma unroll
        for (int i = 0; i < 8; ++i) { x1[i] = qf[i] * eg; x2[i] = kf[i] * e2; x3[i] = beta * vf[i]; }
        put8<false>(Qr, Qr, c, d0, qf); put8<false>(Qd, Qd, c, d0, x1); put8<false>(Kr, Kr, c, d0, kf);
        put8T<false>(KbT, KbT, c, d0, x2); put8T<false>(VbT, VbT, c, d0, x3);
        *(LAS u32x4_t*)(Tp + c * PB + d0) = (u32x4_t){t8.x, t8.y, t8.z, t8.w};
        *(LAS u32x4_t*)(Tq + c * PB + d0) = (u32x4_t){t9.x, t9.y, t9.z, t9.w};
        const float hv[8] = {h0.x, h0.y, h0.z, h0.w, h1.x, h1.y, h1.z, h1.w};
        put8<true>(HTh, HTl, c, d0, hv);
        if ((tid & 7) == 0) { sb[c] = beta; sg[c] = gc; }
    }
    BAR();
    const int ti = w >> 1, tj0 = (w & 1) * 2;
    const f32x4_t zero4 = {0.f, 0.f, 0.f, 0.f};
    f32x4_t u0[2];
#pragma unroll
    for (int tt = 0; tt < 2; ++tt) {
        const int tj = tj0 + tt;
        f32x4_t at = zero4;
        if (tj <= ti) {
            const f32x4_t s = mmp<false, false>(Qr, Qr, Kr, Kr, 16 * ti, 16 * tj, lane, zero4);
            const int j = 16 * tj + cc; const float gj = sg[j];
#pragma unroll
            for (int r = 0; r < 4; ++r) { const int i = 16 * ti + 4 * q4 + r; at[r] = (i >= j) ? s[r] * __expf(fminf(sg[i] - gj, 0.f)) : 0.f; }
        }
        st_tile_R<false>(At, At, 16 * ti, 16 * tj, lane, at);
        u0[tt] = mmp<true, false>(Tp, Tq, VbT, VbT, 16 * ti, 16 * tj, lane, zero4);
        st_tile_R<false>(Wm, Wm, 16 * ti, 16 * tj, lane, mmp<true, false>(Tp, Tq, KbT, KbT, 16 * ti, 16 * tj, lane, zero4));
    }
    BAR();
    f32x4_t o[2];
#pragma unroll
    for (int tt = 0; tt < 2; ++tt) {
        const int tj = tj0 + tt;
        const f32x4_t wh = mmp<false, true>(Wm, Wm, HTh, HTl, 16 * ti, 16 * tj, lane, zero4);
        o[tt] = mmp<false, true>(Qd, Qd, HTh, HTl, 16 * ti, 16 * tj, lane, zero4);
        st_tile_T<false>(VnT, VnT, 16 * ti, 16 * tj, lane, u0[tt] - wh);
    }
    BAR();
#pragma unroll
    for (int tt = 0; tt < 2; ++tt) {
        const int tj = tj0 + tt;
        o[tt] = mmp<false, false>(At, At, VnT, VnT, 16 * ti, 16 * tj, lane, o[tt]);
#pragma unroll
        for (int r = 0; r < 4; ++r) Os[(16 * ti + 4 * q4 + r) * PT + 16 * tj + cc] = o[tt][r];
    }
    BAR();
    {
        const f32x4_t x0 = *(const LAS f32x4_t*)(Os + c * PT + d0), x1 = *(const LAS f32x4_t*)(Os + c * PT + d0 + 4);
        float xv[8] = {x0.x, x0.y, x0.z, x0.w, x1.x, x1.y, x1.z, x1.w};
        float ss = 0.f;
#pragma unroll
        for (int i = 0; i < 8; ++i) ss = fmaf(xv[i], xv[i], ss);
        ss += __shfl_xor(ss, 1); ss += __shfl_xor(ss, 2); ss += __shfl_xor(ss, 4);
        const float rs = rsqrtf(ss * (1.f / 64.f) + 1e-6f);
        float zf[8]; unpack8(*(const uint4*)(PM + (size_t)(t0 + c) * PMLD + 768 + h * 64 + d0), zf);
        float y[8];
#pragma unroll
        for (int i = 0; i < 8; ++i) y[i] = xv[i] * rs * norm_g[d0 + i] * siluf_(zf[i]);
        *(uint4*)(Y + (size_t)(t0 + c) * D + h * 64 + d0) = pack8(y);
    }
    BAR();
}

struct RwkvBufs { bf16_t *RR, *RK, *RV, *RKK, *RA, *RG; float* CW; uint4* MF; float* NF; float* HT; bf16_t* TG; };
__device__ __forceinline__ void rwkv_prep_chunk(const bf16_t* __restrict__ PM, int n, const RwkvBufs& B, const Params& p, int l, const bf16_t* __restrict__ WUPT, const bf16_t* __restrict__ AUPT, const bf16_t* __restrict__ GUPT, LAS unsigned char* lds) {
    const int tid = opq_tid(), w = tid >> 6, lane = tid & 63, q4 = lane >> 4, cc = lane & 15;
    const int t0 = n * 64;
    const float* mu = p.in[24] + l * 1024;
    lds_bf16* Awd = (lds_bf16*)lds; lds_bf16* Aad = Awd + 64 * 72; lds_bf16* Agd = Aad + 64 * 72;
    lds_bf16* La = Agd + 64 * 136; lds_bf16* Lg = La + 64 * 264; lds_bf16* Llw = Lg + 64 * 264;
    for (int px1_ = 0; px1_ < ((PEXP == 1) ? 2 : 1); ++px1_)
    {
        const int t = tid >> 3, c0 = (tid & 7) * 8;
        const bf16_t* row = PM + (size_t)(t0 + t) * PMLD + C_RWKV + 768 + c0;
        const bool hasprev = (t0 + t) > 0;
#pragma unroll
        for (int g8 = 0; g8 < 4; ++g8) {
            float x[8], xp[8];
            unpack8(*(const uint4*)(row + 64 * g8), x);
            if (hasprev) unpack8(*(const uint4*)(row - PMLD + 64 * g8), xp); else {
#pragma unroll
                for (int i = 0; i < 8; ++i) xp[i] = 0.f; }
            const int col = c0 + 64 * g8;
            float y[8];
#pragma unroll
            for (int i = 0; i < 8; ++i) {
                const float v = x[i] + mu[768 + col + i] * (xp[i] - x[i]);
                y[i] = col < 64 ? tanhf_(v) : (col < 128 ? v : sigmoidf_(v));
            }
            const uint4 pk = pack8(y);
            if (col < 64) *(LAS u32x4_t*)(Awd + t * 72 + col) = (u32x4_t){pk.x, pk.y, pk.z, pk.w};
            else if (col < 128) *(LAS u32x4_t*)(Aad + t * 72 + (col - 64)) = (u32x4_t){pk.x, pk.y, pk.z, pk.w};
            else *(LAS u32x4_t*)(Agd + t * 136 + (col - 128)) = (u32x4_t){pk.x, pk.y, pk.z, pk.w};
        }
    }
    BAR();
    const int hh = w >> 1, tt0 = 2 * (w & 1);
    for (int px2_ = 0; px2_ < ((PEXP == 2) ? 2 : 1); ++px2_)
    {
        const float* w0 = p.in[25] + l * W; const float* a0 = p.in[27] + l * W;
#pragma unroll 2
        for (int b = 0; b < 4; ++b) {
            const int ncol = 64 * hh + 16 * b + cc;
            f32x4_t accw[2], acca[2], accg[2];
#pragma unroll
            for (int a = 0; a < 2; ++a) { accw[a] = (f32x4_t){0.f, 0.f, 0.f, 0.f}; acca[a] = accw[a]; accg[a] = accw[a]; }
#pragma unroll
            for (int ks = 0; ks < 4; ++ks) {
                U8 bw, ba, bg;
                bg.q = *(const uint4*)(GUPT + (size_t)ncol * 128 + 32 * ks + 8 * q4);
                if (ks < 2) { bw.q = *(const uint4*)(WUPT + (size_t)ncol * 64 + 32 * ks + 8 * q4); ba.q = *(const uint4*)(AUPT + (size_t)ncol * 64 + 32 * ks + 8 * q4); }
#pragma unroll
                for (int a = 0; a < 2; ++a) {
                    const int row = 16 * (tt0 + a) + cc;
                    U8 ag; ag.x = *(const LAS u32x4_t*)(Agd + row * 136 + 32 * ks + 8 * q4);
                    accg[a] = __builtin_amdgcn_mfma_f32_16x16x32_bf16(ag.v, bg.v, accg[a], 0, 0, 0);
                    if (ks < 2) {
                        U8 aw, aa; aw.x = *(const LAS u32x4_t*)(Awd + row * 72 + 32 * ks + 8 * q4); aa.x = *(const LAS u32x4_t*)(Aad + row * 72 + 32 * ks + 8 * q4);
                        accw[a] = __builtin_amdgcn_mfma_f32_16x16x32_bf16(aw.v, bw.v, accw[a], 0, 0, 0);
                        acca[a] = __builtin_amdgcn_mfma_f32_16x16x32_bf16(aa.v, ba.v, acca[a], 0, 0, 0);
                    }
                }
            }
            const float w0n = w0[ncol], a0n = a0[ncol];
#pragma unroll
            for (int a = 0; a < 2; ++a)
#pragma unroll
                for (int r = 0; r < 4; ++r) {
                    const int t = 16 * (tt0 + a) + 4 * q4 + r;
                    const float logw = -softplusf_(-(w0n + accw[a][r])) - 0.5f;
                    Llw[t * 264 + ncol] = (unsigned short)f2bf(-__expf(logw));
                    La[t * 264 + ncol] = (unsigned short)f2bf(sigmoidf_(a0n + acca[a][r]));
                    Lg[t * 264 + ncol] = (unsigned short)f2bf(accg[a][r]);
                }
        }
    }
    BAR();
    {
        const int t = tid >> 3, j8 = (tid & 7) * 8;
        const bf16_t* row = PM + (size_t)(t0 + t) * PMLD + C_RWKV;
        const bool hasprev = (t0 + t) > 0;
        const float* k_k = p.in[30] + l * W; const float* k_a = p.in[31] + l * W;
#pragma unroll 2
        for (int hd = 0; hd < 4; ++hd) {
            const int nn = 64 * hd + j8;
            float xr[8], xk[8], xv[8], pr[8], pk[8], pv[8], av[8];
            unpack8(*(const uint4*)(row + nn), xr); unpack8(*(const uint4*)(row + 256 + nn), xk); unpack8(*(const uint4*)(row + 512 + nn), xv);
            if (hasprev) { unpack8(*(const uint4*)(row - PMLD + nn), pr); unpack8(*(const uint4*)(row - PMLD + 256 + nn), pk); unpack8(*(const uint4*)(row - PMLD + 512 + nn), pv); }
            else {
#pragma unroll
                for (int i = 0; i < 8; ++i) { pr[i] = 0.f; pk[i] = 0.f; pv[i] = 0.f; } }
            { const u32x4_t t4 = *(const LAS u32x4_t*)(La + t * 264 + nn); unpack8(make_uint4(t4.x, t4.y, t4.z, t4.w), av); }
            float orr[8], okk[8], ovv[8], kraw[8];
            float ss = 0.f;
#pragma unroll
            for (int i = 0; i < 8; ++i) {
                const float r = xr[i] + mu[nn + i] * (pr[i] - xr[i]);
                const float k = xk[i] + mu[256 + nn + i] * (pk[i] - xk[i]);
                const float v = xv[i] + mu[512 + nn + i] * (pv[i] - xv[i]);
                orr[i] = r; ovv[i] = v; okk[i] = k * (1.f + (av[i] - 1.f) * k_a[nn + i]);
                kraw[i] = k * k_k[nn + i]; ss = fmaf(kraw[i], kraw[i], ss);
            }
            ss += __shfl_xor(ss, 1); ss += __shfl_xor(ss, 2); ss += __shfl_xor(ss, 4);
            const float rn = rsqrtf(ss + 1e-6f);
#pragma unroll
            for (int i = 0; i < 8; ++i) kraw[i] *= rn;
            const size_t o = (size_t)(t0 + t) * 256 + nn;
            *(uint4*)(B.RR + o) = pack8(orr); *(uint4*)(B.RK + o) = pack8(okk); *(uint4*)(B.RV + o) = pack8(ovv); *(uint4*)(B.RKK + o) = pack8(kraw);
            { const u32x4_t t4 = *(const LAS u32x4_t*)(La + t * 264 + nn); *(uint4*)(B.RA + o) = make_uint4(t4.x, t4.y, t4.z, t4.w); }
            { const u32x4_t t4 = *(const LAS u32x4_t*)(Lg + t * 264 + nn); *(uint4*)(B.RG + o) = make_uint4(t4.x, t4.y, t4.z, t4.w); }
        }
    }
    for (int px4_ = 0; px4_ < ((PEXP == 4) ? 2 : 1); ++px4_)
    if (tid < 256) {
        float c = 0.f;
#pragma unroll 16
        for (int t = 0; t < 64; ++t) { c += bf2f(Llw[t * 264 + tid]); B.CW[(size_t)(t0 + t) * 256 + tid] = c; }
    }
    BAR();
}

struct RwPiece { float kk[8], al[8], kt[8], v[8], cw[8], cwp[8], cwc[8]; };
__device__ __forceinline__ void rwkv_load_piece(const RwkvBufs& B, int h, int t0, int c, int d0, RwPiece& P) {
    const size_t o = (size_t)(t0 + c) * 256 + h * 64 + d0;
    float a[8];
    unpack8(*(const uint4*)(B.RKK + o), P.kk); unpack8(*(const uint4*)(B.RA + o), a); unpack8(*(const uint4*)(B.RK + o), P.kt); unpack8(*(const uint4*)(B.RV + o), P.v);
    const float4 c0 = *(const float4*)(B.CW + o), c1 = *(const float4*)(B.CW + o + 4);
    P.cw[0] = c0.x; P.cw[1] = c0.y; P.cw[2] = c0.z; P.cw[3] = c0.w; P.cw[4] = c1.x; P.cw[5] = c1.y; P.cw[6] = c1.z; P.cw[7] = c1.w;
    if (c > 0) { const float4 p0 = *(const float4*)(B.CW + o - 256), p1 = *(const float4*)(B.CW + o - 256 + 4);
        P.cwp[0] = p0.x; P.cwp[1] = p0.y; P.cwp[2] = p0.z; P.cwp[3] = p0.w; P.cwp[4] = p1.x; P.cwp[5] = p1.y; P.cwp[6] = p1.z; P.cwp[7] = p1.w; }
    else {
#pragma unroll
        for (int i = 0; i < 8; ++i) P.cwp[i] = 0.f; }
    const size_t oc = (size_t)(t0 + 63) * 256 + h * 64 + d0;
    const float4 e0 = *(const float4*)(B.CW + oc), e1 = *(const float4*)(B.CW + oc + 4);
    P.cwc[0] = e0.x; P.cwc[1] = e0.y; P.cwc[2] = e0.z; P.cwc[3] = e0.w; P.cwc[4] = e1.x; P.cwc[5] = e1.y; P.cwc[6] = e1.z; P.cwc[7] = e1.w;
#pragma unroll
    for (int i = 0; i < 8; ++i) P.al[i] = a[i] * P.kk[i];
}

__device__ __forceinline__ void rwkv_g1_unit(int h, int n, const RwkvBufs& B, bf16_t* __restrict__ Y, LAS unsigned char* lds) {
    const int tid = opq_tid(), w = tid >> 6, lane = tid & 63, q4 = lane >> 4, cc = lane & 15;
    lds_bf16 *P0h = plane(lds, 0), *P0l = plane(lds, 1), *P1h = plane(lds, 2), *P1l = plane(lds, 3), *P2h = plane(lds, 4), *P2l = plane(lds, 5);
    lds_bf16 *Lkh = plane(lds, 6), *Lkl = plane(lds, 7), *P3h = plane(lds, 8), *P3l = plane(lds, 9), *Th = plane(lds, 10), *Tl = plane(lds, 11);
    LAS float* Lm = (LAS float*)(lds + LM_OFF);
    const int t0 = n * 64, u = (4 + h) * 256 + n;
    const int c = tid >> 3, d0 = (tid & 7) * 8;
    RwPiece P; rwkv_load_piece(B, h, t0, c, d0, P);
    {
        float x0[8], x1[8], x2[8];
#pragma unroll
        for (int i = 0; i < 8; ++i) { const float em = __expf(-P.cw[i]); x0[i] = P.kk[i] * __expf(P.cwp[i]); x1[i] = P.al[i] * em; x2[i] = P.kt[i] * em; }
        put8<true>(P0h, P0l, c, d0, x0); put8<true>(P1h, P1l, c, d0, x1); put8<true>(P2h, P2l, c, d0, x2);
    }
    BAR();
    const int ti = w >> 1, tj0 = (w & 1) * 2;
    const f32x4_t zero4 = {0.f, 0.f, 0.f, 0.f};
#pragma unroll
    for (int tt = 0; tt < 2; ++tt) {
        const int tj = tj0 + tt;
        f32x4_t lk = zero4, la = zero4;
        const int j = 16 * tj + cc, jp = (j & 3) * 16 + (j >> 2);
        if (tj <= ti) {
            const f32x4_t a = mmp<true, true>(P0h, P0l, P1h, P1l, 16 * ti, 16 * tj, lane, zero4);
            const f32x4_t b = mmp<true, true>(P0h, P0l, P2h, P2l, 16 * ti, 16 * tj, lane, zero4);
#pragma unroll
            for (int r = 0; r < 4; ++r) { const int i = 16 * ti + 4 * q4 + r; la[r] = (i > j) ? a[r] : 0.f; lk[r] = (i > j) ? b[r] : 0.f; }
        }
#pragma unroll
        for (int r = 0; r < 4; ++r) Lm[(16 * ti + 4 * q4 + r) * PT + jp] = la[r];
        st_tile_R<true>(Lkh, Lkl, 16 * ti, 16 * tj, lane, lk);
    }
    BAR();
    {
        float x0[8], x1[8], x2[8];
#pragma unroll
        for (int i = 0; i < 8; ++i) { const float eb = __expf(P.cwc[i] - P.cw[i]); x0[i] = P.kk[i] * __expf(P.cwp[i]); x1[i] = P.al[i] * eb; x2[i] = P.kt[i] * eb; }
        put8T<true>(P0h, P0l, c, d0, P.v); put8T<true>(P1h, P1l, c, d0, x0); put8T<true>(P2h, P2l, c, d0, x1); put8T<true>(P3h, P3l, c, d0, x2);
    }
    if (w < 4) tri_inverse_4w(Lm, Th, Tl, w, lane);
    BAR();
    { const u32x4_t t4 = *(const LAS u32x4_t*)(Th + c * PB + d0); *(uint4*)(B.TG + (size_t)u * 4096 + c * 64 + d0) = make_uint4(t4.x, t4.y, t4.z, t4.w);
      const u32x4_t t5 = *(const LAS u32x4_t*)(Tl + c * PB + d0); *(uint4*)(Y + (size_t)(t0 + c) * D + 768 + h * 64 + d0) = make_uint4(t5.x, t5.y, t5.z, t5.w); }
    f32x4_t pa[2];
#pragma unroll
    for (int tt = 0; tt < 2; ++tt) pa[tt] = mmp<true, true>(Lkh, Lkl, P0h, P0l, 16 * ti, 16 * (tj0 + tt), lane, zero4);
    BAR();
#pragma unroll
    for (int tt = 0; tt < 2; ++tt) st_tile_T<true>(Lkh, Lkl, 16 * ti, 16 * (tj0 + tt), lane, pa[tt]);
    BAR();
    f32x4_t ua[2], wa[2];
#pragma unroll
    for (int tt = 0; tt < 2; ++tt) {
        ua[tt] = mmp<true, true>(Th, Tl, Lkh, Lkl, 16 * ti, 16 * (tj0 + tt), lane, zero4);
        wa[tt] = mmp<true, true>(Th, Tl, P1h, P1l, 16 * ti, 16 * (tj0 + tt), lane, zero4);
    }
    BAR();
#pragma unroll
    for (int tt = 0; tt < 2; ++tt) {
        st_tile_T<true>(Lkh, Lkl, 16 * ti, 16 * (tj0 + tt), lane, -ua[tt]);
        st_tile_T<true>(P1h, P1l, 16 * ti, 16 * (tj0 + tt), lane, wa[tt]);
    }
    BAR();
    {
#pragma unroll
        for (int tt = 0; tt < 2; ++tt) {
            const int tj = tj0 + tt;
            const f32x4_t a = mmp<true, true>(P2h, P2l, P1h, P1l, 16 * ti, 16 * tj, lane, zero4);
            const float gam = __expf(B.CW[(size_t)(t0 + 63) * 256 + h * 64 + 16 * tj + cc]);
#pragma unroll
            for (int r = 0; r < 4; ++r) { const int ar = 16 * ti + 4 * q4 + r, bc = 16 * tj + cc; Lm[ar * PT + bc] = (ar == bc ? gam : 0.f) - a[r]; }
            f32x4_t nn = mmp<true, true>(P2h, P2l, Lkh, Lkl, 16 * ti, 16 * tj, lane, zero4);
            nn = mmp<true, true>(P3h, P3l, P0h, P0l, 16 * ti, 16 * tj, lane, nn);
            *(float4*)(B.NF + (size_t)u * 4096 + (tj * 64 + lane) * 16 + ti * 4) = make_float4(nn[0], nn[1], nn[2], nn[3]);
        }
    }
    BAR();
    {
        const int combo = tid >> 6, mt = combo >> 1, s = combo & 1, i = lane & 15, qq = lane >> 4;
        const f32x4_t x0 = *(const LAS f32x4_t*)(Lm + (16 * mt + i) * PT + 32 * s + 4 * qq);
        const f32x4_t x1 = *(const LAS f32x4_t*)(Lm + (16 * mt + i) * PT + 32 * s + 16 + 4 * qq);
        const float xv[8] = {x0.x, x0.y, x0.z, x0.w, x1.x, x1.y, x1.z, x1.w};
        U8 H, L; split8(xv, H.v, L.v);
        uint4* mf = B.MF + (size_t)u * 1024 + (size_t)(combo * 2) * 64 + lane;
        mf[0] = H.q; mf[64] = L.q;
    }
    BAR();
}

__device__ __forceinline__ void rwkv_g3_unit(int h, int n, const RwkvBufs& B, bf16_t* __restrict__ Y, const Params& p, int l, LAS unsigned char* lds) {
    const int tid = opq_tid(), w = tid >> 6, lane = tid & 63, q4 = lane >> 4, cc = lane & 15;
    lds_bf16 *KH = plane(lds, 0), *AC = plane(lds, 1), *KC = plane(lds, 2), *RH = plane(lds, 3), *VT = plane(lds, 4), *KHT = plane(lds, 5), *Tp = plane(lds, 6);
    lds_bf16 *HTh = plane(lds, 7), *HTl = plane(lds, 8), *Lk = plane(lds, 9), *Ara = plane(lds, 10), *Ark = plane(lds, 11), *Tq = plane(lds, 12);
    lds_bf16 *PTp = KH, *Wm = AC, *UT = KC;
    LAS float* Os = (LAS float*)(lds + LM_OFF);
    const int t0 = n * 64, u = (4 + h) * 256 + n;
    const int c = tid >> 3, d0 = (tid & 7) * 8;
    {
        RwPiece P; rwkv_load_piece(B, h, t0, c, d0, P);
        float rr[8]; unpack8(*(const uint4*)(B.RR + (size_t)(t0 + c) * 256 + h * 64 + d0), rr);
        const uint4 t8 = *(const uint4*)(B.TG + (size_t)u * 4096 + c * 64 + d0);
        const uint4 t9 = *(const uint4*)(Y + (size_t)(t0 + c) * D + 768 + h * 64 + d0);
        const float* ht = B.HT + (size_t)u * 4096 + c * 64 + d0;
        const float4 h0 = *(const float4*)ht, h1 = *(const float4*)(ht + 4);
        float x0[8], x1[8], x2[8], x3[8];
#pragma unroll
        for (int i = 0; i < 8; ++i) { const float em = __expf(-P.cw[i]); x0[i] = P.kk[i] * __expf(P.cwp[i]); x1[i] = P.al[i] * em; x2[i] = P.kt[i] * em; x3[i] = rr[i] * __expf(P.cw[i]); }
        put8<false>(KH, KH, c, d0, x0); put8<false>(AC, AC, c, d0, x1); put8<false>(KC, KC, c, d0, x2); put8<false>(RH, RH, c, d0, x3);
        put8T<false>(VT, VT, c, d0, P.v); put8T<false>(KHT, KHT, c, d0, x0);
        *(LAS u32x4_t*)(Tp + c * PB + d0) = (u32x4_t){t8.x, t8.y, t8.z, t8.w};
        *(LAS u32x4_t*)(Tq + c * PB + d0) = (u32x4_t){t9.x, t9.y, t9.z, t9.w};
        const float hv[8] = {h0.x, h0.y, h0.z, h0.w, h1.x, h1.y, h1.z, h1.w};
        put8<true>(HTh, HTl, c, d0, hv);
    }
    BAR();
    const int ti = w >> 1, tj0 = (w & 1) * 2;
    const f32x4_t zero4 = {0.f, 0.f, 0.f, 0.f};
#pragma unroll
    for (int tt = 0; tt < 2; ++tt) {
        const int tj = tj0 + tt; const int j = 16 * tj + cc;
        f32x4_t lk = zero4, ara = zero4, ark = zero4;
        if (tj <= ti) {
            const f32x4_t b = mmp<false, false>(KH, KH, KC, KC, 16 * ti, 16 * tj, lane, zero4);
            const f32x4_t e = mmp<false, false>(RH, RH, AC, AC, 16 * ti, 16 * tj, lane, zero4);
            const f32x4_t f = mmp<false, false>(RH, RH, KC, KC, 16 * ti, 16 * tj, lane, zero4);
#pragma unroll
            for (int r = 0; r < 4; ++r) { const int i = 16 * ti + 4 * q4 + r; lk[r] = (i > j) ? b[r] : 0.f; ara[r] = (i >= j) ? e[r] : 0.f; ark[r] = (i >= j) ? f[r] : 0.f; }
        }
        st_tile_R<false>(Lk, Lk, 16 * ti, 16 * tj, lane, lk); st_tile_R<false>(Ara, Ara, 16 * ti, 16 * tj, lane, ara); st_tile_R<false>(Ark, Ark, 16 * ti, 16 * tj, lane, ark);
    }
    BAR();
#pragma unroll
    for (int tt = 0; tt < 2; ++tt) {
        const int tj = tj0 + tt;
        st_tile_T<false>(PTp, PTp, 16 * ti, 16 * tj, lane, mmp<false, false>(Lk, Lk, VT, VT, 16 * ti, 16 * tj, lane, zero4));
        st_tile_R<false>(Wm, Wm, 16 * ti, 16 * tj, lane, mmp<true, false>(Tp, Tq, KHT, KHT, 16 * ti, 16 * tj, lane, zero4));
    }
    BAR();
    f32x4_t o[2];
#pragma unroll
    for (int tt = 0; tt < 2; ++tt) {
        const int tj = tj0 + tt;
        const f32x4_t ua = mmp<true, false>(Tp, Tq, PTp, PTp, 16 * ti, 16 * tj, lane, zero4);
        const f32x4_t wh = mmp<false, true>(Wm, Wm, HTh, HTl, 16 * ti, 16 * tj, lane, zero4);
        st_tile_T<false>(UT, UT, 16 * ti, 16 * tj, lane, -ua - wh);
        o[tt] = mmp<false, true>(RH, RH, HTh, HTl, 16 * ti, 16 * tj, lane, zero4);
        o[tt] = mmp<false, false>(Ark, Ark, VT, VT, 16 * ti, 16 * tj, lane, o[tt]);
    }
    BAR();
#pragma unroll
    for (int tt = 0; tt < 2; ++tt) {
        const int tj = tj0 + tt;
        o[tt] = mmp<false, false>(Ara, Ara, UT, UT, 16 * ti, 16 * tj, lane, o[tt]);
#pragma unroll
        for (int r = 0; r < 4; ++r) Os[(16 * ti + 4 * q4 + r) * PT + 16 * tj + cc] = o[tt][r];
    }
    BAR();
    {
        const f32x4_t x0 = *(const LAS f32x4_t*)(Os + c * PT + d0), x1 = *(const LAS f32x4_t*)(Os + c * PT + d0 + 4);
        const float xv[8] = {x0.x, x0.y, x0.z, x0.w, x1.x, x1.y, x1.z, x1.w};
        float s1 = 0.f;
#pragma unroll
        for (int i = 0; i < 8; ++i) s1 += xv[i];
        s1 += __shfl_xor(s1, 1); s1 += __shfl_xor(s1, 2); s1 += __shfl_xor(s1, 4);
        const float mean = s1 * (1.f / 64.f);
        float s2 = 0.f;
#pragma unroll
        for (int i = 0; i < 8; ++i) { const float dd = xv[i] - mean; s2 = fmaf(dd, dd, s2); }
        s2 += __shfl_xor(s2, 1); s2 += __shfl_xor(s2, 2); s2 += __shfl_xor(s2, 4);
        const float rs = rsqrtf(s2 * (1.f / 64.f) + 64e-5f);
        const size_t o8 = (size_t)(t0 + c) * 256 + h * 64 + d0;
        float rr[8], gg[8], kt2[8], v2[8];
        unpack8(*(const uint4*)(B.RR + o8), rr); unpack8(*(const uint4*)(B.RG + o8), gg); unpack8(*(const uint4*)(B.RK + o8), kt2); unpack8(*(const uint4*)(B.RV + o8), v2);
        const float* r_k = p.in[32] + l * W + h * 64 + d0; const float* ln_g = p.in[33] + l * W + h * 64 + d0; const float* ln_b = p.in[34] + l * W + h * 64 + d0;
        float bs = 0.f;
#pragma unroll
        for (int i = 0; i < 8; ++i) bs = fmaf(rr[i] * kt2[i], r_k[i], bs);
        bs += __shfl_xor(bs, 1); bs += __shfl_xor(bs, 2); bs += __shfl_xor(bs, 4);
        float y[8];
#pragma unroll
        for (int i = 0; i < 8; ++i) y[i] = ((xv[i] - mean) * rs * ln_g[i] + ln_b[i] + bs * v2[i]) * gg[i];
        *(uint4*)(Y + (size_t)(t0 + c) * D + 768 + h * 64 + d0) = pack8(y);
    }
    BAR();
}

struct LruBufs { float2* AGG; float* CAR; };
template <int PASS>
__device__ __forceinline__ void lru_unit(const bf16_t* __restrict__ PM, int n, const LruBufs& B, bf16_t* __restrict__ Y, const Params& p, int l, const bf16_t* __restrict__ LWT  , LAS float* lds) {
    const int tid = opq_tid(), c = tid & 255, half = tid >> 8, w = tid >> 6, lane = tid & 63, q4 = lane >> 4, cc = lane & 15;
    const int t0 = n * 64, tb = t0 + 32 * half;
    LAS float* U = lds;
    lds_bf16* R = (lds_bf16*)(lds + 64 * 260);
    lds_bf16* I = R + 64 * 264;
    {
        const float* cw = p.in[7] + l * 4 * W; const float cb = p.in[8][l * W + c];
        const float w0 = cw[c], w1 = cw[W + c], w2 = cw[2 * W + c], w3 = cw[3 * W + c];
        const bf16_t* col = PM + C_LRU + c;
#pragma unroll 1
        for (int hf = 0; hf < 2; ++hf) {
            bf16_t xr[19];
#pragma unroll
            for (int i = 0; i < 19; ++i) xr[i] = (tb + 16 * hf + i - 3 >= 0) ? col[(size_t)(tb + 16 * hf + i - 3) * PMLD] : (bf16_t)0;
#pragma unroll
            for (int i = 0; i < 16; ++i)
                U[(32 * half + 16 * hf + i) * 260 + c] = cb + w0 * bf2f(xr[i]) + w1 * bf2f(xr[i + 1]) + w2 * bf2f(xr[i + 2]) + w3 * bf2f(xr[i + 3]);
        }
    }
    BAR();
    {
        const int nb = w >> 1, gt = w & 1;
        const bf16_t* wt = LWT + (size_t)gt * 16384 + (size_t)nb * 4096;
        const float* bias = (gt ? p.in[12] : p.in[10]) + l * W + nb * 64;
        const float* lam = p.in[13] + l * W + nb * 64;
#pragma unroll 1
        for (int te = 0; te < 4; ++te) {
            U8 bf[2];
#pragma unroll
            for (int ks = 0; ks < 2; ++ks) bf[ks].q = *(const uint4*)(wt + (size_t)(16 * te + cc) * 64 + 32 * ks + 8 * q4);
            const int ch = nb * 64 + 16 * te + cc;
            const float bv = bias[16 * te + cc];
            const float sp8 = 8.f * softplusf_(-lam[16 * te + cc]);
#pragma unroll
            for (int tt = 0; tt < 4; ++tt) {
                f32x4_t acc = {0.f, 0.f, 0.f, 0.f};
#pragma unroll
                for (int ks = 0; ks < 2; ++ks) {
                    const LAS float* ap = U + (16 * tt + cc) * 260 + nb * 64 + 32 * ks + 8 * q4;
                    const f32x4_t a0 = *(const LAS f32x4_t*)ap, a1 = *(const LAS f32x4_t*)(ap + 4);
                    const float av[8] = {a0.x, a0.y, a0.z, a0.w, a1.x, a1.y, a1.z, a1.w};
                    acc = __builtin_amdgcn_mfma_f32_16x16x32_bf16(hi8(av), bf[ks].v, acc, 0, 0, 0);
                }
#pragma unroll
                for (int r = 0; r < 4; ++r) {
                    const int t = 16 * tt + 4 * q4 + r;
                    const float sg = sigmoidf_(acc[r] + bv);
                    if (gt) I[t * 264 + ch] = (unsigned short)f2bf(sg); else R[t * 264 + ch] = (unsigned short)f2bf(-sp8 * sg);
                }
            }
        }
    }
    BAR();
    float h = 0.f, ap = 1.f;
    const int sc = 2 * n + half;
    bf16_t gc_[8], gn_[8];
    if (PASS == 3) {
        h = B.CAR[(size_t)c * 512 + sc];
#pragma unroll
        for (int i = 0; i < 8; ++i) gc_[i] = PM[(size_t)(tb + i) * PMLD + C_LRU + 256 + c];
    }
#pragma unroll 1
    for (int g8 = 0; g8 < 4; ++g8) {
        if (PASS == 3 && g8 < 3) {
#pragma unroll
            for (int i = 0; i < 8; ++i) gn_[i] = PM[(size_t)(tb + 8 * (g8 + 1) + i) * PMLD + C_LRU + 256 + c];
        }
#pragma unroll
        for (int i = 0; i < 8; ++i) {
            const int t = 32 * half + 8 * g8 + i;
            const float log_a = bf2f(R[t * 264 + c]), ig = bf2f(I[t * 264 + c]);
            const float a = __expf(log_a);
            const float inp = __builtin_amdgcn_sqrtf(fmaxf(1.f - a * a, 0.f)) * (ig * U[t * 260 + c]);
            h = fmaf(a, h, inp); ap *= a;
            if (PASS == 3) Y[(size_t)(t0 + t) * D + 256 + c] = (bf16_t)f2bf(h * geluf_(bf2f(gc_[i])));
        }
        if (PASS == 3) {
#pragma unroll
            for (int i = 0; i < 8; ++i) gc_[i] = gn_[i];
        }
    }
    if (PASS == 1) B.AGG[(size_t)c * 512 + sc] = make_float2(ap, h);
    BAR();
}
__device__ __forceinline__ void lru_carry_wave(const LruBufs& B, int c, int lane) {
    float2 ab[8];
    const float4* src = (const float4*)(B.AGG + (size_t)c * 512 + 8 * lane);
#pragma unroll
    for (int k = 0; k < 4; ++k) { const float4 v = src[k]; ab[2 * k] = make_float2(v.x, v.y); ab[2 * k + 1] = make_float2(v.z, v.w); }
    float A = 1.f, Bv = 0.f;
#pragma unroll
    for (int k = 0; k < 8; ++k) { Bv = fmaf(ab[k].x, Bv, ab[k].y); A *= ab[k].x; }
#pragma unroll
    for (int o = 1; o < 64; o <<= 1) { const float Al = __shfl_up(A, o), Bl = __shfl_up(Bv, o); if (lane >= o) { Bv = fmaf(A, Bl, Bv); A *= Al; } }
    float h = __shfl_up(Bv, 1); if (lane == 0) h = 0.f;
    float o8[8];
#pragma unroll
    for (int k = 0; k < 8; ++k) { o8[k] = h; h = fmaf(ab[k].x, h, ab[k].y); }
    float4* dst = (float4*)(B.CAR + (size_t)c * 512 + 8 * lane);
    dst[0] = make_float4(o8[0], o8[1], o8[2], o8[3]); dst[1] = make_float4(o8[4], o8[5], o8[6], o8[7]);
}

struct S5Bufs { float2* E; float2* CIN; };
struct S5Lane { float lbr, lbi; float bbr[16], bbi[16]; };
__device__ __forceinline__ void s5_lane_consts(const Params& p, int l, int g, int lane, S5Lane& K) {
    const float dt = __expf(p.in[21][l * 16 + g]);
    const float lre = p.in[14][l * 1024 + g * 64 + lane], lim = p.in[15][l * 1024 + g * 64 + lane];
    const float er = __expf(lre * dt);
    K.lbr = er * cosf(lim * dt); K.lbi = er * sinf(lim * dt);
    const float nr = K.lbr - 1.f, ni = K.lbi, den = lre * lre + lim * lim;
    const float fr = (nr * lre + ni * lim) / den, fi = (ni * lre - nr * lim) / den;
    const float* bre = p.in[16] + (size_t)l * 16384 + (g * 64 + lane) * 16; const float* bim = p.in[17] + (size_t)l * 16384 + (g * 64 + lane) * 16;
#pragma unroll
    for (int c = 0; c < 16; ++c) { const float br = bre[c], bi = bim[c]; K.bbr[c] = fr * br - fi * bi; K.bbi[c] = fr * bi + fi * br; }
}
template <int PASS>
__device__ __forceinline__ void s5_unit(const bf16_t* __restrict__ PM, int n, const S5Bufs& B, bf16_t* __restrict__ Y, const Params& p, int l, const bf16_t* __restrict__ GLUT, LAS unsigned char* lds) {
    const int tid = opq_tid(), w = tid >> 6, lane = tid & 63, q4 = lane >> 4, cc = lane & 15;
    const int t0 = n * 64;
    LAS float* us = (LAS float*)lds + w * (64 * 16);
    LAS unsigned char* hs = lds + 32768 + w * (32 * 272);
    lds_bf16* yp = (lds_bf16*)(lds + 32768 + 8 * 32 * 272);
#pragma unroll 1
    for (int gi = 0; gi < 2; ++gi) {
        const int g = 2 * w + gi;
        {
            const bf16_t* src = PM + (size_t)(t0 + lane) * PMLD + C_S5 + g * 16;
            float a[8], b[8]; unpack8(*(const uint4*)src, a); unpack8(*(const uint4*)(src + 8), b);
            *(LAS f32x4_t*)(us + lane * 16) = (f32x4_t){a[0], a[1], a[2], a[3]}; *(LAS f32x4_t*)(us + lane * 16 + 4) = (f32x4_t){a[4], a[5], a[6], a[7]};
            *(LAS f32x4_t*)(us + lane * 16 + 8) = (f32x4_t){b[0], b[1], b[2], b[3]}; *(LAS f32x4_t*)(us + lane * 16 + 12) = (f32x4_t){b[4], b[5], b[6], b[7]};
        }
        S5Lane K; s5_lane_consts(p, l, g, lane, K);
        float hr = 0.f, hi = 0.f;
        if (PASS == 3) { const float2 h0 = B.CIN[((size_t)g * 64 + lane) * 256 + n]; hr = h0.x; hi = h0.y; }
        U8 cf[4];
        float dch = 0.f;
        if (PASS == 3) {
            const float* cre = p.in[18] + (size_t)l * 16384 + (g * 16 + cc) * 64; const float* cim = p.in[19] + (size_t)l * 16384 + (g * 16 + cc) * 64;
#pragma unroll
            for (int ks = 0; ks < 4; ++ks) {
                const float4 r4 = *(const float4*)(cre + 16 * ks + 4 * q4), i4 = *(const float4*)(cim + 16 * ks + 4 * q4);
                cf[ks].u[0] = cvtpk(r4.x, -i4.x); cf[ks].u[1] = cvtpk(r4.y, -i4.y); cf[ks].u[2] = cvtpk(r4.z, -i4.z); cf[ks].u[3] = cvtpk(r4.w, -i4.w);
            }
            dch = p.in[20][l * W + g * 16 + cc];
        }
        asm volatile("s_waitcnt lgkmcnt(0)" ::: "memory");
#pragma unroll 1
        for (int hf = 0; hf < 2; ++hf) {
#pragma unroll 2
            for (int i = 0; i < 32; ++i) {
                const int t = 32 * hf + i;
                const f32x4_t u0 = *(const LAS f32x4_t*)(us + t * 16), u1 = *(const LAS f32x4_t*)(us + t * 16 + 4), u2 = *(const LAS f32x4_t*)(us + t * 16 + 8), u3 = *(const LAS f32x4_t*)(us + t * 16 + 12);
                const float uv[16] = {u0.x, u0.y, u0.z, u0.w, u1.x, u1.y, u1.z, u1.w, u2.x, u2.y, u2.z, u2.w, u3.x, u3.y, u3.z, u3.w};
                float br = 0.f, bi = 0.f;
#pragma unroll
                for (int c = 0; c < 16; ++c) { br = fmaf(K.bbr[c], uv[c], br); bi = fmaf(K.bbi[c], uv[c], bi); }
                const float nhr = K.lbr * hr - K.lbi * hi + br, nhi = K.lbr * hi + K.lbi * hr + bi;
                hr = nhr; hi = nhi;
                if (PASS == 3) *(LAS unsigned*)(hs + i * 272 + 4 * lane) = cvtpk(hr, hi);
            }
            if (PASS == 3) {
                asm volatile("s_waitcnt lgkmcnt(0)" ::: "memory");
#pragma unroll
                for (int tt = 0; tt < 2; ++tt) {
                    f32x4_t acc = {0.f, 0.f, 0.f, 0.f};
#pragma unroll
                    for (int ks = 0; ks < 4; ++ks) {
                        U8 af; af.x = *(const LAS u32x4_t*)(hs + (16 * tt + cc) * 272 + 64 * ks + 16 * q4);
                        acc = __builtin_amdgcn_mfma_f32_16x16x32_bf16(af.v, cf[ks].v, acc, 0, 0, 0);
                    }
#pragma unroll
                    for (int r = 0; r < 4; ++r) {
                        const int t = 32 * hf + 16 * tt + 4 * q4 + r;
                        const float yv = acc[r] + dch * us[t * 16 + cc];
                        yp[t * 264 + g * 16 + cc] = (unsigned short)f2bf(geluf_(yv));
                    }
                }
                asm volatile("s_waitcnt lgkmcnt(0)" ::: "memory");
            }
        }
        if (PASS == 1) B.E[((size_t)g * 64 + lane) * 256 + n] = make_float2(hr, hi);
    }
    if (PASS == 3) {
        BAR();
        const float* gb = p.in[23] + l * W;
#pragma unroll 1
        for (int tn = 2 * w; tn < 2 * w + 2; ++tn) {
            f32x4_t acc[4];
#pragma unroll
            for (int tt = 0; tt < 4; ++tt) acc[tt] = (f32x4_t){0.f, 0.f, 0.f, 0.f};
#pragma unroll
            for (int ks = 0; ks < 8; ++ks) {
                U8 bf; bf.q = *(const uint4*)(GLUT + (size_t)(16 * tn + cc) * 256 + 32 * ks + 8 * q4);
#pragma unroll
                for (int tt = 0; tt < 4; ++tt) {
                    U8 af; af.x = *(const LAS u32x4_t*)(yp + (16 * tt + cc) * 264 + 32 * ks + 8 * q4);
                    acc[tt] = __builtin_amdgcn_mfma_f32_16x16x32_bf16(af.v, bf.v, acc[tt], 0, 0, 0);
                }
            }
            const int ncol = 16 * tn + cc; const float gbn = gb[ncol];
#pragma unroll
            for (int tt = 0; tt < 4; ++tt)
#pragma unroll
                for (int r = 0; r < 4; ++r) {
                    const int t = 16 * tt + 4 * q4 + r;
                    const float yv = bf2f(yp[t * 264 + ncol]);
                    Y[(size_t)(t0 + t) * D + 512 + ncol] = (bf16_t)f2bf(yv * sigmoidf_(acc[tt][r] + gbn));
                }
        }
    }
    BAR();
}
__device__ __forceinline__ void s5_carry_wave(const S5Bufs& B, const Params& p, int l, int gp, int lane) {
    const int g = gp >> 6;
    const float dt = __expf(p.in[21][l * 16 + g]) * 64.f;
    const float lre = p.in[14][l * 1024 + gp], lim = p.in[15][l * 1024 + gp];
    const float er = __expf(lre * dt);
    const float pr = er * cosf(lim * dt), pi = er * sinf(lim * dt);
    float2 e[4];
    const float4* src = (const float4*)(B.E + (size_t)gp * 256 + 4 * lane);
    { const float4 v0 = src[0], v1 = src[1]; e[0] = make_float2(v0.x, v0.y); e[1] = make_float2(v0.z, v0.w); e[2] = make_float2(v1.x, v1.y); e[3] = make_float2(v1.z, v1.w); }
    float Ar = 1.f, Ai = 0.f, Br = 0.f, Bi = 0.f;
#pragma unroll
    for (int k = 0; k < 4; ++k) {
        const float nbr = pr * Br - pi * Bi + e[k].x, nbi = pr * Bi + pi * Br + e[k].y; Br = nbr; Bi = nbi;
        const float nar = pr * Ar - pi * Ai, nai = pr * Ai + pi * Ar; Ar = nar; Ai = nai;
    }
#pragma unroll
    for (int o = 1; o < 64; o <<= 1) {
        const float Alr = __shfl_up(Ar, o), Ali = __shfl_up(Ai, o), Blr = __shfl_up(Br, o), Bli = __shfl_up(Bi, o);
        if (lane >= o) {
            const float nbr = Ar * Blr - Ai * Bli + Br, nbi = Ar * Bli + Ai * Blr + Bi; Br = nbr; Bi = nbi;
            const float nar = Ar * Alr - Ai * Ali, nai = Ar * Ali + Ai * Alr; Ar = nar; Ai = nai;
        }
    }
    float hr = __shfl_up(Br, 1), hi = __shfl_up(Bi, 1); if (lane == 0) { hr = 0.f; hi = 0.f; }
    float2 o4[4];
#pragma unroll
    for (int k = 0; k < 4; ++k) { o4[k] = make_float2(hr, hi); const float nhr = pr * hr - pi * hi + e[k].x, nhi = pr * hi + pi * hr + e[k].y; hr = nhr; hi = nhi; }
    float4* dst = (float4*)(B.CIN + (size_t)gp * 256 + 4 * lane);
    dst[0] = make_float4(o4[0].x, o4[0].y, o4[1].x, o4[1].y); dst[1] = make_float4(o4[2].x, o4[2].y, o4[3].x, o4[3].y);
}

constexpr size_t WS_GQ = 36 * MiB, WS_GK = 44 * MiB, WS_GV = 52 * MiB, WS_GB = 60 * MiB, WS_GC = 61 * MiB;
constexpr size_t WS_MF = 324 * MiB, WS_NF = 356 * MiB, WS_HT = 388 * MiB;
constexpr size_t WS_RR = 420 * MiB, WS_RK = 428 * MiB, WS_RV = 436 * MiB, WS_RKK = 444 * MiB, WS_RA = 452 * MiB, WS_RG = 460 * MiB, WS_CW = 468 * MiB;
constexpr size_t WS_LAGG = 484 * MiB, WS_LCAR = 485 * MiB, WS_S5E = 486 * MiB, WS_S5C = 488 * MiB;
constexpr size_t WS_TG = 490 * MiB;
constexpr int MIX_LDS = 8 * MS * 4 + 1024;
__device__ __forceinline__ LruBufs lru_bufs(unsigned char* ws) { LruBufs B; B.AGG = (float2*)(ws + WS_LAGG); B.CAR = (float*)(ws + WS_LCAR); return B; }
__device__ __forceinline__ S5Bufs s5_bufs(unsigned char* ws) { S5Bufs B; B.E = (float2*)(ws + WS_S5E); B.CIN = (float2*)(ws + WS_S5C); return B; }
__device__ __forceinline__ GdnBufs gdn_bufs(unsigned char* ws) {
    GdnBufs B; B.GQ = (bf16_t*)(ws + WS_GQ); B.GK = (bf16_t*)(ws + WS_GK); B.GV = (bf16_t*)(ws + WS_GV); B.GB = (float*)(ws + WS_GB); B.GC = (float*)(ws + WS_GC);
    B.MF = (uint4*)(ws + WS_MF); B.NF = (float*)(ws + WS_NF); B.HT = (float*)(ws + WS_HT); B.TG = (bf16_t*)(ws + WS_TG); return B;
}
__device__ __forceinline__ RwkvBufs rwkv_bufs(unsigned char* ws) {
    RwkvBufs B; B.RR = (bf16_t*)(ws + WS_RR); B.RK = (bf16_t*)(ws + WS_RK); B.RV = (bf16_t*)(ws + WS_RV); B.RKK = (bf16_t*)(ws + WS_RKK); B.RA = (bf16_t*)(ws + WS_RA); B.RG = (bf16_t*)(ws + WS_RG);
    B.CW = (float*)(ws + WS_CW); B.MF = (uint4*)(ws + WS_MF); B.NF = (float*)(ws + WS_NF); B.HT = (float*)(ws + WS_HT); B.TG = (bf16_t*)(ws + WS_TG); return B;
}
__device__ __forceinline__ unsigned char* opq(unsigned char* w) { unsigned long long v = (unsigned long long)w; asm volatile("" : "+s"(v)); return (unsigned char*)(GAS unsigned char*)v; }
#define XB_TMO      128
#define XB_XCNT(j)  (256  + 64 * (j))
#define XB_XSUB(j)  (1280 + 64 * (j))
#define XB_XGEN(j)  (2304 + 64 * (j))
#define XB_TOP      3328
#define XB_TOPGEN   3392
#define XCD_BAR_WORDS 3456
#define XB_SPIN_CAP (1u << 18)

__device__ __forceinline__ unsigned xb_ld(unsigned* p)              { return __hip_atomic_load(p, __ATOMIC_RELAXED, __HIP_MEMORY_SCOPE_AGENT); }
__device__ __forceinline__ unsigned xb_add(unsigned* p, unsigned v) { return __hip_atomic_fetch_add(p, v, __ATOMIC_RELAXED, __HIP_MEMORY_SCOPE_AGENT); }
__device__ __forceinline__ unsigned xb_xcc_id() { return (unsigned)__builtin_amdgcn_s_getreg((3 << 11) | 20) & 0xFu; }
#define XB_SPIN(cond, bar) do { unsigned _sp = 0; while (cond) { __builtin_amdgcn_s_sleep(1); \
    if ((++_sp & 255u) == 0u) { if (xb_ld(&(bar)[XB_TMO])) break; if (_sp > XB_SPIN_CAP) { atomicAdd(&(bar)[XB_TMO], 1u); break; } } } } while (0)

struct XcdBarrier {
    unsigned* bar; unsigned x;
    volatile LAS unsigned* st;
};

__device__ __forceinline__ XcdBarrier xcd_barrier_post(unsigned* bar, volatile LAS unsigned* st) {
    XcdBarrier b; b.bar = bar; b.x = xb_xcc_id(); b.st = st;
    if (threadIdx.x == 0) (void)xb_add(&bar[XB_XCNT(b.x)], 1u);
    return b;
}
__device__ __forceinline__ void xcd_barrier_complete(unsigned* bar, unsigned x, unsigned& nloc, unsigned& nx) {
    const unsigned G = gridDim.x * gridDim.y * gridDim.z;
    unsigned sum, cnt, mine, sp = 0u;
    for (;;) {
        sum = 0u; cnt = 0u; mine = 0u;
#pragma unroll
        for (unsigned j = 0; j < 16; ++j) { const unsigned c = xb_ld(&bar[XB_XCNT(j)]); sum += c; cnt += (c > 0u) ? 1u : 0u; mine = (j == x) ? c : mine; }
        if (sum == G) break;
        __builtin_amdgcn_s_sleep(1);
        if ((++sp & 255u) == 0u) { if (xb_ld(&bar[XB_TMO])) break; if (sp > XB_SPIN_CAP) { atomicAdd(&bar[XB_TMO], 1u); break; } }
    }
    nloc = mine > 0u ? mine : 1u; nx = cnt > 0u ? cnt : 1u;
}

__device__ __forceinline__ void xcd_barrier(const XcdBarrier& b) {
    asm volatile("s_waitcnt vmcnt(0)" ::: "memory");
    __syncthreads();
    if (threadIdx.x == 0) {
        unsigned* bar = b.bar;
        __builtin_amdgcn_s_waitcnt(0);
        unsigned nloc = b.st[0], nx = b.st[1];
        if (nloc == 0u) { xcd_barrier_complete(bar, b.x, nloc, nx); b.st[0] = nloc; b.st[1] = nx; }
        const unsigned old = xb_add(&bar[XB_XSUB(b.x)], 1u);
        const unsigned gen = old / nloc;
        if (old + 1u == (gen + 1u) * nloc) {
            __builtin_amdgcn_fence(__ATOMIC_RELEASE, "agent");
            asm volatile("s_waitcnt vmcnt(0)" ::: "memory");
            const unsigned og = xb_add(&bar[XB_TOP], 1u);
            const unsigned tg = og / nx;
            if (og + 1u == (tg + 1u) * nx) xb_add(&bar[XB_TOPGEN], 1u);
            else XB_SPIN(xb_ld(&bar[XB_TOPGEN]) == tg, bar);
            __builtin_amdgcn_fence(__ATOMIC_ACQUIRE, "agent");
            xb_add(&bar[XB_XGEN(b.x)], 1u);
            asm volatile("s_waitcnt vmcnt(0)" ::: "memory");
        } else {
            XB_SPIN(xb_ld(&bar[XB_XGEN(b.x)]) == gen, bar);
            __builtin_amdgcn_fence(__ATOMIC_ACQUIRE, "agent");
            asm volatile("s_waitcnt vmcnt(0)" ::: "memory");
        }
    }
    __syncthreads();
}

__device__ __forceinline__ void sub_barrier(unsigned* cnt, unsigned target) {
    asm volatile("s_waitcnt vmcnt(0)" ::: "memory"); __syncthreads();
    if (threadIdx.x == 0) {
        __builtin_amdgcn_fence(__ATOMIC_RELEASE, "agent"); asm volatile("s_waitcnt vmcnt(0)" ::: "memory");
        (void)__hip_atomic_fetch_add(cnt, 1u, __ATOMIC_RELAXED, __HIP_MEMORY_SCOPE_AGENT);
        unsigned sp = 0;
        while (__hip_atomic_load(cnt, __ATOMIC_RELAXED, __HIP_MEMORY_SCOPE_AGENT) < target) { __builtin_amdgcn_s_sleep(2); if (++sp > (1u << 22)) break; }
        __builtin_amdgcn_fence(__ATOMIC_ACQUIRE, "agent"); asm volatile("s_waitcnt vmcnt(0)" ::: "memory");
    }
    __syncthreads();
}

namespace cg = cooperative_groups;
constexpr int FUSED_LDS = MIX_LDS;
static_assert(FUSED_LDS >= pg8::STAGE_BYTES && FUSED_LDS >= 8 * 64 * 33 * 4, "LDS budget");
#define GSYNC() xcd_barrier(bar)
#ifndef PHM
#define PHM 511
#endif
#ifndef REP
#define REP 0
#endif
#ifndef REPU
#define REPU 0
#endif
#ifndef REPP
#define REPP 0
#endif
__global__ void __launch_bounds__(NT, 2) fwd_fused(KParams kp_unused) {
    cg::grid_group grid = cg::this_grid();
    extern __shared__ __attribute__((aligned(16))) unsigned char dl[];
    Params p; p.in.tab = (LAS const unsigned long long*)((LAS unsigned char*)dl + FUSED_LDS);
    {
        const __attribute__((address_space(4))) unsigned long long* ka = (const __attribute__((address_space(4))) unsigned long long*)__builtin_amdgcn_kernarg_segment_ptr();
        if (threadIdx.x < 43) ((LAS unsigned long long*)((LAS unsigned char*)dl + FUSED_LDS))[threadIdx.x] = ka[threadIdx.x];
        if (threadIdx.x < 4) ((LAS unsigned*)((LAS unsigned char*)dl + FUSED_LDS + 512))[threadIdx.x] = 0u;
        __syncthreads();
    }
    const XcdBarrier bar = xcd_barrier_post((unsigned*)(p.ws() + WS_CTL), (volatile LAS unsigned*)((LAS unsigned char*)dl + FUSED_LDS + 512));
    float* X = p.out();
#pragma unroll 1
    for (int l = 0; l < 2; ++l) {
        {
            const int tid = opq_tid();
            convert_weights(p, l, (LAS float*)dl + (tid >> 6) * 64 * 33, blockIdx.x * 8 + (tid >> 6), gridDim.x * 8, tid & 63);
        }
#pragma unroll 1
        for (int b = 0; b < 2; ++b) {
            const float* Xin = (l == 0 ? p.in[0] : X) + (size_t)b * TB * D;
            float* Xb = X + (size_t)b * TB * D;
            { unsigned char* ws = opq(p.ws()); rmsnorm_rows(Xin, p.in[1] + l * D, (bf16_t*)(ws + WS_XN), TB); }
            if (l == 0 && b == 0) grid.sync(); else GSYNC();
#if PHM & 1
            for (int rep_ = 0; rep_ < ((REP & 1) ? 2 : 1); ++rep_) {
            {
                unsigned char* ws = opq(p.ws()); const bf16_t* WL = (const bf16_t*)(ws + WS_W);
                pg8::Gemm g{(const bf16_t*)(ws + WS_XN), WL + WO_IN, TB, 7168, D, D, D, 0};
                pg8::StaticOrder S; S.init(g.M, g.N, (int)gridDim.x, (int)blockIdx.x);
                pg8::gemm_phase<pg8::EpiProjP, pg8::StaticOrder, true, true>((PG8_LAS unsigned char*)dl, g, S, pg8::EpiProjP{(bf16_t*)(ws + WS_PM), (bf16_t*)(ws + WS_G)});
            }
            }
#endif
            GSYNC();
#if PHM & 2
            for (int rep_ = 0; rep_ < ((REP & 2) ? 2 : 1); ++rep_) {
            for (int ps_ = 0; ps_ < ((REPP == 2) ? 2 : 1); ++ps_)
            for (int n = blockIdx.x; n < 512; n += gridDim.x) {
                if (ps_ == 1 && ((n < 256) ? 1 : 2) != REPU) continue;
                unsigned char* ws = opq(p.ws());
                if (n < 256) gdn_prep_chunk((const bf16_t*)(ws + WS_PM), n, gdn_bufs(ws), p, l, (LAS float*)dl);
                else { const bf16_t* WL = (const bf16_t*)(ws + WS_W); rwkv_prep_chunk((const bf16_t*)(ws + WS_PM), n - 256, rwkv_bufs(ws), p, l, WL + WO_WUP, WL + WO_AUP, WL + WO_GUP, (LAS unsigned char*)dl); }
            }
            }
#endif
            if (gridDim.x == 256) {
                asm volatile("s_waitcnt vmcnt(0)" ::: "memory"); __syncthreads();
                if (threadIdx.x == 0) { __builtin_amdgcn_fence(__ATOMIC_ACQUIRE, "agent"); asm volatile("s_waitcnt vmcnt(0)" ::: "memory"); }
                __syncthreads();
            } else GSYNC();
#if PHM & 4
            for (int rep_ = 0; rep_ < ((REP & 4) ? 2 : 1); ++rep_) {
            for (int ps_ = 0; ps_ < ((REPP == 4) ? 2 : 1); ++ps_)
            for (int u = blockIdx.x; u < 2560; u += gridDim.x) {
                const int ut_ = u < 1024 ? 1 : (u < 2048 ? 2 : (u < 2304 ? 3 : 4));
                if (ps_ == 1 && ut_ != REPU) continue;
                unsigned char* ws = opq(p.ws());
                if (u < 1024) gdn_g1_unit(u >> 8, u & 255, gdn_bufs(ws), (bf16_t*)(ws + WS_Y), (LAS unsigned char*)dl);
                else if (u < 2048) rwkv_g1_unit((u - 1024) >> 8, u & 255, rwkv_bufs(ws), (bf16_t*)(ws + WS_Y), (LAS unsigned char*)dl);
                else if (u < 2304) lru_unit<1>((const bf16_t*)(ws + WS_PM), u - 2048, lru_bufs(ws), (bf16_t*)(ws + WS_Y), p, l, (const bf16_t*)(ws + WS_W) + WO_LWT, (LAS float*)dl);
                else s5_unit<1>((const bf16_t*)(ws + WS_PM), u - 2304, s5_bufs(ws), (bf16_t*)(ws + WS_Y), p, l, (const bf16_t*)(ws + WS_W) + WO_GLU, (LAS unsigned char*)dl);
            }
            }
#endif
            GSYNC();
#if PHM & 8
            for (int rep_ = 0; rep_ < ((REP & 8) ? 2 : 1); ++rep_) {
            {
                const int tid = opq_tid(), lane = tid & 63, wv = tid >> 6;
                const int bx = blockIdx.x;
                volatile LAS unsigned* flags = (volatile LAS unsigned*)((LAS unsigned char*)dl + FUSED_LDS + 768);
                if (tid < 16) flags[tid] = 0u;
                __syncthreads();
                if (bx < 32) {
                    unsigned char* ws = opq(p.ws());
                    const GdnBufs B = gdn_bufs(ws); const int sq = bx >> 2, cb = bx & 3;
                    if (wv == 0) chain_wave(B.HT + (size_t)sq * 256 * 4096, cb, 256, lane, (LAS unsigned char*)dl, flags);
                    else chain_loader(B.MF + (size_t)sq * 256 * 1024, B.NF + (size_t)sq * 256 * 4096, cb, 256, lane, wv - 1, (LAS unsigned char*)dl, flags);
                } else {
                    {
                        unsigned char* ws = opq(p.ws());
                        for (int job = (bx - 32) * 8 + wv; job < 1280; job += (int)(gridDim.x - 32) * 8) {
                            if (job < 256) lru_carry_wave(lru_bufs(ws), job, lane);
                            else s5_carry_wave(s5_bufs(ws), p, l, job - 256, lane);
                        }
                    }
                    sub_barrier((unsigned*)(p.ws() + WS_CTL + 15360), (unsigned)(gridDim.x - 32) * (unsigned)(l * 2 + b + 1));
                    for (int u = bx - 32; u < 512; u += (int)gridDim.x - 32) {
                        unsigned char* ws = opq(p.ws());
                        if (u < 256) lru_unit<3>((const bf16_t*)(ws + WS_PM), u, lru_bufs(ws), (bf16_t*)(ws + WS_Y), p, l, (const bf16_t*)(ws + WS_W) + WO_LWT, (LAS float*)dl);
                        else s5_unit<3>((const bf16_t*)(ws + WS_PM), u - 256, s5_bufs(ws), (bf16_t*)(ws + WS_Y), p, l, (const bf16_t*)(ws + WS_W) + WO_GLU, (LAS unsigned char*)dl);
                    }
                }
            }
            }
#endif
            GSYNC();
#if PHM & 16
            for (int rep_ = 0; rep_ < ((REP & 16) ? 2 : 1); ++rep_) {
            for (int ps_ = 0; ps_ < ((REPP == 16) ? 2 : 1); ++ps_)
            for (int u = blockIdx.x; u < 2048; u += gridDim.x) {
                const int ut_ = u < 1024 ? 1 : (u < 2048 ? 2 : (u < 2304 ? 3 : 4));
                if (ps_ == 1 && ut_ != REPU) continue;
                unsigned char* ws = opq(p.ws());
                if (u < 1024) gdn_g3_unit(u >> 8, u & 255, gdn_bufs(ws), (const bf16_t*)(ws + WS_PM), (bf16_t*)(ws + WS_Y), p.in[6] + l * 64, (LAS unsigned char*)dl);
                else rwkv_g3_unit((u - 1024) >> 8, u & 255, rwkv_bufs(ws), (bf16_t*)(ws + WS_Y), p, l, (LAS unsigned char*)dl);
            }
            }
#endif
            GSYNC();
#if PHM & 32
            for (int rep_ = 0; rep_ < ((REP & 32) ? 2 : 1); ++rep_) {
            { unsigned char* ws = opq(p.ws()); merge_phase((const bf16_t*)(ws + WS_Y), (const bf16_t*)(ws + WS_W) + WO_BR, (const bf16_t*)(ws + WS_G), (bf16_t*)(ws + WS_MG), (LAS unsigned char*)dl); }
            }
#endif
            GSYNC();
#if PHM & 64
            {
                unsigned char* ws = opq(p.ws()); const bf16_t* WL = (const bf16_t*)(ws + WS_W);
                pg8::Gemm g{(const bf16_t*)(ws + WS_MG), WL + WO_OUT, TB, D, D, D, D, 0};
                pg8::StaticOrder S; S.init(g.M, g.N, (int)gridDim.x, (int)blockIdx.x);
                pg8::gemm_phase<pg8::EpiResidP, pg8::StaticOrder, false, true>((PG8_LAS unsigned char*)dl, g, S, pg8::EpiResidP{Xin, Xb});
            }
#endif
            GSYNC();
            { unsigned char* ws = opq(p.ws()); rmsnorm_rows(Xb, p.in[37] + l * D, (bf16_t*)(ws + WS_XN), TB); }
            GSYNC();
#if PHM & 128
            for (int rep_ = 0; rep_ < ((REP & 128) ? 2 : 1); ++rep_) {
            {
                unsigned char* ws = opq(p.ws()); const bf16_t* WL = (const bf16_t*)(ws + WS_W);
                pg8::Gemm g{(const bf16_t*)(ws + WS_XN), WL + WO_W1, TB, DFF, D, D, D, 0};
                pg8::StaticOrder S; S.init(g.M, g.N, (int)gridDim.x, (int)blockIdx.x);
                pg8::gemm_phase<pg8::EpiRelu2P, pg8::StaticOrder, true, true>((PG8_LAS unsigned char*)dl, g, S, pg8::EpiRelu2P{(bf16_t*)(ws + WS_HD), DFF, 0});
            }
            }
#endif
            GSYNC();
#if PHM & 256
            {
                unsigned char* ws = opq(p.ws()); const bf16_t* WL = (const bf16_t*)(ws + WS_W);
                pg8::Gemm g{(const bf16_t*)(ws + WS_HD), WL + WO_W2, TB, D, DFF, DFF, DFF, 0};
                pg8::StaticOrder S; S.init(g.M, g.N, (int)gridDim.x, (int)blockIdx.x);
                pg8::gemm_phase<pg8::EpiResidP, pg8::StaticOrder, false, true>((PG8_LAS unsigned char*)dl, g, S, pg8::EpiResidP{Xb, Xb});
            }
#endif
            GSYNC();
        }
    }
    rmsnorm_rows(X, p.in[40], X, 2 * TB);
}

extern "C" void kernel_launch(void* const* d_in, const int* in_sizes, int n_in, void* d_out, int out_size, void* d_ws, size_t ws_size, hipStream_t stream) {
    KParams p{};
    for (int i = 0; i < 41; ++i) p.in[i] = (const float*)d_in[i];
    p.out = (float*)d_out; p.ws = (unsigned char*)d_ws; p.pad = 0;
    static int grid = 0;
    if (grid == 0) {
        int dev = 0, cus = 0, per_cu = 0;
        hipGetDevice(&dev);
        hipDeviceGetAttribute(&cus, hipDeviceAttributeMultiprocessorCount, dev);
        hipFuncSetAttribute((const void*)fwd_fused, hipFuncAttributeMaxDynamicSharedMemorySize, FUSED_LDS + 1024);
        hipOccupancyMaxActiveBlocksPerMultiprocessor(&per_cu, (const void*)fwd_fused, NT, FUSED_LDS + 1024);
        if (per_cu < 1) per_cu = 1;
        grid = cus * per_cu;
        if (grid > 256) grid = 256;
    }
    hipMemsetAsync((unsigned char*)d_ws + WS_CTL, 0, 16384, stream);
    void* args[] = {&p};
    hipError_t e = hipLaunchCooperativeKernel((const void*)fwd_fused, dim3(grid), dim3(NT), args, FUSED_LDS + 1024, stream);
    if (e != hipSuccess) fprintf(stderr, "cooperative launch failed: %s (grid %d)\n", hipGetErrorString(e), grid);
}
```

```cpp
#include <hip/hip_runtime.h>
#ifndef MEXP
#define MEXP 0
#endif
#ifndef PEXP
#define PEXP 0
#endif
#include <hip/hip_cooperative_groups.h>
#include <cstdio>
#include <cstdint>

constexpr int TB = 16384;
constexpr int D = 1024;
constexpr int DIN = 6920;
constexpr int NMIX = 2824;
constexpr int W = 256;
constexpr int DFF = 4096;
constexpr int NT = 512;

constexpr int C_GDN = 0, C_LRU = 1032, C_S5 = 1544, C_RWKV = 1800, C_GATE = 2824;

struct KParams { const float* in[41]; float* out; unsigned char* ws; size_t pad; };
#define LAS __attribute__((address_space(3)))
#define GAS __attribute__((address_space(1)))
struct PIn { LAS const unsigned long long* tab;
    __device__ __forceinline__ const float* operator[](int i) const { LAS const unsigned long long* t = tab; asm volatile("" : "+v"(t)); const unsigned long long v = t[i];
        const unsigned lo = __builtin_amdgcn_readfirstlane((unsigned)v), hi = __builtin_amdgcn_readfirstlane((unsigned)(v >> 32)); return (const float*)(GAS const float*)(((unsigned long long)hi << 32) | lo); } };
struct Params { PIn in;
    __device__ __forceinline__ float* out() const { return (float*)in[41]; }
    __device__ __forceinline__ unsigned char* ws() const { return (unsigned char*)in[42]; } };

typedef unsigned short bf16_t;
constexpr int PMLD = 3072;
constexpr size_t MiB = 1u << 20;
constexpr size_t WS_W  = 0;
constexpr size_t WS_CTL = 35 * MiB;
constexpr size_t WS_XN = 36 * MiB;
constexpr size_t WS_PM = 68 * MiB;
constexpr size_t WS_G  = 164 * MiB;
constexpr size_t WS_HD = 164 * MiB;
constexpr size_t WS_Y  = 292 * MiB;
constexpr size_t WS_MG = 324 * MiB;

__device__ __forceinline__ unsigned f2bf(float f) { unsigned u = __float_as_uint(f); return (u + 0x7fffu + ((u >> 16) & 1u)) >> 16; }
__device__ __forceinline__ float bf2f(bf16_t b) { return __uint_as_float((unsigned)b << 16); }
__device__ __forceinline__ float ldf(const float* p) { return *p; }
__device__ __forceinline__ float ldf(const bf16_t* p) { return bf2f(*p); }
__device__ __forceinline__ float sigmoidf_(float x) { return __builtin_amdgcn_rcpf(1.f + __expf(-x)); }
__device__ __forceinline__ float softplusf_(float x) { const float e = __expf(x); return x > 20.f ? x : (e < 1e-4f ? e : __logf(1.f + e)); }
__device__ __forceinline__ float siluf_(float x) { return x * sigmoidf_(x); }
__device__ __forceinline__ float tanhf_(float y) { return 1.f - 2.f * __builtin_amdgcn_rcpf(1.f + __expf(2.f * y)); }
__device__ __forceinline__ float geluf_(float x) { return 0.5f * x * (1.f + tanhf_(0.7978845608028654f * (x + 0.044715f * x * x * x))); }
__device__ __forceinline__ float rl(float v, int i) { return __int_as_float(__builtin_amdgcn_readlane(__float_as_int(v), i)); }
__device__ __forceinline__ float wave_sum(float v) {
#pragma unroll
    for (int o = 1; o < 64; o <<= 1) v += __shfl_xor(v, o);
    return v;
}

template <class OT>
__device__ __forceinline__ void rmsnorm_rows(const float* X, const float* g, OT* O, int rows) {
    int tid_ = threadIdx.x; asm volatile("" : "+v"(tid_));
    const int lane = tid_ & 63, wv = tid_ >> 6;
    const int gw = blockIdx.x * (NT / 64) + wv, ngw = gridDim.x * (NT / 64);
    for (int r = gw; r < rows; r += ngw) {
        const float4* xr = (const float4*)(X + (size_t)r * D);
        float4 v[4]; float s = 0.f;
#pragma unroll
        for (int j = 0; j < 4; ++j) { v[j] = xr[lane + 64 * j]; s += v[j].x * v[j].x + v[j].y * v[j].y + v[j].z * v[j].z + v[j].w * v[j].w; }
        s = wave_sum(s);
        const float rs = rsqrtf(s * (1.f / D) + 1e-6f);
#pragma unroll
        for (int j = 0; j < 4; ++j) {
            const float4 gg = ((const float4*)g)[lane + 64 * j];
            const float4 o = make_float4(v[j].x * rs * gg.x, v[j].y * rs * gg.y, v[j].z * rs * gg.z, v[j].w * rs * gg.w);
            if constexpr (sizeof(OT) == 4) ((float4*)(O + (size_t)r * D))[lane + 64 * j] = o;
            else ((uint2*)(O + (size_t)r * D))[lane + 64 * j] = make_uint2(f2bf(o.x) | (f2bf(o.y) << 16), f2bf(o.z) | (f2bf(o.w) << 16));
        }
    }
}

namespace pg8 {
#define PG8_LAS __attribute__((address_space(3)))
typedef short bf16x8 __attribute__((ext_vector_type(8)));
typedef float f32x4 __attribute__((ext_vector_type(4)));
typedef unsigned u32x4 __attribute__((ext_vector_type(4)));
constexpr int BM = 256, BK = 64, HALF = 128, HTB = HALF * BK * 2  , STAGE_BYTES = 8 * HTB, NXCD = 8, WGM = 8;

__host__ __device__ __forceinline__ int lds_byte(int r, int c) { const int st = (r >> 4) * 2 + (c >> 5), rr = r & 15, cc = c & 31, ob = rr * 64 + cc * 2; return st * 1024 + (ob ^ (((ob >> 9) & 1) << 5)); }
__host__ __device__ __forceinline__ void stage_rc(int b, int& R, int& C) { const int st = b / 1024, sb = b % 1024, swz = sb ^ (((sb >> 9) & 1) << 5); R = (st >> 1) * 16 + swz / 64; C = (st & 1) * 32 + (swz % 64) / 2; }
__host__ __device__ __forceinline__ int perm32(int rho) { const int n = rho >> 4, i = rho & 15; return 8 * (i >> 2) + 4 * n + (i & 3); }

struct Unit { int pm, pn; };
struct Gemm { const bf16_t* A; const bf16_t* Bt; int M, N, K, lda, ldb, pad; };

struct StaticOrder {
    int nM, nN, nwg, G, c;
    __host__ __device__ void init(int M, int N, int G_, int c_) { nM = M / BM; nN = N / BM; nwg = nM * nN; G = G_; c = c_; }
    __host__ __device__ bool next(int i, Unit& u) const {
        const long L = (long)i * G + c; if (L >= nwg) return false;
        int wgid = (int)L; { const int q = nwg / NXCD, r = nwg % NXCD, xcd = wgid % NXCD, off = wgid / NXCD; wgid = (xcd < r ? xcd * (q + 1) : r * (q + 1) + (xcd - r) * q) + off; }
        const int nig = WGM * nN, gid = wgid / nig, fm = gid * WGM, gsz = (nM - fm) < WGM ? (nM - fm) : WGM;
        u.pm = fm + ((wgid % nig) % gsz); u.pn = (wgid % nig) / gsz; return true;
    }
    __device__ __forceinline__ void a_ready(const Unit&) const {}
    __device__ __forceinline__ void done(const Unit&) const {}
};


typedef __bf16 bf16x2p_t __attribute__((ext_vector_type(2)));
typedef float f32x2p_t __attribute__((ext_vector_type(2)));
__device__ __forceinline__ unsigned cvt_pk_bf16(float lo, float hi) { return __builtin_bit_cast(unsigned, __builtin_convertvector((f32x2p_t){lo, hi}, bf16x2p_t)); }
__device__ __forceinline__ float sigm(float x) { return __builtin_amdgcn_rcpf(1.f + __expf(-x)); }
struct EpiProjP {
    static constexpr bool PERM = true, AFTER_DRAIN = false;
    bf16_t* PM; bf16_t* G;
    __device__ __forceinline__ void operator()(const f32x4 (&acc)[2][2][4][2], const Unit& u, int wr, int wc, int fr, int fq) const {
        const int row0 = u.pm * BM + wr * 64 + fr;
        const bool sg = u.pn >= 12;
        bf16_t* base = sg ? G : PM; const int ld = sg ? 4096 : 3072; const int colt = (sg ? u.pn - 12 : u.pn) * BM;
        const int col0 = colt + wc * 32 + 8 * fq;
#pragma unroll
        for (int ai = 0; ai < 2; ++ai)
#pragma unroll
            for (int m = 0; m < 4; ++m) { bf16_t* rowp = base + (size_t)(row0 + ai * HALF + m * 16) * ld + col0;
#pragma unroll
                for (int bj = 0; bj < 2; ++bj) { f32x4 v0 = acc[ai][bj][m][0], v1 = acc[ai][bj][m][1];
                    if (sg) { v0[0] = sigm(v0[0]); v0[1] = sigm(v0[1]); v0[2] = sigm(v0[2]); v0[3] = sigm(v0[3]); v1[0] = sigm(v1[0]); v1[1] = sigm(v1[1]); v1[2] = sigm(v1[2]); v1[3] = sigm(v1[3]); }
                    u32x4 w; w.x = cvt_pk_bf16(v0[0], v0[1]); w.y = cvt_pk_bf16(v0[2], v0[3]); w.z = cvt_pk_bf16(v1[0], v1[1]); w.w = cvt_pk_bf16(v1[2], v1[3]);
                    *(u32x4*)(rowp + bj * HALF) = w; } }
    }
};
struct EpiRelu2P {
    static constexpr bool PERM = true, AFTER_DRAIN = false;
    bf16_t* O; int ldo; int pad;
    __device__ __forceinline__ void operator()(const f32x4 (&acc)[2][2][4][2], const Unit& u, int wr, int wc, int fr, int fq) const {
        const int row0 = u.pm * BM + wr * 64 + fr, col0 = u.pn * BM + wc * 32 + 8 * fq;
#pragma unroll
        for (int ai = 0; ai < 2; ++ai)
#pragma unroll
            for (int m = 0; m < 4; ++m) { bf16_t* rowp = O + (size_t)(row0 + ai * HALF + m * 16) * ldo + col0;
#pragma unroll
                for (int bj = 0; bj < 2; ++bj) { f32x4 v0 = acc[ai][bj][m][0], v1 = acc[ai][bj][m][1];
#pragma unroll
                    for (int j = 0; j < 4; ++j) { const float a = fmaxf(v0[j], 0.f), b = fmaxf(v1[j], 0.f); v0[j] = a * a; v1[j] = b * b; }
                    u32x4 w; w.x = cvt_pk_bf16(v0[0], v0[1]); w.y = cvt_pk_bf16(v0[2], v0[3]); w.z = cvt_pk_bf16(v1[0], v1[1]); w.w = cvt_pk_bf16(v1[2], v1[3]);
                    *(u32x4*)(rowp + bj * HALF) = w; } }
    }
};
struct EpiResidP {
    static constexpr bool PERM = false, AFTER_DRAIN = false;
    const float* base; float* out;
    __device__ __forceinline__ void operator()(const f32x4 (&acc)[2][2][4][2], const Unit& u, int wr, int wc, int fr, int fq) const {
        const int row0 = u.pm * BM + wr * 64 + fr, col0 = u.pn * BM + wc * 32 + 4 * fq;
#pragma unroll
        for (int ai = 0; ai < 2; ++ai)
#pragma unroll
            for (int m = 0; m < 4; ++m) { const size_t off = (size_t)(row0 + ai * HALF + m * 16) * 1024 + col0;
#pragma unroll
                for (int bj = 0; bj < 2; ++bj)
#pragma unroll
                    for (int n = 0; n < 2; ++n) { const f32x4 b = *(const f32x4*)(base + off + bj * HALF + n * 16); *(f32x4*)(out + off + bj * HALF + n * 16) = b + acc[ai][bj][m][n]; } }
    }
};
template <class Epi, class Sched, bool ALIGN_EPI = false, bool SP2 = false>
__device__ __forceinline__ void gemm_phase(PG8_LAS unsigned char* lds, const Gemm g, const Sched& S, const Epi& E) {
    int tid = threadIdx.x; asm volatile("" : "+v"(tid));
    const int wid = __builtin_amdgcn_readfirstlane(tid >> 6), lane = tid & 63, wr = wid >> 2, wc = wid & 3, fr = lane & 15, fq = lane >> 4;
    const int K = g.K, nt = K / BK;
    unsigned voffA[2], voffB[2];
#pragma unroll
    for (int i = 0; i < 2; ++i) { int R, C; stage_rc(tid * 16 + i * 8192, R, C); const int Rb = Epi::PERM ? ((R & ~31) + perm32(R & 31)) : R;
        voffA[i] = (unsigned)(R * g.lda + C) * 2u; voffB[i] = (unsigned)(Rb * g.ldb + C) * 2u; }
    const size_t kstep = (size_t)(BK * 2);
    const size_t hstepA = (size_t)HALF * g.lda * 2, hstepB = (size_t)HALF * g.ldb * 2;
    const size_t tstepA = 2 * hstepA, tstepB = 2 * hstepB;
    const unsigned ldsw = (unsigned)wid * 1024u;
    const int aoff = lds_byte(wr * 64 + fr, fq * 8), boff = lds_byte(wc * 32 + fr, fq * 8);
#define PG8_SA(b, h) (((b) * 2 + (h)) * HTB)
#define PG8_SB(b, h) ((4 + (b) * 2 + (h)) * HTB)
#define PG8_STAGE(bufoff, gbase, voff) do { _Pragma("unroll") for (int _i = 0; _i < 2; ++_i) \
        __builtin_amdgcn_global_load_lds((const unsigned*)((const char*)(gbase) + (voff)[_i]), (PG8_LAS unsigned*)(lds + (bufoff) + ldsw + _i * 8192), 16, 0, 0); } while (0)
#define PG8_LDA(dst, b, h) do { _Pragma("unroll") for (int m = 0; m < 4; ++m) _Pragma("unroll") for (int k = 0; k < 2; ++k) dst[m][k] = *(const PG8_LAS bf16x8*)(lds + PG8_SA(b, h) + aoff + m * 2048 + k * 1024); } while (0)
#define PG8_LDB(dst, b, h) do { _Pragma("unroll") for (int n = 0; n < 2; ++n) _Pragma("unroll") for (int k = 0; k < 2; ++k) dst[n][k] = *(const PG8_LAS bf16x8*)(lds + PG8_SB(b, h) + boff + n * 2048 + k * 1024); } while (0)
#define PG8_MMA(ai, bj, At, Bt) do { __builtin_amdgcn_s_setprio(1); _Pragma("unroll") for (int m = 0; m < 4; ++m) _Pragma("unroll") for (int n = 0; n < 2; ++n) _Pragma("unroll") for (int k = 0; k < 2; ++k) \
        acc[ai][bj][m][n] = __builtin_amdgcn_mfma_f32_16x16x32_bf16(Bt[n][k], At[m][k], acc[ai][bj][m][n], 0, 0, 0); __builtin_amdgcn_s_setprio(0); } while (0)
#define PG8_WAIT_V(n) asm volatile("s_waitcnt vmcnt(" #n ")" ::: "memory")
#define PG8_WAIT_L(n) asm volatile("s_waitcnt lgkmcnt(" #n ")" ::: "memory")
#define PG8_BAR __builtin_amdgcn_s_barrier()
#define PG8_SCHED __builtin_amdgcn_sched_barrier(0)
    Unit cur, nxt; int ui = 0;
    if (!S.next(0, cur)) return;
    f32x4 acc[2][2][4][2];
#pragma unroll
    for (int a = 0; a < 2; ++a)
#pragma unroll
        for (int b = 0; b < 2; ++b)
#pragma unroll
            for (int m = 0; m < 4; ++m)
#pragma unroll
                for (int n = 0; n < 2; ++n) acc[a][b][m][n] = (f32x4){0.f, 0.f, 0.f, 0.f};
    bf16x8 At[4][2], B0[2][2], B1[2][2];
    const char* cA = (const char*)g.A + (size_t)cur.pm * tstepA; const char* cB = (const char*)g.Bt + (size_t)cur.pn * tstepB;
    S.a_ready(cur);
    if constexpr (SP2) {
        PG8_STAGE(PG8_SB(0, 0), cB, voffB); PG8_STAGE(PG8_SB(0, 1), cB + hstepB, voffB); PG8_STAGE(PG8_SA(0, 0), cA, voffA); PG8_STAGE(PG8_SA(0, 1), cA + hstepA, voffA);
        if (wr == 1) PG8_BAR;
        PG8_WAIT_V(2); PG8_BAR;
        PG8_STAGE(PG8_SB(1, 0), cB + kstep, voffB); PG8_STAGE(PG8_SA(1, 0), cA + kstep, voffA); PG8_STAGE(PG8_SB(1, 1), cB + hstepB + kstep, voffB);
        PG8_WAIT_V(6); PG8_BAR;
    } else {
        PG8_STAGE(PG8_SB(0, 0), cB, voffB); PG8_STAGE(PG8_SA(0, 0), cA, voffA); PG8_STAGE(PG8_SB(0, 1), cB + hstepB, voffB); PG8_STAGE(PG8_SA(0, 1), cA + hstepA, voffA);
        if (wr == 1) PG8_BAR;
        PG8_WAIT_V(4); PG8_BAR;
        PG8_STAGE(PG8_SB(1, 0), cB + kstep, voffB); PG8_STAGE(PG8_SA(1, 0), cA + kstep, voffA); PG8_STAGE(PG8_SB(1, 1), cB + hstepB + kstep, voffB);
        PG8_WAIT_V(6); PG8_BAR;
    }
    for (;;) {
        const bool has_next = S.next(ui + 1, nxt);
        const char* nA = has_next ? (const char*)g.A + (size_t)nxt.pm * tstepA : cA; const char* nB = has_next ? (const char*)g.Bt + (size_t)nxt.pn * tstepB : cB;
        for (int t = 0; t < nt; t += 2) {
            const bool last = (t == nt - 2);
            const char* a1 = cA + (size_t)(t + 1) * kstep;
            const char* a2 = last ? nA : cA + (size_t)(t + 2) * kstep; const char* b2 = last ? nB : cB + (size_t)(t + 2) * kstep;
            const char* a3 = a2 + kstep; const char* b3 = b2 + kstep;
            if (last && has_next) S.a_ready(nxt);
            if constexpr (SP2) {
            PG8_LDB(B0, 0, 0); PG8_LDB(B1, 0, 1); PG8_SCHED; PG8_LDA(At, 0, 0); PG8_STAGE(PG8_SA(1, 1), a1 + hstepA, voffA);
            PG8_WAIT_V(8); PG8_WAIT_L(0); PG8_BAR; PG8_MMA(0, 0, At, B0); PG8_MMA(0, 1, At, B1); PG8_BAR; PG8_SCHED;
            PG8_LDA(At, 0, 1); PG8_STAGE(PG8_SB(0, 0), b2, voffB); PG8_STAGE(PG8_SB(0, 1), b2 + hstepB, voffB); PG8_STAGE(PG8_SA(0, 0), a2, voffA);
            PG8_WAIT_V(8); PG8_WAIT_L(0); PG8_BAR; PG8_MMA(1, 0, At, B0); PG8_MMA(1, 1, At, B1); PG8_BAR; PG8_SCHED;
            PG8_LDB(B0, 1, 0); PG8_LDB(B1, 1, 1); PG8_SCHED; PG8_LDA(At, 1, 0); PG8_STAGE(PG8_SA(0, 1), a2 + hstepA, voffA);
            PG8_WAIT_V(8); PG8_WAIT_L(0); PG8_BAR; PG8_MMA(0, 0, At, B0); PG8_MMA(0, 1, At, B1); PG8_BAR; PG8_SCHED;
            PG8_LDA(At, 1, 1); PG8_STAGE(PG8_SB(1, 0), b3, voffB); PG8_STAGE(PG8_SB(1, 1), b3 + hstepB, voffB); PG8_STAGE(PG8_SA(1, 0), a3, voffA);
            PG8_WAIT_V(8); PG8_WAIT_L(0); PG8_BAR; PG8_MMA(1, 0, At, B0); PG8_MMA(1, 1, At, B1); PG8_BAR; PG8_SCHED;
            } else {
            PG8_LDB(B0, 0, 0); PG8_SCHED; PG8_LDA(At, 0, 0); PG8_STAGE(PG8_SA(1, 1), a1 + hstepA, voffA);
            PG8_WAIT_L(8); PG8_BAR; PG8_WAIT_L(0); PG8_MMA(0, 0, At, B0); PG8_BAR; PG8_SCHED;
            PG8_LDB(B1, 0, 1); PG8_STAGE(PG8_SB(0, 0), b2, voffB);
            PG8_BAR; PG8_WAIT_L(0); PG8_MMA(0, 1, At, B1); PG8_BAR;
            PG8_LDA(At, 0, 1); PG8_STAGE(PG8_SA(0, 0), a2, voffA);
            PG8_BAR; PG8_WAIT_L(0); PG8_MMA(1, 0, At, B0); PG8_BAR; PG8_SCHED;
            PG8_STAGE(PG8_SB(0, 1), b2 + hstepB, voffB);
            PG8_WAIT_V(6); PG8_BAR; PG8_MMA(1, 1, At, B1); PG8_BAR;
            PG8_LDB(B0, 1, 0); PG8_SCHED; PG8_LDA(At, 1, 0); PG8_STAGE(PG8_SA(0, 1), a2 + hstepA, voffA);
            PG8_WAIT_L(8); PG8_BAR; PG8_WAIT_L(0); PG8_MMA(0, 0, At, B0); PG8_BAR; PG8_SCHED;
            PG8_LDB(B1, 1, 1); PG8_STAGE(PG8_SB(1, 0), b3, voffB);
            PG8_BAR; PG8_WAIT_L(0); PG8_MMA(0, 1, At, B1); PG8_BAR;
            PG8_LDA(At, 1, 1); PG8_STAGE(PG8_SA(1, 0), a3, voffA);
            PG8_BAR; PG8_WAIT_L(0); PG8_MMA(1, 0, At, B0); PG8_BAR; PG8_SCHED;
            PG8_STAGE(PG8_SB(1, 1), b3 + hstepB, voffB);
            PG8_WAIT_V(6); PG8_BAR; PG8_MMA(1, 1, At, B1); PG8_BAR;
            }
        }
        if constexpr (ALIGN_EPI) { if (wr == 0) PG8_BAR; }
        if constexpr (!Epi::AFTER_DRAIN) { E(acc, cur, wr, wc, fr, fq); S.done(cur); }
        if (!has_next) break;
#pragma unroll
        for (int a = 0; a < 2; ++a)
#pragma unroll
            for (int b = 0; b < 2; ++b)
#pragma unroll
                for (int m = 0; m < 4; ++m)
#pragma unroll
                    for (int n = 0; n < 2; ++n) acc[a][b][m][n] = (f32x4){0.f, 0.f, 0.f, 0.f};
        cur = nxt; cA = nA; cB = nB; ++ui;
        if constexpr (ALIGN_EPI) { if (wr == 1) PG8_BAR; }
    }
    PG8_WAIT_V(0);
    if constexpr (!ALIGN_EPI) { if (wr == 0) PG8_BAR; }
    PG8_BAR;
    if constexpr (Epi::AFTER_DRAIN) { E.fused(acc, cur, wr, wc, fr, fq, lds, wid, lane); S.done(cur); }
#undef PG8_SA
#undef PG8_SB
#undef PG8_STAGE
#undef PG8_LDA
#undef PG8_LDB
#undef PG8_MMA
#undef PG8_WAIT_V
#undef PG8_WAIT_L
#undef PG8_BAR
#undef PG8_SCHED
}
}


__device__ __forceinline__ unsigned pk2(float lo, float hi) { return f2bf(lo) | (f2bf(hi) << 16); }
template <class CM>
__device__ __forceinline__ void transpose_item(const float* __restrict__ Wsrc, int K, int ldsrc, bf16_t* __restrict__ WT, int nblk, LAS float* scr, int item, int lane, CM colmap) {
    const int kb = item / nblk, nb = item % nblk, k0 = 64 * kb, n0 = 32 * nb;
    const int sc = colmap(n0 + (lane & 31));
#pragma unroll 8
    for (int i = 0; i < 32; ++i) { const int kk = 2 * i + (lane >> 5); scr[kk * 33 + (lane & 31)] = sc >= 0 ? Wsrc[(size_t)(k0 + kk) * ldsrc + sc] : 0.f; }
    asm volatile("s_waitcnt lgkmcnt(0)" ::: "memory");
    const int c = lane & 7;
#pragma unroll
    for (int j = 0; j < 4; ++j) { const int n = (lane >> 3) + 8 * j; const LAS float* s = scr + (8 * c) * 33 + n;
        uint4 o; o.x = pk2(s[0 * 33], s[1 * 33]); o.y = pk2(s[2 * 33], s[3 * 33]); o.z = pk2(s[4 * 33], s[5 * 33]); o.w = pk2(s[6 * 33], s[7 * 33]);
        *(uint4*)(WT + (size_t)(n0 + n) * K + k0 + 8 * c) = o; }
    asm volatile("s_waitcnt lgkmcnt(0)" ::: "memory");
}
constexpr size_t WO_IN = 0;
constexpr size_t WO_BR = WO_IN + (size_t)7168 * 1024;
constexpr size_t WO_OUT = WO_BR + (size_t)4 * 1024 * 256;
constexpr size_t WO_W1 = WO_OUT + (size_t)1024 * 1024;
constexpr size_t WO_W2 = WO_W1 + (size_t)4096 * 1024;
constexpr size_t WO_WUP = WO_W2 + (size_t)4096 * 1024;
constexpr size_t WO_AUP = WO_WUP + 256 * 64;
constexpr size_t WO_GUP = WO_AUP + 256 * 64;
constexpr size_t WO_GLU = WO_GUP + 256 * 128;
constexpr size_t WO_LWT = WO_GLU + 256 * 256;
constexpr size_t WO_S5B = WO_LWT + 2 * 16384;
constexpr size_t WO_S5C = WO_S5B + 16 * 8 * 64 * 8;
constexpr size_t WO_LAYER = WO_S5C + 16 * 4 * 64 * 8;
__device__ __forceinline__ void convert_weights(const Params& p, int l, LAS float* scr, int gw, int ngw, int lane) {
    bf16_t* WB = (bf16_t*)(p.ws() + WS_W);
    constexpr int I_IN = (1024 / 64) * (7168 / 32), I_BR = (256 / 64) * (1024 / 32), I_OUT = (1024 / 64) * (1024 / 32), I_W1 = (1024 / 64) * (4096 / 32), I_W2 = (4096 / 64) * (1024 / 32);
    constexpr int I_UP = 8, I_GUP = 16, I_GLU = 4 * 8, I_LW = 16, I_S5B = 128, I_S5C = 64;
    constexpr int PER_LAYER = I_IN + 4 * I_BR + I_OUT + I_W1 + I_W2 + 2 * I_UP + I_GUP + I_GLU + I_LW + I_S5B + I_S5C;
    for (int it = gw; it < PER_LAYER; it += ngw) {
        int r = it;
        bf16_t* WL = WB;
        if (r < I_IN) { transpose_item(p.in[2] + (size_t)l * D * DIN, 1024, DIN, WL + WO_IN, 7168 / 32, scr, r, lane, [](int j) { return j < NMIX ? j : (j < 3072 ? -1 : j - 248); }); continue; } r -= I_IN;
        if (r < 4 * I_BR) { const int i = r / I_BR; transpose_item(p.in[35] + ((size_t)l * 4 + i) * W * D, 256, D, WL + WO_BR + (size_t)i * 1024 * 256, 1024 / 32, scr, r % I_BR, lane, [](int j) { return j; }); continue; } r -= 4 * I_BR;
        if (r < I_OUT) { transpose_item(p.in[36] + (size_t)l * D * D, 1024, D, WL + WO_OUT, 1024 / 32, scr, r, lane, [](int j) { return j; }); continue; } r -= I_OUT;
        if (r < I_W1) { transpose_item(p.in[38] + (size_t)l * D * DFF, 1024, DFF, WL + WO_W1, 4096 / 32, scr, r, lane, [](int j) { return j; }); continue; } r -= I_W1;
        if (r < I_W2) { transpose_item(p.in[39] + (size_t)l * DFF * D, 4096, D, WL + WO_W2, 1024 / 32, scr, r, lane, [](int j) { return j; }); continue; } r -= I_W2;
        if (r < I_UP) { transpose_item(p.in[26] + (size_t)l * 64 * W, 64, W, WL + WO_WUP, 8, scr, r, lane, [](int j) { return j; }); continue; } r -= I_UP;
        if (r < I_UP) { transpose_item(p.in[28] + (size_t)l * 64 * W, 64, W, WL + WO_AUP, 8, scr, r, lane, [](int j) { return j; }); continue; } r -= I_UP;
        if (r < I_GUP) { transpose_item(p.in[29] + (size_t)l * 128 * W, 128, W, WL + WO_GUP, 8, scr, r, lane, [](int j) { return j; }); continue; } r -= I_GUP;
        if (r < I_GLU) { transpose_item(p.in[22] + (size_t)l * W * W, 256, W, WL + WO_GLU, 8, scr, r, lane, [](int j) { return j; }); continue; } r -= I_GLU;
        if (r < I_LW) { const int gt = r >> 3, nb = (r >> 1) & 3; transpose_item((gt ? p.in[11] : p.in[9]) + (size_t)l * 16384 + nb * 4096, 64, 64, WL + WO_LWT + (size_t)gt * 16384 + nb * 4096, 2, scr, r & 1, lane, [](int j) { return j; }); continue; } r -= I_LW;
        if (r < I_S5B) {
            const int g = r >> 3, tn = r & 7, q4 = lane >> 4, cc = lane & 15, n = 16 * tn + cc, pp = n >> 1, ri = n & 1;
            const float dt = __expf(p.in[21][l * 16 + g]);
            const float lre = p.in[14][l * 1024 + g * 64 + pp], lim = p.in[15][l * 1024 + g * 64 + pp];
            const float er = __expf(lre * dt), lbr = er * cosf(lim * dt), lbi = er * sinf(lim * dt);
            const float nr = lbr - 1.f, ni = lbi, den = lre * lre + lim * lim;
            const float fr = (nr * lre + ni * lim) / den, fi = (ni * lre - nr * lim) / den;
            float v[8];
#pragma unroll
            for (int j = 0; j < 8; ++j) { float x = 0.f;
                if (q4 < 2) { const float br = p.in[16][(size_t)l * 16384 + (g * 64 + pp) * 16 + 8 * q4 + j], bi = p.in[17][(size_t)l * 16384 + (g * 64 + pp) * 16 + 8 * q4 + j]; x = ri ? (fr * bi + fi * br) : (fr * br - fi * bi); }
                v[j] = x; }
            *(uint4*)(WL + WO_S5B + ((size_t)(g * 8 + tn) * 64 + lane) * 8) = make_uint4(pk2(v[0], v[1]), pk2(v[2], v[3]), pk2(v[4], v[5]), pk2(v[6], v[7]));
            continue; } r -= I_S5B;
        {
            const int g = r >> 2, ks = r & 3, q4 = lane >> 4, cc = lane & 15;
            const float* cre = p.in[18] + (size_t)l * 16384 + (g * 16 + cc) * 64 + 16 * ks + 4 * q4; const float* cim = p.in[19] + (size_t)l * 16384 + (g * 16 + cc) * 64 + 16 * ks + 4 * q4;
            *(uint4*)(WL + WO_S5C + ((size_t)(g * 4 + ks) * 64 + lane) * 8) = make_uint4(pk2(cre[0], -cim[0]), pk2(cre[1], -cim[1]), pk2(cre[2], -cim[2]), pk2(cre[3], -cim[3]));
        }
    }
}
#define BAR() do { asm volatile("s_waitcnt lgkmcnt(0)" ::: "memory"); __syncthreads(); } while (0)
typedef short bf16x8_t __attribute__((ext_vector_type(8)));
typedef float f32x4_t __attribute__((ext_vector_type(4)));
constexpr int PT = 68;
constexpr int MS = 64 * PT;
typedef __bf16 bf16x2v_t __attribute__((ext_vector_type(2)));
typedef float f32x2v_t __attribute__((ext_vector_type(2)));
__device__ __forceinline__ unsigned cvtpk(float lo, float hi) { return __builtin_bit_cast(unsigned, __builtin_convertvector((f32x2v_t){lo, hi}, bf16x2v_t)); }
typedef unsigned u32x4_t __attribute__((ext_vector_type(4)));
union U8 { bf16x8_t v; unsigned u[4]; uint4 q; u32x4_t x; };
__device__ __forceinline__ void split8(const float (&x)[8], bf16x8_t& hi, bf16x8_t& lo) {
    U8 H, L;
#pragma unroll
    for (int i = 0; i < 4; ++i) {
        const unsigned pk = cvtpk(x[2 * i], x[2 * i + 1]);
        H.u[i] = pk;
        const float f0 = __uint_as_float(pk << 16), f1 = __uint_as_float(pk & 0xffff0000u);
        L.u[i] = cvtpk(x[2 * i] - f0, x[2 * i + 1] - f1);
    }
    hi = H.v; lo = L.v;
}
__device__ __forceinline__ bf16x8_t hi8(const float (&x)[8]) {
    U8 H;
#pragma unroll
    for (int i = 0; i < 4; ++i) H.u[i] = cvtpk(x[2 * i], x[2 * i + 1]);
    return H.v;
}
template <int NSPLIT>
__device__ __forceinline__ f32x4_t mm_tile(const LAS float* A, const LAS float* Bt, int lane, f32x4_t acc) {
    const LAS float* ap = A + (lane & 15) * PT + 8 * (lane >> 4);
    const LAS float* bp = Bt + (lane & 15) * PT + 8 * (lane >> 4);
#pragma unroll
    for (int ks = 0; ks < 2; ++ks) {
        const f32x4_t a0 = *(const LAS f32x4_t*)(ap + 32 * ks), a1 = *(const LAS f32x4_t*)(ap + 32 * ks + 4);
        const f32x4_t b0 = *(const LAS f32x4_t*)(bp + 32 * ks), b1 = *(const LAS f32x4_t*)(bp + 32 * ks + 4);
        const float av[8] = {a0.x, a0.y, a0.z, a0.w, a1.x, a1.y, a1.z, a1.w};
        const float bv[8] = {b0.x, b0.y, b0.z, b0.w, b1.x, b1.y, b1.z, b1.w};
        if constexpr (NSPLIT == 3) {
            bf16x8_t ah, al, bh, bl; split8(av, ah, al); split8(bv, bh, bl);
            acc = __builtin_amdgcn_mfma_f32_16x16x32_bf16(ah, bh, acc, 0, 0, 0);
            acc = __builtin_amdgcn_mfma_f32_16x16x32_bf16(ah, bl, acc, 0, 0, 0);
            acc = __builtin_amdgcn_mfma_f32_16x16x32_bf16(al, bh, acc, 0, 0, 0);
        } else {
            acc = __builtin_amdgcn_mfma_f32_16x16x32_bf16(hi8(av), hi8(bv), acc, 0, 0, 0);
        }
    }
    return acc;
}
__device__ __forceinline__ int opq_tid() { int t = threadIdx.x; asm volatile("" : "+v"(t)); return t; }
__device__ __forceinline__ void tri_inverse_wave(LAS float* L, int lane) {
    asm volatile("" : "+v"(lane));
    asm volatile("" : "+v"(L));
    const float lf = (float)lane;
    float x[64];
#pragma unroll
    for (int i = 0; i < 64; ++i) {
        float s0 = 0.f, s1 = 0.f, s2 = 0.f, s3 = 0.f;
#pragma unroll
        for (int g4 = 0; g4 * 4 < i; ++g4) {
            const f32x4_t l = *(const LAS f32x4_t*)(L + i * PT + 4 * g4);
            s0 = fmaf(l.x, x[4 * g4], s0);
            if (4 * g4 + 1 < i) s1 = fmaf(l.y, x[4 * g4 + 1], s1);
            if (4 * g4 + 2 < i) s2 = fmaf(l.z, x[4 * g4 + 2], s2);
            if (4 * g4 + 3 < i) s3 = fmaf(l.w, x[4 * g4 + 3], s3);
        }
        x[i] = fmaxf(1.f - fabsf(lf - (float)i), 0.f) - ((s0 + s1) + (s2 + s3));
        L[i * PT + lane] = x[i];
        if ((i & 3) == 3) __builtin_amdgcn_sched_barrier(0);
    }
}
__device__ __forceinline__ float wave_incl_scan(float v, int lane) {
#pragma unroll
    for (int o = 1; o < 64; o <<= 1) { const float u = __shfl_up(v, o); if (lane >= o) v += u; }
    return v;
}

__device__ __forceinline__ void unpack8(const uint4 u, float (&o)[8]) {
    const unsigned w[4] = {u.x, u.y, u.z, u.w};
#pragma unroll
    for (int i = 0; i < 4; ++i) { o[2 * i] = __uint_as_float(w[i] << 16); o[2 * i + 1] = __uint_as_float(w[i] & 0xffff0000u); }
}
__device__ __forceinline__ uint4 pack8(const float (&x)[8]) { return make_uint4(cvtpk(x[0], x[1]), cvtpk(x[2], x[3]), cvtpk(x[4], x[5]), cvtpk(x[6], x[7])); }
typedef unsigned short LAS lds_bf16;
constexpr int MIX_LDS_C = 8 * MS * 4 + 1024;
__device__ __forceinline__ void merge_phase(const bf16_t* __restrict__ Yb, const bf16_t* __restrict__ WbT, const bf16_t* __restrict__ G, bf16_t* __restrict__ MG, LAS unsigned char* lds) {
    const int tid = opq_tid(), w = __builtin_amdgcn_readfirstlane(tid >> 6), lane = tid & 63, q4 = lane >> 4, cc = lane & 15;
    const int wr = w >> 2, wc = w & 3;
    constexpr int PA = 144;
    constexpr int ABUF = 128 * PA, BUF = 2 * ABUF;
    const int bid = blockIdx.x, G_ = gridDim.x;
    const int srow = tid >> 2, sk = (tid & 3) * 16;
    for (int it = 0; ; ++it) {
        const int U = it * G_ + bid;
        if (U >= 1024) break;
        const int Lx = (G_ == 256) ? ((bid & 7) * 128 + it * 32 + (bid >> 3)) : U;
        const int pm = Lx >> 3, pn = Lx & 7;
        const bf16_t* Abase = Yb + (size_t)(pm * 128 + srow) * 1024 + sk;
        const bf16_t* Bbase = WbT + (size_t)(pn * 128 + srow) * 256 + sk;
        const bf16_t* gbase = G + (size_t)(pm * 128 + wr * 64 + cc) * 4096 + pn * 128 + wc * 32 + 4 * q4;
        f32x4_t mg[4][2], acc[4][2];
#pragma unroll
        for (int m = 0; m < 4; ++m)
#pragma unroll
            for (int n = 0; n < 2; ++n) mg[m][n] = (f32x4_t){0.f, 0.f, 0.f, 0.f};
        uint4 r0[4], r1[4];
        uint2 gq[4][2];
#define MG_LOAD(R, s_) do { const int br_ = (s_) >> 2, kq_ = (s_) & 3; const bf16_t* ap_ = Abase + br_ * 256 + kq_ * 64; const bf16_t* bp_ = Bbase + (size_t)br_ * 1024 * 256 + kq_ * 64; \
            R[0] = *(const uint4*)ap_; R[1] = *(const uint4*)(ap_ + 8); R[2] = *(const uint4*)bp_; R[3] = *(const uint4*)(bp_ + 8); } while (0)
#define MG_STORE(R, buf_) do { LAS unsigned char* ab_ = lds + (buf_) * BUF + srow * PA + sk * 2; \
            *(LAS u32x4_t*)ab_ = (u32x4_t){R[0].x, R[0].y, R[0].z, R[0].w}; *(LAS u32x4_t*)(ab_ + 16) = (u32x4_t){R[1].x, R[1].y, R[1].z, R[1].w}; \
            *(LAS u32x4_t*)(ab_ + ABUF) = (u32x4_t){R[2].x, R[2].y, R[2].z, R[2].w}; *(LAS u32x4_t*)(ab_ + ABUF + 16) = (u32x4_t){R[3].x, R[3].y, R[3].z, R[3].w}; } while (0)
#define MG_COMPUTE(buf_) do { const LAS unsigned char* ab_ = lds + (buf_) * BUF + (wr * 64 + cc) * PA + 16 * q4; const LAS unsigned char* bb_ = lds + (buf_) * BUF + ABUF + (wc * 32 + cc) * PA + 16 * q4; \
            _Pragma("unroll") for (int ks = 0; ks < 2; ++ks) { U8 bf_[2]; \
                _Pragma("unroll") for (int n = 0; n < 2; ++n) bf_[n].x = *(const LAS u32x4_t*)(bb_ + n * 16 * PA + ks * 64); \
                _Pragma("unroll") for (int m = 0; m < 4; ++m) { U8 af_; af_.x = *(const LAS u32x4_t*)(ab_ + m * 16 * PA + ks * 64); \
                    _Pragma("unroll") for (int n = 0; n < 2; ++n) acc[m][n] = __builtin_amdgcn_mfma_f32_16x16x32_bf16(bf_[n].v, af_.v, acc[m][n], 0, 0, 0); } } } while (0)
#define MG_STEP(s_, RL, RS) do { \
            if (((s_) & 3) == 0) { \
                _Pragma("unroll") for (int m = 0; m < 4; ++m) _Pragma("unroll") for (int n = 0; n < 2; ++n) { acc[m][n] = (f32x4_t){0.f, 0.f, 0.f, 0.f}; \
                    gq[m][n] = *(const uint2*)(gbase + ((s_) >> 2) * 1024 + (size_t)m * 16 * 4096 + n * 16); \
                    if (MEXP == 1) { const uint2 gx_ = *(const uint2*)(gbase + ((((s_) >> 2) + 1) & 3) * 1024 + (size_t)m * 16 * 4096 + n * 16); asm volatile("" :: "v"(gx_.x), "v"(gx_.y)); } } } \
            if ((s_) + 2 < 16) MG_LOAD(RL, (s_) + 2); \
            if (MEXP == 2) { uint4 rx_[4]; MG_LOAD(rx_, ((s_) + 6) & 15); asm volatile("" :: "v"(rx_[0].x), "v"(rx_[1].x), "v"(rx_[2].x), "v"(rx_[3].x)); } \
            MG_COMPUTE((s_) & 1); \
            if (MEXP == 3) { f32x4_t sv_[4][2]; _Pragma("unroll") for (int m = 0; m < 4; ++m) _Pragma("unroll") for (int n = 0; n < 2; ++n) sv_[m][n] = acc[m][n]; MG_COMPUTE((s_) & 1); \
                _Pragma("unroll") for (int m = 0; m < 4; ++m) _Pragma("unroll") for (int n = 0; n < 2; ++n) { asm volatile("" :: "v"(acc[m][n])); acc[m][n] = sv_[m][n]; } } \
            if (((s_) & 3) == 3) { \
                _Pragma("unroll") for (int m = 0; m < 4; ++m) _Pragma("unroll") for (int n = 0; n < 2; ++n) { const uint2 g2_ = gq[m][n]; \
                    mg[m][n][0] = fmaf(__uint_as_float(g2_.x << 16), acc[m][n][0], mg[m][n][0]); mg[m][n][1] = fmaf(__uint_as_float(g2_.x & 0xffff0000u), acc[m][n][1], mg[m][n][1]); \
                    mg[m][n][2] = fmaf(__uint_as_float(g2_.y << 16), acc[m][n][2], mg[m][n][2]); mg[m][n][3] = fmaf(__uint_as_float(g2_.y & 0xffff0000u), acc[m][n][3], mg[m][n][3]); } } \
            if ((s_) + 1 < 16) MG_STORE(RS, ((s_) + 1) & 1); \
            BAR(); } while (0)
        MG_LOAD(r0, 0); MG_LOAD(r1, 1);
        MG_STORE(r0, 0);
        BAR();
#pragma unroll 1
        for (int s2 = 0; s2 < 16; s2 += 2) {
            MG_STEP(s2, r0, r1);
            MG_STEP(s2 + 1, r1, r0);
        }
        {
            bf16_t* op = MG + (size_t)(pm * 128 + wr * 64 + cc) * 1024 + pn * 128 + wc * 32 + 4 * q4;
#pragma unroll
            for (int m = 0; m < 4; ++m)
#pragma unroll
                for (int n = 0; n < 2; ++n) *(uint2*)(op + (size_t)m * 16 * 1024 + n * 16) = make_uint2(cvtpk(mg[m][n][0], mg[m][n][1]), cvtpk(mg[m][n][2], mg[m][n][3]));
        }
#undef MG_LOAD
#undef MG_STORE
#undef MG_COMPUTE
#undef MG_STEP
    }
}

constexpr int PB = 72;
constexpr int PLBYTES = 64 * PB * 2;
typedef unsigned u32x2_t __attribute__((ext_vector_type(2)));
__device__ __forceinline__ lds_bf16* plane(LAS unsigned char* lds, int i) { return (lds_bf16*)(lds + i * PLBYTES); }
__device__ __forceinline__ void hilo2(float a, float b, unsigned& h, unsigned& l) { h = cvtpk(a, b); l = cvtpk(a - __uint_as_float(h << 16), b - __uint_as_float(h & 0xffff0000u)); }
__device__ __forceinline__ unsigned short bf_hi(float v) { return (unsigned short)(cvtpk(v, 0.f) & 0xffffu); }
template <bool LO>
__device__ __forceinline__ void put8(lds_bf16* Ph, lds_bf16* Pl, int r, int c0, const float (&x)[8]) {
    unsigned h[4], l[4];
#pragma unroll
    for (int i = 0; i < 4; ++i) hilo2(x[2 * i], x[2 * i + 1], h[i], l[i]);
    *(LAS u32x4_t*)(Ph + r * PB + c0) = (u32x4_t){h[0], h[1], h[2], h[3]};
    if (LO) *(LAS u32x4_t*)(Pl + r * PB + c0) = (u32x4_t){l[0], l[1], l[2], l[3]};
}
template <bool LO>
__device__ __forceinline__ void put8T(lds_bf16* Ph, lds_bf16* Pl, int r, int c0, const float (&x)[8]) {
#pragma unroll
    for (int i = 0; i < 4; ++i) {
        unsigned h, l; hilo2(x[2 * i], x[2 * i + 1], h, l);
        Ph[(c0 + 2 * i) * PB + r] = (unsigned short)(h & 0xffffu); Ph[(c0 + 2 * i + 1) * PB + r] = (unsigned short)(h >> 16);
        if (LO) { Pl[(c0 + 2 * i) * PB + r] = (unsigned short)(l & 0xffffu); Pl[(c0 + 2 * i + 1) * PB + r] = (unsigned short)(l >> 16); }
    }
}
__device__ __forceinline__ bf16x8_t frag(const lds_bf16* P, int row, int k) { U8 u; u.x = *(const LAS u32x4_t*)(P + row * PB + k); return u.v; }
template <bool AL, bool BL>
__device__ __forceinline__ f32x4_t mmp(const lds_bf16* Ah, const lds_bf16* Al, const lds_bf16* Bh, const lds_bf16* Bl, int ar0, int br0, int lane, f32x4_t acc) {
    const int r = lane & 15, k0 = 8 * (lane >> 4);
#pragma unroll
    for (int ks = 0; ks < 2; ++ks) {
        const bf16x8_t ah = frag(Ah, ar0 + r, 32 * ks + k0), bh = frag(Bh, br0 + r, 32 * ks + k0);
        acc = __builtin_amdgcn_mfma_f32_16x16x32_bf16(ah, bh, acc, 0, 0, 0);
        if (AL) acc = __builtin_amdgcn_mfma_f32_16x16x32_bf16(frag(Al, ar0 + r, 32 * ks + k0), bh, acc, 0, 0, 0);
        if (BL) acc = __builtin_amdgcn_mfma_f32_16x16x32_bf16(ah, frag(Bl, br0 + r, 32 * ks + k0), acc, 0, 0, 0);
    }
    return acc;
}
template <bool LO>
__device__ __forceinline__ void st_tile_T(lds_bf16* Ph, lds_bf16* Pl, int i0, int j0, int lane, const f32x4_t a) {
    unsigned h0, l0, h1, l1; hilo2(a[0], a[1], h0, l0); hilo2(a[2], a[3], h1, l1);
    const int o = (j0 + (lane & 15)) * PB + i0 + 4 * (lane >> 4);
    *(LAS u32x2_t*)(Ph + o) = (u32x2_t){h0, h1};
    if (LO) *(LAS u32x2_t*)(Pl + o) = (u32x2_t){l0, l1};
}
template <bool LO>
__device__ __forceinline__ void st_tile_R(lds_bf16* Ph, lds_bf16* Pl, int i0, int j0, int lane, const f32x4_t a) {
    unsigned h0, l0, h1, l1; hilo2(a[0], a[1], h0, l0); hilo2(a[2], a[3], h1, l1);
    const int o = (i0 + 4 * (lane >> 4)) * PB + j0 + (lane & 15);
    Ph[o] = (unsigned short)(h0 & 0xffffu); Ph[o + PB] = (unsigned short)(h0 >> 16); Ph[o + 2 * PB] = (unsigned short)(h1 & 0xffffu); Ph[o + 3 * PB] = (unsigned short)(h1 >> 16);
    if (LO) { Pl[o] = (unsigned short)(l0 & 0xffffu); Pl[o + PB] = (unsigned short)(l0 >> 16); Pl[o + 2 * PB] = (unsigned short)(l1 & 0xffffu); Pl[o + 3 * PB] = (unsigned short)(l1 >> 16); }
}
constexpr int LM_OFF = 13 * PLBYTES;
constexpr int VEC_OFF = LM_OFF + MS * 4;
static_assert(VEC_OFF + 1024 <= MIX_LDS_C, "plane LDS map");

struct GdnBufs { bf16_t *GQ, *GK, *GV; float *GB, *GC; uint4* MF; float* NF; float* HT; bf16_t* TG; };
__device__ __forceinline__ void gdn_prep_chunk(const bf16_t* __restrict__ PM, int n, const GdnBufs& B, const Params& p, int l, LAS float* lds) {
    const int tid = opq_tid(), w = tid >> 6, lane = tid & 63;
    const float* conv_w = p.in[3] + l * 4 * 768;
    const int t0 = n * 64;
    float wq[4][4], wk[4][4], wv[4][4];
#pragma unroll
    for (int t = 0; t < 4; ++t)
#pragma unroll
        for (int j = 0; j < 4; ++j) { wq[t][j] = conv_w[t * 768 + 4 * lane + j]; wk[t][j] = conv_w[t * 768 + 256 + 4 * lane + j]; wv[t][j] = conv_w[t * 768 + 512 + 4 * lane + j]; }
    float hq[3][4], hk[3][4], hv[3][4];
    auto ld4 = [&](int t, int col, float (&o)[4]) {
        if (t < 0) { o[0] = o[1] = o[2] = o[3] = 0.f; return; }
        const uint2 u = *(const uint2*)(PM + (size_t)t * PMLD + col);
        o[0] = __uint_as_float(u.x << 16); o[1] = __uint_as_float(u.x & 0xffff0000u); o[2] = __uint_as_float(u.y << 16); o[3] = __uint_as_float(u.y & 0xffff0000u);
    };
    const int tw = t0 + 8 * w;
#pragma unroll
    for (int i = 0; i < 3; ++i) { ld4(tw - 3 + i, 4 * lane, hq[i]); ld4(tw - 3 + i, 256 + 4 * lane, hk[i]); ld4(tw - 3 + i, 512 + 4 * lane, hv[i]); }
#pragma unroll
    for (int i = 0; i < 8; ++i) {
        const int t = tw + i;
        float pq[4], pk[4], pv[4], q[4], k[4], v[4];
        ld4(t, 4 * lane, pq); ld4(t, 256 + 4 * lane, pk); ld4(t, 512 + 4 * lane, pv);
        float sq = 0.f, sk = 0.f;
#pragma unroll
        for (int j = 0; j < 4; ++j) {
            q[j] = siluf_(wq[0][j] * hq[0][j] + wq[1][j] * hq[1][j] + wq[2][j] * hq[2][j] + wq[3][j] * pq[j]);
            k[j] = siluf_(wk[0][j] * hk[0][j] + wk[1][j] * hk[1][j] + wk[2][j] * hk[2][j] + wk[3][j] * pk[j]);
            v[j] = siluf_(wv[0][j] * hv[0][j] + wv[1][j] * hv[1][j] + wv[2][j] * hv[2][j] + wv[3][j] * pv[j]);
            hq[0][j] = hq[1][j]; hq[1][j] = hq[2][j]; hq[2][j] = pq[j];
            hk[0][j] = hk[1][j]; hk[1][j] = hk[2][j]; hk[2][j] = pk[j];
            hv[0][j] = hv[1][j]; hv[1][j] = hv[2][j]; hv[2][j] = pv[j];
            sq = fmaf(q[j], q[j], sq); sk = fmaf(k[j], k[j], sk);
        }
#pragma unroll
        for (int o = 1; o < 16; o <<= 1) { sq += __shfl_xor(sq, o); sk += __shfl_xor(sk, o); }
        const float rq = rsqrtf(sq + 1e-6f) * 0.125f, rk = rsqrtf(sk + 1e-6f);
        uint2 oq, ok, ov;
        oq.x = cvtpk(q[0] * rq, q[1] * rq); oq.y = cvtpk(q[2] * rq, q[3] * rq);
        ok.x = cvtpk(k[0] * rk, k[1] * rk); ok.y = cvtpk(k[2] * rk, k[3] * rk);
        ov.x = cvtpk(v[0], v[1]); ov.y = cvtpk(v[2], v[3]);
        *(uint2*)(B.GQ + (size_t)t * 256 + 4 * lane) = oq;
        *(uint2*)(B.GK + (size_t)t * 256 + 4 * lane) = ok;
        *(uint2*)(B.GV + (size_t)t * 256 + 4 * lane) = ov;
    }
    if (tid < 256) {
        const int t = tid >> 2, h = tid & 3;
        const bf16_t* row = PM + (size_t)(t0 + t) * PMLD;
        B.GB[(size_t)(t0 + t) * 4 + h] = sigmoidf_(bf2f(row[1024 + h]));
        const float* alog_ = p.in[4] + l * 4; const float* dtb_ = p.in[5] + l * 4;
        const float g = -__expf(alog_[h]) * softplusf_(bf2f(row[1028 + h]) + dtb_[h]);
        lds[h * 64 + t] = g;
    }
    BAR();
    if (w == 0) {
#pragma unroll
        for (int h = 0; h < 4; ++h) B.GC[(size_t)(t0 + lane) * 4 + h] = wave_incl_scan(lds[h * 64 + lane], lane);
    }
    BAR();
}

__device__ __forceinline__ float dpp_xor1(float v) { return __int_as_float(__builtin_amdgcn_update_dpp(0, __float_as_int(v), 0xB1, 0xF, 0xF, false)); }
__device__ __forceinline__ float dpp_xor2(float v) { return __int_as_float(__builtin_amdgcn_update_dpp(0, __float_as_int(v), 0x4E, 0xF, 0xF, false)); }
__device__ __forceinline__ void tri_inverse_4w(const LAS float* Lp, lds_bf16* Th, lds_bf16* Tl, int wq, int lane) {
    asm volatile("" : "+v"(lane));
    const int g = lane & 3, j = 16 * wq + (lane >> 2);
    const LAS float* base = Lp + g * 16; asm volatile("" : "+v"(base));
    const float jf = (float)j;
    float x[16];
#pragma unroll
    for (int m = 0; m < 16; ++m) x[m] = 0.f;
    f32x4_t cur[4], nxt[4];
#pragma unroll
    for (int q = 0; q < 4; ++q) cur[q] = (f32x4_t){0.f, 0.f, 0.f, 0.f};
#pragma unroll
    for (int i = 0; i < 64; ++i) {
        if (i + 1 < 64) {
#pragma unroll
            for (int q = 0; q < 4; ++q) if (16 * q < i + 1) nxt[q] = *(const LAS f32x4_t*)(base + (i + 1) * PT + 4 * q);
        }
        float s0 = 0.f, s1 = 0.f;
#pragma unroll
        for (int q = 0; q < 4; ++q) if (16 * q < i) {
            s0 = fmaf(cur[q].x, x[4 * q], s0); if (16 * q + 4 < i) s1 = fmaf(cur[q].y, x[4 * q + 1], s1);
            if (16 * q + 8 < i) s0 = fmaf(cur[q].z, x[4 * q + 2], s0); if (16 * q + 12 < i) s1 = fmaf(cur[q].w, x[4 * q + 3], s1);
        }
        float t = s0 + s1;
        t += dpp_xor1(t); t += dpp_xor2(t);
        const float xi = fmaxf(1.f - fabsf(jf - (float)i), 0.f) - t;
        if (g == (i & 3)) x[i >> 2] = xi;
        unsigned hh, ll; hilo2(xi, xi, hh, ll);
        if (g == 0) Th[i * PB + j] = (unsigned short)(hh & 0xffffu);
        if (g == 1) Tl[i * PB + j] = (unsigned short)(ll & 0xffffu);
#pragma unroll
        for (int q = 0; q < 4; ++q) cur[q] = nxt[q];
    }
}
__device__ __forceinline__ void gdn_g1_unit(int h, int n, const GdnBufs& B, bf16_t* __restrict__ Y, LAS unsigned char* lds) {
    const int tid = opq_tid(), w = tid >> 6, lane = tid & 63, q4 = lane >> 4, cc = lane & 15;
    lds_bf16 *Krh = plane(lds, 0), *Krl = plane(lds, 1), *KdTh = plane(lds, 2), *KdTl = plane(lds, 3), *KbTh = plane(lds, 4), *KbTl = plane(lds, 5);
    lds_bf16 *VbTh = plane(lds, 6), *VbTl = plane(lds, 7), *Th = plane(lds, 8), *Tl = plane(lds, 9), *WmTh = plane(lds, 10), *WmTl = plane(lds, 11);
    lds_bf16 *U0Th = Krh, *U0Tl = Krl;
    LAS float* Lm = (LAS float*)(lds + LM_OFF); LAS float* sb = (LAS float*)(lds + VEC_OFF); LAS float* sg = sb + 64;
    const int t0 = n * 64, u = h * 256 + n;
    const int c = tid >> 3, d0 = (tid & 7) * 8;
    {
        const float beta = B.GB[(size_t)(t0 + c) * 4 + h], gc = B.GC[(size_t)(t0 + c) * 4 + h], gl = B.GC[(size_t)(t0 + 63) * 4 + h];
        float kf[8], vf[8], x1[8], x2[8], x3[8];
        unpack8(*(const uint4*)(B.GK + (size_t)(t0 + c) * 256 + h * 64 + d0), kf);
        unpack8(*(const uint4*)(B.GV + (size_t)(t0 + c) * 256 + h * 64 + d0), vf);
        const float e1 = __expf(gl - gc), e2 = beta * __expf(gc);
#pragma unroll
        for (int i = 0; i < 8; ++i) { x1[i] = kf[i] * e1; x2[i] = kf[i] * e2; x3[i] = beta * vf[i]; }
        put8<true>(Krh, Krl, c, d0, kf); put8T<true>(KdTh, KdTl, c, d0, x1); put8T<true>(KbTh, KbTl, c, d0, x2); put8T<true>(VbTh, VbTl, c, d0, x3);
        if ((tid & 7) == 0) { sb[c] = beta; sg[c] = gc; }
    }
    BAR();
    const int ti = w >> 1, tj0 = (w & 1) * 2;
    const f32x4_t zero4 = {0.f, 0.f, 0.f, 0.f};
#pragma unroll
    for (int tt = 0; tt < 2; ++tt) {
        const int tj = tj0 + tt;
        const int j = 16 * tj + cc, jp = (j & 3) * 16 + (j >> 2);
        f32x4_t lv = zero4;
        if (tj <= ti) {
            const f32x4_t a = mmp<true, true>(Krh, Krl, Krh, Krl, 16 * ti, 16 * tj, lane, zero4);
            const float gj = sg[j];
#pragma unroll
            for (int r = 0; r < 4; ++r) { const int i = 16 * ti + 4 * q4 + r; lv[r] = (i > j) ? sb[i] * a[r] * __expf(sg[i] - gj) : 0.f; }
        }
#pragma unroll
        for (int r = 0; r < 4; ++r) Lm[(16 * ti + 4 * q4 + r) * PT + jp] = lv[r];
    }
    BAR();
    if (w < 4) tri_inverse_4w(Lm, Th, Tl, w, lane);
    BAR();
    { const u32x4_t t4 = *(const LAS u32x4_t*)(Th + c * PB + d0); *(uint4*)(B.TG + (size_t)u * 4096 + c * 64 + d0) = make_uint4(t4.x, t4.y, t4.z, t4.w);
      const u32x4_t t5 = *(const LAS u32x4_t*)(Tl + c * PB + d0); *(uint4*)(Y + (size_t)(t0 + c) * D + h * 64 + d0) = make_uint4(t5.x, t5.y, t5.z, t5.w); }
#pragma unroll
    for (int tt = 0; tt < 2; ++tt) {
        const int tj = tj0 + tt;
        st_tile_T<true>(U0Th, U0Tl, 16 * ti, 16 * tj, lane, mmp<true, true>(Th, Tl, VbTh, VbTl, 16 * ti, 16 * tj, lane, zero4));
        st_tile_T<true>(WmTh, WmTl, 16 * ti, 16 * tj, lane, mmp<true, true>(Th, Tl, KbTh, KbTl, 16 * ti, 16 * tj, lane, zero4));
    }
    BAR();
    {
        const float egl = __expf(B.GC[(size_t)(t0 + 63) * 4 + h]);
#pragma unroll
        for (int tt = 0; tt < 2; ++tt) {
            const int tj = tj0 + tt;
            const f32x4_t a = mmp<true, true>(KdTh, KdTl, WmTh, WmTl, 16 * ti, 16 * tj, lane, zero4);
#pragma unroll
            for (int r = 0; r < 4; ++r) { const int ar = 16 * ti + 4 * q4 + r, bc = 16 * tj + cc; Lm[ar * PT + bc] = (ar == bc ? egl : 0.f) - a[r]; }
            const f32x4_t nn = mmp<true, true>(KdTh, KdTl, U0Th, U0Tl, 16 * ti, 16 * tj, lane, zero4);
            *(float4*)(B.NF + (size_t)u * 4096 + (tj * 64 + lane) * 16 + ti * 4) = make_float4(nn[0], nn[1], nn[2], nn[3]);
        }
    }
    BAR();
    {
        const int combo = tid >> 6, mt = combo >> 1, s = combo & 1, i = lane & 15, qq = lane >> 4;
        const f32x4_t x0 = *(const LAS f32x4_t*)(Lm + (16 * mt + i) * PT + 32 * s + 4 * qq);
        const f32x4_t x1 = *(const LAS f32x4_t*)(Lm + (16 * mt + i) * PT + 32 * s + 16 + 4 * qq);
        const float xv[8] = {x0.x, x0.y, x0.z, x0.w, x1.x, x1.y, x1.z, x1.w};
        U8 H, L; split8(xv, H.v, L.v);
        uint4* mf = B.MF + (size_t)u * 1024 + (size_t)(combo * 2) * 64 + lane;
        mf[0] = H.q; mf[64] = L.q;
    }
    BAR();
}

constexpr int CH_SLOT = 20480, CH_RING = 6;
__device__ __forceinline__ void chain_wave(float* __restrict__ HT, int cb, int nchunk, int lane, LAS unsigned char* ring, volatile LAS unsigned* flags  ) {
    const int q4 = lane >> 4, cc = lane & 15;
    f32x4_t H[4];
#pragma unroll
    for (int m = 0; m < 4; ++m) H[m] = (f32x4_t){0.f, 0.f, 0.f, 0.f};
    U8 mf[16]; f32x4_t nf[4];
    {
        while (flags[0] != 1u) __builtin_amdgcn_s_sleep(1);
        asm volatile("" ::: "memory");
        const LAS unsigned char* sp = ring + lane * 16;
#pragma unroll
        for (int i = 0; i < 16; ++i) mf[i].x = *(const LAS u32x4_t*)(sp + i * 1024);
#pragma unroll
        for (int m = 0; m < 4; ++m) nf[m] = *(const LAS f32x4_t*)(sp + (16 + m) * 1024);
        asm volatile("s_waitcnt lgkmcnt(0)" ::: "memory");
        if (lane == 0) flags[8] = 1u;
    }
    for (int ch = 0; ch < nchunk; ++ch) {
        float* ht = HT + (size_t)ch * 4096 + (16 * cb + cc) * 64 + 4 * q4;
#pragma unroll
        for (int m = 0; m < 4; ++m) *(float4*)(ht + 16 * m) = make_float4(H[m][0], H[m][1], H[m][2], H[m][3]);
        bf16x8_t bh[2], bl[2];
#pragma unroll
        for (int s = 0; s < 2; ++s) {
            const float xv[8] = {H[2 * s][0], H[2 * s][1], H[2 * s][2], H[2 * s][3], H[2 * s + 1][0], H[2 * s + 1][1], H[2 * s + 1][2], H[2 * s + 1][3]};
            split8(xv, bh[s], bl[s]);
        }
#pragma unroll
        for (int m = 0; m < 4; ++m) {
            f32x4_t acc = nf[m];
#pragma unroll
            for (int s = 0; s < 2; ++s) {
                acc = __builtin_amdgcn_mfma_f32_16x16x32_bf16(mf[(m * 2 + s) * 2].v, bh[s], acc, 0, 0, 0);
                acc = __builtin_amdgcn_mfma_f32_16x16x32_bf16(mf[(m * 2 + s) * 2].v, bl[s], acc, 0, 0, 0);
                acc = __builtin_amdgcn_mfma_f32_16x16x32_bf16(mf[(m * 2 + s) * 2 + 1].v, bh[s], acc, 0, 0, 0);
            }
            H[m] = acc;
        }
        if (ch + 1 < nchunk) {
            const int slot = (ch + 1) % CH_RING;
            while (flags[slot] != (unsigned)(ch + 2)) __builtin_amdgcn_s_sleep(1);
            asm volatile("" ::: "memory");
            const LAS unsigned char* sp = ring + slot * CH_SLOT + lane * 16;
#pragma unroll
            for (int i = 0; i < 16; ++i) mf[i].x = *(const LAS u32x4_t*)(sp + i * 1024);
#pragma unroll
            for (int m = 0; m < 4; ++m) nf[m] = *(const LAS f32x4_t*)(sp + (16 + m) * 1024);
            asm volatile("s_waitcnt lgkmcnt(0)" ::: "memory");
            if (lane == 0) flags[8] = (unsigned)(ch + 2);
        }
    }
}
__device__ __forceinline__ void chain_loader(const uint4* __restrict__ MF, const float* __restrict__ NF, int cb, int nchunk, int lane, int lw, LAS unsigned char* ring, volatile LAS unsigned* flags) {
    for (int ch = lw; ch < nchunk; ch += 7) {
        uint4 m[16]; float4 nn[4];
#pragma unroll
        for (int i = 0; i < 16; ++i) m[i] = MF[(size_t)ch * 1024 + (size_t)i * 64 + lane];
#pragma unroll
        for (int k = 0; k < 4; ++k) nn[k] = *(const float4*)(NF + (size_t)ch * 4096 + (cb * 64 + lane) * 16 + k * 4);
        while ((int)flags[8] + CH_RING <= ch) __builtin_amdgcn_s_sleep(2);
        asm volatile("" ::: "memory");
        LAS unsigned char* sp = ring + (ch % CH_RING) * CH_SLOT + lane * 16;
#pragma unroll
        for (int i = 0; i < 16; ++i) *(LAS u32x4_t*)(sp + i * 1024) = (u32x4_t){m[i].x, m[i].y, m[i].z, m[i].w};
#pragma unroll
        for (int k = 0; k < 4; ++k) *(LAS f32x4_t*)(sp + (16 + k) * 1024) = (f32x4_t){nn[k].x, nn[k].y, nn[k].z, nn[k].w};
        asm volatile("s_waitcnt lgkmcnt(0)" ::: "memory");
        if (lane == 0) flags[ch % CH_RING] = (unsigned)(ch + 1);
    }
}

__device__ __forceinline__ void gdn_g3_unit(int h, int n, const GdnBufs& B, const bf16_t* __restrict__ PM, bf16_t* __restrict__ Y, const float* __restrict__ norm_g, LAS unsigned char* lds) {
    const int tid = opq_tid(), w = tid >> 6, lane = tid & 63, q4 = lane >> 4, cc = lane & 15;
    lds_bf16 *Qr = plane(lds, 0), *Qd = plane(lds, 1), *Kr = plane(lds, 2), *KbT = plane(lds, 3), *VbT = plane(lds, 4), *Tp = plane(lds, 5);
    lds_bf16 *At = plane(lds, 6), *Wm = plane(lds, 7), *HTh = plane(lds, 8), *HTl = plane(lds, 9), *VnT = plane(lds, 10), *Tq = plane(lds, 11);
    LAS float* Os = (LAS float*)(lds + LM_OFF); LAS float* sb = (LAS float*)(lds + VEC_OFF); LAS float* sg = sb + 64;
    const int t0 = n * 64, u = h * 256 + n;
    const int c = tid >> 3, d0 = (tid & 7) * 8;
    {
        const float beta = B.GB[(size_t)(t0 + c) * 4 + h], gc = B.GC[(size_t)(t0 + c) * 4 + h];
        float qf[8], kf[8], vf[8], x1[8], x2[8], x3[8];
        unpack8(*(const uint4*)(B.GQ + (size_t)(t0 + c) * 256 + h * 64 + d0), qf);
        unpack8(*(const uint4*)(B.GK + (size_t)(t0 + c) * 256 + h * 64 + d0), kf);
        unpack8(*(const uint4*)(B.GV + (size_t)(t0 + c) * 256 + h * 64 + d0), vf);
        const uint4 t8 = *(const uint4*)(B.TG + (size_t)u * 4096 + c * 64 + d0);
        const uint4 t9 = *(const uint4*)(Y + (size_t)(t0 + c) * D + h * 64 + d0);
        const float* ht = B.HT + (size_t)u * 4096 + c * 64 + d0;
        const float4 h0 = *(const float4*)ht, h1 = *(const float4*)(ht + 4);
        const float eg = __expf(gc), e2 = beta * eg;
#pragma unroll
        for (int i = 0; i < 8; ++i) { x1[i] = qf[i] * eg; x2[i] = kf[i] * e2; x3[i] = beta * vf[i]; }
        put8<false>(Qr, Qr, c, d0, qf); put8<false>(Qd, Qd, c, d0, x1); put8<false>(Kr, Kr, c, d0, kf);
        put8T<false>(KbT, KbT, c, d0, x2); put8T<false>(VbT, VbT, c, d0, x3);
        *(LAS u32x4_t*)(Tp + c * PB + d0) = (u32x4_t){t8.x, t8.y, t8.z, t8.w};
        *(LAS u32x4_t*)(Tq + c * PB + d0) = (u32x4_t){t9.x, t9.y, t9.z, t9.w};
        const float hv[8] = {h0.x, h0.y, h0.z, h0.w, h1.x, h1.y, h1.z, h1.w};
        put8<true>(HTh, HTl, c, d0, hv);
        if ((tid & 7) == 0) { sb[c] = beta; sg[c] = gc; }
    }
    BAR();
    const int ti = w >> 1, tj0 = (w & 1) * 2;
    const f32x4_t zero4 = {0.f, 0.f, 0.f, 0.f};
    f32x4_t u0[2];
#pragma unroll
    for (int tt = 0; tt < 2; ++tt) {
        const int tj = tj0 + tt;
        f32x4_t at = zero4;
        if (tj <= ti) {
            const f32x4_t s = mmp<false, false>(Qr, Qr, Kr, Kr, 16 * ti, 16 * tj, lane, zero4);
            const int j = 16 * tj + cc; const float gj = sg[j];
#pragma unroll
            for (int r = 0; r < 4; ++r) { const int i = 16 * ti + 4 * q4 + r; at[r] = (i >= j) ? s[r] * __expf(fminf(sg[i] - gj, 0.f)) : 0.f; }
        }
        st_tile_R<false>(At, At, 16 * ti, 16 * tj, lane, at);
        u0[tt] = mmp<true, false>(Tp, Tq, VbT, VbT, 16 * ti, 16 * tj, lane, zero4);
        st_tile_R<false>(Wm, Wm, 16 * ti, 16 * tj, lane, mmp<true, false>(Tp, Tq, KbT, KbT, 16 * ti, 16 * tj, lane, zero4));
    }
    BAR();
    f32x4_t o[2];
#pragma unroll
    for (int tt = 0; tt < 2; ++tt) {
        const int tj = tj0 + tt;
        const f32x4_t wh = mmp<false, true>(Wm, Wm, HTh, HTl, 16 * ti, 16 * tj, lane, zero4);
        o[tt] = mmp<false, true>(Qd, Qd, HTh, HTl, 16 * ti, 16 * tj, lane, zero4);
        st_tile_T<false>(VnT, VnT, 16 * ti, 16 * tj, lane, u0[tt] - wh);
    }
    BAR();
#pragma unroll
    for (int tt = 0; tt < 2; ++tt) {
        const int tj = tj0 + tt;
        o[tt] = mmp<false, false>(At, At, VnT, VnT, 16 * ti, 16 * tj, lane, o[tt]);
#pragma unroll
        for (int r = 0; r < 4; ++r) Os[(16 * ti + 4 * q4 + r) * PT + 16 * tj + cc] = o[tt][r];
    }
    BAR();
    {
        const f32x4_t x0 = *(const LAS f32x4_t*)(Os + c * PT + d0), x1 = *(const LAS f32x4_t*)(Os + c * PT + d0 + 4);
        float xv[8] = {x0.x, x0.y, x0.z, x0.w, x1.x, x1.y, x1.z, x1.w};
        float ss = 0.f;
#pragma unroll
        for (int i = 0; i < 8; ++i) ss = fmaf(xv[i], xv[i], ss);
        ss += __shfl_xor(ss, 1); ss += __shfl_xor(ss, 2); ss += __shfl_xor(ss, 4);
        const float rs = rsqrtf(ss * (1.f / 64.f) + 1e-6f);
        float zf[8]; unpack8(*(const uint4*)(PM + (size_t)(t0 + c) * PMLD + 768 + h * 64 + d0), zf);
        float y[8];
#pragma unroll
        for (int i = 0; i < 8; ++i) y[i] = xv[i] * rs * norm_g[d0 + i] * siluf_(zf[i]);
        *(uint4*)(Y + (size_t)(t0 + c) * D + h * 64 + d0) = pack8(y);
    }
    BAR();
}

struct RwkvBufs { bf16_t *RR, *RK, *RV, *RKK, *RA, *RG; float* CW; uint4* MF; float* NF; float* HT; bf16_t* TG; };
__device__ __forceinline__ void rwkv_prep_chunk(const bf16_t* __restrict__ PM, int n, const RwkvBufs& B, const Params& p, int l, const bf16_t* __restrict__ WUPT, const bf16_t* __restrict__ AUPT, const bf16_t* __restrict__ GUPT, LAS unsigned char* lds) {
    const int tid = opq_tid(), w = tid >> 6, lane = tid & 63, q4 = lane >> 4, cc = lane & 15;
    const int t0 = n * 64;
    const float* mu = p.in[24] + l * 1024;
    lds_bf16* Awd = (lds_bf16*)lds; lds_bf16* Aad = Awd + 64 * 72; lds_bf16* Agd = Aad + 64 * 72;
    lds_bf16* La = Agd + 64 * 136; lds_bf16* Lg = La + 64 * 264; lds_bf16* Llw = Lg + 64 * 264;
    for (int px1_ = 0; px1_ < ((PEXP == 1) ? 2 : 1); ++px1_)
    {
        const int t = tid >> 3, c0 = (tid & 7) * 8;
        const bf16_t* row = PM + (size_t)(t0 + t) * PMLD + C_RWKV + 768 + c0;
        const bool hasprev = (t0 + t) > 0;
#pragma unroll
        for (int g8 = 0; g8 < 4; ++g8) {
            float x[8], xp[8];
            unpack8(*(const uint4*)(row + 64 * g8), x);
            if (hasprev) unpack8(*(const uint4*)(row - PMLD + 64 * g8), xp); else {
#pragma unroll
                for (int i = 0; i < 8; ++i) xp[i] = 0.f; }
            const int col = c0 + 64 * g8;
            float y[8];
#pragma unroll
            for (int i = 0; i < 8; ++i) {
                const float v = x[i] + mu[768 + col + i] * (xp[i] - x[i]);
                y[i] = col < 64 ? tanhf_(v) : (col < 128 ? v : sigmoidf_(v));
            }
            const uint4 pk = pack8(y);
            if (col < 64) *(LAS u32x4_t*)(Awd + t * 72 + col) = (u32x4_t){pk.x, pk.y, pk.z, pk.w};
            else if (col < 128) *(LAS u32x4_t*)(Aad + t * 72 + (col - 64)) = (u32x4_t){pk.x, pk.y, pk.z, pk.w};
            else *(LAS u32x4_t*)(Agd + t * 136 + (col - 128)) = (u32x4_t){pk.x, pk.y, pk.z, pk.w};
        }
    }
    BAR();
    const int hh = w >> 1, tt0 = 2 * (w & 1);
    for (int px2_ = 0; px2_ < ((PEXP == 2) ? 2 : 1); ++px2_)
    {
        const float* w0 = p.in[25] + l * W; const float* a0 = p.in[27] + l * W;
#pragma unroll 2
        for (int b = 0; b < 4; ++b) {
            const int ncol = 64 * hh + 16 * b + cc;
            f32x4_t accw[2], acca[2], accg[2];
#pragma unroll
            for (int a = 0; a < 2; ++a) { accw[a] = (f32x4_t){0.f, 0.f, 0.f, 0.f}; acca[a] = accw[a]; accg[a] = accw[a]; }
#pragma unroll
            for (int ks = 0; ks < 4; ++ks) {
                U8 bw, ba, bg;
                bg.q = *(const uint4*)(GUPT + (size_t)ncol * 128 + 32 * ks + 8 * q4);
                if (ks < 2) { bw.q = *(const uint4*)(WUPT + (size_t)ncol * 64 + 32 * ks + 8 * q4); ba.q = *(const uint4*)(AUPT + (size_t)ncol * 64 + 32 * ks + 8 * q4); }
#pragma unroll
                for (int a = 0; a < 2; ++a) {
                    const int row = 16 * (tt0 + a) + cc;
                    U8 ag; ag.x = *(const LAS u32x4_t*)(Agd + row * 136 + 32 * ks + 8 * q4);
                    accg[a] = __builtin_amdgcn_mfma_f32_16x16x32_bf16(ag.v, bg.v, accg[a], 0, 0, 0);
                    if (ks < 2) {
                        U8 aw, aa; aw.x = *(const LAS u32x4_t*)(Awd + row * 72 + 32 * ks + 8 * q4); aa.x = *(const LAS u32x4_t*)(Aad + row * 72 + 32 * ks + 8 * q4);
                        accw[a] = __builtin_amdgcn_mfma_f32_16x16x32_bf16(aw.v, bw.v, accw[a], 0, 0, 0);
                        acca[a] = __builtin_amdgcn_mfma_f32_16x16x32_bf16(aa.v, ba.v, acca[a], 0, 0, 0);
                    }
                }
            }
            const float w0n = w0[ncol], a0n = a0[ncol];
#pragma unroll
            for (int a = 0; a < 2; ++a)
#pragma unroll
                for (int r = 0; r < 4; ++r) {
                    const int t = 16 * (tt0 + a) + 4 * q4 + r;
                    const float logw = -softplusf_(-(w0n + accw[a][r])) - 0.5f;
                    Llw[t * 264 + ncol] = (unsigned short)f2bf(-__expf(logw));
                    La[t * 264 + ncol] = (unsigned short)f2bf(sigmoidf_(a0n + acca[a][r]));
                    Lg[t * 264 + ncol] = (unsigned short)f2bf(accg[a][r]);
                }
        }
    }
    BAR();
    {
        const int t = tid >> 3, j8 = (tid & 7) * 8;
        const bf16_t* row = PM + (size_t)(t0 + t) * PMLD + C_RWKV;
        const bool hasprev = (t0 + t) > 0;
        const float* k_k = p.in[30] + l * W; const float* k_a = p.in[31] + l * W;
#pragma unroll 2
        for (int hd = 0; hd < 4; ++hd) {
            const int nn = 64 * hd + j8;
            float xr[8], xk[8], xv[8], pr[8], pk[8], pv[8], av[8];
            unpack8(*(const uint4*)(row + nn), xr); unpack8(*(const uint4*)(row + 256 + nn), xk); unpack8(*(const uint4*)(row + 512 + nn), xv);
            if (hasprev) { unpack8(*(const uint4*)(row - PMLD + nn), pr); unpack8(*(const uint4*)(row - PMLD + 256 + nn), pk); unpack8(*(const uint4*)(row - PMLD + 512 + nn), pv); }
            else {
#pragma unroll
                for (int i = 0; i < 8; ++i) { pr[i] = 0.f; pk[i] = 0.f; pv[i] = 0.f; } }
            { const u32x4_t t4 = *(const LAS u32x4_t*)(La + t * 264 + nn); unpack8(make_uint4(t4.x, t4.y, t4.z, t4.w), av); }
            float orr[8], okk[8], ovv[8], kraw[8];
            float ss = 0.f;
#pragma unroll
            for (int i = 0; i < 8; ++i) {
                const float r = xr[i] + mu[nn + i] * (pr[i] - xr[i]);
                const float k = xk[i] + mu[256 + nn + i] * (pk[i] - xk[i]);
                const float v = xv[i] + mu[512 + nn + i] * (pv[i] - xv[i]);
                orr[i] = r; ovv[i] = v; okk[i] = k * (1.f + (av[i] - 1.f) * k_a[nn + i]);
                kraw[i] = k * k_k[nn + i]; ss = fmaf(kraw[i], kraw[i], ss);
            }
            ss += __shfl_xor(ss, 1); ss += __shfl_xor(ss, 2); ss += __shfl_xor(ss, 4);
            const float rn = rsqrtf(ss + 1e-6f);
#pragma unroll
            for (int i = 0; i < 8; ++i) kraw[i] *= rn;
            const size_t o = (size_t)(t0 + t) * 256 + nn;
            *(uint4*)(B.RR + o) = pack8(orr); *(uint4*)(B.RK + o) = pack8(okk); *(uint4*)(B.RV + o) = pack8(ovv); *(uint4*)(B.RKK + o) = pack8(kraw);
            { const u32x4_t t4 = *(const LAS u32x4_t*)(La + t * 264 + nn); *(uint4*)(B.RA + o) = make_uint4(t4.x, t4.y, t4.z, t4.w); }
            { const u32x4_t t4 = *(const LAS u32x4_t*)(Lg + t * 264 + nn); *(uint4*)(B.RG + o) = make_uint4(t4.x, t4.y, t4.z, t4.w); }
        }
    }
    for (int px4_ = 0; px4_ < ((PEXP == 4) ? 2 : 1); ++px4_)
    if (tid < 256) {
        float c = 0.f;
#pragma unroll 16
        for (int t = 0; t < 64; ++t) { c += bf2f(Llw[t * 264 + tid]); B.CW[(size_t)(t0 + t) * 256 + tid] = c; }
    }
    BAR();
}

struct RwPiece { float kk[8], al[8], kt[8], v[8], cw[8], cwp[8], cwc[8]; };
__device__ __forceinline__ void rwkv_load_piece(const RwkvBufs& B, int h, int t0, int c, int d0, RwPiece& P) {
    const size_t o = (size_t)(t0 + c) * 256 + h * 64 + d0;
    float a[8];
    unpack8(*(const uint4*)(B.RKK + o), P.kk); unpack8(*(const uint4*)(B.RA + o), a); unpack8(*(const uint4*)(B.RK + o), P.kt); unpack8(*(const uint4*)(B.RV + o), P.v);
    const float4 c0 = *(const float4*)(B.CW + o), c1 = *(const float4*)(B.CW + o + 4);
    P.cw[0] = c0.x; P.cw[1] = c0.y; P.cw[2] = c0.z; P.cw[3] = c0.w; P.cw[4] = c1.x; P.cw[5] = c1.y; P.cw[6] = c1.z; P.cw[7] = c1.w;
    if (c > 0) { const float4 p0 = *(const float4*)(B.CW + o - 256), p1 = *(const float4*)(B.CW + o - 256 + 4);
        P.cwp[0] = p0.x; P.cwp[1] = p0.y; P.cwp[2] = p0.z; P.cwp[3] = p0.w; P.cwp[4] = p1.x; P.cwp[5] = p1.y; P.cwp[6] = p1.z; P.cwp[7] = p1.w; }
    else {
#pragma unroll
        for (int i = 0; i < 8; ++i) P.cwp[i] = 0.f; }
    const size_t oc = (size_t)(t0 + 63) * 256 + h * 64 + d0;
    const float4 e0 = *(const float4*)(B.CW + oc), e1 = *(const float4*)(B.CW + oc + 4);
    P.cwc[0] = e0.x; P.cwc[1] = e0.y; P.cwc[2] = e0.z; P.cwc[3] = e0.w; P.cwc[4] = e1.x; P.cwc[5] = e1.y; P.cwc[6] = e1.z; P.cwc[7] = e1.w;
#pragma unroll
    for (int i = 0; i < 8; ++i) P.al[i] = a[i] * P.kk[i];
}

__device__ __forceinline__ void rwkv_g1_unit(int h, int n, const RwkvBufs& B, bf16_t* __restrict__ Y, LAS unsigned char* lds) {
    const int tid = opq_tid(), w = tid >> 6, lane = tid & 63, q4 = lane >> 4, cc = lane & 15;
    lds_bf16 *P0h = plane(lds, 0), *P0l = plane(lds, 1), *P1h = plane(lds, 2), *P1l = plane(lds, 3), *P2h = plane(lds, 4), *P2l = plane(lds, 5);
    lds_bf16 *Lkh = plane(lds, 6), *Lkl = plane(lds, 7), *P3h = plane(lds, 8), *P3l = plane(lds, 9), *Th = plane(lds, 10), *Tl = plane(lds, 11);
    LAS float* Lm = (LAS float*)(lds + LM_OFF);
    const int t0 = n * 64, u = (4 + h) * 256 + n;
    const int c = tid >> 3, d0 = (tid & 7) * 8;
    RwPiece P; rwkv_load_piece(B, h, t0, c, d0, P);
    {
        float x0[8], x1[8], x2[8];
#pragma unroll
        for (int i = 0; i < 8; ++i) { const float em = __expf(-P.cw[i]); x0[i] = P.kk[i] * __expf(P.cwp[i]); x1[i] = P.al[i] * em; x2[i] = P.kt[i] * em; }
        put8<true>(P0h, P0l, c, d0, x0); put8<true>(P1h, P1l, c, d0, x1); put8<true>(P2h, P2l, c, d0, x2);
    }
    BAR();
    const int ti = w >> 1, tj0 = (w & 1) * 2;
    const f32x4_t zero4 = {0.f, 0.f, 0.f, 0.f};
#pragma unroll
    for (int tt = 0; tt < 2; ++tt) {
        const int tj = tj0 + tt;
        f32x4_t lk = zero4, la = zero4;
        const int j = 16 * tj + cc, jp = (j & 3) * 16 + (j >> 2);
        if (tj <= ti) {
            const f32x4_t a = mmp<true, true>(P0h, P0l, P1h, P1l, 16 * ti, 16 * tj, lane, zero4);
            const f32x4_t b = mmp<true, true>(P0h, P0l, P2h, P2l, 16 * ti, 16 * tj, lane, zero4);
#pragma unroll
            for (int r = 0; r < 4; ++r) { const int i = 16 * ti + 4 * q4 + r; la[r] = (i > j) ? a[r] : 0.f; lk[r] = (i > j) ? b[r] : 0.f; }
        }
#pragma unroll
        for (int r = 0; r < 4; ++r) Lm[(16 * ti + 4 * q4 + r) * PT + jp] = la[r];
        st_tile_R<true>(Lkh, Lkl, 16 * ti, 16 * tj, lane, lk);
    }
    BAR();
    {
        float x0[8], x1[8], x2[8];
#pragma unroll
        for (int i = 0; i < 8; ++i) { const float eb = __expf(P.cwc[i] - P.cw[i]); x0[i] = P.kk[i] * __expf(P.cwp[i]); x1[i] = P.al[i] * eb; x2[i] = P.kt[i] * eb; }
        put8T<true>(P0h, P0l, c, d0, P.v); put8T<true>(P1h, P1l, c, d0, x0); put8T<true>(P2h, P2l, c, d0, x1); put8T<true>(P3h, P3l, c, d0, x2);
    }
    if (w < 4) tri_inverse_4w(Lm, Th, Tl, w, lane);
    BAR();
    { const u32x4_t t4 = *(const LAS u32x4_t*)(Th + c * PB + d0); *(uint4*)(B.TG + (size_t)u * 4096 + c * 64 + d0) = make_uint4(t4.x, t4.y, t4.z, t4.w);
      const u32x4_t t5 = *(const LAS u32x4_t*)(Tl + c * PB + d0); *(uint4*)(Y + (size_t)(t0 + c) * D + 768 + h * 64 + d0) = make_uint4(t5.x, t5.y, t5.z, t5.w); }
    f32x4_t pa[2];
#pragma unroll
    for (int tt = 0; tt < 2; ++tt) pa[tt] = mmp<true, true>(Lkh, Lkl, P0h, P0l, 16 * ti, 16 * (tj0 + tt), lane, zero4);
    BAR();
#pragma unroll
    for (int tt = 0; tt < 2; ++tt) st_tile_T<true>(Lkh, Lkl, 16 * ti, 16 * (tj0 + tt), lane, pa[tt]);
    BAR();
    f32x4_t ua[2], wa[2];
#pragma unroll
    for (int tt = 0; tt < 2; ++tt) {
        ua[tt] = mmp<true, true>(Th, Tl, Lkh, Lkl, 16 * ti, 16 * (tj0 + tt), lane, zero4);
        wa[tt] = mmp<true, true>(Th, Tl, P1h, P1l, 16 * ti, 16 * (tj0 + tt), lane, zero4);
    }
    BAR();
#pragma unroll
    for (int tt = 0; tt < 2; ++tt) {
        st_tile_T<true>(Lkh, Lkl, 16 * ti, 16 * (tj0 + tt), lane, -ua[tt]);
        st_tile_T<true>(P1h, P1l, 16 * ti, 16 * (tj0 + tt), lane, wa[tt]);
    }
    BAR();
    {
#pragma unroll
        for (int tt = 0; tt < 2; ++tt) {
            const int tj = tj0 + tt;
            const f32x4_t a = mmp<true, true>(P2h, P2l, P1h, P1l, 16 * ti, 16 * tj, lane, zero4);
            const float gam = __expf(B.CW[(size_t)(t0 + 63) * 256 + h * 64 + 16 * tj + cc]);
#pragma unroll
            for (int r = 0; r < 4; ++r) { const int ar = 16 * ti + 4 * q4 + r, bc = 16 * tj + cc; Lm[ar * PT + bc] = (ar == bc ? gam : 0.f) - a[r]; }
            f32x4_t nn = mmp<true, true>(P2h, P2l, Lkh, Lkl, 16 * ti, 16 * tj, lane, zero4);
            nn = mmp<true, true>(P3h, P3l, P0h, P0l, 16 * ti, 16 * tj, lane, nn);
            *(float4*)(B.NF + (size_t)u * 4096 + (tj * 64 + lane) * 16 + ti * 4) = make_float4(nn[0], nn[1], nn[2], nn[3]);
        }
    }
    BAR();
    {
        const int combo = tid >> 6, mt = combo >> 1, s = combo & 1, i = lane & 15, qq = lane >> 4;
        const f32x4_t x0 = *(const LAS f32x4_t*)(Lm + (16 * mt + i) * PT + 32 * s + 4 * qq);
        const f32x4_t x1 = *(const LAS f32x4_t*)(Lm + (16 * mt + i) * PT + 32 * s + 16 + 4 * qq);
        const float xv[8] = {x0.x, x0.y, x0.z, x0.w, x1.x, x1.y, x1.z, x1.w};
        U8 H, L; split8(xv, H.v, L.v);
        uint4* mf = B.MF + (size_t)u * 1024 + (size_t)(combo * 2) * 64 + lane;
        mf[0] = H.q; mf[64] = L.q;
    }
    BAR();
}

__device__ __forceinline__ void rwkv_g3_unit(int h, int n, const RwkvBufs& B, bf16_t* __restrict__ Y, const Params& p, int l, LAS unsigned char* lds) {
    const int tid = opq_tid(), w = tid >> 6, lane = tid & 63, q4 = lane >> 4, cc = lane & 15;
    lds_bf16 *KH = plane(lds, 0), *AC = plane(lds, 1), *KC = plane(lds, 2), *RH = plane(lds, 3), *VT = plane(lds, 4), *KHT = plane(lds, 5), *Tp = plane(lds, 6);
    lds_bf16 *HTh = plane(lds, 7), *HTl = plane(lds, 8), *Lk = plane(lds, 9), *Ara = plane(lds, 10), *Ark = plane(lds, 11), *Tq = plane(lds, 12);
    lds_bf16 *PTp = KH, *Wm = AC, *UT = KC;
    LAS float* Os = (LAS float*)(lds + LM_OFF);
    const int t0 = n * 64, u = (4 + h) * 256 + n;
    const int c = tid >> 3, d0 = (tid & 7) * 8;
    {
        RwPiece P; rwkv_load_piece(B, h, t0, c, d0, P);
        float rr[8]; unpack8(*(const uint4*)(B.RR + (size_t)(t0 + c) * 256 + h * 64 + d0), rr);
        const uint4 t8 = *(const uint4*)(B.TG + (size_t)u * 4096 + c * 64 + d0);
        const uint4 t9 = *(const uint4*)(Y + (size_t)(t0 + c) * D + 768 + h * 64 + d0);
        const float* ht = B.HT + (size_t)u * 4096 + c * 64 + d0;
        const float4 h0 = *(const float4*)ht, h1 = *(const float4*)(ht + 4);
        float x0[8], x1[8], x2[8], x3[8];
#pragma unroll
        for (int i = 0; i < 8; ++i) { const float em = __expf(-P.cw[i]); x0[i] = P.kk[i] * __expf(P.cwp[i]); x1[i] = P.al[i] * em; x2[i] = P.kt[i] * em; x3[i] = rr[i] * __expf(P.cw[i]); }
        put8<false>(KH, KH, c, d0, x0); put8<false>(AC, AC, c, d0, x1); put8<false>(KC, KC, c, d0, x2); put8<false>(RH, RH, c, d0, x3);
        put8T<false>(VT, VT, c, d0, P.v); put8T<false>(KHT, KHT, c, d0, x0);
        *(LAS u32x4_t*)(Tp + c * PB + d0) = (u32x4_t){t8.x, t8.y, t8.z, t8.w};
        *(LAS u32x4_t*)(Tq + c * PB + d0) = (u32x4_t){t9.x, t9.y, t9.z, t9.w};
        const float hv[8] = {h0.x, h0.y, h0.z, h0.w, h1.x, h1.y, h1.z, h1.w};
        put8<true>(HTh, HTl, c, d0, hv);
    }
    BAR();
    const int ti = w >> 1, tj0 = (w & 1) * 2;
    const f32x4_t zero4 = {0.f, 0.f, 0.f, 0.f};
#pragma unroll
    for (int tt = 0; tt < 2; ++tt) {
        const int tj = tj0 + tt; const int j = 16 * tj + cc;
        f32x4_t lk = zero4, ara = zero4, ark = zero4;
        if (tj <= ti) {
            const f32x4_t b = mmp<false, false>(KH, KH, KC, KC, 16 * ti, 16 * tj, lane, zero4);
            const f32x4_t e = mmp<false, false>(RH, RH, AC, AC, 16 * ti, 16 * tj, lane, zero4);
            const f32x4_t f = mmp<false, false>(RH, RH, KC, KC, 16 * ti, 16 * tj, lane, zero4);
#pragma unroll
            for (int r = 0; r < 4; ++r) { const int i = 16 * ti + 4 * q4 + r; lk[r] = (i > j) ? b[r] : 0.f; ara[r] = (i >= j) ? e[r] : 0.f; ark[r] = (i >= j) ? f[r] : 0.f; }
        }
        st_tile_R<false>(Lk, Lk, 16 * ti, 16 * tj, lane, lk); st_tile_R<false>(Ara, Ara, 16 * ti, 16 * tj, lane, ara); st_tile_R<false>(Ark, Ark, 16 * ti, 16 * tj, lane, ark);
    }
    BAR();
#pragma unroll
    for (int tt = 0; tt < 2; ++tt) {
        const int tj = tj0 + tt;
        st_tile_T<false>(PTp, PTp, 16 * ti, 16 * tj, lane, mmp<false, false>(Lk, Lk, VT, VT, 16 * ti, 16 * tj, lane, zero4));
        st_tile_R<false>(Wm, Wm, 16 * ti, 16 * tj, lane, mmp<true, false>(Tp, Tq, KHT, KHT, 16 * ti, 16 * tj, lane, zero4));
    }
    BAR();
    f32x4_t o[2];
#pragma unroll
    for (int tt = 0; tt < 2; ++tt) {
        const int tj = tj0 + tt;
        const f32x4_t ua = mmp<true, false>(Tp, Tq, PTp, PTp, 16 * ti, 16 * tj, lane, zero4);
        const f32x4_t wh = mmp<false, true>(Wm, Wm, HTh, HTl, 16 * ti, 16 * tj, lane, zero4);
        st_tile_T<false>(UT, UT, 16 * ti, 16 * tj, lane, -ua - wh);
        o[tt] = mmp<false, true>(RH, RH, HTh, HTl, 16 * ti, 16 * tj, lane, zero4);
        o[tt] = mmp<false, false>(Ark, Ark, VT, VT, 16 * ti, 16 * tj, lane, o[tt]);
    }
    BAR();
#pragma unroll
    for (int tt = 0; tt < 2; ++tt) {
        const int tj = tj0 + tt;
        o[tt] = mmp<false, false>(Ara, Ara, UT, UT, 16 * ti, 16 * tj, lane, o[tt]);
#pragma unroll
        for (int r = 0; r < 4; ++r) Os[(16 * ti + 4 * q4 + r) * PT + 16 * tj + cc] = o[tt][r];
    }
    BAR();
    {
        const f32x4_t x0 = *(const LAS f32x4_t*)(Os + c * PT + d0), x1 = *(const LAS f32x4_t*)(Os + c * PT + d0 + 4);
        const float xv[8] = {x0.x, x0.y, x0.z, x0.w, x1.x, x1.y, x1.z, x1.w};
        float s1 = 0.f;
#pragma unroll
        for (int i = 0; i < 8; ++i) s1 += xv[i];
        s1 += __shfl_xor(s1, 1); s1 += __shfl_xor(s1, 2); s1 += __shfl_xor(s1, 4);
        const float mean = s1 * (1.f / 64.f);
        float s2 = 0.f;
#pragma unroll
        for (int i = 0; i < 8; ++i) { const float dd = xv[i] - mean; s2 = fmaf(dd, dd, s2); }
        s2 += __shfl_xor(s2, 1); s2 += __shfl_xor(s2, 2); s2 += __shfl_xor(s2, 4);
        const float rs = rsqrtf(s2 * (1.f / 64.f) + 64e-5f);
        const size_t o8 = (size_t)(t0 + c) * 256 + h * 64 + d0;
        float rr[8], gg[8], kt2[8], v2[8];
        unpack8(*(const uint4*)(B.RR + o8), rr); unpack8(*(const uint4*)(B.RG + o8), gg); unpack8(*(const uint4*)(B.RK + o8), kt2); unpack8(*(const uint4*)(B.RV + o8), v2);
        const float* r_k = p.in[32] + l * W + h * 64 + d0; const float* ln_g = p.in[33] + l * W + h * 64 + d0; const float* ln_b = p.in[34] + l * W + h * 64 + d0;
        float bs = 0.f;
#pragma unroll
        for (int i = 0; i < 8; ++i) bs = fmaf(rr[i] * kt2[i], r_k[i], bs);
        bs += __shfl_xor(bs, 1); bs += __shfl_xor(bs, 2); bs += __shfl_xor(bs, 4);
        float y[8];
#pragma unroll
        for (int i = 0; i < 8; ++i) y[i] = ((xv[i] - mean) * rs * ln_g[i] + ln_b[i] + bs * v2[i]) * gg[i];
        *(uint4*)(Y + (size_t)(t0 + c) * D + 768 + h * 64 + d0) = pack8(y);
    }
    BAR();
}

struct LruBufs { float2* AGG; float* CAR; };
template <int PASS>
__device__ __forceinline__ void lru_unit(const bf16_t* __restrict__ PM, int n, const LruBufs& B, bf16_t* __restrict__ Y, const Params& p, int l, const bf16_t* __restrict__ LWT  , LAS float* lds) {
    const int tid = opq_tid(), c = tid & 255, half = tid >> 8, w = tid >> 6, lane = tid & 63, q4 = lane >> 4, cc = lane & 15;
    const int t0 = n * 64, tb = t0 + 32 * half;
    LAS float* U = lds;
    lds_bf16* R = (lds_bf16*)(lds + 64 * 260);
    lds_bf16* I = R + 64 * 264;
    {
        const float* cw = p.in[7] + l * 4 * W; const float cb = p.in[8][l * W + c];
        const float w0 = cw[c], w1 = cw[W + c], w2 = cw[2 * W + c], w3 = cw[3 * W + c];
        const bf16_t* col = PM + C_LRU + c;
#pragma unroll 1
        for (int hf = 0; hf < 2; ++hf) {
            bf16_t xr[19];
#pragma unroll
            for (int i = 0; i < 19; ++i) xr[i] = (tb + 16 * hf + i - 3 >= 0) ? col[(size_t)(tb + 16 * hf + i - 3) * PMLD] : (bf16_t)0;
#pragma unroll
            for (int i = 0; i < 16; ++i)
                U[(32 * half + 16 * hf + i) * 260 + c] = cb + w0 * bf2f(xr[i]) + w1 * bf2f(xr[i + 1]) + w2 * bf2f(xr[i + 2]) + w3 * bf2f(xr[i + 3]);
        }
    }
    BAR();
    {
        const int nb = w >> 1, gt = w & 1;
        const bf16_t* wt = LWT + (size_t)gt * 16384 + (size_t)nb * 4096;
        const float* bias = (gt ? p.in[12] : p.in[10]) + l * W + nb * 64;
        const float* lam = p.in[13] + l * W + nb * 64;
#pragma unroll 1
        for (int te = 0; te < 4; ++te) {
            U8 bf[2];
#pragma unroll
            for (int ks = 0; ks < 2; ++ks) bf[ks].q = *(const uint4*)(wt + (size_t)(16 * te + cc) * 64 + 32 * ks + 8 * q4);
            const int ch = nb * 64 + 16 * te + cc;
            const float bv = bias[16 * te + cc];
            const float sp8 = 8.f * softplusf_(-lam[16 * te + cc]);
#pragma unroll
            for (int tt = 0; tt < 4; ++tt) {
                f32x4_t acc = {0.f, 0.f, 0.f, 0.f};
#pragma unroll
                for (int ks = 0; ks < 2; ++ks) {
                    const LAS float* ap = U + (16 * tt + cc) * 260 + nb * 64 + 32 * ks + 8 * q4;
                    const f32x4_t a0 = *(const LAS f32x4_t*)ap, a1 = *(const LAS f32x4_t*)(ap + 4);
                    const float av[8] = {a0.x, a0.y, a0.z, a0.w, a1.x, a1.y, a1.z, a1.w};
                    acc = __builtin_amdgcn_mfma_f32_16x16x32_bf16(hi8(av), bf[ks].v, acc, 0, 0, 0);
                }
#pragma unroll
                for (int r = 0; r < 4; ++r) {
                    const int t = 16 * tt + 4 * q4 + r;
                    const float sg = sigmoidf_(acc[r] + bv);
                    if (gt) I[t * 264 + ch] = (unsigned short)f2bf(sg); else R[t * 264 + ch] = (unsigned short)f2bf(-sp8 * sg);
                }
            }
        }
    }
    BAR();
    float h = 0.f, ap = 1.f;
    const int sc = 2 * n + half;
    bf16_t gc_[8], gn_[8];
    if (PASS == 3) {
        h = B.CAR[(size_t)c * 512 + sc];
#pragma unroll
        for (int i = 0; i < 8; ++i) gc_[i] = PM[(size_t)(tb + i) * PMLD + C_LRU + 256 + c];
    }
#pragma unroll 1
    for (int g8 = 0; g8 < 4; ++g8) {
        if (PASS == 3 && g8 < 3) {
#pragma unroll
            for (int i = 0; i < 8; ++i) gn_[i] = PM[(size_t)(tb + 8 * (g8 + 1) + i) * PMLD + C_LRU + 256 + c];
        }
#pragma unroll
        for (int i = 0; i < 8; ++i) {
            const int t = 32 * half + 8 * g8 + i;
            const float log_a = bf2f(R[t * 264 + c]), ig = bf2f(I[t * 264 + c]);
            const float a = __expf(log_a);
            const float inp = __builtin_amdgcn_sqrtf(fmaxf(1.f - a * a, 0.f)) * (ig * U[t * 260 + c]);
            h = fmaf(a, h, inp); ap *= a;
            if (PASS == 3) Y[(size_t)(t0 + t) * D + 256 + c] = (bf16_t)f2bf(h * geluf_(bf2f(gc_[i])));
        }
        if (PASS == 3) {
#pragma unroll
            for (int i = 0; i < 8; ++i) gc_[i] = gn_[i];
        }
    }
    if (PASS == 1) B.AGG[(size_t)c * 512 + sc] = make_float2(ap, h);
    BAR();
}
__device__ __forceinline__ void lru_carry_wave(const LruBufs& B, int c, int lane) {
    float2 ab[8];
    const float4* src = (const float4*)(B.AGG + (size_t)c * 512 + 8 * lane);
#pragma unroll
    for (int k = 0; k < 4; ++k) { const float4 v = src[k]; ab[2 * k] = make_float2(v.x, v.y); ab[2 * k + 1] = make_float2(v.z, v.w); }
    float A = 1.f, Bv = 0.f;
#pragma unroll
    for (int k = 0; k < 8; ++k) { Bv = fmaf(ab[k].x, Bv, ab[k].y); A *= ab[k].x; }
#pragma unroll
    for (int o = 1; o < 64; o <<= 1) { const float Al = __shfl_up(A, o), Bl = __shfl_up(Bv, o); if (lane >= o) { Bv = fmaf(A, Bl, Bv); A *= Al; } }
    float h = __shfl_up(Bv, 1); if (lane == 0) h = 0.f;
    float o8[8];
#pragma unroll
    for (int k = 0; k < 8; ++k) { o8[k] = h; h = fmaf(ab[k].x, h, ab[k].y); }
    float4* dst = (float4*)(B.CAR + (size_t)c * 512 + 8 * lane);
    dst[0] = make_float4(o8[0], o8[1], o8[2], o8[3]); dst[1] = make_float4(o8[4], o8[5], o8[6], o8[7]);
}

struct S5Bufs { float2* E; float2* CIN; };
template <int PASS>
__device__ __forceinline__ void s5_unit(const bf16_t* __restrict__ PM, int n, const S5Bufs& B, bf16_t* __restrict__ Y, const Params& p, int l, const bf16_t* __restrict__ WL, LAS unsigned char* lds) {
    const int tid = opq_tid(), w = tid >> 6, lane = tid & 63, q4 = lane >> 4, cc = lane & 15;
    const int t0 = n * 64;
    LAS float* bu = (LAS float*)(lds + w * 8448);
    LAS unsigned char* hs = lds + 8 * 8448 + w * 4352;
    lds_bf16* yp = (lds_bf16*)(lds + 8 * 8448 + 8 * 4352);
    const bf16_t* GLUT = WL + WO_GLU;
#pragma unroll 1
    for (int gi = 0; gi < 2; ++gi) {
        const int g = 2 * w + gi;
        U8 bfr[8], cf[4];
#pragma unroll
        for (int tn = 0; tn < 8; ++tn) bfr[tn].q = *(const uint4*)(WL + WO_S5B + ((size_t)(g * 8 + tn) * 64 + lane) * 8);
        float dch = 0.f;
        if (PASS == 3) {
#pragma unroll
            for (int ks = 0; ks < 4; ++ks) cf[ks].q = *(const uint4*)(WL + WO_S5C + ((size_t)(g * 4 + ks) * 64 + lane) * 8);
            dch = p.in[20][l * W + g * 16 + cc];
        }
        float lbr, lbi;
        { const float dt = __expf(p.in[21][l * 16 + g]); const float lre = p.in[14][l * 1024 + g * 64 + lane], lim = p.in[15][l * 1024 + g * 64 + lane];
          const float er = __expf(lre * dt); lbr = er * cosf(lim * dt); lbi = er * sinf(lim * dt); }
        float hr = 0.f, hi = 0.f;
        if (PASS == 3) { const float2 h0 = B.CIN[((size_t)g * 64 + lane) * 256 + n]; hr = h0.x; hi = h0.y; }
#pragma unroll 1
        for (int tt = 0; tt < 4; ++tt) {
            U8 at; at.q = make_uint4(0u, 0u, 0u, 0u); if (q4 < 2) at.q = *(const uint4*)(PM + (size_t)(t0 + 16 * tt + cc) * PMLD + C_S5 + g * 16 + 8 * q4);
#pragma unroll
            for (int tn = 0; tn < 8; ++tn) {
                const f32x4_t acc = __builtin_amdgcn_mfma_f32_16x16x32_bf16(at.v, bfr[tn].v, (f32x4_t){0.f, 0.f, 0.f, 0.f}, 0, 0, 0);
#pragma unroll
                for (int r = 0; r < 4; ++r) bu[(4 * q4 + r) * 132 + 16 * tn + cc] = acc[r];
            }
            asm volatile("s_waitcnt lgkmcnt(0)" ::: "memory");
#pragma unroll
            for (int i = 0; i < 16; ++i) {
                const f32x2v_t bb = *(const LAS f32x2v_t*)(bu + i * 132 + 2 * lane);
                const float nhr = lbr * hr - lbi * hi + bb.x, nhi = lbr * hi + lbi * hr + bb.y;
                hr = nhr; hi = nhi;
                if (PASS == 3) *(LAS unsigned*)(hs + i * 272 + 4 * lane) = cvtpk(hr, hi);
            }
            if (PASS == 3) {
                asm volatile("s_waitcnt lgkmcnt(0)" ::: "memory");
                f32x4_t acc = {0.f, 0.f, 0.f, 0.f};
#pragma unroll
                for (int ks = 0; ks < 4; ++ks) { U8 af; af.x = *(const LAS u32x4_t*)(hs + cc * 272 + 64 * ks + 16 * q4); acc = __builtin_amdgcn_mfma_f32_16x16x32_bf16(af.v, cf[ks].v, acc, 0, 0, 0); }
#pragma unroll
                for (int r = 0; r < 4; ++r) {
                    const int t = 16 * tt + 4 * q4 + r;
                    const float uv = bf2f(PM[(size_t)(t0 + t) * PMLD + C_S5 + g * 16 + cc]);
                    yp[t * 264 + g * 16 + cc] = (unsigned short)f2bf(geluf_(acc[r] + dch * uv));
                }
            }
            asm volatile("s_waitcnt lgkmcnt(0)" ::: "memory");
        }
        if (PASS == 1) B.E[((size_t)g * 64 + lane) * 256 + n] = make_float2(hr, hi);
    }
    if (PASS == 3) {
        BAR();
        const float* gb = p.in[23] + l * W;
#pragma unroll 1
        for (int tn = 2 * w; tn < 2 * w + 2; ++tn) {
            f32x4_t acc[4];
#pragma unroll
            for (int tt = 0; tt < 4; ++tt) acc[tt] = (f32x4_t){0.f, 0.f, 0.f, 0.f};
#pragma unroll
            for (int ks = 0; ks < 8; ++ks) {
                U8 bf; bf.q = *(const uint4*)(GLUT + (size_t)(16 * tn + cc) * 256 + 32 * ks + 8 * q4);
#pragma unroll
                for (int tt = 0; tt < 4; ++tt) {
                    U8 af; af.x = *(const LAS u32x4_t*)(yp + (16 * tt + cc) * 264 + 32 * ks + 8 * q4);
                    acc[tt] = __builtin_amdgcn_mfma_f32_16x16x32_bf16(af.v, bf.v, acc[tt], 0, 0, 0);
                }
            }
            const int ncol = 16 * tn + cc; const float gbn = gb[ncol];
#pragma unroll
            for (int tt = 0; tt < 4; ++tt)
#pragma unroll
                for (int r = 0; r < 4; ++r) {
                    const int t = 16 * tt + 4 * q4 + r;
                    const float yv = bf2f(yp[t * 264 + ncol]);
                    Y[(size_t)(t0 + t) * D + 512 + ncol] = (bf16_t)f2bf(yv * sigmoidf_(acc[tt][r] + gbn));
                }
        }
    }
    BAR();
}
__device__ __forceinline__ void s5_carry_wave(const S5Bufs& B, const Params& p, int l, int gp, int lane) {
    const int g = gp >> 6;
    const float dt = __expf(p.in[21][l * 16 + g]) * 64.f;
    const float lre = p.in[14][l * 1024 + gp], lim = p.in[15][l * 1024 + gp];
    const float er = __expf(lre * dt);
    const float pr = er * cosf(lim * dt), pi = er * sinf(lim * dt);
    float2 e[4];
    const float4* src = (const float4*)(B.E + (size_t)gp * 256 + 4 * lane);
    { const float4 v0 = src[0], v1 = src[1]; e[0] = make_float2(v0.x, v0.y); e[1] = make_float2(v0.z, v0.w); e[2] = make_float2(v1.x, v1.y); e[3] = make_float2(v1.z, v1.w); }
    float Ar = 1.f, Ai = 0.f, Br = 0.f, Bi = 0.f;
#pragma unroll
    for (int k = 0; k < 4; ++k) {
        const float nbr = pr * Br - pi * Bi + e[k].x, nbi = pr * Bi + pi * Br + e[k].y; Br = nbr; Bi = nbi;
        const float nar = pr * Ar - pi * Ai, nai = pr * Ai + pi * Ar; Ar = nar; Ai = nai;
    }
#pragma unroll
    for (int o = 1; o < 64; o <<= 1) {
        const float Alr = __shfl_up(Ar, o), Ali = __shfl_up(Ai, o), Blr = __shfl_up(Br, o), Bli = __shfl_up(Bi, o);
        if (lane >= o) {
            const float nbr = Ar * Blr - Ai * Bli + Br, nbi = Ar * Bli + Ai * Blr + Bi; Br = nbr; Bi = nbi;
            const float nar = Ar * Alr - Ai * Ali, nai = Ar * Ali + Ai * Alr; Ar = nar; Ai = nai;
        }
    }
    float hr = __shfl_up(Br, 1), hi = __shfl_up(Bi, 1); if (lane == 0) { hr = 0.f; hi = 0.f; }
    float2 o4[4];
#pragma unroll
    for (int k = 0; k < 4; ++k) { o4[k] = make_float2(hr, hi); const float nhr = pr * hr - pi * hi + e[k].x, nhi = pr * hi + pi * hr + e[k].y; hr = nhr; hi = nhi; }
    float4* dst = (float4*)(B.CIN + (size_t)gp * 256 + 4 * lane);
    dst[0] = make_float4(o4[0].x, o4[0].y, o4[1].x, o4[1].y); dst[1] = make_float4(o4[2].x, o4[2].y, o4[3].x, o4[3].y);
}

constexpr size_t WS_GQ = 36 * MiB, WS_GK = 44 * MiB, WS_GV = 52 * MiB, WS_GB = 60 * MiB, WS_GC = 61 * MiB;
constexpr size_t WS_MF = 324 * MiB, WS_NF = 356 * MiB, WS_HT = 388 * MiB;
constexpr size_t WS_RR = 420 * MiB, WS_RK = 428 * MiB, WS_RV = 436 * MiB, WS_RKK = 444 * MiB, WS_RA = 452 * MiB, WS_RG = 460 * MiB, WS_CW = 468 * MiB;
constexpr size_t WS_LAGG = 484 * MiB, WS_LCAR = 485 * MiB, WS_S5E = 486 * MiB, WS_S5C = 488 * MiB;
constexpr size_t WS_TG = 490 * MiB;
constexpr int MIX_LDS = 8 * MS * 4 + 1024;
__device__ __forceinline__ LruBufs lru_bufs(unsigned char* ws) { LruBufs B; B.AGG = (float2*)(ws + WS_LAGG); B.CAR = (float*)(ws + WS_LCAR); return B; }
__device__ __forceinline__ S5Bufs s5_bufs(unsigned char* ws) { S5Bufs B; B.E = (float2*)(ws + WS_S5E); B.CIN = (float2*)(ws + WS_S5C); return B; }
__device__ __forceinline__ GdnBufs gdn_bufs(unsigned char* ws) {
    GdnBufs B; B.GQ = (bf16_t*)(ws + WS_GQ); B.GK = (bf16_t*)(ws + WS_GK); B.GV = (bf16_t*)(ws + WS_GV); B.GB = (float*)(ws + WS_GB); B.GC = (float*)(ws + WS_GC);
    B.MF = (uint4*)(ws + WS_MF); B.NF = (float*)(ws + WS_NF); B.HT = (float*)(ws + WS_HT); B.TG = (bf16_t*)(ws + WS_TG); return B;
}
__device__ __forceinline__ RwkvBufs rwkv_bufs(unsigned char* ws) {
    RwkvBufs B; B.RR = (bf16_t*)(ws + WS_RR); B.RK = (bf16_t*)(ws + WS_RK); B.RV = (bf16_t*)(ws + WS_RV); B.RKK = (bf16_t*)(ws + WS_RKK); B.RA = (bf16_t*)(ws + WS_RA); B.RG = (bf16_t*)(ws + WS_RG);
    B.CW = (float*)(ws + WS_CW); B.MF = (uint4*)(ws + WS_MF); B.NF = (float*)(ws + WS_NF); B.HT = (float*)(ws + WS_HT); B.TG = (bf16_t*)(ws + WS_TG); return B;
}
__device__ __forceinline__ unsigned char* opq(unsigned char* w) { unsigned long long v = (unsigned long long)w; asm volatile("" : "+s"(v)); return (unsigned char*)(GAS unsigned char*)v; }
#define XB_TMO      128
#define XB_XCNT(j)  (256  + 64 * (j))
#define XB_XSUB(j)  (1280 + 64 * (j))
#define XB_XGEN(j)  (2304 + 64 * (j))
#define XB_TOP      3328
#define XB_TOPGEN   3392
#define XCD_BAR_WORDS 3456
#define XB_SPIN_CAP (1u << 18)

__device__ __forceinline__ unsigned xb_ld(unsigned* p)              { return __hip_atomic_load(p, __ATOMIC_RELAXED, __HIP_MEMORY_SCOPE_AGENT); }
__device__ __forceinline__ unsigned xb_add(unsigned* p, unsigned v) { return __hip_atomic_fetch_add(p, v, __ATOMIC_RELAXED, __HIP_MEMORY_SCOPE_AGENT); }
__device__ __forceinline__ unsigned xb_xcc_id() { return (unsigned)__builtin_amdgcn_s_getreg((3 << 11) | 20) & 0xFu; }
#define XB_SPIN(cond, bar) do { unsigned _sp = 0; while (cond) { __builtin_amdgcn_s_sleep(1); \
    if ((++_sp & 255u) == 0u) { if (xb_ld(&(bar)[XB_TMO])) break; if (_sp > XB_SPIN_CAP) { atomicAdd(&(bar)[XB_TMO], 1u); break; } } } } while (0)

struct XcdBarrier {
    unsigned* bar; unsigned x;
    volatile LAS unsigned* st;
};

__device__ __forceinline__ XcdBarrier xcd_barrier_post(unsigned* bar, volatile LAS unsigned* st) {
    XcdBarrier b; b.bar = bar; b.x = xb_xcc_id(); b.st = st;
    if (threadIdx.x == 0) (void)xb_add(&bar[XB_XCNT(b.x)], 1u);
    return b;
}
__device__ __forceinline__ void xcd_barrier_complete(unsigned* bar, unsigned x, unsigned& nloc, unsigned& nx) {
    const unsigned G = gridDim.x * gridDim.y * gridDim.z;
    unsigned sum, cnt, mine, sp = 0u;
    for (;;) {
        sum = 0u; cnt = 0u; mine = 0u;
#pragma unroll
        for (unsigned j = 0; j < 16; ++j) { const unsigned c = xb_ld(&bar[XB_XCNT(j)]); sum += c; cnt += (c > 0u) ? 1u : 0u; mine = (j == x) ? c : mine; }
        if (sum == G) break;
        __builtin_amdgcn_s_sleep(1);
        if ((++sp & 255u) == 0u) { if (xb_ld(&bar[XB_TMO])) break; if (sp > XB_SPIN_CAP) { atomicAdd(&bar[XB_TMO], 1u); break; } }
    }
    nloc = mine > 0u ? mine : 1u; nx = cnt > 0u ? cnt : 1u;
}

__device__ __forceinline__ void xcd_barrier(const XcdBarrier& b) {
    asm volatile("s_waitcnt vmcnt(0)" ::: "memory");
    __syncthreads();
    if (threadIdx.x == 0) {
        unsigned* bar = b.bar;
        __builtin_amdgcn_s_waitcnt(0);
        unsigned nloc = b.st[0], nx = b.st[1];
        if (nloc == 0u) { xcd_barrier_complete(bar, b.x, nloc, nx); b.st[0] = nloc; b.st[1] = nx; }
        const unsigned old = xb_add(&bar[XB_XSUB(b.x)], 1u);
        const unsigned gen = old / nloc;
        if (old + 1u == (gen + 1u) * nloc) {
            __builtin_amdgcn_fence(__ATOMIC_RELEASE, "agent");
            asm volatile("s_waitcnt vmcnt(0)" ::: "memory");
            const unsigned og = xb_add(&bar[XB_TOP], 1u);
            const unsigned tg = og / nx;
            if (og + 1u == (tg + 1u) * nx) xb_add(&bar[XB_TOPGEN], 1u);
            else XB_SPIN(xb_ld(&bar[XB_TOPGEN]) == tg, bar);
            __builtin_amdgcn_fence(__ATOMIC_ACQUIRE, "agent");
            xb_add(&bar[XB_XGEN(b.x)], 1u);
            asm volatile("s_waitcnt vmcnt(0)" ::: "memory");
        } else {
            XB_SPIN(xb_ld(&bar[XB_XGEN(b.x)]) == gen, bar);
            __builtin_amdgcn_fence(__ATOMIC_ACQUIRE, "agent");
            asm volatile("s_waitcnt vmcnt(0)" ::: "memory");
        }
    }
    __syncthreads();
}

__device__ __forceinline__ void sub_barrier(unsigned* cnt, unsigned target) {
    asm volatile("s_waitcnt vmcnt(0)" ::: "memory"); __syncthreads();
    if (threadIdx.x == 0) {
        __builtin_amdgcn_fence(__ATOMIC_RELEASE, "agent"); asm volatile("s_waitcnt vmcnt(0)" ::: "memory");
        (void)__hip_atomic_fetch_add(cnt, 1u, __ATOMIC_RELAXED, __HIP_MEMORY_SCOPE_AGENT);
        unsigned sp = 0;
        while (__hip_atomic_load(cnt, __ATOMIC_RELAXED, __HIP_MEMORY_SCOPE_AGENT) < target) { __builtin_amdgcn_s_sleep(2); if (++sp > (1u << 22)) break; }
        __builtin_amdgcn_fence(__ATOMIC_ACQUIRE, "agent"); asm volatile("s_waitcnt vmcnt(0)" ::: "memory");
    }
    __syncthreads();
}

namespace cg = cooperative_groups;
constexpr int FUSED_LDS = MIX_LDS;
static_assert(FUSED_LDS >= pg8::STAGE_BYTES && FUSED_LDS >= 8 * 64 * 33 * 4, "LDS budget");
#define GSYNC() xcd_barrier(bar)
#ifndef PHM
#define PHM 511
#endif
#ifndef REP
#define REP 0
#endif
#ifndef REPU
#define REPU 0
#endif
#ifndef REPP
#define REPP 0
#endif
__global__ void __launch_bounds__(NT, 2) fwd_fused(KParams kp_unused) {
    cg::grid_group grid = cg::this_grid();
    extern __shared__ __attribute__((aligned(16))) unsigned char dl[];
    Params p; p.in.tab = (LAS const unsigned long long*)((LAS unsigned char*)dl + FUSED_LDS);
    {
        const __attribute__((address_space(4))) unsigned long long* ka = (const __attribute__((address_space(4))) unsigned long long*)__builtin_amdgcn_kernarg_segment_ptr();
        if (threadIdx.x < 43) ((LAS unsigned long long*)((LAS unsigned char*)dl + FUSED_LDS))[threadIdx.x] = ka[threadIdx.x];
        if (threadIdx.x < 4) ((LAS unsigned*)((LAS unsigned char*)dl + FUSED_LDS + 512))[threadIdx.x] = 0u;
        __syncthreads();
    }
    const XcdBarrier bar = xcd_barrier_post((unsigned*)(p.ws() + WS_CTL), (volatile LAS unsigned*)((LAS unsigned char*)dl + FUSED_LDS + 512));
    float* X = p.out();
#pragma unroll 1
    for (int l = 0; l < 2; ++l) {
        {
            const int tid = opq_tid();
            convert_weights(p, l, (LAS float*)dl + (tid >> 6) * 64 * 33, blockIdx.x * 8 + (tid >> 6), gridDim.x * 8, tid & 63);
        }
#pragma unroll 1
        for (int b = 0; b < 2; ++b) {
            const float* Xin = (l == 0 ? p.in[0] : X) + (size_t)b * TB * D;
            float* Xb = X + (size_t)b * TB * D;
            { unsigned char* ws = opq(p.ws()); rmsnorm_rows(Xin, p.in[1] + l * D, (bf16_t*)(ws + WS_XN), TB); }
            if (l == 0 && b == 0) grid.sync(); else GSYNC();
#if PHM & 1
            for (int rep_ = 0; rep_ < ((REP & 1) ? 2 : 1); ++rep_) {
            {
                unsigned char* ws = opq(p.ws()); const bf16_t* WL = (const bf16_t*)(ws + WS_W);
                pg8::Gemm g{(const bf16_t*)(ws + WS_XN), WL + WO_IN, TB, 7168, D, D, D, 0};
                pg8::StaticOrder S; S.init(g.M, g.N, (int)gridDim.x, (int)blockIdx.x);
                pg8::gemm_phase<pg8::EpiProjP, pg8::StaticOrder, true, true>((PG8_LAS unsigned char*)dl, g, S, pg8::EpiProjP{(bf16_t*)(ws + WS_PM), (bf16_t*)(ws + WS_G)});
            }
            }
#endif
            GSYNC();
#if PHM & 2
            for (int rep_ = 0; rep_ < ((REP & 2) ? 2 : 1); ++rep_) {
            for (int ps_ = 0; ps_ < ((REPP == 2) ? 2 : 1); ++ps_)
            for (int n = blockIdx.x; n < 512; n += gridDim.x) {
                if (ps_ == 1 && ((n < 256) ? 1 : 2) != REPU) continue;
                unsigned char* ws = opq(p.ws());
                if (n < 256) gdn_prep_chunk((const bf16_t*)(ws + WS_PM), n, gdn_bufs(ws), p, l, (LAS float*)dl);
                else { const bf16_t* WL = (const bf16_t*)(ws + WS_W); rwkv_prep_chunk((const bf16_t*)(ws + WS_PM), n - 256, rwkv_bufs(ws), p, l, WL + WO_WUP, WL + WO_AUP, WL + WO_GUP, (LAS unsigned char*)dl); }
            }
            }
#endif
            if (gridDim.x == 256) {
                asm volatile("s_waitcnt vmcnt(0)" ::: "memory"); __syncthreads();
                if (threadIdx.x == 0) { __builtin_amdgcn_fence(__ATOMIC_ACQUIRE, "agent"); asm volatile("s_waitcnt vmcnt(0)" ::: "memory"); }
                __syncthreads();
            } else GSYNC();
#if PHM & 4
            for (int rep_ = 0; rep_ < ((REP & 4) ? 2 : 1); ++rep_) {
            for (int ps_ = 0; ps_ < ((REPP == 4) ? 2 : 1); ++ps_)
            for (int u = blockIdx.x; u < 2560; u += gridDim.x) {
                const int ut_ = u < 1024 ? 1 : (u < 2048 ? 2 : (u < 2304 ? 3 : 4));
                if (ps_ == 1 && ut_ != REPU) continue;
                unsigned char* ws = opq(p.ws());
                if (u < 1024) gdn_g1_unit(u >> 8, u & 255, gdn_bufs(ws), (bf16_t*)(ws + WS_Y), (LAS unsigned char*)dl);
                else if (u < 2048) rwkv_g1_unit((u - 1024) >> 8, u & 255, rwkv_bufs(ws), (bf16_t*)(ws + WS_Y), (LAS unsigned char*)dl);
                else if (u < 2304) lru_unit<1>((const bf16_t*)(ws + WS_PM), u - 2048, lru_bufs(ws), (bf16_t*)(ws + WS_Y), p, l, (const bf16_t*)(ws + WS_W) + WO_LWT, (LAS float*)dl);
                else s5_unit<1>((const bf16_t*)(ws + WS_PM), u - 2304, s5_bufs(ws), (bf16_t*)(ws + WS_Y), p, l, (const bf16_t*)(ws + WS_W), (LAS unsigned char*)dl);
            }
            }
#endif
            GSYNC();
#if PHM & 8
            for (int rep_ = 0; rep_ < ((REP & 8) ? 2 : 1); ++rep_) {
            {
                const int tid = opq_tid(), lane = tid & 63, wv = tid >> 6;
                const int bx = blockIdx.x;
                volatile LAS unsigned* flags = (volatile LAS unsigned*)((LAS unsigned char*)dl + FUSED_LDS + 768);
                if (tid < 16) flags[tid] = 0u;
                __syncthreads();
                if (bx < 32) {
                    unsigned char* ws = opq(p.ws());
                    const GdnBufs B = gdn_bufs(ws); const int sq = bx >> 2, cb = bx & 3;
                    if (wv == 0) chain_wave(B.HT + (size_t)sq * 256 * 4096, cb, 256, lane, (LAS unsigned char*)dl, flags);
                    else chain_loader(B.MF + (size_t)sq * 256 * 1024, B.NF + (size_t)sq * 256 * 4096, cb, 256, lane, wv - 1, (LAS unsigned char*)dl, flags);
                } else {
                    {
                        unsigned char* ws = opq(p.ws());
                        for (int job = (bx - 32) * 8 + wv; job < 1280; job += (int)(gridDim.x - 32) * 8) {
                            if (job < 256) lru_carry_wave(lru_bufs(ws), job, lane);
                            else s5_carry_wave(s5_bufs(ws), p, l, job - 256, lane);
                        }
                    }
                    sub_barrier((unsigned*)(p.ws() + WS_CTL + 15360), (unsigned)(gridDim.x - 32) * (unsigned)(l * 2 + b + 1));
                    for (int u = bx - 32; u < 512; u += (int)gridDim.x - 32) {
                        unsigned char* ws = opq(p.ws());
                        if (u < 256) lru_unit<3>((const bf16_t*)(ws + WS_PM), u, lru_bufs(ws), (bf16_t*)(ws + WS_Y), p, l, (const bf16_t*)(ws + WS_W) + WO_LWT, (LAS float*)dl);
                        else s5_unit<3>((const bf16_t*)(ws + WS_PM), u - 256, s5_bufs(ws), (bf16_t*)(ws + WS_Y), p, l, (const bf16_t*)(ws + WS_W), (LAS unsigned char*)dl);
                    }
                }
            }
            }
#endif
            GSYNC();
#if PHM & 16
            for (int rep_ = 0; rep_ < ((REP & 16) ? 2 : 1); ++rep_) {
            for (int ps_ = 0; ps_ < ((REPP == 16) ? 2 : 1); ++ps_)
            for (int u = blockIdx.x; u < 2048; u += gridDim.x) {
                const int ut_ = u < 1024 ? 1 : (u < 2048 ? 2 : (u < 2304 ? 3 : 4));
                if (ps_ == 1 && ut_ != REPU) continue;
                unsigned char* ws = opq(p.ws());
                if (u < 1024) gdn_g3_unit(u >> 8, u & 255, gdn_bufs(ws), (const bf16_t*)(ws + WS_PM), (bf16_t*)(ws + WS_Y), p.in[6] + l * 64, (LAS unsigned char*)dl);
                else rwkv_g3_unit((u - 1024) >> 8, u & 255, rwkv_bufs(ws), (bf16_t*)(ws + WS_Y), p, l, (LAS unsigned char*)dl);
            }
            }
#endif
            GSYNC();
#if PHM & 32
            for (int rep_ = 0; rep_ < ((REP & 32) ? 2 : 1); ++rep_) {
            { unsigned char* ws = opq(p.ws()); merge_phase((const bf16_t*)(ws + WS_Y), (const bf16_t*)(ws + WS_W) + WO_BR, (const bf16_t*)(ws + WS_G), (bf16_t*)(ws + WS_MG), (LAS unsigned char*)dl); }
            }
#endif
            GSYNC();
#if PHM & 64
            {
                unsigned char* ws = opq(p.ws()); const bf16_t* WL = (const bf16_t*)(ws + WS_W);
                pg8::Gemm g{(const bf16_t*)(ws + WS_MG), WL + WO_OUT, TB, D, D, D, D, 0};
                pg8::StaticOrder S; S.init(g.M, g.N, (int)gridDim.x, (int)blockIdx.x);
                pg8::gemm_phase<pg8::EpiResidP, pg8::StaticOrder, false, true>((PG8_LAS unsigned char*)dl, g, S, pg8::EpiResidP{Xin, Xb});
            }
#endif
            GSYNC();
            { unsigned char* ws = opq(p.ws()); rmsnorm_rows(Xb, p.in[37] + l * D, (bf16_t*)(ws + WS_XN), TB); }
            GSYNC();
#if PHM & 128
            for (int rep_ = 0; rep_ < ((REP & 128) ? 2 : 1); ++rep_) {
            {
                unsigned char* ws = opq(p.ws()); const bf16_t* WL = (const bf16_t*)(ws + WS_W);
                pg8::Gemm g{(const bf16_t*)(ws + WS_XN), WL + WO_W1, TB, DFF, D, D, D, 0};
                pg8::StaticOrder S; S.init(g.M, g.N, (int)gridDim.x, (int)blockIdx.x);
                pg8::gemm_phase<pg8::EpiRelu2P, pg8::StaticOrder, true, true>((PG8_LAS unsigned char*)dl, g, S, pg8::EpiRelu2P{(bf16_t*)(ws + WS_HD), DFF, 0});
            }
            }
#endif
            GSYNC();
#if PHM & 256
            {
                unsigned char* ws = opq(p.ws()); const bf16_t* WL = (const bf16_t*)(ws + WS_W);
                pg8::Gemm g{(const bf16_t*)(ws + WS_HD), WL + WO_W2, TB, D, DFF, DFF, DFF, 0};
                pg8::StaticOrder S; S.init(g.M, g.N, (int)gridDim.x, (int)blockIdx.x);
                pg8::gemm_phase<pg8::EpiResidP, pg8::StaticOrder, false, true>((PG8_LAS unsigned char*)dl, g, S, pg8::EpiResidP{Xb, Xb});
            }
#endif
            GSYNC();
        }
    }
    rmsnorm_rows(X, p.in[40], X, 2 * TB);
}

extern "C" void kernel_launch(void* const* d_in, const int* in_sizes, int n_in, void* d_out, int out_size, void* d_ws, size_t ws_size, hipStream_t stream) {
    KParams p{};
    for (int i = 0; i < 41; ++i) p.in[i] = (const float*)d_in[i];
    p.out = (float*)d_out; p.ws = (unsigned char*)d_ws; p.pad = 0;
    static int grid = 0;
    if (grid == 0) {
        int dev = 0, cus = 0, per_cu = 0;
        hipGetDevice(&dev);
        hipDeviceGetAttribute(&cus, hipDeviceAttributeMultiprocessorCount, dev);
        hipFuncSetAttribute((const void*)fwd_fused, hipFuncAttributeMaxDynamicSharedMemorySize, FUSED_LDS + 1024);
        hipOccupancyMaxActiveBlocksPerMultiprocessor(&per_cu, (const void*)fwd_fused, NT, FUSED_LDS + 1024);
        if (per_cu < 1) per_cu = 1;
        grid = cus * per_cu;
        if (grid > 256) grid = 256;
    }
    hipMemsetAsync((unsigned char*)d_ws + WS_CTL, 0, 16384, stream);
    void* args[] = {&p};
    hipError_t e = hipLaunchCooperativeKernel((const void*)fwd_fused, dim3(grid), dim3(NT), args, FUSED_LDS + 1024, stream);
    if (e != hipSuccess) fprintf(stderr, "cooperative launch failed: %s (grid %d)\n", hipGetErrorString(e), grid);
}
```

```cpp
#include <hip/hip_runtime.h>
#ifndef MEXP
#define MEXP 0
#endif
#ifndef PEXP
#define PEXP 0
#endif
#include <hip/hip_cooperative_groups.h>
#include <cstdio>
#include <cstdint>

constexpr int TB = 16384;
constexpr int D = 1024;
constexpr int DIN = 6920;
constexpr int NMIX = 2824;
constexpr int W = 256;
constexpr int DFF = 4096;
constexpr int NT = 512;

constexpr int C_GDN = 0, C_LRU = 1032, C_S5 = 1544, C_RWKV = 1800, C_GATE = 2824;

struct KParams { const float* in[41]; float* out; unsigned char* ws; size_t pad; };
#define LAS __attribute__((address_space(3)))
#define GAS __attribute__((address_space(1)))
struct PIn { LAS const unsigned long long* tab;
    __device__ __forceinline__ const float* operator[](int i) const { LAS const unsigned long long* t = tab; asm volatile("" : "+v"(t)); const unsigned long long v = t[i];
        const unsigned lo = __builtin_amdgcn_readfirstlane((unsigned)v), hi = __builtin_amdgcn_readfirstlane((unsigned)(v >> 32)); return (const float*)(GAS const float*)(((unsigned long long)hi << 32) | lo); } };
struct Params { PIn in;
    __device__ __forceinline__ float* out() const { return (float*)in[41]; }
    __device__ __forceinline__ unsigned char* ws() const { return (unsigned char*)in[42]; } };

typedef unsigned short bf16_t;
constexpr int PMLD = 3072;
constexpr size_t MiB = 1u << 20;
constexpr size_t WS_W  = 0;
constexpr size_t WS_CTL = 35 * MiB;
constexpr size_t WS_XN = 36 * MiB;
constexpr size_t WS_PM = 68 * MiB;
constexpr size_t WS_G  = 164 * MiB;
constexpr size_t WS_HD = 164 * MiB;
constexpr size_t WS_Y  = 292 * MiB;
constexpr size_t WS_MG = 324 * MiB;

__device__ __forceinline__ unsigned f2bf(float f) { unsigned u = __float_as_uint(f); return (u + 0x7fffu + ((u >> 16) & 1u)) >> 16; }
__device__ __forceinline__ float bf2f(bf16_t b) { return __uint_as_float((unsigned)b << 16); }
__device__ __forceinline__ float ldf(const float* p) { return *p; }
__device__ __forceinline__ float ldf(const bf16_t* p) { return bf2f(*p); }
__device__ __forceinline__ float sigmoidf_(float x) { return __builtin_amdgcn_rcpf(1.f + __expf(-x)); }
__device__ __forceinline__ float softplusf_(float x) { const float e = __expf(x); return x > 20.f ? x : (e < 1e-4f ? e : __logf(1.f + e)); }
__device__ __forceinline__ float siluf_(float x) { return x * sigmoidf_(x); }
__device__ __forceinline__ float tanhf_(float y) { return 1.f - 2.f * __builtin_amdgcn_rcpf(1.f + __expf(2.f * y)); }
__device__ __forceinline__ float geluf_(float x) { return 0.5f * x * (1.f + tanhf_(0.7978845608028654f * (x + 0.044715f * x * x * x))); }
__device__ __forceinline__ float rl(float v, int i) { return __int_as_float(__builtin_amdgcn_readlane(__float_as_int(v), i)); }
__device__ __forceinline__ float wave_sum(float v) {
#pragma unroll
    for (int o = 1; o < 64; o <<= 1) v += __shfl_xor(v, o);
    return v;
}

template <class OT>
__device__ __forceinline__ void rmsnorm_rows(const float* X, const float* g, OT* O, int rows) {
    int tid_ = threadIdx.x; asm volatile("" : "+v"(tid_));
    const int lane = tid_ & 63, wv = tid_ >> 6;
    const int gw = blockIdx.x * (NT / 64) + wv, ngw = gridDim.x * (NT / 64);
    for (int r = gw; r < rows; r += ngw) {
        const float4* xr = (const float4*)(X + (size_t)r * D);
        float4 v[4]; float s = 0.f;
#pragma unroll
        for (int j = 0; j < 4; ++j) { v[j] = xr[lane + 64 * j]; s += v[j].x * v[j].x + v[j].y * v[j].y + v[j].z * v[j].z + v[j].w * v[j].w; }
        s = wave_sum(s);
        const float rs = rsqrtf(s * (1.f / D) + 1e-6f);
#pragma unroll
        for (int j = 0; j < 4; ++j) {
            const float4 gg = ((const float4*)g)[lane + 64 * j];
            const float4 o = make_float4(v[j].x * rs * gg.x, v[j].y * rs * gg.y, v[j].z * rs * gg.z, v[j].w * rs * gg.w);
            if constexpr (sizeof(OT) == 4) ((float4*)(O + (size_t)r * D))[lane + 64 * j] = o;
            else ((uint2*)(O + (size_t)r * D))[lane + 64 * j] = make_uint2(f2bf(o.x) | (f2bf(o.y) << 16), f2bf(o.z) | (f2bf(o.w) << 16));
        }
    }
}

namespace pg8 {
#define PG8_LAS __attribute__((address_space(3)))
typedef short bf16x8 __attribute__((ext_vector_type(8)));
typedef float f32x4 __attribute__((ext_vector_type(4)));
typedef unsigned u32x4 __attribute__((ext_vector_type(4)));
constexpr int BM = 256, BK = 64, HALF = 128, HTB = HALF * BK * 2  , STAGE_BYTES = 8 * HTB, NXCD = 8, WGM = 8;

__host__ __device__ __forceinline__ int lds_byte(int r, int c) { const int st = (r >> 4) * 2 + (c >> 5), rr = r & 15, cc = c & 31, ob = rr * 64 + cc * 2; return st * 1024 + (ob ^ (((ob >> 9) & 1) << 5)); }
__host__ __device__ __forceinline__ void stage_rc(int b, int& R, int& C) { const int st = b / 1024, sb = b % 1024, swz = sb ^ (((sb >> 9) & 1) << 5); R = (st >> 1) * 16 + swz / 64; C = (st & 1) * 32 + (swz % 64) / 2; }
__host__ __device__ __forceinline__ int perm32(int rho) { const int n = rho >> 4, i = rho & 15; return 8 * (i >> 2) + 4 * n + (i & 3); }

struct Unit { int pm, pn; };
struct Gemm { const bf16_t* A; const bf16_t* Bt; int M, N, K, lda, ldb, pad; };

struct StaticOrder {
    int nM, nN, nwg, G, c;
    __host__ __device__ void init(int M, int N, int G_, int c_) { nM = M / BM; nN = N / BM; nwg = nM * nN; G = G_; c = c_; }
    __host__ __device__ bool next(int i, Unit& u) const {
        const long L = (long)i * G + c; if (L >= nwg) return false;
        int wgid = (int)L; { const int q = nwg / NXCD, r = nwg % NXCD, xcd = wgid % NXCD, off = wgid / NXCD; wgid = (xcd < r ? xcd * (q + 1) : r * (q + 1) + (xcd - r) * q) + off; }
        const int nig = WGM * nN, gid = wgid / nig, fm = gid * WGM, gsz = (nM - fm) < WGM ? (nM - fm) : WGM;
        u.pm = fm + ((wgid % nig) % gsz); u.pn = (wgid % nig) / gsz; return true;
    }
    __device__ __forceinline__ void a_ready(const Unit&) const {}
    __device__ __forceinline__ void done(const Unit&) const {}
};


typedef __bf16 bf16x2p_t __attribute__((ext_vector_type(2)));
typedef float f32x2p_t __attribute__((ext_vector_type(2)));
__device__ __forceinline__ unsigned cvt_pk_bf16(float lo, float hi) { return __builtin_bit_cast(unsigned, __builtin_convertvector((f32x2p_t){lo, hi}, bf16x2p_t)); }
__device__ __forceinline__ float sigm(float x) { return __builtin_amdgcn_rcpf(1.f + __expf(-x)); }
struct EpiProjP {
    static constexpr bool PERM = true, AFTER_DRAIN = false;
    bf16_t* PM; bf16_t* G;
    __device__ __forceinline__ void operator()(const f32x4 (&acc)[2][2][4][2], const Unit& u, int wr, int wc, int fr, int fq) const {
        const int row0 = u.pm * BM + wr * 64 + fr;
        const bool sg = u.pn >= 12;
        bf16_t* base = sg ? G : PM; const int ld = sg ? 4096 : 3072; const int colt = (sg ? u.pn - 12 : u.pn) * BM;
        const int col0 = colt + wc * 32 + 8 * fq;
#pragma unroll
        for (int ai = 0; ai < 2; ++ai)
#pragma unroll
            for (int m = 0; m < 4; ++m) { bf16_t* rowp = base + (size_t)(row0 + ai * HALF + m * 16) * ld + col0;
#pragma unroll
                for (int bj = 0; bj < 2; ++bj) { f32x4 v0 = acc[ai][bj][m][0], v1 = acc[ai][bj][m][1];
                    if (sg) { v0[0] = sigm(v0[0]); v0[1] = sigm(v0[1]); v0[2] = sigm(v0[2]); v0[3] = sigm(v0[3]); v1[0] = sigm(v1[0]); v1[1] = sigm(v1[1]); v1[2] = sigm(v1[2]); v1[3] = sigm(v1[3]); }
                    u32x4 w; w.x = cvt_pk_bf16(v0[0], v0[1]); w.y = cvt_pk_bf16(v0[2], v0[3]); w.z = cvt_pk_bf16(v1[0], v1[1]); w.w = cvt_pk_bf16(v1[2], v1[3]);
                    *(u32x4*)(rowp + bj * HALF) = w; } }
    }
};
struct EpiRelu2P {
    static constexpr bool PERM = true, AFTER_DRAIN = false;
    bf16_t* O; int ldo; int pad;
    __device__ __forceinline__ void operator()(const f32x4 (&acc)[2][2][4][2], const Unit& u, int wr, int wc, int fr, int fq) const {
        const int row0 = u.pm * BM + wr * 64 + fr, col0 = u.pn * BM + wc * 32 + 8 * fq;
#pragma unroll
        for (int ai = 0; ai < 2; ++ai)
#pragma unroll
            for (int m = 0; m < 4; ++m) { bf16_t* rowp = O + (size_t)(row0 + ai * HALF + m * 16) * ldo + col0;
#pragma unroll
                for (int bj = 0; bj < 2; ++bj) { f32x4 v0 = acc[ai][bj][m][0], v1 = acc[ai][bj][m][1];
#pragma unroll
                    for (int j = 0; j < 4; ++j) { const float a = fmaxf(v0[j], 0.f), b = fmaxf(v1[j], 0.f); v0[j] = a * a; v1[j] = b * b; }
                    u32x4 w; w.x = cvt_pk_bf16(v0[0], v0[1]); w.y = cvt_pk_bf16(v0[2], v0[3]); w.z = cvt_pk_bf16(v1[0], v1[1]); w.w = cvt_pk_bf16(v1[2], v1[3]);
                    *(u32x4*)(rowp + bj * HALF) = w; } }
    }
};
struct EpiResidP {
    static constexpr bool PERM = false, AFTER_DRAIN = false;
    const float* base; float* out;
    __device__ __forceinline__ void operator()(const f32x4 (&acc)[2][2][4][2], const Unit& u, int wr, int wc, int fr, int fq) const {
        const int row0 = u.pm * BM + wr * 64 + fr, col0 = u.pn * BM + wc * 32 + 4 * fq;
#pragma unroll
        for (int ai = 0; ai < 2; ++ai)
#pragma unroll
            for (int m = 0; m < 4; ++m) { const size_t off = (size_t)(row0 + ai * HALF + m * 16) * 1024 + col0;
#pragma unroll
                for (int bj = 0; bj < 2; ++bj)
#pragma unroll
                    for (int n = 0; n < 2; ++n) { const f32x4 b = *(const f32x4*)(base + off + bj * HALF + n * 16); *(f32x4*)(out + off + bj * HALF + n * 16) = b + acc[ai][bj][m][n]; } }
    }
};
struct EpiResidNormP {
    static constexpr bool PERM = false, AFTER_DRAIN = false;
    const float* base; float* out; bf16_t* XB; float* SS;
    __device__ __forceinline__ void operator()(const f32x4 (&acc)[2][2][4][2], const Unit& u, int wr, int wc, int fr, int fq) const {
        const int row0 = u.pm * BM + wr * 64 + fr, col0 = u.pn * BM + wc * 32 + 4 * fq;
#pragma unroll
        for (int ai = 0; ai < 2; ++ai)
#pragma unroll
            for (int m = 0; m < 4; ++m) { const int row = row0 + ai * HALF + m * 16; const size_t off = (size_t)row * 1024 + col0; float s = 0.f;
#pragma unroll
                for (int bj = 0; bj < 2; ++bj)
#pragma unroll
                    for (int n = 0; n < 2; ++n) { const f32x4 b = *(const f32x4*)(base + off + bj * HALF + n * 16); const f32x4 v = b + acc[ai][bj][m][n]; *(f32x4*)(out + off + bj * HALF + n * 16) = v;
                        s += v[0] * v[0] + v[1] * v[1] + v[2] * v[2] + v[3] * v[3];
                        typedef unsigned u32x2 __attribute__((ext_vector_type(2)));
                        u32x2 w; w.x = cvt_pk_bf16(v[0], v[1]); w.y = cvt_pk_bf16(v[2], v[3]); *(u32x2*)(XB + off + bj * HALF + n * 16) = w; }
                s += __shfl_xor(s, 16); s += __shfl_xor(s, 32);
                if (fq == 0) SS[(size_t)row * 16 + u.pn * 4 + wc] = s; }
    }
};
struct EpiRelu2NormP {
    static constexpr bool PERM = true, AFTER_DRAIN = false;
    bf16_t* O; int ldo; int pad; const float* SS;
    __device__ __forceinline__ void operator()(const f32x4 (&acc)[2][2][4][2], const Unit& u, int wr, int wc, int fr, int fq) const {
        const int row0 = u.pm * BM + wr * 64 + fr, col0 = u.pn * BM + wc * 32 + 8 * fq;
#pragma unroll
        for (int ai = 0; ai < 2; ++ai)
#pragma unroll
            for (int m = 0; m < 4; ++m) { const int row = row0 + ai * HALF + m * 16; bf16_t* rowp = O + (size_t)row * ldo + col0;
                const f32x4 pp = *(const f32x4*)(SS + (size_t)row * 16 + 4 * fq); float s = (pp[0] + pp[1]) + (pp[2] + pp[3]);
                s += __shfl_xor(s, 16); s += __shfl_xor(s, 32);
                const float rs = rsqrtf(s * (1.f / 1024.f) + 1e-6f);
#pragma unroll
                for (int bj = 0; bj < 2; ++bj) { f32x4 v0 = acc[ai][bj][m][0], v1 = acc[ai][bj][m][1];
#pragma unroll
                    for (int j = 0; j < 4; ++j) { const float a = fmaxf(v0[j] * rs, 0.f), b = fmaxf(v1[j] * rs, 0.f); v0[j] = a * a; v1[j] = b * b; }
                    u32x4 w; w.x = cvt_pk_bf16(v0[0], v0[1]); w.y = cvt_pk_bf16(v0[2], v0[3]); w.z = cvt_pk_bf16(v1[0], v1[1]); w.w = cvt_pk_bf16(v1[2], v1[3]);
                    *(u32x4*)(rowp + bj * HALF) = w; } }
    }
};
template <class Epi, class Sched, bool ALIGN_EPI = false, bool SP2 = false>
__device__ __forceinline__ void gemm_phase(PG8_LAS unsigned char* lds, const Gemm g, const Sched& S, const Epi& E) {
    int tid = threadIdx.x; asm volatile("" : "+v"(tid));
    const int wid = __builtin_amdgcn_readfirstlane(tid >> 6), lane = tid & 63, wr = wid >> 2, wc = wid & 3, fr = lane & 15, fq = lane >> 4;
    const int K = g.K, nt = K / BK;
    unsigned voffA[2], voffB[2];
#pragma unroll
    for (int i = 0; i < 2; ++i) { int R, C; stage_rc(tid * 16 + i * 8192, R, C); const int Rb = Epi::PERM ? ((R & ~31) + perm32(R & 31)) : R;
        voffA[i] = (unsigned)(R * g.lda + C) * 2u; voffB[i] = (unsigned)(Rb * g.ldb + C) * 2u; }
    const size_t kstep = (size_t)(BK * 2);
    const size_t hstepA = (size_t)HALF * g.lda * 2, hstepB = (size_t)HALF * g.ldb * 2;
    const size_t tstepA = 2 * hstepA, tstepB = 2 * hstepB;
    const unsigned ldsw = (unsigned)wid * 1024u;
    const int aoff = lds_byte(wr * 64 + fr, fq * 8), boff = lds_byte(wc * 32 + fr, fq * 8);
#define PG8_SA(b, h) (((b) * 2 + (h)) * HTB)
#define PG8_SB(b, h) ((4 + (b) * 2 + (h)) * HTB)
#define PG8_STAGE(bufoff, gbase, voff) do { _Pragma("unroll") for (int _i = 0; _i < 2; ++_i) \
        __builtin_amdgcn_global_load_lds((const unsigned*)((const char*)(gbase) + (voff)[_i]), (PG8_LAS unsigned*)(lds + (bufoff) + ldsw + _i * 8192), 16, 0, 0); } while (0)
#define PG8_LDA(dst, b, h) do { _Pragma("unroll") for (int m = 0; m < 4; ++m) _Pragma("unroll") for (int k = 0; k < 2; ++k) dst[m][k] = *(const PG8_LAS bf16x8*)(lds + PG8_SA(b, h) + aoff + m * 2048 + k * 1024); } while (0)
#define PG8_LDB(dst, b, h) do { _Pragma("unroll") for (int n = 0; n < 2; ++n) _Pragma("unroll") for (int k = 0; k < 2; ++k) dst[n][k] = *(const PG8_LAS bf16x8*)(lds + PG8_SB(b, h) + boff + n * 2048 + k * 1024); } while (0)
#define PG8_MMA(ai, bj, At, Bt) do { __builtin_amdgcn_s_setprio(1); _Pragma("unroll") for (int m = 0; m < 4; ++m) _Pragma("unroll") for (int n = 0; n < 2; ++n) _Pragma("unroll") for (int k = 0; k < 2; ++k) \
        acc[ai][bj][m][n] = __builtin_amdgcn_mfma_f32_16x16x32_bf16(Bt[n][k], At[m][k], acc[ai][bj][m][n], 0, 0, 0); __builtin_amdgcn_s_setprio(0); } while (0)
#define PG8_WAIT_V(n) asm volatile("s_waitcnt vmcnt(" #n ")" ::: "memory")
#define PG8_WAIT_L(n) asm volatile("s_waitcnt lgkmcnt(" #n ")" ::: "memory")
#define PG8_BAR __builtin_amdgcn_s_barrier()
#define PG8_SCHED __builtin_amdgcn_sched_barrier(0)
    Unit cur, nxt; int ui = 0;
    if (!S.next(0, cur)) return;
    f32x4 acc[2][2][4][2];
#pragma unroll
    for (int a = 0; a < 2; ++a)
#pragma unroll
        for (int b = 0; b < 2; ++b)
#pragma unroll
            for (int m = 0; m < 4; ++m)
#pragma unroll
                for (int n = 0; n < 2; ++n) acc[a][b][m][n] = (f32x4){0.f, 0.f, 0.f, 0.f};
    bf16x8 At[4][2], B0[2][2], B1[2][2];
    const char* cA = (const char*)g.A + (size_t)cur.pm * tstepA; const char* cB = (const char*)g.Bt + (size_t)cur.pn * tstepB;
    S.a_ready(cur);
    if constexpr (SP2) {
        PG8_STAGE(PG8_SB(0, 0), cB, voffB); PG8_STAGE(PG8_SB(0, 1), cB + hstepB, voffB); PG8_STAGE(PG8_SA(0, 0), cA, voffA); PG8_STAGE(PG8_SA(0, 1), cA + hstepA, voffA);
        if (wr == 1) PG8_BAR;
        PG8_WAIT_V(2); PG8_BAR;
        PG8_STAGE(PG8_SB(1, 0), cB + kstep, voffB); PG8_STAGE(PG8_SA(1, 0), cA + kstep, voffA); PG8_STAGE(PG8_SB(1, 1), cB + hstepB + kstep, voffB);
        PG8_WAIT_V(6); PG8_BAR;
    } else {
        PG8_STAGE(PG8_SB(0, 0), cB, voffB); PG8_STAGE(PG8_SA(0, 0), cA, voffA); PG8_STAGE(PG8_SB(0, 1), cB + hstepB, voffB); PG8_STAGE(PG8_SA(0, 1), cA + hstepA, voffA);
        if (wr == 1) PG8_BAR;
        PG8_WAIT_V(4); PG8_BAR;
        PG8_STAGE(PG8_SB(1, 0), cB + kstep, voffB); PG8_STAGE(PG8_SA(1, 0), cA + kstep, voffA); PG8_STAGE(PG8_SB(1, 1), cB + hstepB + kstep, voffB);
        PG8_WAIT_V(6); PG8_BAR;
    }
    for (;;) {
        const bool has_next = S.next(ui + 1, nxt);
        const char* nA = has_next ? (const char*)g.A + (size_t)nxt.pm * tstepA : cA; const char* nB = has_next ? (const char*)g.Bt + (size_t)nxt.pn * tstepB : cB;
        for (int t = 0; t < nt; t += 2) {
            const bool last = (t == nt - 2);
            const char* a1 = cA + (size_t)(t + 1) * kstep;
            const char* a2 = last ? nA : cA + (size_t)(t + 2) * kstep; const char* b2 = last ? nB : cB + (size_t)(t + 2) * kstep;
            const char* a3 = a2 + kstep; const char* b3 = b2 + kstep;
            if (last && has_next) S.a_ready(nxt);
            if constexpr (SP2) {
            PG8_LDB(B0, 0, 0); PG8_LDB(B1, 0, 1); PG8_SCHED; PG8_LDA(At, 0, 0); PG8_STAGE(PG8_SA(1, 1), a1 + hstepA, voffA);
            PG8_WAIT_V(8); PG8_WAIT_L(0); PG8_BAR; PG8_MMA(0, 0, At, B0); PG8_MMA(0, 1, At, B1); PG8_BAR; PG8_SCHED;
            PG8_LDA(At, 0, 1); PG8_STAGE(PG8_SB(0, 0), b2, voffB); PG8_STAGE(PG8_SB(0, 1), b2 + hstepB, voffB); PG8_STAGE(PG8_SA(0, 0), a2, voffA);
            PG8_WAIT_V(8); PG8_WAIT_L(0); PG8_BAR; PG8_MMA(1, 0, At, B0); PG8_MMA(1, 1, At, B1); PG8_BAR; PG8_SCHED;
            PG8_LDB(B0, 1, 0); PG8_LDB(B1, 1, 1); PG8_SCHED; PG8_LDA(At, 1, 0); PG8_STAGE(PG8_SA(0, 1), a2 + hstepA, voffA);
            PG8_WAIT_V(8); PG8_WAIT_L(0); PG8_BAR; PG8_MMA(0, 0, At, B0); PG8_MMA(0, 1, At, B1); PG8_BAR; PG8_SCHED;
            PG8_LDA(At, 1, 1); PG8_STAGE(PG8_SB(1, 0), b3, voffB); PG8_STAGE(PG8_SB(1, 1), b3 + hstepB, voffB); PG8_STAGE(PG8_SA(1, 0), a3, voffA);
            PG8_WAIT_V(8); PG8_WAIT_L(0); PG8_BAR; PG8_MMA(1, 0, At, B0); PG8_MMA(1, 1, At, B1); PG8_BAR; PG8_SCHED;
            } else {
            PG8_LDB(B0, 0, 0); PG8_SCHED; PG8_LDA(At, 0, 0); PG8_STAGE(PG8_SA(1, 1), a1 + hstepA, voffA);
            PG8_WAIT_L(8); PG8_BAR; PG8_WAIT_L(0); PG8_MMA(0, 0, At, B0); PG8_BAR; PG8_SCHED;
            PG8_LDB(B1, 0, 1); PG8_STAGE(PG8_SB(0, 0), b2, voffB);
            PG8_BAR; PG8_WAIT_L(0); PG8_MMA(0, 1, At, B1); PG8_BAR;
            PG8_LDA(At, 0, 1); PG8_STAGE(PG8_SA(0, 0), a2, voffA);
            PG8_BAR; PG8_WAIT_L(0); PG8_MMA(1, 0, At, B0); PG8_BAR; PG8_SCHED;
            PG8_STAGE(PG8_SB(0, 1), b2 + hstepB, voffB);
            PG8_WAIT_V(6); PG8_BAR; PG8_MMA(1, 1, At, B1); PG8_BAR;
            PG8_LDB(B0, 1, 0); PG8_SCHED; PG8_LDA(At, 1, 0); PG8_STAGE(PG8_SA(0, 1), a2 + hstepA, voffA);
            PG8_WAIT_L(8); PG8_BAR; PG8_WAIT_L(0); PG8_MMA(0, 0, At, B0); PG8_BAR; PG8_SCHED;
            PG8_LDB(B1, 1, 1); PG8_STAGE(PG8_SB(1, 0), b3, voffB);
            PG8_BAR; PG8_WAIT_L(0); PG8_MMA(0, 1, At, B1); PG8_BAR;
            PG8_LDA(At, 1, 1); PG8_STAGE(PG8_SA(1, 0), a3, voffA);
            PG8_BAR; PG8_WAIT_L(0); PG8_MMA(1, 0, At, B0); PG8_BAR; PG8_SCHED;
            PG8_STAGE(PG8_SB(1, 1), b3 + hstepB, voffB);
            PG8_WAIT_V(6); PG8_BAR; PG8_MMA(1, 1, At, B1); PG8_BAR;
            }
        }
        if constexpr (ALIGN_EPI) { if (wr == 0) PG8_BAR; }
        if constexpr (!Epi::AFTER_DRAIN) { E(acc, cur, wr, wc, fr, fq); S.done(cur); }
        if (!has_next) break;
#pragma unroll
        for (int a = 0; a < 2; ++a)
#pragma unroll
            for (int b = 0; b < 2; ++b)
#pragma unroll
                for (int m = 0; m < 4; ++m)
#pragma unroll
                    for (int n = 0; n < 2; ++n) acc[a][b][m][n] = (f32x4){0.f, 0.f, 0.f, 0.f};
        cur = nxt; cA = nA; cB = nB; ++ui;
        if constexpr (ALIGN_EPI) { if (wr == 1) PG8_BAR; }
    }
    PG8_WAIT_V(0);
    if constexpr (!ALIGN_EPI) { if (wr == 0) PG8_BAR; }
    PG8_BAR;
    if constexpr (Epi::AFTER_DRAIN) { E.fused(acc, cur, wr, wc, fr, fq, lds, wid, lane); S.done(cur); }
#undef PG8_SA
#undef PG8_SB
#undef PG8_STAGE
#undef PG8_LDA
#undef PG8_LDB
#undef PG8_MMA
#undef PG8_WAIT_V
#undef PG8_WAIT_L
#undef PG8_BAR
#undef PG8_SCHED
}
}


__device__ __forceinline__ unsigned pk2(float lo, float hi) { return f2bf(lo) | (f2bf(hi) << 16); }
template <class CM>
__device__ __forceinline__ void transpose_item(const float* __restrict__ Wsrc, int K, int ldsrc, bf16_t* __restrict__ WT, int nblk, LAS float* scr, int item, int lane, CM colmap, const float* __restrict__ kscale = nullptr) {
    const int kb = item / nblk, nb = item % nblk, k0 = 64 * kb, n0 = 32 * nb;
    const int sc = colmap(n0 + (lane & 31));
#pragma unroll 8
    for (int i = 0; i < 32; ++i) { const int kk = 2 * i + (lane >> 5); scr[kk * 33 + (lane & 31)] = sc >= 0 ? Wsrc[(size_t)(k0 + kk) * ldsrc + sc] * (kscale ? kscale[k0 + kk] : 1.f) : 0.f; }
    asm volatile("s_waitcnt lgkmcnt(0)" ::: "memory");
    const int c = lane & 7;
#pragma unroll
    for (int j = 0; j < 4; ++j) { const int n = (lane >> 3) + 8 * j; const LAS float* s = scr + (8 * c) * 33 + n;
        uint4 o; o.x = pk2(s[0 * 33], s[1 * 33]); o.y = pk2(s[2 * 33], s[3 * 33]); o.z = pk2(s[4 * 33], s[5 * 33]); o.w = pk2(s[6 * 33], s[7 * 33]);
        *(uint4*)(WT + (size_t)(n0 + n) * K + k0 + 8 * c) = o; }
    asm volatile("s_waitcnt lgkmcnt(0)" ::: "memory");
}
constexpr size_t WO_IN = 0;
constexpr size_t WO_BR = WO_IN + (size_t)7168 * 1024;
constexpr size_t WO_OUT = WO_BR + (size_t)4 * 1024 * 256;
constexpr size_t WO_W1 = WO_OUT + (size_t)1024 * 1024;
constexpr size_t WO_W2 = WO_W1 + (size_t)4096 * 1024;
constexpr size_t WO_WUP = WO_W2 + (size_t)4096 * 1024;
constexpr size_t WO_AUP = WO_WUP + 256 * 64;
constexpr size_t WO_GUP = WO_AUP + 256 * 64;
constexpr size_t WO_GLU = WO_GUP + 256 * 128;
constexpr size_t WO_LWT = WO_GLU + 256 * 256;
constexpr size_t WO_S5B = WO_LWT + 2 * 16384;
constexpr size_t WO_S5C = WO_S5B + 16 * 8 * 64 * 8;
constexpr size_t WO_LAYER = WO_S5C + 16 * 4 * 64 * 8;
__device__ __forceinline__ void convert_weights(const Params& p, int l, LAS float* scr, int gw, int ngw, int lane) {
    bf16_t* WB = (bf16_t*)(p.ws() + WS_W);
    constexpr int I_IN = (1024 / 64) * (7168 / 32), I_BR = (256 / 64) * (1024 / 32), I_OUT = (1024 / 64) * (1024 / 32), I_W1 = (1024 / 64) * (4096 / 32), I_W2 = (4096 / 64) * (1024 / 32);
    constexpr int I_UP = 8, I_GUP = 16, I_GLU = 4 * 8, I_LW = 16, I_S5B = 128, I_S5C = 64;
    constexpr int PER_LAYER = I_IN + 4 * I_BR + I_OUT + I_W1 + I_W2 + 2 * I_UP + I_GUP + I_GLU + I_LW + I_S5B + I_S5C;
    for (int it = gw; it < PER_LAYER; it += ngw) {
        int r = it;
        bf16_t* WL = WB;
        if (r < I_IN) { transpose_item(p.in[2] + (size_t)l * D * DIN, 1024, DIN, WL + WO_IN, 7168 / 32, scr, r, lane, [](int j) { return j < NMIX ? j : (j < 3072 ? -1 : j - 248); }); continue; } r -= I_IN;
        if (r < 4 * I_BR) { const int i = r / I_BR; transpose_item(p.in[35] + ((size_t)l * 4 + i) * W * D, 256, D, WL + WO_BR + (size_t)i * 1024 * 256, 1024 / 32, scr, r % I_BR, lane, [](int j) { return j; }); continue; } r -= 4 * I_BR;
        if (r < I_OUT) { transpose_item(p.in[36] + (size_t)l * D * D, 1024, D, WL + WO_OUT, 1024 / 32, scr, r, lane, [](int j) { return j; }); continue; } r -= I_OUT;
        if (r < I_W1) { transpose_item(p.in[38] + (size_t)l * D * DFF, 1024, DFF, WL + WO_W1, 4096 / 32, scr, r, lane, [](int j) { return j; }, p.in[37] + l * D); continue; } r -= I_W1;
        if (r < I_W2) { transpose_item(p.in[39] + (size_t)l * DFF * D, 4096, D, WL + WO_W2, 1024 / 32, scr, r, lane, [](int j) { return j; }); continue; } r -= I_W2;
        if (r < I_UP) { transpose_item(p.in[26] + (size_t)l * 64 * W, 64, W, WL + WO_WUP, 8, scr, r, lane, [](int j) { return j; }); continue; } r -= I_UP;
        if (r < I_UP) { transpose_item(p.in[28] + (size_t)l * 64 * W, 64, W, WL + WO_AUP, 8, scr, r, lane, [](int j) { return j; }); continue; } r -= I_UP;
        if (r < I_GUP) { transpose_item(p.in[29] + (size_t)l * 128 * W, 128, W, WL + WO_GUP, 8, scr, r, lane, [](int j) { return j; }); continue; } r -= I_GUP;
        if (r < I_GLU) { transpose_item(p.in[22] + (size_t)l * W * W, 256, W, WL + WO_GLU, 8, scr, r, lane, [](int j) { return j; }); continue; } r -= I_GLU;
        if (r < I_LW) { const int gt = r >> 3, nb = (r >> 1) & 3; transpose_item((gt ? p.in[11] : p.in[9]) + (size_t)l * 16384 + nb * 4096, 64, 64, WL + WO_LWT + (size_t)gt * 16384 + nb * 4096, 2, scr, r & 1, lane, [](int j) { return j; }); continue; } r -= I_LW;
        if (r < I_S5B) {
            const int g = r >> 3, tn = r & 7, q4 = lane >> 4, cc = lane & 15, n = 16 * tn + cc, pp = n >> 1, ri = n & 1;
            const float dt = __expf(p.in[21][l * 16 + g]);
            const float lre = p.in[14][l * 1024 + g * 64 + pp], lim = p.in[15][l * 1024 + g * 64 + pp];
            const float er = __expf(lre * dt), lbr = er * cosf(lim * dt), lbi = er * sinf(lim * dt);
            const float nr = lbr - 1.f, ni = lbi, den = lre * lre + lim * lim;
            const float fr = (nr * lre + ni * lim) / den, fi = (ni * lre - nr * lim) / den;
            float v[8];
#pragma unroll
            for (int j = 0; j < 8; ++j) { float x = 0.f;
                if (q4 < 2) { const float br = p.in[16][(size_t)l * 16384 + (g * 64 + pp) * 16 + 8 * q4 + j], bi = p.in[17][(size_t)l * 16384 + (g * 64 + pp) * 16 + 8 * q4 + j]; x = ri ? (fr * bi + fi * br) : (fr * br - fi * bi); }
                v[j] = x; }
            *(uint4*)(WL + WO_S5B + ((size_t)(g * 8 + tn) * 64 + lane) * 8) = make_uint4(pk2(v[0], v[1]), pk2(v[2], v[3]), pk2(v[4], v[5]), pk2(v[6], v[7]));
            continue; } r -= I_S5B;
        {
            const int g = r >> 2, ks = r & 3, q4 = lane >> 4, cc = lane & 15;
            const float* cre = p.in[18] + (size_t)l * 16384 + (g * 16 + cc) * 64 + 16 * ks + 4 * q4; const float* cim = p.in[19] + (size_t)l * 16384 + (g * 16 + cc) * 64 + 16 * ks + 4 * q4;
            *(uint4*)(WL + WO_S5C + ((size_t)(g * 4 + ks) * 64 + lane) * 8) = make_uint4(pk2(cre[0], -cim[0]), pk2(cre[1], -cim[1]), pk2(cre[2], -cim[2]), pk2(cre[3], -cim[3]));
        }
    }
}
#define BAR() do { asm volatile("s_waitcnt lgkmcnt(0)" ::: "memory"); __syncthreads(); } while (0)
typedef short bf16x8_t __attribute__((ext_vector_type(8)));
typedef float f32x4_t __attribute__((ext_vector_type(4)));
constexpr int PT = 68;
constexpr int MS = 64 * PT;
typedef __bf16 bf16x2v_t __attribute__((ext_vector_type(2)));
typedef float f32x2v_t __attribute__((ext_vector_type(2)));
__device__ __forceinline__ unsigned cvtpk(float lo, float hi) { return __builtin_bit_cast(unsigned, __builtin_convertvector((f32x2v_t){lo, hi}, bf16x2v_t)); }
typedef unsigned u32x4_t __attribute__((ext_vector_type(4)));
union U8 { bf16x8_t v; unsigned u[4]; uint4 q; u32x4_t x; };
__device__ __forceinline__ void split8(const float (&x)[8], bf16x8_t& hi, bf16x8_t& lo) {
    U8 H, L;
#pragma unroll
    for (int i = 0; i < 4; ++i) {
        const unsigned pk = cvtpk(x[2 * i], x[2 * i + 1]);
        H.u[i] = pk;
        const float f0 = __uint_as_float(pk << 16), f1 = __uint_as_float(pk & 0xffff0000u);
        L.u[i] = cvtpk(x[2 * i] - f0, x[2 * i + 1] - f1);
    }
    hi = H.v; lo = L.v;
}
__device__ __forceinline__ bf16x8_t hi8(const float (&x)[8]) {
    U8 H;
#pragma unroll
    for (int i = 0; i < 4; ++i) H.u[i] = cvtpk(x[2 * i], x[2 * i + 1]);
    return H.v;
}
template <int NSPLIT>
__device__ __forceinline__ f32x4_t mm_tile(const LAS float* A, const LAS float* Bt, int lane, f32x4_t acc) {
    const LAS float* ap = A + (lane & 15) * PT + 8 * (lane >> 4);
    const LAS float* bp = Bt + (lane & 15) * PT + 8 * (lane >> 4);
#pragma unroll
    for (int ks = 0; ks < 2; ++ks) {
        const f32x4_t a0 = *(const LAS f32x4_t*)(ap + 32 * ks), a1 = *(const LAS f32x4_t*)(ap + 32 * ks + 4);
        const f32x4_t b0 = *(const LAS f32x4_t*)(bp + 32 * ks), b1 = *(const LAS f32x4_t*)(bp + 32 * ks + 4);
        const float av[8] = {a0.x, a0.y, a0.z, a0.w, a1.x, a1.y, a1.z, a1.w};
        const float bv[8] = {b0.x, b0.y, b0.z, b0.w, b1.x, b1.y, b1.z, b1.w};
        if constexpr (NSPLIT == 3) {
            bf16x8_t ah, al, bh, bl; split8(av, ah, al); split8(bv, bh, bl);
            acc = __builtin_amdgcn_mfma_f32_16x16x32_bf16(ah, bh, acc, 0, 0, 0);
            acc = __builtin_amdgcn_mfma_f32_16x16x32_bf16(ah, bl, acc, 0, 0, 0);
            acc = __builtin_amdgcn_mfma_f32_16x16x32_bf16(al, bh, acc, 0, 0, 0);
        } else {
            acc = __builtin_amdgcn_mfma_f32_16x16x32_bf16(hi8(av), hi8(bv), acc, 0, 0, 0);
        }
    }
    return acc;
}
__device__ __forceinline__ int opq_tid() { int t = threadIdx.x; asm volatile("" : "+v"(t)); return t; }
__device__ __forceinline__ void tri_inverse_wave(LAS float* L, int lane) {
    asm volatile("" : "+v"(lane));
    asm volatile("" : "+v"(L));
    const float lf = (float)lane;
    float x[64];
#pragma unroll
    for (int i = 0; i < 64; ++i) {
        float s0 = 0.f, s1 = 0.f, s2 = 0.f, s3 = 0.f;
#pragma unroll
        for (int g4 = 0; g4 * 4 < i; ++g4) {
            const f32x4_t l = *(const LAS f32x4_t*)(L + i * PT + 4 * g4);
            s0 = fmaf(l.x, x[4 * g4], s0);
            if (4 * g4 + 1 < i) s1 = fmaf(l.y, x[4 * g4 + 1], s1);
            if (4 * g4 + 2 < i) s2 = fmaf(l.z, x[4 * g4 + 2], s2);
            if (4 * g4 + 3 < i) s3 = fmaf(l.w, x[4 * g4 + 3], s3);
        }
        x[i] = fmaxf(1.f - fabsf(lf - (float)i), 0.f) - ((s0 + s1) + (s2 + s3));
        L[i * PT + lane] = x[i];
        if ((i & 3) == 3) __builtin_amdgcn_sched_barrier(0);
    }
}
__device__ __forceinline__ float wave_incl_scan(float v, int lane) {
#pragma unroll
    for (int o = 1; o < 64; o <<= 1) { const float u = __shfl_up(v, o); if (lane >= o) v += u; }
    return v;
}

__device__ __forceinline__ void unpack8(const uint4 u, float (&o)[8]) {
    const unsigned w[4] = {u.x, u.y, u.z, u.w};
#pragma unroll
    for (int i = 0; i < 4; ++i) { o[2 * i] = __uint_as_float(w[i] << 16); o[2 * i + 1] = __uint_as_float(w[i] & 0xffff0000u); }
}
__device__ __forceinline__ uint4 pack8(const float (&x)[8]) { return make_uint4(cvtpk(x[0], x[1]), cvtpk(x[2], x[3]), cvtpk(x[4], x[5]), cvtpk(x[6], x[7])); }
typedef unsigned short LAS lds_bf16;
constexpr int MIX_LDS_C = 8 * MS * 4 + 1024;
__device__ __forceinline__ void merge_phase(const bf16_t* __restrict__ Yb, const bf16_t* __restrict__ WbT, const bf16_t* __restrict__ G, bf16_t* __restrict__ MG, LAS unsigned char* lds) {
    const int tid = opq_tid(), w = __builtin_amdgcn_readfirstlane(tid >> 6), lane = tid & 63, q4 = lane >> 4, cc = lane & 15;
    const int wr = w >> 2, wc = w & 3;
    constexpr int PA = 144;
    constexpr int ABUF = 128 * PA, BUF = 2 * ABUF;
    const int bid = blockIdx.x, G_ = gridDim.x;
    const int srow = tid >> 2, sk = (tid & 3) * 16;
#define MG_TILE(it_, pm_, pn_, ok_) do { const int U_ = (it_) * G_ + bid; ok_ = U_ < 1024; const int Lx_ = (G_ == 256) ? ((bid & 7) * 128 + (it_) * 32 + (bid >> 3)) : U_; pm_ = (Lx_ >> 3) & 127; pn_ = Lx_ & 7; } while (0)
    int pm, pn; bool ok; MG_TILE(0, pm, pn, ok);
    if (!ok) return;
    const bf16_t* Abase = Yb + (size_t)(pm * 128 + srow) * 1024 + sk;
    const bf16_t* Bbase = WbT + (size_t)(pn * 128 + srow) * 256 + sk;
    const bf16_t* gbase = G + (size_t)(pm * 128 + wr * 64 + cc) * 4096 + pn * 128 + wc * 32 + 4 * q4;
    uint4 r0[4], r1[4];
    uint2 gq[4][2];
#define MG_LOAD(R, ab_, bb_, s_) do { const bf16_t* ap_ = (ab_) + ((s_) >> 2) * 256 + ((s_) & 3) * 64; const bf16_t* bp_ = (bb_) + (size_t)((s_) >> 2) * 1024 * 256 + ((s_) & 3) * 64; \
            R[0] = *(const uint4*)ap_; R[1] = *(const uint4*)(ap_ + 8); R[2] = *(const uint4*)bp_; R[3] = *(const uint4*)(bp_ + 8); } while (0)
#define MG_GLOAD(GQ, gp_) do { _Pragma("unroll") for (int m = 0; m < 4; ++m) _Pragma("unroll") for (int n = 0; n < 2; ++n) GQ[m][n] = *(const uint2*)((gp_) + (size_t)m * 16 * 4096 + n * 16); } while (0)
#define MG_STORE(R, buf_) do { LAS unsigned char* ab_ = lds + (buf_) * BUF + srow * PA + sk * 2; \
            *(LAS u32x4_t*)ab_ = (u32x4_t){R[0].x, R[0].y, R[0].z, R[0].w}; *(LAS u32x4_t*)(ab_ + 16) = (u32x4_t){R[1].x, R[1].y, R[1].z, R[1].w}; \
            *(LAS u32x4_t*)(ab_ + ABUF) = (u32x4_t){R[2].x, R[2].y, R[2].z, R[2].w}; *(LAS u32x4_t*)(ab_ + ABUF + 16) = (u32x4_t){R[3].x, R[3].y, R[3].z, R[3].w}; } while (0)
#define MG_COMPUTE(buf_) do { const LAS unsigned char* ab_ = lds + (buf_) * BUF + (wr * 64 + cc) * PA + 16 * q4; const LAS unsigned char* bb_ = lds + (buf_) * BUF + ABUF + (wc * 32 + cc) * PA + 16 * q4; \
            _Pragma("unroll") for (int ks = 0; ks < 2; ++ks) { U8 bf_[2]; \
                _Pragma("unroll") for (int n = 0; n < 2; ++n) bf_[n].x = *(const LAS u32x4_t*)(bb_ + n * 16 * PA + ks * 64); \
                _Pragma("unroll") for (int m = 0; m < 4; ++m) { U8 af_; af_.x = *(const LAS u32x4_t*)(ab_ + m * 16 * PA + ks * 64); \
                    _Pragma("unroll") for (int n = 0; n < 2; ++n) acc[m][n] = __builtin_amdgcn_mfma_f32_16x16x32_bf16(bf_[n].v, af_.v, acc[m][n], 0, 0, 0); } } } while (0)
#define MG_STEP(j_, RL, RS) do { \
            if (((j_) & 3) == 0) { _Pragma("unroll") for (int m = 0; m < 4; ++m) _Pragma("unroll") for (int n = 0; n < 2; ++n) acc[m][n] = (f32x4_t){0.f, 0.f, 0.f, 0.f}; } \
            if ((j_) + 2 < 4) MG_LOAD(RL, Ae, Be, (j_) + 2); else if ((j_) + 2 < 8) MG_LOAD(RL, Ae + 256, Bo, (j_) + 2 - 4); else MG_LOAD(RL, An, Bn, (j_) + 2 - 8); \
            MG_COMPUTE((j_) & 1); \
            if (((j_) & 3) == 3) { \
                _Pragma("unroll") for (int m = 0; m < 4; ++m) _Pragma("unroll") for (int n = 0; n < 2; ++n) { uint2 g2_ = gq[m][n]; asm volatile("" : "+v"(g2_.x), "+v"(g2_.y));     \
                    mg[m][n][0] = fmaf(__uint_as_float(g2_.x << 16), acc[m][n][0], mg[m][n][0]); mg[m][n][1] = fmaf(__uint_as_float(g2_.x & 0xffff0000u), acc[m][n][1], mg[m][n][1]); \
                    mg[m][n][2] = fmaf(__uint_as_float(g2_.y << 16), acc[m][n][2], mg[m][n][2]); mg[m][n][3] = fmaf(__uint_as_float(g2_.y & 0xffff0000u), acc[m][n][3], mg[m][n][3]); } \
                if ((j_) == 3) MG_GLOAD(gq, ge + 1024); else MG_GLOAD(gq, gn); } \
            MG_STORE(RS, ((j_) + 1) & 1); \
            BAR(); } while (0)
    MG_LOAD(r0, Abase, Bbase, 0); MG_LOAD(r1, Abase, Bbase, 1); MG_GLOAD(gq, gbase);
    MG_STORE(r0, 0);
    BAR();
#pragma unroll 1
    for (int it = 0; ; ++it) {
        int npm, npn; bool has_next; MG_TILE(it + 1, npm, npn, has_next);
        if (!has_next) { npm = pm; npn = pn; }
        const bf16_t* nAbase = Yb + (size_t)(npm * 128 + srow) * 1024 + sk;
        const bf16_t* nBbase = WbT + (size_t)(npn * 128 + srow) * 256 + sk;
        const bf16_t* ngbase = G + (size_t)(npm * 128 + wr * 64 + cc) * 4096 + npn * 128 + wc * 32 + 4 * q4;
        f32x4_t mg[4][2], acc[4][2];
#pragma unroll
        for (int m = 0; m < 4; ++m)
#pragma unroll
            for (int n = 0; n < 2; ++n) { mg[m][n] = (f32x4_t){0.f, 0.f, 0.f, 0.f}; acc[m][n] = (f32x4_t){0.f, 0.f, 0.f, 0.f}; }
#pragma unroll 1
        for (int h = 0; h < 2; ++h) {
            const bf16_t* Ae = Abase + h * 512; const bf16_t* Be = Bbase + (size_t)h * 2 * 1024 * 256; const bf16_t* Bo = Be + 1024 * 256; const bf16_t* ge = gbase + h * 2048;
            const bf16_t* An = h ? nAbase : Abase + 512; const bf16_t* Bn = h ? nBbase : Bbase + (size_t)2 * 1024 * 256; const bf16_t* gn = h ? ngbase : gbase + 2048;
            MG_STEP(0, r0, r1); MG_STEP(1, r1, r0); MG_STEP(2, r0, r1); MG_STEP(3, r1, r0);
            MG_STEP(4, r0, r1); MG_STEP(5, r1, r0); MG_STEP(6, r0, r1); MG_STEP(7, r1, r0);
        }
        {
            bf16_t* op = MG + (size_t)(pm * 128 + wr * 64 + cc) * 1024 + pn * 128 + wc * 32 + 4 * q4;
#pragma unroll
            for (int m = 0; m < 4; ++m)
#pragma unroll
                for (int n = 0; n < 2; ++n) *(uint2*)(op + (size_t)m * 16 * 1024 + n * 16) = make_uint2(cvtpk(mg[m][n][0], mg[m][n][1]), cvtpk(mg[m][n][2], mg[m][n][3]));
        }
        if (!has_next) break;
        pm = npm; pn = npn; Abase = nAbase; Bbase = nBbase; gbase = ngbase;
    }
#undef MG_TILE
#undef MG_LOAD
#undef MG_GLOAD
#undef MG_STORE
#undef MG_COMPUTE
#undef MG_STEP
}

constexpr int PB = 72;
constexpr int PLBYTES = 64 * PB * 2;
typedef unsigned u32x2_t __attribute__((ext_vector_type(2)));
__device__ __forceinline__ lds_bf16* plane(LAS unsigned char* lds, int i) { return (lds_bf16*)(lds + i * PLBYTES); }
__device__ __forceinline__ void hilo2(float a, float b, unsigned& h, unsigned& l) { h = cvtpk(a, b); l = cvtpk(a - __uint_as_float(h << 16), b - __uint_as_float(h & 0xffff0000u)); }
__device__ __forceinline__ unsigned short bf_hi(float v) { return (unsigned short)(cvtpk(v, 0.f) & 0xffffu); }
template <bool LO>
__device__ __forceinline__ void put8(lds_bf16* Ph, lds_bf16* Pl, int r, int c0, const float (&x)[8]) {
    unsigned h[4], l[4];
#pragma unroll
    for (int i = 0; i < 4; ++i) hilo2(x[2 * i], x[2 * i + 1], h[i], l[i]);
    *(LAS u32x4_t*)(Ph + r * PB + c0) = (u32x4_t){h[0], h[1], h[2], h[3]};
    if (LO) *(LAS u32x4_t*)(Pl + r * PB + c0) = (u32x4_t){l[0], l[1], l[2], l[3]};
}
template <bool LO>
__device__ __forceinline__ void put8T(lds_bf16* Ph, lds_bf16* Pl, int r, int c0, const float (&x)[8]) {
#pragma unroll
    for (int i = 0; i < 4; ++i) {
        unsigned h, l; hilo2(x[2 * i], x[2 * i + 1], h, l);
        Ph[(c0 + 2 * i) * PB + r] = (unsigned short)(h & 0xffffu); Ph[(c0 + 2 * i + 1) * PB + r] = (unsigned short)(h >> 16);
        if (LO) { Pl[(c0 + 2 * i) * PB + r] = (unsigned short)(l & 0xffffu); Pl[(c0 + 2 * i + 1) * PB + r] = (unsigned short)(l >> 16); }
    }
}
__device__ __forceinline__ bf16x8_t frag(const lds_bf16* P, int row, int k) { U8 u; u.x = *(const LAS u32x4_t*)(P + row * PB + k); return u.v; }
template <bool AL, bool BL>
__device__ __forceinline__ f32x4_t mmp(const lds_bf16* Ah, const lds_bf16* Al, const lds_bf16* Bh, const lds_bf16* Bl, int ar0, int br0, int lane, f32x4_t acc) {
    const int r = lane & 15, k0 = 8 * (lane >> 4);
#pragma unroll
    for (int ks = 0; ks < 2; ++ks) {
        const bf16x8_t ah = frag(Ah, ar0 + r, 32 * ks + k0), bh = frag(Bh, br0 + r, 32 * ks + k0);
        acc = __builtin_amdgcn_mfma_f32_16x16x32_bf16(ah, bh, acc, 0, 0, 0);
        if (AL) acc = __builtin_amdgcn_mfma_f32_16x16x32_bf16(frag(Al, ar0 + r, 32 * ks + k0), bh, acc, 0, 0, 0);
        if (BL) acc = __builtin_amdgcn_mfma_f32_16x16x32_bf16(ah, frag(Bl, br0 + r, 32 * ks + k0), acc, 0, 0, 0);
    }
    return acc;
}
template <bool LO>
__device__ __forceinline__ void st_tile_T(lds_bf16* Ph, lds_bf16* Pl, int i0, int j0, int lane, const f32x4_t a) {
    unsigned h0, l0, h1, l1; hilo2(a[0], a[1], h0, l0); hilo2(a[2], a[3], h1, l1);
    const int o = (j0 + (lane & 15)) * PB + i0 + 4 * (lane >> 4);
    *(LAS u32x2_t*)(Ph + o) = (u32x2_t){h0, h1};
    if (LO) *(LAS u32x2_t*)(Pl + o) = (u32x2_t){l0, l1};
}
template <bool LO>
__device__ __forceinline__ void st_tile_R(lds_bf16* Ph, lds_bf16* Pl, int i0, int j0, int lane, const f32x4_t a) {
    unsigned h0, l0, h1, l1; hilo2(a[0], a[1], h0, l0); hilo2(a[2], a[3], h1, l1);
    const int o = (i0 + 4 * (lane >> 4)) * PB + j0 + (lane & 15);
    Ph[o] = (unsigned short)(h0 & 0xffffu); Ph[o + PB] = (unsigned short)(h0 >> 16); Ph[o + 2 * PB] = (unsigned short)(h1 & 0xffffu); Ph[o + 3 * PB] = (unsigned short)(h1 >> 16);
    if (LO) { Pl[o] = (unsigned short)(l0 & 0xffffu); Pl[o + PB] = (unsigned short)(l0 >> 16); Pl[o + 2 * PB] = (unsigned short)(l1 & 0xffffu); Pl[o + 3 * PB] = (unsigned short)(l1 >> 16); }
}
constexpr int LM_OFF = 13 * PLBYTES;
constexpr int VEC_OFF = LM_OFF + MS * 4;
static_assert(VEC_OFF + 1024 <= MIX_LDS_C, "plane LDS map");

struct GdnBufs { bf16_t *GQ, *GK, *GV; float *GB, *GC; uint4* MF; float* NF; float* HT; bf16_t* TG; };
__device__ __forceinline__ void gdn_prep_chunk(const bf16_t* __restrict__ PM, int n, const GdnBufs& B, const Params& p, int l, LAS float* lds) {
    const int tid = opq_tid(), w = tid >> 6, lane = tid & 63;
    const float* conv_w = p.in[3] + l * 4 * 768;
    const int t0 = n * 64;
    float wq[4][4], wk[4][4], wv[4][4];
#pragma unroll
    for (int t = 0; t < 4; ++t)
#pragma unroll
        for (int j = 0; j < 4; ++j) { wq[t][j] = conv_w[t * 768 + 4 * lane + j]; wk[t][j] = conv_w[t * 768 + 256 + 4 * lane + j]; wv[t][j] = conv_w[t * 768 + 512 + 4 * lane + j]; }
    float hq[3][4], hk[3][4], hv[3][4];
    auto ld4 = [&](int t, int col, float (&o)[4]) {
        if (t < 0) { o[0] = o[1] = o[2] = o[3] = 0.f; return; }
        const uint2 u = *(const uint2*)(PM + (size_t)t * PMLD + col);
        o[0] = __uint_as_float(u.x << 16); o[1] = __uint_as_float(u.x & 0xffff0000u); o[2] = __uint_as_float(u.y << 16); o[3] = __uint_as_float(u.y & 0xffff0000u);
    };
    const int tw = t0 + 8 * w;
#pragma unroll
    for (int i = 0; i < 3; ++i) { ld4(tw - 3 + i, 4 * lane, hq[i]); ld4(tw - 3 + i, 256 + 4 * lane, hk[i]); ld4(tw - 3 + i, 512 + 4 * lane, hv[i]); }
#pragma unroll
    for (int i = 0; i < 8; ++i) {
        const int t = tw + i;
        float pq[4], pk[4], pv[4], q[4], k[4], v[4];
        ld4(t, 4 * lane, pq); ld4(t, 256 + 4 * lane, pk); ld4(t, 512 + 4 * lane, pv);
        float sq = 0.f, sk = 0.f;
#pragma unroll
        for (int j = 0; j < 4; ++j) {
            q[j] = siluf_(wq[0][j] * hq[0][j] + wq[1][j] * hq[1][j] + wq[2][j] * hq[2][j] + wq[3][j] * pq[j]);
            k[j] = siluf_(wk[0][j] * hk[0][j] + wk[1][j] * hk[1][j] + wk[2][j] * hk[2][j] + wk[3][j] * pk[j]);
            v[j] = siluf_(wv[0][j] * hv[0][j] + wv[1][j] * hv[1][j] + wv[2][j] * hv[2][j] + wv[3][j] * pv[j]);
            hq[0][j] = hq[1][j]; hq[1][j] = hq[2][j]; hq[2][j] = pq[j];
            hk[0][j] = hk[1][j]; hk[1][j] = hk[2][j]; hk[2][j] = pk[j];
            hv[0][j] = hv[1][j]; hv[1][j] = hv[2][j]; hv[2][j] = pv[j];
            sq = fmaf(q[j], q[j], sq); sk = fmaf(k[j], k[j], sk);
        }
#pragma unroll
        for (int o = 1; o < 16; o <<= 1) { sq += __shfl_xor(sq, o); sk += __shfl_xor(sk, o); }
        const float rq = rsqrtf(sq + 1e-6f) * 0.125f, rk = rsqrtf(sk + 1e-6f);
        uint2 oq, ok, ov;
        oq.x = cvtpk(q[0] * rq, q[1] * rq); oq.y = cvtpk(q[2] * rq, q[3] * rq);
        ok.x = cvtpk(k[0] * rk, k[1] * rk); ok.y = cvtpk(k[2] * rk, k[3] * rk);
        ov.x = cvtpk(v[0], v[1]); ov.y = cvtpk(v[2], v[3]);
        *(uint2*)(B.GQ + (size_t)t * 256 + 4 * lane) = oq;
        *(uint2*)(B.GK + (size_t)t * 256 + 4 * lane) = ok;
        *(uint2*)(B.GV + (size_t)t * 256 + 4 * lane) = ov;
    }
    if (tid < 256) {
        const int t = tid >> 2, h = tid & 3;
        const bf16_t* row = PM + (size_t)(t0 + t) * PMLD;
        B.GB[(size_t)(t0 + t) * 4 + h] = sigmoidf_(bf2f(row[1024 + h]));
        const float* alog_ = p.in[4] + l * 4; const float* dtb_ = p.in[5] + l * 4;
        const float g = -__expf(alog_[h]) * softplusf_(bf2f(row[1028 + h]) + dtb_[h]);
        lds[h * 64 + t] = g;
    }
    BAR();
    if (w == 0) {
#pragma unroll
        for (int h = 0; h < 4; ++h) B.GC[(size_t)(t0 + lane) * 4 + h] = wave_incl_scan(lds[h * 64 + lane], lane);
    }
    BAR();
}

__device__ __forceinline__ float dpp_xor1(float v) { return __int_as_float(__builtin_amdgcn_update_dpp(0, __float_as_int(v), 0xB1, 0xF, 0xF, false)); }
__device__ __forceinline__ float dpp_xor2(float v) { return __int_as_float(__builtin_amdgcn_update_dpp(0, __float_as_int(v), 0x4E, 0xF, 0xF, false)); }
__device__ __forceinline__ void tri_inverse_4w(const LAS float* Lp, lds_bf16* Th, lds_bf16* Tl, int wq, int lane) {
    asm volatile("" : "+v"(lane));
    const int g = lane & 3, j = 16 * wq + (lane >> 2);
    const LAS float* base = Lp + g * 16; asm volatile("" : "+v"(base));
    const float jf = (float)j;
    float x[16];
#pragma unroll
    for (int m = 0; m < 16; ++m) x[m] = 0.f;
    f32x4_t cur[4], nxt[4];
#pragma unroll
    for (int q = 0; q < 4; ++q) cur[q] = (f32x4_t){0.f, 0.f, 0.f, 0.f};
#pragma unroll
    for (int i = 0; i < 64; ++i) {
        if (i + 1 < 64) {
#pragma unroll
            for (int q = 0; q < 4; ++q) if (16 * q < i + 1) nxt[q] = *(const LAS f32x4_t*)(base + (i + 1) * PT + 4 * q);
        }
        float s0 = 0.f, s1 = 0.f;
#pragma unroll
        for (int q = 0; q < 4; ++q) if (16 * q < i) {
            s0 = fmaf(cur[q].x, x[4 * q], s0); if (16 * q + 4 < i) s1 = fmaf(cur[q].y, x[4 * q + 1], s1);
            if (16 * q + 8 < i) s0 = fmaf(cur[q].z, x[4 * q + 2], s0); if (16 * q + 12 < i) s1 = fmaf(cur[q].w, x[4 * q + 3], s1);
        }
        float t = s0 + s1;
        t += dpp_xor1(t); t += dpp_xor2(t);
        const float xi = fmaxf(1.f - fabsf(jf - (float)i), 0.f) - t;
        if (g == (i & 3)) x[i >> 2] = xi;
        unsigned hh, ll; hilo2(xi, xi, hh, ll);
        if (g == 0) Th[i * PB + j] = (unsigned short)(hh & 0xffffu);
        if (g == 1) Tl[i * PB + j] = (unsigned short)(ll & 0xffffu);
#pragma unroll
        for (int q = 0; q < 4; ++q) cur[q] = nxt[q];
    }
}
__device__ __forceinline__ void gdn_g1_unit(int h, int n, const GdnBufs& B, bf16_t* __restrict__ Y, LAS unsigned char* lds) {
    const int tid = opq_tid(), w = tid >> 6, lane = tid & 63, q4 = lane >> 4, cc = lane & 15;
    lds_bf16 *Krh = plane(lds, 0), *Krl = plane(lds, 1), *KdTh = plane(lds, 2), *KdTl = plane(lds, 3), *KbTh = plane(lds, 4), *KbTl = plane(lds, 5);
    lds_bf16 *VbTh = plane(lds, 6), *VbTl = plane(lds, 7), *Th = plane(lds, 8), *Tl = plane(lds, 9), *WmTh = plane(lds, 10), *WmTl = plane(lds, 11);
    lds_bf16 *U0Th = Krh, *U0Tl = Krl;
    LAS float* Lm = (LAS float*)(lds + LM_OFF); LAS float* sb = (LAS float*)(lds + VEC_OFF); LAS float* sg = sb + 64;
    const int t0 = n * 64, u = h * 256 + n;
    const int c = tid >> 3, d0 = (tid & 7) * 8;
    {
        const float beta = B.GB[(size_t)(t0 + c) * 4 + h], gc = B.GC[(size_t)(t0 + c) * 4 + h], gl = B.GC[(size_t)(t0 + 63) * 4 + h];
        float kf[8], vf[8], x1[8], x2[8], x3[8];
        unpack8(*(const uint4*)(B.GK + (size_t)(t0 + c) * 256 + h * 64 + d0), kf);
        unpack8(*(const uint4*)(B.GV + (size_t)(t0 + c) * 256 + h * 64 + d0), vf);
        const float e1 = __expf(gl - gc), e2 = beta * __expf(gc);
#pragma unroll
        for (int i = 0; i < 8; ++i) { x1[i] = kf[i] * e1; x2[i] = kf[i] * e2; x3[i] = beta * vf[i]; }
        put8<true>(Krh, Krl, c, d0, kf); put8T<true>(KdTh, KdTl, c, d0, x1); put8T<true>(KbTh, KbTl, c, d0, x2); put8T<true>(VbTh, VbTl, c, d0, x3);
        if ((tid & 7) == 0) { sb[c] = beta; sg[c] = gc; }
    }
    BAR();
    const int ti = w >> 1, tj0 = (w & 1) * 2;
    const f32x4_t zero4 = {0.f, 0.f, 0.f, 0.f};
#pragma unroll
    for (int tt = 0; tt < 2; ++tt) {
        const int tj = tj0 + tt;
        const int j = 16 * tj + cc, jp = (j & 3) * 16 + (j >> 2);
        f32x4_t lv = zero4;
        if (tj <= ti) {
            const f32x4_t a = mmp<true, true>(Krh, Krl, Krh, Krl, 16 * ti, 16 * tj, lane, zero4);
            const float gj = sg[j];
#pragma unroll
            for (int r = 0; r < 4; ++r) { const int i = 16 * ti + 4 * q4 + r; lv[r] = (i > j) ? sb[i] * a[r] * __expf(sg[i] - gj) : 0.f; }
        }
#pragma unroll
        for (int r = 0; r < 4; ++r) Lm[(16 * ti + 4 * q4 + r) * PT + jp] = lv[r];
    }
    BAR();
    if (w < 4) tri_inverse_4w(Lm, Th, Tl, w, lane);
    BAR();
    { const u32x4_t t4 = *(const LAS u32x4_t*)(Th + c * PB + d0); *(uint4*)(B.TG + (size_t)u * 4096 + c * 64 + d0) = make_uint4(t4.x, t4.y, t4.z, t4.w);
      const u32x4_t t5 = *(const LAS u32x4_t*)(Tl + c * PB + d0); *(uint4*)(Y + (size_t)(t0 + c) * D + h * 64 + d0) = make_uint4(t5.x, t5.y, t5.z, t5.w); }
#pragma unroll
    for (int tt = 0; tt < 2; ++tt) {
        const int tj = tj0 + tt;
        st_tile_T<true>(U0Th, U0Tl, 16 * ti, 16 * tj, lane, mmp<true, true>(Th, Tl, VbTh, VbTl, 16 * ti, 16 * tj, lane, zero4));
        st_tile_T<true>(WmTh, WmTl, 16 * ti, 16 * tj, lane, mmp<true, true>(Th, Tl, KbTh, KbTl, 16 * ti, 16 * tj, lane, zero4));
    }
    BAR();
    {
        const float egl = __expf(B.GC[(size_t)(t0 + 63) * 4 + h]);
#pragma unroll
        for (int tt = 0; tt < 2; ++tt) {
            const int tj = tj0 + tt;
            const f32x4_t a = mmp<true, true>(KdTh, KdTl, WmTh, WmTl, 16 * ti, 16 * tj, lane, zero4);
#pragma unroll
            for (int r = 0; r < 4; ++r) { const int ar = 16 * ti + 4 * q4 + r, bc = 16 * tj + cc; Lm[ar * PT + bc] = (ar == bc ? egl : 0.f) - a[r]; }
            const f32x4_t nn = mmp<true, true>(KdTh, KdTl, U0Th, U0Tl, 16 * ti, 16 * tj, lane, zero4);
            *(float4*)(B.NF + (size_t)u * 4096 + (tj * 64 + lane) * 16 + ti * 4) = make_float4(nn[0], nn[1], nn[2], nn[3]);
        }
    }
    BAR();
    {
        const int combo = tid >> 6, mt = combo >> 1, s = combo & 1, i = lane & 15, qq = lane >> 4;
        const f32x4_t x0 = *(const LAS f32x4_t*)(Lm + (16 * mt + i) * PT + 32 * s + 4 * qq);
        const f32x4_t x1 = *(const LAS f32x4_t*)(Lm + (16 * mt + i) * PT + 32 * s + 16 + 4 * qq);
        const float xv[8] = {x0.x, x0.y, x0.z, x0.w, x1.x, x1.y, x1.z, x1.w};
        U8 H, L; split8(xv, H.v, L.v);
        uint4* mf = B.MF + (size_t)u * 1024 + (size_t)(combo * 2) * 64 + lane;
        mf[0] = H.q; mf[64] = L.q;
    }
    BAR();
}

constexpr int CH_SLOT = 20480, CH_RING = 6;
__device__ __forceinline__ void chain_wave(float* __restrict__ HT, int cb, int nchunk, int lane, LAS unsigned char* ring, volatile LAS unsigned* flags  ) {
    const int q4 = lane >> 4, cc = lane & 15;
    f32x4_t H[4];
#pragma unroll
    for (int m = 0; m < 4; ++m) H[m] = (f32x4_t){0.f, 0.f, 0.f, 0.f};
    U8 mf[16]; f32x4_t nf[4];
    {
        while (flags[0] != 1u) __builtin_amdgcn_s_sleep(1);
        asm volatile("" ::: "memory");
        const LAS unsigned char* sp = ring + lane * 16;
#pragma unroll
        for (int i = 0; i < 16; ++i) mf[i].x = *(const LAS u32x4_t*)(sp + i * 1024);
#pragma unroll
        for (int m = 0; m < 4; ++m) nf[m] = *(const LAS f32x4_t*)(sp + (16 + m) * 1024);
        asm volatile("s_waitcnt lgkmcnt(0)" ::: "memory");
        if (lane == 0) flags[8] = 1u;
    }
    for (int ch = 0; ch < nchunk; ++ch) {
        float* ht = HT + (size_t)ch * 4096 + (16 * cb + cc) * 64 + 4 * q4;
#pragma unroll
        for (int m = 0; m < 4; ++m) *(float4*)(ht + 16 * m) = make_float4(H[m][0], H[m][1], H[m][2], H[m][3]);
        bf16x8_t bh[2], bl[2];
#pragma unroll
        for (int s = 0; s < 2; ++s) {
            const float xv[8] = {H[2 * s][0], H[2 * s][1], H[2 * s][2], H[2 * s][3], H[2 * s + 1][0], H[2 * s + 1][1], H[2 * s + 1][2], H[2 * s + 1][3]};
            split8(xv, bh[s], bl[s]);
        }
#pragma unroll
        for (int m = 0; m < 4; ++m) {
            f32x4_t acc = nf[m];
#pragma unroll
            for (int s = 0; s < 2; ++s) {
                acc = __builtin_amdgcn_mfma_f32_16x16x32_bf16(mf[(m * 2 + s) * 2].v, bh[s], acc, 0, 0, 0);
                acc = __builtin_amdgcn_mfma_f32_16x16x32_bf16(mf[(m * 2 + s) * 2].v, bl[s], acc, 0, 0, 0);
                acc = __builtin_amdgcn_mfma_f32_16x16x32_bf16(mf[(m * 2 + s) * 2 + 1].v, bh[s], acc, 0, 0, 0);
            }
            H[m] = acc;
        }
        if (ch + 1 < nchunk) {
            const int slot = (ch + 1) % CH_RING;
            while (flags[slot] != (unsigned)(ch + 2)) __builtin_amdgcn_s_sleep(1);
            asm volatile("" ::: "memory");
            const LAS unsigned char* sp = ring + slot * CH_SLOT + lane * 16;
#pragma unroll
            for (int i = 0; i < 16; ++i) mf[i].x = *(const LAS u32x4_t*)(sp + i * 1024);
#pragma unroll
            for (int m = 0; m < 4; ++m) nf[m] = *(const LAS f32x4_t*)(sp + (16 + m) * 1024);
            asm volatile("s_waitcnt lgkmcnt(0)" ::: "memory");
            if (lane == 0) flags[8] = (unsigned)(ch + 2);
        }
    }
}
__device__ __forceinline__ void chain_loader(const uint4* __restrict__ MF, const float* __restrict__ NF, int cb, int nchunk, int lane, int lw, LAS unsigned char* ring, volatile LAS unsigned* flags) {
    for (int ch = lw; ch < nchunk; ch += 7) {
        uint4 m[16]; float4 nn[4];
#pragma unroll
        for (int i = 0; i < 16; ++i) m[i] = MF[(size_t)ch * 1024 + (size_t)i * 64 + lane];
#pragma unroll
        for (int k = 0; k < 4; ++k) nn[k] = *(const float4*)(NF + (size_t)ch * 4096 + (cb * 64 + lane) * 16 + k * 4);
        while ((int)flags[8] + CH_RING <= ch) __builtin_amdgcn_s_sleep(2);
        asm volatile("" ::: "memory");
        LAS unsigned char* sp = ring + (ch % CH_RING) * CH_SLOT + lane * 16;
#pragma unroll
        for (int i = 0; i < 16; ++i) *(LAS u32x4_t*)(sp + i * 1024) = (u32x4_t){m[i].x, m[i].y, m[i].z, m[i].w};
#pragma unroll
        for (int k = 0; k < 4; ++k) *(LAS f32x4_t*)(sp + (16 + k) * 1024) = (f32x4_t){nn[k].x, nn[k].y, nn[k].z, nn[k].w};
        asm volatile("s_waitcnt lgkmcnt(0)" ::: "memory");
        if (lane == 0) flags[ch % CH_RING] = (unsigned)(ch + 1);
    }
}

__device__ __forceinline__ void gdn_g3_unit(int h, int n, const GdnBufs& B, const bf16_t* __restrict__ PM, bf16_t* __restrict__ Y, const float* __restrict__ norm_g, LAS unsigned char* lds) {
    const int tid = opq_tid(), w = tid >> 6, lane = tid & 63, q4 = lane >> 4, cc = lane & 15;
    lds_bf16 *Qr = plane(lds, 0), *Qd = plane(lds, 1), *Kr = plane(lds, 2), *KbT = plane(lds, 3), *VbT = plane(lds, 4), *Tp = plane(lds, 5);
    lds_bf16 *At = plane(lds, 6), *Wm = plane(lds, 7), *HTh = plane(lds, 8), *HTl = plane(lds, 9), *VnT = plane(lds, 10), *Tq = plane(lds, 11);
    LAS float* Os = (LAS float*)(lds + LM_OFF); LAS float* sb = (LAS float*)(lds + VEC_OFF); LAS float* sg = sb + 64;
    const int t0 = n * 64, u = h * 256 + n;
    const int c = tid >> 3, d0 = (tid & 7) * 8;
    {
        const float beta = B.GB[(size_t)(t0 + c) * 4 + h], gc = B.GC[(size_t)(t0 + c) * 4 + h];
        float qf[8], kf[8], vf[8], x1[8], x2[8], x3[8];
        unpack8(*(const uint4*)(B.GQ + (size_t)(t0 + c) * 256 + h * 64 + d0), qf);
        unpack8(*(const uint4*)(B.GK + (size_t)(t0 + c) * 256 + h * 64 + d0), kf);
        unpack8(*(const uint4*)(B.GV + (size_t)(t0 + c) * 256 + h * 64 + d0), vf);
        const uint4 t8 = *(const uint4*)(B.TG + (size_t)u * 4096 + c * 64 + d0);
        const uint4 t9 = *(const uint4*)(Y + (size_t)(t0 + c) * D + h * 64 + d0);
        const float* ht = B.HT + (size_t)u * 4096 + c * 64 + d0;
        const float4 h0 = *(const float4*)ht, h1 = *(const float4*)(ht + 4);
        const float eg = __expf(gc), e2 = beta * eg;
#pragma unroll
        for (int i = 0; i < 8; ++i) { x1[i] = qf[i] * eg; x2[i] = kf[i] * e2; x3[i] = beta * vf[i]; }
        put8<false>(Qr, Qr, c, d0, qf); put8<false>(Qd, Qd, c, d0, x1); put8<false>(Kr, Kr, c, d0, kf);
        put8T<false>(KbT, KbT, c, d0, x2); put8T<false>(VbT, VbT, c, d0, x3);
        *(LAS u32x4_t*)(Tp + c * PB + d0) = (u32x4_t){t8.x, t8.y, t8.z, t8.w};
        *(LAS u32x4_t*)(Tq + c * PB + d0) = (u32x4_t){t9.x, t9.y, t9.z, t9.w};
        const float hv[8] = {h0.x, h0.y, h0.z, h0.w, h1.x, h1.y, h1.z, h1.w};
        put8<true>(HTh, HTl, c, d0, hv);
        if ((tid & 7) == 0) { sb[c] = beta; sg[c] = gc; }
    }
    BAR();
    const int ti = w >> 1, tj0 = (w & 1) * 2;
    const f32x4_t zero4 = {0.f, 0.f, 0.f, 0.f};
    f32x4_t u0[2];
#pragma unroll
    for (int tt = 0; tt < 2; ++tt) {
        const int tj = tj0 + tt;
        f32x4_t at = zero4;
        if (tj <= ti) {
            const f32x4_t s = mmp<false, false>(Qr, Qr, Kr, Kr, 16 * ti, 16 * tj, lane, zero4);
            const int j = 16 * tj + cc; const float gj = sg[j];
#pragma unroll
            for (int r = 0; r < 4; ++r) { const int i = 16 * ti + 4 * q4 + r; at[r] = (i >= j) ? s[r] * __expf(fminf(sg[i] - gj, 0.f)) : 0.f; }
        }
        st_tile_R<false>(At, At, 16 * ti, 16 * tj, lane, at);
        u0[tt] = mmp<true, false>(Tp, Tq, VbT, VbT, 16 * ti, 16 * tj, lane, zero4);
        st_tile_R<false>(Wm, Wm, 16 * ti, 16 * tj, lane, mmp<true, false>(Tp, Tq, KbT, KbT, 16 * ti, 16 * tj, lane, zero4));
    }
    BAR();
    f32x4_t o[2];
#pragma unroll
    for (int tt = 0; tt < 2; ++tt) {
        const int tj = tj0 + tt;
        const f32x4_t wh = mmp<false, true>(Wm, Wm, HTh, HTl, 16 * ti, 16 * tj, lane, zero4);
        o[tt] = mmp<false, true>(Qd, Qd, HTh, HTl, 16 * ti, 16 * tj, lane, zero4);
        st_tile_T<false>(VnT, VnT, 16 * ti, 16 * tj, lane, u0[tt] - wh);
    }
    BAR();
#pragma unroll
    for (int tt = 0; tt < 2; ++tt) {
        const int tj = tj0 + tt;
        o[tt] = mmp<false, false>(At, At, VnT, VnT, 16 * ti, 16 * tj, lane, o[tt]);
#pragma unroll
        for (int r = 0; r < 4; ++r) Os[(16 * ti + 4 * q4 + r) * PT + 16 * tj + cc] = o[tt][r];
    }
    BAR();
    {
        const f32x4_t x0 = *(const LAS f32x4_t*)(Os + c * PT + d0), x1 = *(const LAS f32x4_t*)(Os + c * PT + d0 + 4);
        float xv[8] = {x0.x, x0.y, x0.z, x0.w, x1.x, x1.y, x1.z, x1.w};
        float ss = 0.f;
#pragma unroll
        for (int i = 0; i < 8; ++i) ss = fmaf(xv[i], xv[i], ss);
        ss += __shfl_xor(ss, 1); ss += __shfl_xor(ss, 2); ss += __shfl_xor(ss, 4);
        const float rs = rsqrtf(ss * (1.f / 64.f) + 1e-6f);
        float zf[8]; unpack8(*(const uint4*)(PM + (size_t)(t0 + c) * PMLD + 768 + h * 64 + d0), zf);
        float y[8];
#pragma unroll
        for (int i = 0; i < 8; ++i) y[i] = xv[i] * rs * norm_g[d0 + i] * siluf_(zf[i]);
        *(uint4*)(Y + (size_t)(t0 + c) * D + h * 64 + d0) = pack8(y);
    }
    BAR();
}

struct RwkvBufs { bf16_t *RR, *RK, *RV, *RKK, *RA, *RG; float* CW; uint4* MF; float* NF; float* HT; bf16_t* TG; };
__device__ __forceinline__ void rwkv_prep_chunk(const bf16_t* __restrict__ PM, int n, const RwkvBufs& B, const Params& p, int l, const bf16_t* __restrict__ WUPT, const bf16_t* __restrict__ AUPT, const bf16_t* __restrict__ GUPT, LAS unsigned char* lds) {
    const int tid = opq_tid(), w = tid >> 6, lane = tid & 63, q4 = lane >> 4, cc = lane & 15;
    const int t0 = n * 64;
    const float* mu = p.in[24] + l * 1024;
    lds_bf16* Awd = (lds_bf16*)lds; lds_bf16* Aad = Awd + 64 * 72; lds_bf16* Agd = Aad + 64 * 72;
    lds_bf16* La = Agd + 64 * 136; lds_bf16* Lg = La + 64 * 264; lds_bf16* Llw = Lg + 64 * 264;
    for (int px1_ = 0; px1_ < ((PEXP == 1) ? 2 : 1); ++px1_)
    {
        const int t = tid >> 3, c0 = (tid & 7) * 8;
        const bf16_t* row = PM + (size_t)(t0 + t) * PMLD + C_RWKV + 768 + c0;
        const bool hasprev = (t0 + t) > 0;
#pragma unroll
        for (int g8 = 0; g8 < 4; ++g8) {
            float x[8], xp[8];
            unpack8(*(const uint4*)(row + 64 * g8), x);
            if (hasprev) unpack8(*(const uint4*)(row - PMLD + 64 * g8), xp); else {
#pragma unroll
                for (int i = 0; i < 8; ++i) xp[i] = 0.f; }
            const int col = c0 + 64 * g8;
            float y[8];
#pragma unroll
            for (int i = 0; i < 8; ++i) {
                const float v = x[i] + mu[768 + col + i] * (xp[i] - x[i]);
                y[i] = col < 64 ? tanhf_(v) : (col < 128 ? v : sigmoidf_(v));
            }
            const uint4 pk = pack8(y);
            if (col < 64) *(LAS u32x4_t*)(Awd + t * 72 + col) = (u32x4_t){pk.x, pk.y, pk.z, pk.w};
            else if (col < 128) *(LAS u32x4_t*)(Aad + t * 72 + (col - 64)) = (u32x4_t){pk.x, pk.y, pk.z, pk.w};
            else *(LAS u32x4_t*)(Agd + t * 136 + (col - 128)) = (u32x4_t){pk.x, pk.y, pk.z, pk.w};
        }
    }
    BAR();
    const int hh = w >> 1, tt0 = 2 * (w & 1);
    for (int px2_ = 0; px2_ < ((PEXP == 2) ? 2 : 1); ++px2_)
    {
        const float* w0 = p.in[25] + l * W; const float* a0 = p.in[27] + l * W;
#pragma unroll 2
        for (int b = 0; b < 4; ++b) {
            const int ncol = 64 * hh + 16 * b + cc;
            f32x4_t accw[2], acca[2], accg[2];
#pragma unroll
            for (int a = 0; a < 2; ++a) { accw[a] = (f32x4_t){0.f, 0.f, 0.f, 0.f}; acca[a] = accw[a]; accg[a] = accw[a]; }
#pragma unroll
            for (int ks = 0; ks < 4; ++ks) {
                U8 bw, ba, bg;
                bg.q = *(const uint4*)(GUPT + (size_t)ncol * 128 + 32 * ks + 8 * q4);
                if (ks < 2) { bw.q = *(const uint4*)(WUPT + (size_t)ncol * 64 + 32 * ks + 8 * q4); ba.q = *(const uint4*)(AUPT + (size_t)ncol * 64 + 32 * ks + 8 * q4); }
#pragma unroll
                for (int a = 0; a < 2; ++a) {
                    const int row = 16 * (tt0 + a) + cc;
                    U8 ag; ag.x = *(const LAS u32x4_t*)(Agd + row * 136 + 32 * ks + 8 * q4);
                    accg[a] = __builtin_amdgcn_mfma_f32_16x16x32_bf16(ag.v, bg.v, accg[a], 0, 0, 0);
                    if (ks < 2) {
                        U8 aw, aa; aw.x = *(const LAS u32x4_t*)(Awd + row * 72 + 32 * ks + 8 * q4); aa.x = *(const LAS u32x4_t*)(Aad + row * 72 + 32 * ks + 8 * q4);
                        accw[a] = __builtin_amdgcn_mfma_f32_16x16x32_bf16(aw.v, bw.v, accw[a], 0, 0, 0);
                        acca[a] = __builtin_amdgcn_mfma_f32_16x16x32_bf16(aa.v, ba.v, acca[a], 0, 0, 0);
                    }
                }
            }
            const float w0n = w0[ncol], a0n = a0[ncol];
#pragma unroll
            for (int a = 0; a < 2; ++a)
#pragma unroll
                for (int r = 0; r < 4; ++r) {
                    const int t = 16 * (tt0 + a) + 4 * q4 + r;
                    const float logw = -softplusf_(-(w0n + accw[a][r])) - 0.5f;
                    Llw[t * 264 + ncol] = (unsigned short)f2bf(-__expf(logw));
                    La[t * 264 + ncol] = (unsigned short)f2bf(sigmoidf_(a0n + acca[a][r]));
                    Lg[t * 264 + ncol] = (unsigned short)f2bf(accg[a][r]);
                }
        }
    }
    BAR();
    {
        const int t = tid >> 3, j8 = (tid & 7) * 8;
        const bf16_t* row = PM + (size_t)(t0 + t) * PMLD + C_RWKV;
        const bool hasprev = (t0 + t) > 0;
        const float* k_k = p.in[30] + l * W; const float* k_a = p.in[31] + l * W;
#pragma unroll 2
        for (int hd = 0; hd < 4; ++hd) {
            const int nn = 64 * hd + j8;
            float xr[8], xk[8], xv[8], pr[8], pk[8], pv[8], av[8];
            unpack8(*(const uint4*)(row + nn), xr); unpack8(*(const uint4*)(row + 256 + nn), xk); unpack8(*(const uint4*)(row + 512 + nn), xv);
            if (hasprev) { unpack8(*(const uint4*)(row - PMLD + nn), pr); unpack8(*(const uint4*)(row - PMLD + 256 + nn), pk); unpack8(*(const uint4*)(row - PMLD + 512 + nn), pv); }
            else {
#pragma unroll
                for (int i = 0; i < 8; ++i) { pr[i] = 0.f; pk[i] = 0.f; pv[i] = 0.f; } }
            { const u32x4_t t4 = *(const LAS u32x4_t*)(La + t * 264 + nn); unpack8(make_uint4(t4.x, t4.y, t4.z, t4.w), av); }
            float orr[8], okk[8], ovv[8], kraw[8];
            float ss = 0.f;
#pragma unroll
            for (int i = 0; i < 8; ++i) {
                const float r = xr[i] + mu[nn + i] * (pr[i] - xr[i]);
                const float k = xk[i] + mu[256 + nn + i] * (pk[i] - xk[i]);
                const float v = xv[i] + mu[512 + nn + i] * (pv[i] - xv[i]);
                orr[i] = r; ovv[i] = v; okk[i] = k * (1.f + (av[i] - 1.f) * k_a[nn + i]);
                kraw[i] = k * k_k[nn + i]; ss = fmaf(kraw[i], kraw[i], ss);
            }
            ss += __shfl_xor(ss, 1); ss += __shfl_xor(ss, 2); ss += __shfl_xor(ss, 4);
            const float rn = rsqrtf(ss + 1e-6f);
#pragma unroll
            for (int i = 0; i < 8; ++i) kraw[i] *= rn;
            const size_t o = (size_t)(t0 + t) * 256 + nn;
            *(uint4*)(B.RR + o) = pack8(orr); *(uint4*)(B.RK + o) = pack8(okk); *(uint4*)(B.RV + o) = pack8(ovv); *(uint4*)(B.RKK + o) = pack8(kraw);
            { const u32x4_t t4 = *(const LAS u32x4_t*)(La + t * 264 + nn); *(uint4*)(B.RA + o) = make_uint4(t4.x, t4.y, t4.z, t4.w); }
            { const u32x4_t t4 = *(const LAS u32x4_t*)(Lg + t * 264 + nn); *(uint4*)(B.RG + o) = make_uint4(t4.x, t4.y, t4.z, t4.w); }
        }
    }
    for (int px4_ = 0; px4_ < ((PEXP == 4) ? 2 : 1); ++px4_)
    if (tid < 256) {
        float c = 0.f;
#pragma unroll 16
        for (int t = 0; t < 64; ++t) { c += bf2f(Llw[t * 264 + tid]); B.CW[(size_t)(t0 + t) * 256 + tid] = c; }
    }
    BAR();
}

struct RwPiece { float kk[8], al[8], kt[8], v[8], cw[8], cwp[8], cwc[8]; };
__device__ __forceinline__ void rwkv_load_piece(const RwkvBufs& B, int h, int t0, int c, int d0, RwPiece& P) {
    const size_t o = (size_t)(t0 + c) * 256 + h * 64 + d0;
    float a[8];
    unpack8(*(const uint4*)(B.RKK + o), P.kk); unpack8(*(const uint4*)(B.RA + o), a); unpack8(*(const uint4*)(B.RK + o), P.kt); unpack8(*(const uint4*)(B.RV + o), P.v);
    const float4 c0 = *(const float4*)(B.CW + o), c1 = *(const float4*)(B.CW + o + 4);
    P.cw[0] = c0.x; P.cw[1] = c0.y; P.cw[2] = c0.z; P.cw[3] = c0.w; P.cw[4] = c1.x; P.cw[5] = c1.y; P.cw[6] = c1.z; P.cw[7] = c1.w;
    if (c > 0) { const float4 p0 = *(const float4*)(B.CW + o - 256), p1 = *(const float4*)(B.CW + o - 256 + 4);
        P.cwp[0] = p0.x; P.cwp[1] = p0.y; P.cwp[2] = p0.z; P.cwp[3] = p0.w; P.cwp[4] = p1.x; P.cwp[5] = p1.y; P.cwp[6] = p1.z; P.cwp[7] = p1.w; }
    else {
#pragma unroll
        for (int i = 0; i < 8; ++i) P.cwp[i] = 0.f; }
    const size_t oc = (size_t)(t0 + 63) * 256 + h * 64 + d0;
    const float4 e0 = *(const float4*)(B.CW + oc), e1 = *(const float4*)(B.CW + oc + 4);
    P.cwc[0] = e0.x; P.cwc[1] = e0.y; P.cwc[2] = e0.z; P.cwc[3] = e0.w; P.cwc[4] = e1.x; P.cwc[5] = e1.y; P.cwc[6] = e1.z; P.cwc[7] = e1.w;
#pragma unroll
    for (int i = 0; i < 8; ++i) P.al[i] = a[i] * P.kk[i];
}

__device__ __forceinline__ void rwkv_g1_unit(int h, int n, const RwkvBufs& B, bf16_t* __restrict__ Y, LAS unsigned char* lds) {
    const int tid = opq_tid(), w = tid >> 6, lane = tid & 63, q4 = lane >> 4, cc = lane & 15;
    lds_bf16 *P0h = plane(lds, 0), *P0l = plane(lds, 1), *P1h = plane(lds, 2), *P1l = plane(lds, 3), *P2h = plane(lds, 4), *P2l = plane(lds, 5);
    lds_bf16 *Lkh = plane(lds, 6), *Lkl = plane(lds, 7), *P3h = plane(lds, 8), *P3l = plane(lds, 9), *Th = plane(lds, 10), *Tl = plane(lds, 11);
    LAS float* Lm = (LAS float*)(lds + LM_OFF);
    const int t0 = n * 64, u = (4 + h) * 256 + n;
    const int c = tid >> 3, d0 = (tid & 7) * 8;
    RwPiece P; rwkv_load_piece(B, h, t0, c, d0, P);
    {
        float x0[8], x1[8], x2[8];
#pragma unroll
        for (int i = 0; i < 8; ++i) { const float em = __expf(-P.cw[i]); x0[i] = P.kk[i] * __expf(P.cwp[i]); x1[i] = P.al[i] * em; x2[i] = P.kt[i] * em; }
        put8<true>(P0h, P0l, c, d0, x0); put8<true>(P1h, P1l, c, d0, x1); put8<true>(P2h, P2l, c, d0, x2);
    }
    BAR();
    const int ti = w >> 1, tj0 = (w & 1) * 2;
    const f32x4_t zero4 = {0.f, 0.f, 0.f, 0.f};
#pragma unroll
    for (int tt = 0; tt < 2; ++tt) {
        const int tj = tj0 + tt;
        f32x4_t lk = zero4, la = zero4;
        const int j = 16 * tj + cc, jp = (j & 3) * 16 + (j >> 2);
        if (tj <= ti) {
            const f32x4_t a = mmp<true, true>(P0h, P0l, P1h, P1l, 16 * ti, 16 * tj, lane, zero4);
            const f32x4_t b = mmp<true, true>(P0h, P0l, P2h, P2l, 16 * ti, 16 * tj, lane, zero4);
#pragma unroll
            for (int r = 0; r < 4; ++r) { const int i = 16 * ti + 4 * q4 + r; la[r] = (i > j) ? a[r] : 0.f; lk[r] = (i > j) ? b[r] : 0.f; }
        }
#pragma unroll
        for (int r = 0; r < 4; ++r) Lm[(16 * ti + 4 * q4 + r) * PT + jp] = la[r];
        st_tile_R<true>(Lkh, Lkl, 16 * ti, 16 * tj, lane, lk);
    }
    BAR();
    {
        float x0[8], x1[8], x2[8];
#pragma unroll
        for (int i = 0; i < 8; ++i) { const float eb = __expf(P.cwc[i] - P.cw[i]); x0[i] = P.kk[i] * __expf(P.cwp[i]); x1[i] = P.al[i] * eb; x2[i] = P.kt[i] * eb; }
        put8T<true>(P0h, P0l, c, d0, P.v); put8T<true>(P1h, P1l, c, d0, x0); put8T<true>(P2h, P2l, c, d0, x1); put8T<true>(P3h, P3l, c, d0, x2);
    }
    if (w < 4) tri_inverse_4w(Lm, Th, Tl, w, lane);
    BAR();
    { const u32x4_t t4 = *(const LAS u32x4_t*)(Th + c * PB + d0); *(uint4*)(B.TG + (size_t)u * 4096 + c * 64 + d0) = make_uint4(t4.x, t4.y, t4.z, t4.w);
      const u32x4_t t5 = *(const LAS u32x4_t*)(Tl + c * PB + d0); *(uint4*)(Y + (size_t)(t0 + c) * D + 768 + h * 64 + d0) = make_uint4(t5.x, t5.y, t5.z, t5.w); }
    f32x4_t pa[2];
#pragma unroll
    for (int tt = 0; tt < 2; ++tt) pa[tt] = mmp<true, true>(Lkh, Lkl, P0h, P0l, 16 * ti, 16 * (tj0 + tt), lane, zero4);
    BAR();
#pragma unroll
    for (int tt = 0; tt < 2; ++tt) st_tile_T<true>(Lkh, Lkl, 16 * ti, 16 * (tj0 + tt), lane, pa[tt]);
    BAR();
    f32x4_t ua[2], wa[2];
#pragma unroll
    for (int tt = 0; tt < 2; ++tt) {
        ua[tt] = mmp<true, true>(Th, Tl, Lkh, Lkl, 16 * ti, 16 * (tj0 + tt), lane, zero4);
        wa[tt] = mmp<true, true>(Th, Tl, P1h, P1l, 16 * ti, 16 * (tj0 + tt), lane, zero4);
    }
    BAR();
#pragma unroll
    for (int tt = 0; tt < 2; ++tt) {
        st_tile_T<true>(Lkh, Lkl, 16 * ti, 16 * (tj0 + tt), lane, -ua[tt]);
        st_tile_T<true>(P1h, P1l, 16 * ti, 16 * (tj0 + tt), lane, wa[tt]);
    }
    BAR();
    {
#pragma unroll
        for (int tt = 0; tt < 2; ++tt) {
            const int tj = tj0 + tt;
            const f32x4_t a = mmp<true, true>(P2h, P2l, P1h, P1l, 16 * ti, 16 * tj, lane, zero4);
            const float gam = __expf(B.CW[(size_t)(t0 + 63) * 256 + h * 64 + 16 * tj + cc]);
#pragma unroll
            for (int r = 0; r < 4; ++r) { const int ar = 16 * ti + 4 * q4 + r, bc = 16 * tj + cc; Lm[ar * PT + bc] = (ar == bc ? gam : 0.f) - a[r]; }
            f32x4_t nn = mmp<true, true>(P2h, P2l, Lkh, Lkl, 16 * ti, 16 * tj, lane, zero4);
            nn = mmp<true, true>(P3h, P3l, P0h, P0l, 16 * ti, 16 * tj, lane, nn);
            *(float4*)(B.NF + (size_t)u * 4096 + (tj * 64 + lane) * 16 + ti * 4) = make_float4(nn[0], nn[1], nn[2], nn[3]);
        }
    }
    BAR();
    {
        const int combo = tid >> 6, mt = combo >> 1, s = combo & 1, i = lane & 15, qq = lane >> 4;
        const f32x4_t x0 = *(const LAS f32x4_t*)(Lm + (16 * mt + i) * PT + 32 * s + 4 * qq);
        const f32x4_t x1 = *(const LAS f32x4_t*)(Lm + (16 * mt + i) * PT + 32 * s + 16 + 4 * qq);
        const float xv[8] = {x0.x, x0.y, x0.z, x0.w, x1.x, x1.y, x1.z, x1.w};
        U8 H, L; split8(xv, H.v, L.v);
        uint4* mf = B.MF + (size_t)u * 1024 + (size_t)(combo * 2) * 64 + lane;
        mf[0] = H.q; mf[64] = L.q;
    }
    BAR();
}

__device__ __forceinline__ void rwkv_g3_unit(int h, int n, const RwkvBufs& B, bf16_t* __restrict__ Y, const Params& p, int l, LAS unsigned char* lds) {
    const int tid = opq_tid(), w = tid >> 6, lane = tid & 63, q4 = lane >> 4, cc = lane & 15;
    lds_bf16 *KH = plane(lds, 0), *AC = plane(lds, 1), *KC = plane(lds, 2), *RH = plane(lds, 3), *VT = plane(lds, 4), *KHT = plane(lds, 5), *Tp = plane(lds, 6);
    lds_bf16 *HTh = plane(lds, 7), *HTl = plane(lds, 8), *Lk = plane(lds, 9), *Ara = plane(lds, 10), *Ark = plane(lds, 11), *Tq = plane(lds, 12);
    lds_bf16 *PTp = KH, *Wm = AC, *UT = KC;
    LAS float* Os = (LAS float*)(lds + LM_OFF);
    const int t0 = n * 64, u = (4 + h) * 256 + n;
    const int c = tid >> 3, d0 = (tid & 7) * 8;
    {
        RwPiece P; rwkv_load_piece(B, h, t0, c, d0, P);
        float rr[8]; unpack8(*(const uint4*)(B.RR + (size_t)(t0 + c) * 256 + h * 64 + d0), rr);
        const uint4 t8 = *(const uint4*)(B.TG + (size_t)u * 4096 + c * 64 + d0);
        const uint4 t9 = *(const uint4*)(Y + (size_t)(t0 + c) * D + 768 + h * 64 + d0);
        const float* ht = B.HT + (size_t)u * 4096 + c * 64 + d0;
        const float4 h0 = *(const float4*)ht, h1 = *(const float4*)(ht + 4);
        float x0[8], x1[8], x2[8], x3[8];
#pragma unroll
        for (int i = 0; i < 8; ++i) { const float em = __expf(-P.cw[i]); x0[i] = P.kk[i] * __expf(P.cwp[i]); x1[i] = P.al[i] * em; x2[i] = P.kt[i] * em; x3[i] = rr[i] * __expf(P.cw[i]); }
        put8<false>(KH, KH, c, d0, x0); put8<false>(AC, AC, c, d0, x1); put8<false>(KC, KC, c, d0, x2); put8<false>(RH, RH, c, d0, x3);
        put8T<false>(VT, VT, c, d0, P.v); put8T<false>(KHT, KHT, c, d0, x0);
        *(LAS u32x4_t*)(Tp + c * PB + d0) = (u32x4_t){t8.x, t8.y, t8.z, t8.w};
        *(LAS u32x4_t*)(Tq + c * PB + d0) = (u32x4_t){t9.x, t9.y, t9.z, t9.w};
        const float hv[8] = {h0.x, h0.y, h0.z, h0.w, h1.x, h1.y, h1.z, h1.w};
        put8<true>(HTh, HTl, c, d0, hv);
    }
    BAR();
    const int ti = w >> 1, tj0 = (w & 1) * 2;
    const f32x4_t zero4 = {0.f, 0.f, 0.f, 0.f};
#pragma unroll
    for (int tt = 0; tt < 2; ++tt) {
        const int tj = tj0 + tt; const int j = 16 * tj + cc;
        f32x4_t lk = zero4, ara = zero4, ark = zero4;
        if (tj <= ti) {
            const f32x4_t b = mmp<false, false>(KH, KH, KC, KC, 16 * ti, 16 * tj, lane, zero4);
            const f32x4_t e = mmp<false, false>(RH, RH, AC, AC, 16 * ti, 16 * tj, lane, zero4);
            const f32x4_t f = mmp<false, false>(RH, RH, KC, KC, 16 * ti, 16 * tj, lane, zero4);
#pragma unroll
            for (int r = 0; r < 4; ++r) { const int i = 16 * ti + 4 * q4 + r; lk[r] = (i > j) ? b[r] : 0.f; ara[r] = (i >= j) ? e[r] : 0.f; ark[r] = (i >= j) ? f[r] : 0.f; }
        }
        st_tile_R<false>(Lk, Lk, 16 * ti, 16 * tj, lane, lk); st_tile_R<false>(Ara, Ara, 16 * ti, 16 * tj, lane, ara); st_tile_R<false>(Ark, Ark, 16 * ti, 16 * tj, lane, ark);
    }
    BAR();
#pragma unroll
    for (int tt = 0; tt < 2; ++tt) {
        const int tj = tj0 + tt;
        st_tile_T<false>(PTp, PTp, 16 * ti, 16 * tj, lane, mmp<false, false>(Lk, Lk, VT, VT, 16 * ti, 16 * tj, lane, zero4));
        st_tile_R<false>(Wm, Wm, 16 * ti, 16 * tj, lane, mmp<true, false>(Tp, Tq, KHT, KHT, 16 * ti, 16 * tj, lane, zero4));
    }
    BAR();
    f32x4_t o[2];
#pragma unroll
    for (int tt = 0; tt < 2; ++tt) {
        const int tj = tj0 + tt;
        const f32x4_t ua = mmp<true, false>(Tp, Tq, PTp, PTp, 16 * ti, 16 * tj, lane, zero4);
        const f32x4_t wh = mmp<false, true>(Wm, Wm, HTh, HTl, 16 * ti, 16 * tj, lane, zero4);
        st_tile_T<false>(UT, UT, 16 * ti, 16 * tj, lane, -ua - wh);
        o[tt] = mmp<false, true>(RH, RH, HTh, HTl, 16 * ti, 16 * tj, lane, zero4);
        o[tt] = mmp<false, false>(Ark, Ark, VT, VT, 16 * ti, 16 * tj, lane, o[tt]);
    }
    BAR();
#pragma unroll
    for (int tt = 0; tt < 2; ++tt) {
        const int tj = tj0 + tt;
        o[tt] = mmp<false, false>(Ara, Ara, UT, UT, 16 * ti, 16 * tj, lane, o[tt]);
#pragma unroll
        for (int r = 0; r < 4; ++r) Os[(16 * ti + 4 * q4 + r) * PT + 16 * tj + cc] = o[tt][r];
    }
    BAR();
    {
        const f32x4_t x0 = *(const LAS f32x4_t*)(Os + c * PT + d0), x1 = *(const LAS f32x4_t*)(Os + c * PT + d0 + 4);
        const float xv[8] = {x0.x, x0.y, x0.z, x0.w, x1.x, x1.y, x1.z, x1.w};
        float s1 = 0.f;
#pragma unroll
        for (int i = 0; i < 8; ++i) s1 += xv[i];
        s1 += __shfl_xor(s1, 1); s1 += __shfl_xor(s1, 2); s1 += __shfl_xor(s1, 4);
        const float mean = s1 * (1.f / 64.f);
        float s2 = 0.f;
#pragma unroll
        for (int i = 0; i < 8; ++i) { const float dd = xv[i] - mean; s2 = fmaf(dd, dd, s2); }
        s2 += __shfl_xor(s2, 1); s2 += __shfl_xor(s2, 2); s2 += __shfl_xor(s2, 4);
        const float rs = rsqrtf(s2 * (1.f / 64.f) + 64e-5f);
        const size_t o8 = (size_t)(t0 + c) * 256 + h * 64 + d0;
        float rr[8], gg[8], kt2[8], v2[8];
        unpack8(*(const uint4*)(B.RR + o8), rr); unpack8(*(const uint4*)(B.RG + o8), gg); unpack8(*(const uint4*)(B.RK + o8), kt2); unpack8(*(const uint4*)(B.RV + o8), v2);
        const float* r_k = p.in[32] + l * W + h * 64 + d0; const float* ln_g = p.in[33] + l * W + h * 64 + d0; const float* ln_b = p.in[34] + l * W + h * 64 + d0;
        float bs = 0.f;
#pragma unroll
        for (int i = 0; i < 8; ++i) bs = fmaf(rr[i] * kt2[i], r_k[i], bs);
        bs += __shfl_xor(bs, 1); bs += __shfl_xor(bs, 2); bs += __shfl_xor(bs, 4);
        float y[8];
#pragma unroll
        for (int i = 0; i < 8; ++i) y[i] = ((xv[i] - mean) * rs * ln_g[i] + ln_b[i] + bs * v2[i]) * gg[i];
        *(uint4*)(Y + (size_t)(t0 + c) * D + 768 + h * 64 + d0) = pack8(y);
    }
    BAR();
}

struct LruBufs { float2* AGG; float* CAR; };
template <int PASS>
__device__ __forceinline__ void lru_unit(const bf16_t* __restrict__ PM, int n, const LruBufs& B, bf16_t* __restrict__ Y, const Params& p, int l, const bf16_t* __restrict__ LWT  , LAS float* lds) {
    const int tid = opq_tid(), c = tid & 255, half = tid >> 8, w = tid >> 6, lane = tid & 63, q4 = lane >> 4, cc = lane & 15;
    const int t0 = n * 64, tb = t0 + 32 * half;
    LAS float* U = lds;
    lds_bf16* R = (lds_bf16*)(lds + 64 * 260);
    lds_bf16* I = R + 64 * 264;
    {
        const float* cw = p.in[7] + l * 4 * W; const float cb = p.in[8][l * W + c];
        const float w0 = cw[c], w1 = cw[W + c], w2 = cw[2 * W + c], w3 = cw[3 * W + c];
        const bf16_t* col = PM + C_LRU + c;
#pragma unroll 1
        for (int hf = 0; hf < 2; ++hf) {
            bf16_t xr[19];
#pragma unroll
            for (int i = 0; i < 19; ++i) xr[i] = (tb + 16 * hf + i - 3 >= 0) ? col[(size_t)(tb + 16 * hf + i - 3) * PMLD] : (bf16_t)0;
#pragma unroll
            for (int i = 0; i < 16; ++i)
                U[(32 * half + 16 * hf + i) * 260 + c] = cb + w0 * bf2f(xr[i]) + w1 * bf2f(xr[i + 1]) + w2 * bf2f(xr[i + 2]) + w3 * bf2f(xr[i + 3]);
        }
    }
    BAR();
    {
        const int nb = w >> 1, gt = w & 1;
        const bf16_t* wt = LWT + (size_t)gt * 16384 + (size_t)nb * 4096;
        const float* bias = (gt ? p.in[12] : p.in[10]) + l * W + nb * 64;
        const float* lam = p.in[13] + l * W + nb * 64;
#pragma unroll 1
        for (int te = 0; te < 4; ++te) {
            U8 bf[2];
#pragma unroll
            for (int ks = 0; ks < 2; ++ks) bf[ks].q = *(const uint4*)(wt + (size_t)(16 * te + cc) * 64 + 32 * ks + 8 * q4);
            const int ch = nb * 64 + 16 * te + cc;
            const float bv = bias[16 * te + cc];
            const float sp8 = 8.f * softplusf_(-lam[16 * te + cc]);
#pragma unroll
            for (int tt = 0; tt < 4; ++tt) {
                f32x4_t acc = {0.f, 0.f, 0.f, 0.f};
#pragma unroll
                for (int ks = 0; ks < 2; ++ks) {
                    const LAS float* ap = U + (16 * tt + cc) * 260 + nb * 64 + 32 * ks + 8 * q4;
                    const f32x4_t a0 = *(const LAS f32x4_t*)ap, a1 = *(const LAS f32x4_t*)(ap + 4);
                    const float av[8] = {a0.x, a0.y, a0.z, a0.w, a1.x, a1.y, a1.z, a1.w};
                    acc = __builtin_amdgcn_mfma_f32_16x16x32_bf16(hi8(av), bf[ks].v, acc, 0, 0, 0);
                }
#pragma unroll
                for (int r = 0; r < 4; ++r) {
                    const int t = 16 * tt + 4 * q4 + r;
                    const float sg = sigmoidf_(acc[r] + bv);
                    if (gt) I[t * 264 + ch] = (unsigned short)f2bf(sg); else R[t * 264 + ch] = (unsigned short)f2bf(-sp8 * sg);
                }
            }
        }
    }
    BAR();
    float h = 0.f, ap = 1.f;
    const int sc = 2 * n + half;
    bf16_t gc_[8], gn_[8];
    if (PASS == 3) {
        h = B.CAR[(size_t)c * 512 + sc];
#pragma unroll
        for (int i = 0; i < 8; ++i) gc_[i] = PM[(size_t)(tb + i) * PMLD + C_LRU + 256 + c];
    }
#pragma unroll 1
    for (int g8 = 0; g8 < 4; ++g8) {
        if (PASS == 3 && g8 < 3) {
#pragma unroll
            for (int i = 0; i < 8; ++i) gn_[i] = PM[(size_t)(tb + 8 * (g8 + 1) + i) * PMLD + C_LRU + 256 + c];
        }
#pragma unroll
        for (int i = 0; i < 8; ++i) {
            const int t = 32 * half + 8 * g8 + i;
            const float log_a = bf2f(R[t * 264 + c]), ig = bf2f(I[t * 264 + c]);
            const float a = __expf(log_a);
            const float inp = __builtin_amdgcn_sqrtf(fmaxf(1.f - a * a, 0.f)) * (ig * U[t * 260 + c]);
            h = fmaf(a, h, inp); ap *= a;
            if (PASS == 3) Y[(size_t)(t0 + t) * D + 256 + c] = (bf16_t)f2bf(h * geluf_(bf2f(gc_[i])));
        }
        if (PASS == 3) {
#pragma unroll
            for (int i = 0; i < 8; ++i) gc_[i] = gn_[i];
        }
    }
    if (PASS == 1) B.AGG[(size_t)c * 512 + sc] = make_float2(ap, h);
    BAR();
}
__device__ __forceinline__ void lru_carry_wave(const LruBufs& B, int c, int lane) {
    float2 ab[8];
    const float4* src = (const float4*)(B.AGG + (size_t)c * 512 + 8 * lane);
#pragma unroll
    for (int k = 0; k < 4; ++k) { const float4 v = src[k]; ab[2 * k] = make_float2(v.x, v.y); ab[2 * k + 1] = make_float2(v.z, v.w); }
    float A = 1.f, Bv = 0.f;
#pragma unroll
    for (int k = 0; k < 8; ++k) { Bv = fmaf(ab[k].x, Bv, ab[k].y); A *= ab[k].x; }
#pragma unroll
    for (int o = 1; o < 64; o <<= 1) { const float Al = __shfl_up(A, o), Bl = __shfl_up(Bv, o); if (lane >= o) { Bv = fmaf(A, Bl, Bv); A *= Al; } }
    float h = __shfl_up(Bv, 1); if (lane == 0) h = 0.f;
    float o8[8];
#pragma unroll
    for (int k = 0; k < 8; ++k) { o8[k] = h; h = fmaf(ab[k].x, h, ab[k].y); }
    float4* dst = (float4*)(B.CAR + (size_t)c * 512 + 8 * lane);
    dst[0] = make_float4(o8[0], o8[1], o8[2], o8[3]); dst[1] = make_float4(o8[4], o8[5], o8[6], o8[7]);
}

struct S5Bufs { float2* E; float2* CIN; };
template <int PASS>
__device__ __forceinline__ void s5_unit(const bf16_t* __restrict__ PM, int n, const S5Bufs& B, bf16_t* __restrict__ Y, const Params& p, int l, const bf16_t* __restrict__ WL, LAS unsigned char* lds) {
    const int tid = opq_tid(), w = tid >> 6, lane = tid & 63, q4 = lane >> 4, cc = lane & 15;
    const int t0 = n * 64;
    LAS float* bu = (LAS float*)(lds + w * 8448);
    LAS unsigned char* hs = lds + 8 * 8448 + w * 4352;
    lds_bf16* yp = (lds_bf16*)(lds + 8 * 8448 + 8 * 4352);
    const bf16_t* GLUT = WL + WO_GLU;
#pragma unroll 1
    for (int gi = 0; gi < 2; ++gi) {
        const int g = 2 * w + gi;
        U8 bfr[8], cf[4];
#pragma unroll
        for (int tn = 0; tn < 8; ++tn) bfr[tn].q = *(const uint4*)(WL + WO_S5B + ((size_t)(g * 8 + tn) * 64 + lane) * 8);
        float dch = 0.f;
        if (PASS == 3) {
#pragma unroll
            for (int ks = 0; ks < 4; ++ks) cf[ks].q = *(const uint4*)(WL + WO_S5C + ((size_t)(g * 4 + ks) * 64 + lane) * 8);
            dch = p.in[20][l * W + g * 16 + cc];
        }
        float lbr, lbi;
        { const float dt = __expf(p.in[21][l * 16 + g]); const float lre = p.in[14][l * 1024 + g * 64 + lane], lim = p.in[15][l * 1024 + g * 64 + lane];
          const float er = __expf(lre * dt); lbr = er * cosf(lim * dt); lbi = er * sinf(lim * dt); }
        float hr = 0.f, hi = 0.f;
        if (PASS == 3) { const float2 h0 = B.CIN[((size_t)g * 64 + lane) * 256 + n]; hr = h0.x; hi = h0.y; }
#pragma unroll 1
        for (int tt = 0; tt < 4; ++tt) {
            U8 at; at.q = make_uint4(0u, 0u, 0u, 0u); if (q4 < 2) at.q = *(const uint4*)(PM + (size_t)(t0 + 16 * tt + cc) * PMLD + C_S5 + g * 16 + 8 * q4);
#pragma unroll
            for (int tn = 0; tn < 8; ++tn) {
                const f32x4_t acc = __builtin_amdgcn_mfma_f32_16x16x32_bf16(at.v, bfr[tn].v, (f32x4_t){0.f, 0.f, 0.f, 0.f}, 0, 0, 0);
#pragma unroll
                for (int r = 0; r < 4; ++r) bu[(4 * q4 + r) * 132 + 16 * tn + cc] = acc[r];
            }
            asm volatile("s_waitcnt lgkmcnt(0)" ::: "memory");
#pragma unroll
            for (int i = 0; i < 16; ++i) {
                const f32x2v_t bb = *(const LAS f32x2v_t*)(bu + i * 132 + 2 * lane);
                const float nhr = lbr * hr - lbi * hi + bb.x, nhi = lbr * hi + lbi * hr + bb.y;
                hr = nhr; hi = nhi;
                if (PASS == 3) *(LAS unsigned*)(hs + i * 272 + 4 * lane) = cvtpk(hr, hi);
            }
            if (PASS == 3) {
                asm volatile("s_waitcnt lgkmcnt(0)" ::: "memory");
                f32x4_t acc = {0.f, 0.f, 0.f, 0.f};
#pragma unroll
                for (int ks = 0; ks < 4; ++ks) { U8 af; af.x = *(const LAS u32x4_t*)(hs + cc * 272 + 64 * ks + 16 * q4); acc = __builtin_amdgcn_mfma_f32_16x16x32_bf16(af.v, cf[ks].v, acc, 0, 0, 0); }
#pragma unroll
                for (int r = 0; r < 4; ++r) {
                    const int t = 16 * tt + 4 * q4 + r;
                    const float uv = bf2f(PM[(size_t)(t0 + t) * PMLD + C_S5 + g * 16 + cc]);
                    yp[t * 264 + g * 16 + cc] = (unsigned short)f2bf(geluf_(acc[r] + dch * uv));
                }
            }
            asm volatile("s_waitcnt lgkmcnt(0)" ::: "memory");
        }
        if (PASS == 1) B.E[((size_t)g * 64 + lane) * 256 + n] = make_float2(hr, hi);
    }
    if (PASS == 3) {
        BAR();
        const float* gb = p.in[23] + l * W;
#pragma unroll 1
        for (int tn = 2 * w; tn < 2 * w + 2; ++tn) {
            f32x4_t acc[4];
#pragma unroll
            for (int tt = 0; tt < 4; ++tt) acc[tt] = (f32x4_t){0.f, 0.f, 0.f, 0.f};
#pragma unroll
            for (int ks = 0; ks < 8; ++ks) {
                U8 bf; bf.q = *(const uint4*)(GLUT + (size_t)(16 * tn + cc) * 256 + 32 * ks + 8 * q4);
#pragma unroll
                for (int tt = 0; tt < 4; ++tt) {
                    U8 af; af.x = *(const LAS u32x4_t*)(yp + (16 * tt + cc) * 264 + 32 * ks + 8 * q4);
                    acc[tt] = __builtin_amdgcn_mfma_f32_16x16x32_bf16(af.v, bf.v, acc[tt], 0, 0, 0);
                }
            }
            const int ncol = 16 * tn + cc; const float gbn = gb[ncol];
#pragma unroll
            for (int tt = 0; tt < 4; ++tt)
#pragma unroll
                for (int r = 0; r < 4; ++r) {
                    const int t = 16 * tt + 4 * q4 + r;
                    const float yv = bf2f(yp[t * 264 + ncol]);
                    Y[(size_t)(t0 + t) * D + 512 + ncol] = (bf16_t)f2bf(yv * sigmoidf_(acc[tt][r] + gbn));
                }
        }
    }
    BAR();
}
__device__ __forceinline__ void s5_carry_wave(const S5Bufs& B, const Params& p, int l, int gp, int lane) {
    const int g = gp >> 6;
    const float dt = __expf(p.in[21][l * 16 + g]) * 64.f;
    const float lre = p.in[14][l * 1024 + gp], lim = p.in[15][l * 1024 + gp];
    const float er = __expf(lre * dt);
    const float pr = er * cosf(lim * dt), pi = er * sinf(lim * dt);
    float2 e[4];
    const float4* src = (const float4*)(B.E + (size_t)gp * 256 + 4 * lane);
    { const float4 v0 = src[0], v1 = src[1]; e[0] = make_float2(v0.x, v0.y); e[1] = make_float2(v0.z, v0.w); e[2] = make_float2(v1.x, v1.y); e[3] = make_float2(v1.z, v1.w); }
    float Ar = 1.f, Ai = 0.f, Br = 0.f, Bi = 0.f;
#pragma unroll
    for (int k = 0; k < 4; ++k) {
        const float nbr = pr * Br - pi * Bi + e[k].x, nbi = pr * Bi + pi * Br + e[k].y; Br = nbr; Bi = nbi;
        const float nar = pr * Ar - pi * Ai, nai = pr * Ai + pi * Ar; Ar = nar; Ai = nai;
    }
#pragma unroll
    for (int o = 1; o < 64; o <<= 1) {
        const float Alr = __shfl_up(Ar, o), Ali = __shfl_up(Ai, o), Blr = __shfl_up(Br, o), Bli = __shfl_up(Bi, o);
        if (lane >= o) {
            const float nbr = Ar * Blr - Ai * Bli + Br, nbi = Ar * Bli + Ai * Blr + Bi; Br = nbr; Bi = nbi;
            const float nar = Ar * Alr - Ai * Ali, nai = Ar * Ali + Ai * Alr; Ar = nar; Ai = nai;
        }
    }
    float hr = __shfl_up(Br, 1), hi = __shfl_up(Bi, 1); if (lane == 0) { hr = 0.f; hi = 0.f; }
    float2 o4[4];
#pragma unroll
    for (int k = 0; k < 4; ++k) { o4[k] = make_float2(hr, hi); const float nhr = pr * hr - pi * hi + e[k].x, nhi = pr * hi + pi * hr + e[k].y; hr = nhr; hi = nhi; }
    float4* dst = (float4*)(B.CIN + (size_t)gp * 256 + 4 * lane);
    dst[0] = make_float4(o4[0].x, o4[0].y, o4[1].x, o4[1].y); dst[1] = make_float4(o4[2].x, o4[2].y, o4[3].x, o4[3].y);
}

constexpr size_t WS_GQ = 36 * MiB, WS_GK = 44 * MiB, WS_GV = 52 * MiB, WS_GB = 60 * MiB, WS_GC = 61 * MiB;
constexpr size_t WS_MF = 324 * MiB, WS_NF = 356 * MiB, WS_HT = 388 * MiB;
constexpr size_t WS_RR = 420 * MiB, WS_RK = 428 * MiB, WS_RV = 436 * MiB, WS_RKK = 444 * MiB, WS_RA = 452 * MiB, WS_RG = 460 * MiB, WS_CW = 468 * MiB;
constexpr size_t WS_LAGG = 484 * MiB, WS_LCAR = 485 * MiB, WS_S5E = 486 * MiB, WS_S5C = 488 * MiB;
constexpr size_t WS_SS = 506 * MiB;
constexpr size_t WS_TG = 490 * MiB;
constexpr int MIX_LDS = 8 * MS * 4 + 1024;
__device__ __forceinline__ LruBufs lru_bufs(unsigned char* ws) { LruBufs B; B.AGG = (float2*)(ws + WS_LAGG); B.CAR = (float*)(ws + WS_LCAR); return B; }
__device__ __forceinline__ S5Bufs s5_bufs(unsigned char* ws) { S5Bufs B; B.E = (float2*)(ws + WS_S5E); B.CIN = (float2*)(ws + WS_S5C); return B; }
__device__ __forceinline__ GdnBufs gdn_bufs(unsigned char* ws) {
    GdnBufs B; B.GQ = (bf16_t*)(ws + WS_GQ); B.GK = (bf16_t*)(ws + WS_GK); B.GV = (bf16_t*)(ws + WS_GV); B.GB = (float*)(ws + WS_GB); B.GC = (float*)(ws + WS_GC);
    B.MF = (uint4*)(ws + WS_MF); B.NF = (float*)(ws + WS_NF); B.HT = (float*)(ws + WS_HT); B.TG = (bf16_t*)(ws + WS_TG); return B;
}
__device__ __forceinline__ RwkvBufs rwkv_bufs(unsigned char* ws) {
    RwkvBufs B; B.RR = (bf16_t*)(ws + WS_RR); B.RK = (bf16_t*)(ws + WS_RK); B.RV = (bf16_t*)(ws + WS_RV); B.RKK = (bf16_t*)(ws + WS_RKK); B.RA = (bf16_t*)(ws + WS_RA); B.RG = (bf16_t*)(ws + WS_RG);
    B.CW = (float*)(ws + WS_CW); B.MF = (uint4*)(ws + WS_MF); B.NF = (float*)(ws + WS_NF); B.HT = (float*)(ws + WS_HT); B.TG = (bf16_t*)(ws + WS_TG); return B;
}
__device__ __forceinline__ unsigned char* opq(unsigned char* w) { unsigned long long v = (unsigned long long)w; asm volatile("" : "+s"(v)); return (unsigned char*)(GAS unsigned char*)v; }
#define XB_TMO      128
#define XB_XCNT(j)  (256  + 64 * (j))
#define XB_XSUB(j)  (1280 + 64 * (j))
#define XB_XGEN(j)  (2304 + 64 * (j))
#define XB_TOP      3328
#define XB_TOPGEN   3392
#define XCD_BAR_WORDS 3456
#define XB_SPIN_CAP (1u << 18)

__device__ __forceinline__ unsigned xb_ld(unsigned* p)              { return __hip_atomic_load(p, __ATOMIC_RELAXED, __HIP_MEMORY_SCOPE_AGENT); }
__device__ __forceinline__ unsigned xb_add(unsigned* p, unsigned v) { return __hip_atomic_fetch_add(p, v, __ATOMIC_RELAXED, __HIP_MEMORY_SCOPE_AGENT); }
__device__ __forceinline__ unsigned xb_xcc_id() { return (unsigned)__builtin_amdgcn_s_getreg((3 << 11) | 20) & 0xFu; }
#define XB_SPIN(cond, bar) do { unsigned _sp = 0; while (cond) { __builtin_amdgcn_s_sleep(1); \
    if ((++_sp & 255u) == 0u) { if (xb_ld(&(bar)[XB_TMO])) break; if (_sp > XB_SPIN_CAP) { atomicAdd(&(bar)[XB_TMO], 1u); break; } } } } while (0)

struct XcdBarrier {
    unsigned* bar; unsigned x;
    volatile LAS unsigned* st;
};

__device__ __forceinline__ XcdBarrier xcd_barrier_post(unsigned* bar, volatile LAS unsigned* st) {
    XcdBarrier b; b.bar = bar; b.x = xb_xcc_id(); b.st = st;
    if (threadIdx.x == 0) (void)xb_add(&bar[XB_XCNT(b.x)], 1u);
    return b;
}
__device__ __forceinline__ void xcd_barrier_complete(unsigned* bar, unsigned x, unsigned& nloc, unsigned& nx) {
    const unsigned G = gridDim.x * gridDim.y * gridDim.z;
    unsigned sum, cnt, mine, sp = 0u;
    for (;;) {
        sum = 0u; cnt = 0u; mine = 0u;
#pragma unroll
        for (unsigned j = 0; j < 16; ++j) { const unsigned c = xb_ld(&bar[XB_XCNT(j)]); sum += c; cnt += (c > 0u) ? 1u : 0u; mine = (j == x) ? c : mine; }
        if (sum == G) break;
        __builtin_amdgcn_s_sleep(1);
        if ((++sp & 255u) == 0u) { if (xb_ld(&bar[XB_TMO])) break; if (sp > XB_SPIN_CAP) { atomicAdd(&bar[XB_TMO], 1u); break; } }
    }
    nloc = mine > 0u ? mine : 1u; nx = cnt > 0u ? cnt : 1u;
}

__device__ __forceinline__ void xcd_barrier(const XcdBarrier& b) {
    asm volatile("s_waitcnt vmcnt(0)" ::: "memory");
    __syncthreads();
    if (threadIdx.x == 0) {
        unsigned* bar = b.bar;
        __builtin_amdgcn_s_waitcnt(0);
        unsigned nloc = b.st[0], nx = b.st[1];
        if (nloc == 0u) { xcd_barrier_complete(bar, b.x, nloc, nx); b.st[0] = nloc; b.st[1] = nx; }
        const unsigned old = xb_add(&bar[XB_XSUB(b.x)], 1u);
        const unsigned gen = old / nloc;
        if (old + 1u == (gen + 1u) * nloc) {
            __builtin_amdgcn_fence(__ATOMIC_RELEASE, "agent");
            asm volatile("s_waitcnt vmcnt(0)" ::: "memory");
            const unsigned og = xb_add(&bar[XB_TOP], 1u);
            const unsigned tg = og / nx;
            if (og + 1u == (tg + 1u) * nx) xb_add(&bar[XB_TOPGEN], 1u);
            else XB_SPIN(xb_ld(&bar[XB_TOPGEN]) == tg, bar);
            __builtin_amdgcn_fence(__ATOMIC_ACQUIRE, "agent");
            xb_add(&bar[XB_XGEN(b.x)], 1u);
            asm volatile("s_waitcnt vmcnt(0)" ::: "memory");
        } else {
            XB_SPIN(xb_ld(&bar[XB_XGEN(b.x)]) == gen, bar);
            __builtin_amdgcn_fence(__ATOMIC_ACQUIRE, "agent");
            asm volatile("s_waitcnt vmcnt(0)" ::: "memory");
        }
    }
    __syncthreads();
}

__device__ __forceinline__ void sub_barrier(unsigned* cnt, unsigned target) {
    asm volatile("s_waitcnt vmcnt(0)" ::: "memory"); __syncthreads();
    if (threadIdx.x == 0) {
        __builtin_amdgcn_fence(__ATOMIC_RELEASE, "agent"); asm volatile("s_waitcnt vmcnt(0)" ::: "memory");
        (void)__hip_atomic_fetch_add(cnt, 1u, __ATOMIC_RELAXED, __HIP_MEMORY_SCOPE_AGENT);
        unsigned sp = 0;
        while (__hip_atomic_load(cnt, __ATOMIC_RELAXED, __HIP_MEMORY_SCOPE_AGENT) < target) { __builtin_amdgcn_s_sleep(2); if (++sp > (1u << 22)) break; }
        __builtin_amdgcn_fence(__ATOMIC_ACQUIRE, "agent"); asm volatile("s_waitcnt vmcnt(0)" ::: "memory");
    }
    __syncthreads();
}

namespace cg = cooperative_groups;
constexpr int FUSED_LDS = MIX_LDS;
static_assert(FUSED_LDS >= pg8::STAGE_BYTES && FUSED_LDS >= 8 * 64 * 33 * 4, "LDS budget");
#define GSYNC() xcd_barrier(bar)
#ifndef PHM
#define PHM 511
#endif
#ifndef REP
#define REP 0
#endif
#ifndef REPU
#define REPU 0
#endif
#ifndef REPP
#define REPP 0
#endif
__global__ void __launch_bounds__(NT, 2) fwd_fused(KParams kp_unused) {
    cg::grid_group grid = cg::this_grid();
    extern __shared__ __attribute__((aligned(16))) unsigned char dl[];
    Params p; p.in.tab = (LAS const unsigned long long*)((LAS unsigned char*)dl + FUSED_LDS);
    {
        const __attribute__((address_space(4))) unsigned long long* ka = (const __attribute__((address_space(4))) unsigned long long*)__builtin_amdgcn_kernarg_segment_ptr();
        if (threadIdx.x < 43) ((LAS unsigned long long*)((LAS unsigned char*)dl + FUSED_LDS))[threadIdx.x] = ka[threadIdx.x];
        if (threadIdx.x < 4) ((LAS unsigned*)((LAS unsigned char*)dl + FUSED_LDS + 512))[threadIdx.x] = 0u;
        __syncthreads();
    }
    const XcdBarrier bar = xcd_barrier_post((unsigned*)(p.ws() + WS_CTL), (volatile LAS unsigned*)((LAS unsigned char*)dl + FUSED_LDS + 512));
    float* X = p.out();
#pragma unroll 1
    for (int l = 0; l < 2; ++l) {
        {
            const int tid = opq_tid();
            convert_weights(p, l, (LAS float*)dl + (tid >> 6) * 64 * 33, blockIdx.x * 8 + (tid >> 6), gridDim.x * 8, tid & 63);
        }
#pragma unroll 1
        for (int b = 0; b < 2; ++b) {
            const float* Xin = (l == 0 ? p.in[0] : X) + (size_t)b * TB * D;
            float* Xb = X + (size_t)b * TB * D;
            { unsigned char* ws = opq(p.ws()); rmsnorm_rows(Xin, p.in[1] + l * D, (bf16_t*)(ws + WS_XN), TB); }
            if (l == 0 && b == 0) grid.sync(); else GSYNC();
#if PHM & 1
            for (int rep_ = 0; rep_ < ((REP & 1) ? 2 : 1); ++rep_) {
            {
                unsigned char* ws = opq(p.ws()); const bf16_t* WL = (const bf16_t*)(ws + WS_W);
                pg8::Gemm g{(const bf16_t*)(ws + WS_XN), WL + WO_IN, TB, 7168, D, D, D, 0};
                pg8::StaticOrder S; S.init(g.M, g.N, (int)gridDim.x, (int)blockIdx.x);
                pg8::gemm_phase<pg8::EpiProjP, pg8::StaticOrder, true, true>((PG8_LAS unsigned char*)dl, g, S, pg8::EpiProjP{(bf16_t*)(ws + WS_PM), (bf16_t*)(ws + WS_G)});
            }
            }
#endif
            GSYNC();
#if PHM & 2
            for (int rep_ = 0; rep_ < ((REP & 2) ? 2 : 1); ++rep_) {
            for (int ps_ = 0; ps_ < ((REPP == 2) ? 2 : 1); ++ps_)
            for (int n = blockIdx.x; n < 512; n += gridDim.x) {
                if (ps_ == 1 && ((n < 256) ? 1 : 2) != REPU) continue;
                unsigned char* ws = opq(p.ws());
                if (n < 256) gdn_prep_chunk((const bf16_t*)(ws + WS_PM), n, gdn_bufs(ws), p, l, (LAS float*)dl);
                else { const bf16_t* WL = (const bf16_t*)(ws + WS_W); rwkv_prep_chunk((const bf16_t*)(ws + WS_PM), n - 256, rwkv_bufs(ws), p, l, WL + WO_WUP, WL + WO_AUP, WL + WO_GUP, (LAS unsigned char*)dl); }
            }
            }
#endif
            if (gridDim.x == 256) {
                asm volatile("s_waitcnt vmcnt(0)" ::: "memory"); __syncthreads();
                if (threadIdx.x == 0) { __builtin_amdgcn_fence(__ATOMIC_ACQUIRE, "agent"); asm volatile("s_waitcnt vmcnt(0)" ::: "memory"); }
                __syncthreads();
            } else GSYNC();
#if PHM & 4
            for (int rep_ = 0; rep_ < ((REP & 4) ? 2 : 1); ++rep_) {
            for (int ps_ = 0; ps_ < ((REPP == 4) ? 2 : 1); ++ps_)
            for (int u = blockIdx.x; u < 2048; u += gridDim.x) {
                const int ut_ = u < 1024 ? 1 : 2;
                if (ps_ == 1 && ut_ != REPU) continue;
                unsigned char* ws = opq(p.ws());
                if (u < 1024) gdn_g1_unit(u >> 8, u & 255, gdn_bufs(ws), (bf16_t*)(ws + WS_Y), (LAS unsigned char*)dl);
                else rwkv_g1_unit((u - 1024) >> 8, u & 255, rwkv_bufs(ws), (bf16_t*)(ws + WS_Y), (LAS unsigned char*)dl);
            }
            }
#endif
            GSYNC();
#if PHM & 8
            for (int rep_ = 0; rep_ < ((REP & 8) ? 2 : 1); ++rep_) {
            {
                const int tid = opq_tid(), lane = tid & 63, wv = tid >> 6;
                const int bx = blockIdx.x;
                volatile LAS unsigned* flags = (volatile LAS unsigned*)((LAS unsigned char*)dl + FUSED_LDS + 768);
                if (tid < 16) flags[tid] = 0u;
                __syncthreads();
                if (bx < 32) {
                    unsigned char* ws = opq(p.ws());
                    const GdnBufs B = gdn_bufs(ws); const int sq = bx >> 2, cb = bx & 3;
                    if (wv == 0) chain_wave(B.HT + (size_t)sq * 256 * 4096, cb, 256, lane, (LAS unsigned char*)dl, flags);
                    else chain_loader(B.MF + (size_t)sq * 256 * 1024, B.NF + (size_t)sq * 256 * 4096, cb, 256, lane, wv - 1, (LAS unsigned char*)dl, flags);
                } else {
                    for (int u = bx - 32; u < 512; u += (int)gridDim.x - 32) {
                        unsigned char* ws = opq(p.ws());
                        if (u < 256) lru_unit<1>((const bf16_t*)(ws + WS_PM), u, lru_bufs(ws), (bf16_t*)(ws + WS_Y), p, l, (const bf16_t*)(ws + WS_W) + WO_LWT, (LAS float*)dl);
                        else s5_unit<1>((const bf16_t*)(ws + WS_PM), u - 256, s5_bufs(ws), (bf16_t*)(ws + WS_Y), p, l, (const bf16_t*)(ws + WS_W), (LAS unsigned char*)dl);
                    }
                    sub_barrier((unsigned*)(p.ws() + WS_CTL + 15488), (unsigned)(gridDim.x - 32) * (unsigned)(l * 2 + b + 1));
                    {
                        unsigned char* ws = opq(p.ws());
                        for (int job = (bx - 32) * 8 + wv; job < 1280; job += (int)(gridDim.x - 32) * 8) {
                            if (job < 256) lru_carry_wave(lru_bufs(ws), job, lane);
                            else s5_carry_wave(s5_bufs(ws), p, l, job - 256, lane);
                        }
                    }
                    sub_barrier((unsigned*)(p.ws() + WS_CTL + 15360), (unsigned)(gridDim.x - 32) * (unsigned)(l * 2 + b + 1));
                    for (int u = bx - 32; u < 512; u += (int)gridDim.x - 32) {
                        unsigned char* ws = opq(p.ws());
                        if (u < 256) lru_unit<3>((const bf16_t*)(ws + WS_PM), u, lru_bufs(ws), (bf16_t*)(ws + WS_Y), p, l, (const bf16_t*)(ws + WS_W) + WO_LWT, (LAS float*)dl);
                        else s5_unit<3>((const bf16_t*)(ws + WS_PM), u - 256, s5_bufs(ws), (bf16_t*)(ws + WS_Y), p, l, (const bf16_t*)(ws + WS_W), (LAS unsigned char*)dl);
                    }
                }
            }
            }
#endif
            GSYNC();
#if PHM & 16
            for (int rep_ = 0; rep_ < ((REP & 16) ? 2 : 1); ++rep_) {
            for (int ps_ = 0; ps_ < ((REPP == 16) ? 2 : 1); ++ps_)
            for (int u = blockIdx.x; u < 2048; u += gridDim.x) {
                const int ut_ = u < 1024 ? 1 : (u < 2048 ? 2 : (u < 2304 ? 3 : 4));
                if (ps_ == 1 && ut_ != REPU) continue;
                unsigned char* ws = opq(p.ws());
                if (u < 1024) gdn_g3_unit(u >> 8, u & 255, gdn_bufs(ws), (const bf16_t*)(ws + WS_PM), (bf16_t*)(ws + WS_Y), p.in[6] + l * 64, (LAS unsigned char*)dl);
                else rwkv_g3_unit((u - 1024) >> 8, u & 255, rwkv_bufs(ws), (bf16_t*)(ws + WS_Y), p, l, (LAS unsigned char*)dl);
            }
            }
#endif
            GSYNC();
#if PHM & 32
            for (int rep_ = 0; rep_ < ((REP & 32) ? 2 : 1); ++rep_) {
            { unsigned char* ws = opq(p.ws()); merge_phase((const bf16_t*)(ws + WS_Y), (const bf16_t*)(ws + WS_W) + WO_BR, (const bf16_t*)(ws + WS_G), (bf16_t*)(ws + WS_MG), (LAS unsigned char*)dl); }
            }
#endif
            GSYNC();
#if PHM & 64
            {
                unsigned char* ws = opq(p.ws()); const bf16_t* WL = (const bf16_t*)(ws + WS_W);
                pg8::Gemm g{(const bf16_t*)(ws + WS_MG), WL + WO_OUT, TB, D, D, D, D, 0};
                pg8::StaticOrder S; S.init(g.M, g.N, (int)gridDim.x, (int)blockIdx.x);
                pg8::gemm_phase<pg8::EpiResidNormP, pg8::StaticOrder, false, true>((PG8_LAS unsigned char*)dl, g, S, pg8::EpiResidNormP{Xin, Xb, (bf16_t*)(ws + WS_XN), (float*)(ws + WS_SS)});
            }
#endif
            GSYNC();
#if PHM & 128
            for (int rep_ = 0; rep_ < ((REP & 128) ? 2 : 1); ++rep_) {
            {
                unsigned char* ws = opq(p.ws()); const bf16_t* WL = (const bf16_t*)(ws + WS_W);
                pg8::Gemm g{(const bf16_t*)(ws + WS_XN), WL + WO_W1, TB, DFF, D, D, D, 0};
                pg8::StaticOrder S; S.init(g.M, g.N, (int)gridDim.x, (int)blockIdx.x);
                pg8::gemm_phase<pg8::EpiRelu2NormP, pg8::StaticOrder, true, true>((PG8_LAS unsigned char*)dl, g, S, pg8::EpiRelu2NormP{(bf16_t*)(ws + WS_HD), DFF, 0, (const float*)(ws + WS_SS)});
            }
            }
#endif
            GSYNC();
#if PHM & 256
            {
                unsigned char* ws = opq(p.ws()); const bf16_t* WL = (const bf16_t*)(ws + WS_W);
                pg8::Gemm g{(const bf16_t*)(ws + WS_HD), WL + WO_W2, TB, D, DFF, DFF, DFF, 0};
                pg8::StaticOrder S; S.init(g.M, g.N, (int)gridDim.x, (int)blockIdx.x);
                pg8::gemm_phase<pg8::EpiResidP, pg8::StaticOrder, false, true>((PG8_LAS unsigned char*)dl, g, S, pg8::EpiResidP{Xb, Xb});
            }
#endif
            GSYNC();
        }
    }
    rmsnorm_rows(X, p.in[40], X, 2 * TB);
}

extern "C" void kernel_launch(void* const* d_in, const int* in_sizes, int n_in, void* d_out, int out_size, void* d_ws, size_t ws_size, hipStream_t stream) {
    KParams p{};
    for (int i = 0; i < 41; ++i) p.in[i] = (const float*)d_in[i];
    p.out = (float*)d_out; p.ws = (unsigned char*)d_ws; p.pad = 0;
    static int grid = 0;
    if (grid == 0) {
        int dev = 0, cus = 0, per_cu = 0;
        hipGetDevice(&dev);
        hipDeviceGetAttribute(&cus, hipDeviceAttributeMultiprocessorCount, dev);
        hipFuncSetAttribute((const void*)fwd_fused, hipFuncAttributeMaxDynamicSharedMemorySize, FUSED_LDS + 1024);
        hipOccupancyMaxActiveBlocksPerMultiprocessor(&per_cu, (const void*)fwd_fused, NT, FUSED_LDS + 1024);
        if (per_cu < 1) per_cu = 1;
        grid = cus * per_cu;
        if (grid > 256) grid = 256;
    }
    hipMemsetAsync((unsigned char*)d_ws + WS_CTL, 0, 16384, stream);
    void* args[] = {&p};
    hipError_t e = hipLaunchCooperativeKernel((const void*)fwd_fused, dim3(grid), dim3(NT), args, FUSED_LDS + 1024, stream);
    if (e != hipSuccess) fprintf(stderr, "cooperative launch failed: %s (grid %d)\n", hipGetErrorString(e), grid);
}
```

```cpp
#include <hip/hip_runtime.h>
#ifndef MEXP
#define MEXP 0
#endif
#ifndef PEXP
#define PEXP 0
#endif
#include <hip/hip_cooperative_groups.h>
#include <cstdio>
#include <cstdint>

constexpr int TB = 16384;
constexpr int D = 1024;
constexpr int DIN = 6920;
constexpr int NMIX = 2824;
constexpr int W = 256;
constexpr int DFF = 4096;
constexpr int NT = 512;

constexpr int C_GDN = 0, C_LRU = 1032, C_S5 = 1544, C_RWKV = 1800, C_GATE = 2824;

struct KParams { const float* in[41]; float* out; unsigned char* ws; size_t pad; };
#define LAS __attribute__((address_space(3)))
#define GAS __attribute__((address_space(1)))
struct PIn { LAS const unsigned long long* tab;
    __device__ __forceinline__ const float* operator[](int i) const { LAS const unsigned long long* t = tab; asm volatile("" : "+v"(t)); const unsigned long long v = t[i];
        const unsigned lo = __builtin_amdgcn_readfirstlane((unsigned)v), hi = __builtin_amdgcn_readfirstlane((unsigned)(v >> 32)); return (const float*)(GAS const float*)(((unsigned long long)hi << 32) | lo); } };
struct Params { PIn in;
    __device__ __forceinline__ float* out() const { return (float*)in[41]; }
    __device__ __forceinline__ unsigned char* ws() const { return (unsigned char*)in[42]; } };

typedef unsigned short bf16_t;
constexpr int PMLD = 3072;
constexpr size_t MiB = 1u << 20;
constexpr size_t WS_W  = 0;
constexpr size_t WS_CTL = 35 * MiB;
constexpr size_t WS_XN = 36 * MiB;
constexpr size_t WS_PM = 68 * MiB;
constexpr size_t WS_G  = 164 * MiB;
constexpr size_t WS_HD = 164 * MiB;
constexpr size_t WS_Y  = 292 * MiB;
constexpr size_t WS_MG = 324 * MiB;

__device__ __forceinline__ unsigned f2bf(float f) { unsigned u = __float_as_uint(f); return (u + 0x7fffu + ((u >> 16) & 1u)) >> 16; }
__device__ __forceinline__ float bf2f(bf16_t b) { return __uint_as_float((unsigned)b << 16); }
__device__ __forceinline__ float ldf(const float* p) { return *p; }
__device__ __forceinline__ float ldf(const bf16_t* p) { return bf2f(*p); }
__device__ __forceinline__ float sigmoidf_(float x) { return __builtin_amdgcn_rcpf(1.f + __expf(-x)); }
__device__ __forceinline__ float softplusf_(float x) { const float e = __expf(x); return x > 20.f ? x : (e < 1e-4f ? e : __logf(1.f + e)); }
__device__ __forceinline__ float siluf_(float x) { return x * sigmoidf_(x); }
__device__ __forceinline__ float tanhf_(float y) { return 1.f - 2.f * __builtin_amdgcn_rcpf(1.f + __expf(2.f * y)); }
__device__ __forceinline__ float geluf_(float x) { return 0.5f * x * (1.f + tanhf_(0.7978845608028654f * (x + 0.044715f * x * x * x))); }
__device__ __forceinline__ float rl(float v, int i) { return __int_as_float(__builtin_amdgcn_readlane(__float_as_int(v), i)); }
__device__ __forceinline__ float wave_sum(float v) {
#pragma unroll
    for (int o = 1; o < 64; o <<= 1) v += __shfl_xor(v, o);
    return v;
}

template <class OT>
__device__ __forceinline__ void rmsnorm_rows(const float* X, const float* g, OT* O, int rows) {
    int tid_ = threadIdx.x; asm volatile("" : "+v"(tid_));
    const int lane = tid_ & 63, wv = tid_ >> 6;
    const int gw = blockIdx.x * (NT / 64) + wv, ngw = gridDim.x * (NT / 64);
    for (int r = gw; r < rows; r += ngw) {
        const float4* xr = (const float4*)(X + (size_t)r * D);
        float4 v[4]; float s = 0.f;
#pragma unroll
        for (int j = 0; j < 4; ++j) { v[j] = xr[lane + 64 * j]; s += v[j].x * v[j].x + v[j].y * v[j].y + v[j].z * v[j].z + v[j].w * v[j].w; }
        s = wave_sum(s);
        const float rs = rsqrtf(s * (1.f / D) + 1e-6f);
#pragma unroll
        for (int j = 0; j < 4; ++j) {
            const float4 gg = ((const float4*)g)[lane + 64 * j];
            const float4 o = make_float4(v[j].x * rs * gg.x, v[j].y * rs * gg.y, v[j].z * rs * gg.z, v[j].w * rs * gg.w);
            if constexpr (sizeof(OT) == 4) ((float4*)(O + (size_t)r * D))[lane + 64 * j] = o;
            else ((uint2*)(O + (size_t)r * D))[lane + 64 * j] = make_uint2(f2bf(o.x) | (f2bf(o.y) << 16), f2bf(o.z) | (f2bf(o.w) << 16));
        }
    }
}

namespace pg8 {
#define PG8_LAS __attribute__((address_space(3)))
typedef short bf16x8 __attribute__((ext_vector_type(8)));
typedef float f32x4 __attribute__((ext_vector_type(4)));
typedef unsigned u32x4 __attribute__((ext_vector_type(4)));
constexpr int BM = 256, BK = 64, HALF = 128, HTB = HALF * BK * 2  , STAGE_BYTES = 8 * HTB, NXCD = 8, WGM = 8;

__host__ __device__ __forceinline__ int lds_byte(int r, int c) { const int st = (r >> 4) * 2 + (c >> 5), rr = r & 15, cc = c & 31, ob = rr * 64 + cc * 2; return st * 1024 + (ob ^ (((ob >> 9) & 1) << 5)); }
__host__ __device__ __forceinline__ void stage_rc(int b, int& R, int& C) { const int st = b / 1024, sb = b % 1024, swz = sb ^ (((sb >> 9) & 1) << 5); R = (st >> 1) * 16 + swz / 64; C = (st & 1) * 32 + (swz % 64) / 2; }
__host__ __device__ __forceinline__ int perm32(int rho) { const int n = rho >> 4, i = rho & 15; return 8 * (i >> 2) + 4 * n + (i & 3); }

struct Unit { int pm, pn; };
struct Gemm { const bf16_t* A; const bf16_t* Bt; int M, N, K, lda, ldb, pad; };

struct StaticOrder {
    int nM, nN, nwg, G, c;
    __host__ __device__ void init(int M, int N, int G_, int c_) { nM = M / BM; nN = N / BM; nwg = nM * nN; G = G_; c = c_; }
    __host__ __device__ bool next(int i, Unit& u) const {
        const long L = (long)i * G + c; if (L >= nwg) return false;
        int wgid = (int)L; { const int q = nwg / NXCD, r = nwg % NXCD, xcd = wgid % NXCD, off = wgid / NXCD; wgid = (xcd < r ? xcd * (q + 1) : r * (q + 1) + (xcd - r) * q) + off; }
        const int nig = WGM * nN, gid = wgid / nig, fm = gid * WGM, gsz = (nM - fm) < WGM ? (nM - fm) : WGM;
        u.pm = fm + ((wgid % nig) % gsz); u.pn = (wgid % nig) / gsz; return true;
    }
    __device__ __forceinline__ void a_ready(const Unit&) const {}
    __device__ __forceinline__ void done(const Unit&) const {}
};


typedef __bf16 bf16x2p_t __attribute__((ext_vector_type(2)));
typedef float f32x2p_t __attribute__((ext_vector_type(2)));
__device__ __forceinline__ unsigned cvt_pk_bf16(float lo, float hi) { return __builtin_bit_cast(unsigned, __builtin_convertvector((f32x2p_t){lo, hi}, bf16x2p_t)); }
__device__ __forceinline__ float sigm(float x) { return __builtin_amdgcn_rcpf(1.f + __expf(-x)); }
struct EpiProjP {
    static constexpr bool PERM = true, AFTER_DRAIN = false;
    bf16_t* PM; bf16_t* G;
    __device__ __forceinline__ void operator()(const f32x4 (&acc)[2][2][4][2], const Unit& u, int wr, int wc, int fr, int fq) const {
        const int row0 = u.pm * BM + wr * 64 + fr;
        const bool sg = u.pn >= 12;
        bf16_t* base = sg ? G : PM; const int ld = sg ? 4096 : 3072; const int colt = (sg ? u.pn - 12 : u.pn) * BM;
        const int col0 = colt + wc * 32 + 8 * fq;
#pragma unroll
        for (int ai = 0; ai < 2; ++ai)
#pragma unroll
            for (int m = 0; m < 4; ++m) { bf16_t* rowp = base + (size_t)(row0 + ai * HALF + m * 16) * ld + col0;
#pragma unroll
                for (int bj = 0; bj < 2; ++bj) { f32x4 v0 = acc[ai][bj][m][0], v1 = acc[ai][bj][m][1];
                    if (sg) { v0[0] = sigm(v0[0]); v0[1] = sigm(v0[1]); v0[2] = sigm(v0[2]); v0[3] = sigm(v0[3]); v1[0] = sigm(v1[0]); v1[1] = sigm(v1[1]); v1[2] = sigm(v1[2]); v1[3] = sigm(v1[3]); }
                    u32x4 w; w.x = cvt_pk_bf16(v0[0], v0[1]); w.y = cvt_pk_bf16(v0[2], v0[3]); w.z = cvt_pk_bf16(v1[0], v1[1]); w.w = cvt_pk_bf16(v1[2], v1[3]);
                    *(u32x4*)(rowp + bj * HALF) = w; } }
    }
};
struct EpiRelu2P {
    static constexpr bool PERM = true, AFTER_DRAIN = false;
    bf16_t* O; int ldo; int pad;
    __device__ __forceinline__ void operator()(const f32x4 (&acc)[2][2][4][2], const Unit& u, int wr, int wc, int fr, int fq) const {
        const int row0 = u.pm * BM + wr * 64 + fr, col0 = u.pn * BM + wc * 32 + 8 * fq;
#pragma unroll
        for (int ai = 0; ai < 2; ++ai)
#pragma unroll
            for (int m = 0; m < 4; ++m) { bf16_t* rowp = O + (size_t)(row0 + ai * HALF + m * 16) * ldo + col0;
#pragma unroll
                for (int bj = 0; bj < 2; ++bj) { f32x4 v0 = acc[ai][bj][m][0], v1 = acc[ai][bj][m][1];
#pragma unroll
                    for (int j = 0; j < 4; ++j) { const float a = fmaxf(v0[j], 0.f), b = fmaxf(v1[j], 0.f); v0[j] = a * a; v1[j] = b * b; }
                    u32x4 w; w.x = cvt_pk_bf16(v0[0], v0[1]); w.y = cvt_pk_bf16(v0[2], v0[3]); w.z = cvt_pk_bf16(v1[0], v1[1]); w.w = cvt_pk_bf16(v1[2], v1[3]);
                    *(u32x4*)(rowp + bj * HALF) = w; } }
    }
};
struct EpiResidP {
    static constexpr bool PERM = false, AFTER_DRAIN = false;
    const float* base; float* out;
    __device__ __forceinline__ void operator()(const f32x4 (&acc)[2][2][4][2], const Unit& u, int wr, int wc, int fr, int fq) const {
        const int row0 = u.pm * BM + wr * 64 + fr, col0 = u.pn * BM + wc * 32 + 4 * fq;
        f32x4 rb[4][4];
#define EPI_LD(g_) do { const size_t off_ = (size_t)(row0 + ((g_) >> 2) * HALF + ((g_) & 3) * 16) * 1024 + col0; \
            _Pragma("unroll") for (int bj = 0; bj < 2; ++bj) _Pragma("unroll") for (int n = 0; n < 2; ++n) rb[(g_) & 3][bj * 2 + n] = *(const f32x4*)(base + off_ + bj * HALF + n * 16); } while (0)
#define EPI_ST(g_) do { const size_t off_ = (size_t)(row0 + ((g_) >> 2) * HALF + ((g_) & 3) * 16) * 1024 + col0; \
            _Pragma("unroll") for (int bj = 0; bj < 2; ++bj) _Pragma("unroll") for (int n = 0; n < 2; ++n) *(f32x4*)(out + off_ + bj * HALF + n * 16) = rb[(g_) & 3][bj * 2 + n] + acc[(g_) >> 2][bj][(g_) & 3][n]; } while (0)
        EPI_LD(0); EPI_LD(1); EPI_LD(2);
        EPI_LD(3); EPI_ST(0); EPI_LD(4); EPI_ST(1); EPI_LD(5); EPI_ST(2); EPI_LD(6); EPI_ST(3); EPI_LD(7); EPI_ST(4);
        EPI_ST(5); EPI_ST(6); EPI_ST(7);
#undef EPI_LD
#undef EPI_ST
    }
};
template <class Epi, class Sched, bool ALIGN_EPI = false, bool SP2 = false>
__device__ __forceinline__ void gemm_phase(PG8_LAS unsigned char* lds, const Gemm g, const Sched& S, const Epi& E) {
    int tid = threadIdx.x; asm volatile("" : "+v"(tid));
    const int wid = __builtin_amdgcn_readfirstlane(tid >> 6), lane = tid & 63, wr = wid >> 2, wc = wid & 3, fr = lane & 15, fq = lane >> 4;
    const int K = g.K, nt = K / BK;
    unsigned voffA[2], voffB[2];
#pragma unroll
    for (int i = 0; i < 2; ++i) { int R, C; stage_rc(tid * 16 + i * 8192, R, C); const int Rb = Epi::PERM ? ((R & ~31) + perm32(R & 31)) : R;
        voffA[i] = (unsigned)(R * g.lda + C) * 2u; voffB[i] = (unsigned)(Rb * g.ldb + C) * 2u; }
    const size_t kstep = (size_t)(BK * 2);
    const size_t hstepA = (size_t)HALF * g.lda * 2, hstepB = (size_t)HALF * g.ldb * 2;
    const size_t tstepA = 2 * hstepA, tstepB = 2 * hstepB;
    const unsigned ldsw = (unsigned)wid * 1024u;
    const int aoff = lds_byte(wr * 64 + fr, fq * 8), boff = lds_byte(wc * 32 + fr, fq * 8);
#define PG8_SA(b, h) (((b) * 2 + (h)) * HTB)
#define PG8_SB(b, h) ((4 + (b) * 2 + (h)) * HTB)
#define PG8_STAGE(bufoff, gbase, voff) do { _Pragma("unroll") for (int _i = 0; _i < 2; ++_i) \
        __builtin_amdgcn_global_load_lds((const unsigned*)((const char*)(gbase) + (voff)[_i]), (PG8_LAS unsigned*)(lds + (bufoff) + ldsw + _i * 8192), 16, 0, 0); } while (0)
#define PG8_LDA(dst, b, h) do { _Pragma("unroll") for (int m = 0; m < 4; ++m) _Pragma("unroll") for (int k = 0; k < 2; ++k) dst[m][k] = *(const PG8_LAS bf16x8*)(lds + PG8_SA(b, h) + aoff + m * 2048 + k * 1024); } while (0)
#define PG8_LDB(dst, b, h) do { _Pragma("unroll") for (int n = 0; n < 2; ++n) _Pragma("unroll") for (int k = 0; k < 2; ++k) dst[n][k] = *(const PG8_LAS bf16x8*)(lds + PG8_SB(b, h) + boff + n * 2048 + k * 1024); } while (0)
#define PG8_MMA(ai, bj, At, Bt) do { __builtin_amdgcn_s_setprio(1); _Pragma("unroll") for (int m = 0; m < 4; ++m) _Pragma("unroll") for (int n = 0; n < 2; ++n) _Pragma("unroll") for (int k = 0; k < 2; ++k) \
        acc[ai][bj][m][n] = __builtin_amdgcn_mfma_f32_16x16x32_bf16(Bt[n][k], At[m][k], acc[ai][bj][m][n], 0, 0, 0); __builtin_amdgcn_s_setprio(0); } while (0)
#define PG8_WAIT_V(n) asm volatile("s_waitcnt vmcnt(" #n ")" ::: "memory")
#define PG8_WAIT_L(n) asm volatile("s_waitcnt lgkmcnt(" #n ")" ::: "memory")
#define PG8_BAR __builtin_amdgcn_s_barrier()
#define PG8_SCHED __builtin_amdgcn_sched_barrier(0)
    Unit cur, nxt; int ui = 0;
    if (!S.next(0, cur)) return;
    f32x4 acc[2][2][4][2];
#pragma unroll
    for (int a = 0; a < 2; ++a)
#pragma unroll
        for (int b = 0; b < 2; ++b)
#pragma unroll
            for (int m = 0; m < 4; ++m)
#pragma unroll
                for (int n = 0; n < 2; ++n) acc[a][b][m][n] = (f32x4){0.f, 0.f, 0.f, 0.f};
    bf16x8 At[4][2], B0[2][2], B1[2][2];
    const char* cA = (const char*)g.A + (size_t)cur.pm * tstepA; const char* cB = (const char*)g.Bt + (size_t)cur.pn * tstepB;
    S.a_ready(cur);
    if constexpr (SP2) {
        PG8_STAGE(PG8_SB(0, 0), cB, voffB); PG8_STAGE(PG8_SB(0, 1), cB + hstepB, voffB); PG8_STAGE(PG8_SA(0, 0), cA, voffA); PG8_STAGE(PG8_SA(0, 1), cA + hstepA, voffA);
        if (wr == 1) PG8_BAR;
        PG8_WAIT_V(2); PG8_BAR;
        PG8_STAGE(PG8_SB(1, 0), cB + kstep, voffB); PG8_STAGE(PG8_SA(1, 0), cA + kstep, voffA); PG8_STAGE(PG8_SB(1, 1), cB + hstepB + kstep, voffB);
        PG8_WAIT_V(6); PG8_BAR;
    } else {
        PG8_STAGE(PG8_SB(0, 0), cB, voffB); PG8_STAGE(PG8_SA(0, 0), cA, voffA); PG8_STAGE(PG8_SB(0, 1), cB + hstepB, voffB); PG8_STAGE(PG8_SA(0, 1), cA + hstepA, voffA);
        if (wr == 1) PG8_BAR;
        PG8_WAIT_V(4); PG8_BAR;
        PG8_STAGE(PG8_SB(1, 0), cB + kstep, voffB); PG8_STAGE(PG8_SA(1, 0), cA + kstep, voffA); PG8_STAGE(PG8_SB(1, 1), cB + hstepB + kstep, voffB);
        PG8_WAIT_V(6); PG8_BAR;
    }
    for (;;) {
        const bool has_next = S.next(ui + 1, nxt);
        const char* nA = has_next ? (const char*)g.A + (size_t)nxt.pm * tstepA : cA; const char* nB = has_next ? (const char*)g.Bt + (size_t)nxt.pn * tstepB : cB;
        for (int t = 0; t < nt; t += 2) {
            const bool last = (t == nt - 2);
            const char* a1 = cA + (size_t)(t + 1) * kstep;
            const char* a2 = last ? nA : cA + (size_t)(t + 2) * kstep; const char* b2 = last ? nB : cB + (size_t)(t + 2) * kstep;
            const char* a3 = a2 + kstep; const char* b3 = b2 + kstep;
            if (last && has_next) S.a_ready(nxt);
            if constexpr (SP2) {
            PG8_LDB(B0, 0, 0); PG8_LDB(B1, 0, 1); PG8_SCHED; PG8_LDA(At, 0, 0); PG8_STAGE(PG8_SA(1, 1), a1 + hstepA, voffA);
            PG8_WAIT_V(8); PG8_WAIT_L(0); PG8_BAR; PG8_MMA(0, 0, At, B0); PG8_MMA(0, 1, At, B1); PG8_BAR; PG8_SCHED;
            PG8_LDA(At, 0, 1); PG8_STAGE(PG8_SB(0, 0), b2, voffB); PG8_STAGE(PG8_SB(0, 1), b2 + hstepB, voffB); PG8_STAGE(PG8_SA(0, 0), a2, voffA);
            PG8_WAIT_V(8); PG8_WAIT_L(0); PG8_BAR; PG8_MMA(1, 0, At, B0); PG8_MMA(1, 1, At, B1); PG8_BAR; PG8_SCHED;
            PG8_LDB(B0, 1, 0); PG8_LDB(B1, 1, 1); PG8_SCHED; PG8_LDA(At, 1, 0); PG8_STAGE(PG8_SA(0, 1), a2 + hstepA, voffA);
            PG8_WAIT_V(8); PG8_WAIT_L(0); PG8_BAR; PG8_MMA(0, 0, At, B0); PG8_MMA(0, 1, At, B1); PG8_BAR; PG8_SCHED;
            PG8_LDA(At, 1, 1); PG8_STAGE(PG8_SB(1, 0), b3, voffB); PG8_STAGE(PG8_SB(1, 1), b3 + hstepB, voffB); PG8_STAGE(PG8_SA(1, 0), a3, voffA);
            PG8_WAIT_V(8); PG8_WAIT_L(0); PG8_BAR; PG8_MMA(1, 0, At, B0); PG8_MMA(1, 1, At, B1); PG8_BAR; PG8_SCHED;
            } else {
            PG8_LDB(B0, 0, 0); PG8_SCHED; PG8_LDA(At, 0, 0); PG8_STAGE(PG8_SA(1, 1), a1 + hstepA, voffA);
            PG8_WAIT_L(8); PG8_BAR; PG8_WAIT_L(0); PG8_MMA(0, 0, At, B0); PG8_BAR; PG8_SCHED;
            PG8_LDB(B1, 0, 1); PG8_STAGE(PG8_SB(0, 0), b2, voffB);
            PG8_BAR; PG8_WAIT_L(0); PG8_MMA(0, 1, At, B1); PG8_BAR;
            PG8_LDA(At, 0, 1); PG8_STAGE(PG8_SA(0, 0), a2, voffA);
            PG8_BAR; PG8_WAIT_L(0); PG8_MMA(1, 0, At, B0); PG8_BAR; PG8_SCHED;
            PG8_STAGE(PG8_SB(0, 1), b2 + hstepB, voffB);
            PG8_WAIT_V(6); PG8_BAR; PG8_MMA(1, 1, At, B1); PG8_BAR;
            PG8_LDB(B0, 1, 0); PG8_SCHED; PG8_LDA(At, 1, 0); PG8_STAGE(PG8_SA(0, 1), a2 + hstepA, voffA);
            PG8_WAIT_L(8); PG8_BAR; PG8_WAIT_L(0); PG8_MMA(0, 0, At, B0); PG8_BAR; PG8_SCHED;
            PG8_LDB(B1, 1, 1); PG8_STAGE(PG8_SB(1, 0), b3, voffB);
            PG8_BAR; PG8_WAIT_L(0); PG8_MMA(0, 1, At, B1); PG8_BAR;
            PG8_LDA(At, 1, 1); PG8_STAGE(PG8_SA(1, 0), a3, voffA);
            PG8_BAR; PG8_WAIT_L(0); PG8_MMA(1, 0, At, B0); PG8_BAR; PG8_SCHED;
            PG8_STAGE(PG8_SB(1, 1), b3 + hstepB, voffB);
            PG8_WAIT_V(6); PG8_BAR; PG8_MMA(1, 1, At, B1); PG8_BAR;
            }
        }
        if constexpr (ALIGN_EPI) { if (wr == 0) PG8_BAR; }
        if constexpr (!Epi::AFTER_DRAIN) { E(acc, cur, wr, wc, fr, fq); S.done(cur); }
        if (!has_next) break;
#pragma unroll
        for (int a = 0; a < 2; ++a)
#pragma unroll
            for (int b = 0; b < 2; ++b)
#pragma unroll
                for (int m = 0; m < 4; ++m)
#pragma unroll
                    for (int n = 0; n < 2; ++n) acc[a][b][m][n] = (f32x4){0.f, 0.f, 0.f, 0.f};
        cur = nxt; cA = nA; cB = nB; ++ui;
        if constexpr (ALIGN_EPI) { if (wr == 1) PG8_BAR; }
    }
    PG8_WAIT_V(0);
    if constexpr (!ALIGN_EPI) { if (wr == 0) PG8_BAR; }
    PG8_BAR;
    if constexpr (Epi::AFTER_DRAIN) { E.fused(acc, cur, wr, wc, fr, fq, lds, wid, lane); S.done(cur); }
#undef PG8_SA
#undef PG8_SB
#undef PG8_STAGE
#undef PG8_LDA
#undef PG8_LDB
#undef PG8_MMA
#undef PG8_WAIT_V
#undef PG8_WAIT_L
#undef PG8_BAR
#undef PG8_SCHED
}
}


__device__ __forceinline__ unsigned pk2(float lo, float hi) { return f2bf(lo) | (f2bf(hi) << 16); }
template <class CM>
__device__ __forceinline__ void transpose_item(const float* __restrict__ Wsrc, int K, int ldsrc, bf16_t* __restrict__ WT, int nblk, LAS float* scr, int item, int lane, CM colmap) {
    const int kb = item / nblk, nb = item % nblk, k0 = 64 * kb, n0 = 32 * nb;
    const int sc = colmap(n0 + (lane & 31));
#pragma unroll 8
    for (int i = 0; i < 32; ++i) { const int kk = 2 * i + (lane >> 5); const float wv_ = Wsrc[(size_t)(k0 + kk) * ldsrc + (sc >= 0 ? sc : 0)]; scr[kk * 33 + (lane & 31)] = sc >= 0 ? wv_ : 0.f; }
    asm volatile("s_waitcnt lgkmcnt(0)" ::: "memory");
    const int c = lane & 7;
#pragma unroll
    for (int j = 0; j < 4; ++j) { const int n = (lane >> 3) + 8 * j; const LAS float* s = scr + (8 * c) * 33 + n;
        uint4 o; o.x = pk2(s[0 * 33], s[1 * 33]); o.y = pk2(s[2 * 33], s[3 * 33]); o.z = pk2(s[4 * 33], s[5 * 33]); o.w = pk2(s[6 * 33], s[7 * 33]);
        *(uint4*)(WT + (size_t)(n0 + n) * K + k0 + 8 * c) = o; }
    asm volatile("s_waitcnt lgkmcnt(0)" ::: "memory");
}
constexpr size_t WO_IN = 0;
constexpr size_t WO_BR = WO_IN + (size_t)7168 * 1024;
constexpr size_t WO_OUT = WO_BR + (size_t)4 * 1024 * 256;
constexpr size_t WO_W1 = WO_OUT + (size_t)1024 * 1024;
constexpr size_t WO_W2 = WO_W1 + (size_t)4096 * 1024;
constexpr size_t WO_WUP = WO_W2 + (size_t)4096 * 1024;
constexpr size_t WO_AUP = WO_WUP + 256 * 64;
constexpr size_t WO_GUP = WO_AUP + 256 * 64;
constexpr size_t WO_GLU = WO_GUP + 256 * 128;
constexpr size_t WO_LWT = WO_GLU + 256 * 256;
constexpr size_t WO_S5B = WO_LWT + 2 * 16384;
constexpr size_t WO_S5C = WO_S5B + 16 * 8 * 64 * 8;
constexpr size_t WO_LAYER = WO_S5C + 16 * 4 * 64 * 8;
__device__ __forceinline__ void convert_weights(const Params& p, int l, LAS float* scr, int gw, int ngw, int lane) {
    bf16_t* WB = (bf16_t*)(p.ws() + WS_W);
    constexpr int I_IN = (1024 / 64) * (7168 / 32), I_BR = (256 / 64) * (1024 / 32), I_OUT = (1024 / 64) * (1024 / 32), I_W1 = (1024 / 64) * (4096 / 32), I_W2 = (4096 / 64) * (1024 / 32);
    constexpr int I_UP = 8, I_GUP = 16, I_GLU = 4 * 8, I_LW = 16, I_S5B = 128, I_S5C = 64;
    constexpr int PER_LAYER = I_IN + 4 * I_BR + I_OUT + I_W1 + I_W2 + 2 * I_UP + I_GUP + I_GLU + I_LW + I_S5B + I_S5C;
    for (int it = gw; it < PER_LAYER; it += ngw) {
        int r = it;
        bf16_t* WL = WB;
        if (r < I_IN) { transpose_item(p.in[2] + (size_t)l * D * DIN, 1024, DIN, WL + WO_IN, 7168 / 32, scr, r, lane, [](int j) { return j < NMIX ? j : (j < 3072 ? -1 : j - 248); }); continue; } r -= I_IN;
        if (r < 4 * I_BR) { const int i = r / I_BR; transpose_item(p.in[35] + ((size_t)l * 4 + i) * W * D, 256, D, WL + WO_BR + (size_t)i * 1024 * 256, 1024 / 32, scr, r % I_BR, lane, [](int j) { return j; }); continue; } r -= 4 * I_BR;
        if (r < I_OUT) { transpose_item(p.in[36] + (size_t)l * D * D, 1024, D, WL + WO_OUT, 1024 / 32, scr, r, lane, [](int j) { return j; }); continue; } r -= I_OUT;
        if (r < I_W1) { transpose_item(p.in[38] + (size_t)l * D * DFF, 1024, DFF, WL + WO_W1, 4096 / 32, scr, r, lane, [](int j) { return j; }); continue; } r -= I_W1;
        if (r < I_W2) { transpose_item(p.in[39] + (size_t)l * DFF * D, 4096, D, WL + WO_W2, 1024 / 32, scr, r, lane, [](int j) { return j; }); continue; } r -= I_W2;
        if (r < I_UP) { transpose_item(p.in[26] + (size_t)l * 64 * W, 64, W, WL + WO_WUP, 8, scr, r, lane, [](int j) { return j; }); continue; } r -= I_UP;
        if (r < I_UP) { transpose_item(p.in[28] + (size_t)l * 64 * W, 64, W, WL + WO_AUP, 8, scr, r, lane, [](int j) { return j; }); continue; } r -= I_UP;
        if (r < I_GUP) { transpose_item(p.in[29] + (size_t)l * 128 * W, 128, W, WL + WO_GUP, 8, scr, r, lane, [](int j) { return j; }); continue; } r -= I_GUP;
        if (r < I_GLU) { transpose_item(p.in[22] + (size_t)l * W * W, 256, W, WL + WO_GLU, 8, scr, r, lane, [](int j) { return j; }); continue; } r -= I_GLU;
        if (r < I_LW) { const int gt = r >> 3, nb = (r >> 1) & 3; transpose_item((gt ? p.in[11] : p.in[9]) + (size_t)l * 16384 + nb * 4096, 64, 64, WL + WO_LWT + (size_t)gt * 16384 + nb * 4096, 2, scr, r & 1, lane, [](int j) { return j; }); continue; } r -= I_LW;
        if (r < I_S5B) {
            const int g = r >> 3, tn = r & 7, q4 = lane >> 4, cc = lane & 15, n = 16 * tn + cc, pp = n >> 1, ri = n & 1;
            const float dt = __expf(p.in[21][l * 16 + g]);
            const float lre = p.in[14][l * 1024 + g * 64 + pp], lim = p.in[15][l * 1024 + g * 64 + pp];
            const float er = __expf(lre * dt), lbr = er * cosf(lim * dt), lbi = er * sinf(lim * dt);
            const float nr = lbr - 1.f, ni = lbi, den = lre * lre + lim * lim;
            const float fr = (nr * lre + ni * lim) / den, fi = (ni * lre - nr * lim) / den;
            float v[8];
#pragma unroll
            for (int j = 0; j < 8; ++j) { float x = 0.f;
                if (q4 < 2) { const float br = p.in[16][(size_t)l * 16384 + (g * 64 + pp) * 16 + 8 * q4 + j], bi = p.in[17][(size_t)l * 16384 + (g * 64 + pp) * 16 + 8 * q4 + j]; x = ri ? (fr * bi + fi * br) : (fr * br - fi * bi); }
                v[j] = x; }
            *(uint4*)(WL + WO_S5B + ((size_t)(g * 8 + tn) * 64 + lane) * 8) = make_uint4(pk2(v[0], v[1]), pk2(v[2], v[3]), pk2(v[4], v[5]), pk2(v[6], v[7]));
            continue; } r -= I_S5B;
        {
            const int g = r >> 2, ks = r & 3, q4 = lane >> 4, cc = lane & 15;
            const float* cre = p.in[18] + (size_t)l * 16384 + (g * 16 + cc) * 64 + 16 * ks + 4 * q4; const float* cim = p.in[19] + (size_t)l * 16384 + (g * 16 + cc) * 64 + 16 * ks + 4 * q4;
            *(uint4*)(WL + WO_S5C + ((size_t)(g * 4 + ks) * 64 + lane) * 8) = make_uint4(pk2(cre[0], -cim[0]), pk2(cre[1], -cim[1]), pk2(cre[2], -cim[2]), pk2(cre[3], -cim[3]));
        }
    }
}
#define BAR() do { asm volatile("s_waitcnt lgkmcnt(0)" ::: "memory"); __syncthreads(); } while (0)
typedef short bf16x8_t __attribute__((ext_vector_type(8)));
typedef float f32x4_t __attribute__((ext_vector_type(4)));
constexpr int PT = 68;
constexpr int MS = 64 * PT;
typedef __bf16 bf16x2v_t __attribute__((ext_vector_type(2)));
typedef float f32x2v_t __attribute__((ext_vector_type(2)));
__device__ __forceinline__ unsigned cvtpk(float lo, float hi) { return __builtin_bit_cast(unsigned, __builtin_convertvector((f32x2v_t){lo, hi}, bf16x2v_t)); }
typedef unsigned u32x4_t __attribute__((ext_vector_type(4)));
union U8 { bf16x8_t v; unsigned u[4]; uint4 q; u32x4_t x; };
__device__ __forceinline__ void split8(const float (&x)[8], bf16x8_t& hi, bf16x8_t& lo) {
    U8 H, L;
#pragma unroll
    for (int i = 0; i < 4; ++i) {
        const unsigned pk = cvtpk(x[2 * i], x[2 * i + 1]);
        H.u[i] = pk;
        const float f0 = __uint_as_float(pk << 16), f1 = __uint_as_float(pk & 0xffff0000u);
        L.u[i] = cvtpk(x[2 * i] - f0, x[2 * i + 1] - f1);
    }
    hi = H.v; lo = L.v;
}
__device__ __forceinline__ bf16x8_t hi8(const float (&x)[8]) {
    U8 H;
#pragma unroll
    for (int i = 0; i < 4; ++i) H.u[i] = cvtpk(x[2 * i], x[2 * i + 1]);
    return H.v;
}
template <int NSPLIT>
__device__ __forceinline__ f32x4_t mm_tile(const LAS float* A, const LAS float* Bt, int lane, f32x4_t acc) {
    const LAS float* ap = A + (lane & 15) * PT + 8 * (lane >> 4);
    const LAS float* bp = Bt + (lane & 15) * PT + 8 * (lane >> 4);
#pragma unroll
    for (int ks = 0; ks < 2; ++ks) {
        const f32x4_t a0 = *(const LAS f32x4_t*)(ap + 32 * ks), a1 = *(const LAS f32x4_t*)(ap + 32 * ks + 4);
        const f32x4_t b0 = *(const LAS f32x4_t*)(bp + 32 * ks), b1 = *(const LAS f32x4_t*)(bp + 32 * ks + 4);
        const float av[8] = {a0.x, a0.y, a0.z, a0.w, a1.x, a1.y, a1.z, a1.w};
        const float bv[8] = {b0.x, b0.y, b0.z, b0.w, b1.x, b1.y, b1.z, b1.w};
        if constexpr (NSPLIT == 3) {
            bf16x8_t ah, al, bh, bl; split8(av, ah, al); split8(bv, bh, bl);
            acc = __builtin_amdgcn_mfma_f32_16x16x32_bf16(ah, bh, acc, 0, 0, 0);
            acc = __builtin_amdgcn_mfma_f32_16x16x32_bf16(ah, bl, acc, 0, 0, 0);
            acc = __builtin_amdgcn_mfma_f32_16x16x32_bf16(al, bh, acc, 0, 0, 0);
        } else {
            acc = __builtin_amdgcn_mfma_f32_16x16x32_bf16(hi8(av), hi8(bv), acc, 0, 0, 0);
        }
    }
    return acc;
}
__device__ __forceinline__ int opq_tid() { int t = threadIdx.x; asm volatile("" : "+v"(t)); return t; }
__device__ __forceinline__ void tri_inverse_wave(LAS float* L, int lane) {
    asm volatile("" : "+v"(lane));
    asm volatile("" : "+v"(L));
    const float lf = (float)lane;
    float x[64];
#pragma unroll
    for (int i = 0; i < 64; ++i) {
        float s0 = 0.f, s1 = 0.f, s2 = 0.f, s3 = 0.f;
#pragma unroll
        for (int g4 = 0; g4 * 4 < i; ++g4) {
            const f32x4_t l = *(const LAS f32x4_t*)(L + i * PT + 4 * g4);
            s0 = fmaf(l.x, x[4 * g4], s0);
            if (4 * g4 + 1 < i) s1 = fmaf(l.y, x[4 * g4 + 1], s1);
            if (4 * g4 + 2 < i) s2 = fmaf(l.z, x[4 * g4 + 2], s2);
            if (4 * g4 + 3 < i) s3 = fmaf(l.w, x[4 * g4 + 3], s3);
        }
        x[i] = fmaxf(1.f - fabsf(lf - (float)i), 0.f) - ((s0 + s1) + (s2 + s3));
        L[i * PT + lane] = x[i];
        if ((i & 3) == 3) __builtin_amdgcn_sched_barrier(0);
    }
}
__device__ __forceinline__ float wave_incl_scan(float v, int lane) {
#pragma unroll
    for (int o = 1; o < 64; o <<= 1) { const float u = __shfl_up(v, o); if (lane >= o) v += u; }
    return v;
}

__device__ __forceinline__ void unpack8(const uint4 u, float (&o)[8]) {
    const unsigned w[4] = {u.x, u.y, u.z, u.w};
#pragma unroll
    for (int i = 0; i < 4; ++i) { o[2 * i] = __uint_as_float(w[i] << 16); o[2 * i + 1] = __uint_as_float(w[i] & 0xffff0000u); }
}
__device__ __forceinline__ uint4 pack8(const float (&x)[8]) { return make_uint4(cvtpk(x[0], x[1]), cvtpk(x[2], x[3]), cvtpk(x[4], x[5]), cvtpk(x[6], x[7])); }
typedef unsigned short LAS lds_bf16;
constexpr int MIX_LDS_C = 8 * MS * 4 + 1024;
__device__ __forceinline__ void merge_phase(const bf16_t* __restrict__ Yb, const bf16_t* __restrict__ WbT, const bf16_t* __restrict__ G, bf16_t* __restrict__ MG, LAS unsigned char* lds) {
    const int tid = opq_tid(), w = __builtin_amdgcn_readfirstlane(tid >> 6), lane = tid & 63, q4 = lane >> 4, cc = lane & 15;
    const int wr = w >> 2, wc = w & 3;
    constexpr int PA = 144;
    constexpr int ABUF = 128 * PA, BUF = 2 * ABUF;
    const int bid = blockIdx.x, G_ = gridDim.x;
    const int srow = tid >> 2, sk = (tid & 3) * 16;
#define MG_TILE(it_, pm_, pn_, ok_) do { const int U_ = (it_) * G_ + bid; ok_ = U_ < 1024; const int Lx_ = (G_ == 256) ? ((bid & 7) * 128 + (it_) * 32 + (bid >> 3)) : U_; pm_ = (Lx_ >> 3) & 127; pn_ = Lx_ & 7; } while (0)
    int pm, pn; bool ok; MG_TILE(0, pm, pn, ok);
    if (!ok) return;
    const bf16_t* Abase = Yb + (size_t)(pm * 128 + srow) * 1024 + sk;
    const bf16_t* Bbase = WbT + (size_t)(pn * 128 + srow) * 256 + sk;
    const bf16_t* gbase = G + (size_t)(pm * 128 + wr * 64 + cc) * 4096 + pn * 128 + wc * 32 + 4 * q4;
    uint4 r0[4], r1[4];
    uint2 gq[4][2];
#define MG_LOAD(R, ab_, bb_, s_) do { const bf16_t* ap_ = (ab_) + ((s_) >> 2) * 256 + ((s_) & 3) * 64; const bf16_t* bp_ = (bb_) + (size_t)((s_) >> 2) * 1024 * 256 + ((s_) & 3) * 64; \
            R[0] = *(const uint4*)ap_; R[1] = *(const uint4*)(ap_ + 8); R[2] = *(const uint4*)bp_; R[3] = *(const uint4*)(bp_ + 8); } while (0)
#define MG_GLOAD(GQ, gp_) do { _Pragma("unroll") for (int m = 0; m < 4; ++m) _Pragma("unroll") for (int n = 0; n < 2; ++n) GQ[m][n] = *(const uint2*)((gp_) + (size_t)m * 16 * 4096 + n * 16); } while (0)
#define MG_STORE(R, buf_) do { LAS unsigned char* ab_ = lds + (buf_) * BUF + srow * PA + sk * 2; \
            *(LAS u32x4_t*)ab_ = (u32x4_t){R[0].x, R[0].y, R[0].z, R[0].w}; *(LAS u32x4_t*)(ab_ + 16) = (u32x4_t){R[1].x, R[1].y, R[1].z, R[1].w}; \
            *(LAS u32x4_t*)(ab_ + ABUF) = (u32x4_t){R[2].x, R[2].y, R[2].z, R[2].w}; *(LAS u32x4_t*)(ab_ + ABUF + 16) = (u32x4_t){R[3].x, R[3].y, R[3].z, R[3].w}; } while (0)
#define MG_COMPUTE(buf_) do { const LAS unsigned char* ab_ = lds + (buf_) * BUF + (wr * 64 + cc) * PA + 16 * q4; const LAS unsigned char* bb_ = lds + (buf_) * BUF + ABUF + (wc * 32 + cc) * PA + 16 * q4; \
            _Pragma("unroll") for (int ks = 0; ks < 2; ++ks) { U8 bf_[2]; \
                _Pragma("unroll") for (int n = 0; n < 2; ++n) bf_[n].x = *(const LAS u32x4_t*)(bb_ + n * 16 * PA + ks * 64); \
                _Pragma("unroll") for (int m = 0; m < 4; ++m) { U8 af_; af_.x = *(const LAS u32x4_t*)(ab_ + m * 16 * PA + ks * 64); \
                    _Pragma("unroll") for (int n = 0; n < 2; ++n) acc[m][n] = __builtin_amdgcn_mfma_f32_16x16x32_bf16(bf_[n].v, af_.v, acc[m][n], 0, 0, 0); } } } while (0)
#define MG_STEP(j_, RL, RS) do { \
            if (((j_) & 3) == 0) { _Pragma("unroll") for (int m = 0; m < 4; ++m) _Pragma("unroll") for (int n = 0; n < 2; ++n) acc[m][n] = (f32x4_t){0.f, 0.f, 0.f, 0.f}; } \
            if ((j_) + 2 < 4) MG_LOAD(RL, Ae, Be, (j_) + 2); else if ((j_) + 2 < 8) MG_LOAD(RL, Ae + 256, Bo, (j_) + 2 - 4); else MG_LOAD(RL, An, Bn, (j_) + 2 - 8); \
            MG_COMPUTE((j_) & 1); \
            if (((j_) & 3) == 3) { \
                _Pragma("unroll") for (int m = 0; m < 4; ++m) _Pragma("unroll") for (int n = 0; n < 2; ++n) { uint2 g2_ = gq[m][n]; asm volatile("" : "+v"(g2_.x), "+v"(g2_.y));     \
                    mg[m][n][0] = fmaf(__uint_as_float(g2_.x << 16), acc[m][n][0], mg[m][n][0]); mg[m][n][1] = fmaf(__uint_as_float(g2_.x & 0xffff0000u), acc[m][n][1], mg[m][n][1]); \
                    mg[m][n][2] = fmaf(__uint_as_float(g2_.y << 16), acc[m][n][2], mg[m][n][2]); mg[m][n][3] = fmaf(__uint_as_float(g2_.y & 0xffff0000u), acc[m][n][3], mg[m][n][3]); } \
                if ((j_) == 3) MG_GLOAD(gq, ge + 1024); else MG_GLOAD(gq, gn); } \
            MG_STORE(RS, ((j_) + 1) & 1); \
            BAR(); } while (0)
    MG_LOAD(r0, Abase, Bbase, 0); MG_LOAD(r1, Abase, Bbase, 1); MG_GLOAD(gq, gbase);
    MG_STORE(r0, 0);
    BAR();
#pragma unroll 1
    for (int it = 0; ; ++it) {
        int npm, npn; bool has_next; MG_TILE(it + 1, npm, npn, has_next);
        if (!has_next) { npm = pm; npn = pn; }
        const bf16_t* nAbase = Yb + (size_t)(npm * 128 + srow) * 1024 + sk;
        const bf16_t* nBbase = WbT + (size_t)(npn * 128 + srow) * 256 + sk;
        const bf16_t* ngbase = G + (size_t)(npm * 128 + wr * 64 + cc) * 4096 + npn * 128 + wc * 32 + 4 * q4;
        f32x4_t mg[4][2], acc[4][2];
#pragma unroll
        for (int m = 0; m < 4; ++m)
#pragma unroll
            for (int n = 0; n < 2; ++n) { mg[m][n] = (f32x4_t){0.f, 0.f, 0.f, 0.f}; acc[m][n] = (f32x4_t){0.f, 0.f, 0.f, 0.f}; }
#pragma unroll 1
        for (int h = 0; h < 2; ++h) {
            const bf16_t* Ae = Abase + h * 512; const bf16_t* Be = Bbase + (size_t)h * 2 * 1024 * 256; const bf16_t* Bo = Be + 1024 * 256; const bf16_t* ge = gbase + h * 2048;
            const bf16_t* An = h ? nAbase : Abase + 512; const bf16_t* Bn = h ? nBbase : Bbase + (size_t)2 * 1024 * 256; const bf16_t* gn = h ? ngbase : gbase + 2048;
            MG_STEP(0, r0, r1); MG_STEP(1, r1, r0); MG_STEP(2, r0, r1); MG_STEP(3, r1, r0);
            MG_STEP(4, r0, r1); MG_STEP(5, r1, r0); MG_STEP(6, r0, r1); MG_STEP(7, r1, r0);
        }
        {
            bf16_t* op = MG + (size_t)(pm * 128 + wr * 64 + cc) * 1024 + pn * 128 + wc * 32 + 4 * q4;
#pragma unroll
            for (int m = 0; m < 4; ++m)
#pragma unroll
                for (int n = 0; n < 2; ++n) *(uint2*)(op + (size_t)m * 16 * 1024 + n * 16) = make_uint2(cvtpk(mg[m][n][0], mg[m][n][1]), cvtpk(mg[m][n][2], mg[m][n][3]));
        }
        if (!has_next) break;
        pm = npm; pn = npn; Abase = nAbase; Bbase = nBbase; gbase = ngbase;
    }
#undef MG_TILE
#undef MG_LOAD
#undef MG_GLOAD
#undef MG_STORE
#undef MG_COMPUTE
#undef MG_STEP
}

constexpr int PB = 72;
constexpr int PLBYTES = 64 * PB * 2;
typedef unsigned u32x2_t __attribute__((ext_vector_type(2)));
__device__ __forceinline__ lds_bf16* plane(LAS unsigned char* lds, int i) { return (lds_bf16*)(lds + i * PLBYTES); }
__device__ __forceinline__ void hilo2(float a, float b, unsigned& h, unsigned& l) { h = cvtpk(a, b); l = cvtpk(a - __uint_as_float(h << 16), b - __uint_as_float(h & 0xffff0000u)); }
__device__ __forceinline__ unsigned short bf_hi(float v) { return (unsigned short)(cvtpk(v, 0.f) & 0xffffu); }
template <bool LO>
__device__ __forceinline__ void put8(lds_bf16* Ph, lds_bf16* Pl, int r, int c0, const float (&x)[8]) {
    unsigned h[4], l[4];
#pragma unroll
    for (int i = 0; i < 4; ++i) hilo2(x[2 * i], x[2 * i + 1], h[i], l[i]);
    *(LAS u32x4_t*)(Ph + r * PB + c0) = (u32x4_t){h[0], h[1], h[2], h[3]};
    if (LO) *(LAS u32x4_t*)(Pl + r * PB + c0) = (u32x4_t){l[0], l[1], l[2], l[3]};
}
template <bool LO>
__device__ __forceinline__ void put8T(lds_bf16* Ph, lds_bf16* Pl, int r, int c0, const float (&x)[8]) {
#pragma unroll
    for (int i = 0; i < 4; ++i) {
        unsigned h, l; hilo2(x[2 * i], x[2 * i + 1], h, l);
        Ph[(c0 + 2 * i) * PB + r] = (unsigned short)(h & 0xffffu); Ph[(c0 + 2 * i + 1) * PB + r] = (unsigned short)(h >> 16);
        if (LO) { Pl[(c0 + 2 * i) * PB + r] = (unsigned short)(l & 0xffffu); Pl[(c0 + 2 * i + 1) * PB + r] = (unsigned short)(l >> 16); }
    }
}
__device__ __forceinline__ bf16x8_t frag(const lds_bf16* P, int row, int k) { U8 u; u.x = *(const LAS u32x4_t*)(P + row * PB + k); return u.v; }
template <bool AL, bool BL>
__device__ __forceinline__ f32x4_t mmp(const lds_bf16* Ah, const lds_bf16* Al, const lds_bf16* Bh, const lds_bf16* Bl, int ar0, int br0, int lane, f32x4_t acc) {
    const int r = lane & 15, k0 = 8 * (lane >> 4);
#pragma unroll
    for (int ks = 0; ks < 2; ++ks) {
        const bf16x8_t ah = frag(Ah, ar0 + r, 32 * ks + k0), bh = frag(Bh, br0 + r, 32 * ks + k0);
        acc = __builtin_amdgcn_mfma_f32_16x16x32_bf16(ah, bh, acc, 0, 0, 0);
        if (AL) acc = __builtin_amdgcn_mfma_f32_16x16x32_bf16(frag(Al, ar0 + r, 32 * ks + k0), bh, acc, 0, 0, 0);
        if (BL) acc = __builtin_amdgcn_mfma_f32_16x16x32_bf16(ah, frag(Bl, br0 + r, 32 * ks + k0), acc, 0, 0, 0);
    }
    return acc;
}
template <bool LO>
__device__ __forceinline__ void st_tile_T(lds_bf16* Ph, lds_bf16* Pl, int i0, int j0, int lane, const f32x4_t a) {
    unsigned h0, l0, h1, l1; hilo2(a[0], a[1], h0, l0); hilo2(a[2], a[3], h1, l1);
    const int o = (j0 + (lane & 15)) * PB + i0 + 4 * (lane >> 4);
    *(LAS u32x2_t*)(Ph + o) = (u32x2_t){h0, h1};
    if (LO) *(LAS u32x2_t*)(Pl + o) = (u32x2_t){l0, l1};
}
template <bool LO>
__device__ __forceinline__ void st_tile_R(lds_bf16* Ph, lds_bf16* Pl, int i0, int j0, int lane, const f32x4_t a) {
    unsigned h0, l0, h1, l1; hilo2(a[0], a[1], h0, l0); hilo2(a[2], a[3], h1, l1);
    const int o = (i0 + 4 * (lane >> 4)) * PB + j0 + (lane & 15);
    Ph[o] = (unsigned short)(h0 & 0xffffu); Ph[o + PB] = (unsigned short)(h0 >> 16); Ph[o + 2 * PB] = (unsigned short)(h1 & 0xffffu); Ph[o + 3 * PB] = (unsigned short)(h1 >> 16);
    if (LO) { Pl[o] = (unsigned short)(l0 & 0xffffu); Pl[o + PB] = (unsigned short)(l0 >> 16); Pl[o + 2 * PB] = (unsigned short)(l1 & 0xffffu); Pl[o + 3 * PB] = (unsigned short)(l1 >> 16); }
}
constexpr int LM_OFF = 13 * PLBYTES;
constexpr int VEC_OFF = LM_OFF + MS * 4;
static_assert(VEC_OFF + 1024 <= MIX_LDS_C, "plane LDS map");

struct GdnBufs { bf16_t *GQ, *GK, *GV; float *GB, *GC; uint4* MF; float* NF; float* HT; bf16_t* TG; };
__device__ __forceinline__ void gdn_prep_chunk(const bf16_t* __restrict__ PM, int n, const GdnBufs& B, const Params& p, int l, LAS float* lds) {
    const int tid = opq_tid(), w = tid >> 6, lane = tid & 63;
    const float* conv_w = p.in[3] + l * 4 * 768;
    const int t0 = n * 64;
    float wq[4][4], wk[4][4], wv[4][4];
#pragma unroll
    for (int t = 0; t < 4; ++t)
#pragma unroll
        for (int j = 0; j < 4; ++j) { wq[t][j] = conv_w[t * 768 + 4 * lane + j]; wk[t][j] = conv_w[t * 768 + 256 + 4 * lane + j]; wv[t][j] = conv_w[t * 768 + 512 + 4 * lane + j]; }
    float hq[3][4], hk[3][4], hv[3][4];
    auto ld4 = [&](int t, int col, float (&o)[4]) {
        uint2 u = *(const uint2*)(PM + (size_t)(t < 0 ? 0 : t) * PMLD + col);
        if (t < 0) u = make_uint2(0u, 0u);
        o[0] = __uint_as_float(u.x << 16); o[1] = __uint_as_float(u.x & 0xffff0000u); o[2] = __uint_as_float(u.y << 16); o[3] = __uint_as_float(u.y & 0xffff0000u);
    };
    const int tw = t0 + 8 * w;
#pragma unroll
    for (int i = 0; i < 3; ++i) { ld4(tw - 3 + i, 4 * lane, hq[i]); ld4(tw - 3 + i, 256 + 4 * lane, hk[i]); ld4(tw - 3 + i, 512 + 4 * lane, hv[i]); }
#pragma unroll
    for (int i = 0; i < 8; ++i) {
        const int t = tw + i;
        float pq[4], pk[4], pv[4], q[4], k[4], v[4];
        ld4(t, 4 * lane, pq); ld4(t, 256 + 4 * lane, pk); ld4(t, 512 + 4 * lane, pv);
        float sq = 0.f, sk = 0.f;
#pragma unroll
        for (int j = 0; j < 4; ++j) {
            q[j] = siluf_(wq[0][j] * hq[0][j] + wq[1][j] * hq[1][j] + wq[2][j] * hq[2][j] + wq[3][j] * pq[j]);
            k[j] = siluf_(wk[0][j] * hk[0][j] + wk[1][j] * hk[1][j] + wk[2][j] * hk[2][j] + wk[3][j] * pk[j]);
            v[j] = siluf_(wv[0][j] * hv[0][j] + wv[1][j] * hv[1][j] + wv[2][j] * hv[2][j] + wv[3][j] * pv[j]);
            hq[0][j] = hq[1][j]; hq[1][j] = hq[2][j]; hq[2][j] = pq[j];
            hk[0][j] = hk[1][j]; hk[1][j] = hk[2][j]; hk[2][j] = pk[j];
            hv[0][j] = hv[1][j]; hv[1][j] = hv[2][j]; hv[2][j] = pv[j];
            sq = fmaf(q[j], q[j], sq); sk = fmaf(k[j], k[j], sk);
        }
#pragma unroll
        for (int o = 1; o < 16; o <<= 1) { sq += __shfl_xor(sq, o); sk += __shfl_xor(sk, o); }
        const float rq = rsqrtf(sq + 1e-6f) * 0.125f, rk = rsqrtf(sk + 1e-6f);
        uint2 oq, ok, ov;
        oq.x = cvtpk(q[0] * rq, q[1] * rq); oq.y = cvtpk(q[2] * rq, q[3] * rq);
        ok.x = cvtpk(k[0] * rk, k[1] * rk); ok.y = cvtpk(k[2] * rk, k[3] * rk);
        ov.x = cvtpk(v[0], v[1]); ov.y = cvtpk(v[2], v[3]);
        *(uint2*)(B.GQ + (size_t)t * 256 + 4 * lane) = oq;
        *(uint2*)(B.GK + (size_t)t * 256 + 4 * lane) = ok;
        *(uint2*)(B.GV + (size_t)t * 256 + 4 * lane) = ov;
    }
    if (tid < 256) {
        const int t = tid >> 2, h = tid & 3;
        const bf16_t* row = PM + (size_t)(t0 + t) * PMLD;
        B.GB[(size_t)(t0 + t) * 4 + h] = sigmoidf_(bf2f(row[1024 + h]));
        const float* alog_ = p.in[4] + l * 4; const float* dtb_ = p.in[5] + l * 4;
        const float g = -__expf(alog_[h]) * softplusf_(bf2f(row[1028 + h]) + dtb_[h]);
        lds[h * 64 + t] = g;
    }
    BAR();
    if (w == 0) {
#pragma unroll
        for (int h = 0; h < 4; ++h) B.GC[(size_t)(t0 + lane) * 4 + h] = wave_incl_scan(lds[h * 64 + lane], lane);
    }
    BAR();
}

__device__ __forceinline__ float dpp_xor1(float v) { return __int_as_float(__builtin_amdgcn_update_dpp(0, __float_as_int(v), 0xB1, 0xF, 0xF, false)); }
__device__ __forceinline__ float dpp_xor2(float v) { return __int_as_float(__builtin_amdgcn_update_dpp(0, __float_as_int(v), 0x4E, 0xF, 0xF, false)); }
__device__ __forceinline__ void tri_inverse_4w(const LAS float* Lp, lds_bf16* Th, lds_bf16* Tl, int wq, int lane) {
    asm volatile("" : "+v"(lane));
    const int g = lane & 3, j = 16 * wq + (lane >> 2);
    const LAS float* base = Lp + g * 16; asm volatile("" : "+v"(base));
    const float jf = (float)j;
    float x[16];
#pragma unroll
    for (int m = 0; m < 16; ++m) x[m] = 0.f;
    f32x4_t cur[4], nxt[4];
#pragma unroll
    for (int q = 0; q < 4; ++q) cur[q] = (f32x4_t){0.f, 0.f, 0.f, 0.f};
#pragma unroll
    for (int i = 0; i < 64; ++i) {
        if (i + 1 < 64) {
#pragma unroll
            for (int q = 0; q < 4; ++q) if (16 * q < i + 1) nxt[q] = *(const LAS f32x4_t*)(base + (i + 1) * PT + 4 * q);
        }
        float s0 = 0.f, s1 = 0.f;
#pragma unroll
        for (int q = 0; q < 4; ++q) if (16 * q < i) {
            s0 = fmaf(cur[q].x, x[4 * q], s0); if (16 * q + 4 < i) s1 = fmaf(cur[q].y, x[4 * q + 1], s1);
            if (16 * q + 8 < i) s0 = fmaf(cur[q].z, x[4 * q + 2], s0); if (16 * q + 12 < i) s1 = fmaf(cur[q].w, x[4 * q + 3], s1);
        }
        float t = s0 + s1;
        t += dpp_xor1(t); t += dpp_xor2(t);
        const float xi = fmaxf(1.f - fabsf(jf - (float)i), 0.f) - t;
        if (g == (i & 3)) x[i >> 2] = xi;
        unsigned hh, ll; hilo2(xi, xi, hh, ll);
        if (g == 0) Th[i * PB + j] = (unsigned short)(hh & 0xffffu);
        if (g == 1) Tl[i * PB + j] = (unsigned short)(ll & 0xffffu);
#pragma unroll
        for (int q = 0; q < 4; ++q) cur[q] = nxt[q];
    }
}
__device__ __forceinline__ void gdn_g1_unit(int h, int n, const GdnBufs& B, bf16_t* __restrict__ Y, LAS unsigned char* lds) {
    const int tid = opq_tid(), w = tid >> 6, lane = tid & 63, q4 = lane >> 4, cc = lane & 15;
    lds_bf16 *Krh = plane(lds, 0), *Krl = plane(lds, 1), *KdTh = plane(lds, 2), *KdTl = plane(lds, 3), *KbTh = plane(lds, 4), *KbTl = plane(lds, 5);
    lds_bf16 *VbTh = plane(lds, 6), *VbTl = plane(lds, 7), *Th = plane(lds, 8), *Tl = plane(lds, 9), *WmTh = plane(lds, 10), *WmTl = plane(lds, 11);
    lds_bf16 *U0Th = Krh, *U0Tl = Krl;
    LAS float* Lm = (LAS float*)(lds + LM_OFF); LAS float* sb = (LAS float*)(lds + VEC_OFF); LAS float* sg = sb + 64;
    const int t0 = n * 64, u = h * 256 + n;
    const int c = tid >> 3, d0 = (tid & 7) * 8;
    {
        const float beta = B.GB[(size_t)(t0 + c) * 4 + h], gc = B.GC[(size_t)(t0 + c) * 4 + h], gl = B.GC[(size_t)(t0 + 63) * 4 + h];
        float kf[8], vf[8], x1[8], x2[8], x3[8];
        unpack8(*(const uint4*)(B.GK + (size_t)(t0 + c) * 256 + h * 64 + d0), kf);
        unpack8(*(const uint4*)(B.GV + (size_t)(t0 + c) * 256 + h * 64 + d0), vf);
        const float e1 = __expf(gl - gc), e2 = beta * __expf(gc);
#pragma unroll
        for (int i = 0; i < 8; ++i) { x1[i] = kf[i] * e1; x2[i] = kf[i] * e2; x3[i] = beta * vf[i]; }
        put8<true>(Krh, Krl, c, d0, kf); put8T<true>(KdTh, KdTl, c, d0, x1); put8T<true>(KbTh, KbTl, c, d0, x2); put8T<true>(VbTh, VbTl, c, d0, x3);
        if ((tid & 7) == 0) { sb[c] = beta; sg[c] = gc; }
    }
    BAR();
    const int ti = w >> 1, tj0 = (w & 1) * 2;
    const f32x4_t zero4 = {0.f, 0.f, 0.f, 0.f};
#pragma unroll
    for (int tt = 0; tt < 2; ++tt) {
        const int tj = tj0 + tt;
        const int j = 16 * tj + cc, jp = (j & 3) * 16 + (j >> 2);
        f32x4_t lv = zero4;
        if (tj <= ti) {
            const f32x4_t a = mmp<true, true>(Krh, Krl, Krh, Krl, 16 * ti, 16 * tj, lane, zero4);
            const float gj = sg[j];
#pragma unroll
            for (int r = 0; r < 4; ++r) { const int i = 16 * ti + 4 * q4 + r; lv[r] = (i > j) ? sb[i] * a[r] * __expf(sg[i] - gj) : 0.f; }
        }
#pragma unroll
        for (int r = 0; r < 4; ++r) Lm[(16 * ti + 4 * q4 + r) * PT + jp] = lv[r];
    }
    BAR();
    if (w < 4) tri_inverse_4w(Lm, Th, Tl, w, lane);
    BAR();
    { const u32x4_t t4 = *(const LAS u32x4_t*)(Th + c * PB + d0); *(uint4*)(B.TG + (size_t)u * 4096 + c * 64 + d0) = make_uint4(t4.x, t4.y, t4.z, t4.w);
      const u32x4_t t5 = *(const LAS u32x4_t*)(Tl + c * PB + d0); *(uint4*)(Y + (size_t)(t0 + c) * D + h * 64 + d0) = make_uint4(t5.x, t5.y, t5.z, t5.w); }
#pragma unroll
    for (int tt = 0; tt < 2; ++tt) {
        const int tj = tj0 + tt;
        st_tile_T<true>(U0Th, U0Tl, 16 * ti, 16 * tj, lane, mmp<true, true>(Th, Tl, VbTh, VbTl, 16 * ti, 16 * tj, lane, zero4));
        st_tile_T<true>(WmTh, WmTl, 16 * ti, 16 * tj, lane, mmp<true, true>(Th, Tl, KbTh, KbTl, 16 * ti, 16 * tj, lane, zero4));
    }
    BAR();
    {
        const float egl = __expf(B.GC[(size_t)(t0 + 63) * 4 + h]);
#pragma unroll
        for (int tt = 0; tt < 2; ++tt) {
            const int tj = tj0 + tt;
            const f32x4_t a = mmp<true, true>(KdTh, KdTl, WmTh, WmTl, 16 * ti, 16 * tj, lane, zero4);
#pragma unroll
            for (int r = 0; r < 4; ++r) { const int ar = 16 * ti + 4 * q4 + r, bc = 16 * tj + cc; Lm[ar * PT + bc] = (ar == bc ? egl : 0.f) - a[r]; }
            const f32x4_t nn = mmp<true, true>(KdTh, KdTl, U0Th, U0Tl, 16 * ti, 16 * tj, lane, zero4);
            *(float4*)(B.NF + (size_t)u * 4096 + (tj * 64 + lane) * 16 + ti * 4) = make_float4(nn[0], nn[1], nn[2], nn[3]);
        }
    }
    BAR();
    {
        const int combo = tid >> 6, mt = combo >> 1, s = combo & 1, i = lane & 15, qq = lane >> 4;
        const f32x4_t x0 = *(const LAS f32x4_t*)(Lm + (16 * mt + i) * PT + 32 * s + 4 * qq);
        const f32x4_t x1 = *(const LAS f32x4_t*)(Lm + (16 * mt + i) * PT + 32 * s + 16 + 4 * qq);
        const float xv[8] = {x0.x, x0.y, x0.z, x0.w, x1.x, x1.y, x1.z, x1.w};
        U8 H, L; split8(xv, H.v, L.v);
        uint4* mf = B.MF + (size_t)u * 1024 + (size_t)(combo * 2) * 64 + lane;
        mf[0] = H.q; mf[64] = L.q;
    }
    BAR();
}

constexpr int CH_SLOT = 20480, CH_RING = 6;
__device__ __forceinline__ void chain_wave(float* __restrict__ HT, int cb, int nchunk, int lane, LAS unsigned char* ring, volatile LAS unsigned* flags  ) {
    const int q4 = lane >> 4, cc = lane & 15;
    f32x4_t H[4];
#pragma unroll
    for (int m = 0; m < 4; ++m) H[m] = (f32x4_t){0.f, 0.f, 0.f, 0.f};
    U8 mf[16]; f32x4_t nf[4];
    {
        while (flags[0] != 1u) __builtin_amdgcn_s_sleep(1);
        asm volatile("" ::: "memory");
        const LAS unsigned char* sp = ring + lane * 16;
#pragma unroll
        for (int i = 0; i < 16; ++i) mf[i].x = *(const LAS u32x4_t*)(sp + i * 1024);
#pragma unroll
        for (int m = 0; m < 4; ++m) nf[m] = *(const LAS f32x4_t*)(sp + (16 + m) * 1024);
        asm volatile("s_waitcnt lgkmcnt(0)" ::: "memory");
        if (lane == 0) flags[8] = 1u;
    }
    for (int ch = 0; ch < nchunk; ++ch) {
        float* ht = HT + (size_t)ch * 4096 + (16 * cb + cc) * 64 + 4 * q4;
#pragma unroll
        for (int m = 0; m < 4; ++m) *(float4*)(ht + 16 * m) = make_float4(H[m][0], H[m][1], H[m][2], H[m][3]);
        bf16x8_t bh[2], bl[2];
#pragma unroll
        for (int s = 0; s < 2; ++s) {
            const float xv[8] = {H[2 * s][0], H[2 * s][1], H[2 * s][2], H[2 * s][3], H[2 * s + 1][0], H[2 * s + 1][1], H[2 * s + 1][2], H[2 * s + 1][3]};
            split8(xv, bh[s], bl[s]);
        }
#pragma unroll
        for (int m = 0; m < 4; ++m) {
            f32x4_t acc = nf[m];
#pragma unroll
            for (int s = 0; s < 2; ++s) {
                acc = __builtin_amdgcn_mfma_f32_16x16x32_bf16(mf[(m * 2 + s) * 2].v, bh[s], acc, 0, 0, 0);
                acc = __builtin_amdgcn_mfma_f32_16x16x32_bf16(mf[(m * 2 + s) * 2].v, bl[s], acc, 0, 0, 0);
                acc = __builtin_amdgcn_mfma_f32_16x16x32_bf16(mf[(m * 2 + s) * 2 + 1].v, bh[s], acc, 0, 0, 0);
            }
            H[m] = acc;
        }
        if (ch + 1 < nchunk) {
            const int slot = (ch + 1) % CH_RING;
            while (flags[slot] != (unsigned)(ch + 2)) __builtin_amdgcn_s_sleep(1);
            asm volatile("" ::: "memory");
            const LAS unsigned char* sp = ring + slot * CH_SLOT + lane * 16;
#pragma unroll
            for (int i = 0; i < 16; ++i) mf[i].x = *(const LAS u32x4_t*)(sp + i * 1024);
#pragma unroll
            for (int m = 0; m < 4; ++m) nf[m] = *(const LAS f32x4_t*)(sp + (16 + m) * 1024);
            asm volatile("s_waitcnt lgkmcnt(0)" ::: "memory");
            if (lane == 0) flags[8] = (unsigned)(ch + 2);
        }
    }
}
__device__ __forceinline__ void chain_loader(const uint4* __restrict__ MF, const float* __restrict__ NF, int cb, int nchunk, int lane, int lw, LAS unsigned char* ring, volatile LAS unsigned* flags) {
    for (int ch = lw; ch < nchunk; ch += 7) {
        uint4 m[16]; float4 nn[4];
#pragma unroll
        for (int i = 0; i < 16; ++i) m[i] = MF[(size_t)ch * 1024 + (size_t)i * 64 + lane];
#pragma unroll
        for (int k = 0; k < 4; ++k) nn[k] = *(const float4*)(NF + (size_t)ch * 4096 + (cb * 64 + lane) * 16 + k * 4);
        while ((int)flags[8] + CH_RING <= ch) __builtin_amdgcn_s_sleep(2);
        asm volatile("" ::: "memory");
        LAS unsigned char* sp = ring + (ch % CH_RING) * CH_SLOT + lane * 16;
#pragma unroll
        for (int i = 0; i < 16; ++i) *(LAS u32x4_t*)(sp + i * 1024) = (u32x4_t){m[i].x, m[i].y, m[i].z, m[i].w};
#pragma unroll
        for (int k = 0; k < 4; ++k) *(LAS f32x4_t*)(sp + (16 + k) * 1024) = (f32x4_t){nn[k].x, nn[k].y, nn[k].z, nn[k].w};
        asm volatile("s_waitcnt lgkmcnt(0)" ::: "memory");
        if (lane == 0) flags[ch % CH_RING] = (unsigned)(ch + 1);
    }
}

__device__ __forceinline__ void gdn_g3_unit(int h, int n, const GdnBufs& B, const bf16_t* __restrict__ PM, bf16_t* __restrict__ Y, const float* __restrict__ norm_g, LAS unsigned char* lds) {
    const int tid = opq_tid(), w = tid >> 6, lane = tid & 63, q4 = lane >> 4, cc = lane & 15;
    lds_bf16 *Qr = plane(lds, 0), *Qd = plane(lds, 1), *Kr = plane(lds, 2), *KbT = plane(lds, 3), *VbT = plane(lds, 4), *Tp = plane(lds, 5);
    lds_bf16 *At = plane(lds, 6), *Wm = plane(lds, 7), *HTh = plane(lds, 8), *HTl = plane(lds, 9), *VnT = plane(lds, 10), *Tq = plane(lds, 11);
    LAS float* Os = (LAS float*)(lds + LM_OFF); LAS float* sb = (LAS float*)(lds + VEC_OFF); LAS float* sg = sb + 64;
    const int t0 = n * 64, u = h * 256 + n;
    const int c = tid >> 3, d0 = (tid & 7) * 8;
    {
        const float beta = B.GB[(size_t)(t0 + c) * 4 + h], gc = B.GC[(size_t)(t0 + c) * 4 + h];
        float qf[8], kf[8], vf[8], x1[8], x2[8], x3[8];
        unpack8(*(const uint4*)(B.GQ + (size_t)(t0 + c) * 256 + h * 64 + d0), qf);
        unpack8(*(const uint4*)(B.GK + (size_t)(t0 + c) * 256 + h * 64 + d0), kf);
        unpack8(*(const uint4*)(B.GV + (size_t)(t0 + c) * 256 + h * 64 + d0), vf);
        const uint4 t8 = *(const uint4*)(B.TG + (size_t)u * 4096 + c * 64 + d0);
        const uint4 t9 = *(const uint4*)(Y + (size_t)(t0 + c) * D + h * 64 + d0);
        const float* ht = B.HT + (size_t)u * 4096 + c * 64 + d0;
        const float4 h0 = *(const float4*)ht, h1 = *(const float4*)(ht + 4);
        const float eg = __expf(gc), e2 = beta * eg;
#pragma unroll
        for (int i = 0; i < 8; ++i) { x1[i] = qf[i] * eg; x2[i] = kf[i] * e2; x3[i] = beta * vf[i]; }
        put8<false>(Qr, Qr, c, d0, qf); put8<false>(Qd, Qd, c, d0, x1); put8<false>(Kr, Kr, c, d0, kf);
        put8T<false>(KbT, KbT, c, d0, x2); put8T<false>(VbT, VbT, c, d0, x3);
        *(LAS u32x4_t*)(Tp + c * PB + d0) = (u32x4_t){t8.x, t8.y, t8.z, t8.w};
        *(LAS u32x4_t*)(Tq + c * PB + d0) = (u32x4_t){t9.x, t9.y, t9.z, t9.w};
        const float hv[8] = {h0.x, h0.y, h0.z, h0.w, h1.x, h1.y, h1.z, h1.w};
        put8<true>(HTh, HTl, c, d0, hv);
        if ((tid & 7) == 0) { sb[c] = beta; sg[c] = gc; }
    }
    BAR();
    const int ti = w >> 1, tj0 = (w & 1) * 2;
    const f32x4_t zero4 = {0.f, 0.f, 0.f, 0.f};
    f32x4_t u0[2];
#pragma unroll
    for (int tt = 0; tt < 2; ++tt) {
        const int tj = tj0 + tt;
        f32x4_t at = zero4;
        if (tj <= ti) {
            const f32x4_t s = mmp<false, false>(Qr, Qr, Kr, Kr, 16 * ti, 16 * tj, lane, zero4);
            const int j = 16 * tj + cc; const float gj = sg[j];
#pragma unroll
            for (int r = 0; r < 4; ++r) { const int i = 16 * ti + 4 * q4 + r; at[r] = (i >= j) ? s[r] * __expf(fminf(sg[i] - gj, 0.f)) : 0.f; }
        }
        st_tile_R<false>(At, At, 16 * ti, 16 * tj, lane, at);
        u0[tt] = mmp<true, false>(Tp, Tq, VbT, VbT, 16 * ti, 16 * tj, lane, zero4);
        st_tile_R<false>(Wm, Wm, 16 * ti, 16 * tj, lane, mmp<true, false>(Tp, Tq, KbT, KbT, 16 * ti, 16 * tj, lane, zero4));
    }
    BAR();
    f32x4_t o[2];
#pragma unroll
    for (int tt = 0; tt < 2; ++tt) {
        const int tj = tj0 + tt;
        const f32x4_t wh = mmp<false, true>(Wm, Wm, HTh, HTl, 16 * ti, 16 * tj, lane, zero4);
        o[tt] = mmp<false, true>(Qd, Qd, HTh, HTl, 16 * ti, 16 * tj, lane, zero4);
        st_tile_T<false>(VnT, VnT, 16 * ti, 16 * tj, lane, u0[tt] - wh);
    }
    BAR();
#pragma unroll
    for (int tt = 0; tt < 2; ++tt) {
        const int tj = tj0 + tt;
        o[tt] = mmp<false, false>(At, At, VnT, VnT, 16 * ti, 16 * tj, lane, o[tt]);
#pragma unroll
        for (int r = 0; r < 4; ++r) Os[(16 * ti + 4 * q4 + r) * PT + 16 * tj + cc] = o[tt][r];
    }
    BAR();
    {
        const f32x4_t x0 = *(const LAS f32x4_t*)(Os + c * PT + d0), x1 = *(const LAS f32x4_t*)(Os + c * PT + d0 + 4);
        float xv[8] = {x0.x, x0.y, x0.z, x0.w, x1.x, x1.y, x1.z, x1.w};
        float ss = 0.f;
#pragma unroll
        for (int i = 0; i < 8; ++i) ss = fmaf(xv[i], xv[i], ss);
        ss += __shfl_xor(ss, 1); ss += __shfl_xor(ss, 2); ss += __shfl_xor(ss, 4);
        const float rs = rsqrtf(ss * (1.f / 64.f) + 1e-6f);
        float zf[8]; unpack8(*(const uint4*)(PM + (size_t)(t0 + c) * PMLD + 768 + h * 64 + d0), zf);
        float y[8];
#pragma unroll
        for (int i = 0; i < 8; ++i) y[i] = xv[i] * rs * norm_g[d0 + i] * siluf_(zf[i]);
        *(uint4*)(Y + (size_t)(t0 + c) * D + h * 64 + d0) = pack8(y);
    }
    BAR();
}

struct RwkvBufs { bf16_t *RR, *RK, *RV, *RKK, *RA, *RG; float* CW; uint4* MF; float* NF; float* HT; bf16_t* TG; };
__device__ __forceinline__ void rwkv_prep_chunk(const bf16_t* __restrict__ PM, int n, const RwkvBufs& B, const Params& p, int l, const bf16_t* __restrict__ WUPT, const bf16_t* __restrict__ AUPT, const bf16_t* __restrict__ GUPT, LAS unsigned char* lds) {
    const int tid = opq_tid(), w = tid >> 6, lane = tid & 63, q4 = lane >> 4, cc = lane & 15;
    const int t0 = n * 64;
    const float* mu = p.in[24] + l * 1024;
    lds_bf16* Awd = (lds_bf16*)lds; lds_bf16* Aad = Awd + 64 * 72; lds_bf16* Agd = Aad + 64 * 72;
    lds_bf16* La = Agd + 64 * 136; lds_bf16* Lg = La + 64 * 264; lds_bf16* Llw = Lg + 64 * 264;
    for (int px1_ = 0; px1_ < ((PEXP == 1) ? 2 : 1); ++px1_)
    {
        const int t = tid >> 3, c0 = (tid & 7) * 8;
        const bf16_t* row = PM + (size_t)(t0 + t) * PMLD + C_RWKV + 768 + c0;
        const bool hasprev = (t0 + t) > 0;
#pragma unroll
        for (int g8 = 0; g8 < 4; ++g8) {
            float x[8], xp[8];
            unpack8(*(const uint4*)(row + 64 * g8), x);
            if (hasprev) unpack8(*(const uint4*)(row - PMLD + 64 * g8), xp); else {
#pragma unroll
                for (int i = 0; i < 8; ++i) xp[i] = 0.f; }
            const int col = c0 + 64 * g8;
            float y[8];
#pragma unroll
            for (int i = 0; i < 8; ++i) {
                const float v = x[i] + mu[768 + col + i] * (xp[i] - x[i]);
                y[i] = col < 64 ? tanhf_(v) : (col < 128 ? v : sigmoidf_(v));
            }
            const uint4 pk = pack8(y);
            if (col < 64) *(LAS u32x4_t*)(Awd + t * 72 + col) = (u32x4_t){pk.x, pk.y, pk.z, pk.w};
            else if (col < 128) *(LAS u32x4_t*)(Aad + t * 72 + (col - 64)) = (u32x4_t){pk.x, pk.y, pk.z, pk.w};
            else *(LAS u32x4_t*)(Agd + t * 136 + (col - 128)) = (u32x4_t){pk.x, pk.y, pk.z, pk.w};
        }
    }
    BAR();
    const int hh = w >> 1, tt0 = 2 * (w & 1);
    for (int px2_ = 0; px2_ < ((PEXP == 2) ? 2 : 1); ++px2_)
    {
        const float* w0 = p.in[25] + l * W; const float* a0 = p.in[27] + l * W;
#pragma unroll 2
        for (int b = 0; b < 4; ++b) {
            const int ncol = 64 * hh + 16 * b + cc;
            f32x4_t accw[2], acca[2], accg[2];
#pragma unroll
            for (int a = 0; a < 2; ++a) { accw[a] = (f32x4_t){0.f, 0.f, 0.f, 0.f}; acca[a] = accw[a]; accg[a] = accw[a]; }
#pragma unroll
            for (int ks = 0; ks < 4; ++ks) {
                U8 bw, ba, bg;
                bg.q = *(const uint4*)(GUPT + (size_t)ncol * 128 + 32 * ks + 8 * q4);
                if (ks < 2) { bw.q = *(const uint4*)(WUPT + (size_t)ncol * 64 + 32 * ks + 8 * q4); ba.q = *(const uint4*)(AUPT + (size_t)ncol * 64 + 32 * ks + 8 * q4); }
#pragma unroll
                for (int a = 0; a < 2; ++a) {
                    const int row = 16 * (tt0 + a) + cc;
                    U8 ag; ag.x = *(const LAS u32x4_t*)(Agd + row * 136 + 32 * ks + 8 * q4);
                    accg[a] = __builtin_amdgcn_mfma_f32_16x16x32_bf16(ag.v, bg.v, accg[a], 0, 0, 0);
                    if (ks < 2) {
                        U8 aw, aa; aw.x = *(const LAS u32x4_t*)(Awd + row * 72 + 32 * ks + 8 * q4); aa.x = *(const LAS u32x4_t*)(Aad + row * 72 + 32 * ks + 8 * q4);
                        accw[a] = __builtin_amdgcn_mfma_f32_16x16x32_bf16(aw.v, bw.v, accw[a], 0, 0, 0);
                        acca[a] = __builtin_amdgcn_mfma_f32_16x16x32_bf16(aa.v, ba.v, acca[a], 0, 0, 0);
                    }
                }
            }
            const float w0n = w0[ncol], a0n = a0[ncol];
#pragma unroll
            for (int a = 0; a < 2; ++a)
#pragma unroll
                for (int r = 0; r < 4; ++r) {
                    const int t = 16 * (tt0 + a) + 4 * q4 + r;
                    const float logw = -softplusf_(-(w0n + accw[a][r])) - 0.5f;
                    Llw[t * 264 + ncol] = (unsigned short)f2bf(-__expf(logw));
                    La[t * 264 + ncol] = (unsigned short)f2bf(sigmoidf_(a0n + acca[a][r]));
                    Lg[t * 264 + ncol] = (unsigned short)f2bf(accg[a][r]);
                }
        }
    }
    BAR();
    {
        const int t = tid >> 3, j8 = (tid & 7) * 8;
        const bf16_t* row = PM + (size_t)(t0 + t) * PMLD + C_RWKV;
        const bool hasprev = (t0 + t) > 0;
        const float* k_k = p.in[30] + l * W; const float* k_a = p.in[31] + l * W;
#pragma unroll 2
        for (int hd = 0; hd < 4; ++hd) {
            const int nn = 64 * hd + j8;
            float xr[8], xk[8], xv[8], pr[8], pk[8], pv[8], av[8];
            unpack8(*(const uint4*)(row + nn), xr); unpack8(*(const uint4*)(row + 256 + nn), xk); unpack8(*(const uint4*)(row + 512 + nn), xv);
            if (hasprev) { unpack8(*(const uint4*)(row - PMLD + nn), pr); unpack8(*(const uint4*)(row - PMLD + 256 + nn), pk); unpack8(*(const uint4*)(row - PMLD + 512 + nn), pv); }
            else {
#pragma unroll
                for (int i = 0; i < 8; ++i) { pr[i] = 0.f; pk[i] = 0.f; pv[i] = 0.f; } }
            { const u32x4_t t4 = *(const LAS u32x4_t*)(La + t * 264 + nn); unpack8(make_uint4(t4.x, t4.y, t4.z, t4.w), av); }
            float orr[8], okk[8], ovv[8], kraw[8];
            float ss = 0.f;
#pragma unroll
            for (int i = 0; i < 8; ++i) {
                const float r = xr[i] + mu[nn + i] * (pr[i] - xr[i]);
                const float k = xk[i] + mu[256 + nn + i] * (pk[i] - xk[i]);
                const float v = xv[i] + mu[512 + nn + i] * (pv[i] - xv[i]);
                orr[i] = r; ovv[i] = v; okk[i] = k * (1.f + (av[i] - 1.f) * k_a[nn + i]);
                kraw[i] = k * k_k[nn + i]; ss = fmaf(kraw[i], kraw[i], ss);
            }
            ss += __shfl_xor(ss, 1); ss += __shfl_xor(ss, 2); ss += __shfl_xor(ss, 4);
            const float rn = rsqrtf(ss + 1e-6f);
#pragma unroll
            for (int i = 0; i < 8; ++i) kraw[i] *= rn;
            const size_t o = (size_t)(t0 + t) * 256 + nn;
            *(uint4*)(B.RR + o) = pack8(orr); *(uint4*)(B.RK + o) = pack8(okk); *(uint4*)(B.RV + o) = pack8(ovv); *(uint4*)(B.RKK + o) = pack8(kraw);
            { const u32x4_t t4 = *(const LAS u32x4_t*)(La + t * 264 + nn); *(uint4*)(B.RA + o) = make_uint4(t4.x, t4.y, t4.z, t4.w); }
            { const u32x4_t t4 = *(const LAS u32x4_t*)(Lg + t * 264 + nn); *(uint4*)(B.RG + o) = make_uint4(t4.x, t4.y, t4.z, t4.w); }
        }
    }
    for (int px4_ = 0; px4_ < ((PEXP == 4) ? 2 : 1); ++px4_)
    if (tid < 256) {
        float c = 0.f;
#pragma unroll 16
        for (int t = 0; t < 64; ++t) { c += bf2f(Llw[t * 264 + tid]); B.CW[(size_t)(t0 + t) * 256 + tid] = c; }
    }
    BAR();
}

struct RwPiece { float kk[8], al[8], kt[8], v[8], cw[8], cwp[8], cwc[8]; };
__device__ __forceinline__ void rwkv_load_piece(const RwkvBufs& B, int h, int t0, int c, int d0, RwPiece& P) {
    const size_t o = (size_t)(t0 + c) * 256 + h * 64 + d0;
    float a[8];
    unpack8(*(const uint4*)(B.RKK + o), P.kk); unpack8(*(const uint4*)(B.RA + o), a); unpack8(*(const uint4*)(B.RK + o), P.kt); unpack8(*(const uint4*)(B.RV + o), P.v);
    const float4 c0 = *(const float4*)(B.CW + o), c1 = *(const float4*)(B.CW + o + 4);
    P.cw[0] = c0.x; P.cw[1] = c0.y; P.cw[2] = c0.z; P.cw[3] = c0.w; P.cw[4] = c1.x; P.cw[5] = c1.y; P.cw[6] = c1.z; P.cw[7] = c1.w;
    if (c > 0) { const float4 p0 = *(const float4*)(B.CW + o - 256), p1 = *(const float4*)(B.CW + o - 256 + 4);
        P.cwp[0] = p0.x; P.cwp[1] = p0.y; P.cwp[2] = p0.z; P.cwp[3] = p0.w; P.cwp[4] = p1.x; P.cwp[5] = p1.y; P.cwp[6] = p1.z; P.cwp[7] = p1.w; }
    else {
#pragma unroll
        for (int i = 0; i < 8; ++i) P.cwp[i] = 0.f; }
    const size_t oc = (size_t)(t0 + 63) * 256 + h * 64 + d0;
    const float4 e0 = *(const float4*)(B.CW + oc), e1 = *(const float4*)(B.CW + oc + 4);
    P.cwc[0] = e0.x; P.cwc[1] = e0.y; P.cwc[2] = e0.z; P.cwc[3] = e0.w; P.cwc[4] = e1.x; P.cwc[5] = e1.y; P.cwc[6] = e1.z; P.cwc[7] = e1.w;
#pragma unroll
    for (int i = 0; i < 8; ++i) P.al[i] = a[i] * P.kk[i];
}

__device__ __forceinline__ void rwkv_g1_unit(int h, int n, const RwkvBufs& B, bf16_t* __restrict__ Y, LAS unsigned char* lds) {
    const int tid = opq_tid(), w = tid >> 6, lane = tid & 63, q4 = lane >> 4, cc = lane & 15;
    lds_bf16 *P0h = plane(lds, 0), *P0l = plane(lds, 1), *P1h = plane(lds, 2), *P1l = plane(lds, 3), *P2h = plane(lds, 4), *P2l = plane(lds, 5);
    lds_bf16 *Lkh = plane(lds, 6), *Lkl = plane(lds, 7), *P3h = plane(lds, 8), *P3l = plane(lds, 9), *Th = plane(lds, 10), *Tl = plane(lds, 11);
    LAS float* Lm = (LAS float*)(lds + LM_OFF);
    const int t0 = n * 64, u = (4 + h) * 256 + n;
    const int c = tid >> 3, d0 = (tid & 7) * 8;
    RwPiece P; rwkv_load_piece(B, h, t0, c, d0, P);
    {
        float x0[8], x1[8], x2[8];
#pragma unroll
        for (int i = 0; i < 8; ++i) { const float em = __expf(-P.cw[i]); x0[i] = P.kk[i] * __expf(P.cwp[i]); x1[i] = P.al[i] * em; x2[i] = P.kt[i] * em; }
        put8<true>(P0h, P0l, c, d0, x0); put8<true>(P1h, P1l, c, d0, x1); put8<true>(P2h, P2l, c, d0, x2);
    }
    BAR();
    const int ti = w >> 1, tj0 = (w & 1) * 2;
    const f32x4_t zero4 = {0.f, 0.f, 0.f, 0.f};
#pragma unroll
    for (int tt = 0; tt < 2; ++tt) {
        const int tj = tj0 + tt;
        f32x4_t lk = zero4, la = zero4;
        const int j = 16 * tj + cc, jp = (j & 3) * 16 + (j >> 2);
        if (tj <= ti) {
            const f32x4_t a = mmp<true, true>(P0h, P0l, P1h, P1l, 16 * ti, 16 * tj, lane, zero4);
            const f32x4_t b = mmp<true, true>(P0h, P0l, P2h, P2l, 16 * ti, 16 * tj, lane, zero4);
#pragma unroll
            for (int r = 0; r < 4; ++r) { const int i = 16 * ti + 4 * q4 + r; la[r] = (i > j) ? a[r] : 0.f; lk[r] = (i > j) ? b[r] : 0.f; }
        }
#pragma unroll
        for (int r = 0; r < 4; ++r) Lm[(16 * ti + 4 * q4 + r) * PT + jp] = la[r];
        st_tile_R<true>(Lkh, Lkl, 16 * ti, 16 * tj, lane, lk);
    }
    BAR();
    {
        float x0[8], x1[8], x2[8];
#pragma unroll
        for (int i = 0; i < 8; ++i) { const float eb = __expf(P.cwc[i] - P.cw[i]); x0[i] = P.kk[i] * __expf(P.cwp[i]); x1[i] = P.al[i] * eb; x2[i] = P.kt[i] * eb; }
        put8T<true>(P0h, P0l, c, d0, P.v); put8T<true>(P1h, P1l, c, d0, x0); put8T<true>(P2h, P2l, c, d0, x1); put8T<true>(P3h, P3l, c, d0, x2);
    }
    if (w < 4) tri_inverse_4w(Lm, Th, Tl, w, lane);
    BAR();
    { const u32x4_t t4 = *(const LAS u32x4_t*)(Th + c * PB + d0); *(uint4*)(B.TG + (size_t)u * 4096 + c * 64 + d0) = make_uint4(t4.x, t4.y, t4.z, t4.w);
      const u32x4_t t5 = *(const LAS u32x4_t*)(Tl + c * PB + d0); *(uint4*)(Y + (size_t)(t0 + c) * D + 768 + h * 64 + d0) = make_uint4(t5.x, t5.y, t5.z, t5.w); }
    f32x4_t pa[2];
#pragma unroll
    for (int tt = 0; tt < 2; ++tt) pa[tt] = mmp<true, true>(Lkh, Lkl, P0h, P0l, 16 * ti, 16 * (tj0 + tt), lane, zero4);
    BAR();
#pragma unroll
    for (int tt = 0; tt < 2; ++tt) st_tile_T<true>(Lkh, Lkl, 16 * ti, 16 * (tj0 + tt), lane, pa[tt]);
    BAR();
    f32x4_t ua[2], wa[2];
#pragma unroll
    for (int tt = 0; tt < 2; ++tt) {
        ua[tt] = mmp<true, true>(Th, Tl, Lkh, Lkl, 16 * ti, 16 * (tj0 + tt), lane, zero4);
        wa[tt] = mmp<true, true>(Th, Tl, P1h, P1l, 16 * ti, 16 * (tj0 + tt), lane, zero4);
    }
    BAR();
#pragma unroll
    for (int tt = 0; tt < 2; ++tt) {
        st_tile_T<true>(Lkh, Lkl, 16 * ti, 16 * (tj0 + tt), lane, -ua[tt]);
        st_tile_T<true>(P1h, P1l, 16 * ti, 16 * (tj0 + tt), lane, wa[tt]);
    }
    BAR();
    {
#pragma unroll
        for (int tt = 0; tt < 2; ++tt) {
            const int tj = tj0 + tt;
            const f32x4_t a = mmp<true, true>(P2h, P2l, P1h, P1l, 16 * ti, 16 * tj, lane, zero4);
            const float gam = __expf(B.CW[(size_t)(t0 + 63) * 256 + h * 64 + 16 * tj + cc]);
#pragma unroll
            for (int r = 0; r < 4; ++r) { const int ar = 16 * ti + 4 * q4 + r, bc = 16 * tj + cc; Lm[ar * PT + bc] = (ar == bc ? gam : 0.f) - a[r]; }
            f32x4_t nn = mmp<true, true>(P2h, P2l, Lkh, Lkl, 16 * ti, 16 * tj, lane, zero4);
            nn = mmp<true, true>(P3h, P3l, P0h, P0l, 16 * ti, 16 * tj, lane, nn);
            *(float4*)(B.NF + (size_t)u * 4096 + (tj * 64 + lane) * 16 + ti * 4) = make_float4(nn[0], nn[1], nn[2], nn[3]);
        }
    }
    BAR();
    {
        const int combo = tid >> 6, mt = combo >> 1, s = combo & 1, i = lane & 15, qq = lane >> 4;
        const f32x4_t x0 = *(const LAS f32x4_t*)(Lm + (16 * mt + i) * PT + 32 * s + 4 * qq);
        const f32x4_t x1 = *(const LAS f32x4_t*)(Lm + (16 * mt + i) * PT + 32 * s + 16 + 4 * qq);
        const float xv[8] = {x0.x, x0.y, x0.z, x0.w, x1.x, x1.y, x1.z, x1.w};
        U8 H, L; split8(xv, H.v, L.v);
        uint4* mf = B.MF + (size_t)u * 1024 + (size_t)(combo * 2) * 64 + lane;
        mf[0] = H.q; mf[64] = L.q;
    }
    BAR();
}

__device__ __forceinline__ void rwkv_g3_unit(int h, int n, const RwkvBufs& B, bf16_t* __restrict__ Y, const Params& p, int l, LAS unsigned char* lds) {
    const int tid = opq_tid(), w = tid >> 6, lane = tid & 63, q4 = lane >> 4, cc = lane & 15;
    lds_bf16 *KH = plane(lds, 0), *AC = plane(lds, 1), *KC = plane(lds, 2), *RH = plane(lds, 3), *VT = plane(lds, 4), *KHT = plane(lds, 5), *Tp = plane(lds, 6);
    lds_bf16 *HTh = plane(lds, 7), *HTl = plane(lds, 8), *Lk = plane(lds, 9), *Ara = plane(lds, 10), *Ark = plane(lds, 11), *Tq = plane(lds, 12);
    lds_bf16 *PTp = KH, *Wm = AC, *UT = KC;
    LAS float* Os = (LAS float*)(lds + LM_OFF);
    const int t0 = n * 64, u = (4 + h) * 256 + n;
    const int c = tid >> 3, d0 = (tid & 7) * 8;
    {
        RwPiece P; rwkv_load_piece(B, h, t0, c, d0, P);
        float rr[8]; unpack8(*(const uint4*)(B.RR + (size_t)(t0 + c) * 256 + h * 64 + d0), rr);
        const uint4 t8 = *(const uint4*)(B.TG + (size_t)u * 4096 + c * 64 + d0);
        const uint4 t9 = *(const uint4*)(Y + (size_t)(t0 + c) * D + 768 + h * 64 + d0);
        const float* ht = B.HT + (size_t)u * 4096 + c * 64 + d0;
        const float4 h0 = *(const float4*)ht, h1 = *(const float4*)(ht + 4);
        float x0[8], x1[8], x2[8], x3[8];
#pragma unroll
        for (int i = 0; i < 8; ++i) { const float em = __expf(-P.cw[i]); x0[i] = P.kk[i] * __expf(P.cwp[i]); x1[i] = P.al[i] * em; x2[i] = P.kt[i] * em; x3[i] = rr[i] * __expf(P.cw[i]); }
        put8<false>(KH, KH, c, d0, x0); put8<false>(AC, AC, c, d0, x1); put8<false>(KC, KC, c, d0, x2); put8<false>(RH, RH, c, d0, x3);
        put8T<false>(VT, VT, c, d0, P.v); put8T<false>(KHT, KHT, c, d0, x0);
        *(LAS u32x4_t*)(Tp + c * PB + d0) = (u32x4_t){t8.x, t8.y, t8.z, t8.w};
        *(LAS u32x4_t*)(Tq + c * PB + d0) = (u32x4_t){t9.x, t9.y, t9.z, t9.w};
        const float hv[8] = {h0.x, h0.y, h0.z, h0.w, h1.x, h1.y, h1.z, h1.w};
        put8<true>(HTh, HTl, c, d0, hv);
    }
    BAR();
    const int ti = w >> 1, tj0 = (w & 1) * 2;
    const f32x4_t zero4 = {0.f, 0.f, 0.f, 0.f};
#pragma unroll
    for (int tt = 0; tt < 2; ++tt) {
        const int tj = tj0 + tt; const int j = 16 * tj + cc;
        f32x4_t lk = zero4, ara = zero4, ark = zero4;
        if (tj <= ti) {
            const f32x4_t b = mmp<false, false>(KH, KH, KC, KC, 16 * ti, 16 * tj, lane, zero4);
            const f32x4_t e = mmp<false, false>(RH, RH, AC, AC, 16 * ti, 16 * tj, lane, zero4);
            const f32x4_t f = mmp<false, false>(RH, RH, KC, KC, 16 * ti, 16 * tj, lane, zero4);
#pragma unroll
            for (int r = 0; r < 4; ++r) { const int i = 16 * ti + 4 * q4 + r; lk[r] = (i > j) ? b[r] : 0.f; ara[r] = (i >= j) ? e[r] : 0.f; ark[r] = (i >= j) ? f[r] : 0.f; }
        }
        st_tile_R<false>(Lk, Lk, 16 * ti, 16 * tj, lane, lk); st_tile_R<false>(Ara, Ara, 16 * ti, 16 * tj, lane, ara); st_tile_R<false>(Ark, Ark, 16 * ti, 16 * tj, lane, ark);
    }
    BAR();
#pragma unroll
    for (int tt = 0; tt < 2; ++tt) {
        const int tj = tj0 + tt;
        st_tile_T<false>(PTp, PTp, 16 * ti, 16 * tj, lane, mmp<false, false>(Lk, Lk, VT, VT, 16 * ti, 16 * tj, lane, zero4));
        st_tile_R<false>(Wm, Wm, 16 * ti, 16 * tj, lane, mmp<true, false>(Tp, Tq, KHT, KHT, 16 * ti, 16 * tj, lane, zero4));
    }
    BAR();
    f32x4_t o[2];
#pragma unroll
    for (int tt = 0; tt < 2; ++tt) {
        const int tj = tj0 + tt;
        const f32x4_t ua = mmp<true, false>(Tp, Tq, PTp, PTp, 16 * ti, 16 * tj, lane, zero4);
        const f32x4_t wh = mmp<false, true>(Wm, Wm, HTh, HTl, 16 * ti, 16 * tj, lane, zero4);
        st_tile_T<false>(UT, UT, 16 * ti, 16 * tj, lane, -ua - wh);
        o[tt] = mmp<false, true>(RH, RH, HTh, HTl, 16 * ti, 16 * tj, lane, zero4);
        o[tt] = mmp<false, false>(Ark, Ark, VT, VT, 16 * ti, 16 * tj, lane, o[tt]);
    }
    BAR();
#pragma unroll
    for (int tt = 0; tt < 2; ++tt) {
        const int tj = tj0 + tt;
        o[tt] = mmp<false, false>(Ara, Ara, UT, UT, 16 * ti, 16 * tj, lane, o[tt]);
#pragma unroll
        for (int r = 0; r < 4; ++r) Os[(16 * ti + 4 * q4 + r) * PT + 16 * tj + cc] = o[tt][r];
    }
    BAR();
    {
        const f32x4_t x0 = *(const LAS f32x4_t*)(Os + c * PT + d0), x1 = *(const LAS f32x4_t*)(Os + c * PT + d0 + 4);
        const float xv[8] = {x0.x, x0.y, x0.z, x0.w, x1.x, x1.y, x1.z, x1.w};
        float s1 = 0.f;
#pragma unroll
        for (int i = 0; i < 8; ++i) s1 += xv[i];
        s1 += __shfl_xor(s1, 1); s1 += __shfl_xor(s1, 2); s1 += __shfl_xor(s1, 4);
        const float mean = s1 * (1.f / 64.f);
        float s2 = 0.f;
#pragma unroll
        for (int i = 0; i < 8; ++i) { const float dd = xv[i] - mean; s2 = fmaf(dd, dd, s2); }
        s2 += __shfl_xor(s2, 1); s2 += __shfl_xor(s2, 2); s2 += __shfl_xor(s2, 4);
        const float rs = rsqrtf(s2 * (1.f / 64.f) + 64e-5f);
        const size_t o8 = (size_t)(t0 + c) * 256 + h * 64 + d0;
        float rr[8], gg[8], kt2[8], v2[8];
        unpack8(*(const uint4*)(B.RR + o8), rr); unpack8(*(const uint4*)(B.RG + o8), gg); unpack8(*(const uint4*)(B.RK + o8), kt2); unpack8(*(const uint4*)(B.RV + o8), v2);
        const float* r_k = p.in[32] + l * W + h * 64 + d0; const float* ln_g = p.in[33] + l * W + h * 64 + d0; const float* ln_b = p.in[34] + l * W + h * 64 + d0;
        float bs = 0.f;
#pragma unroll
        for (int i = 0; i < 8; ++i) bs = fmaf(rr[i] * kt2[i], r_k[i], bs);
        bs += __shfl_xor(bs, 1); bs += __shfl_xor(bs, 2); bs += __shfl_xor(bs, 4);
        float y[8];
#pragma unroll
        for (int i = 0; i < 8; ++i) y[i] = ((xv[i] - mean) * rs * ln_g[i] + ln_b[i] + bs * v2[i]) * gg[i];
        *(uint4*)(Y + (size_t)(t0 + c) * D + 768 + h * 64 + d0) = pack8(y);
    }
    BAR();
}

struct LruBufs { float2* AGG; float* CAR; };
template <int PASS>
__device__ __forceinline__ void lru_unit(const bf16_t* __restrict__ PM, int n, const LruBufs& B, bf16_t* __restrict__ Y, const Params& p, int l, const bf16_t* __restrict__ LWT  , LAS float* lds) {
    const int tid = opq_tid(), c = tid & 255, half = tid >> 8, w = tid >> 6, lane = tid & 63, q4 = lane >> 4, cc = lane & 15;
    const int t0 = n * 64, tb = t0 + 32 * half;
    LAS float* U = lds;
    lds_bf16* R = (lds_bf16*)(lds + 64 * 260);
    lds_bf16* I = R + 64 * 264;
    {
        const float* cw = p.in[7] + l * 4 * W; const float cb = p.in[8][l * W + c];
        const float w0 = cw[c], w1 = cw[W + c], w2 = cw[2 * W + c], w3 = cw[3 * W + c];
        const bf16_t* col = PM + C_LRU + c;
#pragma unroll 1
        for (int hf = 0; hf < 2; ++hf) {
            bf16_t xr[19];
#pragma unroll
            for (int i = 0; i < 19; ++i) { const int tq = tb + 16 * hf + i - 3; const bf16_t xv_ = col[(size_t)(tq >= 0 ? tq : 0) * PMLD]; xr[i] = tq >= 0 ? xv_ : (bf16_t)0; }
#pragma unroll
            for (int i = 0; i < 16; ++i)
                U[(32 * half + 16 * hf + i) * 260 + c] = cb + w0 * bf2f(xr[i]) + w1 * bf2f(xr[i + 1]) + w2 * bf2f(xr[i + 2]) + w3 * bf2f(xr[i + 3]);
        }
    }
    BAR();
    {
        const int nb = w >> 1, gt = w & 1;
        const bf16_t* wt = LWT + (size_t)gt * 16384 + (size_t)nb * 4096;
        const float* bias = (gt ? p.in[12] : p.in[10]) + l * W + nb * 64;
        const float* lam = p.in[13] + l * W + nb * 64;
#pragma unroll 1
        for (int te = 0; te < 4; ++te) {
            U8 bf[2];
#pragma unroll
            for (int ks = 0; ks < 2; ++ks) bf[ks].q = *(const uint4*)(wt + (size_t)(16 * te + cc) * 64 + 32 * ks + 8 * q4);
            const int ch = nb * 64 + 16 * te + cc;
            const float bv = bias[16 * te + cc];
            const float sp8 = 8.f * softplusf_(-lam[16 * te + cc]);
#pragma unroll
            for (int tt = 0; tt < 4; ++tt) {
                f32x4_t acc = {0.f, 0.f, 0.f, 0.f};
#pragma unroll
                for (int ks = 0; ks < 2; ++ks) {
                    const LAS float* ap = U + (16 * tt + cc) * 260 + nb * 64 + 32 * ks + 8 * q4;
                    const f32x4_t a0 = *(const LAS f32x4_t*)ap, a1 = *(const LAS f32x4_t*)(ap + 4);
                    const float av[8] = {a0.x, a0.y, a0.z, a0.w, a1.x, a1.y, a1.z, a1.w};
                    acc = __builtin_amdgcn_mfma_f32_16x16x32_bf16(hi8(av), bf[ks].v, acc, 0, 0, 0);
                }
#pragma unroll
                for (int r = 0; r < 4; ++r) {
                    const int t = 16 * tt + 4 * q4 + r;
                    const float sg = sigmoidf_(acc[r] + bv);
                    if (gt) I[t * 264 + ch] = (unsigned short)f2bf(sg); else R[t * 264 + ch] = (unsigned short)f2bf(-sp8 * sg);
                }
            }
        }
    }
    BAR();
    float h = 0.f, ap = 1.f;
    const int sc = 2 * n + half;
    bf16_t gc_[8], gn_[8];
    if (PASS == 3) {
        h = B.CAR[(size_t)c * 512 + sc];
#pragma unroll
        for (int i = 0; i < 8; ++i) gc_[i] = PM[(size_t)(tb + i) * PMLD + C_LRU + 256 + c];
    }
#pragma unroll 1
    for (int g8 = 0; g8 < 4; ++g8) {
        if (PASS == 3 && g8 < 3) {
#pragma unroll
            for (int i = 0; i < 8; ++i) gn_[i] = PM[(size_t)(tb + 8 * (g8 + 1) + i) * PMLD + C_LRU + 256 + c];
        }
#pragma unroll
        for (int i = 0; i < 8; ++i) {
            const int t = 32 * half + 8 * g8 + i;
            const float log_a = bf2f(R[t * 264 + c]), ig = bf2f(I[t * 264 + c]);
            const float a = __expf(log_a);
            const float inp = __builtin_amdgcn_sqrtf(fmaxf(1.f - a * a, 0.f)) * (ig * U[t * 260 + c]);
            h = fmaf(a, h, inp); ap *= a;
            if (PASS == 3) Y[(size_t)(t0 + t) * D + 256 + c] = (bf16_t)f2bf(h * geluf_(bf2f(gc_[i])));
        }
        if (PASS == 3) {
#pragma unroll
            for (int i = 0; i < 8; ++i) gc_[i] = gn_[i];
        }
    }
    if (PASS == 1) B.AGG[(size_t)c * 512 + sc] = make_float2(ap, h);
    BAR();
}
__device__ __forceinline__ void lru_carry_wave(const LruBufs& B, int c, int lane) {
    float2 ab[8];
    const float4* src = (const float4*)(B.AGG + (size_t)c * 512 + 8 * lane);
#pragma unroll
    for (int k = 0; k < 4; ++k) { const float4 v = src[k]; ab[2 * k] = make_float2(v.x, v.y); ab[2 * k + 1] = make_float2(v.z, v.w); }
    float A = 1.f, Bv = 0.f;
#pragma unroll
    for (int k = 0; k < 8; ++k) { Bv = fmaf(ab[k].x, Bv, ab[k].y); A *= ab[k].x; }
#pragma unroll
    for (int o = 1; o < 64; o <<= 1) { const float Al = __shfl_up(A, o), Bl = __shfl_up(Bv, o); if (lane >= o) { Bv = fmaf(A, Bl, Bv); A *= Al; } }
    float h = __shfl_up(Bv, 1); if (lane == 0) h = 0.f;
    float o8[8];
#pragma unroll
    for (int k = 0; k < 8; ++k) { o8[k] = h; h = fmaf(ab[k].x, h, ab[k].y); }
    float4* dst = (float4*)(B.CAR + (size_t)c * 512 + 8 * lane);
    dst[0] = make_float4(o8[0], o8[1], o8[2], o8[3]); dst[1] = make_float4(o8[4], o8[5], o8[6], o8[7]);
}

struct S5Bufs { float2* E; float2* CIN; };
template <int PASS>
__device__ __forceinline__ void s5_unit(const bf16_t* __restrict__ PM, int n, const S5Bufs& B, bf16_t* __restrict__ Y, const Params& p, int l, const bf16_t* __restrict__ WL, LAS unsigned char* lds) {
    const int tid = opq_tid(), w = tid >> 6, lane = tid & 63, q4 = lane >> 4, cc = lane & 15;
    const int t0 = n * 64;
    LAS float* bu = (LAS float*)(lds + w * 8448);
    LAS unsigned char* hs = lds + 8 * 8448 + w * 4352;
    lds_bf16* yp = (lds_bf16*)(lds + 8 * 8448 + 8 * 4352);
    const bf16_t* GLUT = WL + WO_GLU;
#pragma unroll 1
    for (int gi = 0; gi < 2; ++gi) {
        const int g = 2 * w + gi;
        U8 bfr[8], cf[4];
#pragma unroll
        for (int tn = 0; tn < 8; ++tn) bfr[tn].q = *(const uint4*)(WL + WO_S5B + ((size_t)(g * 8 + tn) * 64 + lane) * 8);
        float dch = 0.f;
        if (PASS == 3) {
#pragma unroll
            for (int ks = 0; ks < 4; ++ks) cf[ks].q = *(const uint4*)(WL + WO_S5C + ((size_t)(g * 4 + ks) * 64 + lane) * 8);
            dch = p.in[20][l * W + g * 16 + cc];
        }
        float lbr, lbi;
        { const float dt = __expf(p.in[21][l * 16 + g]); const float lre = p.in[14][l * 1024 + g * 64 + lane], lim = p.in[15][l * 1024 + g * 64 + lane];
          const float er = __expf(lre * dt); lbr = er * cosf(lim * dt); lbi = er * sinf(lim * dt); }
        float hr = 0.f, hi = 0.f;
        if (PASS == 3) { const float2 h0 = B.CIN[((size_t)g * 64 + lane) * 256 + n]; hr = h0.x; hi = h0.y; }
#pragma unroll 1
        for (int tt = 0; tt < 4; ++tt) {
            U8 at; at.q = *(const uint4*)(PM + (size_t)(t0 + 16 * tt + cc) * PMLD + C_S5 + g * 16 + 8 * (q4 & 1)); if (q4 >= 2) at.q = make_uint4(0u, 0u, 0u, 0u);
            unsigned short uvr[4];
            if (PASS == 3) {
#pragma unroll
                for (int r = 0; r < 4; ++r) uvr[r] = PM[(size_t)(t0 + 16 * tt + 4 * q4 + r) * PMLD + C_S5 + g * 16 + cc];
            }
#pragma unroll
            for (int tn = 0; tn < 8; ++tn) {
                const f32x4_t acc = __builtin_amdgcn_mfma_f32_16x16x32_bf16(at.v, bfr[tn].v, (f32x4_t){0.f, 0.f, 0.f, 0.f}, 0, 0, 0);
#pragma unroll
                for (int r = 0; r < 4; ++r) bu[(4 * q4 + r) * 132 + 16 * tn + cc] = acc[r];
            }
            asm volatile("s_waitcnt lgkmcnt(0)" ::: "memory");
#pragma unroll
            for (int i = 0; i < 16; ++i) {
                const f32x2v_t bb = *(const LAS f32x2v_t*)(bu + i * 132 + 2 * lane);
                const float nhr = lbr * hr - lbi * hi + bb.x, nhi = lbr * hi + lbi * hr + bb.y;
                hr = nhr; hi = nhi;
                if (PASS == 3) *(LAS unsigned*)(hs + i * 272 + 4 * lane) = cvtpk(hr, hi);
            }
            if (PASS == 3) {
                asm volatile("s_waitcnt lgkmcnt(0)" ::: "memory");
                f32x4_t acc = {0.f, 0.f, 0.f, 0.f};
#pragma unroll
                for (int ks = 0; ks < 4; ++ks) { U8 af; af.x = *(const LAS u32x4_t*)(hs + cc * 272 + 64 * ks + 16 * q4); acc = __builtin_amdgcn_mfma_f32_16x16x32_bf16(af.v, cf[ks].v, acc, 0, 0, 0); }
#pragma unroll
                for (int r = 0; r < 4; ++r) {
                    const int t = 16 * tt + 4 * q4 + r;
                    const float uv = bf2f(uvr[r]);
                    yp[t * 264 + g * 16 + cc] = (unsigned short)f2bf(geluf_(acc[r] + dch * uv));
                }
            }
            asm volatile("s_waitcnt lgkmcnt(0)" ::: "memory");
        }
        if (PASS == 1) B.E[((size_t)g * 64 + lane) * 256 + n] = make_float2(hr, hi);
    }
    if (PASS == 3) {
        BAR();
        const float* gb = p.in[23] + l * W;
#pragma unroll 1
        for (int tn = 2 * w; tn < 2 * w + 2; ++tn) {
            f32x4_t acc[4];
#pragma unroll
            for (int tt = 0; tt < 4; ++tt) acc[tt] = (f32x4_t){0.f, 0.f, 0.f, 0.f};
            U8 bf[8];
#pragma unroll
            for (int ks = 0; ks < 8; ++ks) bf[ks].q = *(const uint4*)(GLUT + (size_t)(16 * tn + cc) * 256 + 32 * ks + 8 * q4);
#pragma unroll
            for (int ks = 0; ks < 8; ++ks) {
#pragma unroll
                for (int tt = 0; tt < 4; ++tt) {
                    U8 af; af.x = *(const LAS u32x4_t*)(yp + (16 * tt + cc) * 264 + 32 * ks + 8 * q4);
                    acc[tt] = __builtin_amdgcn_mfma_f32_16x16x32_bf16(af.v, bf[ks].v, acc[tt], 0, 0, 0);
                }
            }
            const int ncol = 16 * tn + cc; const float gbn = gb[ncol];
#pragma unroll
            for (int tt = 0; tt < 4; ++tt)
#pragma unroll
                for (int r = 0; r < 4; ++r) {
                    const int t = 16 * tt + 4 * q4 + r;
                    const float yv = bf2f(yp[t * 264 + ncol]);
                    Y[(size_t)(t0 + t) * D + 512 + ncol] = (bf16_t)f2bf(yv * sigmoidf_(acc[tt][r] + gbn));
                }
        }
    }
    BAR();
}
__device__ __forceinline__ void s5_carry_wave(const S5Bufs& B, const Params& p, int l, int gp, int lane) {
    const int g = gp >> 6;
    const float dt = __expf(p.in[21][l * 16 + g]) * 64.f;
    const float lre = p.in[14][l * 1024 + gp], lim = p.in[15][l * 1024 + gp];
    const float er = __expf(lre * dt);
    const float pr = er * cosf(lim * dt), pi = er * sinf(lim * dt);
    float2 e[4];
    const float4* src = (const float4*)(B.E + (size_t)gp * 256 + 4 * lane);
    { const float4 v0 = src[0], v1 = src[1]; e[0] = make_float2(v0.x, v0.y); e[1] = make_float2(v0.z, v0.w); e[2] = make_float2(v1.x, v1.y); e[3] = make_float2(v1.z, v1.w); }
    float Ar = 1.f, Ai = 0.f, Br = 0.f, Bi = 0.f;
#pragma unroll
    for (int k = 0; k < 4; ++k) {
        const float nbr = pr * Br - pi * Bi + e[k].x, nbi = pr * Bi + pi * Br + e[k].y; Br = nbr; Bi = nbi;
        const float nar = pr * Ar - pi * Ai, nai = pr * Ai + pi * Ar; Ar = nar; Ai = nai;
    }
#pragma unroll
    for (int o = 1; o < 64; o <<= 1) {
        const float Alr = __shfl_up(Ar, o), Ali = __shfl_up(Ai, o), Blr = __shfl_up(Br, o), Bli = __shfl_up(Bi, o);
        if (lane >= o) {
            const float nbr = Ar * Blr - Ai * Bli + Br, nbi = Ar * Bli + Ai * Blr + Bi; Br = nbr; Bi = nbi;
            const float nar = Ar * Alr - Ai * Ali, nai = Ar * Ali + Ai * Alr; Ar = nar; Ai = nai;
        }
    }
    float hr = __shfl_up(Br, 1), hi = __shfl_up(Bi, 1); if (lane == 0) { hr = 0.f; hi = 0.f; }
    float2 o4[4];
#pragma unroll
    for (int k = 0; k < 4; ++k) { o4[k] = make_float2(hr, hi); const float nhr = pr * hr - pi * hi + e[k].x, nhi = pr * hi + pi * hr + e[k].y; hr = nhr; hi = nhi; }
    float4* dst = (float4*)(B.CIN + (size_t)gp * 256 + 4 * lane);
    dst[0] = make_float4(o4[0].x, o4[0].y, o4[1].x, o4[1].y); dst[1] = make_float4(o4[2].x, o4[2].y, o4[3].x, o4[3].y);
}

constexpr size_t WS_GQ = 36 * MiB, WS_GK = 44 * MiB, WS_GV = 52 * MiB, WS_GB = 60 * MiB, WS_GC = 61 * MiB;
constexpr size_t WS_MF = 324 * MiB, WS_NF = 356 * MiB, WS_HT = 388 * MiB;
constexpr size_t WS_RR = 420 * MiB, WS_RK = 428 * MiB, WS_RV = 436 * MiB, WS_RKK = 444 * MiB, WS_RA = 452 * MiB, WS_RG = 460 * MiB, WS_CW = 468 * MiB;
constexpr size_t WS_LAGG = 484 * MiB, WS_LCAR = 485 * MiB, WS_S5E = 486 * MiB, WS_S5C = 488 * MiB;
constexpr size_t WS_TG = 490 * MiB;
constexpr int MIX_LDS = 8 * MS * 4 + 1024;
__device__ __forceinline__ LruBufs lru_bufs(unsigned char* ws) { LruBufs B; B.AGG = (float2*)(ws + WS_LAGG); B.CAR = (float*)(ws + WS_LCAR); return B; }
__device__ __forceinline__ S5Bufs s5_bufs(unsigned char* ws) { S5Bufs B; B.E = (float2*)(ws + WS_S5E); B.CIN = (float2*)(ws + WS_S5C); return B; }
__device__ __forceinline__ GdnBufs gdn_bufs(unsigned char* ws) {
    GdnBufs B; B.GQ = (bf16_t*)(ws + WS_GQ); B.GK = (bf16_t*)(ws + WS_GK); B.GV = (bf16_t*)(ws + WS_GV); B.GB = (float*)(ws + WS_GB); B.GC = (float*)(ws + WS_GC);
    B.MF = (uint4*)(ws + WS_MF); B.NF = (float*)(ws + WS_NF); B.HT = (float*)(ws + WS_HT); B.TG = (bf16_t*)(ws + WS_TG); return B;
}
__device__ __forceinline__ RwkvBufs rwkv_bufs(unsigned char* ws) {
    RwkvBufs B; B.RR = (bf16_t*)(ws + WS_RR); B.RK = (bf16_t*)(ws + WS_RK); B.RV = (bf16_t*)(ws + WS_RV); B.RKK = (bf16_t*)(ws + WS_RKK); B.RA = (bf16_t*)(ws + WS_RA); B.RG = (bf16_t*)(ws + WS_RG);
    B.CW = (float*)(ws + WS_CW); B.MF = (uint4*)(ws + WS_MF); B.NF = (float*)(ws + WS_NF); B.HT = (float*)(ws + WS_HT); B.TG = (bf16_t*)(ws + WS_TG); return B;
}
__device__ __forceinline__ unsigned char* opq(unsigned char* w) { unsigned long long v = (unsigned long long)w; asm volatile("" : "+s"(v)); return (unsigned char*)(GAS unsigned char*)v; }
#define XB_TMO      128
#define XB_XCNT(j)  (256  + 64 * (j))
#define XB_XSUB(j)  (1280 + 64 * (j))
#define XB_XGEN(j)  (2304 + 64 * (j))
#define XB_TOP      3328
#define XB_TOPGEN   3392
#define XCD_BAR_WORDS 3456
#define XB_SPIN_CAP (1u << 18)

__device__ __forceinline__ unsigned xb_ld(unsigned* p)              { return __hip_atomic_load(p, __ATOMIC_RELAXED, __HIP_MEMORY_SCOPE_AGENT); }
__device__ __forceinline__ unsigned xb_add(unsigned* p, unsigned v) { return __hip_atomic_fetch_add(p, v, __ATOMIC_RELAXED, __HIP_MEMORY_SCOPE_AGENT); }
__device__ __forceinline__ unsigned xb_xcc_id() { return (unsigned)__builtin_amdgcn_s_getreg((3 << 11) | 20) & 0xFu; }
#define XB_SPIN(cond, bar) do { unsigned _sp = 0; while (cond) { __builtin_amdgcn_s_sleep(1); \
    if ((++_sp & 255u) == 0u) { if (xb_ld(&(bar)[XB_TMO])) break; if (_sp > XB_SPIN_CAP) { atomicAdd(&(bar)[XB_TMO], 1u); break; } } } } while (0)

struct XcdBarrier {
    unsigned* bar; unsigned x;
    volatile LAS unsigned* st;
};

__device__ __forceinline__ XcdBarrier xcd_barrier_post(unsigned* bar, volatile LAS unsigned* st) {
    XcdBarrier b; b.bar = bar; b.x = xb_xcc_id(); b.st = st;
    if (threadIdx.x == 0) (void)xb_add(&bar[XB_XCNT(b.x)], 1u);
    return b;
}
__device__ __forceinline__ void xcd_barrier_complete(unsigned* bar, unsigned x, unsigned& nloc, unsigned& nx) {
    const unsigned G = gridDim.x * gridDim.y * gridDim.z;
    unsigned sum, cnt, mine, sp = 0u;
    for (;;) {
        sum = 0u; cnt = 0u; mine = 0u;
#pragma unroll
        for (unsigned j = 0; j < 16; ++j) { const unsigned c = xb_ld(&bar[XB_XCNT(j)]); sum += c; cnt += (c > 0u) ? 1u : 0u; mine = (j == x) ? c : mine; }
        if (sum == G) break;
        __builtin_amdgcn_s_sleep(1);
        if ((++sp & 255u) == 0u) { if (xb_ld(&bar[XB_TMO])) break; if (sp > XB_SPIN_CAP) { atomicAdd(&bar[XB_TMO], 1u); break; } }
    }
    nloc = mine > 0u ? mine : 1u; nx = cnt > 0u ? cnt : 1u;
}

__device__ __forceinline__ void xcd_barrier(const XcdBarrier& b) {
    asm volatile("s_waitcnt vmcnt(0)" ::: "memory");
    __syncthreads();
    if (threadIdx.x == 0) {
        unsigned* bar = b.bar;
        __builtin_amdgcn_s_waitcnt(0);
        unsigned nloc = b.st[0], nx = b.st[1];
        if (nloc == 0u) { xcd_barrier_complete(bar, b.x, nloc, nx); b.st[0] = nloc; b.st[1] = nx; }
        const unsigned old = xb_add(&bar[XB_XSUB(b.x)], 1u);
        const unsigned gen = old / nloc;
        if (old + 1u == (gen + 1u) * nloc) {
            __builtin_amdgcn_fence(__ATOMIC_RELEASE, "agent");
            asm volatile("s_waitcnt vmcnt(0)" ::: "memory");
            const unsigned og = xb_add(&bar[XB_TOP], 1u);
            const unsigned tg = og / nx;
            if (og + 1u == (tg + 1u) * nx) xb_add(&bar[XB_TOPGEN], 1u);
            else XB_SPIN(xb_ld(&bar[XB_TOPGEN]) == tg, bar);
            __builtin_amdgcn_fence(__ATOMIC_ACQUIRE, "agent");
            xb_add(&bar[XB_XGEN(b.x)], 1u);
            asm volatile("s_waitcnt vmcnt(0)" ::: "memory");
        } else {
            XB_SPIN(xb_ld(&bar[XB_XGEN(b.x)]) == gen, bar);
            __builtin_amdgcn_fence(__ATOMIC_ACQUIRE, "agent");
            asm volatile("s_waitcnt vmcnt(0)" ::: "memory");
        }
    }
    __syncthreads();
}

__device__ __forceinline__ void sub_barrier(unsigned* cnt, unsigned target) {
    asm volatile("s_waitcnt vmcnt(0)" ::: "memory"); __syncthreads();
    if (threadIdx.x == 0) {
        __builtin_amdgcn_fence(__ATOMIC_RELEASE, "agent"); asm volatile("s_waitcnt vmcnt(0)" ::: "memory");
        (void)__hip_atomic_fetch_add(cnt, 1u, __ATOMIC_RELAXED, __HIP_MEMORY_SCOPE_AGENT);
        unsigned sp = 0;
        while (__hip_atomic_load(cnt, __ATOMIC_RELAXED, __HIP_MEMORY_SCOPE_AGENT) < target) { __builtin_amdgcn_s_sleep(2); if (++sp > (1u << 22)) break; }
        __builtin_amdgcn_fence(__ATOMIC_ACQUIRE, "agent"); asm volatile("s_waitcnt vmcnt(0)" ::: "memory");
    }
    __syncthreads();
}

namespace cg = cooperative_groups;
constexpr int FUSED_LDS = MIX_LDS;
static_assert(FUSED_LDS >= pg8::STAGE_BYTES && FUSED_LDS >= 8 * 64 * 33 * 4, "LDS budget");
#define GSYNC() xcd_barrier(bar)
#ifndef PHM
#define PHM 511
#endif
#ifndef REP
#define REP 0
#endif
#ifndef REPU
#define REPU 0
#endif
#ifndef REPP
#define REPP 0
#endif
__global__ void __launch_bounds__(NT, 2) fwd_fused(KParams kp_unused) {
    cg::grid_group grid = cg::this_grid();
    extern __shared__ __attribute__((aligned(16))) unsigned char dl[];
    Params p; p.in.tab = (LAS const unsigned long long*)((LAS unsigned char*)dl + FUSED_LDS);
    {
        const __attribute__((address_space(4))) unsigned long long* ka = (const __attribute__((address_space(4))) unsigned long long*)__builtin_amdgcn_kernarg_segment_ptr();
        if (threadIdx.x < 43) ((LAS unsigned long long*)((LAS unsigned char*)dl + FUSED_LDS))[threadIdx.x] = ka[threadIdx.x];
        if (threadIdx.x < 4) ((LAS unsigned*)((LAS unsigned char*)dl + FUSED_LDS + 512))[threadIdx.x] = 0u;
        __syncthreads();
    }
    const XcdBarrier bar = xcd_barrier_post((unsigned*)(p.ws() + WS_CTL), (volatile LAS unsigned*)((LAS unsigned char*)dl + FUSED_LDS + 512));
    float* X = p.out();
#pragma unroll 1
    for (int l = 0; l < 2; ++l) {
        {
            const int tid = opq_tid();
            convert_weights(p, l, (LAS float*)dl + (tid >> 6) * 64 * 33, blockIdx.x * 8 + (tid >> 6), gridDim.x * 8, tid & 63);
        }
#pragma unroll 1
        for (int b = 0; b < 2; ++b) {
            const float* Xin = (l == 0 ? p.in[0] : X) + (size_t)b * TB * D;
            float* Xb = X + (size_t)b * TB * D;
            { unsigned char* ws = opq(p.ws()); rmsnorm_rows(Xin, p.in[1] + l * D, (bf16_t*)(ws + WS_XN), TB); }
            if (l == 0 && b == 0) grid.sync(); else GSYNC();
#if PHM & 1
            for (int rep_ = 0; rep_ < ((REP & 1) ? 2 : 1); ++rep_) {
            {
                unsigned char* ws = opq(p.ws()); const bf16_t* WL = (const bf16_t*)(ws + WS_W);
                pg8::Gemm g{(const bf16_t*)(ws + WS_XN), WL + WO_IN, TB, 7168, D, D, D, 0};
                pg8::StaticOrder S; S.init(g.M, g.N, (int)gridDim.x, (int)blockIdx.x);
                pg8::gemm_phase<pg8::EpiProjP, pg8::StaticOrder, true, true>((PG8_LAS unsigned char*)dl, g, S, pg8::EpiProjP{(bf16_t*)(ws + WS_PM), (bf16_t*)(ws + WS_G)});
            }
            }
#endif
            GSYNC();
#if PHM & 2
            for (int rep_ = 0; rep_ < ((REP & 2) ? 2 : 1); ++rep_) {
            for (int ps_ = 0; ps_ < ((REPP == 2) ? 2 : 1); ++ps_)
            for (int n = blockIdx.x; n < 512; n += gridDim.x) {
                if (ps_ == 1 && ((n < 256) ? 1 : 2) != REPU) continue;
                unsigned char* ws = opq(p.ws());
                if (n < 256) gdn_prep_chunk((const bf16_t*)(ws + WS_PM), n, gdn_bufs(ws), p, l, (LAS float*)dl);
                else { const bf16_t* WL = (const bf16_t*)(ws + WS_W); rwkv_prep_chunk((const bf16_t*)(ws + WS_PM), n - 256, rwkv_bufs(ws), p, l, WL + WO_WUP, WL + WO_AUP, WL + WO_GUP, (LAS unsigned char*)dl); }
            }
            }
#endif
            if (gridDim.x == 256) {
                asm volatile("s_waitcnt vmcnt(0)" ::: "memory"); __syncthreads();
                if (threadIdx.x == 0) { __builtin_amdgcn_fence(__ATOMIC_ACQUIRE, "agent"); asm volatile("s_waitcnt vmcnt(0)" ::: "memory"); }
                __syncthreads();
            } else GSYNC();
#if PHM & 4
            for (int rep_ = 0; rep_ < ((REP & 4) ? 2 : 1); ++rep_) {
            for (int ps_ = 0; ps_ < ((REPP == 4) ? 2 : 1); ++ps_)
            for (int u = blockIdx.x; u < 2048; u += gridDim.x) {
                const int ut_ = u < 1024 ? 1 : 2;
                if (ps_ == 1 && ut_ != REPU) continue;
                unsigned char* ws = opq(p.ws());
                if (u < 1024) gdn_g1_unit(u >> 8, u & 255, gdn_bufs(ws), (bf16_t*)(ws + WS_Y), (LAS unsigned char*)dl);
                else rwkv_g1_unit((u - 1024) >> 8, u & 255, rwkv_bufs(ws), (bf16_t*)(ws + WS_Y), (LAS unsigned char*)dl);
            }
            }
#endif
            GSYNC();
#if PHM & 8
            for (int rep_ = 0; rep_ < ((REP & 8) ? 2 : 1); ++rep_) {
            {
                const int tid = opq_tid(), lane = tid & 63, wv = tid >> 6;
                const int bx = blockIdx.x;
                volatile LAS unsigned* flags = (volatile LAS unsigned*)((LAS unsigned char*)dl + FUSED_LDS + 768);
                if (tid < 16) flags[tid] = 0u;
                __syncthreads();
                if (bx < 32) {
                    unsigned char* ws = opq(p.ws());
                    const GdnBufs B = gdn_bufs(ws); const int sq = bx >> 2, cb = bx & 3;
                    if (wv == 0) chain_wave(B.HT + (size_t)sq * 256 * 4096, cb, 256, lane, (LAS unsigned char*)dl, flags);
                    else chain_loader(B.MF + (size_t)sq * 256 * 1024, B.NF + (size_t)sq * 256 * 4096, cb, 256, lane, wv - 1, (LAS unsigned char*)dl, flags);
                } else {
                    for (int u = bx - 32; u < 512; u += (int)gridDim.x - 32) {
                        unsigned char* ws = opq(p.ws());
                        if (u < 256) lru_unit<1>((const bf16_t*)(ws + WS_PM), u, lru_bufs(ws), (bf16_t*)(ws + WS_Y), p, l, (const bf16_t*)(ws + WS_W) + WO_LWT, (LAS float*)dl);
                        else s5_unit<1>((const bf16_t*)(ws + WS_PM), u - 256, s5_bufs(ws), (bf16_t*)(ws + WS_Y), p, l, (const bf16_t*)(ws + WS_W), (LAS unsigned char*)dl);
                    }
                    sub_barrier((unsigned*)(p.ws() + WS_CTL + 15488), (unsigned)(gridDim.x - 32) * (unsigned)(l * 2 + b + 1));
                    {
                        unsigned char* ws = opq(p.ws());
                        for (int job = (bx - 32) * 8 + wv; job < 1280; job += (int)(gridDim.x - 32) * 8) {
                            if (job < 256) lru_carry_wave(lru_bufs(ws), job, lane);
                            else s5_carry_wave(s5_bufs(ws), p, l, job - 256, lane);
                        }
                    }
                    sub_barrier((unsigned*)(p.ws() + WS_CTL + 15360), (unsigned)(gridDim.x - 32) * (unsigned)(l * 2 + b + 1));
                    for (int u = bx - 32; u < 512; u += (int)gridDim.x - 32) {
                        unsigned char* ws = opq(p.ws());
                        if (u < 256) lru_unit<3>((const bf16_t*)(ws + WS_PM), u, lru_bufs(ws), (bf16_t*)(ws + WS_Y), p, l, (const bf16_t*)(ws + WS_W) + WO_LWT, (LAS float*)dl);
                        else s5_unit<3>((const bf16_t*)(ws + WS_PM), u - 256, s5_bufs(ws), (bf16_t*)(ws + WS_Y), p, l, (const bf16_t*)(ws + WS_W), (LAS unsigned char*)dl);
                    }
                }
            }
            }
#endif
            GSYNC();
#if PHM & 16
            for (int rep_ = 0; rep_ < ((REP & 16) ? 2 : 1); ++rep_) {
            for (int ps_ = 0; ps_ < ((REPP == 16) ? 2 : 1); ++ps_)
            for (int u = blockIdx.x; u < 2048; u += gridDim.x) {
                const int ut_ = u < 1024 ? 1 : (u < 2048 ? 2 : (u < 2304 ? 3 : 4));
                if (ps_ == 1 && ut_ != REPU) continue;
                unsigned char* ws = opq(p.ws());
                if (u < 1024) gdn_g3_unit(u >> 8, u & 255, gdn_bufs(ws), (const bf16_t*)(ws + WS_PM), (bf16_t*)(ws + WS_Y), p.in[6] + l * 64, (LAS unsigned char*)dl);
                else rwkv_g3_unit((u - 1024) >> 8, u & 255, rwkv_bufs(ws), (bf16_t*)(ws + WS_Y), p, l, (LAS unsigned char*)dl);
            }
            }
#endif
            GSYNC();
#if PHM & 32
            for (int rep_ = 0; rep_ < ((REP & 32) ? 2 : 1); ++rep_) {
            { unsigned char* ws = opq(p.ws()); merge_phase((const bf16_t*)(ws + WS_Y), (const bf16_t*)(ws + WS_W) + WO_BR, (const bf16_t*)(ws + WS_G), (bf16_t*)(ws + WS_MG), (LAS unsigned char*)dl); }
            }
#endif
            GSYNC();
#if PHM & 64
            {
                unsigned char* ws = opq(p.ws()); const bf16_t* WL = (const bf16_t*)(ws + WS_W);
                pg8::Gemm g{(const bf16_t*)(ws + WS_MG), WL + WO_OUT, TB, D, D, D, D, 0};
                pg8::StaticOrder S; S.init(g.M, g.N, (int)gridDim.x, (int)blockIdx.x);
                pg8::gemm_phase<pg8::EpiResidP, pg8::StaticOrder, false, true>((PG8_LAS unsigned char*)dl, g, S, pg8::EpiResidP{Xin, Xb});
            }
#endif
            GSYNC();
            { unsigned char* ws = opq(p.ws()); rmsnorm_rows(Xb, p.in[37] + l * D, (bf16_t*)(ws + WS_XN), TB); }
            GSYNC();
#if PHM & 128
            for (int rep_ = 0; rep_ < ((REP & 128) ? 2 : 1); ++rep_) {
            {
                unsigned char* ws = opq(p.ws()); const bf16_t* WL = (const bf16_t*)(ws + WS_W);
                pg8::Gemm g{(const bf16_t*)(ws + WS_XN), WL + WO_W1, TB, DFF, D, D, D, 0};
                pg8::StaticOrder S; S.init(g.M, g.N, (int)gridDim.x, (int)blockIdx.x);
                pg8::gemm_phase<pg8::EpiRelu2P, pg8::StaticOrder, true, true>((PG8_LAS unsigned char*)dl, g, S, pg8::EpiRelu2P{(bf16_t*)(ws + WS_HD), DFF, 0});
            }
            }
#endif
            GSYNC();
#if PHM & 256
            {
                unsigned char* ws = opq(p.ws()); const bf16_t* WL = (const bf16_t*)(ws + WS_W);
                pg8::Gemm g{(const bf16_t*)(ws + WS_HD), WL + WO_W2, TB, D, DFF, DFF, DFF, 0};
                pg8::StaticOrder S; S.init(g.M, g.N, (int)gridDim.x, (int)blockIdx.x);
                pg8::gemm_phase<pg8::EpiResidP, pg8::StaticOrder, false, true>((PG8_LAS unsigned char*)dl, g, S, pg8::EpiResidP{Xb, Xb});
            }
#endif
            GSYNC();
        }
    }
    rmsnorm_rows(X, p.in[40], X, 2 * TB);
}

extern "C" void kernel_launch(void* const* d_in, const int* in_sizes, int n_in, void* d_out, int out_size, void* d_ws, size_t ws_size, hipStream_t stream) {
    KParams p{};
    for (int i = 0; i < 41; ++i) p.in[i] = (const float*)d_in[i];
    p.out = (float*)d_out; p.ws = (unsigned char*)d_ws; p.pad = 0;
    static int grid = 0;
    if (grid == 0) {
        int dev = 0, cus = 0, per_cu = 0;
        hipGetDevice(&dev);
        hipDeviceGetAttribute(&cus, hipDeviceAttributeMultiprocessorCount, dev);
        hipFuncSetAttribute((const void*)fwd_fused, hipFuncAttributeMaxDynamicSharedMemorySize, FUSED_LDS + 1024);
        hipOccupancyMaxActiveBlocksPerMultiprocessor(&per_cu, (const void*)fwd_fused, NT, FUSED_LDS + 1024);
        if (per_cu < 1) per_cu = 1;
        grid = cus * per_cu;
        if (grid > 256) grid = 256;
    }
    hipMemsetAsync((unsigned char*)d_ws + WS_CTL, 0, 16384, stream);
    void* args[] = {&p};
    hipError_t e = hipLaunchCooperativeKernel((const void*)fwd_fused, dim3(grid), dim3(NT), args, FUSED_LDS + 1024, stream);
    if (e != hipSuccess) fprintf(stderr, "cooperative launch failed: %s (grid %d)\n", hipGetErrorString(e), grid);
}
```

```cpp
#include <hip/hip_runtime.h>
#ifndef MEXP
#define MEXP 0
#endif
#ifndef PEXP
#define PEXP 0
#endif
#include <hip/hip_cooperative_groups.h>
#include <cstdio>
#include <cstdint>

constexpr int TB = 16384;
constexpr int D = 1024;
constexpr int DIN = 6920;
constexpr int NMIX = 2824;
constexpr int W = 256;
constexpr int DFF = 4096;
constexpr int NT = 512;

constexpr int C_GDN = 0, C_LRU = 1032, C_S5 = 1544, C_RWKV = 1800, C_GATE = 2824;

struct KParams { const float* in[41]; float* out; unsigned char* ws; size_t pad; };
#define LAS __attribute__((address_space(3)))
#define GAS __attribute__((address_space(1)))
struct PIn { LAS const unsigned long long* tab;
    __device__ __forceinline__ const float* operator[](int i) const { LAS const unsigned long long* t = tab; asm volatile("" : "+v"(t)); const unsigned long long v = t[i];
        const unsigned lo = __builtin_amdgcn_readfirstlane((unsigned)v), hi = __builtin_amdgcn_readfirstlane((unsigned)(v >> 32)); return (const float*)(GAS const float*)(((unsigned long long)hi << 32) | lo); } };
struct Params { PIn in;
    __device__ __forceinline__ float* out() const { return (float*)in[41]; }
    __device__ __forceinline__ unsigned char* ws() const { return (unsigned char*)in[42]; } };

typedef unsigned short bf16_t;
constexpr int PMLD = 3072;
constexpr size_t MiB = 1u << 20;
constexpr size_t WS_W  = 0;
constexpr size_t WS_CTL = 35 * MiB;
constexpr size_t WS_XN = 36 * MiB;
constexpr size_t WS_PM = 68 * MiB;
constexpr size_t WS_G  = 164 * MiB;
constexpr size_t WS_HD = 164 * MiB;
constexpr size_t WS_Y  = 292 * MiB;
constexpr size_t WS_MG = 324 * MiB;

__device__ __forceinline__ unsigned f2bf(float f) { unsigned u = __float_as_uint(f); return (u + 0x7fffu + ((u >> 16) & 1u)) >> 16; }
__device__ __forceinline__ float bf2f(bf16_t b) { return __uint_as_float((unsigned)b << 16); }
__device__ __forceinline__ float ldf(const float* p) { return *p; }
__device__ __forceinline__ float ldf(const bf16_t* p) { return bf2f(*p); }
__device__ __forceinline__ float sigmoidf_(float x) { return __builtin_amdgcn_rcpf(1.f + __expf(-x)); }
__device__ __forceinline__ float softplusf_(float x) { const float e = __expf(x); return x > 20.f ? x : (e < 1e-4f ? e : __logf(1.f + e)); }
__device__ __forceinline__ float siluf_(float x) { return x * sigmoidf_(x); }
__device__ __forceinline__ float tanhf_(float y) { return 1.f - 2.f * __builtin_amdgcn_rcpf(1.f + __expf(2.f * y)); }
__device__ __forceinline__ float geluf_(float x) { return 0.5f * x * (1.f + tanhf_(0.7978845608028654f * (x + 0.044715f * x * x * x))); }
__device__ __forceinline__ float rl(float v, int i) { return __int_as_float(__builtin_amdgcn_readlane(__float_as_int(v), i)); }
__device__ __forceinline__ float wave_sum(float v) {
#pragma unroll
    for (int o = 1; o < 64; o <<= 1) v += __shfl_xor(v, o);
    return v;
}

template <class OT>
__device__ __forceinline__ void rmsnorm_rows(const float* X, const float* g, OT* O, int rows) {
    int tid_ = threadIdx.x; asm volatile("" : "+v"(tid_));
    const int lane = tid_ & 63, wv = tid_ >> 6;
    const int gw = blockIdx.x * (NT / 64) + wv, ngw = gridDim.x * (NT / 64);
    float4 gg[4];
#pragma unroll
    for (int j = 0; j < 4; ++j) gg[j] = ((const float4*)g)[lane + 64 * j];
    if (gw >= rows) return;
    float4 v[4], vn[4];
#pragma unroll
    for (int j = 0; j < 4; ++j) v[j] = ((const float4*)(X + (size_t)gw * D))[lane + 64 * j];
    for (int r = gw; r < rows; r += ngw) {
        const int rn = (r + ngw < rows) ? r + ngw : r;
#pragma unroll
        for (int j = 0; j < 4; ++j) vn[j] = ((const float4*)(X + (size_t)rn * D))[lane + 64 * j];
        float s = 0.f;
#pragma unroll
        for (int j = 0; j < 4; ++j) s += v[j].x * v[j].x + v[j].y * v[j].y + v[j].z * v[j].z + v[j].w * v[j].w;
        s = wave_sum(s);
        const float rs = rsqrtf(s * (1.f / D) + 1e-6f);
#pragma unroll
        for (int j = 0; j < 4; ++j) {
            const float4 o = make_float4(v[j].x * rs * gg[j].x, v[j].y * rs * gg[j].y, v[j].z * rs * gg[j].z, v[j].w * rs * gg[j].w);
            if constexpr (sizeof(OT) == 4) ((float4*)(O + (size_t)r * D))[lane + 64 * j] = o;
            else ((uint2*)(O + (size_t)r * D))[lane + 64 * j] = make_uint2(f2bf(o.x) | (f2bf(o.y) << 16), f2bf(o.z) | (f2bf(o.w) << 16));
        }
#pragma unroll
        for (int j = 0; j < 4; ++j) v[j] = vn[j];
    }
}

namespace pg8 {
#define PG8_LAS __attribute__((address_space(3)))
typedef short bf16x8 __attribute__((ext_vector_type(8)));
typedef float f32x4 __attribute__((ext_vector_type(4)));
typedef unsigned u32x4 __attribute__((ext_vector_type(4)));
constexpr int BM = 256, BK = 64, HALF = 128, HTB = HALF * BK * 2  , STAGE_BYTES = 8 * HTB, NXCD = 8, WGM = 8;

__host__ __device__ __forceinline__ int lds_byte(int r, int c) { const int st = (r >> 4) * 2 + (c >> 5), rr = r & 15, cc = c & 31, ob = rr * 64 + cc * 2; return st * 1024 + (ob ^ (((ob >> 9) & 1) << 5)); }
__host__ __device__ __forceinline__ void stage_rc(int b, int& R, int& C) { const int st = b / 1024, sb = b % 1024, swz = sb ^ (((sb >> 9) & 1) << 5); R = (st >> 1) * 16 + swz / 64; C = (st & 1) * 32 + (swz % 64) / 2; }
__host__ __device__ __forceinline__ int perm32(int rho) { const int n = rho >> 4, i = rho & 15; return 8 * (i >> 2) + 4 * n + (i & 3); }

struct Unit { int pm, pn; };
struct Gemm { const bf16_t* A; const bf16_t* Bt; int M, N, K, lda, ldb, pad; };

struct StaticOrder {
    int nM, nN, nwg, G, c;
    __host__ __device__ void init(int M, int N, int G_, int c_) { nM = M / BM; nN = N / BM; nwg = nM * nN; G = G_; c = c_; }
    __host__ __device__ bool next(int i, Unit& u) const {
        const long L = (long)i * G + c; if (L >= nwg) return false;
        int wgid = (int)L; { const int q = nwg / NXCD, r = nwg % NXCD, xcd = wgid % NXCD, off = wgid / NXCD; wgid = (xcd < r ? xcd * (q + 1) : r * (q + 1) + (xcd - r) * q) + off; }
        const int nig = WGM * nN, gid = wgid / nig, fm = gid * WGM, gsz = (nM - fm) < WGM ? (nM - fm) : WGM;
        u.pm = fm + ((wgid % nig) % gsz); u.pn = (wgid % nig) / gsz; return true;
    }
    __device__ __forceinline__ void a_ready(const Unit&) const {}
    __device__ __forceinline__ void done(const Unit&) const {}
};


typedef __bf16 bf16x2p_t __attribute__((ext_vector_type(2)));
typedef float f32x2p_t __attribute__((ext_vector_type(2)));
__device__ __forceinline__ unsigned cvt_pk_bf16(float lo, float hi) { return __builtin_bit_cast(unsigned, __builtin_convertvector((f32x2p_t){lo, hi}, bf16x2p_t)); }
__device__ __forceinline__ float sigm(float x) { return __builtin_amdgcn_rcpf(1.f + __expf(-x)); }
struct EpiProjP {
    static constexpr bool PERM = true, AFTER_DRAIN = false;
    bf16_t* PM; bf16_t* G;
    __device__ __forceinline__ void operator()(const f32x4 (&acc)[2][2][4][2], const Unit& u, int wr, int wc, int fr, int fq) const {
        const int row0 = u.pm * BM + wr * 64 + fr;
        const bool sg = u.pn >= 12;
        bf16_t* base = sg ? G : PM; const int ld = sg ? 4096 : 3072; const int colt = (sg ? u.pn - 12 : u.pn) * BM;
        const int col0 = colt + wc * 32 + 8 * fq;
#pragma unroll
        for (int ai = 0; ai < 2; ++ai)
#pragma unroll
            for (int m = 0; m < 4; ++m) { bf16_t* rowp = base + (size_t)(row0 + ai * HALF + m * 16) * ld + col0;
#pragma unroll
                for (int bj = 0; bj < 2; ++bj) { f32x4 v0 = acc[ai][bj][m][0], v1 = acc[ai][bj][m][1];
                    if (sg) { v0[0] = sigm(v0[0]); v0[1] = sigm(v0[1]); v0[2] = sigm(v0[2]); v0[3] = sigm(v0[3]); v1[0] = sigm(v1[0]); v1[1] = sigm(v1[1]); v1[2] = sigm(v1[2]); v1[3] = sigm(v1[3]); }
                    u32x4 w; w.x = cvt_pk_bf16(v0[0], v0[1]); w.y = cvt_pk_bf16(v0[2], v0[3]); w.z = cvt_pk_bf16(v1[0], v1[1]); w.w = cvt_pk_bf16(v1[2], v1[3]);
                    *(u32x4*)(rowp + bj * HALF) = w; } }
    }
};
struct EpiRelu2P {
    static constexpr bool PERM = true, AFTER_DRAIN = false;
    bf16_t* O; int ldo; int pad;
    __device__ __forceinline__ void operator()(const f32x4 (&acc)[2][2][4][2], const Unit& u, int wr, int wc, int fr, int fq) const {
        const int row0 = u.pm * BM + wr * 64 + fr, col0 = u.pn * BM + wc * 32 + 8 * fq;
#pragma unroll
        for (int ai = 0; ai < 2; ++ai)
#pragma unroll
            for (int m = 0; m < 4; ++m) { bf16_t* rowp = O + (size_t)(row0 + ai * HALF + m * 16) * ldo + col0;
#pragma unroll
                for (int bj = 0; bj < 2; ++bj) { f32x4 v0 = acc[ai][bj][m][0], v1 = acc[ai][bj][m][1];
#pragma unroll
                    for (int j = 0; j < 4; ++j) { const float a = fmaxf(v0[j], 0.f), b = fmaxf(v1[j], 0.f); v0[j] = a * a; v1[j] = b * b; }
                    u32x4 w; w.x = cvt_pk_bf16(v0[0], v0[1]); w.y = cvt_pk_bf16(v0[2], v0[3]); w.z = cvt_pk_bf16(v1[0], v1[1]); w.w = cvt_pk_bf16(v1[2], v1[3]);
                    *(u32x4*)(rowp + bj * HALF) = w; } }
    }
};
struct EpiResidP {
    static constexpr bool PERM = false, AFTER_DRAIN = false;
    const float* base; float* out;
    __device__ __forceinline__ void operator()(const f32x4 (&acc)[2][2][4][2], const Unit& u, int wr, int wc, int fr, int fq) const {
        const int row0 = u.pm * BM + wr * 64 + fr, col0 = u.pn * BM + wc * 32 + 4 * fq;
        f32x4 rb[4][4];
#define EPI_LD(g_) do { const size_t off_ = (size_t)(row0 + ((g_) >> 2) * HALF + ((g_) & 3) * 16) * 1024 + col0; \
            _Pragma("unroll") for (int bj = 0; bj < 2; ++bj) _Pragma("unroll") for (int n = 0; n < 2; ++n) rb[(g_) & 3][bj * 2 + n] = *(const f32x4*)(base + off_ + bj * HALF + n * 16); } while (0)
#define EPI_ST(g_) do { const size_t off_ = (size_t)(row0 + ((g_) >> 2) * HALF + ((g_) & 3) * 16) * 1024 + col0; \
            _Pragma("unroll") for (int bj = 0; bj < 2; ++bj) _Pragma("unroll") for (int n = 0; n < 2; ++n) *(f32x4*)(out + off_ + bj * HALF + n * 16) = rb[(g_) & 3][bj * 2 + n] + acc[(g_) >> 2][bj][(g_) & 3][n]; } while (0)
        EPI_LD(0); EPI_LD(1); EPI_LD(2);
        EPI_LD(3); EPI_ST(0); EPI_LD(4); EPI_ST(1); EPI_LD(5); EPI_ST(2); EPI_LD(6); EPI_ST(3); EPI_LD(7); EPI_ST(4);
        EPI_ST(5); EPI_ST(6); EPI_ST(7);
#undef EPI_LD
#undef EPI_ST
    }
};
template <class Epi, class Sched, bool ALIGN_EPI = false, bool SP2 = false>
__device__ __forceinline__ void gemm_phase(PG8_LAS unsigned char* lds, const Gemm g, const Sched& S, const Epi& E) {
    int tid = threadIdx.x; asm volatile("" : "+v"(tid));
    const int wid = __builtin_amdgcn_readfirstlane(tid >> 6), lane = tid & 63, wr = wid >> 2, wc = wid & 3, fr = lane & 15, fq = lane >> 4;
    const int K = g.K, nt = K / BK;
    unsigned voffA[2], voffB[2];
#pragma unroll
    for (int i = 0; i < 2; ++i) { int R, C; stage_rc(tid * 16 + i * 8192, R, C); const int Rb = Epi::PERM ? ((R & ~31) + perm32(R & 31)) : R;
        voffA[i] = (unsigned)(R * g.lda + C) * 2u; voffB[i] = (unsigned)(Rb * g.ldb + C) * 2u; }
    const size_t kstep = (size_t)(BK * 2);
    const size_t hstepA = (size_t)HALF * g.lda * 2, hstepB = (size_t)HALF * g.ldb * 2;
    const size_t tstepA = 2 * hstepA, tstepB = 2 * hstepB;
    const unsigned ldsw = (unsigned)wid * 1024u;
    const int aoff = lds_byte(wr * 64 + fr, fq * 8), boff = lds_byte(wc * 32 + fr, fq * 8);
#define PG8_SA(b, h) (((b) * 2 + (h)) * HTB)
#define PG8_SB(b, h) ((4 + (b) * 2 + (h)) * HTB)
#define PG8_STAGE(bufoff, gbase, voff) do { _Pragma("unroll") for (int _i = 0; _i < 2; ++_i) \
        __builtin_amdgcn_global_load_lds((const unsigned*)((const char*)(gbase) + (voff)[_i]), (PG8_LAS unsigned*)(lds + (bufoff) + ldsw + _i * 8192), 16, 0, 0); } while (0)
#define PG8_LDA(dst, b, h) do { _Pragma("unroll") for (int m = 0; m < 4; ++m) _Pragma("unroll") for (int k = 0; k < 2; ++k) dst[m][k] = *(const PG8_LAS bf16x8*)(lds + PG8_SA(b, h) + aoff + m * 2048 + k * 1024); } while (0)
#define PG8_LDB(dst, b, h) do { _Pragma("unroll") for (int n = 0; n < 2; ++n) _Pragma("unroll") for (int k = 0; k < 2; ++k) dst[n][k] = *(const PG8_LAS bf16x8*)(lds + PG8_SB(b, h) + boff + n * 2048 + k * 1024); } while (0)
#define PG8_MMA(ai, bj, At, Bt) do { __builtin_amdgcn_s_setprio(1); _Pragma("unroll") for (int m = 0; m < 4; ++m) _Pragma("unroll") for (int n = 0; n < 2; ++n) _Pragma("unroll") for (int k = 0; k < 2; ++k) \
        acc[ai][bj][m][n] = __builtin_amdgcn_mfma_f32_16x16x32_bf16(Bt[n][k], At[m][k], acc[ai][bj][m][n], 0, 0, 0); __builtin_amdgcn_s_setprio(0); } while (0)
#define PG8_WAIT_V(n) asm volatile("s_waitcnt vmcnt(" #n ")" ::: "memory")
#define PG8_WAIT_L(n) asm volatile("s_waitcnt lgkmcnt(" #n ")" ::: "memory")
#define PG8_BAR __builtin_amdgcn_s_barrier()
#define PG8_SCHED __builtin_amdgcn_sched_barrier(0)
    Unit cur, nxt; int ui = 0;
    if (!S.next(0, cur)) return;
    f32x4 acc[2][2][4][2];
#pragma unroll
    for (int a = 0; a < 2; ++a)
#pragma unroll
        for (int b = 0; b < 2; ++b)
#pragma unroll
            for (int m = 0; m < 4; ++m)
#pragma unroll
                for (int n = 0; n < 2; ++n) acc[a][b][m][n] = (f32x4){0.f, 0.f, 0.f, 0.f};
    bf16x8 At[4][2], B0[2][2], B1[2][2];
    const char* cA = (const char*)g.A + (size_t)cur.pm * tstepA; const char* cB = (const char*)g.Bt + (size_t)cur.pn * tstepB;
    S.a_ready(cur);
    if constexpr (SP2) {
        PG8_STAGE(PG8_SB(0, 0), cB, voffB); PG8_STAGE(PG8_SB(0, 1), cB + hstepB, voffB); PG8_STAGE(PG8_SA(0, 0), cA, voffA); PG8_STAGE(PG8_SA(0, 1), cA + hstepA, voffA);
        if (wr == 1) PG8_BAR;
        PG8_WAIT_V(2); PG8_BAR;
        PG8_STAGE(PG8_SB(1, 0), cB + kstep, voffB); PG8_STAGE(PG8_SA(1, 0), cA + kstep, voffA); PG8_STAGE(PG8_SB(1, 1), cB + hstepB + kstep, voffB);
        PG8_WAIT_V(6); PG8_BAR;
    } else {
        PG8_STAGE(PG8_SB(0, 0), cB, voffB); PG8_STAGE(PG8_SA(0, 0), cA, voffA); PG8_STAGE(PG8_SB(0, 1), cB + hstepB, voffB); PG8_STAGE(PG8_SA(0, 1), cA + hstepA, voffA);
        if (wr == 1) PG8_BAR;
        PG8_WAIT_V(4); PG8_BAR;
        PG8_STAGE(PG8_SB(1, 0), cB + kstep, voffB); PG8_STAGE(PG8_SA(1, 0), cA + kstep, voffA); PG8_STAGE(PG8_SB(1, 1), cB + hstepB + kstep, voffB);
        PG8_WAIT_V(6); PG8_BAR;
    }
    for (;;) {
        const bool has_next = S.next(ui + 1, nxt);
        const char* nA = has_next ? (const char*)g.A + (size_t)nxt.pm * tstepA : cA; const char* nB = has_next ? (const char*)g.Bt + (size_t)nxt.pn * tstepB : cB;
        for (int t = 0; t < nt; t += 2) {
            const bool last = (t == nt - 2);
            const char* a1 = cA + (size_t)(t + 1) * kstep;
            const char* a2 = last ? nA : cA + (size_t)(t + 2) * kstep; const char* b2 = last ? nB : cB + (size_t)(t + 2) * kstep;
            const char* a3 = a2 + kstep; const char* b3 = b2 + kstep;
            if (last && has_next) S.a_ready(nxt);
            if constexpr (SP2) {
            PG8_LDB(B0, 0, 0); PG8_LDB(B1, 0, 1); PG8_SCHED; PG8_LDA(At, 0, 0); PG8_STAGE(PG8_SA(1, 1), a1 + hstepA, voffA);
            PG8_WAIT_V(8); PG8_WAIT_L(0); PG8_BAR; PG8_MMA(0, 0, At, B0); PG8_MMA(0, 1, At, B1); PG8_BAR; PG8_SCHED;
            PG8_LDA(At, 0, 1); PG8_STAGE(PG8_SB(0, 0), b2, voffB); PG8_STAGE(PG8_SB(0, 1), b2 + hstepB, voffB); PG8_STAGE(PG8_SA(0, 0), a2, voffA);
            PG8_WAIT_V(8); PG8_WAIT_L(0); PG8_BAR; PG8_MMA(1, 0, At, B0); PG8_MMA(1, 1, At, B1); PG8_BAR; PG8_SCHED;
            PG8_LDB(B0, 1, 0); PG8_LDB(B1, 1, 1); PG8_SCHED; PG8_LDA(At, 1, 0); PG8_STAGE(PG8_SA(0, 1), a2 + hstepA, voffA);
            PG8_WAIT_V(8); PG8_WAIT_L(0); PG8_BAR; PG8_MMA(0, 0, At, B0); PG8_MMA(0, 1, At, B1); PG8_BAR; PG8_SCHED;
            PG8_LDA(At, 1, 1); PG8_STAGE(PG8_SB(1, 0), b3, voffB); PG8_STAGE(PG8_SB(1, 1), b3 + hstepB, voffB); PG8_STAGE(PG8_SA(1, 0), a3, voffA);
            PG8_WAIT_V(8); PG8_WAIT_L(0); PG8_BAR; PG8_MMA(1, 0, At, B0); PG8_MMA(1, 1, At, B1); PG8_BAR; PG8_SCHED;
            } else {
            PG8_LDB(B0, 0, 0); PG8_SCHED; PG8_LDA(At, 0, 0); PG8_STAGE(PG8_SA(1, 1), a1 + hstepA, voffA);
            PG8_WAIT_L(8); PG8_BAR; PG8_WAIT_L(0); PG8_MMA(0, 0, At, B0); PG8_BAR; PG8_SCHED;
            PG8_LDB(B1, 0, 1); PG8_STAGE(PG8_SB(0, 0), b2, voffB);
            PG8_BAR; PG8_WAIT_L(0); PG8_MMA(0, 1, At, B1); PG8_BAR;
            PG8_LDA(At, 0, 1); PG8_STAGE(PG8_SA(0, 0), a2, voffA);
            PG8_BAR; PG8_WAIT_L(0); PG8_MMA(1, 0, At, B0); PG8_BAR; PG8_SCHED;
            PG8_STAGE(PG8_SB(0, 1), b2 + hstepB, voffB);
            PG8_WAIT_V(6); PG8_BAR; PG8_MMA(1, 1, At, B1); PG8_BAR;
            PG8_LDB(B0, 1, 0); PG8_SCHED; PG8_LDA(At, 1, 0); PG8_STAGE(PG8_SA(0, 1), a2 + hstepA, voffA);
            PG8_WAIT_L(8); PG8_BAR; PG8_WAIT_L(0); PG8_MMA(0, 0, At, B0); PG8_BAR; PG8_SCHED;
            PG8_LDB(B1, 1, 1); PG8_STAGE(PG8_SB(1, 0), b3, voffB);
            PG8_BAR; PG8_WAIT_L(0); PG8_MMA(0, 1, At, B1); PG8_BAR;
            PG8_LDA(At, 1, 1); PG8_STAGE(PG8_SA(1, 0), a3, voffA);
            PG8_BAR; PG8_WAIT_L(0); PG8_MMA(1, 0, At, B0); PG8_BAR; PG8_SCHED;
            PG8_STAGE(PG8_SB(1, 1), b3 + hstepB, voffB);
            PG8_WAIT_V(6); PG8_BAR; PG8_MMA(1, 1, At, B1); PG8_BAR;
            }
        }
        if constexpr (ALIGN_EPI) { if (wr == 0) PG8_BAR; }
        if constexpr (!Epi::AFTER_DRAIN) { E(acc, cur, wr, wc, fr, fq); S.done(cur); }
        if (!has_next) break;
#pragma unroll
        for (int a = 0; a < 2; ++a)
#pragma unroll
            for (int b = 0; b < 2; ++b)
#pragma unroll
                for (int m = 0; m < 4; ++m)
#pragma unroll
                    for (int n = 0; n < 2; ++n) acc[a][b][m][n] = (f32x4){0.f, 0.f, 0.f, 0.f};
        cur = nxt; cA = nA; cB = nB; ++ui;
        if constexpr (ALIGN_EPI) { if (wr == 1) PG8_BAR; }
    }
    PG8_WAIT_V(0);
    if constexpr (!ALIGN_EPI) { if (wr == 0) PG8_BAR; }
    PG8_BAR;
    if constexpr (Epi::AFTER_DRAIN) { E.fused(acc, cur, wr, wc, fr, fq, lds, wid, lane); S.done(cur); }
#undef PG8_SA
#undef PG8_SB
#undef PG8_STAGE
#undef PG8_LDA
#undef PG8_LDB
#undef PG8_MMA
#undef PG8_WAIT_V
#undef PG8_WAIT_L
#undef PG8_BAR
#undef PG8_SCHED
}
}


__device__ __forceinline__ unsigned pk2(float lo, float hi) { return f2bf(lo) | (f2bf(hi) << 16); }
template <class CM>
__device__ __forceinline__ void transpose_item(const float* __restrict__ Wsrc, int K, int ldsrc, bf16_t* __restrict__ WT, int nblk, LAS float* scr, int item, int lane, CM colmap) {
    const int kb = item / nblk, nb = item % nblk, k0 = 64 * kb, n0 = 32 * nb;
    const int sc = colmap(n0 + (lane & 31));
#pragma unroll 8
    for (int i = 0; i < 32; ++i) { const int kk = 2 * i + (lane >> 5); const float wv_ = Wsrc[(size_t)(k0 + kk) * ldsrc + (sc >= 0 ? sc : 0)]; scr[kk * 33 + (lane & 31)] = sc >= 0 ? wv_ : 0.f; }
    asm volatile("s_waitcnt lgkmcnt(0)" ::: "memory");
    const int c = lane & 7;
#pragma unroll
    for (int j = 0; j < 4; ++j) { const int n = (lane >> 3) + 8 * j; const LAS float* s = scr + (8 * c) * 33 + n;
        uint4 o; o.x = pk2(s[0 * 33], s[1 * 33]); o.y = pk2(s[2 * 33], s[3 * 33]); o.z = pk2(s[4 * 33], s[5 * 33]); o.w = pk2(s[6 * 33], s[7 * 33]);
        *(uint4*)(WT + (size_t)(n0 + n) * K + k0 + 8 * c) = o; }
    asm volatile("s_waitcnt lgkmcnt(0)" ::: "memory");
}
constexpr size_t WO_IN = 0;
constexpr size_t WO_BR = WO_IN + (size_t)7168 * 1024;
constexpr size_t WO_OUT = WO_BR + (size_t)4 * 1024 * 256;
constexpr size_t WO_W1 = WO_OUT + (size_t)1024 * 1024;
constexpr size_t WO_W2 = WO_W1 + (size_t)4096 * 1024;
constexpr size_t WO_WUP = WO_W2 + (size_t)4096 * 1024;
constexpr size_t WO_AUP = WO_WUP + 256 * 64;
constexpr size_t WO_GUP = WO_AUP + 256 * 64;
constexpr size_t WO_GLU = WO_GUP + 256 * 128;
constexpr size_t WO_LWT = WO_GLU + 256 * 256;
constexpr size_t WO_S5B = WO_LWT + 2 * 16384;
constexpr size_t WO_S5C = WO_S5B + 16 * 8 * 64 * 8;
constexpr size_t WO_LAYER = WO_S5C + 16 * 4 * 64 * 8;
__device__ __forceinline__ void convert_weights(const Params& p, int l, LAS float* scr, int gw, int ngw, int lane) {
    bf16_t* WB = (bf16_t*)(p.ws() + WS_W);
    constexpr int I_IN = (1024 / 64) * (7168 / 32), I_BR = (256 / 64) * (1024 / 32), I_OUT = (1024 / 64) * (1024 / 32), I_W1 = (1024 / 64) * (4096 / 32), I_W2 = (4096 / 64) * (1024 / 32);
    constexpr int I_UP = 8, I_GUP = 16, I_GLU = 4 * 8, I_LW = 16, I_S5B = 128, I_S5C = 64;
    constexpr int PER_LAYER = I_IN + 4 * I_BR + I_OUT + I_W1 + I_W2 + 2 * I_UP + I_GUP + I_GLU + I_LW + I_S5B + I_S5C;
    for (int it = gw; it < PER_LAYER; it += ngw) {
        int r = it;
        bf16_t* WL = WB;
        if (r < I_IN) { transpose_item(p.in[2] + (size_t)l * D * DIN, 1024, DIN, WL + WO_IN, 7168 / 32, scr, r, lane, [](int j) { return j < NMIX ? j : (j < 3072 ? -1 : j - 248); }); continue; } r -= I_IN;
        if (r < 4 * I_BR) { const int i = r / I_BR; transpose_item(p.in[35] + ((size_t)l * 4 + i) * W * D, 256, D, WL + WO_BR + (size_t)i * 1024 * 256, 1024 / 32, scr, r % I_BR, lane, [](int j) { return j; }); continue; } r -= 4 * I_BR;
        if (r < I_OUT) { transpose_item(p.in[36] + (size_t)l * D * D, 1024, D, WL + WO_OUT, 1024 / 32, scr, r, lane, [](int j) { return j; }); continue; } r -= I_OUT;
        if (r < I_W1) { transpose_item(p.in[38] + (size_t)l * D * DFF, 1024, DFF, WL + WO_W1, 4096 / 32, scr, r, lane, [](int j) { return j; }); continue; } r -= I_W1;
        if (r < I_W2) { transpose_item(p.in[39] + (size_t)l * DFF * D, 4096, D, WL + WO_W2, 1024 / 32, scr, r, lane, [](int j) { return j; }); continue; } r -= I_W2;
        if (r < I_UP) { transpose_item(p.in[26] + (size_t)l * 64 * W, 64, W, WL + WO_WUP, 8, scr, r, lane, [](int j) { return j; }); continue; } r -= I_UP;
        if (r < I_UP) { transpose_item(p.in[28] + (size_t)l * 64 * W, 64, W, WL + WO_AUP, 8, scr, r, lane, [](int j) { return j; }); continue; } r -= I_UP;
        if (r < I_GUP) { transpose_item(p.in[29] + (size_t)l * 128 * W, 128, W, WL + WO_GUP, 8, scr, r, lane, [](int j) { return j; }); continue; } r -= I_GUP;
        if (r < I_GLU) { transpose_item(p.in[22] + (size_t)l * W * W, 256, W, WL + WO_GLU, 8, scr, r, lane, [](int j) { return j; }); continue; } r -= I_GLU;
        if (r < I_LW) { const int gt = r >> 3, nb = (r >> 1) & 3; transpose_item((gt ? p.in[11] : p.in[9]) + (size_t)l * 16384 + nb * 4096, 64, 64, WL + WO_LWT + (size_t)gt * 16384 + nb * 4096, 2, scr, r & 1, lane, [](int j) { return j; }); continue; } r -= I_LW;
        if (r < I_S5B) {
            const int g = r >> 3, tn = r & 7, q4 = lane >> 4, cc = lane & 15, n = 16 * tn + cc, pp = n >> 1, ri = n & 1;
            const float dt = __expf(p.in[21][l * 16 + g]);
            const float lre = p.in[14][l * 1024 + g * 64 + pp], lim = p.in[15][l * 1024 + g * 64 + pp];
            const float er = __expf(lre * dt), lbr = er * cosf(lim * dt), lbi = er * sinf(lim * dt);
            const float nr = lbr - 1.f, ni = lbi, den = lre * lre + lim * lim;
            const float fr = (nr * lre + ni * lim) / den, fi = (ni * lre - nr * lim) / den;
            float v[8];
#pragma unroll
            for (int j = 0; j < 8; ++j) { float x = 0.f;
                if (q4 < 2) { const float br = p.in[16][(size_t)l * 16384 + (g * 64 + pp) * 16 + 8 * q4 + j], bi = p.in[17][(size_t)l * 16384 + (g * 64 + pp) * 16 + 8 * q4 + j]; x = ri ? (fr * bi + fi * br) : (fr * br - fi * bi); }
                v[j] = x; }
            *(uint4*)(WL + WO_S5B + ((size_t)(g * 8 + tn) * 64 + lane) * 8) = make_uint4(pk2(v[0], v[1]), pk2(v[2], v[3]), pk2(v[4], v[5]), pk2(v[6], v[7]));
            continue; } r -= I_S5B;
        {
            const int g = r >> 2, ks = r & 3, q4 = lane >> 4, cc = lane & 15;
            const float* cre = p.in[18] + (size_t)l * 16384 + (g * 16 + cc) * 64 + 16 * ks + 4 * q4; const float* cim = p.in[19] + (size_t)l * 16384 + (g * 16 + cc) * 64 + 16 * ks + 4 * q4;
            *(uint4*)(WL + WO_S5C + ((size_t)(g * 4 + ks) * 64 + lane) * 8) = make_uint4(pk2(cre[0], -cim[0]), pk2(cre[1], -cim[1]), pk2(cre[2], -cim[2]), pk2(cre[3], -cim[3]));
        }
    }
}
#define BAR() do { asm volatile("s_waitcnt lgkmcnt(0)" ::: "memory"); __syncthreads(); } while (0)
typedef short bf16x8_t __attribute__((ext_vector_type(8)));
typedef float f32x4_t __attribute__((ext_vector_type(4)));
constexpr int PT = 68;
constexpr int MS = 64 * PT;
typedef __bf16 bf16x2v_t __attribute__((ext_vector_type(2)));
typedef float f32x2v_t __attribute__((ext_vector_type(2)));
__device__ __forceinline__ unsigned cvtpk(float lo, float hi) { return __builtin_bit_cast(unsigned, __builtin_convertvector((f32x2v_t){lo, hi}, bf16x2v_t)); }
typedef unsigned u32x4_t __attribute__((ext_vector_type(4)));
union U8 { bf16x8_t v; unsigned u[4]; uint4 q; u32x4_t x; };
__device__ __forceinline__ void split8(const float (&x)[8], bf16x8_t& hi, bf16x8_t& lo) {
    U8 H, L;
#pragma unroll
    for (int i = 0; i < 4; ++i) {
        const unsigned pk = cvtpk(x[2 * i], x[2 * i + 1]);
        H.u[i] = pk;
        const float f0 = __uint_as_float(pk << 16), f1 = __uint_as_float(pk & 0xffff0000u);
        L.u[i] = cvtpk(x[2 * i] - f0, x[2 * i + 1] - f1);
    }
    hi = H.v; lo = L.v;
}
__device__ __forceinline__ bf16x8_t hi8(const float (&x)[8]) {
    U8 H;
#pragma unroll
    for (int i = 0; i < 4; ++i) H.u[i] = cvtpk(x[2 * i], x[2 * i + 1]);
    return H.v;
}
template <int NSPLIT>
__device__ __forceinline__ f32x4_t mm_tile(const LAS float* A, const LAS float* Bt, int lane, f32x4_t acc) {
    const LAS float* ap = A + (lane & 15) * PT + 8 * (lane >> 4);
    const LAS float* bp = Bt + (lane & 15) * PT + 8 * (lane >> 4);
#pragma unroll
    for (int ks = 0; ks < 2; ++ks) {
        const f32x4_t a0 = *(const LAS f32x4_t*)(ap + 32 * ks), a1 = *(const LAS f32x4_t*)(ap + 32 * ks + 4);
        const f32x4_t b0 = *(const LAS f32x4_t*)(bp + 32 * ks), b1 = *(const LAS f32x4_t*)(bp + 32 * ks + 4);
        const float av[8] = {a0.x, a0.y, a0.z, a0.w, a1.x, a1.y, a1.z, a1.w};
        const float bv[8] = {b0.x, b0.y, b0.z, b0.w, b1.x, b1.y, b1.z, b1.w};
        if constexpr (NSPLIT == 3) {
            bf16x8_t ah, al, bh, bl; split8(av, ah, al); split8(bv, bh, bl);
            acc = __builtin_amdgcn_mfma_f32_16x16x32_bf16(ah, bh, acc, 0, 0, 0);
            acc = __builtin_amdgcn_mfma_f32_16x16x32_bf16(ah, bl, acc, 0, 0, 0);
            acc = __builtin_amdgcn_mfma_f32_16x16x32_bf16(al, bh, acc, 0, 0, 0);
        } else {
            acc = __builtin_amdgcn_mfma_f32_16x16x32_bf16(hi8(av), hi8(bv), acc, 0, 0, 0);
        }
    }
    return acc;
}
__device__ __forceinline__ int opq_tid() { int t = threadIdx.x; asm volatile("" : "+v"(t)); return t; }
__device__ __forceinline__ void tri_inverse_wave(LAS float* L, int lane) {
    asm volatile("" : "+v"(lane));
    asm volatile("" : "+v"(L));
    const float lf = (float)lane;
    float x[64];
#pragma unroll
    for (int i = 0; i < 64; ++i) {
        float s0 = 0.f, s1 = 0.f, s2 = 0.f, s3 = 0.f;
#pragma unroll
        for (int g4 = 0; g4 * 4 < i; ++g4) {
            const f32x4_t l = *(const LAS f32x4_t*)(L + i * PT + 4 * g4);
            s0 = fmaf(l.x, x[4 * g4], s0);
            if (4 * g4 + 1 < i) s1 = fmaf(l.y, x[4 * g4 + 1], s1);
            if (4 * g4 + 2 < i) s2 = fmaf(l.z, x[4 * g4 + 2], s2);
            if (4 * g4 + 3 < i) s3 = fmaf(l.w, x[4 * g4 + 3], s3);
        }
        x[i] = fmaxf(1.f - fabsf(lf - (float)i), 0.f) - ((s0 + s1) + (s2 + s3));
        L[i * PT + lane] = x[i];
        if ((i & 3) == 3) __builtin_amdgcn_sched_barrier(0);
    }
}
__device__ __forceinline__ float wave_incl_scan(float v, int lane) {
#pragma unroll
    for (int o = 1; o < 64; o <<= 1) { const float u = __shfl_up(v, o); if (lane >= o) v += u; }
    return v;
}

__device__ __forceinline__ void unpack8(const uint4 u, float (&o)[8]) {
    const unsigned w[4] = {u.x, u.y, u.z, u.w};
#pragma unroll
    for (int i = 0; i < 4; ++i) { o[2 * i] = __uint_as_float(w[i] << 16); o[2 * i + 1] = __uint_as_float(w[i] & 0xffff0000u); }
}
__device__ __forceinline__ uint4 pack8(const float (&x)[8]) { return make_uint4(cvtpk(x[0], x[1]), cvtpk(x[2], x[3]), cvtpk(x[4], x[5]), cvtpk(x[6], x[7])); }
typedef unsigned short LAS lds_bf16;
constexpr int MIX_LDS_C = 8 * MS * 4 + 1024;
__device__ __forceinline__ void merge_phase(const bf16_t* __restrict__ Yb, const bf16_t* __restrict__ WbT, const bf16_t* __restrict__ G, bf16_t* __restrict__ MG, LAS unsigned char* lds) {
    const int tid = opq_tid(), w = __builtin_amdgcn_readfirstlane(tid >> 6), lane = tid & 63, q4 = lane >> 4, cc = lane & 15;
    const int wr = w >> 2, wc = w & 3;
    constexpr int PA = 144;
    constexpr int ABUF = 128 * PA, BUF = 2 * ABUF;
    const int bid = blockIdx.x, G_ = gridDim.x;
    const int srow = tid >> 2, sk = (tid & 3) * 16;
#define MG_TILE(it_, pm_, pn_, ok_) do { const int U_ = (it_) * G_ + bid; ok_ = U_ < 1024; const int Lx_ = (G_ == 256) ? ((bid & 7) * 128 + (it_) * 32 + (bid >> 3)) : U_; pm_ = (Lx_ >> 3) & 127; pn_ = Lx_ & 7; } while (0)
    int pm, pn; bool ok; MG_TILE(0, pm, pn, ok);
    if (!ok) return;
    const bf16_t* Abase = Yb + (size_t)(pm * 128 + srow) * 1024 + sk;
    const bf16_t* Bbase = WbT + (size_t)(pn * 128 + srow) * 256 + sk;
    const bf16_t* gbase = G + (size_t)(pm * 128 + wr * 64 + cc) * 4096 + pn * 128 + wc * 32 + 4 * q4;
    uint4 r0[4], r1[4];
    uint2 gq[4][2];
#define MG_LOAD(R, ab_, bb_, s_) do { const bf16_t* ap_ = (ab_) + ((s_) >> 2) * 256 + ((s_) & 3) * 64; const bf16_t* bp_ = (bb_) + (size_t)((s_) >> 2) * 1024 * 256 + ((s_) & 3) * 64; \
            R[0] = *(const uint4*)ap_; R[1] = *(const uint4*)(ap_ + 8); R[2] = *(const uint4*)bp_; R[3] = *(const uint4*)(bp_ + 8); } while (0)
#define MG_GLOAD(GQ, gp_) do { _Pragma("unroll") for (int m = 0; m < 4; ++m) _Pragma("unroll") for (int n = 0; n < 2; ++n) GQ[m][n] = *(const uint2*)((gp_) + (size_t)m * 16 * 4096 + n * 16); } while (0)
#define MG_STORE(R, buf_) do { LAS unsigned char* ab_ = lds + (buf_) * BUF + srow * PA + sk * 2; \
            *(LAS u32x4_t*)ab_ = (u32x4_t){R[0].x, R[0].y, R[0].z, R[0].w}; *(LAS u32x4_t*)(ab_ + 16) = (u32x4_t){R[1].x, R[1].y, R[1].z, R[1].w}; \
            *(LAS u32x4_t*)(ab_ + ABUF) = (u32x4_t){R[2].x, R[2].y, R[2].z, R[2].w}; *(LAS u32x4_t*)(ab_ + ABUF + 16) = (u32x4_t){R[3].x, R[3].y, R[3].z, R[3].w}; } while (0)
#define MG_COMPUTE(buf_) do { const LAS unsigned char* ab_ = lds + (buf_) * BUF + (wr * 64 + cc) * PA + 16 * q4; const LAS unsigned char* bb_ = lds + (buf_) * BUF + ABUF + (wc * 32 + cc) * PA + 16 * q4; \
            _Pragma("unroll") for (int ks = 0; ks < 2; ++ks) { U8 bf_[2]; \
                _Pragma("unroll") for (int n = 0; n < 2; ++n) bf_[n].x = *(const LAS u32x4_t*)(bb_ + n * 16 * PA + ks * 64); \
                _Pragma("unroll") for (int m = 0; m < 4; ++m) { U8 af_; af_.x = *(const LAS u32x4_t*)(ab_ + m * 16 * PA + ks * 64); \
                    _Pragma("unroll") for (int n = 0; n < 2; ++n) acc[m][n] = __builtin_amdgcn_mfma_f32_16x16x32_bf16(bf_[n].v, af_.v, acc[m][n], 0, 0, 0); } } } while (0)
#define MG_STEP(j_, RL, RS) do { \
            if (((j_) & 3) == 0) { _Pragma("unroll") for (int m = 0; m < 4; ++m) _Pragma("unroll") for (int n = 0; n < 2; ++n) acc[m][n] = (f32x4_t){0.f, 0.f, 0.f, 0.f}; } \
            if ((j_) + 2 < 4) MG_LOAD(RL, Ae, Be, (j_) + 2); else if ((j_) + 2 < 8) MG_LOAD(RL, Ae + 256, Bo, (j_) + 2 - 4); else MG_LOAD(RL, An, Bn, (j_) + 2 - 8); \
            MG_COMPUTE((j_) & 1); \
            if (((j_) & 3) == 3) { \
                _Pragma("unroll") for (int m = 0; m < 4; ++m) _Pragma("unroll") for (int n = 0; n < 2; ++n) { uint2 g2_ = gq[m][n]; asm volatile("" : "+v"(g2_.x), "+v"(g2_.y));     \
                    mg[m][n][0] = fmaf(__uint_as_float(g2_.x << 16), acc[m][n][0], mg[m][n][0]); mg[m][n][1] = fmaf(__uint_as_float(g2_.x & 0xffff0000u), acc[m][n][1], mg[m][n][1]); \
                    mg[m][n][2] = fmaf(__uint_as_float(g2_.y << 16), acc[m][n][2], mg[m][n][2]); mg[m][n][3] = fmaf(__uint_as_float(g2_.y & 0xffff0000u), acc[m][n][3], mg[m][n][3]); } \
                if ((j_) == 3) MG_GLOAD(gq, ge + 1024); else MG_GLOAD(gq, gn); } \
            MG_STORE(RS, ((j_) + 1) & 1); \
            BAR(); } while (0)
    MG_LOAD(r0, Abase, Bbase, 0); MG_LOAD(r1, Abase, Bbase, 1); MG_GLOAD(gq, gbase);
    MG_STORE(r0, 0);
    BAR();
#pragma unroll 1
    for (int it = 0; ; ++it) {
        int npm, npn; bool has_next; MG_TILE(it + 1, npm, npn, has_next);
        if (!has_next) { npm = pm; npn = pn; }
        const bf16_t* nAbase = Yb + (size_t)(npm * 128 + srow) * 1024 + sk;
        const bf16_t* nBbase = WbT + (size_t)(npn * 128 + srow) * 256 + sk;
        const bf16_t* ngbase = G + (size_t)(npm * 128 + wr * 64 + cc) * 4096 + npn * 128 + wc * 32 + 4 * q4;
        f32x4_t mg[4][2], acc[4][2];
#pragma unroll
        for (int m = 0; m < 4; ++m)
#pragma unroll
            for (int n = 0; n < 2; ++n) { mg[m][n] = (f32x4_t){0.f, 0.f, 0.f, 0.f}; acc[m][n] = (f32x4_t){0.f, 0.f, 0.f, 0.f}; }
#pragma unroll 1
        for (int h = 0; h < 2; ++h) {
            const bf16_t* Ae = Abase + h * 512; const bf16_t* Be = Bbase + (size_t)h * 2 * 1024 * 256; const bf16_t* Bo = Be + 1024 * 256; const bf16_t* ge = gbase + h * 2048;
            const bf16_t* An = h ? nAbase : Abase + 512; const bf16_t* Bn = h ? nBbase : Bbase + (size_t)2 * 1024 * 256; const bf16_t* gn = h ? ngbase : gbase + 2048;
            MG_STEP(0, r0, r1); MG_STEP(1, r1, r0); MG_STEP(2, r0, r1); MG_STEP(3, r1, r0);
            MG_STEP(4, r0, r1); MG_STEP(5, r1, r0); MG_STEP(6, r0, r1); MG_STEP(7, r1, r0);
        }
        {
            bf16_t* op = MG + (size_t)(pm * 128 + wr * 64 + cc) * 1024 + pn * 128 + wc * 32 + 4 * q4;
#pragma unroll
            for (int m = 0; m < 4; ++m)
#pragma unroll
                for (int n = 0; n < 2; ++n) *(uint2*)(op + (size_t)m * 16 * 1024 + n * 16) = make_uint2(cvtpk(mg[m][n][0], mg[m][n][1]), cvtpk(mg[m][n][2], mg[m][n][3]));
        }
        if (!has_next) break;
        pm = npm; pn = npn; Abase = nAbase; Bbase = nBbase; gbase = ngbase;
    }
#undef MG_TILE
#undef MG_LOAD
#undef MG_GLOAD
#undef MG_STORE
#undef MG_COMPUTE
#undef MG_STEP
}

constexpr int PB = 72;
constexpr int PLBYTES = 64 * PB * 2;
typedef unsigned u32x2_t __attribute__((ext_vector_type(2)));
__device__ __forceinline__ lds_bf16* plane(LAS unsigned char* lds, int i) { return (lds_bf16*)(lds + i * PLBYTES); }
__device__ __forceinline__ void hilo2(float a, float b, unsigned& h, unsigned& l) { h = cvtpk(a, b); l = cvtpk(a - __uint_as_float(h << 16), b - __uint_as_float(h & 0xffff0000u)); }
__device__ __forceinline__ unsigned short bf_hi(float v) { return (unsigned short)(cvtpk(v, 0.f) & 0xffffu); }
template <bool LO>
__device__ __forceinline__ void put8(lds_bf16* Ph, lds_bf16* Pl, int r, int c0, const float (&x)[8]) {
    unsigned h[4], l[4];
#pragma unroll
    for (int i = 0; i < 4; ++i) hilo2(x[2 * i], x[2 * i + 1], h[i], l[i]);
    *(LAS u32x4_t*)(Ph + r * PB + c0) = (u32x4_t){h[0], h[1], h[2], h[3]};
    if (LO) *(LAS u32x4_t*)(Pl + r * PB + c0) = (u32x4_t){l[0], l[1], l[2], l[3]};
}
template <bool LO>
__device__ __forceinline__ void put8T(lds_bf16* Ph, lds_bf16* Pl, int r, int c0, const float (&x)[8]) {
#pragma unroll
    for (int i = 0; i < 4; ++i) {
        unsigned h, l; hilo2(x[2 * i], x[2 * i + 1], h, l);
        Ph[(c0 + 2 * i) * PB + r] = (unsigned short)(h & 0xffffu); Ph[(c0 + 2 * i + 1) * PB + r] = (unsigned short)(h >> 16);
        if (LO) { Pl[(c0 + 2 * i) * PB + r] = (unsigned short)(l & 0xffffu); Pl[(c0 + 2 * i + 1) * PB + r] = (unsigned short)(l >> 16); }
    }
}
__device__ __forceinline__ bf16x8_t frag(const lds_bf16* P, int row, int k) { U8 u; u.x = *(const LAS u32x4_t*)(P + row * PB + k); return u.v; }
template <bool AL, bool BL>
__device__ __forceinline__ f32x4_t mmp(const lds_bf16* Ah, const lds_bf16* Al, const lds_bf16* Bh, const lds_bf16* Bl, int ar0, int br0, int lane, f32x4_t acc) {
    const int r = lane & 15, k0 = 8 * (lane >> 4);
#pragma unroll
    for (int ks = 0; ks < 2; ++ks) {
        const bf16x8_t ah = frag(Ah, ar0 + r, 32 * ks + k0), bh = frag(Bh, br0 + r, 32 * ks + k0);
        acc = __builtin_amdgcn_mfma_f32_16x16x32_bf16(ah, bh, acc, 0, 0, 0);
        if (AL) acc = __builtin_amdgcn_mfma_f32_16x16x32_bf16(frag(Al, ar0 + r, 32 * ks + k0), bh, acc, 0, 0, 0);
        if (BL) acc = __builtin_amdgcn_mfma_f32_16x16x32_bf16(ah, frag(Bl, br0 + r, 32 * ks + k0), acc, 0, 0, 0);
    }
    return acc;
}
template <bool LO>
__device__ __forceinline__ void st_tile_T(lds_bf16* Ph, lds_bf16* Pl, int i0, int j0, int lane, const f32x4_t a) {
    unsigned h0, l0, h1, l1; hilo2(a[0], a[1], h0, l0); hilo2(a[2], a[3], h1, l1);
    const int o = (j0 + (lane & 15)) * PB + i0 + 4 * (lane >> 4);
    *(LAS u32x2_t*)(Ph + o) = (u32x2_t){h0, h1};
    if (LO) *(LAS u32x2_t*)(Pl + o) = (u32x2_t){l0, l1};
}
template <bool LO>
__device__ __forceinline__ void st_tile_R(lds_bf16* Ph, lds_bf16* Pl, int i0, int j0, int lane, const f32x4_t a) {
    unsigned h0, l0, h1, l1; hilo2(a[0], a[1], h0, l0); hilo2(a[2], a[3], h1, l1);
    const int o = (i0 + 4 * (lane >> 4)) * PB + j0 + (lane & 15);
    Ph[o] = (unsigned short)(h0 & 0xffffu); Ph[o + PB] = (unsigned short)(h0 >> 16); Ph[o + 2 * PB] = (unsigned short)(h1 & 0xffffu); Ph[o + 3 * PB] = (unsigned short)(h1 >> 16);
    if (LO) { Pl[o] = (unsigned short)(l0 & 0xffffu); Pl[o + PB] = (unsigned short)(l0 >> 16); Pl[o + 2 * PB] = (unsigned short)(l1 & 0xffffu); Pl[o + 3 * PB] = (unsigned short)(l1 >> 16); }
}
constexpr int LM_OFF = 13 * PLBYTES;
constexpr int VEC_OFF = LM_OFF + MS * 4;
static_assert(VEC_OFF + 1024 <= MIX_LDS_C, "plane LDS map");

struct GdnBufs { bf16_t *GQ, *GK, *GV; float *GB, *GC; uint4* MF; float* NF; float* HT; bf16_t* TG; };
__device__ __forceinline__ void gdn_prep_chunk(const bf16_t* __restrict__ PM, int n, const GdnBufs& B, const Params& p, int l, LAS float* lds) {
    const int tid = opq_tid(), w = tid >> 6, lane = tid & 63;
    const float* conv_w = p.in[3] + l * 4 * 768;
    const int t0 = n * 64;
    float wq[4][4], wk[4][4], wv[4][4];
#pragma unroll
    for (int t = 0; t < 4; ++t)
#pragma unroll
        for (int j = 0; j < 4; ++j) { wq[t][j] = conv_w[t * 768 + 4 * lane + j]; wk[t][j] = conv_w[t * 768 + 256 + 4 * lane + j]; wv[t][j] = conv_w[t * 768 + 512 + 4 * lane + j]; }
    float hq[3][4], hk[3][4], hv[3][4];
    auto ld4 = [&](int t, int col, float (&o)[4]) {
        uint2 u = *(const uint2*)(PM + (size_t)(t < 0 ? 0 : t) * PMLD + col);
        if (t < 0) u = make_uint2(0u, 0u);
        o[0] = __uint_as_float(u.x << 16); o[1] = __uint_as_float(u.x & 0xffff0000u); o[2] = __uint_as_float(u.y << 16); o[3] = __uint_as_float(u.y & 0xffff0000u);
    };
    const int tw = t0 + 8 * w;
#pragma unroll
    for (int i = 0; i < 3; ++i) { ld4(tw - 3 + i, 4 * lane, hq[i]); ld4(tw - 3 + i, 256 + 4 * lane, hk[i]); ld4(tw - 3 + i, 512 + 4 * lane, hv[i]); }
#pragma unroll
    for (int i = 0; i < 8; ++i) {
        const int t = tw + i;
        float pq[4], pk[4], pv[4], q[4], k[4], v[4];
        ld4(t, 4 * lane, pq); ld4(t, 256 + 4 * lane, pk); ld4(t, 512 + 4 * lane, pv);
        float sq = 0.f, sk = 0.f;
#pragma unroll
        for (int j = 0; j < 4; ++j) {
            q[j] = siluf_(wq[0][j] * hq[0][j] + wq[1][j] * hq[1][j] + wq[2][j] * hq[2][j] + wq[3][j] * pq[j]);
            k[j] = siluf_(wk[0][j] * hk[0][j] + wk[1][j] * hk[1][j] + wk[2][j] * hk[2][j] + wk[3][j] * pk[j]);
            v[j] = siluf_(wv[0][j] * hv[0][j] + wv[1][j] * hv[1][j] + wv[2][j] * hv[2][j] + wv[3][j] * pv[j]);
            hq[0][j] = hq[1][j]; hq[1][j] = hq[2][j]; hq[2][j] = pq[j];
            hk[0][j] = hk[1][j]; hk[1][j] = hk[2][j]; hk[2][j] = pk[j];
            hv[0][j] = hv[1][j]; hv[1][j] = hv[2][j]; hv[2][j] = pv[j];
            sq = fmaf(q[j], q[j], sq); sk = fmaf(k[j], k[j], sk);
        }
#pragma unroll
        for (int o = 1; o < 16; o <<= 1) { sq += __shfl_xor(sq, o); sk += __shfl_xor(sk, o); }
        const float rq = rsqrtf(sq + 1e-6f) * 0.125f, rk = rsqrtf(sk + 1e-6f);
        uint2 oq, ok, ov;
        oq.x = cvtpk(q[0] * rq, q[1] * rq); oq.y = cvtpk(q[2] * rq, q[3] * rq);
        ok.x = cvtpk(k[0] * rk, k[1] * rk); ok.y = cvtpk(k[2] * rk, k[3] * rk);
        ov.x = cvtpk(v[0], v[1]); ov.y = cvtpk(v[2], v[3]);
        *(uint2*)(B.GQ + (size_t)t * 256 + 4 * lane) = oq;
        *(uint2*)(B.GK + (size_t)t * 256 + 4 * lane) = ok;
        *(uint2*)(B.GV + (size_t)t * 256 + 4 * lane) = ov;
    }
    if (tid < 256) {
        const int t = tid >> 2, h = tid & 3;
        const bf16_t* row = PM + (size_t)(t0 + t) * PMLD;
        B.GB[(size_t)(t0 + t) * 4 + h] = sigmoidf_(bf2f(row[1024 + h]));
        const float* alog_ = p.in[4] + l * 4; const float* dtb_ = p.in[5] + l * 4;
        const float g = -__expf(alog_[h]) * softplusf_(bf2f(row[1028 + h]) + dtb_[h]);
        lds[h * 64 + t] = g;
    }
    BAR();
    if (w == 0) {
#pragma unroll
        for (int h = 0; h < 4; ++h) B.GC[(size_t)(t0 + lane) * 4 + h] = wave_incl_scan(lds[h * 64 + lane], lane);
    }
    BAR();
}

__device__ __forceinline__ float dpp_xor1(float v) { return __int_as_float(__builtin_amdgcn_update_dpp(0, __float_as_int(v), 0xB1, 0xF, 0xF, false)); }
__device__ __forceinline__ float dpp_xor2(float v) { return __int_as_float(__builtin_amdgcn_update_dpp(0, __float_as_int(v), 0x4E, 0xF, 0xF, false)); }
__device__ __forceinline__ void tri_inverse_4w(const LAS float* Lp, lds_bf16* Th, lds_bf16* Tl, int wq, int lane) {
    asm volatile("" : "+v"(lane));
    const int g = lane & 3, j = 16 * wq + (lane >> 2);
    const LAS float* base = Lp + g * 16; asm volatile("" : "+v"(base));
    const float jf = (float)j;
    float x[16];
#pragma unroll
    for (int m = 0; m < 16; ++m) x[m] = 0.f;
    f32x4_t cur[4], nxt[4];
#pragma unroll
    for (int q = 0; q < 4; ++q) cur[q] = (f32x4_t){0.f, 0.f, 0.f, 0.f};
#pragma unroll
    for (int i = 0; i < 64; ++i) {
        if (i + 1 < 64) {
#pragma unroll
            for (int q = 0; q < 4; ++q) if (16 * q < i + 1) nxt[q] = *(const LAS f32x4_t*)(base + (i + 1) * PT + 4 * q);
        }
        float s0 = 0.f, s1 = 0.f;
#pragma unroll
        for (int q = 0; q < 4; ++q) if (16 * q < i) {
            s0 = fmaf(cur[q].x, x[4 * q], s0); if (16 * q + 4 < i) s1 = fmaf(cur[q].y, x[4 * q + 1], s1);
            if (16 * q + 8 < i) s0 = fmaf(cur[q].z, x[4 * q + 2], s0); if (16 * q + 12 < i) s1 = fmaf(cur[q].w, x[4 * q + 3], s1);
        }
        float t = s0 + s1;
        t += dpp_xor1(t); t += dpp_xor2(t);
        const float xi = fmaxf(1.f - fabsf(jf - (float)i), 0.f) - t;
        if (g == (i & 3)) x[i >> 2] = xi;
        unsigned hh, ll; hilo2(xi, xi, hh, ll);
        if (g == 0) Th[i * PB + j] = (unsigned short)(hh & 0xffffu);
        if (g == 1) Tl[i * PB + j] = (unsigned short)(ll & 0xffffu);
#pragma unroll
        for (int q = 0; q < 4; ++q) cur[q] = nxt[q];
    }
}
__device__ __forceinline__ void gdn_g1_unit(int h, int n, const GdnBufs& B, bf16_t* __restrict__ Y, LAS unsigned char* lds) {
    const int tid = opq_tid(), w = tid >> 6, lane = tid & 63, q4 = lane >> 4, cc = lane & 15;
    lds_bf16 *Krh = plane(lds, 0), *Krl = plane(lds, 1), *KdTh = plane(lds, 2), *KdTl = plane(lds, 3), *KbTh = plane(lds, 4), *KbTl = plane(lds, 5);
    lds_bf16 *VbTh = plane(lds, 6), *VbTl = plane(lds, 7), *Th = plane(lds, 8), *Tl = plane(lds, 9), *WmTh = plane(lds, 10), *WmTl = plane(lds, 11);
    lds_bf16 *U0Th = Krh, *U0Tl = Krl;
    LAS float* Lm = (LAS float*)(lds + LM_OFF); LAS float* sb = (LAS float*)(lds + VEC_OFF); LAS float* sg = sb + 64;
    const int t0 = n * 64, u = h * 256 + n;
    const int c = tid >> 3, d0 = (tid & 7) * 8;
    {
        const float beta = B.GB[(size_t)(t0 + c) * 4 + h], gc = B.GC[(size_t)(t0 + c) * 4 + h], gl = B.GC[(size_t)(t0 + 63) * 4 + h];
        float kf[8], vf[8], x1[8], x2[8], x3[8];
        unpack8(*(const uint4*)(B.GK + (size_t)(t0 + c) * 256 + h * 64 + d0), kf);
        unpack8(*(const uint4*)(B.GV + (size_t)(t0 + c) * 256 + h * 64 + d0), vf);
        const float e1 = __expf(gl - gc), e2 = beta * __expf(gc);
#pragma unroll
        for (int i = 0; i < 8; ++i) { x1[i] = kf[i] * e1; x2[i] = kf[i] * e2; x3[i] = beta * vf[i]; }
        put8<true>(Krh, Krl, c, d0, kf); put8T<true>(KdTh, KdTl, c, d0, x1); put8T<true>(KbTh, KbTl, c, d0, x2); put8T<true>(VbTh, VbTl, c, d0, x3);
        if ((tid & 7) == 0) { sb[c] = beta; sg[c] = gc; }
    }
    BAR();
    const int ti = w >> 1, tj0 = (w & 1) * 2;
    const f32x4_t zero4 = {0.f, 0.f, 0.f, 0.f};
#pragma unroll
    for (int tt = 0; tt < 2; ++tt) {
        const int tj = tj0 + tt;
        const int j = 16 * tj + cc, jp = (j & 3) * 16 + (j >> 2);
        f32x4_t lv = zero4;
        if (tj <= ti) {
            const f32x4_t a = mmp<true, true>(Krh, Krl, Krh, Krl, 16 * ti, 16 * tj, lane, zero4);
            const float gj = sg[j];
#pragma unroll
            for (int r = 0; r < 4; ++r) { const int i = 16 * ti + 4 * q4 + r; lv[r] = (i > j) ? sb[i] * a[r] * __expf(sg[i] - gj) : 0.f; }
        }
#pragma unroll
        for (int r = 0; r < 4; ++r) Lm[(16 * ti + 4 * q4 + r) * PT + jp] = lv[r];
    }
    BAR();
    if (w < 4) tri_inverse_4w(Lm, Th, Tl, w, lane);
    BAR();
    { const u32x4_t t4 = *(const LAS u32x4_t*)(Th + c * PB + d0); *(uint4*)(B.TG + (size_t)u * 4096 + c * 64 + d0) = make_uint4(t4.x, t4.y, t4.z, t4.w);
      const u32x4_t t5 = *(const LAS u32x4_t*)(Tl + c * PB + d0); *(uint4*)(Y + (size_t)(t0 + c) * D + h * 64 + d0) = make_uint4(t5.x, t5.y, t5.z, t5.w); }
#pragma unroll
    for (int tt = 0; tt < 2; ++tt) {
        const int tj = tj0 + tt;
        st_tile_T<true>(U0Th, U0Tl, 16 * ti, 16 * tj, lane, mmp<true, true>(Th, Tl, VbTh, VbTl, 16 * ti, 16 * tj, lane, zero4));
        st_tile_T<true>(WmTh, WmTl, 16 * ti, 16 * tj, lane, mmp<true, true>(Th, Tl, KbTh, KbTl, 16 * ti, 16 * tj, lane, zero4));
    }
    BAR();
    {
        const float egl = __expf(B.GC[(size_t)(t0 + 63) * 4 + h]);
#pragma unroll
        for (int tt = 0; tt < 2; ++tt) {
            const int tj = tj0 + tt;
            const f32x4_t a = mmp<true, true>(KdTh, KdTl, WmTh, WmTl, 16 * ti, 16 * tj, lane, zero4);
#pragma unroll
            for (int r = 0; r < 4; ++r) { const int ar = 16 * ti + 4 * q4 + r, bc = 16 * tj + cc; Lm[ar * PT + bc] = (ar == bc ? egl : 0.f) - a[r]; }
            const f32x4_t nn = mmp<true, true>(KdTh, KdTl, U0Th, U0Tl, 16 * ti, 16 * tj, lane, zero4);
            *(float4*)(B.NF + (size_t)u * 4096 + (tj * 64 + lane) * 16 + ti * 4) = make_float4(nn[0], nn[1], nn[2], nn[3]);
        }
    }
    BAR();
    {
        const int combo = tid >> 6, mt = combo >> 1, s = combo & 1, i = lane & 15, qq = lane >> 4;
        const f32x4_t x0 = *(const LAS f32x4_t*)(Lm + (16 * mt + i) * PT + 32 * s + 4 * qq);
        const f32x4_t x1 = *(const LAS f32x4_t*)(Lm + (16 * mt + i) * PT + 32 * s + 16 + 4 * qq);
        const float xv[8] = {x0.x, x0.y, x0.z, x0.w, x1.x, x1.y, x1.z, x1.w};
        U8 H, L; split8(xv, H.v, L.v);
        uint4* mf = B.MF + (size_t)u * 1024 + (size_t)(combo * 2) * 64 + lane;
        mf[0] = H.q; mf[64] = L.q;
    }
    BAR();
}

constexpr int CH_SLOT = 20480, CH_RING = 6;
__device__ __forceinline__ void chain_wave(float* __restrict__ HT, int cb, int nchunk, int lane, LAS unsigned char* ring, volatile LAS unsigned* flags  ) {
    const int q4 = lane >> 4, cc = lane & 15;
    f32x4_t H[4];
#pragma unroll
    for (int m = 0; m < 4; ++m) H[m] = (f32x4_t){0.f, 0.f, 0.f, 0.f};
    U8 mf[16]; f32x4_t nf[4];
    {
        while (flags[0] != 1u) __builtin_amdgcn_s_sleep(1);
        asm volatile("" ::: "memory");
        const LAS unsigned char* sp = ring + lane * 16;
#pragma unroll
        for (int i = 0; i < 16; ++i) mf[i].x = *(const LAS u32x4_t*)(sp + i * 1024);
#pragma unroll
        for (int m = 0; m < 4; ++m) nf[m] = *(const LAS f32x4_t*)(sp + (16 + m) * 1024);
        asm volatile("s_waitcnt lgkmcnt(0)" ::: "memory");
        if (lane == 0) flags[8] = 1u;
    }
    for (int ch = 0; ch < nchunk; ++ch) {
        float* ht = HT + (size_t)ch * 4096 + (16 * cb + cc) * 64 + 4 * q4;
#pragma unroll
        for (int m = 0; m < 4; ++m) *(float4*)(ht + 16 * m) = make_float4(H[m][0], H[m][1], H[m][2], H[m][3]);
        bf16x8_t bh[2], bl[2];
#pragma unroll
        for (int s = 0; s < 2; ++s) {
            const float xv[8] = {H[2 * s][0], H[2 * s][1], H[2 * s][2], H[2 * s][3], H[2 * s + 1][0], H[2 * s + 1][1], H[2 * s + 1][2], H[2 * s + 1][3]};
            split8(xv, bh[s], bl[s]);
        }
#pragma unroll
        for (int m = 0; m < 4; ++m) {
            f32x4_t acc = nf[m];
#pragma unroll
            for (int s = 0; s < 2; ++s) {
                acc = __builtin_amdgcn_mfma_f32_16x16x32_bf16(mf[(m * 2 + s) * 2].v, bh[s], acc, 0, 0, 0);
                acc = __builtin_amdgcn_mfma_f32_16x16x32_bf16(mf[(m * 2 + s) * 2].v, bl[s], acc, 0, 0, 0);
                acc = __builtin_amdgcn_mfma_f32_16x16x32_bf16(mf[(m * 2 + s) * 2 + 1].v, bh[s], acc, 0, 0, 0);
            }
            H[m] = acc;
        }
        if (ch + 1 < nchunk) {
            const int slot = (ch + 1) % CH_RING;
            while (flags[slot] != (unsigned)(ch + 2)) __builtin_amdgcn_s_sleep(1);
            asm volatile("" ::: "memory");
            const LAS unsigned char* sp = ring + slot * CH_SLOT + lane * 16;
#pragma unroll
            for (int i = 0; i < 16; ++i) mf[i].x = *(const LAS u32x4_t*)(sp + i * 1024);
#pragma unroll
            for (int m = 0; m < 4; ++m) nf[m] = *(const LAS f32x4_t*)(sp + (16 + m) * 1024);
            asm volatile("s_waitcnt lgkmcnt(0)" ::: "memory");
            if (lane == 0) flags[8] = (unsigned)(ch + 2);
        }
    }
}
__device__ __forceinline__ void chain_loader(const uint4* __restrict__ MF, const float* __restrict__ NF, int cb, int nchunk, int lane, int lw, LAS unsigned char* ring, volatile LAS unsigned* flags) {
    for (int ch = lw; ch < nchunk; ch += 7) {
        uint4 m[16]; float4 nn[4];
#pragma unroll
        for (int i = 0; i < 16; ++i) m[i] = MF[(size_t)ch * 1024 + (size_t)i * 64 + lane];
#pragma unroll
        for (int k = 0; k < 4; ++k) nn[k] = *(const float4*)(NF + (size_t)ch * 4096 + (cb * 64 + lane) * 16 + k * 4);
        while ((int)flags[8] + CH_RING <= ch) __builtin_amdgcn_s_sleep(2);
        asm volatile("" ::: "memory");
        LAS unsigned char* sp = ring + (ch % CH_RING) * CH_SLOT + lane * 16;
#pragma unroll
        for (int i = 0; i < 16; ++i) *(LAS u32x4_t*)(sp + i * 1024) = (u32x4_t){m[i].x, m[i].y, m[i].z, m[i].w};
#pragma unroll
        for (int k = 0; k < 4; ++k) *(LAS f32x4_t*)(sp + (16 + k) * 1024) = (f32x4_t){nn[k].x, nn[k].y, nn[k].z, nn[k].w};
        asm volatile("s_waitcnt lgkmcnt(0)" ::: "memory");
        if (lane == 0) flags[ch % CH_RING] = (unsigned)(ch + 1);
    }
}

__device__ __forceinline__ void gdn_g3_unit(int h, int n, const GdnBufs& B, const bf16_t* __restrict__ PM, bf16_t* __restrict__ Y, const float* __restrict__ norm_g, LAS unsigned char* lds) {
    const int tid = opq_tid(), w = tid >> 6, lane = tid & 63, q4 = lane >> 4, cc = lane & 15;
    lds_bf16 *Qr = plane(lds, 0), *Qd = plane(lds, 1), *Kr = plane(lds, 2), *KbT = plane(lds, 3), *VbT = plane(lds, 4), *Tp = plane(lds, 5);
    lds_bf16 *At = plane(lds, 6), *Wm = plane(lds, 7), *HTh = plane(lds, 8), *HTl = plane(lds, 9), *VnT = plane(lds, 10), *Tq = plane(lds, 11);
    LAS float* Os = (LAS float*)(lds + LM_OFF); LAS float* sb = (LAS float*)(lds + VEC_OFF); LAS float* sg = sb + 64;
    const int t0 = n * 64, u = h * 256 + n;
    const int c = tid >> 3, d0 = (tid & 7) * 8;
    {
        const float beta = B.GB[(size_t)(t0 + c) * 4 + h], gc = B.GC[(size_t)(t0 + c) * 4 + h];
        float qf[8], kf[8], vf[8], x1[8], x2[8], x3[8];
        unpack8(*(const uint4*)(B.GQ + (size_t)(t0 + c) * 256 + h * 64 + d0), qf);
        unpack8(*(const uint4*)(B.GK + (size_t)(t0 + c) * 256 + h * 64 + d0), kf);
        unpack8(*(const uint4*)(B.GV + (size_t)(t0 + c) * 256 + h * 64 + d0), vf);
        const uint4 t8 = *(const uint4*)(B.TG + (size_t)u * 4096 + c * 64 + d0);
        const uint4 t9 = *(const uint4*)(Y + (size_t)(t0 + c) * D + h * 64 + d0);
        const float* ht = B.HT + (size_t)u * 4096 + c * 64 + d0;
        const float4 h0 = *(const float4*)ht, h1 = *(const float4*)(ht + 4);
        const float eg = __expf(gc), e2 = beta * eg;
#pragma unroll
        for (int i = 0; i < 8; ++i) { x1[i] = qf[i] * eg; x2[i] = kf[i] * e2; x3[i] = beta * vf[i]; }
        put8<false>(Qr, Qr, c, d0, qf); put8<false>(Qd, Qd, c, d0, x1); put8<false>(Kr, Kr, c, d0, kf);
        put8T<false>(KbT, KbT, c, d0, x2); put8T<false>(VbT, VbT, c, d0, x3);
        *(LAS u32x4_t*)(Tp + c * PB + d0) = (u32x4_t){t8.x, t8.y, t8.z, t8.w};
        *(LAS u32x4_t*)(Tq + c * PB + d0) = (u32x4_t){t9.x, t9.y, t9.z, t9.w};
        const float hv[8] = {h0.x, h0.y, h0.z, h0.w, h1.x, h1.y, h1.z, h1.w};
        put8<true>(HTh, HTl, c, d0, hv);
        if ((tid & 7) == 0) { sb[c] = beta; sg[c] = gc; }
    }
    BAR();
    const int ti = w >> 1, tj0 = (w & 1) * 2;
    const f32x4_t zero4 = {0.f, 0.f, 0.f, 0.f};
    f32x4_t u0[2];
#pragma unroll
    for (int tt = 0; tt < 2; ++tt) {
        const int tj = tj0 + tt;
        f32x4_t at = zero4;
        if (tj <= ti) {
            const f32x4_t s = mmp<false, false>(Qr, Qr, Kr, Kr, 16 * ti, 16 * tj, lane, zero4);
            const int j = 16 * tj + cc; const float gj = sg[j];
#pragma unroll
            for (int r = 0; r < 4; ++r) { const int i = 16 * ti + 4 * q4 + r; at[r] = (i >= j) ? s[r] * __expf(fminf(sg[i] - gj, 0.f)) : 0.f; }
        }
        st_tile_R<false>(At, At, 16 * ti, 16 * tj, lane, at);
        u0[tt] = mmp<true, false>(Tp, Tq, VbT, VbT, 16 * ti, 16 * tj, lane, zero4);
        st_tile_R<false>(Wm, Wm, 16 * ti, 16 * tj, lane, mmp<true, false>(Tp, Tq, KbT, KbT, 16 * ti, 16 * tj, lane, zero4));
    }
    BAR();
    f32x4_t o[2];
#pragma unroll
    for (int tt = 0; tt < 2; ++tt) {
        const int tj = tj0 + tt;
        const f32x4_t wh = mmp<false, true>(Wm, Wm, HTh, HTl, 16 * ti, 16 * tj, lane, zero4);
        o[tt] = mmp<false, true>(Qd, Qd, HTh, HTl, 16 * ti, 16 * tj, lane, zero4);
        st_tile_T<false>(VnT, VnT, 16 * ti, 16 * tj, lane, u0[tt] - wh);
    }
    BAR();
#pragma unroll
    for (int tt = 0; tt < 2; ++tt) {
        const int tj = tj0 + tt;
        o[tt] = mmp<false, false>(At, At, VnT, VnT, 16 * ti, 16 * tj, lane, o[tt]);
#pragma unroll
        for (int r = 0; r < 4; ++r) Os[(16 * ti + 4 * q4 + r) * PT + 16 * tj + cc] = o[tt][r];
    }
    BAR();
    {
        const f32x4_t x0 = *(const LAS f32x4_t*)(Os + c * PT + d0), x1 = *(const LAS f32x4_t*)(Os + c * PT + d0 + 4);
        float xv[8] = {x0.x, x0.y, x0.z, x0.w, x1.x, x1.y, x1.z, x1.w};
        float ss = 0.f;
#pragma unroll
        for (int i = 0; i < 8; ++i) ss = fmaf(xv[i], xv[i], ss);
        ss += __shfl_xor(ss, 1); ss += __shfl_xor(ss, 2); ss += __shfl_xor(ss, 4);
        const float rs = rsqrtf(ss * (1.f / 64.f) + 1e-6f);
        float zf[8]; unpack8(*(const uint4*)(PM + (size_t)(t0 + c) * PMLD + 768 + h * 64 + d0), zf);
        float y[8];
#pragma unroll
        for (int i = 0; i < 8; ++i) y[i] = xv[i] * rs * norm_g[d0 + i] * siluf_(zf[i]);
        *(uint4*)(Y + (size_t)(t0 + c) * D + h * 64 + d0) = pack8(y);
    }
    BAR();
}

struct RwkvBufs { bf16_t *RR, *RK, *RV, *RKK, *RA, *RG; float* CW; uint4* MF; float* NF; float* HT; bf16_t* TG; };
__device__ __forceinline__ void rwkv_prep_chunk(const bf16_t* __restrict__ PM, int n, const RwkvBufs& B, const Params& p, int l, const bf16_t* __restrict__ WUPT, const bf16_t* __restrict__ AUPT, const bf16_t* __restrict__ GUPT, LAS unsigned char* lds) {
    const int tid = opq_tid(), w = tid >> 6, lane = tid & 63, q4 = lane >> 4, cc = lane & 15;
    const int t0 = n * 64;
    const float* mu = p.in[24] + l * 1024;
    lds_bf16* Awd = (lds_bf16*)lds; lds_bf16* Aad = Awd + 64 * 72; lds_bf16* Agd = Aad + 64 * 72;
    lds_bf16* La = Agd + 64 * 136; lds_bf16* Lg = La + 64 * 264; lds_bf16* Llw = Lg + 64 * 264;
    for (int px1_ = 0; px1_ < ((PEXP == 1) ? 2 : 1); ++px1_)
    {
        const int t = tid >> 3, c0 = (tid & 7) * 8;
        const bf16_t* row = PM + (size_t)(t0 + t) * PMLD + C_RWKV + 768 + c0;
        const bool hasprev = (t0 + t) > 0;
#pragma unroll
        for (int g8 = 0; g8 < 4; ++g8) {
            float x[8], xp[8];
            unpack8(*(const uint4*)(row + 64 * g8), x);
            unpack8(*(const uint4*)(row - (hasprev ? PMLD : 0) + 64 * g8), xp);
            if (!hasprev) {
#pragma unroll
                for (int i = 0; i < 8; ++i) xp[i] = 0.f; }
            const int col = c0 + 64 * g8;
            float y[8];
#pragma unroll
            for (int i = 0; i < 8; ++i) {
                const float v = x[i] + mu[768 + col + i] * (xp[i] - x[i]);
                y[i] = col < 64 ? tanhf_(v) : (col < 128 ? v : sigmoidf_(v));
            }
            const uint4 pk = pack8(y);
            if (col < 64) *(LAS u32x4_t*)(Awd + t * 72 + col) = (u32x4_t){pk.x, pk.y, pk.z, pk.w};
            else if (col < 128) *(LAS u32x4_t*)(Aad + t * 72 + (col - 64)) = (u32x4_t){pk.x, pk.y, pk.z, pk.w};
            else *(LAS u32x4_t*)(Agd + t * 136 + (col - 128)) = (u32x4_t){pk.x, pk.y, pk.z, pk.w};
        }
    }
    BAR();
    const int hh = w >> 1, tt0 = 2 * (w & 1);
    for (int px2_ = 0; px2_ < ((PEXP == 2) ? 2 : 1); ++px2_)
    {
        const float* w0 = p.in[25] + l * W; const float* a0 = p.in[27] + l * W;
#pragma unroll 2
        for (int b = 0; b < 4; ++b) {
            const int ncol = 64 * hh + 16 * b + cc;
            f32x4_t accw[2], acca[2], accg[2];
#pragma unroll
            for (int a = 0; a < 2; ++a) { accw[a] = (f32x4_t){0.f, 0.f, 0.f, 0.f}; acca[a] = accw[a]; accg[a] = accw[a]; }
            U8 bg[4], bw[2], ba[2];
#pragma unroll
            for (int ks = 0; ks < 4; ++ks) bg[ks].q = *(const uint4*)(GUPT + (size_t)ncol * 128 + 32 * ks + 8 * q4);
#pragma unroll
            for (int ks = 0; ks < 2; ++ks) { bw[ks].q = *(const uint4*)(WUPT + (size_t)ncol * 64 + 32 * ks + 8 * q4); ba[ks].q = *(const uint4*)(AUPT + (size_t)ncol * 64 + 32 * ks + 8 * q4); }
            const float w0n = w0[ncol], a0n = a0[ncol];
#pragma unroll
            for (int ks = 0; ks < 4; ++ks) {
#pragma unroll
                for (int a = 0; a < 2; ++a) {
                    const int row = 16 * (tt0 + a) + cc;
                    U8 ag; ag.x = *(const LAS u32x4_t*)(Agd + row * 136 + 32 * ks + 8 * q4);
                    accg[a] = __builtin_amdgcn_mfma_f32_16x16x32_bf16(ag.v, bg[ks].v, accg[a], 0, 0, 0);
                    if (ks < 2) {
                        U8 aw, aa; aw.x = *(const LAS u32x4_t*)(Awd + row * 72 + 32 * ks + 8 * q4); aa.x = *(const LAS u32x4_t*)(Aad + row * 72 + 32 * ks + 8 * q4);
                        accw[a] = __builtin_amdgcn_mfma_f32_16x16x32_bf16(aw.v, bw[ks].v, accw[a], 0, 0, 0);
                        acca[a] = __builtin_amdgcn_mfma_f32_16x16x32_bf16(aa.v, ba[ks].v, acca[a], 0, 0, 0);
                    }
                }
            }
#pragma unroll
            for (int a = 0; a < 2; ++a)
#pragma unroll
                for (int r = 0; r < 4; ++r) {
                    const int t = 16 * (tt0 + a) + 4 * q4 + r;
                    const float logw = -softplusf_(-(w0n + accw[a][r])) - 0.5f;
                    Llw[t * 264 + ncol] = (unsigned short)f2bf(-__expf(logw));
                    La[t * 264 + ncol] = (unsigned short)f2bf(sigmoidf_(a0n + acca[a][r]));
                    Lg[t * 264 + ncol] = (unsigned short)f2bf(accg[a][r]);
                }
        }
    }
    BAR();
    {
        const int t = tid >> 3, j8 = (tid & 7) * 8;
        const bf16_t* row = PM + (size_t)(t0 + t) * PMLD + C_RWKV;
        const bool hasprev = (t0 + t) > 0;
        const float* k_k = p.in[30] + l * W; const float* k_a = p.in[31] + l * W;
#pragma unroll 2
        for (int hd = 0; hd < 4; ++hd) {
            const int nn = 64 * hd + j8;
            float xr[8], xk[8], xv[8], pr[8], pk[8], pv[8], av[8];
            unpack8(*(const uint4*)(row + nn), xr); unpack8(*(const uint4*)(row + 256 + nn), xk); unpack8(*(const uint4*)(row + 512 + nn), xv);
            { const bf16_t* prow = row - (hasprev ? PMLD : 0);
              unpack8(*(const uint4*)(prow + nn), pr); unpack8(*(const uint4*)(prow + 256 + nn), pk); unpack8(*(const uint4*)(prow + 512 + nn), pv); }
            if (!hasprev) {
#pragma unroll
                for (int i = 0; i < 8; ++i) { pr[i] = 0.f; pk[i] = 0.f; pv[i] = 0.f; } }
            { const u32x4_t t4 = *(const LAS u32x4_t*)(La + t * 264 + nn); unpack8(make_uint4(t4.x, t4.y, t4.z, t4.w), av); }
            float orr[8], okk[8], ovv[8], kraw[8];
            float ss = 0.f;
#pragma unroll
            for (int i = 0; i < 8; ++i) {
                const float r = xr[i] + mu[nn + i] * (pr[i] - xr[i]);
                const float k = xk[i] + mu[256 + nn + i] * (pk[i] - xk[i]);
                const float v = xv[i] + mu[512 + nn + i] * (pv[i] - xv[i]);
                orr[i] = r; ovv[i] = v; okk[i] = k * (1.f + (av[i] - 1.f) * k_a[nn + i]);
                kraw[i] = k * k_k[nn + i]; ss = fmaf(kraw[i], kraw[i], ss);
            }
            ss += __shfl_xor(ss, 1); ss += __shfl_xor(ss, 2); ss += __shfl_xor(ss, 4);
            const float rn = rsqrtf(ss + 1e-6f);
#pragma unroll
            for (int i = 0; i < 8; ++i) kraw[i] *= rn;
            const size_t o = (size_t)(t0 + t) * 256 + nn;
            *(uint4*)(B.RR + o) = pack8(orr); *(uint4*)(B.RK + o) = pack8(okk); *(uint4*)(B.RV + o) = pack8(ovv); *(uint4*)(B.RKK + o) = pack8(kraw);
            { const u32x4_t t4 = *(const LAS u32x4_t*)(La + t * 264 + nn); *(uint4*)(B.RA + o) = make_uint4(t4.x, t4.y, t4.z, t4.w); }
            { const u32x4_t t4 = *(const LAS u32x4_t*)(Lg + t * 264 + nn); *(uint4*)(B.RG + o) = make_uint4(t4.x, t4.y, t4.z, t4.w); }
        }
    }
    for (int px4_ = 0; px4_ < ((PEXP == 4) ? 2 : 1); ++px4_)
    if (tid < 256) {
        float c = 0.f;
#pragma unroll 16
        for (int t = 0; t < 64; ++t) { c += bf2f(Llw[t * 264 + tid]); B.CW[(size_t)(t0 + t) * 256 + tid] = c; }
    }
    BAR();
}

struct RwPiece { float kk[8], al[8], kt[8], v[8], cw[8], cwp[8], cwc[8]; };
__device__ __forceinline__ void rwkv_load_piece(const RwkvBufs& B, int h, int t0, int c, int d0, RwPiece& P) {
    const size_t o = (size_t)(t0 + c) * 256 + h * 64 + d0;
    float a[8];
    unpack8(*(const uint4*)(B.RKK + o), P.kk); unpack8(*(const uint4*)(B.RA + o), a); unpack8(*(const uint4*)(B.RK + o), P.kt); unpack8(*(const uint4*)(B.RV + o), P.v);
    const float4 c0 = *(const float4*)(B.CW + o), c1 = *(const float4*)(B.CW + o + 4);
    P.cw[0] = c0.x; P.cw[1] = c0.y; P.cw[2] = c0.z; P.cw[3] = c0.w; P.cw[4] = c1.x; P.cw[5] = c1.y; P.cw[6] = c1.z; P.cw[7] = c1.w;
    { const size_t op = c > 0 ? o - 256 : o;
      const float4 p0 = *(const float4*)(B.CW + op), p1 = *(const float4*)(B.CW + op + 4);
      P.cwp[0] = p0.x; P.cwp[1] = p0.y; P.cwp[2] = p0.z; P.cwp[3] = p0.w; P.cwp[4] = p1.x; P.cwp[5] = p1.y; P.cwp[6] = p1.z; P.cwp[7] = p1.w;
      if (c == 0) {
#pragma unroll
        for (int i = 0; i < 8; ++i) P.cwp[i] = 0.f; } }
    const size_t oc = (size_t)(t0 + 63) * 256 + h * 64 + d0;
    const float4 e0 = *(const float4*)(B.CW + oc), e1 = *(const float4*)(B.CW + oc + 4);
    P.cwc[0] = e0.x; P.cwc[1] = e0.y; P.cwc[2] = e0.z; P.cwc[3] = e0.w; P.cwc[4] = e1.x; P.cwc[5] = e1.y; P.cwc[6] = e1.z; P.cwc[7] = e1.w;
#pragma unroll
    for (int i = 0; i < 8; ++i) P.al[i] = a[i] * P.kk[i];
}

__device__ __forceinline__ void rwkv_g1_unit(int h, int n, const RwkvBufs& B, bf16_t* __restrict__ Y, LAS unsigned char* lds) {
    const int tid = opq_tid(), w = tid >> 6, lane = tid & 63, q4 = lane >> 4, cc = lane & 15;
    lds_bf16 *P0h = plane(lds, 0), *P0l = plane(lds, 1), *P1h = plane(lds, 2), *P1l = plane(lds, 3), *P2h = plane(lds, 4), *P2l = plane(lds, 5);
    lds_bf16 *Lkh = plane(lds, 6), *Lkl = plane(lds, 7), *P3h = plane(lds, 8), *P3l = plane(lds, 9), *Th = plane(lds, 10), *Tl = plane(lds, 11);
    LAS float* Lm = (LAS float*)(lds + LM_OFF);
    const int t0 = n * 64, u = (4 + h) * 256 + n;
    const int c = tid >> 3, d0 = (tid & 7) * 8;
    RwPiece P; rwkv_load_piece(B, h, t0, c, d0, P);
    {
        float x0[8], x1[8], x2[8];
#pragma unroll
        for (int i = 0; i < 8; ++i) { const float em = __expf(-P.cw[i]); x0[i] = P.kk[i] * __expf(P.cwp[i]); x1[i] = P.al[i] * em; x2[i] = P.kt[i] * em; }
        put8<true>(P0h, P0l, c, d0, x0); put8<true>(P1h, P1l, c, d0, x1); put8<true>(P2h, P2l, c, d0, x2);
    }
    BAR();
    const int ti = w >> 1, tj0 = (w & 1) * 2;
    const f32x4_t zero4 = {0.f, 0.f, 0.f, 0.f};
#pragma unroll
    for (int tt = 0; tt < 2; ++tt) {
        const int tj = tj0 + tt;
        f32x4_t lk = zero4, la = zero4;
        const int j = 16 * tj + cc, jp = (j & 3) * 16 + (j >> 2);
        if (tj <= ti) {
            const f32x4_t a = mmp<true, true>(P0h, P0l, P1h, P1l, 16 * ti, 16 * tj, lane, zero4);
            const f32x4_t b = mmp<true, true>(P0h, P0l, P2h, P2l, 16 * ti, 16 * tj, lane, zero4);
#pragma unroll
            for (int r = 0; r < 4; ++r) { const int i = 16 * ti + 4 * q4 + r; la[r] = (i > j) ? a[r] : 0.f; lk[r] = (i > j) ? b[r] : 0.f; }
        }
#pragma unroll
        for (int r = 0; r < 4; ++r) Lm[(16 * ti + 4 * q4 + r) * PT + jp] = la[r];
        st_tile_R<true>(Lkh, Lkl, 16 * ti, 16 * tj, lane, lk);
    }
    BAR();
    {
        float x0[8], x1[8], x2[8];
#pragma unroll
        for (int i = 0; i < 8; ++i) { const float eb = __expf(P.cwc[i] - P.cw[i]); x0[i] = P.kk[i] * __expf(P.cwp[i]); x1[i] = P.al[i] * eb; x2[i] = P.kt[i] * eb; }
        put8T<true>(P0h, P0l, c, d0, P.v); put8T<true>(P1h, P1l, c, d0, x0); put8T<true>(P2h, P2l, c, d0, x1); put8T<true>(P3h, P3l, c, d0, x2);
    }
    if (w < 4) tri_inverse_4w(Lm, Th, Tl, w, lane);
    BAR();
    { const u32x4_t t4 = *(const LAS u32x4_t*)(Th + c * PB + d0); *(uint4*)(B.TG + (size_t)u * 4096 + c * 64 + d0) = make_uint4(t4.x, t4.y, t4.z, t4.w);
      const u32x4_t t5 = *(const LAS u32x4_t*)(Tl + c * PB + d0); *(uint4*)(Y + (size_t)(t0 + c) * D + 768 + h * 64 + d0) = make_uint4(t5.x, t5.y, t5.z, t5.w); }
    f32x4_t pa[2];
#pragma unroll
    for (int tt = 0; tt < 2; ++tt) pa[tt] = mmp<true, true>(Lkh, Lkl, P0h, P0l, 16 * ti, 16 * (tj0 + tt), lane, zero4);
    BAR();
#pragma unroll
    for (int tt = 0; tt < 2; ++tt) st_tile_T<true>(Lkh, Lkl, 16 * ti, 16 * (tj0 + tt), lane, pa[tt]);
    BAR();
    f32x4_t ua[2], wa[2];
#pragma unroll
    for (int tt = 0; tt < 2; ++tt) {
        ua[tt] = mmp<true, true>(Th, Tl, Lkh, Lkl, 16 * ti, 16 * (tj0 + tt), lane, zero4);
        wa[tt] = mmp<true, true>(Th, Tl, P1h, P1l, 16 * ti, 16 * (tj0 + tt), lane, zero4);
    }
    BAR();
#pragma unroll
    for (int tt = 0; tt < 2; ++tt) {
        st_tile_T<true>(Lkh, Lkl, 16 * ti, 16 * (tj0 + tt), lane, -ua[tt]);
        st_tile_T<true>(P1h, P1l, 16 * ti, 16 * (tj0 + tt), lane, wa[tt]);
    }
    BAR();
    {
#pragma unroll
        for (int tt = 0; tt < 2; ++tt) {
            const int tj = tj0 + tt;
            const f32x4_t a = mmp<true, true>(P2h, P2l, P1h, P1l, 16 * ti, 16 * tj, lane, zero4);
            const float gam = __expf(B.CW[(size_t)(t0 + 63) * 256 + h * 64 + 16 * tj + cc]);
#pragma unroll
            for (int r = 0; r < 4; ++r) { const int ar = 16 * ti + 4 * q4 + r, bc = 16 * tj + cc; Lm[ar * PT + bc] = (ar == bc ? gam : 0.f) - a[r]; }
            f32x4_t nn = mmp<true, true>(P2h, P2l, Lkh, Lkl, 16 * ti, 16 * tj, lane, zero4);
            nn = mmp<true, true>(P3h, P3l, P0h, P0l, 16 * ti, 16 * tj, lane, nn);
            *(float4*)(B.NF + (size_t)u * 4096 + (tj * 64 + lane) * 16 + ti * 4) = make_float4(nn[0], nn[1], nn[2], nn[3]);
        }
    }
    BAR();
    {
        const int combo = tid >> 6, mt = combo >> 1, s = combo & 1, i = lane & 15, qq = lane >> 4;
        const f32x4_t x0 = *(const LAS f32x4_t*)(Lm + (16 * mt + i) * PT + 32 * s + 4 * qq);
        const f32x4_t x1 = *(const LAS f32x4_t*)(Lm + (16 * mt + i) * PT + 32 * s + 16 + 4 * qq);
        const float xv[8] = {x0.x, x0.y, x0.z, x0.w, x1.x, x1.y, x1.z, x1.w};
        U8 H, L; split8(xv, H.v, L.v);
        uint4* mf = B.MF + (size_t)u * 1024 + (size_t)(combo * 2) * 64 + lane;
        mf[0] = H.q; mf[64] = L.q;
    }
    BAR();
}

__device__ __forceinline__ void rwkv_g3_unit(int h, int n, const RwkvBufs& B, bf16_t* __restrict__ Y, const Params& p, int l, LAS unsigned char* lds) {
    const int tid = opq_tid(), w = tid >> 6, lane = tid & 63, q4 = lane >> 4, cc = lane & 15;
    lds_bf16 *KH = plane(lds, 0), *AC = plane(lds, 1), *KC = plane(lds, 2), *RH = plane(lds, 3), *VT = plane(lds, 4), *KHT = plane(lds, 5), *Tp = plane(lds, 6);
    lds_bf16 *HTh = plane(lds, 7), *HTl = plane(lds, 8), *Lk = plane(lds, 9), *Ara = plane(lds, 10), *Ark = plane(lds, 11), *Tq = plane(lds, 12);
    lds_bf16 *PTp = KH, *Wm = AC, *UT = KC;
    LAS float* Os = (LAS float*)(lds + LM_OFF);
    const int t0 = n * 64, u = (4 + h) * 256 + n;
    const int c = tid >> 3, d0 = (tid & 7) * 8;
    {
        RwPiece P; rwkv_load_piece(B, h, t0, c, d0, P);
        float rr[8]; unpack8(*(const uint4*)(B.RR + (size_t)(t0 + c) * 256 + h * 64 + d0), rr);
        const uint4 t8 = *(const uint4*)(B.TG + (size_t)u * 4096 + c * 64 + d0);
        const uint4 t9 = *(const uint4*)(Y + (size_t)(t0 + c) * D + 768 + h * 64 + d0);
        const float* ht = B.HT + (size_t)u * 4096 + c * 64 + d0;
        const float4 h0 = *(const float4*)ht, h1 = *(const float4*)(ht + 4);
        float x0[8], x1[8], x2[8], x3[8];
#pragma unroll
        for (int i = 0; i < 8; ++i) { const float em = __expf(-P.cw[i]); x0[i] = P.kk[i] * __expf(P.cwp[i]); x1[i] = P.al[i] * em; x2[i] = P.kt[i] * em; x3[i] = rr[i] * __expf(P.cw[i]); }
        put8<false>(KH, KH, c, d0, x0); put8<false>(AC, AC, c, d0, x1); put8<false>(KC, KC, c, d0, x2); put8<false>(RH, RH, c, d0, x3);
        put8T<false>(VT, VT, c, d0, P.v); put8T<false>(KHT, KHT, c, d0, x0);
        *(LAS u32x4_t*)(Tp + c * PB + d0) = (u32x4_t){t8.x, t8.y, t8.z, t8.w};
        *(LAS u32x4_t*)(Tq + c * PB + d0) = (u32x4_t){t9.x, t9.y, t9.z, t9.w};
        const float hv[8] = {h0.x, h0.y, h0.z, h0.w, h1.x, h1.y, h1.z, h1.w};
        put8<true>(HTh, HTl, c, d0, hv);
    }
    BAR();
    const int ti = w >> 1, tj0 = (w & 1) * 2;
    const f32x4_t zero4 = {0.f, 0.f, 0.f, 0.f};
#pragma unroll
    for (int tt = 0; tt < 2; ++tt) {
        const int tj = tj0 + tt; const int j = 16 * tj + cc;
        f32x4_t lk = zero4, ara = zero4, ark = zero4;
        if (tj <= ti) {
            const f32x4_t b = mmp<false, false>(KH, KH, KC, KC, 16 * ti, 16 * tj, lane, zero4);
            const f32x4_t e = mmp<false, false>(RH, RH, AC, AC, 16 * ti, 16 * tj, lane, zero4);
            const f32x4_t f = mmp<false, false>(RH, RH, KC, KC, 16 * ti, 16 * tj, lane, zero4);
#pragma unroll
            for (int r = 0; r < 4; ++r) { const int i = 16 * ti + 4 * q4 + r; lk[r] = (i > j) ? b[r] : 0.f; ara[r] = (i >= j) ? e[r] : 0.f; ark[r] = (i >= j) ? f[r] : 0.f; }
        }
        st_tile_R<false>(Lk, Lk, 16 * ti, 16 * tj, lane, lk); st_tile_R<false>(Ara, Ara, 16 * ti, 16 * tj, lane, ara); st_tile_R<false>(Ark, Ark, 16 * ti, 16 * tj, lane, ark);
    }
    BAR();
#pragma unroll
    for (int tt = 0; tt < 2; ++tt) {
        const int tj = tj0 + tt;
        st_tile_T<false>(PTp, PTp, 16 * ti, 16 * tj, lane, mmp<false, false>(Lk, Lk, VT, VT, 16 * ti, 16 * tj, lane, zero4));
        st_tile_R<false>(Wm, Wm, 16 * ti, 16 * tj, lane, mmp<true, false>(Tp, Tq, KHT, KHT, 16 * ti, 16 * tj, lane, zero4));
    }
    BAR();
    f32x4_t o[2];
#pragma unroll
    for (int tt = 0; tt < 2; ++tt) {
        const int tj = tj0 + tt;
        const f32x4_t ua = mmp<true, false>(Tp, Tq, PTp, PTp, 16 * ti, 16 * tj, lane, zero4);
        const f32x4_t wh = mmp<false, true>(Wm, Wm, HTh, HTl, 16 * ti, 16 * tj, lane, zero4);
        st_tile_T<false>(UT, UT, 16 * ti, 16 * tj, lane, -ua - wh);
        o[tt] = mmp<false, true>(RH, RH, HTh, HTl, 16 * ti, 16 * tj, lane, zero4);
        o[tt] = mmp<false, false>(Ark, Ark, VT, VT, 16 * ti, 16 * tj, lane, o[tt]);
    }
    BAR();
#pragma unroll
    for (int tt = 0; tt < 2; ++tt) {
        const int tj = tj0 + tt;
        o[tt] = mmp<false, false>(Ara, Ara, UT, UT, 16 * ti, 16 * tj, lane, o[tt]);
#pragma unroll
        for (int r = 0; r < 4; ++r) Os[(16 * ti + 4 * q4 + r) * PT + 16 * tj + cc] = o[tt][r];
    }
    BAR();
    {
        const f32x4_t x0 = *(const LAS f32x4_t*)(Os + c * PT + d0), x1 = *(const LAS f32x4_t*)(Os + c * PT + d0 + 4);
        const float xv[8] = {x0.x, x0.y, x0.z, x0.w, x1.x, x1.y, x1.z, x1.w};
        float s1 = 0.f;
#pragma unroll
        for (int i = 0; i < 8; ++i) s1 += xv[i];
        s1 += __shfl_xor(s1, 1); s1 += __shfl_xor(s1, 2); s1 += __shfl_xor(s1, 4);
        const float mean = s1 * (1.f / 64.f);
        float s2 = 0.f;
#pragma unroll
        for (int i = 0; i < 8; ++i) { const float dd = xv[i] - mean; s2 = fmaf(dd, dd, s2); }
        s2 += __shfl_xor(s2, 1); s2 += __shfl_xor(s2, 2); s2 += __shfl_xor(s2, 4);
        const float rs = rsqrtf(s2 * (1.f / 64.f) + 64e-5f);
        const size_t o8 = (size_t)(t0 + c) * 256 + h * 64 + d0;
        float rr[8], gg[8], kt2[8], v2[8];
        unpack8(*(const uint4*)(B.RR + o8), rr); unpack8(*(const uint4*)(B.RG + o8), gg); unpack8(*(const uint4*)(B.RK + o8), kt2); unpack8(*(const uint4*)(B.RV + o8), v2);
        const float* r_k = p.in[32] + l * W + h * 64 + d0; const float* ln_g = p.in[33] + l * W + h * 64 + d0; const float* ln_b = p.in[34] + l * W + h * 64 + d0;
        float bs = 0.f;
#pragma unroll
        for (int i = 0; i < 8; ++i) bs = fmaf(rr[i] * kt2[i], r_k[i], bs);
        bs += __shfl_xor(bs, 1); bs += __shfl_xor(bs, 2); bs += __shfl_xor(bs, 4);
        float y[8];
#pragma unroll
        for (int i = 0; i < 8; ++i) y[i] = ((xv[i] - mean) * rs * ln_g[i] + ln_b[i] + bs * v2[i]) * gg[i];
        *(uint4*)(Y + (size_t)(t0 + c) * D + 768 + h * 64 + d0) = pack8(y);
    }
    BAR();
}

struct LruBufs { float2* AGG; float* CAR; };
template <int PASS>
__device__ __forceinline__ void lru_unit(const bf16_t* __restrict__ PM, int n, const LruBufs& B, bf16_t* __restrict__ Y, const Params& p, int l, const bf16_t* __restrict__ LWT  , LAS float* lds) {
    const int tid = opq_tid(), c = tid & 255, half = tid >> 8, w = tid >> 6, lane = tid & 63, q4 = lane >> 4, cc = lane & 15;
    const int t0 = n * 64, tb = t0 + 32 * half;
    LAS float* U = lds;
    lds_bf16* R = (lds_bf16*)(lds + 64 * 260);
    lds_bf16* I = R + 64 * 264;
    {
        const float* cw = p.in[7] + l * 4 * W; const float cb = p.in[8][l * W + c];
        const float w0 = cw[c], w1 = cw[W + c], w2 = cw[2 * W + c], w3 = cw[3 * W + c];
        const bf16_t* col = PM + C_LRU + c;
#pragma unroll 1
        for (int hf = 0; hf < 2; ++hf) {
            bf16_t xr[19];
#pragma unroll
            for (int i = 0; i < 19; ++i) { const int tq = tb + 16 * hf + i - 3; const bf16_t xv_ = col[(size_t)(tq >= 0 ? tq : 0) * PMLD]; xr[i] = tq >= 0 ? xv_ : (bf16_t)0; }
#pragma unroll
            for (int i = 0; i < 16; ++i)
                U[(32 * half + 16 * hf + i) * 260 + c] = cb + w0 * bf2f(xr[i]) + w1 * bf2f(xr[i + 1]) + w2 * bf2f(xr[i + 2]) + w3 * bf2f(xr[i + 3]);
        }
    }
    BAR();
    {
        const int nb = w >> 1, gt = w & 1;
        const bf16_t* wt = LWT + (size_t)gt * 16384 + (size_t)nb * 4096;
        const float* bias = (gt ? p.in[12] : p.in[10]) + l * W + nb * 64;
        const float* lam = p.in[13] + l * W + nb * 64;
#pragma unroll 1
        for (int te = 0; te < 4; ++te) {
            U8 bf[2];
#pragma unroll
            for (int ks = 0; ks < 2; ++ks) bf[ks].q = *(const uint4*)(wt + (size_t)(16 * te + cc) * 64 + 32 * ks + 8 * q4);
            const int ch = nb * 64 + 16 * te + cc;
            const float bv = bias[16 * te + cc];
            const float sp8 = 8.f * softplusf_(-lam[16 * te + cc]);
#pragma unroll
            for (int tt = 0; tt < 4; ++tt) {
                f32x4_t acc = {0.f, 0.f, 0.f, 0.f};
#pragma unroll
                for (int ks = 0; ks < 2; ++ks) {
                    const LAS float* ap = U + (16 * tt + cc) * 260 + nb * 64 + 32 * ks + 8 * q4;
                    const f32x4_t a0 = *(const LAS f32x4_t*)ap, a1 = *(const LAS f32x4_t*)(ap + 4);
                    const float av[8] = {a0.x, a0.y, a0.z, a0.w, a1.x, a1.y, a1.z, a1.w};
                    acc = __builtin_amdgcn_mfma_f32_16x16x32_bf16(hi8(av), bf[ks].v, acc, 0, 0, 0);
                }
#pragma unroll
                for (int r = 0; r < 4; ++r) {
                    const int t = 16 * tt + 4 * q4 + r;
                    const float sg = sigmoidf_(acc[r] + bv);
                    if (gt) I[t * 264 + ch] = (unsigned short)f2bf(sg); else R[t * 264 + ch] = (unsigned short)f2bf(-sp8 * sg);
                }
            }
        }
    }
    BAR();
    float h = 0.f, ap = 1.f;
    const int sc = 2 * n + half;
    bf16_t gc_[8], gn_[8];
    if (PASS == 3) {
        h = B.CAR[(size_t)c * 512 + sc];
#pragma unroll
        for (int i = 0; i < 8; ++i) gc_[i] = PM[(size_t)(tb + i) * PMLD + C_LRU + 256 + c];
    }
#pragma unroll 1
    for (int g8 = 0; g8 < 4; ++g8) {
        if (PASS == 3 && g8 < 3) {
#pragma unroll
            for (int i = 0; i < 8; ++i) gn_[i] = PM[(size_t)(tb + 8 * (g8 + 1) + i) * PMLD + C_LRU + 256 + c];
        }
#pragma unroll
        for (int i = 0; i < 8; ++i) {
            const int t = 32 * half + 8 * g8 + i;
            const float log_a = bf2f(R[t * 264 + c]), ig = bf2f(I[t * 264 + c]);
            const float a = __expf(log_a);
            const float inp = __builtin_amdgcn_sqrtf(fmaxf(1.f - a * a, 0.f)) * (ig * U[t * 260 + c]);
            h = fmaf(a, h, inp); ap *= a;
            if (PASS == 3) Y[(size_t)(t0 + t) * D + 256 + c] = (bf16_t)f2bf(h * geluf_(bf2f(gc_[i])));
        }
        if (PASS == 3) {
#pragma unroll
            for (int i = 0; i < 8; ++i) gc_[i] = gn_[i];
        }
    }
    if (PASS == 1) B.AGG[(size_t)c * 512 + sc] = make_float2(ap, h);
    BAR();
}
__device__ __forceinline__ void lru_carry_wave(const LruBufs& B, int c, int lane) {
    float2 ab[8];
    const float4* src = (const float4*)(B.AGG + (size_t)c * 512 + 8 * lane);
#pragma unroll
    for (int k = 0; k < 4; ++k) { const float4 v = src[k]; ab[2 * k] = make_float2(v.x, v.y); ab[2 * k + 1] = make_float2(v.z, v.w); }
    float A = 1.f, Bv = 0.f;
#pragma unroll
    for (int k = 0; k < 8; ++k) { Bv = fmaf(ab[k].x, Bv, ab[k].y); A *= ab[k].x; }
#pragma unroll
    for (int o = 1; o < 64; o <<= 1) { const float Al = __shfl_up(A, o), Bl = __shfl_up(Bv, o); if (lane >= o) { Bv = fmaf(A, Bl, Bv); A *= Al; } }
    float h = __shfl_up(Bv, 1); if (lane == 0) h = 0.f;
    float o8[8];
#pragma unroll
    for (int k = 0; k < 8; ++k) { o8[k] = h; h = fmaf(ab[k].x, h, ab[k].y); }
    float4* dst = (float4*)(B.CAR + (size_t)c * 512 + 8 * lane);
    dst[0] = make_float4(o8[0], o8[1], o8[2], o8[3]); dst[1] = make_float4(o8[4], o8[5], o8[6], o8[7]);
}

struct S5Bufs { float2* E; float2* CIN; };
template <int PASS>
__device__ __forceinline__ void s5_unit(const bf16_t* __restrict__ PM, int n, const S5Bufs& B, bf16_t* __restrict__ Y, const Params& p, int l, const bf16_t* __restrict__ WL, LAS unsigned char* lds) {
    const int tid = opq_tid(), w = tid >> 6, lane = tid & 63, q4 = lane >> 4, cc = lane & 15;
    const int t0 = n * 64;
    LAS float* bu = (LAS float*)(lds + w * 8448);
    LAS unsigned char* hs = lds + 8 * 8448 + w * 4352;
    lds_bf16* yp = (lds_bf16*)(lds + 8 * 8448 + 8 * 4352);
    const bf16_t* GLUT = WL + WO_GLU;
#pragma unroll 1
    for (int gi = 0; gi < 2; ++gi) {
        const int g = 2 * w + gi;
        U8 bfr[8], cf[4];
#pragma unroll
        for (int tn = 0; tn < 8; ++tn) bfr[tn].q = *(const uint4*)(WL + WO_S5B + ((size_t)(g * 8 + tn) * 64 + lane) * 8);
        float dch = 0.f;
        if (PASS == 3) {
#pragma unroll
            for (int ks = 0; ks < 4; ++ks) cf[ks].q = *(const uint4*)(WL + WO_S5C + ((size_t)(g * 4 + ks) * 64 + lane) * 8);
            dch = p.in[20][l * W + g * 16 + cc];
        }
        float lbr, lbi;
        { const float dt = __expf(p.in[21][l * 16 + g]); const float lre = p.in[14][l * 1024 + g * 64 + lane], lim = p.in[15][l * 1024 + g * 64 + lane];
          const float er = __expf(lre * dt); lbr = er * cosf(lim * dt); lbi = er * sinf(lim * dt); }
        float hr = 0.f, hi = 0.f;
        if (PASS == 3) { const float2 h0 = B.CIN[((size_t)g * 64 + lane) * 256 + n]; hr = h0.x; hi = h0.y; }
#pragma unroll 1
        for (int tt = 0; tt < 4; ++tt) {
            U8 at; at.q = *(const uint4*)(PM + (size_t)(t0 + 16 * tt + cc) * PMLD + C_S5 + g * 16 + 8 * (q4 & 1)); if (q4 >= 2) at.q = make_uint4(0u, 0u, 0u, 0u);
            unsigned short uvr[4];
            if (PASS == 3) {
#pragma unroll
                for (int r = 0; r < 4; ++r) uvr[r] = PM[(size_t)(t0 + 16 * tt + 4 * q4 + r) * PMLD + C_S5 + g * 16 + cc];
            }
#pragma unroll
            for (int tn = 0; tn < 8; ++tn) {
                const f32x4_t acc = __builtin_amdgcn_mfma_f32_16x16x32_bf16(at.v, bfr[tn].v, (f32x4_t){0.f, 0.f, 0.f, 0.f}, 0, 0, 0);
#pragma unroll
                for (int r = 0; r < 4; ++r) bu[(4 * q4 + r) * 132 + 16 * tn + cc] = acc[r];
            }
            asm volatile("s_waitcnt lgkmcnt(0)" ::: "memory");
#pragma unroll
            for (int i = 0; i < 16; ++i) {
                const f32x2v_t bb = *(const LAS f32x2v_t*)(bu + i * 132 + 2 * lane);
                const float nhr = lbr * hr - lbi * hi + bb.x, nhi = lbr * hi + lbi * hr + bb.y;
                hr = nhr; hi = nhi;
                if (PASS == 3) *(LAS unsigned*)(hs + i * 272 + 4 * lane) = cvtpk(hr, hi);
            }
            if (PASS == 3) {
                asm volatile("s_waitcnt lgkmcnt(0)" ::: "memory");
                f32x4_t acc = {0.f, 0.f, 0.f, 0.f};
#pragma unroll
                for (int ks = 0; ks < 4; ++ks) { U8 af; af.x = *(const LAS u32x4_t*)(hs + cc * 272 + 64 * ks + 16 * q4); acc = __builtin_amdgcn_mfma_f32_16x16x32_bf16(af.v, cf[ks].v, acc, 0, 0, 0); }
#pragma unroll
                for (int r = 0; r < 4; ++r) {
                    const int t = 16 * tt + 4 * q4 + r;
                    const float uv = bf2f(uvr[r]);
                    yp[t * 264 + g * 16 + cc] = (unsigned short)f2bf(geluf_(acc[r] + dch * uv));
                }
            }
            asm volatile("s_waitcnt lgkmcnt(0)" ::: "memory");
        }
        if (PASS == 1) B.E[((size_t)g * 64 + lane) * 256 + n] = make_float2(hr, hi);
    }
    if (PASS == 3) {
        BAR();
        const float* gb = p.in[23] + l * W;
#pragma unroll 1
        for (int tn = 2 * w; tn < 2 * w + 2; ++tn) {
            f32x4_t acc[4];
#pragma unroll
            for (int tt = 0; tt < 4; ++tt) acc[tt] = (f32x4_t){0.f, 0.f, 0.f, 0.f};
            U8 bf[8];
#pragma unroll
            for (int ks = 0; ks < 8; ++ks) bf[ks].q = *(const uint4*)(GLUT + (size_t)(16 * tn + cc) * 256 + 32 * ks + 8 * q4);
#pragma unroll
            for (int ks = 0; ks < 8; ++ks) {
#pragma unroll
                for (int tt = 0; tt < 4; ++tt) {
                    U8 af; af.x = *(const LAS u32x4_t*)(yp + (16 * tt + cc) * 264 + 32 * ks + 8 * q4);
                    acc[tt] = __builtin_amdgcn_mfma_f32_16x16x32_bf16(af.v, bf[ks].v, acc[tt], 0, 0, 0);
                }
            }
            const int ncol = 16 * tn + cc; const float gbn = gb[ncol];
#pragma unroll
            for (int tt = 0; tt < 4; ++tt)
#pragma unroll
                for (int r = 0; r < 4; ++r) {
                    const int t = 16 * tt + 4 * q4 + r;
                    const float yv = bf2f(yp[t * 264 + ncol]);
                    Y[(size_t)(t0 + t) * D + 512 + ncol] = (bf16_t)f2bf(yv * sigmoidf_(acc[tt][r] + gbn));
                }
        }
    }
    BAR();
}
__device__ __forceinline__ void s5_carry_wave(const S5Bufs& B, const Params& p, int l, int gp, int lane) {
    const int g = gp >> 6;
    const float dt = __expf(p.in[21][l * 16 + g]) * 64.f;
    const float lre = p.in[14][l * 1024 + gp], lim = p.in[15][l * 1024 + gp];
    const float er = __expf(lre * dt);
    const float pr = er * cosf(lim * dt), pi = er * sinf(lim * dt);
    float2 e[4];
    const float4* src = (const float4*)(B.E + (size_t)gp * 256 + 4 * lane);
    { const float4 v0 = src[0], v1 = src[1]; e[0] = make_float2(v0.x, v0.y); e[1] = make_float2(v0.z, v0.w); e[2] = make_float2(v1.x, v1.y); e[3] = make_float2(v1.z, v1.w); }
    float Ar = 1.f, Ai = 0.f, Br = 0.f, Bi = 0.f;
#pragma unroll
    for (int k = 0; k < 4; ++k) {
        const float nbr = pr * Br - pi * Bi + e[k].x, nbi = pr * Bi + pi * Br + e[k].y; Br = nbr; Bi = nbi;
        const float nar = pr * Ar - pi * Ai, nai = pr * Ai + pi * Ar; Ar = nar; Ai = nai;
    }
#pragma unroll
    for (int o = 1; o < 64; o <<= 1) {
        const float Alr = __shfl_up(Ar, o), Ali = __shfl_up(Ai, o), Blr = __shfl_up(Br, o), Bli = __shfl_up(Bi, o);
        if (lane >= o) {
            const float nbr = Ar * Blr - Ai * Bli + Br, nbi = Ar * Bli + Ai * Blr + Bi; Br = nbr; Bi = nbi;
            const float nar = Ar * Alr - Ai * Ali, nai = Ar * Ali + Ai * Alr; Ar = nar; Ai = nai;
        }
    }
    float hr = __shfl_up(Br, 1), hi = __shfl_up(Bi, 1); if (lane == 0) { hr = 0.f; hi = 0.f; }
    float2 o4[4];
#pragma unroll
    for (int k = 0; k < 4; ++k) { o4[k] = make_float2(hr, hi); const float nhr = pr * hr - pi * hi + e[k].x, nhi = pr * hi + pi * hr + e[k].y; hr = nhr; hi = nhi; }
    float4* dst = (float4*)(B.CIN + (size_t)gp * 256 + 4 * lane);
    dst[0] = make_float4(o4[0].x, o4[0].y, o4[1].x, o4[1].y); dst[1] = make_float4(o4[2].x, o4[2].y, o4[3].x, o4[3].y);
}

constexpr size_t WS_GQ = 36 * MiB, WS_GK = 44 * MiB, WS_GV = 52 * MiB, WS_GB = 60 * MiB, WS_GC = 61 * MiB;
constexpr size_t WS_MF = 324 * MiB, WS_NF = 356 * MiB, WS_HT = 388 * MiB;
constexpr size_t WS_RR = 420 * MiB, WS_RK = 428 * MiB, WS_RV = 436 * MiB, WS_RKK = 444 * MiB, WS_RA = 452 * MiB, WS_RG = 460 * MiB, WS_CW = 468 * MiB;
constexpr size_t WS_LAGG = 484 * MiB, WS_LCAR = 485 * MiB, WS_S5E = 486 * MiB, WS_S5C = 488 * MiB;
constexpr size_t WS_TG = 490 * MiB;
constexpr int MIX_LDS = 8 * MS * 4 + 1024;
__device__ __forceinline__ LruBufs lru_bufs(unsigned char* ws) { LruBufs B; B.AGG = (float2*)(ws + WS_LAGG); B.CAR = (float*)(ws + WS_LCAR); return B; }
__device__ __forceinline__ S5Bufs s5_bufs(unsigned char* ws) { S5Bufs B; B.E = (float2*)(ws + WS_S5E); B.CIN = (float2*)(ws + WS_S5C); return B; }
__device__ __forceinline__ GdnBufs gdn_bufs(unsigned char* ws) {
    GdnBufs B; B.GQ = (bf16_t*)(ws + WS_GQ); B.GK = (bf16_t*)(ws + WS_GK); B.GV = (bf16_t*)(ws + WS_GV); B.GB = (float*)(ws + WS_GB); B.GC = (float*)(ws + WS_GC);
    B.MF = (uint4*)(ws + WS_MF); B.NF = (float*)(ws + WS_NF); B.HT = (float*)(ws + WS_HT); B.TG = (bf16_t*)(ws + WS_TG); return B;
}
__device__ __forceinline__ RwkvBufs rwkv_bufs(unsigned char* ws) {
    RwkvBufs B; B.RR = (bf16_t*)(ws + WS_RR); B.RK = (bf16_t*)(ws + WS_RK); B.RV = (bf16_t*)(ws + WS_RV); B.RKK = (bf16_t*)(ws + WS_RKK); B.RA = (bf16_t*)(ws + WS_RA); B.RG = (bf16_t*)(ws + WS_RG);
    B.CW = (float*)(ws + WS_CW); B.MF = (uint4*)(ws + WS_MF); B.NF = (float*)(ws + WS_NF); B.HT = (float*)(ws + WS_HT); B.TG = (bf16_t*)(ws + WS_TG); return B;
}
__device__ __forceinline__ unsigned char* opq(unsigned char* w) { unsigned long long v = (unsigned long long)w; asm volatile("" : "+s"(v)); return (unsigned char*)(GAS unsigned char*)v; }
#define XB_TMO      128
#define XB_XCNT(j)  (256  + 64 * (j))
#define XB_XSUB(j)  (1280 + 64 * (j))
#define XB_XGEN(j)  (2304 + 64 * (j))
#define XB_TOP      3328
#define XB_TOPGEN   3392
#define XCD_BAR_WORDS 3456
#define XB_SPIN_CAP (1u << 18)

__device__ __forceinline__ unsigned xb_ld(unsigned* p)              { return __hip_atomic_load(p, __ATOMIC_RELAXED, __HIP_MEMORY_SCOPE_AGENT); }
__device__ __forceinline__ unsigned xb_add(unsigned* p, unsigned v) { return __hip_atomic_fetch_add(p, v, __ATOMIC_RELAXED, __HIP_MEMORY_SCOPE_AGENT); }
__device__ __forceinline__ unsigned xb_xcc_id() { return (unsigned)__builtin_amdgcn_s_getreg((3 << 11) | 20) & 0xFu; }
#define XB_SPIN(cond, bar) do { unsigned _sp = 0; while (cond) { __builtin_amdgcn_s_sleep(1); \
    if ((++_sp & 255u) == 0u) { if (xb_ld(&(bar)[XB_TMO])) break; if (_sp > XB_SPIN_CAP) { atomicAdd(&(bar)[XB_TMO], 1u); break; } } } } while (0)

struct XcdBarrier {
    unsigned* bar; unsigned x;
    volatile LAS unsigned* st;
};

__device__ __forceinline__ XcdBarrier xcd_barrier_post(unsigned* bar, volatile LAS unsigned* st) {
    XcdBarrier b; b.bar = bar; b.x = xb_xcc_id(); b.st = st;
    if (threadIdx.x == 0) (void)xb_add(&bar[XB_XCNT(b.x)], 1u);
    return b;
}
__device__ __forceinline__ void xcd_barrier_complete(unsigned* bar, unsigned x, unsigned& nloc, unsigned& nx) {
    const unsigned G = gridDim.x * gridDim.y * gridDim.z;
    unsigned sum, cnt, mine, sp = 0u;
    for (;;) {
        sum = 0u; cnt = 0u; mine = 0u;
#pragma unroll
        for (unsigned j = 0; j < 16; ++j) { const unsigned c = xb_ld(&bar[XB_XCNT(j)]); sum += c; cnt += (c > 0u) ? 1u : 0u; mine = (j == x) ? c : mine; }
        if (sum == G) break;
        __builtin_amdgcn_s_sleep(1);
        if ((++sp & 255u) == 0u) { if (xb_ld(&bar[XB_TMO])) break; if (sp > XB_SPIN_CAP) { atomicAdd(&bar[XB_TMO], 1u); break; } }
    }
    nloc = mine > 0u ? mine : 1u; nx = cnt > 0u ? cnt : 1u;
}

__device__ __forceinline__ void xcd_barrier(const XcdBarrier& b) {
    asm volatile("s_waitcnt vmcnt(0)" ::: "memory");
    __syncthreads();
    if (threadIdx.x == 0) {
        unsigned* bar = b.bar;
        __builtin_amdgcn_s_waitcnt(0);
        unsigned nloc = b.st[0], nx = b.st[1];
        if (nloc == 0u) { xcd_barrier_complete(bar, b.x, nloc, nx); b.st[0] = nloc; b.st[1] = nx; }
        const unsigned old = xb_add(&bar[XB_XSUB(b.x)], 1u);
        const unsigned gen = old / nloc;
        if (old + 1u == (gen + 1u) * nloc) {
            __builtin_amdgcn_fence(__ATOMIC_RELEASE, "agent");
            asm volatile("s_waitcnt vmcnt(0)" ::: "memory");
            const unsigned og = xb_add(&bar[XB_TOP], 1u);
            const unsigned tg = og / nx;
            if (og + 1u == (tg + 1u) * nx) xb_add(&bar[XB_TOPGEN], 1u);
            else XB_SPIN(xb_ld(&bar[XB_TOPGEN]) == tg, bar);
            __builtin_amdgcn_fence(__ATOMIC_ACQUIRE, "agent");
            xb_add(&bar[XB_XGEN(b.x)], 1u);
            asm volatile("s_waitcnt vmcnt(0)" ::: "memory");
        } else {
            XB_SPIN(xb_ld(&bar[XB_XGEN(b.x)]) == gen, bar);
            __builtin_amdgcn_fence(__ATOMIC_ACQUIRE, "agent");
            asm volatile("s_waitcnt vmcnt(0)" ::: "memory");
        }
    }
    __syncthreads();
}

__device__ __forceinline__ void sub_barrier(unsigned* cnt, unsigned target) {
    asm volatile("s_waitcnt vmcnt(0)" ::: "memory"); __syncthreads();
    if (threadIdx.x == 0) {
        __builtin_amdgcn_fence(__ATOMIC_RELEASE, "agent"); asm volatile("s_waitcnt vmcnt(0)" ::: "memory");
        (void)__hip_atomic_fetch_add(cnt, 1u, __ATOMIC_RELAXED, __HIP_MEMORY_SCOPE_AGENT);
        unsigned sp = 0;
        while (__hip_atomic_load(cnt, __ATOMIC_RELAXED, __HIP_MEMORY_SCOPE_AGENT) < target) { __builtin_amdgcn_s_sleep(2); if (++sp > (1u << 22)) break; }
        __builtin_amdgcn_fence(__ATOMIC_ACQUIRE, "agent"); asm volatile("s_waitcnt vmcnt(0)" ::: "memory");
    }
    __syncthreads();
}

namespace cg = cooperative_groups;
constexpr int FUSED_LDS = MIX_LDS;
static_assert(FUSED_LDS >= pg8::STAGE_BYTES && FUSED_LDS >= 8 * 64 * 33 * 4, "LDS budget");
#define GSYNC() xcd_barrier(bar)
#ifndef PHM
#define PHM 511
#endif
#ifndef REP
#define REP 0
#endif
#ifndef REPU
#define REPU 0
#endif
#ifndef REPP
#define REPP 0
#endif
__global__ void __launch_bounds__(NT, 2) fwd_fused(KParams kp_unused) {
    cg::grid_group grid = cg::this_grid();
    extern __shared__ __attribute__((aligned(16))) unsigned char dl[];
    Params p; p.in.tab = (LAS const unsigned long long*)((LAS unsigned char*)dl + FUSED_LDS);
    {
        const __attribute__((address_space(4))) unsigned long long* ka = (const __attribute__((address_space(4))) unsigned long long*)__builtin_amdgcn_kernarg_segment_ptr();
        if (threadIdx.x < 43) ((LAS unsigned long long*)((LAS unsigned char*)dl + FUSED_LDS))[threadIdx.x] = ka[threadIdx.x];
        if (threadIdx.x < 4) ((LAS unsigned*)((LAS unsigned char*)dl + FUSED_LDS + 512))[threadIdx.x] = 0u;
        __syncthreads();
    }
    const XcdBarrier bar = xcd_barrier_post((unsigned*)(p.ws() + WS_CTL), (volatile LAS unsigned*)((LAS unsigned char*)dl + FUSED_LDS + 512));
    float* X = p.out();
#pragma unroll 1
    for (int l = 0; l < 2; ++l) {
        {
            const int tid = opq_tid();
            convert_weights(p, l, (LAS float*)dl + (tid >> 6) * 64 * 33, blockIdx.x * 8 + (tid >> 6), gridDim.x * 8, tid & 63);
        }
#pragma unroll 1
        for (int b = 0; b < 2; ++b) {
            const float* Xin = (l == 0 ? p.in[0] : X) + (size_t)b * TB * D;
            float* Xb = X + (size_t)b * TB * D;
            { unsigned char* ws = opq(p.ws()); rmsnorm_rows(Xin, p.in[1] + l * D, (bf16_t*)(ws + WS_XN), TB); }
            if (l == 0 && b == 0) grid.sync(); else GSYNC();
#if PHM & 1
            for (int rep_ = 0; rep_ < ((REP & 1) ? 2 : 1); ++rep_) {
            {
                unsigned char* ws = opq(p.ws()); const bf16_t* WL = (const bf16_t*)(ws + WS_W);
                pg8::Gemm g{(const bf16_t*)(ws + WS_XN), WL + WO_IN, TB, 7168, D, D, D, 0};
                pg8::StaticOrder S; S.init(g.M, g.N, (int)gridDim.x, (int)blockIdx.x);
                pg8::gemm_phase<pg8::EpiProjP, pg8::StaticOrder, true, true>((PG8_LAS unsigned char*)dl, g, S, pg8::EpiProjP{(bf16_t*)(ws + WS_PM), (bf16_t*)(ws + WS_G)});
            }
            }
#endif
            GSYNC();
#if PHM & 2
            for (int rep_ = 0; rep_ < ((REP & 2) ? 2 : 1); ++rep_) {
            for (int ps_ = 0; ps_ < ((REPP == 2) ? 2 : 1); ++ps_)
            for (int n = blockIdx.x; n < 512; n += gridDim.x) {
                if (ps_ == 1 && ((n < 256) ? 1 : 2) != REPU) continue;
                unsigned char* ws = opq(p.ws());
                if (n < 256) gdn_prep_chunk((const bf16_t*)(ws + WS_PM), n, gdn_bufs(ws), p, l, (LAS float*)dl);
                else { const bf16_t* WL = (const bf16_t*)(ws + WS_W); rwkv_prep_chunk((const bf16_t*)(ws + WS_PM), n - 256, rwkv_bufs(ws), p, l, WL + WO_WUP, WL + WO_AUP, WL + WO_GUP, (LAS unsigned char*)dl); }
            }
            }
#endif
            if (gridDim.x == 256) {
                asm volatile("s_waitcnt vmcnt(0)" ::: "memory"); __syncthreads();
                if (threadIdx.x == 0) { __builtin_amdgcn_fence(__ATOMIC_ACQUIRE, "agent"); asm volatile("s_waitcnt vmcnt(0)" ::: "memory"); }
                __syncthreads();
            } else GSYNC();
#if PHM & 4
            for (int rep_ = 0; rep_ < ((REP & 4) ? 2 : 1); ++rep_) {
            for (int ps_ = 0; ps_ < ((REPP == 4) ? 2 : 1); ++ps_)
            for (int u = blockIdx.x; u < 2048; u += gridDim.x) {
                const int ut_ = u < 1024 ? 1 : 2;
                if (ps_ == 1 && ut_ != REPU) continue;
                unsigned char* ws = opq(p.ws());
                if (u < 1024) gdn_g1_unit(u >> 8, u & 255, gdn_bufs(ws), (bf16_t*)(ws + WS_Y), (LAS unsigned char*)dl);
                else rwkv_g1_unit((u - 1024) >> 8, u & 255, rwkv_bufs(ws), (bf16_t*)(ws + WS_Y), (LAS unsigned char*)dl);
            }
            }
#endif
            GSYNC();
#if PHM & 8
            for (int rep_ = 0; rep_ < ((REP & 8) ? 2 : 1); ++rep_) {
            {
                const int tid = opq_tid(), lane = tid & 63, wv = tid >> 6;
                const int bx = blockIdx.x;
                volatile LAS unsigned* flags = (volatile LAS unsigned*)((LAS unsigned char*)dl + FUSED_LDS + 768);
                if (tid < 16) flags[tid] = 0u;
                __syncthreads();
                if (bx < 32) {
                    unsigned char* ws = opq(p.ws());
                    const GdnBufs B = gdn_bufs(ws); const int sq = bx >> 2, cb = bx & 3;
                    if (wv == 0) chain_wave(B.HT + (size_t)sq * 256 * 4096, cb, 256, lane, (LAS unsigned char*)dl, flags);
                    else chain_loader(B.MF + (size_t)sq * 256 * 1024, B.NF + (size_t)sq * 256 * 4096, cb, 256, lane, wv - 1, (LAS unsigned char*)dl, flags);
                } else {
                    for (int u = bx - 32; u < 512; u += (int)gridDim.x - 32) {
                        unsigned char* ws = opq(p.ws());
                        if (u < 256) lru_unit<1>((const bf16_t*)(ws + WS_PM), u, lru_bufs(ws), (bf16_t*)(ws + WS_Y), p, l, (const bf16_t*)(ws + WS_W) + WO_LWT, (LAS float*)dl);
                        else s5_unit<1>((const bf16_t*)(ws + WS_PM), u - 256, s5_bufs(ws), (bf16_t*)(ws + WS_Y), p, l, (const bf16_t*)(ws + WS_W), (LAS unsigned char*)dl);
                    }
                    sub_barrier((unsigned*)(p.ws() + WS_CTL + 15488), (unsigned)(gridDim.x - 32) * (unsigned)(l * 2 + b + 1));
                    {
                        unsigned char* ws = opq(p.ws());
                        for (int job = (bx - 32) * 8 + wv; job < 1280; job += (int)(gridDim.x - 32) * 8) {
                            if (job < 256) lru_carry_wave(lru_bufs(ws), job, lane);
                            else s5_carry_wave(s5_bufs(ws), p, l, job - 256, lane);
                        }
                    }
                    sub_barrier((unsigned*)(p.ws() + WS_CTL + 15360), (unsigned)(gridDim.x - 32) * (unsigned)(l * 2 + b + 1));
                    for (int u = bx - 32; u < 512; u += (int)gridDim.x - 32) {
                        unsigned char* ws = opq(p.ws());
                        if (u < 256) lru_unit<3>((const bf16_t*)(ws + WS_PM), u, lru_bufs(ws), (bf16_t*)(ws + WS_Y), p, l, (const bf16_t*)(ws + WS_W) + WO_LWT, (LAS float*)dl);
                        else s5_unit<3>((const bf16_t*)(ws + WS_PM), u - 256, s5_bufs(ws), (bf16_t*)(ws + WS_Y), p, l, (const bf16_t*)(ws + WS_W), (LAS unsigned char*)dl);
                    }
                }
            }
            }
#endif
            GSYNC();
#if PHM & 16
            for (int rep_ = 0; rep_ < ((REP & 16) ? 2 : 1); ++rep_) {
            for (int ps_ = 0; ps_ < ((REPP == 16) ? 2 : 1); ++ps_)
            for (int u = blockIdx.x; u < 2048; u += gridDim.x) {
                const int ut_ = u < 1024 ? 1 : (u < 2048 ? 2 : (u < 2304 ? 3 : 4));
                if (ps_ == 1 && ut_ != REPU) continue;
                unsigned char* ws = opq(p.ws());
                if (u < 1024) gdn_g3_unit(u >> 8, u & 255, gdn_bufs(ws), (const bf16_t*)(ws + WS_PM), (bf16_t*)(ws + WS_Y), p.in[6] + l * 64, (LAS unsigned char*)dl);
                else rwkv_g3_unit((u - 1024) >> 8, u & 255, rwkv_bufs(ws), (bf16_t*)(ws + WS_Y), p, l, (LAS unsigned char*)dl);
            }
            }
#endif
            GSYNC();
#if PHM & 32
            for (int rep_ = 0; rep_ < ((REP & 32) ? 2 : 1); ++rep_) {
            { unsigned char* ws = opq(p.ws()); merge_phase((const bf16_t*)(ws + WS_Y), (const bf16_t*)(ws + WS_W) + WO_BR, (const bf16_t*)(ws + WS_G), (bf16_t*)(ws + WS_MG), (LAS unsigned char*)dl); }
            }
#endif
            GSYNC();
#if PHM & 64
            {
                unsigned char* ws = opq(p.ws()); const bf16_t* WL = (const bf16_t*)(ws + WS_W);
                pg8::Gemm g{(const bf16_t*)(ws + WS_MG), WL + WO_OUT, TB, D, D, D, D, 0};
                pg8::StaticOrder S; S.init(g.M, g.N, (int)gridDim.x, (int)blockIdx.x);
                pg8::gemm_phase<pg8::EpiResidP, pg8::StaticOrder, false, true>((PG8_LAS unsigned char*)dl, g, S, pg8::EpiResidP{Xin, Xb});
            }
#endif
            GSYNC();
            { unsigned char* ws = opq(p.ws()); rmsnorm_rows(Xb, p.in[37] + l * D, (bf16_t*)(ws + WS_XN), TB); }
            GSYNC();
#if PHM & 128
            for (int rep_ = 0; rep_ < ((REP & 128) ? 2 : 1); ++rep_) {
            {
                unsigned char* ws = opq(p.ws()); const bf16_t* WL = (const bf16_t*)(ws + WS_W);
                pg8::Gemm g{(const bf16_t*)(ws + WS_XN), WL + WO_W1, TB, DFF, D, D, D, 0};
                pg8::StaticOrder S; S.init(g.M, g.N, (int)gridDim.x, (int)blockIdx.x);
                pg8::gemm_phase<pg8::EpiRelu2P, pg8::StaticOrder, true, true>((PG8_LAS unsigned char*)dl, g, S, pg8::EpiRelu2P{(bf16_t*)(ws + WS_HD), DFF, 0});
            }
            }
#endif
            GSYNC();
#if PHM & 256
            {
                unsigned char* ws = opq(p.ws()); const bf16_t* WL = (const bf16_t*)(ws + WS_W);
                pg8::Gemm g{(const bf16_t*)(ws + WS_HD), WL + WO_W2, TB, D, DFF, DFF, DFF, 0};
                pg8::StaticOrder S; S.init(g.M, g.N, (int)gridDim.x, (int)blockIdx.x);
                pg8::gemm_phase<pg8::EpiResidP, pg8::StaticOrder, false, true>((PG8_LAS unsigned char*)dl, g, S, pg8::EpiResidP{Xb, Xb});
            }
#endif
            GSYNC();
        }
    }
    rmsnorm_rows(X, p.in[40], X, 2 * TB);
}

extern "C" void kernel_launch(void* const* d_in, const int* in_sizes, int n_in, void* d_out, int out_size, void* d_ws, size_t ws_size, hipStream_t stream) {
    KParams p{};
    for (int i = 0; i < 41; ++i) p.in[i] = (const float*)d_in[i];
    p.out = (float*)d_out; p.ws = (unsigned char*)d_ws; p.pad = 0;
    static int grid = 0;
    if (grid == 0) {
        int dev = 0, cus = 0, per_cu = 0;
        hipGetDevice(&dev);
        hipDeviceGetAttribute(&cus, hipDeviceAttributeMultiprocessorCount, dev);
        hipFuncSetAttribute((const void*)fwd_fused, hipFuncAttributeMaxDynamicSharedMemorySize, FUSED_LDS + 1024);
        hipOccupancyMaxActiveBlocksPerMultiprocessor(&per_cu, (const void*)fwd_fused, NT, FUSED_LDS + 1024);
        if (per_cu < 1) per_cu = 1;
        grid = cus * per_cu;
        if (grid > 256) grid = 256;
    }
    hipMemsetAsync((unsigned char*)d_ws + WS_CTL, 0, 16384, stream);
    void* args[] = {&p};
    hipError_t e = hipLaunchCooperativeKernel((const void*)fwd_fused, dim3(grid), dim3(NT), args, FUSED_LDS + 1024, stream);
    if (e != hipSuccess) fprintf(stderr, "cooperative launch failed: %s (grid %d)\n", hipGetErrorString(e), grid);
}
```
